# Optimizing an MI355X kernel written in HIP

```python
import math
import jax, jax.numpy as jnp
from jax import lax
import numpy as np

D_MODEL = 2048
BATCH = 16
SEQ = 2048
DEPTH = 4

N_MIXERS = 2
MEM_LEN = 256
MIX_WIDTH = D_MODEL
MEM_HEADS = 4
MEM_HEAD_DIM = MIX_WIDTH // (4 * MEM_HEADS)
MEM_WIDTH = MEM_HEADS * MEM_HEAD_DIM
SEQ_WIDTH = MIX_WIDTH - MEM_WIDTH

RWKV_HEAD = 64
RWKV_HEADS = SEQ_WIDTH // RWKV_HEAD
LORA_W = 96
LORA_A = 96
LORA_V = 64
LORA_G = 256
RWKV_GN_EPS = 1e-5 * RWKV_HEAD

RET_HEADS = 6
RET_DV = SEQ_WIDTH // RET_HEADS
RET_DK = RET_DV // 2
RET_CHUNK = 128
ROPE_BASE = 10000.0

D_FF = 5632
N_EXPERTS = 8
TOP_K = 2
D_FF_EXPERT = 5632

ALPHA = (2.0 * DEPTH) ** 0.25
BETA = (8.0 * DEPTH) ** -0.25
LN_EPS = 1e-5

kernel_name = "hybrid_rwkv7_retention_memattn_moe_deepnorm"


def layer_norm(x, g, b, eps=LN_EPS):
    xf = x.astype(jnp.float32)
    mu = jnp.mean(xf, -1, keepdims=True)
    var = jnp.mean(jnp.square(xf - mu), -1, keepdims=True)
    return ((xf - mu) * lax.rsqrt(var + eps)).astype(x.dtype) * g + b


def head_norm(y, g, b, eps):
    B, S, H, d = y.shape
    yf = y.astype(jnp.float32)
    mu = jnp.mean(yf, -1, keepdims=True)
    var = jnp.mean(jnp.square(yf - mu), -1, keepdims=True)
    yn = ((yf - mu) * lax.rsqrt(var + eps)).astype(y.dtype)
    return yn.reshape(B, S, H * d) * g + b


def split_cols(p, sizes):
    idx = [int(i) for i in np.cumsum(sizes)[:-1]]
    return jnp.split(p, idx, axis=-1)


def token_shift(p):
    return jnp.pad(p, ((0, 0), (1, 0), (0, 0)))[:, :-1]


def rwkv7_scan(r, w, k, v, kk, a):
    f32 = jnp.float32
    B, S, H, N = r.shape
    xs = tuple(jnp.moveaxis(t.astype(f32), 1, 0) for t in (r, w, k, v, kk, a))

    def step(state, inp):
        r_t, w_t, k_t, v_t, kk_t, a_t = inp
        sa = jnp.einsum('bhij,bhj->bhi', state, -kk_t)
        state = (state * w_t[:, :, None, :]
                 + sa[..., None] * (kk_t * a_t)[:, :, None, :]
                 + v_t[..., None] * k_t[:, :, None, :])
        y_t = jnp.einsum('bhij,bhj->bhi', state, r_t)
        return state, y_t

    s0 = jnp.zeros((B, H, N, N), f32)
    _, y = lax.scan(step, s0, xs)
    return jnp.moveaxis(y, 0, 1).astype(r.dtype)


def rwkv7_mixer(p, mu, up_w, up_a, up_g, up_v, vecs, v_first):
    B, S, _ = p.shape
    p = p + mu * (token_shift(p) - p)
    if up_v is None:
        r, k, v, xw, xa, xg = split_cols(p, [SEQ_WIDTH] * 3 + [LORA_W, LORA_A, LORA_G])
        w0, a0, k_k, k_a, r_k, gn_g, gn_b = vecs
        v_first = v
    else:
        r, k, v, xw, xa, xv, xg = split_cols(p, [SEQ_WIDTH] * 3 + [LORA_W, LORA_A, LORA_V, LORA_G])
        w0, a0, v0, k_k, k_a, r_k, gn_g, gn_b = vecs
        v = v + (v_first - v) * jax.nn.sigmoid(v0 + xv @ up_v)
    w_log = -jax.nn.softplus(-(w0 + jnp.tanh(xw) @ up_w)) - 0.5
    decay = jnp.exp(-jnp.exp(w_log.astype(jnp.float32))).astype(p.dtype)
    a = jax.nn.sigmoid(a0 + xa @ up_a)
    g = jax.nn.sigmoid(xg) @ up_g

    heads = lambda t: t.reshape(B, S, RWKV_HEADS, RWKV_HEAD)
    kk = heads(k * k_k).astype(jnp.float32)
    kk = (kk / jnp.maximum(jnp.sqrt(jnp.sum(jnp.square(kk), -1, keepdims=True)), 1e-12)).astype(p.dtype)
    k = k * (1.0 + (a - 1.0) * k_a)
    r_h, k_h, v_h = heads(r), heads(k), heads(v)
    y = rwkv7_scan(r_h, heads(decay), k_h, v_h, kk, heads(a))
    bonus = jnp.sum(r_h * k_h * r_k.reshape(RWKV_HEADS, RWKV_HEAD), -1, keepdims=True) * v_h
    y = head_norm(y, gn_g, gn_b, RWKV_GN_EPS) + bonus.reshape(B, S, SEQ_WIDTH)
    return y * g, v_first


def rotary(x, pos):
    d = x.shape[-1]
    inv = 1.0 / (ROPE_BASE ** (jnp.arange(0, d, 2, dtype=jnp.float32) / d))
    ang = pos.astype(jnp.float32)[..., None] * inv
    cos = jnp.cos(ang)[:, :, None, :]
    sin = jnp.sin(ang)[:, :, None, :]
    x1, x2 = jnp.split(x.astype(jnp.float32), 2, axis=-1)
    return jnp.concatenate([x1 * cos - x2 * sin, x1 * sin + x2 * cos], -1).astype(x.dtype)


def retention(q, k, v, pos):
    f32 = jnp.float32
    B, S, H, dk = q.shape
    dv = v.shape[-1]
    C = RET_CHUNK
    nC = S // C
    q = rotary(q, pos)
    k = rotary(k, pos) * (dk ** -0.5)
    log_g = jnp.log1p(-jnp.exp2(-5.0 - jnp.arange(H, dtype=f32)))
    idx = jnp.arange(C, dtype=f32)
    diff = idx[:, None] - idx[None, :]
    intra_decay = jnp.where(diff >= 0, jnp.exp(jnp.maximum(diff, 0.0)[None] * log_g[:, None, None]), 0.0)
    q_decay = jnp.exp((idx + 1.0)[:, None] * log_g[None, :])[None, :, :, None]
    k_decay = jnp.exp((C - 1.0 - idx)[:, None] * log_g[None, :])[None, :, :, None]
    chunk_decay = jnp.exp(C * log_g)[None, :, None, None]

    def chunks(t):
        return jnp.moveaxis(t.astype(f32).reshape(B, nC, C, H, t.shape[-1]), 1, 0)

    def step(R, inp):
        qc, kc, vc = inp
        s = jnp.einsum('bnhd,bmhd->bhnm', qc, kc) * intra_decay[None]
        o = jnp.einsum('bhnm,bmhe->bnhe', s, vc)
        o = o + jnp.einsum('bnhd,bhde->bnhe', qc * q_decay, R)
        R = R * chunk_decay + jnp.einsum('bmhd,bmhe->bhde', kc * k_decay, vc)
        return R, o

    R0 = jnp.zeros((B, H, dk, dv), f32)
    _, o = lax.scan(step, R0, (chunks(q), chunks(k), chunks(v)))
    return jnp.moveaxis(o, 0, 1).reshape(B, S, H, dv).astype(v.dtype)


def retention_mixer(p, positions, gn):
    B, S, _ = p.shape
    q, k, v, g = split_cols(p, [RET_HEADS * RET_DK, RET_HEADS * RET_DK, SEQ_WIDTH, SEQ_WIDTH])
    o = retention(q.reshape(B, S, RET_HEADS, RET_DK), k.reshape(B, S, RET_HEADS, RET_DK),
                  v.reshape(B, S, RET_HEADS, RET_DV), positions)
    return jax.nn.silu(g) * head_norm(o, gn[0], gn[1], LN_EPS)


def memory_attention(q, mem_k, mem_v):
    B, S, _ = q.shape
    q = q.reshape(B, S, MEM_HEADS, MEM_HEAD_DIM)
    s = jnp.einsum('bshd,bmhd->bhsm', q, mem_k).astype(jnp.float32) * (MEM_HEAD_DIM ** -0.5)
    p = jax.nn.softmax(s, axis=-1).astype(mem_v.dtype)
    return jnp.einsum('bhsm,bmhd->bshd', p, mem_v).reshape(B, S, MEM_WIDTH)


def swiglu(x, w_gate, w_up, w_down):
    return (jax.nn.silu(x @ w_gate) * (x @ w_up)) @ w_down


def moe_swiglu(x, w_router, w_gate, w_up, w_down):
    logits = (x @ w_router).astype(jnp.float32)
    top_val, top_idx = lax.top_k(logits, TOP_K)
    top_w = jax.nn.softmax(top_val, axis=-1)
    combine = jnp.sum(jax.nn.one_hot(top_idx, N_EXPERTS, dtype=jnp.float32) * top_w[..., None], axis=-2)
    combine = combine.astype(x.dtype)
    y = jnp.zeros_like(x)
    for e in range(N_EXPERTS):
        y = y + combine[..., e:e + 1] * swiglu(x, w_gate[e], w_up[e], w_down[e])
    return y


def setup_inputs(seed: int = 0) -> dict:
    key = jax.random.key(seed)
    keys = iter(jax.random.split(key, 128))
    f32 = jnp.float32

    def normal(shape, scale):
        return jax.random.normal(next(keys), shape, f32) * scale

    def uniform(shape, lo, hi):
        return jax.random.uniform(next(keys), shape, f32, lo, hi)

    def gain(n):
        return 1.0 + normal((n,), 0.02)

    def proj_in(sizes, scales):
        col_scale = jnp.concatenate([jnp.full((n,), s, f32) for n, s in zip(sizes, scales)])
        return normal((D_MODEL, sum(sizes)), D_MODEL ** -0.5) * col_scale

    def norms():
        return jnp.stack([gain(D_MODEL), normal((D_MODEL,), 0.02), gain(D_MODEL), normal((D_MODEL,), 0.02)])

    inp = {}
    inp["x"] = normal((BATCH, SEQ, D_MODEL), 1.0)
    inp["mem"] = normal((BATCH, MEM_LEN, D_MODEL), 1.0)
    offset = jax.random.randint(next(keys), (BATCH, 1), 0, 4096, dtype=jnp.int32)
    inp["positions"] = offset + jnp.arange(SEQ, dtype=jnp.int32)[None, :]
    inp["mem_w_kv"] = proj_in([MEM_WIDTH, MEM_WIDTH], [1.0, BETA])

    def add_rwkv(pre, with_v):
        sizes = [SEQ_WIDTH] * 3 + [LORA_W, LORA_A] + ([LORA_V] if with_v else []) + [LORA_G]
        scales = [1.0, 1.0, BETA, 1.0, 1.0] + ([1.0] if with_v else []) + [1.0]
        inp[pre + "w_in"] = proj_in(sizes + [MEM_WIDTH], scales + [1.0])
        inp[pre + "mu"] = uniform((sum(sizes),), 0.0, 1.0)
        inp[pre + "lora_w"] = normal((LORA_W, SEQ_WIDTH), 0.5 * LORA_W ** -0.5)
        inp[pre + "lora_a"] = normal((LORA_A, SEQ_WIDTH), 0.5 * LORA_A ** -0.5)
        if with_v:
            inp[pre + "lora_v"] = normal((LORA_V, SEQ_WIDTH), 0.5 * LORA_V ** -0.5)
        inp[pre + "lora_g"] = normal((LORA_G, SEQ_WIDTH), LORA_G ** -0.5)
        vecs = [uniform((SEQ_WIDTH,), -6.5, -1.5), normal((SEQ_WIDTH,), 0.5)]
        if with_v:
            vecs.append(normal((SEQ_WIDTH,), 0.5))
        vecs += [0.85 + normal((SEQ_WIDTH,), 0.1), 1.0 + normal((SEQ_WIDTH,), 0.1),
                 normal((SEQ_WIDTH,), 0.1), gain(SEQ_WIDTH), normal((SEQ_WIDTH,), 0.02)]
        inp[pre + "vecs"] = jnp.stack(vecs)
        inp[pre + "w_out"] = normal((MIX_WIDTH, D_MODEL), BETA * MIX_WIDTH ** -0.5)
        inp[pre + "norms"] = norms()
        inp[pre + "ffn_gate"] = normal((D_MODEL, D_FF), BETA * D_MODEL ** -0.5)
        inp[pre + "ffn_up"] = normal((D_MODEL, D_FF), BETA * D_MODEL ** -0.5)
        inp[pre + "ffn_down"] = normal((D_FF, D_MODEL), BETA * D_FF ** -0.5)

    def add_ret(pre):
        qk = RET_HEADS * RET_DK
        inp[pre + "w_in"] = proj_in([qk, qk, SEQ_WIDTH, SEQ_WIDTH, MEM_WIDTH], [1.0, 1.0, BETA, 1.0, 1.0])
        inp[pre + "gn"] = jnp.stack([gain(SEQ_WIDTH), normal((SEQ_WIDTH,), 0.02)])
        inp[pre + "w_out"] = normal((MIX_WIDTH, D_MODEL), BETA * MIX_WIDTH ** -0.5)
        inp[pre + "norms"] = norms()
        inp[pre + "router"] = normal((D_MODEL, N_EXPERTS), D_MODEL ** -0.5)
        inp[pre + "moe_gate"] = normal((N_EXPERTS, D_MODEL, D_FF_EXPERT), BETA * D_MODEL ** -0.5)
        inp[pre + "moe_up"] = normal((N_EXPERTS, D_MODEL, D_FF_EXPERT), BETA * D_MODEL ** -0.5)
        inp[pre + "moe_down"] = normal((N_EXPERTS, D_FF_EXPERT, D_MODEL), BETA * D_FF_EXPERT ** -0.5)

    add_rwkv("l0_", False)
    add_ret("l1_")
    add_rwkv("l2_", True)
    add_ret("l3_")
    return inp


def reference(x, mem, positions, mem_w_kv,
              l0_w_in, l0_mu, l0_lora_w, l0_lora_a, l0_lora_g, l0_vecs, l0_w_out, l0_norms,
              l0_ffn_gate, l0_ffn_up, l0_ffn_down,
              l1_w_in, l1_gn, l1_w_out, l1_norms, l1_router, l1_moe_gate, l1_moe_up, l1_moe_down,
              l2_w_in, l2_mu, l2_lora_w, l2_lora_a, l2_lora_v, l2_lora_g, l2_vecs, l2_w_out, l2_norms,
              l2_ffn_gate, l2_ffn_up, l2_ffn_down,
              l3_w_in, l3_gn, l3_w_out, l3_norms, l3_router, l3_moe_gate, l3_moe_up, l3_moe_down):
    B, M, _ = mem.shape
    mem_kv = mem @ mem_w_kv
    mem_k, mem_v = [t.reshape(B, M, MEM_HEADS, MEM_HEAD_DIM) for t in jnp.split(mem_kv, 2, axis=-1)]

    layers = [
        dict(w_in=l0_w_in, mixer=(l0_mu, l0_lora_w, l0_lora_a, l0_lora_g, None, l0_vecs),
             w_out=l0_w_out, norms=l0_norms, ffn=(l0_ffn_gate, l0_ffn_up, l0_ffn_down)),
        dict(w_in=l1_w_in, mixer=(l1_gn,), w_out=l1_w_out, norms=l1_norms,
             ffn=(l1_router, l1_moe_gate, l1_moe_up, l1_moe_down)),
        dict(w_in=l2_w_in, mixer=(l2_mu, l2_lora_w, l2_lora_a, l2_lora_g, l2_lora_v, l2_vecs),
             w_out=l2_w_out, norms=l2_norms, ffn=(l2_ffn_gate, l2_ffn_up, l2_ffn_down)),
        dict(w_in=l3_w_in, mixer=(l3_gn,), w_out=l3_w_out, norms=l3_norms,
             ffn=(l3_router, l3_moe_gate, l3_moe_up, l3_moe_down)),
    ]

    v_first = None
    for i in range(DEPTH):
        L = layers[i]
        p = x @ L["w_in"]
        p_seq, q_mem = p[..., :-MEM_WIDTH], p[..., -MEM_WIDTH:]
        if i % N_MIXERS == 0:
            y_seq, v_first = rwkv7_mixer(p_seq, *L["mixer"], v_first)
        else:
            y_seq = retention_mixer(p_seq, positions, *L["mixer"])
        y_mem = memory_attention(q_mem, mem_k, mem_v)
        h = jnp.concatenate([y_seq, y_mem], axis=-1) @ L["w_out"]
        nrm = L["norms"]
        x = layer_norm(ALPHA * x + h, nrm[0], nrm[1])
        if i % 2 == 0:
            f = swiglu(x, *L["ffn"])
        else:
            f = moe_swiglu(x, *L["ffn"])
        x = layer_norm(ALPHA * x + f, nrm[2], nrm[3])
    return x
```

```cpp
#include <hip/hip_runtime.h>
#include <cstdio>
#include <cstdint>

#define LAS __attribute__((address_space(3)))
#define GAS __attribute__((address_space(1)))
typedef unsigned short bf16;
typedef short bf16x8 __attribute__((ext_vector_type(8)));
typedef float f32x4 __attribute__((ext_vector_type(4)));
typedef float f32x2 __attribute__((ext_vector_type(2)));
typedef unsigned u32x4 __attribute__((ext_vector_type(4)));
typedef unsigned u32x2 __attribute__((ext_vector_type(2)));

constexpr int M = 32768, D = 2048, SEQ = 2048, NB = 16;
constexpr int SW = 1536;
constexpr int LDP_RW = 5632, LDP_RET = 5120;
constexpr int DFF = 5632;
constexpr int NSLOT = 67584;
constexpr float ALPHA = 1.6817928305074290f;
constexpr float LN_EPS = 1e-5f;
constexpr int NWAVES = 8, NTHR = 512, GRID = 256;

constexpr size_t MiB = 1u << 20;
constexpr size_t WS_CTL = 0, CTL_BYTES = 1 * MiB;
constexpr size_t WS_WKV = 1 * MiB;
constexpr size_t WS_WIN = WS_WKV + 4 * MiB;
constexpr size_t WS_WOUT = WS_WIN + 88 * MiB;
constexpr size_t WS_WLORA = WS_WOUT + 32 * MiB;
constexpr size_t WS_WFGU = WS_WLORA + 6 * MiB;
constexpr size_t WS_WFD = WS_WFGU + 88 * MiB;
constexpr size_t WS_MEMB = WS_WFD + 44 * MiB;
constexpr size_t WS_MEMK = WS_MEMB + 16 * MiB;
constexpr size_t WS_MEMVT = WS_MEMK + 4 * MiB;
constexpr size_t WS_CS = WS_MEMVT + 4 * MiB;
constexpr size_t WS_XB = WS_CS + 16 * MiB;
constexpr size_t WS_MIX = WS_XB + 128 * MiB;
constexpr size_t WS_VFIRST = WS_MIX + 128 * MiB;
constexpr size_t WS_P = WS_VFIRST + 96 * MiB;
constexpr size_t WS_MISC = WS_P + 352 * MiB;
constexpr size_t WS_ROUTE = WS_MISC, WS_SLOT1 = WS_MISC + 512 * 1024, WS_SLOT2 = WS_SLOT1 + 128 * 1024, WS_SLOTTOK = WS_SLOT2 + 128 * 1024;
constexpr size_t WS_BONUS = WS_MISC + 2 * MiB;
constexpr size_t WS_SB = WS_BONUS + 3 * MiB;
constexpr size_t WS_ALORA = WS_SB, WS_LORAOUT = WS_SB + 32 * MiB, WS_SCANIN = WS_SB + 416 * MiB;
constexpr size_t WS_QR = WS_SB, WS_KR = WS_SB + 48 * MiB, WS_KDT = WS_SB + 96 * MiB, WS_VT = WS_SB + 144 * MiB, WS_KVT = WS_SB + 240 * MiB, WS_RTB = WS_SB + 432 * MiB;
constexpr size_t WS_HID = WS_SB;
constexpr size_t WS_XPERM = WS_SB, WS_HIDM = WS_SB + 264 * MiB, WS_MWGU = WS_SB + 1184 * MiB, WS_MWD = WS_SB + 1360 * MiB;
constexpr size_t WS_XLO = WS_SB + 1518 * MiB;
constexpr size_t WS_X8 = WS_XLO + 64 * MiB;
constexpr size_t WS_END = WS_X8 + 64 * MiB;
constexpr int CW_BAR = 4096;
constexpr int CW_CNT = 16384;
constexpr int CW_NT = 20480;
constexpr int CW_TEXP = 20544;

constexpr int RING_BYTES = 131072;
constexpr int LDS_MISC = RING_BYTES;
constexpr int LDS_BYTES = RING_BYTES + 8192;

#define LDS_WAIT() asm volatile("s_waitcnt lgkmcnt(0)" ::: "memory")
#define VM_WAIT() asm volatile("s_waitcnt vmcnt(0)" ::: "memory")
__device__ __forceinline__ unsigned cvt_pk_bf16(float lo, float hi) { unsigned r; asm volatile("v_cvt_pk_bf16_f32 %0, %1, %2" : "=v"(r) : "v"(lo), "v"(hi)); return r; }
__device__ __forceinline__ bf16 f2bf(float f) { return (bf16)(cvt_pk_bf16(f, 0.f) & 0xffffu); }
__device__ __forceinline__ float bf2f(bf16 b) { return __uint_as_float(((unsigned)b) << 16); }
__device__ __forceinline__ float bflo(unsigned w) { return __uint_as_float(w << 16); }
__device__ __forceinline__ float bfhi(unsigned w) { return __uint_as_float(w & 0xffff0000u); }
template <int CTRL> __device__ __forceinline__ float dpp_add(float x) {
    int y = __builtin_amdgcn_update_dpp(0, __float_as_int(x), CTRL, 0xf, 0xf, true);
    return x + __int_as_float(y);
}
__device__ __forceinline__ float row16_sum(float x) { x = dpp_add<0xB1>(x); x = dpp_add<0x4E>(x); x = dpp_add<0x141>(x); x = dpp_add<0x140>(x); return x; }
__device__ __forceinline__ float wave_sum(float v) {
    v = row16_sum(v);
    const float a = __int_as_float(__builtin_amdgcn_readlane(__float_as_int(v), 0)), b = __int_as_float(__builtin_amdgcn_readlane(__float_as_int(v), 16));
    const float c = __int_as_float(__builtin_amdgcn_readlane(__float_as_int(v), 32)), d = __int_as_float(__builtin_amdgcn_readlane(__float_as_int(v), 48));
    return (a + b) + (c + d);
}
__device__ __forceinline__ unsigned pk4_fp8(float a, float b, float c, float d) {
    a = __builtin_amdgcn_fmed3f(a, -448.f, 448.f); b = __builtin_amdgcn_fmed3f(b, -448.f, 448.f); c = __builtin_amdgcn_fmed3f(c, -448.f, 448.f); d = __builtin_amdgcn_fmed3f(d, -448.f, 448.f);
    unsigned w = 0; w = __builtin_amdgcn_cvt_pk_fp8_f32(a, b, w, false); w = __builtin_amdgcn_cvt_pk_fp8_f32(c, d, w, true); return w; }
__device__ __forceinline__ float sigmoidf_(float z) { return __builtin_amdgcn_rcpf(1.0f + __expf(-z)); }

__device__ __forceinline__ unsigned char* opq(unsigned char* p) { asm volatile("" : "+s"(p)); return p; }
__device__ __forceinline__ int opq_i(int v) { asm volatile("" : "+s"(v)); return v; }
__device__ __forceinline__ int opq_v(int v) { asm volatile("" : "+v"(v)); return v; }
__device__ __forceinline__ int lane_id_asm() { int l; asm volatile("v_mbcnt_lo_u32_b32 %0, -1, 0\n\tv_mbcnt_hi_u32_b32 %0, -1, %0" : "=v"(l)); return l; }
#define XB_TMO      128
#define XB_XCNT(j)  (256  + 64 * (j))
#define XB_XSUB(j)  (1280 + 64 * (j))
#define XB_XGEN(j)  (2304 + 64 * (j))
#define XB_TOP      3328
#define XB_TOPGEN   3392
#define XCD_BAR_WORDS 3456
#define XB_SPIN_CAP (1u << 18)
__device__ __forceinline__ unsigned xb_ld(unsigned* p)              { return __hip_atomic_load(p, __ATOMIC_RELAXED, __HIP_MEMORY_SCOPE_AGENT); }
__device__ __forceinline__ unsigned xb_add(unsigned* p, unsigned v) { return __hip_atomic_fetch_add(p, v, __ATOMIC_RELAXED, __HIP_MEMORY_SCOPE_AGENT); }
__device__ __forceinline__ unsigned xb_xcc_id() { return (unsigned)__builtin_amdgcn_s_getreg((3 << 11) | 20) & 0xFu; }
#define XB_SPIN(cond, bar) do { unsigned _sp = 0; while (cond) { __builtin_amdgcn_s_sleep(1); \
    if ((++_sp & 255u) == 0u) { if (xb_ld(&(bar)[XB_TMO])) break; if (_sp > XB_SPIN_CAP) { atomicAdd(&(bar)[XB_TMO], 1u); break; } } } } while (0)
struct XcdBarrier { unsigned* bar; unsigned x; volatile LAS unsigned* st; };
__device__ __forceinline__ XcdBarrier xcd_barrier_post(unsigned* bar, volatile LAS unsigned* st) {
    XcdBarrier b; b.bar = bar; b.x = xb_xcc_id(); b.st = st;
    if (threadIdx.x == 0) (void)xb_add(&bar[XB_XCNT(b.x)], 1u);
    return b;
}
__device__ __forceinline__ void xcd_barrier_complete(unsigned* bar, unsigned x, unsigned& nloc, unsigned& nx) {
    const unsigned G = gridDim.x * gridDim.y * gridDim.z;
    unsigned sum, cnt, mine, sp = 0u;
    for (;;) {
        sum = 0u; cnt = 0u; mine = 0u;
#pragma unroll
        for (unsigned j = 0; j < 16; ++j) { const unsigned c = xb_ld(&bar[XB_XCNT(j)]); sum += c; cnt += (c > 0u) ? 1u : 0u; mine = (j == x) ? c : mine; }
        if (sum == G) break;
        __builtin_amdgcn_s_sleep(1);
        if ((++sp & 255u) == 0u) { if (xb_ld(&bar[XB_TMO])) break; if (sp > XB_SPIN_CAP) { atomicAdd(&bar[XB_TMO], 1u); break; } }
    }
    nloc = mine > 0u ? mine : 1u; nx = cnt > 0u ? cnt : 1u;
}
__device__ __forceinline__ void xcd_barrier(const XcdBarrier& b, const bool leader  ) {
    asm volatile("s_waitcnt vmcnt(0)" ::: "memory");
    __syncthreads();
    if (leader) {
        unsigned* bar = b.bar;
        __builtin_amdgcn_s_waitcnt(0);
        unsigned nloc = b.st[0], nx = b.st[1];
        if (nloc == 0u) { xcd_barrier_complete(bar, b.x, nloc, nx); b.st[0] = nloc; b.st[1] = nx; }
        const unsigned old = xb_add(&bar[XB_XSUB(b.x)], 1u);
        const unsigned gen = old / nloc;
        if (old + 1u == (gen + 1u) * nloc) {
            __builtin_amdgcn_fence(__ATOMIC_RELEASE, "agent");
            asm volatile("s_waitcnt vmcnt(0)" ::: "memory");
            const unsigned og = xb_add(&bar[XB_TOP], 1u);
            const unsigned tg = og / nx;
            if (og + 1u == (tg + 1u) * nx) xb_add(&bar[XB_TOPGEN], 1u);
            else XB_SPIN(xb_ld(&bar[XB_TOPGEN]) == tg, bar);
            __builtin_amdgcn_fence(__ATOMIC_ACQUIRE, "agent");
            xb_add(&bar[XB_XGEN(b.x)], 1u);
            asm volatile("s_waitcnt vmcnt(0)" ::: "memory");
        } else {
            XB_SPIN(xb_ld(&bar[XB_XGEN(b.x)]) == gen, bar);
            __builtin_amdgcn_fence(__ATOMIC_ACQUIRE, "agent");
            asm volatile("s_waitcnt vmcnt(0)" ::: "memory");
        }
    }
    __syncthreads();
}

namespace pg8 {
constexpr int BM = 256, BK = 64, HALF = 128, HTB = HALF * BK * 2, STAGE_BYTES = 8 * HTB, NXCD = 8, WGM = 8;
__host__ __device__ __forceinline__ int lds_byte(int r, int c) { const int st = (r >> 4) * 2 + (c >> 5), rr = r & 15, cc = c & 31, ob = rr * 64 + cc * 2; return st * 1024 + (ob ^ (((ob >> 9) & 1) << 5)); }
__host__ __device__ __forceinline__ void stage_rc(int b, int& R, int& C) { const int st = b / 1024, sb = b % 1024, swz = sb ^ (((sb >> 9) & 1) << 5); R = (st >> 1) * 16 + swz / 64; C = (st & 1) * 32 + (swz % 64) / 2; }
__host__ __device__ __forceinline__ int perm32(int rho) { const int n = rho >> 4, i = rho & 15; return 8 * (i >> 2) + 4 * n + (i & 3); }
typedef int i32x8 __attribute__((ext_vector_type(8)));
typedef int i32x4_ __attribute__((ext_vector_type(4)));
__device__ __forceinline__ i32x8 cat8(bf16x8 a, bf16x8 b) { const i32x4_ x = __builtin_bit_cast(i32x4_, a), y = __builtin_bit_cast(i32x4_, b); return __builtin_shufflevector(x, y, 0, 1, 2, 3, 4, 5, 6, 7); }
__device__ __forceinline__ void mfma8(f32x4& acc, const i32x8 a, const i32x8 b) {
    asm volatile("v_mfma_scale_f32_16x16x128_f8f6f4 %0, %1, %2, %0, %3, %3 op_sel_hi:[0,0,0]" : "+v"(acc) : "v"(a), "v"(b), "v"(127)); }
struct Unit { int pm, pn, z; };
struct Order {
    int nM, nN, nwg, G, c;
    __device__ __forceinline__ void init(int nM_, int nN_, int G_, int c_) { nM = nM_; nN = nN_; nwg = nM * nN; G = G_; c = c_; }
    __device__ __forceinline__ bool next_mn(int i, Unit& u) const {
        const long L = (long)i * G + c; if (L >= nwg) return false;
        int wgid = (int)L; { const int q = nwg / NXCD, r = nwg % NXCD, xcd = wgid % NXCD, off = wgid / NXCD; wgid = (xcd < r ? xcd * (q + 1) : r * (q + 1) + (xcd - r) * q) + off; }
        const int nig = WGM * nN, gid = wgid / nig, fm = gid * WGM, gsz = (nM - fm) < WGM ? (nM - fm) : WGM;
        u.pm = fm + ((wgid % nig) % gsz); u.pn = (wgid % nig) / gsz; u.z = 0; return true;
    }
};

template <class Epi, class Sched, bool ALIGN_EPI, bool SP2, bool FP8 = false>
__device__ __forceinline__ void gemm_phase(LAS unsigned char* lds, const int tid_in, const char* base  , const int lda, const int ldb, const int K, const Sched& S, const Epi& E) {
    const int tid = tid_in, wid = __builtin_amdgcn_readfirstlane(tid >> 6), lane = tid & 63, wr = wid >> 2, wc = wid & 3, fr = lane & 15, fq = lane >> 4;
    const int nt = K / BK;
    unsigned voffA[2], voffB[2];
#pragma unroll
    for (int i = 0; i < 2; ++i) { int R, C; stage_rc(tid * 16 + i * 8192, R, C); const int Rb = Epi::PERM ? ((R & ~31) + perm32(R & 31)) : R;
        voffA[i] = (unsigned)(R * lda + C) * 2u; voffB[i] = (unsigned)(Rb * ldb + C) * 2u; }
    constexpr bool GATHER = Sched::GATHER;
    unsigned gvC[2][2], gvN[2][2];
#define PG8_GV(dst, unit) do { _Pragma("unroll") for (int hh_ = 0; hh_ < 2; ++hh_) _Pragma("unroll") for (int i_ = 0; i_ < 2; ++i_) { int R_, C_; stage_rc(tid * 16 + i_ * 8192, R_, C_); \
        dst[hh_][i_] = S.arow(unit, hh_ * HALF + R_) + (unsigned)C_ * 2u; } } while (0)
    const unsigned kstep = (unsigned)(BK * 2);
    const unsigned hstepA = (unsigned)(HALF * lda * 2), hstepB = (unsigned)(HALF * ldb * 2);
    const __amdgpu_buffer_rsrc_t rsrc = __builtin_amdgcn_make_buffer_rsrc((void*)base, 0, 0xffffffffu, 0x00020000);
    const unsigned ldsw = (unsigned)wid * 1024u;
    const int aoff = lds_byte(wr * 64 + fr, fq * 8), boff = lds_byte(wc * 32 + fr, fq * 8);
#define PG8_SA(b, h) (((b) * 2 + (h)) * HTB)
#define PG8_SB(b, h) ((4 + (b) * 2 + (h)) * HTB)
#define PG8_STAGE(bufoff, goff, voff) do { _Pragma("unroll") for (int _i = 0; _i < 2; ++_i) \
        __builtin_amdgcn_raw_ptr_buffer_load_lds(rsrc, (LAS unsigned*)(lds + (bufoff) + ldsw + _i * 8192), 16, (voff)[_i], (goff), 0, 0); } while (0)
#define PG8_STAGE_A(bufoff, aoff, hh, nx) do { if constexpr (GATHER) { unsigned gv_[2]; gv_[0] = (nx) ? gvN[hh][0] : gvC[hh][0]; gv_[1] = (nx) ? gvN[hh][1] : gvC[hh][1]; PG8_STAGE(bufoff, aoff, gv_); } \
        else { PG8_STAGE(bufoff, (aoff) + (hh) * hstepA, voffA); } } while (0)
#define PG8_LDA(dst, b, h) do { _Pragma("unroll") for (int m = 0; m < 4; ++m) _Pragma("unroll") for (int k = 0; k < 2; ++k) dst[m][k] = *(const LAS bf16x8*)(lds + PG8_SA(b, h) + aoff + m * 2048 + k * 1024); } while (0)
#define PG8_LDB(dst, b, h) do { _Pragma("unroll") for (int n = 0; n < 2; ++n) _Pragma("unroll") for (int k = 0; k < 2; ++k) dst[n][k] = *(const LAS bf16x8*)(lds + PG8_SB(b, h) + boff + n * 2048 + k * 1024); } while (0)
#define PG8_MMA(ai, bj, At, Bt) do { __builtin_amdgcn_s_setprio(1); \
        if constexpr (FP8) { _Pragma("unroll") for (int m = 0; m < 4; ++m) _Pragma("unroll") for (int n = 0; n < 2; ++n) \
            mfma8(acc[ai][bj][m][n], cat8(Bt[n][0], Bt[n][1]), cat8(At[m][0], At[m][1])); } \
        else { _Pragma("unroll") for (int m = 0; m < 4; ++m) _Pragma("unroll") for (int n = 0; n < 2; ++n) _Pragma("unroll") for (int k = 0; k < 2; ++k) \
            acc[ai][bj][m][n] = __builtin_amdgcn_mfma_f32_16x16x32_bf16(Bt[n][k], At[m][k], acc[ai][bj][m][n], 0, 0, 0); } \
        __builtin_amdgcn_s_setprio(0); } while (0)
#define PG8_WAIT_V(n) asm volatile("s_waitcnt vmcnt(" #n ")" ::: "memory")
#define PG8_WAIT_L(n) asm volatile("s_waitcnt lgkmcnt(" #n ")" ::: "memory")
#define PG8_BAR __builtin_amdgcn_s_barrier()
#define PG8_SCHED __builtin_amdgcn_sched_barrier(0)
    Unit cur, nxt; int ui = 0;
    if (!S.next(0, cur)) return;
    f32x4 acc[2][2][4][2];
#pragma unroll
    for (int a = 0; a < 2; ++a)
#pragma unroll
        for (int b = 0; b < 2; ++b)
#pragma unroll
            for (int m = 0; m < 4; ++m)
#pragma unroll
                for (int n = 0; n < 2; ++n) acc[a][b][m][n] = (f32x4){0.f, 0.f, 0.f, 0.f};
    bf16x8 At[4][2], B0[2][2], B1[2][2];
    unsigned cA = S.A(cur), cB = S.B(cur);
    if constexpr (GATHER) { PG8_GV(gvC, cur); _Pragma("unroll") for (int hh_ = 0; hh_ < 2; ++hh_) _Pragma("unroll") for (int i_ = 0; i_ < 2; ++i_) gvN[hh_][i_] = gvC[hh_][i_]; }
    if constexpr (SP2) {
        PG8_STAGE(PG8_SB(0, 0), cB, voffB); PG8_STAGE(PG8_SB(0, 1), cB + hstepB, voffB); PG8_STAGE_A(PG8_SA(0, 0), cA, 0, false); PG8_STAGE_A(PG8_SA(0, 1), cA, 1, false);
        if (wr == 1) PG8_BAR;
        PG8_WAIT_V(2); PG8_BAR;
        PG8_STAGE(PG8_SB(1, 0), cB + kstep, voffB); PG8_STAGE_A(PG8_SA(1, 0), cA + kstep, 0, false); PG8_STAGE(PG8_SB(1, 1), cB + hstepB + kstep, voffB);
        PG8_WAIT_V(6); PG8_BAR;
    } else {
        PG8_STAGE(PG8_SB(0, 0), cB, voffB); PG8_STAGE_A(PG8_SA(0, 0), cA, 0, false); PG8_STAGE(PG8_SB(0, 1), cB + hstepB, voffB); PG8_STAGE_A(PG8_SA(0, 1), cA, 1, false);
        if (wr == 1) PG8_BAR;
        PG8_WAIT_V(4); PG8_BAR;
        PG8_STAGE(PG8_SB(1, 0), cB + kstep, voffB); PG8_STAGE_A(PG8_SA(1, 0), cA + kstep, 0, false); PG8_STAGE(PG8_SB(1, 1), cB + hstepB + kstep, voffB);
        PG8_WAIT_V(6); PG8_BAR;
    }
    for (;;) {
        const bool has_next = S.next(ui + 1, nxt);
        const unsigned nA = has_next ? S.A(nxt) : cA, nB = has_next ? S.B(nxt) : cB;
        if constexpr (GATHER) { if (has_next) PG8_GV(gvN, nxt); }
        for (int t = 0; t < nt; t += 2) {
            const bool last = (t == nt - 2);
            const unsigned a1 = cA + (unsigned)(t + 1) * kstep;
            const unsigned a2 = last ? nA : cA + (unsigned)(t + 2) * kstep, b2 = last ? nB : cB + (unsigned)(t + 2) * kstep;
            const unsigned a3 = a2 + kstep, b3 = b2 + kstep;
            if constexpr (SP2) {
            PG8_LDB(B0, 0, 0); PG8_LDB(B1, 0, 1); PG8_SCHED; PG8_LDA(At, 0, 0); PG8_STAGE_A(PG8_SA(1, 1), a1, 1, false);
            PG8_WAIT_V(8); PG8_WAIT_L(0); PG8_BAR; PG8_MMA(0, 0, At, B0); PG8_MMA(0, 1, At, B1); PG8_BAR; PG8_SCHED;
            PG8_LDA(At, 0, 1); PG8_STAGE(PG8_SB(0, 0), b2, voffB); PG8_STAGE(PG8_SB(0, 1), b2 + hstepB, voffB); PG8_STAGE_A(PG8_SA(0, 0), a2, 0, last);
            PG8_WAIT_V(8); PG8_WAIT_L(0); PG8_BAR; PG8_MMA(1, 0, At, B0); PG8_MMA(1, 1, At, B1); PG8_BAR; PG8_SCHED;
            PG8_LDB(B0, 1, 0); PG8_LDB(B1, 1, 1); PG8_SCHED; PG8_LDA(At, 1, 0); PG8_STAGE_A(PG8_SA(0, 1), a2, 1, last);
            PG8_WAIT_V(8); PG8_WAIT_L(0); PG8_BAR; PG8_MMA(0, 0, At, B0); PG8_MMA(0, 1, At, B1); PG8_BAR; PG8_SCHED;
            PG8_LDA(At, 1, 1); PG8_STAGE(PG8_SB(1, 0), b3, voffB); PG8_STAGE(PG8_SB(1, 1), b3 + hstepB, voffB); PG8_STAGE_A(PG8_SA(1, 0), a3, 0, last);
            PG8_WAIT_V(8); PG8_WAIT_L(0); PG8_BAR; PG8_MMA(1, 0, At, B0); PG8_MMA(1, 1, At, B1); PG8_BAR; PG8_SCHED;
            } else {
            PG8_LDB(B0, 0, 0); PG8_SCHED; PG8_LDA(At, 0, 0); PG8_STAGE_A(PG8_SA(1, 1), a1, 1, false);
            PG8_WAIT_L(8); PG8_BAR; PG8_WAIT_L(0); PG8_MMA(0, 0, At, B0); PG8_BAR; PG8_SCHED;
            PG8_LDB(B1, 0, 1); PG8_STAGE(PG8_SB(0, 0), b2, voffB);
            PG8_BAR; PG8_WAIT_L(0); PG8_MMA(0, 1, At, B1); PG8_BAR;
            PG8_LDA(At, 0, 1); PG8_STAGE_A(PG8_SA(0, 0), a2, 0, last);
            PG8_BAR; PG8_WAIT_L(0); PG8_MMA(1, 0, At, B0); PG8_BAR; PG8_SCHED;
            PG8_STAGE(PG8_SB(0, 1), b2 + hstepB, voffB);
            PG8_WAIT_V(6); PG8_BAR; PG8_MMA(1, 1, At, B1); PG8_BAR;
            PG8_LDB(B0, 1, 0); PG8_SCHED; PG8_LDA(At, 1, 0); PG8_STAGE_A(PG8_SA(0, 1), a2, 1, last);
            PG8_WAIT_L(8); PG8_BAR; PG8_WAIT_L(0); PG8_MMA(0, 0, At, B0); PG8_BAR; PG8_SCHED;
            PG8_LDB(B1, 1, 1); PG8_STAGE(PG8_SB(1, 0), b3, voffB);
            PG8_BAR; PG8_WAIT_L(0); PG8_MMA(0, 1, At, B1); PG8_BAR;
            PG8_LDA(At, 1, 1); PG8_STAGE_A(PG8_SA(1, 0), a3, 0, last);
            PG8_BAR; PG8_WAIT_L(0); PG8_MMA(1, 0, At, B0); PG8_BAR; PG8_SCHED;
            PG8_STAGE(PG8_SB(1, 1), b3 + hstepB, voffB);
            PG8_WAIT_V(6); PG8_BAR; PG8_MMA(1, 1, At, B1); PG8_BAR;
            }
        }
        if constexpr (ALIGN_EPI) { if (wr == 0) PG8_BAR; }
        if constexpr (FP8) asm volatile("s_nop 15\n\ts_nop 15\n\ts_nop 7" ::: "memory");
        E(acc, cur, wr, wc, fr, fq);
        if (!has_next) break;
#pragma unroll
        for (int a = 0; a < 2; ++a)
#pragma unroll
            for (int b = 0; b < 2; ++b)
#pragma unroll
                for (int m = 0; m < 4; ++m)
#pragma unroll
                    for (int n = 0; n < 2; ++n) acc[a][b][m][n] = (f32x4){0.f, 0.f, 0.f, 0.f};
        cur = nxt; cA = nA; cB = nB; ++ui;
        if constexpr (GATHER) { _Pragma("unroll") for (int hh_ = 0; hh_ < 2; ++hh_) _Pragma("unroll") for (int i_ = 0; i_ < 2; ++i_) gvC[hh_][i_] = gvN[hh_][i_]; }
        if constexpr (ALIGN_EPI) { if (wr == 1) PG8_BAR; }
    }
    PG8_WAIT_V(0);
    if constexpr (!ALIGN_EPI) { if (wr == 0) PG8_BAR; }
    PG8_BAR;
#undef PG8_SA
#undef PG8_SB
#undef PG8_STAGE
#undef PG8_STAGE_A
#undef PG8_GV
#undef PG8_LDA
#undef PG8_LDB
#undef PG8_MMA
#undef PG8_WAIT_V
#undef PG8_WAIT_L
#undef PG8_BAR
#undef PG8_SCHED
}

struct SchedPlain : Order {
    static constexpr bool GATHER = false; __device__ __forceinline__ unsigned arow(const Unit&, int) const { return 0u; }
    unsigned A0, B0, at, bt;
    __device__ __forceinline__ bool next(int i, Unit& u) const { return next_mn(i, u); }
    __device__ __forceinline__ unsigned A(const Unit& u) const { return A0 + (unsigned)u.pm * at; }
    __device__ __forceinline__ unsigned B(const Unit& u) const { return B0 + (unsigned)u.pn * bt; }
};
struct SchedLora : Order {
    static constexpr bool GATHER = false; __device__ __forceinline__ unsigned arow(const Unit&, int) const { return 0u; }
    unsigned A0, B0; int skipv;
    __device__ __forceinline__ bool next(int i, Unit& u) const { if (!next_mn(i, u)) return false; if (skipv && u.pn >= 12) u.pn += 6; return true; }
    __device__ __forceinline__ unsigned A(const Unit& u) const { return A0 + (unsigned)u.pm * (256u * 512u * 2u) + (u.pn >= 18 ? 512u : 0u); }
    __device__ __forceinline__ unsigned B(const Unit& u) const { return B0 + (unsigned)u.pn * (256u * 256u * 2u); }
};
struct SchedMem {
    static constexpr bool GATHER = false; __device__ __forceinline__ unsigned arow(const Unit&, int) const { return 0u; }
    int G, c; unsigned memb, wkv;
    __device__ __forceinline__ bool next(int i, Unit& u) const {
        const int L = i * G + c; if (L >= 64) return false;
        if (L < 32) { u.z = 0; u.pm = L >> 1; u.pn = L & 1; } else { const int q = L - 32; u.z = 1; u.pm = q & 1; u.pn = q >> 1; }
        return true;
    }
    __device__ __forceinline__ unsigned A(const Unit& u) const { return u.z == 0 ? memb + (unsigned)u.pm * (256u * 2048u * 2u) : wkv + (unsigned)(2 + u.pm) * (256u * 2048u * 2u); }
    __device__ __forceinline__ unsigned B(const Unit& u) const { return u.z == 0 ? wkv + (unsigned)u.pn * (256u * 2048u * 2u) : memb + (unsigned)u.pn * (256u * 2048u * 2u); }
};
struct SchedMoE : Order {
    static constexpr bool GATHER = false; __device__ __forceinline__ unsigned arow(const Unit&, int) const { return 0u; }
    unsigned A0, B0, at, bt, be; const int* texp;
    __device__ __forceinline__ bool next(int i, Unit& u) const { if (!next_mn(i, u)) return false; u.z = __builtin_amdgcn_readfirstlane(texp[u.pm]); return true; }
    __device__ __forceinline__ unsigned A(const Unit& u) const { return A0 + (unsigned)u.pm * at; }
    __device__ __forceinline__ unsigned B(const Unit& u) const { return B0 + (unsigned)u.z * be + (unsigned)u.pn * bt; }
};

struct SchedMoEg : Order {
    static constexpr bool GATHER = true;
    unsigned B0, bt, be, xoff, zoff; const int* texp; const int* slot_tok;
    __device__ __forceinline__ bool next(int i, Unit& u) const { if (!next_mn(i, u)) return false; u.z = __builtin_amdgcn_readfirstlane(texp[u.pm]); return true; }
    __device__ __forceinline__ unsigned A(const Unit&) const { return 0u; }
    __device__ __forceinline__ unsigned B(const Unit& u) const { return B0 + (unsigned)u.z * be + (unsigned)u.pn * bt; }
    __device__ __forceinline__ unsigned arow(const Unit& u, int r) const { const int tok = slot_tok[u.pm * 256 + r]; return tok < 0 ? zoff : xoff + (unsigned)tok * 2048u; }
};

struct EpiBf16 {
    static constexpr bool PERM = true;
    bf16* O; int ldc;
    __device__ __forceinline__ void operator()(const f32x4 (&acc)[2][2][4][2], const Unit& u, int wr, int wc, int fr, int fq) const {
        const int row0 = u.pm * BM + wr * 64 + fr, col0 = u.pn * BM + wc * 32 + 8 * fq;
#pragma unroll
        for (int ai = 0; ai < 2; ++ai)
#pragma unroll
            for (int m = 0; m < 4; ++m) { bf16* rowp = O + (size_t)(row0 + ai * HALF + m * 16) * ldc + col0;
#pragma unroll
                for (int bj = 0; bj < 2; ++bj) { const f32x4 v0 = acc[ai][bj][m][0], v1 = acc[ai][bj][m][1];
                    u32x4 w; w.x = cvt_pk_bf16(v0[0], v0[1]); w.y = cvt_pk_bf16(v0[2], v0[3]); w.z = cvt_pk_bf16(v1[0], v1[1]); w.w = cvt_pk_bf16(v1[2], v1[3]);
                    *(u32x4*)(rowp + bj * HALF) = w; } }
    }
};
struct EpiMem {
    static constexpr bool PERM = true;
    bf16* O0; bf16* O1;
    __device__ __forceinline__ void operator()(const f32x4 (&acc)[2][2][4][2], const Unit& u, int wr, int wc, int fr, int fq) const {
        EpiBf16 e; e.O = u.z == 0 ? O0 : O1; e.ldc = u.z == 0 ? 512 : 4096; e(acc, u, wr, wc, fr, fq);
    }
};
struct EpiLora {
    static constexpr bool PERM = true;
    bf16* O; const float* vecs;
    __device__ __forceinline__ void operator()(const f32x4 (&acc)[2][2][4][2], const Unit& u, int wr, int wc, int fr, int fq) const {
        const int type = u.pn / 6;
        const int row0 = u.pm * BM + wr * 64 + fr, col0 = u.pn * BM + wc * 32 + 8 * fq, cb0 = (u.pn % 6) * BM + wc * 32 + 8 * fq;
        const float* bp = vecs + (type < 3 ? type : 0) * SW;
        const float sc = type == 0 ? 0.6065306597126334f : 1.0f;
#pragma unroll
        for (int bj = 0; bj < 2; ++bj) {
            f32x4 bv0 = (f32x4){0.f, 0.f, 0.f, 0.f}, bv1 = bv0;
            if (type < 3) { bv0 = *(const f32x4*)(bp + cb0 + bj * HALF); bv1 = *(const f32x4*)(bp + cb0 + bj * HALF + 4); }
#pragma unroll
            for (int ai = 0; ai < 2; ++ai)
#pragma unroll
                for (int m = 0; m < 4; ++m) { bf16* rowp = O + (size_t)(row0 + ai * HALF + m * 16) * 6144 + col0 + bj * HALF;
                    f32x4 v0_ = acc[ai][bj][m][0] + bv0, v1_ = acc[ai][bj][m][1] + bv1;
                    if (type < 3) {
#pragma unroll
                        for (int j = 0; j < 4; ++j) { v0_[j] = sc * sigmoidf_(v0_[j]); v1_[j] = sc * sigmoidf_(v1_[j]); } }
                    u32x4 w; w.x = cvt_pk_bf16(v0_[0], v0_[1]); w.y = cvt_pk_bf16(v0_[2], v0_[3]); w.z = cvt_pk_bf16(v1_[0], v1_[1]); w.w = cvt_pk_bf16(v1_[2], v1_[3]);
                    *(u32x4*)rowp = w; asm volatile("" ::: "memory"); }
        }
    }
};
struct EpiSwiglu {
    static constexpr bool PERM = true;
    bf16* O; int ldc;
    __device__ __forceinline__ void operator()(const f32x4 (&acc)[2][2][4][2], const Unit& u, int wr, int wc, int fr, int fq) const {
        const int row0 = u.pm * BM + wr * 64 + fr, col0 = u.pn * HALF + wc * 32 + 8 * fq;
#pragma unroll
        for (int ai = 0; ai < 2; ++ai)
#pragma unroll
            for (int m = 0; m < 4; ++m) { bf16* rowp = O + (size_t)(row0 + ai * HALF + m * 16) * ldc + col0;
                float h[8];
#pragma unroll
                for (int n = 0; n < 2; ++n)
#pragma unroll
                    for (int j = 0; j < 4; ++j) { const float g = acc[ai][0][m][n][j], up = acc[ai][1][m][n][j]; h[n * 4 + j] = g * sigmoidf_(g) * up; }
                u32x4 w; w.x = cvt_pk_bf16(h[0], h[1]); w.y = cvt_pk_bf16(h[2], h[3]); w.z = cvt_pk_bf16(h[4], h[5]); w.w = cvt_pk_bf16(h[6], h[7]);
                *(u32x4*)rowp = w; asm volatile("" ::: "memory"); }
    }
};
struct EpiSwiglu8 {
    static constexpr bool PERM = true;
    unsigned char* O; int ldc; float inv, so;
    __device__ __forceinline__ void operator()(const f32x4 (&acc)[2][2][4][2], const Unit& u, int wr, int wc, int fr, int fq) const {
        const int row0 = u.pm * BM + wr * 64 + fr, col0 = u.pn * HALF + wc * 32 + 8 * fq;
        const float c1 = -inv * 1.4426950408889634f, c2 = inv * inv * so;
#pragma unroll
        for (int ai = 0; ai < 2; ++ai)
#pragma unroll
            for (int m = 0; m < 4; ++m) { unsigned char* rowp = O + (size_t)(row0 + ai * HALF + m * 16) * ldc + col0;
                float h[8];
#pragma unroll
                for (int n = 0; n < 2; ++n)
#pragma unroll
                    for (int j = 0; j < 4; ++j) { const float ag = acc[ai][0][m][n][j], au = acc[ai][1][m][n][j];
                        h[n * 4 + j] = (ag * au) * __builtin_amdgcn_rcpf(1.0f + __builtin_amdgcn_exp2f(ag * c1)) * c2; }
                u32x2 w; w.x = pk4_fp8(h[0], h[1], h[2], h[3]); w.y = pk4_fp8(h[4], h[5], h[6], h[7]);
                *(u32x2*)rowp = w; asm volatile("" ::: "memory"); }
    }
};
struct EpiBf16S {
    static constexpr bool PERM = true;
    bf16* O; int ldc; float sc;
    __device__ __forceinline__ void operator()(const f32x4 (&acc)[2][2][4][2], const Unit& u, int wr, int wc, int fr, int fq) const {
        const int row0 = u.pm * BM + wr * 64 + fr, col0 = u.pn * BM + wc * 32 + 8 * fq;
#pragma unroll
        for (int ai = 0; ai < 2; ++ai)
#pragma unroll
            for (int m = 0; m < 4; ++m) { bf16* rowp = O + (size_t)(row0 + ai * HALF + m * 16) * ldc + col0;
#pragma unroll
                for (int bj = 0; bj < 2; ++bj) { const f32x4 v0 = acc[ai][bj][m][0] * sc, v1 = acc[ai][bj][m][1] * sc;
                    u32x4 w; w.x = cvt_pk_bf16(v0[0], v0[1]); w.y = cvt_pk_bf16(v0[2], v0[3]); w.z = cvt_pk_bf16(v1[0], v1[1]); w.w = cvt_pk_bf16(v1[2], v1[3]);
                    *(u32x4*)(rowp + bj * HALF) = w; } }
    }
};
struct EpiFp8S {
    static constexpr bool PERM = true;
    unsigned char* O; int ldc; float sc;
    __device__ __forceinline__ void operator()(const f32x4 (&acc)[2][2][4][2], const Unit& u, int wr, int wc, int fr, int fq) const {
        const int row0 = u.pm * BM + wr * 64 + fr, col0 = u.pn * BM + wc * 32 + 8 * fq;
#pragma unroll
        for (int ai = 0; ai < 2; ++ai)
#pragma unroll
            for (int m = 0; m < 4; ++m) { unsigned char* rowp = O + (size_t)(row0 + ai * HALF + m * 16) * ldc + col0;
#pragma unroll
                for (int bj = 0; bj < 2; ++bj) { const f32x4 v0 = acc[ai][bj][m][0] * sc, v1 = acc[ai][bj][m][1] * sc;
                    u32x2 w; w.x = pk4_fp8(v0[0], v0[1], v0[2], v0[3]); w.y = pk4_fp8(v1[0], v1[1], v1[2], v1[3]);
                    *(u32x2*)(rowp + bj * HALF) = w; } }
    }
};
struct EpiRes {
    static constexpr bool PERM = false;
    const float* X; float* T;
    __device__ __forceinline__ void operator()(const f32x4 (&acc)[2][2][4][2], const Unit& u, int wr, int wc, int fr, int fq) const {
        const int row0 = u.pm * BM + wr * 64 + fr, col0 = u.pn * BM + wc * 32 + 4 * fq;
#pragma unroll
        for (int ai = 0; ai < 2; ++ai)
#pragma unroll
            for (int m = 0; m < 4; ++m) { const size_t off = (size_t)(row0 + ai * HALF + m * 16) * D + col0;
#pragma unroll
                for (int bj = 0; bj < 2; ++bj)
#pragma unroll
                    for (int n = 0; n < 2; ++n) { const f32x4 xv = *(const f32x4*)(X + off + bj * HALF + n * 16);
                        *(f32x4*)(T + off + bj * HALF + n * 16) = xv * ALPHA + acc[ai][bj][m][n]; } }
    }
};
}

struct Args {
    const float* in[43];
    float* out; unsigned char* ws;
    int ph_lo, ph_hi;
};
struct Ctx { LAS unsigned char* lds; int tid, lane, wave, bid, G, gw, NGW; unsigned char* ws; };

enum { I_X = 0, I_MEM = 1, I_POS = 2, I_WKV = 3,
       L0_WIN = 4, L0_MU, L0_LW, L0_LA, L0_LG, L0_VECS, L0_WOUT, L0_NORMS, L0_FG, L0_FU, L0_FD,
       L1_WIN = 15, L1_GN, L1_WOUT, L1_NORMS, L1_ROUTER, L1_MG, L1_MU_, L1_MD,
       L2_WIN = 23, L2_MU, L2_LW, L2_LA, L2_LV, L2_LG, L2_VECS, L2_WOUT, L2_NORMS, L2_FG, L2_FU, L2_FD,
       L3_WIN = 35, L3_GN, L3_WOUT, L3_NORMS, L3_ROUTER, L3_MG, L3_MU_, L3_MD };

__device__ __forceinline__ void tr_load(f32x4 (&v)[8], const float* W, int ldw, int k0, int n0, int lane) {
#pragma unroll
    for (int i = 0; i < 8; ++i) v[i] = *(const f32x4*)(W + (size_t)(k0 + 8 * i + (lane >> 3)) * ldw + n0 + 4 * (lane & 7));
}
__device__ __forceinline__ void tr_store(const f32x4 (&v)[8], int k0, bf16* WT, int ldt, int drow0, LAS float* scr, int lane) {
#pragma unroll
    for (int i = 0; i < 8; ++i) { LAS float* d = scr + (8 * i + (lane >> 3)) * 33 + 4 * (lane & 7); d[0] = v[i][0]; d[1] = v[i][1]; d[2] = v[i][2]; d[3] = v[i][3]; }
    LDS_WAIT(); asm volatile("" ::: "memory");
    const int c = lane & 7;
#pragma unroll
    for (int j = 0; j < 4; ++j) { const int n = (lane >> 3) + 8 * j; const LAS float* s = scr + (8 * c) * 33 + n;
        u32x4 o; o.x = cvt_pk_bf16(s[0 * 33], s[1 * 33]); o.y = cvt_pk_bf16(s[2 * 33], s[3 * 33]); o.z = cvt_pk_bf16(s[4 * 33], s[5 * 33]); o.w = cvt_pk_bf16(s[6 * 33], s[7 * 33]);
        *(u32x4*)(WT + (size_t)(drow0 + n) * ldt + k0 + 8 * c) = o; }
    LDS_WAIT(); asm volatile("" ::: "memory");
}
__device__ __forceinline__ void conv_mat(const Ctx& C, const float* W, int K, int N, bf16* WT, int mode, int off, int gw0) {
    LAS float* scr = (LAS float*)(C.lds + C.wave * 16384);
    const int nblk = N / 32, items = (K / 64) * nblk;
    int start = C.gw - gw0; if (start < 0) start += C.NGW;
#define CONV_DROW(n0_) (mode == 0 ? off + (n0_) : ((n0_) / 128) * 256 + off + ((n0_) % 128))
    f32x4 va[8], vb[8];
    int it = start;
    if (it < items) tr_load(va, W, N, 64 * (it / nblk), 32 * (it % nblk), C.lane);
    while (it < items) {
        const int it1 = it + C.NGW;
        if (it1 < items) tr_load(vb, W, N, 64 * (it1 / nblk), 32 * (it1 % nblk), C.lane);
        tr_store(va, 64 * (it / nblk), WT, K, CONV_DROW(32 * (it % nblk)), scr, C.lane);
        if (it1 >= items) break;
        const int it2 = it1 + C.NGW;
        if (it2 < items) tr_load(va, W, N, 64 * (it2 / nblk), 32 * (it2 % nblk), C.lane);
        tr_store(vb, 64 * (it1 / nblk), WT, K, CONV_DROW(32 * (it1 % nblk)), scr, C.lane);
        it = it2;
    }
#undef CONV_DROW
}
__device__ __forceinline__ void conv_lora(const Ctx& C, const float* lw, const float* la, const float* lv, const float* lg, bf16* Bt) {
    for (int idx = C.bid * NTHR + C.tid; idx < 6144 * 256; idx += C.G * NTHR) {
        const int n_ = idx % 1536, rest = idx / 1536, k = rest % 256, blk = rest / 256;
        float v = 0.f;
        if (blk == 0) { if (k < 96) v = lw[k * 1536 + n_]; }
        else if (blk == 1) { if (k >= 96 && k < 192) v = la[(k - 96) * 1536 + n_]; }
        else if (blk == 2) { if (lv && k >= 192) v = lv[(k - 192) * 1536 + n_]; }
        else v = lg[k * 1536 + n_];
        Bt[(size_t)(blk * 1536 + n_) * 256 + k] = f2bf(v);
    }
}
__device__ __forceinline__ void conv_f32_bf16(const Ctx& C, const float* src, bf16* dst, size_t n8) {
    for (size_t i = (size_t)C.bid * NTHR + C.tid; i < n8; i += (size_t)C.G * NTHR) {
        const f32x4 a = ((const f32x4*)src)[2 * i], b = ((const f32x4*)src)[2 * i + 1];
        u32x4 w; w.x = cvt_pk_bf16(a[0], a[1]); w.y = cvt_pk_bf16(a[2], a[3]); w.z = cvt_pk_bf16(b[0], b[1]); w.w = cvt_pk_bf16(b[2], b[3]);
        ((u32x4*)dst)[i] = w; }
}

struct CvJob { const float* W; bf16* WT; int N, K, k0, n0, mode, off; float f8s; };
__device__ __forceinline__ void cv_load(f32x4 (&v)[8], const CvJob& J, int wave, int lane) {
    const int n = J.n0 + 4 * lane;
#pragma unroll
    for (int i = 0; i < 8; ++i) { v[i] = (f32x4){0.f, 0.f, 0.f, 0.f}; if (n < J.N) v[i] = *(const f32x4*)(J.W + (size_t)(J.k0 + 8 * wave + i) * J.N + n); }
}
__device__ __forceinline__ void cv_put(const f32x4 (&v)[8], LAS float* T, int wave, int lane) {
#pragma unroll
    for (int i = 0; i < 8; ++i) *(LAS f32x4*)(T + (8 * wave + i) * 256 + 4 * (lane ^ wave)) = v[i];
}
__device__ __forceinline__ void cv_out(const CvJob& J, const LAS float* T, int wave, int lane) {
    const int c = lane & 7;
#pragma unroll
    for (int j = 0; j < 4; ++j) { const int nl = 32 * wave + 8 * j + (lane >> 3), n = J.n0 + nl; const LAS float* s = T + (8 * c) * 256 + (nl ^ (c << 2));
        u32x4 o; o.x = cvt_pk_bf16(s[0 * 256], s[1 * 256]); o.y = cvt_pk_bf16(s[2 * 256], s[3 * 256]); o.z = cvt_pk_bf16(s[4 * 256], s[5 * 256]); o.w = cvt_pk_bf16(s[6 * 256], s[7 * 256]);
        if (n < J.N) { const int drow = J.mode == 0 ? J.off + n : (n / 128) * 256 + J.off + (n % 128);
            *(u32x4*)(J.WT + (size_t)drow * J.K + J.k0 + 8 * c) = o; } }
}
__device__ __forceinline__ void cv_out8(const CvJob& J, const LAS float* T, int wave, int lane) {
    const int c4 = lane & 3; unsigned char* W8 = (unsigned char*)J.WT;
#pragma unroll
    for (int j = 0; j < 2; ++j) { const int nl = 32 * wave + 16 * j + (lane >> 2), n = J.n0 + nl;
        float v[16];
#pragma unroll
        for (int q = 0; q < 16; ++q) { const int k = 16 * c4 + q; v[q] = T[k * 256 + (nl ^ (((k >> 3) & 7) << 2))] * J.f8s; }
        u32x4 o; o.x = pk4_fp8(v[0], v[1], v[2], v[3]); o.y = pk4_fp8(v[4], v[5], v[6], v[7]); o.z = pk4_fp8(v[8], v[9], v[10], v[11]); o.w = pk4_fp8(v[12], v[13], v[14], v[15]);
        if (n < J.N) { const int drow = J.mode == 0 ? J.off + n : (n / 128) * 256 + J.off + (n % 128);
            *(u32x4*)(W8 + (size_t)drow * J.K + J.k0 + 16 * c4) = o; } }
}
template <class Dec>
__device__ __forceinline__ void conv_run(const Ctx& C, int ntiles, const Dec& dec, const int t0 = -1, const int STR = GRID) {
    LAS float* T = (LAS float*)C.lds;
    f32x4 va[8], vb[8]; CvJob ja, jb, jc;
    int t = t0 < 0 ? C.bid : t0;
    if (t < ntiles) { dec(t, ja); cv_load(va, ja, C.wave, C.lane); }
    if (t + STR < ntiles) { dec(t + STR, jb); cv_load(vb, jb, C.wave, C.lane); }
    while (t < ntiles) {
        __syncthreads(); cv_put(va, T, C.wave, C.lane); jc = ja;
        if (t + 2 * STR < ntiles) { dec(t + 2 * STR, ja); cv_load(va, ja, C.wave, C.lane); }
        __syncthreads(); if (jc.f8s > 0.f) cv_out8(jc, T, C.wave, C.lane); else cv_out(jc, T, C.wave, C.lane);
        t += STR; if (t >= ntiles) break;
        __syncthreads(); cv_put(vb, T, C.wave, C.lane); jc = jb;
        if (t + 2 * STR < ntiles) { dec(t + 2 * STR, jb); cv_load(vb, jb, C.wave, C.lane); }
        __syncthreads(); if (jc.f8s > 0.f) cv_out8(jc, T, C.wave, C.lane); else cv_out(jc, T, C.wave, C.lane);
        t += STR;
    }
    __syncthreads();
}
struct MoeDec { const float* mg; const float* mu; const float* md; unsigned char* ws;
    __device__ __forceinline__ void operator()(int t, CvJob& J) const {
        const int j = t / 704, r = t % 704, e = j / 3, kind = j % 3;
        if (kind < 2) { J.W = (kind == 0 ? mg : mu) + (size_t)e * 2048 * 5632; J.WT = (bf16*)(ws + WS_MWGU + (size_t)e * 22 * MiB); J.N = 5632; J.K = 2048; J.mode = 1; J.off = kind * 128; J.f8s = 1024.f; J.k0 = 64 * (r / 22); J.n0 = 256 * (r % 22); }
        else { J.W = md + (size_t)e * 2048 * 5632; J.WT = (bf16*)(ws + WS_MWD + (size_t)e * 11 * MiB); J.N = 2048; J.K = 5632; J.mode = 0; J.off = 0; J.f8s = 2048.f; J.k0 = 64 * (r / 8); J.n0 = 256 * (r % 8); }
    } };
struct StaticDec { const float* const* in; unsigned char* ws;
    __device__ __forceinline__ void set(CvJob& J, const float* W, bf16* WT, int K, int N, int mode, int off, int r, float f8s = 0.f) const {
        const int nn = (N + 255) / 256; J.W = W; J.WT = WT; J.N = N; J.K = K; J.mode = mode; J.off = off; J.f8s = f8s; J.k0 = 64 * (r / nn); J.n0 = 256 * (r % nn); }
    __device__ __forceinline__ void operator()(int t, CvJob& J) const {
        int r = t;
        if (r < 128) { set(J, in[I_WKV], (bf16*)(ws + WS_WKV), 2048, 1024, 0, 0, r); return; } r -= 128;
        if (r < 704) { set(J, in[L0_WIN], (bf16*)(ws + WS_WIN), 2048, 5568, 0, 0, r); return; } r -= 704;
        if (r < 640) { set(J, in[L1_WIN], (bf16*)(ws + WS_WIN + (size_t)22 * MiB), 2048, 5120, 0, 0, r); return; } r -= 640;
        if (r < 704) { set(J, in[L2_WIN], (bf16*)(ws + WS_WIN + (size_t)44 * MiB), 2048, 5632, 0, 0, r); return; } r -= 704;
        if (r < 640) { set(J, in[L3_WIN], (bf16*)(ws + WS_WIN + (size_t)66 * MiB), 2048, 5120, 0, 0, r); return; } r -= 640;
        if (r < 256) { set(J, in[L0_WOUT], (bf16*)(ws + WS_WOUT), 2048, 2048, 0, 0, r); return; } r -= 256;
        if (r < 256) { set(J, in[L1_WOUT], (bf16*)(ws + WS_WOUT + (size_t)8 * MiB), 2048, 2048, 0, 0, r); return; } r -= 256;
        if (r < 256) { set(J, in[L2_WOUT], (bf16*)(ws + WS_WOUT + (size_t)16 * MiB), 2048, 2048, 0, 0, r); return; } r -= 256;
        if (r < 256) { set(J, in[L3_WOUT], (bf16*)(ws + WS_WOUT + (size_t)24 * MiB), 2048, 2048, 0, 0, r); return; } r -= 256;
        if (r < 704) { set(J, in[L0_FG], (bf16*)(ws + WS_WFGU), 2048, 5632, 1, 0, r, 1024.f); return; } r -= 704;
        if (r < 704) { set(J, in[L0_FU], (bf16*)(ws + WS_WFGU), 2048, 5632, 1, 128, r, 1024.f); return; } r -= 704;
        if (r < 704) { set(J, in[L0_FD], (bf16*)(ws + WS_WFD), 5632, 2048, 0, 0, r, 2048.f); return; } r -= 704;
        if (r < 704) { set(J, in[L2_FG], (bf16*)(ws + WS_WFGU + (size_t)44 * MiB), 2048, 5632, 1, 0, r, 1024.f); return; } r -= 704;
        if (r < 704) { set(J, in[L2_FU], (bf16*)(ws + WS_WFGU + (size_t)44 * MiB), 2048, 5632, 1, 128, r, 1024.f); return; } r -= 704;
        set(J, in[L2_FD], (bf16*)(ws + WS_WFD + (size_t)22 * MiB), 5632, 2048, 0, 0, r, 2048.f);
    } };

__device__ __forceinline__ void ph_prologue(const Ctx& C, const Args& A) {
    unsigned char* ws = C.ws;
    { StaticDec dec; dec.in = A.in; dec.ws = ws; conv_run(C, 8064, dec); }
    conv_lora(C, A.in[L0_LW], A.in[L0_LA], nullptr, A.in[L0_LG], (bf16*)(ws + WS_WLORA));
    conv_lora(C, A.in[L2_LW], A.in[L2_LA], A.in[L2_LV], A.in[L2_LG], (bf16*)(ws + WS_WLORA + 3 * MiB));
    { u32x4* z = (u32x4*)(ws + WS_WIN + (size_t)5568 * 2048 * 2);
      for (int i = C.bid * NTHR + C.tid; i < 64 * 2048 * 2 / 16; i += C.G * NTHR) z[i] = (u32x4){0u, 0u, 0u, 0u}; }
    { const f32x4* xs = (const f32x4*)A.in[I_X]; u32x2* hi = (u32x2*)(ws + WS_XB); unsigned* lo = (unsigned*)(ws + WS_XLO);
      for (size_t i = (size_t)C.bid * NTHR + C.tid; i < (size_t)M * D / 4; i += (size_t)C.G * NTHR) { const f32x4 o = xs[i];
          u32x2 w; w.x = cvt_pk_bf16(o[0], o[1]); w.y = cvt_pk_bf16(o[2], o[3]); hi[i] = w;
          lo[i] = pk4_fp8((o[0] - bflo(w.x)) * 8192.f, (o[1] - bfhi(w.x)) * 8192.f, (o[2] - bflo(w.y)) * 8192.f, (o[3] - bfhi(w.y)) * 8192.f); } }
    conv_f32_bf16(C, A.in[I_MEM], (bf16*)(ws + WS_MEMB), (size_t)4096 * 2048 / 8);
    { const int* pos = (const int*)A.in[I_POS]; f32x2* cs = (f32x2*)(ws + WS_CS);
      for (int idx = C.bid * NTHR + C.tid; idx < M * 64; idx += C.G * NTHR) {
          const int m = idx >> 6, i = idx & 63;
          const float pw = (float)exp2(13.287712379549449 * (double)i / 64.0);
          const float inv = 1.0f / pw;
          const float ang = (float)pos[m] * inv;
          const double x = (double)ang;
          const double n = rint(x * 0.15915494309189535);
          const double r = fma(-n, 6.283185307179586, x) - n * 2.4492935982947064e-16;
          const double r2 = r * r;
          double s = -1.0 / 121645100408832000.0;
          s = fma(s, r2, 1.0 / 355687428096000.0);
          s = fma(s, r2, -1.0 / 1307674368000.0);
          s = fma(s, r2, 1.0 / 6227020800.0);
          s = fma(s, r2, -1.0 / 39916800.0);
          s = fma(s, r2, 1.0 / 362880.0);
          s = fma(s, r2, -1.0 / 5040.0);
          s = fma(s, r2, 1.0 / 120.0);
          s = fma(s, r2, -1.0 / 6.0);
          s = fma(s * r2, r, r);
          double c = 1.0 / 2432902008176640000.0;
          c = fma(c, r2, -1.0 / 6402373705728000.0);
          c = fma(c, r2, 1.0 / 20922789888000.0);
          c = fma(c, r2, -1.0 / 87178291200.0);
          c = fma(c, r2, 1.0 / 479001600.0);
          c = fma(c, r2, -1.0 / 3628800.0);
          c = fma(c, r2, 1.0 / 40320.0);
          c = fma(c, r2, -1.0 / 720.0);
          c = fma(c, r2, 1.0 / 24.0);
          c = fma(c, r2, -0.5);
          c = fma(c, r2, 1.0);
          cs[idx] = (f32x2){(float)c, (float)s};
      } }
}

struct LnRow { u32x2 rh[8]; unsigned rl[8]; u32x2 a[8]; float w1, w2; };
__device__ __forceinline__ void ln_load(LnRow& R, const Ctx& C, int m, const void* Hp, int hmode) {
    const u32x2* hr = (const u32x2*)(C.ws + WS_XB + (size_t)m * D * 2) + C.lane;
    const unsigned* lr = (const unsigned*)(C.ws + WS_XLO + (size_t)m * D) + C.lane;
#pragma unroll
    for (int j = 0; j < 8; ++j) { R.rh[j] = hr[64 * j]; R.rl[j] = lr[64 * j]; }
    if (hmode == 0) {
        const u32x2* ar = (const u32x2*)((const bf16*)Hp + (size_t)m * D) + C.lane;
#pragma unroll
        for (int j = 0; j < 8; ++j) R.a[j] = ar[64 * j];
        R.w1 = 1.f; R.w2 = 0.f;
    } else if (hmode == 1) {
        const unsigned* ar = (const unsigned*)((const unsigned char*)Hp + (size_t)m * D) + C.lane;
#pragma unroll
        for (int j = 0; j < 8; ++j) { R.a[j].x = ar[64 * j]; R.a[j].y = 0u; }
        R.w1 = 1.f / 256.f; R.w2 = 0.f;
    } else {
        const f32x4 rt = ((const f32x4*)(C.ws + WS_ROUTE))[m];
        const int s1 = ((const int*)(C.ws + WS_SLOT1))[m], s2 = ((const int*)(C.ws + WS_SLOT2))[m];
        R.w1 = rt[1] * (1.f / 256.f); R.w2 = rt[2] * (1.f / 256.f);
        const unsigned* y1 = (const unsigned*)((const unsigned char*)Hp + (size_t)s1 * D) + C.lane;
        const unsigned* y2 = (const unsigned*)((const unsigned char*)Hp + (size_t)s2 * D) + C.lane;
#pragma unroll
        for (int j = 0; j < 8; ++j) { R.a[j].x = y1[64 * j]; R.a[j].y = y2[64 * j]; }
    }
}
__device__ __forceinline__ void ln_row(const LnRow& R, const Ctx& C, int m, const float* gain, const float* bias, int hmode, float* Xf32out, unsigned char* X8out,
                                       LAS float* rw, LAS int* hist, bool do_route) {
    const int l4 = 4 * C.lane;
    f32x4 v[8]; float s = 0.f;
#pragma unroll
    for (int j = 0; j < 8; ++j) { f32x4 f, x;
        const f32x2 l01 = __builtin_amdgcn_cvt_pk_f32_fp8(R.rl[j], false), l23 = __builtin_amdgcn_cvt_pk_f32_fp8(R.rl[j], true);
        x[0] = bflo(R.rh[j].x) + l01[0] * (1.f / 8192.f); x[1] = bfhi(R.rh[j].x) + l01[1] * (1.f / 8192.f); x[2] = bflo(R.rh[j].y) + l23[0] * (1.f / 8192.f); x[3] = bfhi(R.rh[j].y) + l23[1] * (1.f / 8192.f);
        if (hmode == 0) { f[0] = bflo(R.a[j].x); f[1] = bfhi(R.a[j].x); f[2] = bflo(R.a[j].y); f[3] = bfhi(R.a[j].y); }
        else { const f32x2 a01 = __builtin_amdgcn_cvt_pk_f32_fp8(R.a[j].x, false), a23 = __builtin_amdgcn_cvt_pk_f32_fp8(R.a[j].x, true);
            f[0] = R.w1 * a01[0]; f[1] = R.w1 * a01[1]; f[2] = R.w1 * a23[0]; f[3] = R.w1 * a23[1];
            if (hmode == 2) { const f32x2 b01 = __builtin_amdgcn_cvt_pk_f32_fp8(R.a[j].y, false), b23 = __builtin_amdgcn_cvt_pk_f32_fp8(R.a[j].y, true);
                f[0] += R.w2 * b01[0]; f[1] += R.w2 * b01[1]; f[2] += R.w2 * b23[0]; f[3] += R.w2 * b23[1]; } }
        v[j] = x * ALPHA + f; s += (v[j][0] + v[j][1]) + (v[j][2] + v[j][3]); }
    const float mean = wave_sum(s) * (1.f / D); float s2 = 0.f;
#pragma unroll
    for (int j = 0; j < 8; ++j) { v[j] = v[j] - mean; s2 += (v[j][0] * v[j][0] + v[j][1] * v[j][1]) + (v[j][2] * v[j][2] + v[j][3] * v[j][3]); }
    const float rstd = 1.0f / sqrtf(wave_sum(s2) * (1.f / D) + LN_EPS);
    float lg[8];
#pragma unroll
    for (int e = 0; e < 8; ++e) lg[e] = 0.f;
    u32x2* ho = (u32x2*)(C.ws + WS_XB + (size_t)m * D * 2) + C.lane;
    unsigned* lo = (unsigned*)(C.ws + WS_XLO + (size_t)m * D) + C.lane;
#pragma unroll
    for (int j = 0; j < 8; ++j) {
        const f32x4 gv = *((const f32x4*)(gain + 256 * j + l4)), bv = *((const f32x4*)(bias + 256 * j + l4));
        const f32x4 o = v[j] * rstd * gv + bv;
        if (Xf32out) ((f32x4*)(Xf32out + (size_t)m * D))[64 * j + C.lane] = o;
        else { u32x2 w; w.x = cvt_pk_bf16(o[0], o[1]); w.y = cvt_pk_bf16(o[2], o[3]); ho[64 * j] = w;
            lo[64 * j] = pk4_fp8((o[0] - bflo(w.x)) * 8192.f, (o[1] - bfhi(w.x)) * 8192.f, (o[2] - bflo(w.y)) * 8192.f, (o[3] - bfhi(w.y)) * 8192.f); }
        if (X8out) ((unsigned*)(X8out + (size_t)m * D))[64 * j + C.lane] = pk4_fp8(o[0] * 16.f, o[1] * 16.f, o[2] * 16.f, o[3] * 16.f);
        if (do_route) {
#pragma unroll
            for (int e = 0; e < 8; ++e) { const f32x4 we = *(const LAS f32x4*)(rw + e * 2048 + 256 * j + l4);
                lg[e] += (o[0] * we[0] + o[1] * we[1]) + (o[2] * we[2] + o[3] * we[3]); }
        }
    }
    if (do_route) {
#pragma unroll
        for (int e = 0; e < 8; ++e) lg[e] = wave_sum(lg[e]);
        int e1 = 0; float v1 = lg[0];
#pragma unroll
        for (int e = 1; e < 8; ++e) if (lg[e] > v1) { v1 = lg[e]; e1 = e; }
        int e2 = -1; float v2 = -3.0e38f;
#pragma unroll
        for (int e = 0; e < 8; ++e) if (e != e1 && lg[e] > v2) { v2 = lg[e]; e2 = e; }
        const float ex = __expf(v2 - v1); const float w1 = 1.0f / (1.0f + ex), w2 = ex / (1.0f + ex);
        if (C.lane == 0) { f32x4 rt; rt[0] = __int_as_float(e1 | (e2 << 8)); rt[1] = w1; rt[2] = w2; rt[3] = 0.f; ((f32x4*)(C.ws + WS_ROUTE))[m] = rt;
            atomicAdd((int*)&hist[e1], 1); atomicAdd((int*)&hist[e2], 1); }
    }
}
__device__ __forceinline__ void ph_ln(const Ctx& C, const void* Hp, int hmode, const float* gain, const float* bias, float* Xf32out, unsigned char* X8out,
                                      const float* router, bool do_route) {
    unsigned char* ws = C.ws;
    LAS float* rw = (LAS float*)C.lds;
    LAS int* hist = (LAS int*)(C.lds + LDS_MISC + 64);
    if (do_route) {
        for (int col = C.tid; col < 2048; col += NTHR) { const f32x4 a = ((const f32x4*)router)[2 * col], b = ((const f32x4*)router)[2 * col + 1];
            rw[0 * 2048 + col] = a[0]; rw[1 * 2048 + col] = a[1]; rw[2 * 2048 + col] = a[2]; rw[3 * 2048 + col] = a[3]; rw[4 * 2048 + col] = b[0]; rw[5 * 2048 + col] = b[1]; rw[6 * 2048 + col] = b[2]; rw[7 * 2048 + col] = b[3]; }
        if (C.tid < 8) hist[C.tid] = 0;
        int* st = (int*)(ws + WS_SLOTTOK);
        for (int i = C.bid * NTHR + C.tid; i < NSLOT; i += C.G * NTHR) st[i] = -1;
        __syncthreads();
    }
    const int m0 = C.bid * 128 + C.wave * 16;
    LnRow Ra, Rb;
    ln_load(Ra, C, m0, Hp, hmode);
#pragma unroll 1
    for (int r = 0; r < 16; r += 2) {
        ln_load(Rb, C, m0 + r + 1, Hp, hmode);
        ln_row(Ra, C, m0 + r, gain, bias, hmode, Xf32out, X8out, rw, hist, do_route);
        if (r + 2 < 16) ln_load(Ra, C, m0 + r + 2, Hp, hmode);
        ln_row(Rb, C, m0 + r + 1, gain, bias, hmode, Xf32out, X8out, rw, hist, do_route);
    }
    if (do_route) { __syncthreads(); if (C.tid < 8) ((int*)(ws + WS_CTL))[CW_CNT + C.bid * 8 + C.tid] = hist[C.tid]; }
}

__device__ __forceinline__ void ph_slots(const Ctx& C) {
    unsigned char* ws = C.ws;
    LAS int* sm = (LAS int*)(C.lds + LDS_MISC + 128);
    const int* cnt = (const int*)(ws + WS_CTL) + CW_CNT;
    if (C.tid < 8) { int tot = 0, mine = 0; for (int b = 0; b < C.G; ++b) { const int c = cnt[b * 8 + C.tid]; if (b < C.bid) mine += c; tot += c; } sm[C.tid] = tot; sm[8 + C.tid] = mine; }
    __syncthreads();
    if (C.tid == 0) { int base = 0; for (int e = 0; e < 8; ++e) { sm[16 + e] = base; base += (sm[e] + 255) & ~255; } sm[24] = base >> 8; }
    __syncthreads();
    if (C.wave == 0) {
        int off[8];
#pragma unroll
        for (int e = 0; e < 8; ++e) off[e] = sm[16 + e] + sm[8 + e];
        const unsigned long long lt = (1ull << C.lane) - 1ull;
        for (int it = 0; it < 2; ++it) {
            const int m = C.bid * 128 + it * 64 + C.lane;
            const int ee = __float_as_int(((const f32x4*)(ws + WS_ROUTE))[m][0]); const int e1 = ee & 0xff, e2 = (ee >> 8) & 0xff;
            int s1 = 0, s2 = 0;
#pragma unroll
            for (int e = 0; e < 8; ++e) { const unsigned long long m1 = __ballot(e1 == e), m2 = __ballot(e2 == e);
                const int c1 = __popcll(m1), c2 = __popcll(m2);
                if (e1 == e) s1 = off[e] + __popcll(m1 & lt);
                if (e2 == e) s2 = off[e] + c1 + __popcll(m2 & lt);
                off[e] += c1 + c2; }
            ((int*)(ws + WS_SLOT1))[m] = s1; ((int*)(ws + WS_SLOT2))[m] = s2;
            int* st = (int*)(ws + WS_SLOTTOK); st[s1] = m; st[s2] = m;
        }
    }
    if (C.bid == 0) {
        int* ctl = (int*)(ws + WS_CTL);
        if (C.tid == 0) ctl[CW_NT] = sm[24];
        if (C.tid < 264) { int e = 0;
#pragma unroll
            for (int q = 1; q < 8; ++q) if (C.tid >= (sm[16 + q] >> 8)) e = q;
            ctl[CW_TEXP + C.tid] = e; }
    }
}
__device__ __forceinline__ void ph_gather(const Ctx& C) {
    unsigned char* ws = C.ws;
    const int* st = (const int*)(ws + WS_SLOTTOK); const u32x4* xb = (const u32x4*)(ws + WS_XB); u32x4* xp = (u32x4*)(ws + WS_XPERM);
    for (int s = C.gw; s < NSLOT; s += C.NGW) { const int tok = st[s];
#pragma unroll
        for (int j = 0; j < 2; ++j) { u32x4 v = xb[(size_t)(tok < 0 ? 0 : tok) * 128 + j * 64 + C.lane]; const unsigned k = tok < 0 ? 0u : 0xffffffffu; v.x &= k; v.y &= k; v.z &= k; v.w &= k; xp[(size_t)s * 128 + j * 64 + C.lane] = v; } }
}
__device__ __forceinline__ void ph_moe_wconv(const Ctx& C, const float* mg, const float* mu, const float* md) {
    MoeDec dec; dec.mg = mg; dec.mu = mu; dec.md = md; dec.ws = C.ws; conv_run(C, 16896, dec, C.bid - 192, 64);
}

__device__ __forceinline__ void ph_memattn(const Ctx& C, const bf16* P, int ldp, int qm0) {
    unsigned char* ws = C.ws;
    const bf16* memK = (const bf16*)(ws + WS_MEMK); const bf16* memVT = (const bf16*)(ws + WS_MEMVT); bf16* mix = (bf16*)(ws + WS_MIX);
    const int g = C.lane >> 4, r16 = C.lane & 15;
    LAS unsigned char* LK = C.lds; LAS unsigned char* LV = C.lds + 65536;
    const int b = C.bid >> 4, hm = (C.bid >> 2) & 3, qb = C.bid & 3;
    __syncthreads();
    {   u32x4 st[16];
#pragma unroll
        for (int i = 0; i < 8; ++i) { const int q = C.tid + 512 * i, row = q >> 4, pc = q & 15;
            st[i] = *(const u32x4*)(memK + (size_t)(b * 256 + row) * 512 + hm * 128 + pc * 8); }
#pragma unroll
        for (int i = 0; i < 8; ++i) { const int q = C.tid + 512 * i, row = q >> 5, pc = q & 31;
            st[8 + i] = *(const u32x4*)(memVT + (size_t)(hm * 128 + row) * 4096 + b * 256 + pc * 8); }
#pragma unroll
        for (int i = 0; i < 8; ++i) { const int q = C.tid + 512 * i, row = q >> 4, pc = q & 15;
            *(LAS u32x4*)(LK + row * 256 + ((pc ^ (row & 15)) * 16)) = st[i]; }
#pragma unroll
        for (int i = 0; i < 8; ++i) { const int q = C.tid + 512 * i, row = q >> 5, pc = q & 31;
            *(LAS u32x4*)(LV + row * 512 + ((pc ^ (row & 15)) * 16)) = st[8 + i]; }
    }
    __syncthreads();
    for (int qt = 0; qt < 4; ++qt) {
        const int m0 = b * SEQ + qb * 512 + C.wave * 64 + qt * 16;
        bf16x8 qf[4];
#pragma unroll
        for (int s = 0; s < 4; ++s) qf[s] = *(const bf16x8*)(P + (size_t)(m0 + r16) * ldp + qm0 + hm * 128 + 32 * s + 8 * g);
        f32x4 sacc[16];
#pragma unroll
        for (int kt = 0; kt < 16; ++kt) { sacc[kt] = (f32x4){0.f, 0.f, 0.f, 0.f};
#pragma unroll
            for (int s = 0; s < 4; ++s) { const bf16x8 kf = *(const LAS bf16x8*)(LK + (16 * kt + r16) * 256 + (((4 * s + g) ^ r16) * 16));
                sacc[kt] = __builtin_amdgcn_mfma_f32_16x16x32_bf16(kf, qf[s], sacc[kt], 0, 0, 0); } }
        float mx = -3.0e38f;
#pragma unroll
        for (int kt = 0; kt < 16; ++kt)
#pragma unroll
            for (int j = 0; j < 4; ++j) mx = fmaxf(mx, sacc[kt][j]);
        mx = fmaxf(mx, __shfl_xor(mx, 16)); mx = fmaxf(mx, __shfl_xor(mx, 32));
        const float sc = 0.08838834764831845f * 1.4426950408889634f;
        float sum = 0.f;
#pragma unroll
        for (int kt = 0; kt < 16; ++kt)
#pragma unroll
            for (int j = 0; j < 4; ++j) { const float pv = exp2f((sacc[kt][j] - mx) * sc); sacc[kt][j] = pv; sum += pv; }
        sum += __shfl_xor(sum, 16); sum += __shfl_xor(sum, 32);
        f32x4 oacc[8];
#pragma unroll
        for (int dt = 0; dt < 8; ++dt) oacc[dt] = (f32x4){0.f, 0.f, 0.f, 0.f};
#pragma unroll
        for (int ks = 0; ks < 8; ++ks) {
            u32x4 pw; pw.x = cvt_pk_bf16(sacc[2 * ks][0], sacc[2 * ks][1]); pw.y = cvt_pk_bf16(sacc[2 * ks][2], sacc[2 * ks][3]);
            pw.z = cvt_pk_bf16(sacc[2 * ks + 1][0], sacc[2 * ks + 1][1]); pw.w = cvt_pk_bf16(sacc[2 * ks + 1][2], sacc[2 * ks + 1][3]);
            const bf16x8 pa = __builtin_bit_cast(bf16x8, pw);
#pragma unroll
            for (int dt = 0; dt < 8; ++dt) { const LAS unsigned char* vr = LV + (16 * dt + r16) * 512;
                const u32x2 lo = *(const LAS u32x2*)(vr + (((8 * ks + g) ^ (2 * r16)) * 8)), hi = *(const LAS u32x2*)(vr + (((8 * ks + 4 + g) ^ (2 * r16)) * 8));
                u32x4 vw; vw.x = lo.x; vw.y = lo.y; vw.z = hi.x; vw.w = hi.y;
                oacc[dt] = __builtin_amdgcn_mfma_f32_16x16x32_bf16(pa, __builtin_bit_cast(bf16x8, vw), oacc[dt], 0, 0, 0); } }
        float inv[4];
#pragma unroll
        for (int j = 0; j < 4; ++j) inv[j] = 1.0f / __shfl(sum, 4 * g + j);
#pragma unroll
        for (int dt = 0; dt < 8; ++dt)
#pragma unroll
            for (int j = 0; j < 4; ++j) mix[(size_t)(m0 + 4 * g + j) * D + SW + hm * 128 + 16 * dt + r16] = f2bf(oacc[dt][j] * inv[j]);
    }
    __syncthreads();
}

__device__ __forceinline__ void ph_rwkv_prep1(const Ctx& C, const float* mu, bool with_v) {
    unsigned char* ws = C.ws;
    const bf16* P = (const bf16*)(ws + WS_P); bf16* AL = (bf16*)(ws + WS_ALORA);
    const int oc0 = 8 * C.lane;
    const int XW0 = 4608, XA0 = 4704, XV0 = 4800, XG0 = with_v ? 4864 : 4800;
    int src, mode;
    if (oc0 < 96) { src = XW0 + oc0; mode = 0; } else if (oc0 < 192) { src = XA0 + oc0 - 96; mode = 1; }
    else if (oc0 < 256) { src = XV0 + oc0 - 192; mode = with_v ? 1 : 2; } else { src = XG0 + oc0 - 256; mode = 3; }
    f32x4 mu0 = (f32x4){0.f, 0.f, 0.f, 0.f}, mu1 = mu0;
    if (mode != 2) { mu0 = *(const f32x4*)(mu + src); mu1 = *(const f32x4*)(mu + src + 4); }
    for (int m = C.gw; m < M; m += C.NGW) {
        u32x4 o = (u32x4){0u, 0u, 0u, 0u};
        if (mode != 2) {
            const u32x4 cu = *(const u32x4*)(P + (size_t)m * LDP_RW + src);
            u32x4 pr = (u32x4){0u, 0u, 0u, 0u};
            if ((m & (SEQ - 1)) != 0) pr = *(const u32x4*)(P + (size_t)(m - 1) * LDP_RW + src);
            float v[8];
#pragma unroll
            for (int q = 0; q < 4; ++q) { const float c0 = bflo(cu[q]), c1 = bfhi(cu[q]), p0 = bflo(pr[q]), p1 = bfhi(pr[q]);
                const float m0 = q < 2 ? mu0[2 * q] : mu1[2 * q - 4], m1 = q < 2 ? mu0[2 * q + 1] : mu1[2 * q - 3];
                v[2 * q] = c0 + m0 * (p0 - c0); v[2 * q + 1] = c1 + m1 * (p1 - c1); }
#pragma unroll
            for (int q = 0; q < 8; ++q) { if (mode == 0) v[q] = 1.0f - 2.0f * __builtin_amdgcn_rcpf(1.0f + __expf(2.0f * v[q])); else if (mode == 3) v[q] = sigmoidf_(v[q]); }
            o.x = cvt_pk_bf16(v[0], v[1]); o.y = cvt_pk_bf16(v[2], v[3]); o.z = cvt_pk_bf16(v[4], v[5]); o.w = cvt_pk_bf16(v[6], v[7]);
        }
        *(u32x4*)(AL + (size_t)m * 512 + oc0) = o;
    }
}
__device__ __forceinline__ void ph_rwkv_prep2(const Ctx& C, const float* mu, const float* vecs, bool with_v) {
    unsigned char* ws = C.ws;
    const bf16* P = (const bf16*)(ws + WS_P); const bf16* LO = (const bf16*)(ws + WS_LORAOUT); bf16* VF = (bf16*)(ws + WS_VFIRST);
    unsigned char* SI = ws + WS_SCANIN; float* BON = (float*)(ws + WS_BONUS);
    const float* k_k = vecs + (with_v ? 3 : 2) * SW; const float* k_a = k_k + SW; const float* r_k = k_a + SW;
    const int hq = C.lane >> 4, cl = (C.lane & 15) * 4;
    for (int m = C.gw; m < M; m += C.NGW) {
        const int t = m & (SEQ - 1), b = m >> 11; const bool hp = t != 0;
        const bf16* pc = P + (size_t)m * LDP_RW; const bf16* pp = pc - LDP_RW;
#pragma unroll 2
        for (int it = 0; it < 6; ++it) {
            const int c = it * 256 + 4 * C.lane, head = 4 * it + hq;
            const u32x2 rc = *(const u32x2*)(pc + c), kc = *(const u32x2*)(pc + SW + c), vc = *(const u32x2*)(pc + 2 * SW + c);
            u32x2 rp = (u32x2){0u, 0u}, kp_ = rp, vp = rp;
            if (hp) { rp = *(const u32x2*)(pp + c); kp_ = *(const u32x2*)(pp + SW + c); vp = *(const u32x2*)(pp + 2 * SW + c); }
            const u32x2 Ew = *(const u32x2*)(LO + (size_t)m * 6144 + c), aw = *(const u32x2*)(LO + (size_t)m * 6144 + SW + c);
            u32x2 svw = (u32x2){0u, 0u}, vfw = svw;
            if (with_v) { svw = *(const u32x2*)(LO + (size_t)m * 6144 + 2 * SW + c); vfw = *(const u32x2*)(VF + (size_t)m * SW + c); }
            const f32x4 mr = *(const f32x4*)(mu + c), mk = *(const f32x4*)(mu + SW + c), mv = *(const f32x4*)(mu + 2 * SW + c);
            const f32x4 kk4 = *(const f32x4*)(k_k + c), ka4 = *(const f32x4*)(k_a + c), rk4 = *(const f32x4*)(r_k + c);
            float rm[4], km[4], vm[4], E[4], a[4], sv[4], vf[4];
#define UNPK(dst, w) dst[0] = bflo(w.x); dst[1] = bfhi(w.x); dst[2] = bflo(w.y); dst[3] = bfhi(w.y)
            float t0[4], t1[4];
            UNPK(t0, rc); UNPK(t1, rp);
#pragma unroll
            for (int j = 0; j < 4; ++j) rm[j] = t0[j] + mr[j] * (t1[j] - t0[j]);
            UNPK(t0, kc); UNPK(t1, kp_);
#pragma unroll
            for (int j = 0; j < 4; ++j) km[j] = t0[j] + mk[j] * (t1[j] - t0[j]);
            UNPK(t0, vc); UNPK(t1, vp);
#pragma unroll
            for (int j = 0; j < 4; ++j) vm[j] = t0[j] + mv[j] * (t1[j] - t0[j]);
            UNPK(E, Ew); UNPK(a, aw); UNPK(sv, svw); UNPK(vf, vfw);
#undef UNPK
            float vv[4], kkr[4], kp[4], ss = 0.f, bs = 0.f;
#pragma unroll
            for (int j = 0; j < 4; ++j) {
                vv[j] = with_v ? vm[j] + (vf[j] - vm[j]) * sv[j] : vm[j];
                kkr[j] = km[j] * kk4[j]; ss += kkr[j] * kkr[j];
                kp[j] = km[j] * (1.0f + (a[j] - 1.0f) * ka4[j]);
                bs += rm[j] * kp[j] * rk4[j]; }
            ss = row16_sum(ss); bs = row16_sum(bs);
            const float inv = 1.0f / fmaxf(sqrtf(ss), 1e-12f);
            if (!with_v) { u32x2 w; w.x = cvt_pk_bf16(vm[0], vm[1]); w.y = cvt_pk_bf16(vm[2], vm[3]); *(u32x2*)(VF + (size_t)m * SW + c) = w; }
            unsigned char* rec = SI + ((size_t)(b * 24 + head) * SEQ + t) * 896;
            f32x4 wv; float kk[4];
#pragma unroll
            for (int j = 0; j < 4; ++j) { wv[j] = __expf(-E[j]); kk[j] = kkr[j] * inv; }
            *(f32x4*)(rec + cl * 4) = wv;
            u32x2 o;
            o.x = cvt_pk_bf16(-kk[0], -kk[1]); o.y = cvt_pk_bf16(-kk[2], -kk[3]); *(u32x2*)(rec + 256 + cl * 2) = o;
            o.x = cvt_pk_bf16(kk[0] * a[0], kk[1] * a[1]); o.y = cvt_pk_bf16(kk[2] * a[2], kk[3] * a[3]); *(u32x2*)(rec + 384 + cl * 2) = o;
            o.x = cvt_pk_bf16(kp[0], kp[1]); o.y = cvt_pk_bf16(kp[2], kp[3]); *(u32x2*)(rec + 512 + cl * 2) = o;
            o.x = cvt_pk_bf16(rm[0], rm[1]); o.y = cvt_pk_bf16(rm[2], rm[3]); *(u32x2*)(rec + 640 + cl * 2) = o;
            o.x = cvt_pk_bf16(vv[0], vv[1]); o.y = cvt_pk_bf16(vv[2], vv[3]); *(u32x2*)(rec + 768 + cl * 2) = o;
            if ((C.lane & 15) == 0) BON[m * 24 + head] = bs;
        }
    }
}
__device__ __forceinline__ float fma_(float a, float b, float c) { float d; asm("v_fma_f32 %0, %1, %2, %3" : "=v"(d) : "v"(a), "v"(b), "v"(c)); return d; }
__device__ __forceinline__ float mul_(float a, float b) { float d; asm("v_mul_f32 %0, %1, %2" : "=v"(d) : "v"(a), "v"(b)); return d; }
__device__ __forceinline__ void ph_rwkv_scan(const Ctx& C, const float* mg, const float* mu, const float* md, const float* vecs, bool with_v) {
    if (C.bid >= 192) { ph_moe_wconv(C, mg, mu, md); return; }
    unsigned char* ws = C.ws;
    const unsigned char* SI = ws + WS_SCANIN;
    constexpr int TC = 16, NCH = SEQ / TC, REC = 7 * 64;
    LAS float* buf = (LAS float*)C.lds;
    LAS float* ybuf = (LAS float*)(C.lds + 114688);
    const bool scanner = C.wave < 4;
    const int slot = (C.wave >> 1) & 1;
    const int rg = C.lane >> 3, cg = C.lane & 7;
    const int rbase = 32 * (C.wave & 1) + 4 * rg;
    if (!scanner) {
        const int lw = C.wave - 4, qd = C.lane;
        const int q2 = qd - 16, lvec = 1 + (q2 >> 3), lpart = q2 & 7;
        const float* BON = (const float*)(ws + WS_BONUS); bf16* mix = (bf16*)(ws + WS_MIX); const bf16* LO = (const bf16*)(ws + WS_LORAOUT);
        const float* gn_g = vecs + (with_v ? 6 : 5) * SW; const float* gn_b = gn_g + SW;
        const int p0 = C.bid * 2, b0 = p0 / 24, h0 = p0 % 24, b1 = (p0 + 1) / 24, h1 = (p0 + 1) % 24;
        const int pr = C.lane >> 4, pc4 = 4 * (C.lane & 15);
        const f32x4 gg0 = *(const f32x4*)(gn_g + h0 * 64 + pc4), gb0 = *(const f32x4*)(gn_b + h0 * 64 + pc4), gg1 = *(const f32x4*)(gn_g + h1 * 64 + pc4), gb1 = *(const f32x4*)(gn_b + h1 * 64 + pc4);
        u32x4 st[8];
#define SCAN_ISSUE(ch_) do { _Pragma("unroll") for (int i_ = 0; i_ < 8; ++i_) { const int ps = lw + 4 * i_; \
        const int sl_ = ps >> 4, t_ = (ch_) * TC + (ps & 15); \
        st[i_] = qd < 56 ? *(const u32x4*)(SI + ((size_t)(p0 + sl_) * SEQ + t_) * 896 + qd * 16) \
                         : *(const u32x4*)(LO + (size_t)((sl_ ? b1 : b0) * SEQ + t_) * 6144 + 3 * SW + (sl_ ? h1 : h0) * 64 + (qd - 56) * 8); } } while (0)
#define SCAN_COMMIT(bsel_) do { _Pragma("unroll") for (int i_ = 0; i_ < 8; ++i_) { const int ps = lw + 4 * i_; \
        LAS float* dst = buf + (((bsel_) * 2 * TC) + ps) * REC; \
        if (qd < 16) *(LAS u32x4*)(dst + 4 * qd) = st[i_]; \
        else { LAS float* d2 = dst + lvec * 64 + lpart * 8; \
            f32x4 a_, b_; a_[0] = bflo(st[i_].x); a_[1] = bfhi(st[i_].x); a_[2] = bflo(st[i_].y); a_[3] = bfhi(st[i_].y); \
            b_[0] = bflo(st[i_].z); b_[1] = bfhi(st[i_].z); b_[2] = bflo(st[i_].w); b_[3] = bfhi(st[i_].w); \
            *(LAS f32x4*)d2 = a_; *(LAS f32x4*)(d2 + 4) = b_; } } } while (0)
#define SCAN_POST(cp_) do { _Pragma("unroll") for (int g_ = 0; g_ < 2; ++g_) { const int ps = lw + 4 * (4 * g_ + pr), sl = ps >> 4, stp = ps & 15; \
        const LAS float* rec = buf + ((((cp_) & 1) * 2 * TC) + ps) * REC; \
        const f32x4 yv = *(const LAS f32x4*)(ybuf + ((((cp_) & 1) * 2 + sl) * TC + stp) * 64 + pc4), vv = *(const LAS f32x4*)(rec + 5 * 64 + pc4), gq = *(const LAS f32x4*)(rec + 6 * 64 + pc4); \
        const int m = (sl ? b1 : b0) * SEQ + (cp_) * TC + stp, hh = sl ? h1 : h0; \
        const float bon = BON[m * 24 + hh]; \
        const float mean = row16_sum((yv[0] + yv[1]) + (yv[2] + yv[3])) * (1.f / 64.f); const f32x4 d = yv - mean; \
        const float var = row16_sum((d[0] * d[0] + d[1] * d[1]) + (d[2] * d[2] + d[3] * d[3])) * (1.f / 64.f); \
        const float rstd = 1.0f / sqrtf(var + 64e-5f); const f32x4 gg = sl ? gg1 : gg0, gb = sl ? gb1 : gb0; \
        const f32x4 o_ = (d * rstd * gg + gb + vv * bon) * gq; \
        u32x2 w_; w_.x = cvt_pk_bf16(o_[0], o_[1]); w_.y = cvt_pk_bf16(o_[2], o_[3]); \
        *(u32x2*)(mix + (size_t)m * D + hh * 64 + pc4) = w_; } } while (0)
        SCAN_ISSUE(0); SCAN_COMMIT(0);
        __syncthreads();
        for (int ch = 0; ch < NCH; ++ch) {
            if (ch + 1 < NCH) SCAN_ISSUE(ch + 1);
            if (ch > 0) SCAN_POST(ch - 1);
            if (ch + 1 < NCH) SCAN_COMMIT((ch & 1) ^ 1);
            __syncthreads();
        }
        SCAN_POST(NCH - 1);
#undef SCAN_ISSUE
#undef SCAN_COMMIT
#undef SCAN_POST
    } else {
        f32x2 S[4][4];
#pragma unroll
        for (int i = 0; i < 4; ++i)
#pragma unroll
            for (int c = 0; c < 4; ++c) S[i][c] = (f32x2){0.f, 0.f};
        __syncthreads();
        for (int ch = 0; ch < NCH; ++ch) {
            const LAS float* base = buf + (((ch & 1) * 2 + slot) * TC) * REC;
            LAS float* yb = ybuf + (((ch & 1) * 2 + slot) * TC) * 64 + rbase;
#pragma unroll 2
            for (int s = 0; s < TC; ++s) {
                const LAS float* rp = base + s * REC + 8 * cg;
                f32x2 wv[4], nv[4], bv[4], kv[4], rv[4];
                { const f32x4 x0 = *(const LAS f32x4*)(rp), x1 = *(const LAS f32x4*)(rp + 4); wv[0] = (f32x2){x0[0], x0[1]}; wv[1] = (f32x2){x0[2], x0[3]}; wv[2] = (f32x2){x1[0], x1[1]}; wv[3] = (f32x2){x1[2], x1[3]}; }
                { const f32x4 x0 = *(const LAS f32x4*)(rp + 64), x1 = *(const LAS f32x4*)(rp + 68); nv[0] = (f32x2){x0[0], x0[1]}; nv[1] = (f32x2){x0[2], x0[3]}; nv[2] = (f32x2){x1[0], x1[1]}; nv[3] = (f32x2){x1[2], x1[3]}; }
                { const f32x4 x0 = *(const LAS f32x4*)(rp + 128), x1 = *(const LAS f32x4*)(rp + 132); bv[0] = (f32x2){x0[0], x0[1]}; bv[1] = (f32x2){x0[2], x0[3]}; bv[2] = (f32x2){x1[0], x1[1]}; bv[3] = (f32x2){x1[2], x1[3]}; }
                { const f32x4 x0 = *(const LAS f32x4*)(rp + 192), x1 = *(const LAS f32x4*)(rp + 196); kv[0] = (f32x2){x0[0], x0[1]}; kv[1] = (f32x2){x0[2], x0[3]}; kv[2] = (f32x2){x1[0], x1[1]}; kv[3] = (f32x2){x1[2], x1[3]}; }
                { const f32x4 x0 = *(const LAS f32x4*)(rp + 256), x1 = *(const LAS f32x4*)(rp + 260); rv[0] = (f32x2){x0[0], x0[1]}; rv[1] = (f32x2){x0[2], x0[3]}; rv[2] = (f32x2){x1[0], x1[1]}; rv[3] = (f32x2){x1[2], x1[3]}; }
                const f32x4 vv = *(const LAS f32x4*)(base + s * REC + 320 + rbase);
                f32x4 yo;
#pragma unroll
                for (int i = 0; i < 4; ++i) {
                    f32x2 a2 = S[i][0] * nv[0];
#pragma unroll
                    for (int c = 1; c < 4; ++c) a2 = S[i][c] * nv[c] + a2;
                    float sa = a2[0] + a2[1];
                    sa = dpp_add<0xB1>(sa); sa = dpp_add<0x4E>(sa); sa = dpp_add<0x141>(sa);
                    const f32x2 sa2 = (f32x2){sa, sa}, v2 = (f32x2){vv[i], vv[i]};
                    f32x2 y2 = (f32x2){0.f, 0.f};
#pragma unroll
                    for (int c = 0; c < 4; ++c) { S[i][c] = S[i][c] * wv[c] + (sa2 * bv[c] + v2 * kv[c]); y2 = S[i][c] * rv[c] + y2; }
                    float y = y2[0] + y2[1];
                    y = dpp_add<0xB1>(y); y = dpp_add<0x4E>(y); y = dpp_add<0x141>(y);
                    yo[i] = y;
                }
                if (cg == 0) *(LAS f32x4*)(yb + s * 64) = yo;
            }
            __syncthreads();
        }
    }
}

__device__ __constant__ float RET_LG2[6] = {-0.04580368961312479f, -0.02272007650008353f, -0.011315313227834146f, -0.005646563141142063f, -0.0028205190623786626f, -0.0014095702546713536f};
__device__ __forceinline__ void ph_ret_prep(const Ctx& C) {
    unsigned char* ws = C.ws;
    const bf16* P = (const bf16*)(ws + WS_P); const f32x2* CS = (const f32x2*)(ws + WS_CS);
    bf16* QR = (bf16*)(ws + WS_QR); bf16* KR = (bf16*)(ws + WS_KR); bf16* KDT = (bf16*)(ws + WS_KDT); bf16* VT = (bf16*)(ws + WS_VT);
    for (int u = C.bid; u < 1536; u += C.G) {
        const int c = u & 15, bh = u >> 4, h = bh % 6, b = bh / 6, m0 = b * SEQ + c * 128;
        const float lg2 = RET_LG2[h];
        for (int task = C.tid; task < 1536; task += NTHR) {
            if (task < 512) {
                const bool isk = task >= 256; const int tk = task & 255, i0 = 4 * (tk & 15), tg = tk >> 4;
                const int colb = (isk ? 768 : 0) + h * 128 + i0; const float scl = isk ? 0.08838834764831845f : 1.0f;
                bf16* N = isk ? KR : QR;
                float o1[4][8], o2[4][8];
#pragma unroll
                for (int j = 0; j < 8; ++j) { const int m = m0 + tg * 8 + j;
                    const u32x2 a = *(const u32x2*)(P + (size_t)m * LDP_RET + colb), b2 = *(const u32x2*)(P + (size_t)m * LDP_RET + colb + 64);
                    const f32x4 cs01 = *(const f32x4*)(CS + (size_t)m * 64 + i0), cs23 = *(const f32x4*)(CS + (size_t)m * 64 + i0 + 2);
                    const float x1[4] = {bflo(a.x), bfhi(a.x), bflo(a.y), bfhi(a.y)}, x2[4] = {bflo(b2.x), bfhi(b2.x), bflo(b2.y), bfhi(b2.y)};
                    const float cc[4] = {cs01[0], cs01[2], cs23[0], cs23[2]}, sn[4] = {cs01[1], cs01[3], cs23[1], cs23[3]};
#pragma unroll
                    for (int q = 0; q < 4; ++q) { o1[q][j] = (x1[q] * cc[q] - x2[q] * sn[q]) * scl; o2[q][j] = (x1[q] * sn[q] + x2[q] * cc[q]) * scl; }
                    u32x2 w1, w2; w1.x = cvt_pk_bf16(o1[0][j], o1[1][j]); w1.y = cvt_pk_bf16(o1[2][j], o1[3][j]); w2.x = cvt_pk_bf16(o2[0][j], o2[1][j]); w2.y = cvt_pk_bf16(o2[2][j], o2[3][j]);
                    *(u32x2*)(N + (size_t)m * 768 + h * 128 + i0) = w1; *(u32x2*)(N + (size_t)m * 768 + h * 128 + i0 + 64) = w2; }
                if (isk) {
                    float kd[8];
#pragma unroll
                    for (int j = 0; j < 8; ++j) kd[j] = exp2f((float)(127 - (tg * 8 + j)) * lg2);
#pragma unroll
                    for (int q = 0; q < 4; ++q) {
                        u32x4 w1, w2;
                        w1.x = cvt_pk_bf16(o1[q][0] * kd[0], o1[q][1] * kd[1]); w1.y = cvt_pk_bf16(o1[q][2] * kd[2], o1[q][3] * kd[3]); w1.z = cvt_pk_bf16(o1[q][4] * kd[4], o1[q][5] * kd[5]); w1.w = cvt_pk_bf16(o1[q][6] * kd[6], o1[q][7] * kd[7]);
                        w2.x = cvt_pk_bf16(o2[q][0] * kd[0], o2[q][1] * kd[1]); w2.y = cvt_pk_bf16(o2[q][2] * kd[2], o2[q][3] * kd[3]); w2.z = cvt_pk_bf16(o2[q][4] * kd[4], o2[q][5] * kd[5]); w2.w = cvt_pk_bf16(o2[q][6] * kd[6], o2[q][7] * kd[7]);
                        *(u32x4*)(KDT + (size_t)(bh * 128 + i0 + q) * SEQ + c * 128 + tg * 8) = w1;
                        *(u32x4*)(KDT + (size_t)(bh * 128 + i0 + q + 64) * SEQ + c * 128 + tg * 8) = w2; }
                }
            } else {
                const int tv = task - 512, e0 = 4 * (tv & 63), tg = tv >> 6;
                u32x2 vin[8];
#pragma unroll
                for (int j = 0; j < 8; ++j) vin[j] = *(const u32x2*)(P + (size_t)(m0 + tg * 8 + j) * LDP_RET + 1536 + h * 256 + e0);
                u32x4 w0, w1, w2, w3;
#define PKLO(a_, b_) (((a_) & 0xffffu) | ((b_) << 16))
#define PKHI(a_, b_) (((a_) >> 16) | ((b_) & 0xffff0000u))
                w0.x = PKLO(vin[0].x, vin[1].x); w0.y = PKLO(vin[2].x, vin[3].x); w0.z = PKLO(vin[4].x, vin[5].x); w0.w = PKLO(vin[6].x, vin[7].x);
                w1.x = PKHI(vin[0].x, vin[1].x); w1.y = PKHI(vin[2].x, vin[3].x); w1.z = PKHI(vin[4].x, vin[5].x); w1.w = PKHI(vin[6].x, vin[7].x);
                w2.x = PKLO(vin[0].y, vin[1].y); w2.y = PKLO(vin[2].y, vin[3].y); w2.z = PKLO(vin[4].y, vin[5].y); w2.w = PKLO(vin[6].y, vin[7].y);
                w3.x = PKHI(vin[0].y, vin[1].y); w3.y = PKHI(vin[2].y, vin[3].y); w3.z = PKHI(vin[4].y, vin[5].y); w3.w = PKHI(vin[6].y, vin[7].y);
#undef PKLO
#undef PKHI
                bf16* vt = VT + (size_t)(bh * 256 + e0) * SEQ + c * 128 + tg * 8;
                *(u32x4*)vt = w0; *(u32x4*)(vt + SEQ) = w1; *(u32x4*)(vt + 2 * SEQ) = w2; *(u32x4*)(vt + 3 * SEQ) = w3;
            }
        }
    }
}
__device__ __forceinline__ void ph_ret_kv(const Ctx& C) {
    unsigned char* ws = C.ws;
    const bf16* KDT = (const bf16*)(ws + WS_KDT); const bf16* VT = (const bf16*)(ws + WS_VT); bf16* KVT = (bf16*)(ws + WS_KVT);
    const int g = C.lane >> 4, r16 = C.lane & 15, w = C.wave;
    for (int u = C.bid; u < 1536; u += C.G) {
        const int c = u & 15, bh = u >> 4;
        f32x4 acc[16];
#pragma unroll
        for (int et = 0; et < 16; ++et) acc[et] = (f32x4){0.f, 0.f, 0.f, 0.f};
#pragma unroll
        for (int ks = 0; ks < 4; ++ks) {
            const bf16x8 af = *(const bf16x8*)(KDT + (size_t)(bh * 128 + 16 * w + r16) * SEQ + c * 128 + 32 * ks + 8 * g);
#pragma unroll
            for (int et = 0; et < 16; ++et) { const bf16x8 bf = *(const bf16x8*)(VT + (size_t)(bh * 256 + 16 * et + r16) * SEQ + c * 128 + 32 * ks + 8 * g);
                acc[et] = __builtin_amdgcn_mfma_f32_16x16x32_bf16(af, bf, acc[et], 0, 0, 0); } }
#pragma unroll
        for (int et = 0; et < 16; ++et) { u32x2 wv; wv.x = cvt_pk_bf16(acc[et][0], acc[et][1]); wv.y = cvt_pk_bf16(acc[et][2], acc[et][3]); *(u32x2*)(KVT + ((size_t)u * 256 + 16 * et + r16) * 128 + 16 * w + 4 * g) = wv; }
    }
}
__device__ __forceinline__ void ph_ret_prefix(const Ctx& C) {
    unsigned char* ws = C.ws;
    const bf16* KVT = (const bf16*)(ws + WS_KVT); bf16* RTB = (bf16*)(ws + WS_RTB);
    for (int idx = C.bid * NTHR + C.tid; idx < 96 * 8192; idx += C.G * NTHR) {
        const int bh = idx >> 13, rem = idx & 8191; const int h = bh % 6;
        const float cd = exp2f(128.0f * RET_LG2[h]);
        f32x4 r = (f32x4){0.f, 0.f, 0.f, 0.f};
#pragma unroll
        for (int c = 0; c < 16; ++c) { const size_t off = ((size_t)(bh * 16 + c) * 8192 + rem) * 4;
            u32x2 w; w.x = cvt_pk_bf16(r[0], r[1]); w.y = cvt_pk_bf16(r[2], r[3]); *(u32x2*)(RTB + off) = w;
            const u32x2 kw = *(const u32x2*)(KVT + off); const f32x4 kv = (f32x4){bflo(kw.x), bfhi(kw.x), bflo(kw.y), bfhi(kw.y)}; r = r * cd + kv; }
    }
}
__device__ __forceinline__ void ph_ret_out(const Ctx& C, const float* gn) {
    unsigned char* ws = C.ws;
    const bf16* P = (const bf16*)(ws + WS_P); const bf16* QR = (const bf16*)(ws + WS_QR); const bf16* KR = (const bf16*)(ws + WS_KR);
    const bf16* VT = (const bf16*)(ws + WS_VT); const bf16* RTB = (const bf16*)(ws + WS_RTB); bf16* mix = (bf16*)(ws + WS_MIX);
    const int g = C.lane >> 4, r16 = C.lane & 15, w = C.wave;
    LAS unsigned char* LR = C.lds; LAS unsigned char* LV = C.lds + 65536;
    for (int u = C.bid; u < 1536; u += C.G) {
        const int c = u & 15, bh = u >> 4, h = bh % 6, b = bh / 6, m0 = b * SEQ + c * 128;
        const float lg2 = RET_LG2[h];
        __syncthreads();
        {   u32x4 st[16];
#pragma unroll
            for (int i = 0; i < 8; ++i) { const int q = C.tid + 512 * i, row = q >> 4, pc = q & 15;
                st[i] = *(const u32x4*)(RTB + ((size_t)u * 256 + row) * 128 + pc * 8);
                st[8 + i] = *(const u32x4*)(VT + (size_t)(bh * 256 + row) * SEQ + c * 128 + pc * 8); }
#pragma unroll
            for (int i = 0; i < 8; ++i) { const int q = C.tid + 512 * i, row = q >> 4, pc = q & 15; const int off = row * 256 + ((pc ^ (row & 15)) * 16);
                *(LAS u32x4*)(LR + off) = st[i]; *(LAS u32x4*)(LV + off) = st[8 + i]; }
        }
        __syncthreads();
        const int nl = 16 * w + r16;
        bf16x8 qf[4];
#pragma unroll
        for (int s = 0; s < 4; ++s) qf[s] = *(const bf16x8*)(QR + (size_t)(m0 + nl) * 768 + h * 128 + 32 * s + 8 * g);
        f32x4 o[16];
        const float qdec = exp2f((float)(nl + 1) * lg2);
#pragma unroll
        for (int et = 0; et < 16; ++et) { f32x4 a = (f32x4){0.f, 0.f, 0.f, 0.f};
#pragma unroll
            for (int s = 0; s < 4; ++s) { const bf16x8 rf = *(const LAS bf16x8*)(LR + (16 * et + r16) * 256 + (((4 * s + g) ^ r16) * 16));
                a = __builtin_amdgcn_mfma_f32_16x16x32_bf16(rf, qf[s], a, 0, 0, 0); }
            o[et] = a * qdec; }
        u32x2 pb[8];
#pragma unroll
        for (int mt = 0; mt < 8; ++mt) {
            pb[mt] = (u32x2){0u, 0u};
            if (mt <= w) { f32x4 a = (f32x4){0.f, 0.f, 0.f, 0.f};
#pragma unroll
                for (int s = 0; s < 4; ++s) { const bf16x8 kf = *(const bf16x8*)(KR + (size_t)(m0 + 16 * mt + r16) * 768 + h * 128 + 32 * s + 8 * g);
                    a = __builtin_amdgcn_mfma_f32_16x16x32_bf16(kf, qf[s], a, 0, 0, 0); }
#pragma unroll
                for (int j = 0; j < 4; ++j) { const int diff = nl - (16 * mt + 4 * g + j); a[j] = diff >= 0 ? a[j] * exp2f((float)diff * lg2) : 0.f; }
                pb[mt].x = cvt_pk_bf16(a[0], a[1]); pb[mt].y = cvt_pk_bf16(a[2], a[3]); }
        }
#pragma unroll
        for (int ks = 0; ks < 4; ++ks) {
            if (2 * ks <= w) {
                u32x4 pw; pw.x = pb[2 * ks].x; pw.y = pb[2 * ks].y; pw.z = pb[2 * ks + 1].x; pw.w = pb[2 * ks + 1].y;
                const bf16x8 pf = __builtin_bit_cast(bf16x8, pw);
#pragma unroll
                for (int et = 0; et < 16; ++et) { const LAS unsigned char* vr = LV + (16 * et + r16) * 256;
                    const u32x2 lo = *(const LAS u32x2*)(vr + (((8 * ks + g) ^ (2 * r16)) * 8)), hi = *(const LAS u32x2*)(vr + (((8 * ks + 4 + g) ^ (2 * r16)) * 8));
                    u32x4 vw; vw.x = lo.x; vw.y = lo.y; vw.z = hi.x; vw.w = hi.y;
                    o[et] = __builtin_amdgcn_mfma_f32_16x16x32_bf16(__builtin_bit_cast(bf16x8, vw), pf, o[et], 0, 0, 0); } }
        }
        float s1 = 0.f;
#pragma unroll
        for (int et = 0; et < 16; ++et) s1 += (o[et][0] + o[et][1]) + (o[et][2] + o[et][3]);
        s1 += __shfl_xor(s1, 16); s1 += __shfl_xor(s1, 32);
        const float mean = s1 * (1.f / 256.f); float s2 = 0.f;
#pragma unroll
        for (int et = 0; et < 16; ++et) { o[et] = o[et] - mean; s2 += (o[et][0] * o[et][0] + o[et][1] * o[et][1]) + (o[et][2] * o[et][2] + o[et][3] * o[et][3]); }
        s2 += __shfl_xor(s2, 16); s2 += __shfl_xor(s2, 32);
        const float rstd = 1.0f / sqrtf(s2 * (1.f / 256.f) + 1e-5f);
        const int m = m0 + nl;
#pragma unroll
        for (int et = 0; et < 16; ++et) { const int e = h * 256 + 16 * et + 4 * g;
            const f32x4 gg = *(const f32x4*)(gn + e), gb = *(const f32x4*)(gn + SW + e);
            const u32x2 gw_ = *(const u32x2*)(P + (size_t)m * LDP_RET + 3072 + e);
            float gt[4] = {bflo(gw_.x), bfhi(gw_.x), bflo(gw_.y), bfhi(gw_.y)}; float ov[4];
#pragma unroll
            for (int j = 0; j < 4; ++j) { const float yn = o[et][j] * rstd * gg[j] + gb[j]; ov[j] = yn * gt[j] * sigmoidf_(gt[j]); }
            u32x2 wv; wv.x = cvt_pk_bf16(ov[0], ov[1]); wv.y = cvt_pk_bf16(ov[2], ov[3]);
            *(u32x2*)(mix + (size_t)m * D + e) = wv; }
    }
    __syncthreads();
}

constexpr int PH_PER_PAIR = 23, NPH = 2 + 2 * PH_PER_PAIR;
__global__ void __launch_bounds__(NTHR, 2) fwd_kernel(Args args) {
    extern __shared__ __attribute__((aligned(16))) unsigned char lds_raw[];
    Ctx C;
    C.lds = (LAS unsigned char*)lds_raw;
    C.tid = threadIdx.x; C.lane = C.tid & 63; C.wave = __builtin_amdgcn_readfirstlane(C.tid >> 6);
    C.bid = blockIdx.x; C.G = GRID; C.gw = C.bid * NWAVES + C.wave; C.NGW = C.G * NWAVES; C.ws = args.ws;
    for (int u = C.tid; u < (LDS_BYTES - LDS_MISC) / 4; u += NTHR) ((LAS unsigned*)(C.lds + LDS_MISC))[u] = 0u;
    __syncthreads();
    const int lo = args.ph_lo, hi = args.ph_hi;
    XcdBarrier bar; bar.bar = (unsigned*)(args.ws + WS_CTL) + CW_BAR; bar.x = 0; bar.st = nullptr;
    if (hi - lo > 1) bar = xcd_barrier_post((unsigned*)(args.ws + WS_CTL) + CW_BAR, (volatile LAS unsigned*)(C.lds + LDS_MISC));
#ifndef ENMASK
#define ENMASK 0x1ffffffu
#endif
#define EN(j) ((((unsigned)(ENMASK)) >> (j)) & 1u)
#ifndef DBLMASK
#define DBLMASK 0u
#endif
#define REP(j) for (int rep_ = 0; rep_ < 1 + (int)((((unsigned)(DBLMASK)) >> (j)) & 1u); ++rep_)
#define IN(k) (lo <= (k) && (k) < hi)
#define SEAM(k) do { if (IN((k) + 1)) xcd_barrier(bar, Cq.tid == 0); } while (0)

#define PH_BEGIN Ctx Cq; Cq.lds = C.lds; Cq.lane = lane_id_asm(); Cq.wave = opq_i(C.wave); Cq.tid = Cq.wave * 64 + Cq.lane; Cq.bid = opq_i((int)blockIdx.x); Cq.G = GRID; \
        Cq.gw = Cq.bid * NWAVES + Cq.wave; Cq.NGW = Cq.G * NWAVES; Cq.ws = opq(args.ws); unsigned char* ws = Cq.ws; const int lq = opq_i(lp); (void)ws; (void)lq
    { const int lp = 0;
    REP(0) if (EN(0) && IN(0)) { PH_BEGIN; ph_prologue(Cq, args); SEAM(0); }
    REP(1) if (EN(1) && IN(1)) { PH_BEGIN;
        pg8::SchedMem S; S.G = Cq.G; S.c = Cq.bid; S.memb = (unsigned)WS_MEMB; S.wkv = (unsigned)WS_WKV;
        pg8::EpiMem E; E.O0 = (bf16*)(ws + WS_MEMK); E.O1 = (bf16*)(ws + WS_MEMVT);
        pg8::gemm_phase<pg8::EpiMem, pg8::SchedMem, true, true>(Cq.lds, Cq.tid, (const char*)ws, 2048, 2048, 2048, S, E);
        SEAM(1);
    } }
#pragma unroll 1
    for (int lp = 0; lp < 2; ++lp) {
        const int pb = 2 + lp * PH_PER_PAIR;
        REP(2) if (EN(2) && IN(pb + 0)) {
            PH_BEGIN;
            pg8::SchedPlain S; S.init(M / 256, 22, Cq.G, Cq.bid); S.A0 = (unsigned)(WS_XB); S.B0 = (unsigned)(WS_WIN + (size_t)(2 * lq) * 22 * MiB); S.at = (unsigned)(256 * 2048 * 2); S.bt = (unsigned)(256 * 2048 * 2);
            pg8::EpiBf16 E; E.O = (bf16*)(ws + WS_P); E.ldc = LDP_RW;
            pg8::gemm_phase<pg8::EpiBf16, pg8::SchedPlain, true, true>(Cq.lds, Cq.tid, (const char*)ws, 2048, 2048, 2048, S, E);
            SEAM(pb + 0);
        }
        REP(3) if (EN(3) && IN(pb + 1)) { PH_BEGIN; const bool with_v = lq == 1; ph_rwkv_prep1(Cq, args.in[lq ? L2_MU : L0_MU], with_v); ph_memattn(Cq, (const bf16*)(ws + WS_P), LDP_RW, with_v ? 5120 : 5056); SEAM(pb + 1); }
        REP(4) if (EN(4) && IN(pb + 2)) {
            PH_BEGIN; const float* vecs = args.in[lq ? L2_VECS : L0_VECS];
            pg8::SchedLora S; S.skipv = lq == 0; S.init(M / 256, lq == 0 ? 18 : 24, Cq.G, Cq.bid); S.A0 = (unsigned)(WS_ALORA); S.B0 = (unsigned)(WS_WLORA + (size_t)lq * 3 * MiB);
            pg8::EpiLora E; E.O = (bf16*)(ws + WS_LORAOUT); E.vecs = vecs;
            pg8::gemm_phase<pg8::EpiLora, pg8::SchedLora, true, true>(Cq.lds, Cq.tid, (const char*)ws, 512, 256, opq_i(256), S, E);
            SEAM(pb + 2);
        }
        REP(5) if (EN(5) && IN(pb + 3)) { PH_BEGIN; ph_rwkv_prep2(Cq, args.in[lq ? L2_MU : L0_MU], args.in[lq ? L2_VECS : L0_VECS], lq == 1); SEAM(pb + 3); }
        REP(6) if (EN(6) && IN(pb + 4)) { PH_BEGIN; ph_rwkv_scan(Cq, args.in[lq ? L3_MG : L1_MG], args.in[lq ? L3_MU_ : L1_MU_], args.in[lq ? L3_MD : L1_MD], args.in[lq ? L2_VECS : L0_VECS], lq == 1); SEAM(pb + 4); }
        REP(8) if (EN(8) && IN(pb + 6)) {
            PH_BEGIN;
            pg8::SchedPlain S; S.init(M / 256, 8, Cq.G, Cq.bid); S.A0 = (unsigned)(WS_MIX); S.B0 = (unsigned)(WS_WOUT + (size_t)(2 * lq) * 8 * MiB); S.at = (unsigned)(256 * 2048 * 2); S.bt = (unsigned)(256 * 2048 * 2);
            pg8::EpiBf16 E; E.O = (bf16*)(ws + WS_P); E.ldc = D;
            pg8::gemm_phase<pg8::EpiBf16, pg8::SchedPlain, true, true>(Cq.lds, Cq.tid, (const char*)ws, 2048, 2048, 2048, S, E);
            SEAM(pb + 6);
        }
        REP(9) if (EN(9) && IN(pb + 7)) { PH_BEGIN; const float* nr = args.in[lq ? L2_NORMS : L0_NORMS];
            ph_ln(Cq, ws + WS_P, 0, nr, nr + D, nullptr, ws + WS_X8, nullptr, false); SEAM(pb + 7); }
        REP(10) if (EN(10) && IN(pb + 8)) {
            PH_BEGIN;
            pg8::SchedPlain S; S.init(M / 256, 44, Cq.G, Cq.bid); S.A0 = (unsigned)(WS_X8); S.B0 = (unsigned)(WS_WFGU + (size_t)lq * 44 * MiB); S.at = (unsigned)(256 * 2048); S.bt = (unsigned)(256 * 2048);
            pg8::EpiSwiglu8 E; E.O = ws + WS_HID; E.ldc = DFF; E.inv = 1.0f / 16384.0f; E.so = 32.0f;
            pg8::gemm_phase<pg8::EpiSwiglu8, pg8::SchedPlain, true, true, true>(Cq.lds, Cq.tid, (const char*)ws, 1024, 1024, 1024, S, E);
            SEAM(pb + 8);
        }
        REP(11) if (EN(11) && IN(pb + 9)) {
            PH_BEGIN;
            pg8::SchedPlain S; S.init(M / 256, 8, Cq.G, Cq.bid); S.A0 = (unsigned)(WS_HID); S.B0 = (unsigned)(WS_WFD + (size_t)lq * 22 * MiB); S.at = (unsigned)(256 * DFF); S.bt = (unsigned)(256 * DFF);
            pg8::EpiFp8S E; E.O = ws + WS_P; E.ldc = D; E.sc = 1.0f / 256.0f;
            pg8::gemm_phase<pg8::EpiFp8S, pg8::SchedPlain, true, true, true>(Cq.lds, Cq.tid, (const char*)ws, DFF / 2, DFF / 2, DFF / 2, S, E);
            SEAM(pb + 9);
        }
        REP(12) if (EN(12) && IN(pb + 10)) { PH_BEGIN; const float* nr = args.in[lq ? L2_NORMS : L0_NORMS];
            ph_ln(Cq, ws + WS_P, 1, nr + 2 * D, nr + 3 * D, nullptr, nullptr, nullptr, false); SEAM(pb + 10); }
        REP(13) if (EN(13) && IN(pb + 11)) {
            PH_BEGIN;
            pg8::SchedPlain S; S.init(M / 256, 20, Cq.G, Cq.bid); S.A0 = (unsigned)(WS_XB); S.B0 = (unsigned)(WS_WIN + (size_t)(2 * lq + 1) * 22 * MiB); S.at = (unsigned)(256 * 2048 * 2); S.bt = (unsigned)(256 * 2048 * 2);
            pg8::EpiBf16 E; E.O = (bf16*)(ws + WS_P); E.ldc = LDP_RET;
            pg8::gemm_phase<pg8::EpiBf16, pg8::SchedPlain, true, true>(Cq.lds, Cq.tid, (const char*)ws, 2048, 2048, 2048, S, E);
            SEAM(pb + 11);
        }
        REP(14) if (EN(14) && IN(pb + 12)) { PH_BEGIN; ph_ret_prep(Cq); ph_memattn(Cq, (const bf16*)(ws + WS_P), LDP_RET, 4608); SEAM(pb + 12); }
        REP(15) if (EN(15) && IN(pb + 13)) { PH_BEGIN; ph_ret_kv(Cq); SEAM(pb + 13); }
        REP(16) if (EN(16) && IN(pb + 14)) { PH_BEGIN; ph_ret_prefix(Cq); SEAM(pb + 14); }
        REP(17) if (EN(17) && IN(pb + 15)) { PH_BEGIN; ph_ret_out(Cq, args.in[lq ? L3_GN : L1_GN]); SEAM(pb + 15); }
        REP(18) if (EN(18) && IN(pb + 16)) {
            PH_BEGIN;
            pg8::SchedPlain S; S.init(M / 256, 8, Cq.G, Cq.bid); S.A0 = (unsigned)(WS_MIX); S.B0 = (unsigned)(WS_WOUT + (size_t)(2 * lq + 1) * 8 * MiB); S.at = (unsigned)(256 * 2048 * 2); S.bt = (unsigned)(256 * 2048 * 2);
            pg8::EpiBf16 E; E.O = (bf16*)(ws + WS_P); E.ldc = D;
            pg8::gemm_phase<pg8::EpiBf16, pg8::SchedPlain, true, true>(Cq.lds, Cq.tid, (const char*)ws, 2048, 2048, 2048, S, E);
            SEAM(pb + 16);
        }
        REP(19) if (EN(19) && IN(pb + 17)) {
            PH_BEGIN; const float* nr = args.in[lq ? L3_NORMS : L1_NORMS];
            REP(25) { ph_ln(Cq, ws + WS_P, 0, nr, nr + D, nullptr, ws + WS_X8, args.in[lq ? L3_ROUTER : L1_ROUTER], true);
            __syncthreads(); }
            SEAM(pb + 17);
        }
        REP(20) if (EN(20) && IN(pb + 18)) { PH_BEGIN; ph_slots(Cq); SEAM(pb + 18); }
        REP(22) if (EN(22) && IN(pb + 20)) {
            PH_BEGIN;
            const int nT = __builtin_amdgcn_readfirstlane(((const int*)(ws + WS_CTL))[CW_NT]);
            pg8::SchedMoEg S; S.init(nT, 44, Cq.G, Cq.bid); S.B0 = (unsigned)(WS_MWGU); S.bt = (unsigned)(256 * 2048); S.be = (unsigned)(22 * MiB);
            S.xoff = (unsigned)WS_X8; S.zoff = (unsigned)(WS_CTL + 512 * 1024); S.texp = (const int*)(ws + WS_CTL) + CW_TEXP; S.slot_tok = (const int*)(ws + WS_SLOTTOK);
            pg8::EpiSwiglu8 E; E.O = ws + WS_HIDM; E.ldc = DFF; E.inv = 1.0f / 16384.0f; E.so = 32.0f;
            pg8::gemm_phase<pg8::EpiSwiglu8, pg8::SchedMoEg, true, true, true>(Cq.lds, Cq.tid, (const char*)ws, 1024, 1024, 1024, S, E);
            SEAM(pb + 20);
        }
        REP(23) if (EN(23) && IN(pb + 21)) {
            PH_BEGIN;
            const int nT = __builtin_amdgcn_readfirstlane(((const int*)(ws + WS_CTL))[CW_NT]);
            pg8::SchedMoE S; S.init(nT, 8, Cq.G, Cq.bid); S.A0 = (unsigned)(WS_HIDM); S.B0 = (unsigned)(WS_MWD); S.at = (unsigned)(256 * DFF); S.bt = (unsigned)(256 * DFF); S.be = (unsigned)(11 * MiB);
            S.texp = (const int*)(ws + WS_CTL) + CW_TEXP;
            pg8::EpiFp8S E; E.O = ws + WS_XPERM; E.ldc = D; E.sc = 1.0f / 256.0f;
            pg8::gemm_phase<pg8::EpiFp8S, pg8::SchedMoE, true, true, true>(Cq.lds, Cq.tid, (const char*)ws, DFF / 2, DFF / 2, DFF / 2, S, E);
            SEAM(pb + 21);
        }
        REP(24) if (EN(24) && IN(pb + 22)) {
            PH_BEGIN; const float* nr = args.in[lq ? L3_NORMS : L1_NORMS];
            ph_ln(Cq, ws + WS_XPERM, 2, nr + 2 * D, nr + 3 * D, lq == 1 ? args.out : nullptr, nullptr, nullptr, false);
            SEAM(pb + 22);
        }
    }
#undef IN
#undef SEAM
}

#ifndef MK_PER_PHASE
#define MK_PER_PHASE 0
#endif
extern "C" void kernel_launch(void* const* d_in, const int* in_sizes, int n_in, void* d_out, int out_size, void* d_ws, size_t ws_size, hipStream_t stream) {
    static int ready = 0;
    if (ready == 0) {
        ready = 1;
        if (n_in != 43 || out_size != M * D || ws_size < WS_END) { fprintf(stderr, "kernel_launch: unexpected problem (n_in %d out %d ws %zu need %zu)\n", n_in, out_size, ws_size, (size_t)WS_END); ready = -1; }
        else if (hipFuncSetAttribute((const void*)fwd_kernel, hipFuncAttributeMaxDynamicSharedMemorySize, LDS_BYTES) != hipSuccess) { fprintf(stderr, "kernel_launch: hipFuncSetAttribute failed\n"); ready = -1; }
        (void)hipGetLastError();
    }
    if (ready < 0) return;
    (void)hipMemsetAsync((char*)d_ws + WS_CTL, 0, CTL_BYTES, stream);
    Args a{};
    for (int i = 0; i < 43; ++i) a.in[i] = (const float*)d_in[i];
    a.out = (float*)d_out; a.ws = (unsigned char*)d_ws;
#if MK_PER_PHASE
    for (int p = 0; p < NPH; ++p) { a.ph_lo = p; a.ph_hi = p + 1; hipLaunchKernelGGL(fwd_kernel, dim3(GRID), dim3(NTHR), LDS_BYTES, stream, a); }
#else
    a.ph_lo = 0; a.ph_hi = NPH;
    hipLaunchKernelGGL(fwd_kernel, dim3(GRID), dim3(NTHR), LDS_BYTES, stream, a);
#endif
}
```

```cpp
#include <hip/hip_runtime.h>
#include <cstdio>
#include <cstdint>

#define LAS __attribute__((address_space(3)))
#define GAS __attribute__((address_space(1)))
typedef unsigned short bf16;
typedef short bf16x8 __attribute__((ext_vector_type(8)));
typedef float f32x4 __attribute__((ext_vector_type(4)));
typedef float f32x2 __attribute__((ext_vector_type(2)));
typedef unsigned u32x4 __attribute__((ext_vector_type(4)));
typedef unsigned u32x2 __attribute__((ext_vector_type(2)));

constexpr int M = 32768, D = 2048, SEQ = 2048, NB = 16;
constexpr int SW = 1536;
constexpr int LDP_RW = 5632, LDP_RET = 5120;
constexpr int DFF = 5632;
constexpr int NSLOT = 67584;
constexpr float ALPHA = 1.6817928305074290f;
constexpr float LN_EPS = 1e-5f;
constexpr int NWAVES = 8, NTHR = 512, GRID = 256;

constexpr size_t MiB = 1u << 20;
constexpr size_t WS_CTL = 0, CTL_BYTES = 1 * MiB;
constexpr size_t WS_WKV = 1 * MiB;
constexpr size_t WS_WIN = WS_WKV + 4 * MiB;
constexpr size_t WS_WOUT = WS_WIN + 88 * MiB;
constexpr size_t WS_WLORA = WS_WOUT + 32 * MiB;
constexpr size_t WS_WFGU = WS_WLORA + 6 * MiB;
constexpr size_t WS_WFD = WS_WFGU + 88 * MiB;
constexpr size_t WS_MEMB = WS_WFD + 44 * MiB;
constexpr size_t WS_MEMK = WS_MEMB + 16 * MiB;
constexpr size_t WS_MEMVT = WS_MEMK + 4 * MiB;
constexpr size_t WS_CS = WS_MEMVT + 4 * MiB;
constexpr size_t WS_XB = WS_CS + 16 * MiB;
constexpr size_t WS_MIX = WS_XB + 128 * MiB;
constexpr size_t WS_VFIRST = WS_MIX + 128 * MiB;
constexpr size_t WS_P = WS_VFIRST + 96 * MiB;
constexpr size_t WS_MISC = WS_P + 352 * MiB;
constexpr size_t WS_ROUTE = WS_MISC, WS_SLOT1 = WS_MISC + 512 * 1024, WS_SLOT2 = WS_SLOT1 + 128 * 1024, WS_SLOTTOK = WS_SLOT2 + 128 * 1024;
constexpr size_t WS_BONUS = WS_MISC + 2 * MiB;
constexpr size_t WS_SB = WS_BONUS + 3 * MiB;
constexpr size_t WS_ALORA = WS_SB, WS_LORAOUT = WS_SB + 32 * MiB, WS_SCANIN = WS_SB + 416 * MiB;
constexpr size_t WS_QR = WS_SB, WS_KR = WS_SB + 48 * MiB, WS_KDT = WS_SB + 96 * MiB, WS_VT = WS_SB + 144 * MiB, WS_KVT = WS_SB + 240 * MiB, WS_RTB = WS_SB + 432 * MiB;
constexpr size_t WS_HID = WS_SB;
constexpr size_t WS_XPERM = WS_SB, WS_HIDM = WS_SB + 264 * MiB, WS_MWGU = WS_SB + 1184 * MiB, WS_MWD = WS_SB + 1360 * MiB;
constexpr size_t WS_XLO = WS_SB + 1518 * MiB;
constexpr size_t WS_X8 = WS_XLO + 64 * MiB;
constexpr size_t WS_END = WS_X8 + 64 * MiB;
constexpr int CW_BAR = 4096;
constexpr int CW_CNT = 16384;
constexpr int CW_NT = 20480;
constexpr int CW_TEXP = 20544;

constexpr int RING_BYTES = 131072;
constexpr int LDS_MISC = RING_BYTES;
constexpr int LDS_BYTES = RING_BYTES + 8192;

#define LDS_WAIT() asm volatile("s_waitcnt lgkmcnt(0)" ::: "memory")
#define VM_WAIT() asm volatile("s_waitcnt vmcnt(0)" ::: "memory")
__device__ __forceinline__ unsigned cvt_pk_bf16(float lo, float hi) { unsigned r; asm volatile("v_cvt_pk_bf16_f32 %0, %1, %2" : "=v"(r) : "v"(lo), "v"(hi)); return r; }
__device__ __forceinline__ bf16 f2bf(float f) { return (bf16)(cvt_pk_bf16(f, 0.f) & 0xffffu); }
__device__ __forceinline__ float bf2f(bf16 b) { return __uint_as_float(((unsigned)b) << 16); }
__device__ __forceinline__ float bflo(unsigned w) { return __uint_as_float(w << 16); }
__device__ __forceinline__ float bfhi(unsigned w) { return __uint_as_float(w & 0xffff0000u); }
template <int CTRL> __device__ __forceinline__ float dpp_add(float x) {
    int y = __builtin_amdgcn_update_dpp(0, __float_as_int(x), CTRL, 0xf, 0xf, true);
    return x + __int_as_float(y);
}
__device__ __forceinline__ float row16_sum(float x) { x = dpp_add<0xB1>(x); x = dpp_add<0x4E>(x); x = dpp_add<0x141>(x); x = dpp_add<0x140>(x); return x; }
__device__ __forceinline__ float wave_sum(float v) {
    v = row16_sum(v);
    const float a = __int_as_float(__builtin_amdgcn_readlane(__float_as_int(v), 0)), b = __int_as_float(__builtin_amdgcn_readlane(__float_as_int(v), 16));
    const float c = __int_as_float(__builtin_amdgcn_readlane(__float_as_int(v), 32)), d = __int_as_float(__builtin_amdgcn_readlane(__float_as_int(v), 48));
    return (a + b) + (c + d);
}
__device__ __forceinline__ unsigned pk4_fp8(float a, float b, float c, float d) {
    a = __builtin_amdgcn_fmed3f(a, -448.f, 448.f); b = __builtin_amdgcn_fmed3f(b, -448.f, 448.f); c = __builtin_amdgcn_fmed3f(c, -448.f, 448.f); d = __builtin_amdgcn_fmed3f(d, -448.f, 448.f);
    unsigned w = 0; w = __builtin_amdgcn_cvt_pk_fp8_f32(a, b, w, false); w = __builtin_amdgcn_cvt_pk_fp8_f32(c, d, w, true); return w; }
__device__ __forceinline__ float sigmoidf_(float z) { return __builtin_amdgcn_rcpf(1.0f + __expf(-z)); }

__device__ __forceinline__ unsigned char* opq(unsigned char* p) { asm volatile("" : "+s"(p)); return p; }
__device__ __forceinline__ int opq_i(int v) { asm volatile("" : "+s"(v)); return v; }
__device__ __forceinline__ int opq_v(int v) { asm volatile("" : "+v"(v)); return v; }
__device__ __forceinline__ int lane_id_asm() { int l; asm volatile("v_mbcnt_lo_u32_b32 %0, -1, 0\n\tv_mbcnt_hi_u32_b32 %0, -1, %0" : "=v"(l)); return l; }
#define XB_TMO      128
#define XB_XCNT(j)  (256  + 64 * (j))
#define XB_XSUB(j)  (1280 + 64 * (j))
#define XB_XGEN(j)  (2304 + 64 * (j))
#define XB_TOP      3328
#define XB_TOPGEN   3392
#define XCD_BAR_WORDS 3456
#define XB_SPIN_CAP (1u << 18)
__device__ __forceinline__ unsigned xb_ld(unsigned* p)              { return __hip_atomic_load(p, __ATOMIC_RELAXED, __HIP_MEMORY_SCOPE_AGENT); }
__device__ __forceinline__ unsigned xb_add(unsigned* p, unsigned v) { return __hip_atomic_fetch_add(p, v, __ATOMIC_RELAXED, __HIP_MEMORY_SCOPE_AGENT); }
__device__ __forceinline__ unsigned xb_xcc_id() { return (unsigned)__builtin_amdgcn_s_getreg((3 << 11) | 20) & 0xFu; }
#define XB_SPIN(cond, bar) do { unsigned _sp = 0; while (cond) { __builtin_amdgcn_s_sleep(1); \
    if ((++_sp & 255u) == 0u) { if (xb_ld(&(bar)[XB_TMO])) break; if (_sp > XB_SPIN_CAP) { atomicAdd(&(bar)[XB_TMO], 1u); break; } } } } while (0)
struct XcdBarrier { unsigned* bar; unsigned x; volatile LAS unsigned* st; };
__device__ __forceinline__ XcdBarrier xcd_barrier_post(unsigned* bar, volatile LAS unsigned* st) {
    XcdBarrier b; b.bar = bar; b.x = xb_xcc_id(); b.st = st;
    if (threadIdx.x == 0) (void)xb_add(&bar[XB_XCNT(b.x)], 1u);
    return b;
}
__device__ __forceinline__ void xcd_barrier_complete(unsigned* bar, unsigned x, unsigned& nloc, unsigned& nx) {
    const unsigned G = gridDim.x * gridDim.y * gridDim.z;
    unsigned sum, cnt, mine, sp = 0u;
    for (;;) {
        sum = 0u; cnt = 0u; mine = 0u;
#pragma unroll
        for (unsigned j = 0; j < 16; ++j) { const unsigned c = xb_ld(&bar[XB_XCNT(j)]); sum += c; cnt += (c > 0u) ? 1u : 0u; mine = (j == x) ? c : mine; }
        if (sum == G) break;
        __builtin_amdgcn_s_sleep(1);
        if ((++sp & 255u) == 0u) { if (xb_ld(&bar[XB_TMO])) break; if (sp > XB_SPIN_CAP) { atomicAdd(&bar[XB_TMO], 1u); break; } }
    }
    nloc = mine > 0u ? mine : 1u; nx = cnt > 0u ? cnt : 1u;
}
__device__ __forceinline__ void xcd_barrier(const XcdBarrier& b, const bool leader  ) {
    asm volatile("s_waitcnt vmcnt(0)" ::: "memory");
    __syncthreads();
    if (leader) {
        unsigned* bar = b.bar;
        __builtin_amdgcn_s_waitcnt(0);
        unsigned nloc = b.st[0], nx = b.st[1];
        if (nloc == 0u) { xcd_barrier_complete(bar, b.x, nloc, nx); b.st[0] = nloc; b.st[1] = nx; }
        const unsigned old = xb_add(&bar[XB_XSUB(b.x)], 1u);
        const unsigned gen = old / nloc;
        if (old + 1u == (gen + 1u) * nloc) {
            __builtin_amdgcn_fence(__ATOMIC_RELEASE, "agent");
            asm volatile("s_waitcnt vmcnt(0)" ::: "memory");
            const unsigned og = xb_add(&bar[XB_TOP], 1u);
            const unsigned tg = og / nx;
            if (og + 1u == (tg + 1u) * nx) xb_add(&bar[XB_TOPGEN], 1u);
            else XB_SPIN(xb_ld(&bar[XB_TOPGEN]) == tg, bar);
            __builtin_amdgcn_fence(__ATOMIC_ACQUIRE, "agent");
            xb_add(&bar[XB_XGEN(b.x)], 1u);
            asm volatile("s_waitcnt vmcnt(0)" ::: "memory");
        } else {
            XB_SPIN(xb_ld(&bar[XB_XGEN(b.x)]) == gen, bar);
            __builtin_amdgcn_fence(__ATOMIC_ACQUIRE, "agent");
            asm volatile("s_waitcnt vmcnt(0)" ::: "memory");
        }
    }
    __syncthreads();
}

namespace pg8 {
constexpr int BM = 256, BK = 64, HALF = 128, HTB = HALF * BK * 2, STAGE_BYTES = 8 * HTB, NXCD = 8, WGM = 8;
__host__ __device__ __forceinline__ int lds_byte(int r, int c) { const int st = (r >> 4) * 2 + (c >> 5), rr = r & 15, cc = c & 31, ob = rr * 64 + cc * 2; return st * 1024 + (ob ^ (((ob >> 9) & 1) << 5)); }
__host__ __device__ __forceinline__ void stage_rc(int b, int& R, int& C) { const int st = b / 1024, sb = b % 1024, swz = sb ^ (((sb >> 9) & 1) << 5); R = (st >> 1) * 16 + swz / 64; C = (st & 1) * 32 + (swz % 64) / 2; }
__host__ __device__ __forceinline__ int perm32(int rho) { const int n = rho >> 4, i = rho & 15; return 8 * (i >> 2) + 4 * n + (i & 3); }
typedef int i32x8 __attribute__((ext_vector_type(8)));
typedef int i32x4_ __attribute__((ext_vector_type(4)));
__device__ __forceinline__ i32x8 cat8(bf16x8 a, bf16x8 b) { const i32x4_ x = __builtin_bit_cast(i32x4_, a), y = __builtin_bit_cast(i32x4_, b); return __builtin_shufflevector(x, y, 0, 1, 2, 3, 4, 5, 6, 7); }
__device__ __forceinline__ void mfma8(f32x4& acc, const i32x8 a, const i32x8 b) {
    asm volatile("v_mfma_scale_f32_16x16x128_f8f6f4 %0, %1, %2, %0, %3, %3 op_sel_hi:[0,0,0]" : "+v"(acc) : "v"(a), "v"(b), "v"(127)); }
struct Unit { int pm, pn, z; };
struct Order {
    int nM, nN, nwg, G, c;
    __device__ __forceinline__ void init(int nM_, int nN_, int G_, int c_) { nM = nM_; nN = nN_; nwg = nM * nN; G = G_; c = c_; }
    __device__ __forceinline__ bool next_mn(int i, Unit& u) const {
        const long L = (long)i * G + c; if (L >= nwg) return false;
        int wgid = (int)L; { const int q = nwg / NXCD, r = nwg % NXCD, xcd = wgid % NXCD, off = wgid / NXCD; wgid = (xcd < r ? xcd * (q + 1) : r * (q + 1) + (xcd - r) * q) + off; }
        const int nig = WGM * nN, gid = wgid / nig, fm = gid * WGM, gsz = (nM - fm) < WGM ? (nM - fm) : WGM;
        u.pm = fm + ((wgid % nig) % gsz); u.pn = (wgid % nig) / gsz; u.z = 0; return true;
    }
};

template <class Epi, class Sched, bool ALIGN_EPI, bool SP2, bool FP8 = false>
__device__ __forceinline__ void gemm_phase(LAS unsigned char* lds, const int tid_in, const char* base  , const int lda, const int ldb, const int K, const Sched& S, const Epi& E) {
    const int tid = tid_in, wid = __builtin_amdgcn_readfirstlane(tid >> 6), lane = tid & 63, wr = wid >> 2, wc = wid & 3, fr = lane & 15, fq = lane >> 4;
    const int nt = K / BK;
    unsigned voffA[2], voffB[2];
#pragma unroll
    for (int i = 0; i < 2; ++i) { int R, C; stage_rc(tid * 16 + i * 8192, R, C); const int Rb = Epi::PERM ? ((R & ~31) + perm32(R & 31)) : R;
        voffA[i] = (unsigned)(R * lda + C) * 2u; voffB[i] = (unsigned)(Rb * ldb + C) * 2u; }
    constexpr bool GATHER = Sched::GATHER;
    unsigned gvC[2][2], gvN[2][2];
#define PG8_GV(dst, unit) do { _Pragma("unroll") for (int hh_ = 0; hh_ < 2; ++hh_) _Pragma("unroll") for (int i_ = 0; i_ < 2; ++i_) { int R_, C_; stage_rc(tid * 16 + i_ * 8192, R_, C_); \
        dst[hh_][i_] = S.arow(unit, hh_ * HALF + R_) + (unsigned)C_ * 2u; } } while (0)
    const unsigned kstep = (unsigned)(BK * 2);
    const unsigned hstepA = (unsigned)(HALF * lda * 2), hstepB = (unsigned)(HALF * ldb * 2);
    const __amdgpu_buffer_rsrc_t rsrc = __builtin_amdgcn_make_buffer_rsrc((void*)base, 0, 0xffffffffu, 0x00020000);
    const unsigned ldsw = (unsigned)wid * 1024u;
    const int aoff = lds_byte(wr * 64 + fr, fq * 8), boff = lds_byte(wc * 32 + fr, fq * 8);
#define PG8_SA(b, h) (((b) * 2 + (h)) * HTB)
#define PG8_SB(b, h) ((4 + (b) * 2 + (h)) * HTB)
#define PG8_STAGE(bufoff, goff, voff) do { _Pragma("unroll") for (int _i = 0; _i < 2; ++_i) \
        __builtin_amdgcn_raw_ptr_buffer_load_lds(rsrc, (LAS unsigned*)(lds + (bufoff) + ldsw + _i * 8192), 16, (voff)[_i], (goff), 0, 0); } while (0)
#define PG8_STAGE_A(bufoff, aoff, hh, nx) do { if constexpr (GATHER) { unsigned gv_[2]; gv_[0] = (nx) ? gvN[hh][0] : gvC[hh][0]; gv_[1] = (nx) ? gvN[hh][1] : gvC[hh][1]; PG8_STAGE(bufoff, aoff, gv_); } \
        else { PG8_STAGE(bufoff, (aoff) + (hh) * hstepA, voffA); } } while (0)
#define PG8_LDA(dst, b, h) do { _Pragma("unroll") for (int m = 0; m < 4; ++m) _Pragma("unroll") for (int k = 0; k < 2; ++k) dst[m][k] = *(const LAS bf16x8*)(lds + PG8_SA(b, h) + aoff + m * 2048 + k * 1024); } while (0)
#define PG8_LDB(dst, b, h) do { _Pragma("unroll") for (int n = 0; n < 2; ++n) _Pragma("unroll") for (int k = 0; k < 2; ++k) dst[n][k] = *(const LAS bf16x8*)(lds + PG8_SB(b, h) + boff + n * 2048 + k * 1024); } while (0)
#define PG8_MMA(ai, bj, At, Bt) do { __builtin_amdgcn_s_setprio(1); \
        if constexpr (FP8) { _Pragma("unroll") for (int m = 0; m < 4; ++m) _Pragma("unroll") for (int n = 0; n < 2; ++n) \
            mfma8(acc[ai][bj][m][n], cat8(Bt[n][0], Bt[n][1]), cat8(At[m][0], At[m][1])); } \
        else { _Pragma("unroll") for (int m = 0; m < 4; ++m) _Pragma("unroll") for (int n = 0; n < 2; ++n) _Pragma("unroll") for (int k = 0; k < 2; ++k) \
            acc[ai][bj][m][n] = __builtin_amdgcn_mfma_f32_16x16x32_bf16(Bt[n][k], At[m][k], acc[ai][bj][m][n], 0, 0, 0); } \
        __builtin_amdgcn_s_setprio(0); } while (0)
#define PG8_WAIT_V(n) asm volatile("s_waitcnt vmcnt(" #n ")" ::: "memory")
#define PG8_WAIT_L(n) asm volatile("s_waitcnt lgkmcnt(" #n ")" ::: "memory")
#define PG8_BAR __builtin_amdgcn_s_barrier()
#define PG8_SCHED __builtin_amdgcn_sched_barrier(0)
    Unit cur, nxt; int ui = 0;
    if (!S.next(0, cur)) return;
    f32x4 acc[2][2][4][2];
#pragma unroll
    for (int a = 0; a < 2; ++a)
#pragma unroll
        for (int b = 0; b < 2; ++b)
#pragma unroll
            for (int m = 0; m < 4; ++m)
#pragma unroll
                for (int n = 0; n < 2; ++n) acc[a][b][m][n] = (f32x4){0.f, 0.f, 0.f, 0.f};
    bf16x8 At[4][2], B0[2][2], B1[2][2];
    unsigned cA = S.A(cur), cB = S.B(cur);
    if constexpr (GATHER) { PG8_GV(gvC, cur); _Pragma("unroll") for (int hh_ = 0; hh_ < 2; ++hh_) _Pragma("unroll") for (int i_ = 0; i_ < 2; ++i_) gvN[hh_][i_] = gvC[hh_][i_]; }
    if constexpr (SP2) {
        PG8_STAGE(PG8_SB(0, 0), cB, voffB); PG8_STAGE(PG8_SB(0, 1), cB + hstepB, voffB); PG8_STAGE_A(PG8_SA(0, 0), cA, 0, false); PG8_STAGE_A(PG8_SA(0, 1), cA, 1, false);
        if (wr == 1) PG8_BAR;
        PG8_WAIT_V(2); PG8_BAR;
        PG8_STAGE(PG8_SB(1, 0), cB + kstep, voffB); PG8_STAGE_A(PG8_SA(1, 0), cA + kstep, 0, false); PG8_STAGE(PG8_SB(1, 1), cB + hstepB + kstep, voffB);
        PG8_WAIT_V(6); PG8_BAR;
    } else {
        PG8_STAGE(PG8_SB(0, 0), cB, voffB); PG8_STAGE_A(PG8_SA(0, 0), cA, 0, false); PG8_STAGE(PG8_SB(0, 1), cB + hstepB, voffB); PG8_STAGE_A(PG8_SA(0, 1), cA, 1, false);
        if (wr == 1) PG8_BAR;
        PG8_WAIT_V(4); PG8_BAR;
        PG8_STAGE(PG8_SB(1, 0), cB + kstep, voffB); PG8_STAGE_A(PG8_SA(1, 0), cA + kstep, 0, false); PG8_STAGE(PG8_SB(1, 1), cB + hstepB + kstep, voffB);
        PG8_WAIT_V(6); PG8_BAR;
    }
    for (;;) {
        const bool has_next = S.next(ui + 1, nxt);
        const unsigned nA = has_next ? S.A(nxt) : cA, nB = has_next ? S.B(nxt) : cB;
        if constexpr (GATHER) { if (has_next) PG8_GV(gvN, nxt); }
        for (int t = 0; t < nt; t += 2) {
            const bool last = (t == nt - 2);
            const unsigned a1 = cA + (unsigned)(t + 1) * kstep;
            const unsigned a2 = last ? nA : cA + (unsigned)(t + 2) * kstep, b2 = last ? nB : cB + (unsigned)(t + 2) * kstep;
            const unsigned a3 = a2 + kstep, b3 = b2 + kstep;
            if constexpr (SP2) {
            PG8_LDB(B0, 0, 0); PG8_LDB(B1, 0, 1); PG8_SCHED; PG8_LDA(At, 0, 0); PG8_STAGE_A(PG8_SA(1, 1), a1, 1, false);
            PG8_WAIT_V(8); PG8_WAIT_L(0); PG8_BAR; PG8_MMA(0, 0, At, B0); PG8_MMA(0, 1, At, B1); PG8_BAR; PG8_SCHED;
            PG8_LDA(At, 0, 1); PG8_STAGE(PG8_SB(0, 0), b2, voffB); PG8_STAGE(PG8_SB(0, 1), b2 + hstepB, voffB); PG8_STAGE_A(PG8_SA(0, 0), a2, 0, last);
            PG8_WAIT_V(8); PG8_WAIT_L(0); PG8_BAR; PG8_MMA(1, 0, At, B0); PG8_MMA(1, 1, At, B1); PG8_BAR; PG8_SCHED;
            PG8_LDB(B0, 1, 0); PG8_LDB(B1, 1, 1); PG8_SCHED; PG8_LDA(At, 1, 0); PG8_STAGE_A(PG8_SA(0, 1), a2, 1, last);
            PG8_WAIT_V(8); PG8_WAIT_L(0); PG8_BAR; PG8_MMA(0, 0, At, B0); PG8_MMA(0, 1, At, B1); PG8_BAR; PG8_SCHED;
            PG8_LDA(At, 1, 1); PG8_STAGE(PG8_SB(1, 0), b3, voffB); PG8_STAGE(PG8_SB(1, 1), b3 + hstepB, voffB); PG8_STAGE_A(PG8_SA(1, 0), a3, 0, last);
            PG8_WAIT_V(8); PG8_WAIT_L(0); PG8_BAR; PG8_MMA(1, 0, At, B0); PG8_MMA(1, 1, At, B1); PG8_BAR; PG8_SCHED;
            } else {
            PG8_LDB(B0, 0, 0); PG8_SCHED; PG8_LDA(At, 0, 0); PG8_STAGE_A(PG8_SA(1, 1), a1, 1, false);
            PG8_WAIT_L(8); PG8_BAR; PG8_WAIT_L(0); PG8_MMA(0, 0, At, B0); PG8_BAR; PG8_SCHED;
            PG8_LDB(B1, 0, 1); PG8_STAGE(PG8_SB(0, 0), b2, voffB);
            PG8_BAR; PG8_WAIT_L(0); PG8_MMA(0, 1, At, B1); PG8_BAR;
            PG8_LDA(At, 0, 1); PG8_STAGE_A(PG8_SA(0, 0), a2, 0, last);
            PG8_BAR; PG8_WAIT_L(0); PG8_MMA(1, 0, At, B0); PG8_BAR; PG8_SCHED;
            PG8_STAGE(PG8_SB(0, 1), b2 + hstepB, voffB);
            PG8_WAIT_V(6); PG8_BAR; PG8_MMA(1, 1, At, B1); PG8_BAR;
            PG8_LDB(B0, 1, 0); PG8_SCHED; PG8_LDA(At, 1, 0); PG8_STAGE_A(PG8_SA(0, 1), a2, 1, last);
            PG8_WAIT_L(8); PG8_BAR; PG8_WAIT_L(0); PG8_MMA(0, 0, At, B0); PG8_BAR; PG8_SCHED;
            PG8_LDB(B1, 1, 1); PG8_STAGE(PG8_SB(1, 0), b3, voffB);
            PG8_BAR; PG8_WAIT_L(0); PG8_MMA(0, 1, At, B1); PG8_BAR;
            PG8_LDA(At, 1, 1); PG8_STAGE_A(PG8_SA(1, 0), a3, 0, last);
            PG8_BAR; PG8_WAIT_L(0); PG8_MMA(1, 0, At, B0); PG8_BAR; PG8_SCHED;
            PG8_STAGE(PG8_SB(1, 1), b3 + hstepB, voffB);
            PG8_WAIT_V(6); PG8_BAR; PG8_MMA(1, 1, At, B1); PG8_BAR;
            }
        }
        if constexpr (ALIGN_EPI) { if (wr == 0) PG8_BAR; }
        if constexpr (FP8) asm volatile("s_nop 15\n\ts_nop 15\n\ts_nop 7" ::: "memory");
        E(acc, cur, wr, wc, fr, fq);
        if (!has_next) break;
#pragma unroll
        for (int a = 0; a < 2; ++a)
#pragma unroll
            for (int b = 0; b < 2; ++b)
#pragma unroll
                for (int m = 0; m < 4; ++m)
#pragma unroll
                    for (int n = 0; n < 2; ++n) acc[a][b][m][n] = (f32x4){0.f, 0.f, 0.f, 0.f};
        cur = nxt; cA = nA; cB = nB; ++ui;
        if constexpr (GATHER) { _Pragma("unroll") for (int hh_ = 0; hh_ < 2; ++hh_) _Pragma("unroll") for (int i_ = 0; i_ < 2; ++i_) gvC[hh_][i_] = gvN[hh_][i_]; }
        if constexpr (ALIGN_EPI) { if (wr == 1) PG8_BAR; }
    }
    PG8_WAIT_V(0);
    if constexpr (!ALIGN_EPI) { if (wr == 0) PG8_BAR; }
    PG8_BAR;
#undef PG8_SA
#undef PG8_SB
#undef PG8_STAGE
#undef PG8_STAGE_A
#undef PG8_GV
#undef PG8_LDA
#undef PG8_LDB
#undef PG8_MMA
#undef PG8_WAIT_V
#undef PG8_WAIT_L
#undef PG8_BAR
#undef PG8_SCHED
}

struct SchedPlain : Order {
    static constexpr bool GATHER = false; __device__ __forceinline__ unsigned arow(const Unit&, int) const { return 0u; }
    unsigned A0, B0, at, bt;
    __device__ __forceinline__ bool next(int i, Unit& u) const { return next_mn(i, u); }
    __device__ __forceinline__ unsigned A(const Unit& u) const { return A0 + (unsigned)u.pm * at; }
    __device__ __forceinline__ unsigned B(const Unit& u) const { return B0 + (unsigned)u.pn * bt; }
};
struct SchedLora : Order {
    static constexpr bool GATHER = false; __device__ __forceinline__ unsigned arow(const Unit&, int) const { return 0u; }
    unsigned A0, B0; int skipv;
    __device__ __forceinline__ bool next(int i, Unit& u) const { if (!next_mn(i, u)) return false; if (skipv && u.pn >= 12) u.pn += 6; return true; }
    __device__ __forceinline__ unsigned A(const Unit& u) const { return A0 + (unsigned)u.pm * (256u * 512u * 2u) + (u.pn >= 18 ? 512u : 0u); }
    __device__ __forceinline__ unsigned B(const Unit& u) const { return B0 + (unsigned)u.pn * (256u * 256u * 2u); }
};
struct SchedMem {
    static constexpr bool GATHER = false; __device__ __forceinline__ unsigned arow(const Unit&, int) const { return 0u; }
    int G, c; unsigned memb, wkv;
    __device__ __forceinline__ bool next(int i, Unit& u) const {
        const int L = i * G + c; if (L >= 64) return false;
        if (L < 32) { u.z = 0; u.pm = L >> 1; u.pn = L & 1; } else { const int q = L - 32; u.z = 1; u.pm = q & 1; u.pn = q >> 1; }
        return true;
    }
    __device__ __forceinline__ unsigned A(const Unit& u) const { return u.z == 0 ? memb + (unsigned)u.pm * (256u * 2048u * 2u) : wkv + (unsigned)(2 + u.pm) * (256u * 2048u * 2u); }
    __device__ __forceinline__ unsigned B(const Unit& u) const { return u.z == 0 ? wkv + (unsigned)u.pn * (256u * 2048u * 2u) : memb + (unsigned)u.pn * (256u * 2048u * 2u); }
};
struct SchedMoE : Order {
    static constexpr bool GATHER = false; __device__ __forceinline__ unsigned arow(const Unit&, int) const { return 0u; }
    unsigned A0, B0, at, bt, be; const int* texp;
    __device__ __forceinline__ bool next(int i, Unit& u) const { if (!next_mn(i, u)) return false; u.z = __builtin_amdgcn_readfirstlane(texp[u.pm]); return true; }
    __device__ __forceinline__ unsigned A(const Unit& u) const { return A0 + (unsigned)u.pm * at; }
    __device__ __forceinline__ unsigned B(const Unit& u) const { return B0 + (unsigned)u.z * be + (unsigned)u.pn * bt; }
};

struct SchedMoEg : Order {
    static constexpr bool GATHER = true;
    unsigned B0, bt, be, xoff, zoff; const int* texp; const int* slot_tok;
    __device__ __forceinline__ bool next(int i, Unit& u) const { if (!next_mn(i, u)) return false; u.z = __builtin_amdgcn_readfirstlane(texp[u.pm]); return true; }
    __device__ __forceinline__ unsigned A(const Unit&) const { return 0u; }
    __device__ __forceinline__ unsigned B(const Unit& u) const { return B0 + (unsigned)u.z * be + (unsigned)u.pn * bt; }
    __device__ __forceinline__ unsigned arow(const Unit& u, int r) const { const int tok = slot_tok[u.pm * 256 + r]; return tok < 0 ? zoff : xoff + (unsigned)tok * 2048u; }
};

struct EpiBf16 {
    static constexpr bool PERM = true;
    bf16* O; int ldc;
    __device__ __forceinline__ void operator()(const f32x4 (&acc)[2][2][4][2], const Unit& u, int wr, int wc, int fr, int fq) const {
        const int row0 = u.pm * BM + wr * 64 + fr, col0 = u.pn * BM + wc * 32 + 8 * fq;
#pragma unroll
        for (int ai = 0; ai < 2; ++ai)
#pragma unroll
            for (int m = 0; m < 4; ++m) { bf16* rowp = O + (size_t)(row0 + ai * HALF + m * 16) * ldc + col0;
#pragma unroll
                for (int bj = 0; bj < 2; ++bj) { const f32x4 v0 = acc[ai][bj][m][0], v1 = acc[ai][bj][m][1];
                    u32x4 w; w.x = cvt_pk_bf16(v0[0], v0[1]); w.y = cvt_pk_bf16(v0[2], v0[3]); w.z = cvt_pk_bf16(v1[0], v1[1]); w.w = cvt_pk_bf16(v1[2], v1[3]);
                    *(u32x4*)(rowp + bj * HALF) = w; } }
    }
};
struct EpiMem {
    static constexpr bool PERM = true;
    bf16* O0; bf16* O1;
    __device__ __forceinline__ void operator()(const f32x4 (&acc)[2][2][4][2], const Unit& u, int wr, int wc, int fr, int fq) const {
        EpiBf16 e; e.O = u.z == 0 ? O0 : O1; e.ldc = u.z == 0 ? 512 : 4096; e(acc, u, wr, wc, fr, fq);
    }
};
struct EpiLora {
    static constexpr bool PERM = true;
    bf16* O; const float* vecs;
    __device__ __forceinline__ void operator()(const f32x4 (&acc)[2][2][4][2], const Unit& u, int wr, int wc, int fr, int fq) const {
        const int type = u.pn / 6;
        const int row0 = u.pm * BM + wr * 64 + fr, col0 = u.pn * BM + wc * 32 + 8 * fq, cb0 = (u.pn % 6) * BM + wc * 32 + 8 * fq;
        const float* bp = vecs + (type < 3 ? type : 0) * SW;
        const float sc = type == 0 ? 0.6065306597126334f : 1.0f;
#pragma unroll
        for (int bj = 0; bj < 2; ++bj) {
            f32x4 bv0 = (f32x4){0.f, 0.f, 0.f, 0.f}, bv1 = bv0;
            if (type < 3) { bv0 = *(const f32x4*)(bp + cb0 + bj * HALF); bv1 = *(const f32x4*)(bp + cb0 + bj * HALF + 4); }
#pragma unroll
            for (int ai = 0; ai < 2; ++ai)
#pragma unroll
                for (int m = 0; m < 4; ++m) { bf16* rowp = O + (size_t)(row0 + ai * HALF + m * 16) * 6144 + col0 + bj * HALF;
                    f32x4 v0_ = acc[ai][bj][m][0] + bv0, v1_ = acc[ai][bj][m][1] + bv1;
                    if (type < 3) {
#pragma unroll
                        for (int j = 0; j < 4; ++j) { v0_[j] = sc * sigmoidf_(v0_[j]); v1_[j] = sc * sigmoidf_(v1_[j]); } }
                    u32x4 w; w.x = cvt_pk_bf16(v0_[0], v0_[1]); w.y = cvt_pk_bf16(v0_[2], v0_[3]); w.z = cvt_pk_bf16(v1_[0], v1_[1]); w.w = cvt_pk_bf16(v1_[2], v1_[3]);
                    *(u32x4*)rowp = w; asm volatile("" ::: "memory"); }
        }
    }
};
struct EpiSwiglu {
    static constexpr bool PERM = true;
    bf16* O; int ldc;
    __device__ __forceinline__ void operator()(const f32x4 (&acc)[2][2][4][2], const Unit& u, int wr, int wc, int fr, int fq) const {
        const int row0 = u.pm * BM + wr * 64 + fr, col0 = u.pn * HALF + wc * 32 + 8 * fq;
#pragma unroll
        for (int ai = 0; ai < 2; ++ai)
#pragma unroll
            for (int m = 0; m < 4; ++m) { bf16* rowp = O + (size_t)(row0 + ai * HALF + m * 16) * ldc + col0;
                float h[8];
#pragma unroll
                for (int n = 0; n < 2; ++n)
#pragma unroll
                    for (int j = 0; j < 4; ++j) { const float g = acc[ai][0][m][n][j], up = acc[ai][1][m][n][j]; h[n * 4 + j] = g * sigmoidf_(g) * up; }
                u32x4 w; w.x = cvt_pk_bf16(h[0], h[1]); w.y = cvt_pk_bf16(h[2], h[3]); w.z = cvt_pk_bf16(h[4], h[5]); w.w = cvt_pk_bf16(h[6], h[7]);
                *(u32x4*)rowp = w; asm volatile("" ::: "memory"); }
    }
};
struct EpiSwiglu8 {
    static constexpr bool PERM = true;
    unsigned char* O; int ldc; float inv, so;
    __device__ __forceinline__ void operator()(const f32x4 (&acc)[2][2][4][2], const Unit& u, int wr, int wc, int fr, int fq) const {
        const int row0 = u.pm * BM + wr * 64 + fr, col0 = u.pn * HALF + wc * 32 + 8 * fq;
        const float c1 = -inv * 1.4426950408889634f, c2 = inv * inv * so;
#pragma unroll
        for (int ai = 0; ai < 2; ++ai)
#pragma unroll
            for (int m = 0; m < 4; ++m) { unsigned char* rowp = O + (size_t)(row0 + ai * HALF + m * 16) * ldc + col0;
                float h[8];
#pragma unroll
                for (int n = 0; n < 2; ++n)
#pragma unroll
                    for (int j = 0; j < 4; ++j) { const float ag = acc[ai][0][m][n][j], au = acc[ai][1][m][n][j];
                        h[n * 4 + j] = (ag * au) * __builtin_amdgcn_rcpf(1.0f + __builtin_amdgcn_exp2f(ag * c1)) * c2; }
                u32x2 w; w.x = pk4_fp8(h[0], h[1], h[2], h[3]); w.y = pk4_fp8(h[4], h[5], h[6], h[7]);
                *(u32x2*)rowp = w; asm volatile("" ::: "memory"); }
    }
};
struct EpiBf16S {
    static constexpr bool PERM = true;
    bf16* O; int ldc; float sc;
    __device__ __forceinline__ void operator()(const f32x4 (&acc)[2][2][4][2], const Unit& u, int wr, int wc, int fr, int fq) const {
        const int row0 = u.pm * BM + wr * 64 + fr, col0 = u.pn * BM + wc * 32 + 8 * fq;
#pragma unroll
        for (int ai = 0; ai < 2; ++ai)
#pragma unroll
            for (int m = 0; m < 4; ++m) { bf16* rowp = O + (size_t)(row0 + ai * HALF + m * 16) * ldc + col0;
#pragma unroll
                for (int bj = 0; bj < 2; ++bj) { const f32x4 v0 = acc[ai][bj][m][0] * sc, v1 = acc[ai][bj][m][1] * sc;
                    u32x4 w; w.x = cvt_pk_bf16(v0[0], v0[1]); w.y = cvt_pk_bf16(v0[2], v0[3]); w.z = cvt_pk_bf16(v1[0], v1[1]); w.w = cvt_pk_bf16(v1[2], v1[3]);
                    *(u32x4*)(rowp + bj * HALF) = w; } }
    }
};
struct EpiFp8S {
    static constexpr bool PERM = true;
    unsigned char* O; int ldc; float sc;
    __device__ __forceinline__ void operator()(const f32x4 (&acc)[2][2][4][2], const Unit& u, int wr, int wc, int fr, int fq) const {
        const int row0 = u.pm * BM + wr * 64 + fr, col0 = u.pn * BM + wc * 32 + 8 * fq;
#pragma unroll
        for (int ai = 0; ai < 2; ++ai)
#pragma unroll
            for (int m = 0; m < 4; ++m) { unsigned char* rowp = O + (size_t)(row0 + ai * HALF + m * 16) * ldc + col0;
#pragma unroll
                for (int bj = 0; bj < 2; ++bj) { const f32x4 v0 = acc[ai][bj][m][0] * sc, v1 = acc[ai][bj][m][1] * sc;
                    u32x2 w; w.x = pk4_fp8(v0[0], v0[1], v0[2], v0[3]); w.y = pk4_fp8(v1[0], v1[1], v1[2], v1[3]);
                    *(u32x2*)(rowp + bj * HALF) = w; } }
    }
};
struct EpiRes {
    static constexpr bool PERM = false;
    const float* X; float* T;
    __device__ __forceinline__ void operator()(const f32x4 (&acc)[2][2][4][2], const Unit& u, int wr, int wc, int fr, int fq) const {
        const int row0 = u.pm * BM + wr * 64 + fr, col0 = u.pn * BM + wc * 32 + 4 * fq;
#pragma unroll
        for (int ai = 0; ai < 2; ++ai)
#pragma unroll
            for (int m = 0; m < 4; ++m) { const size_t off = (size_t)(row0 + ai * HALF + m * 16) * D + col0;
#pragma unroll
                for (int bj = 0; bj < 2; ++bj)
#pragma unroll
                    for (int n = 0; n < 2; ++n) { const f32x4 xv = *(const f32x4*)(X + off + bj * HALF + n * 16);
                        *(f32x4*)(T + off + bj * HALF + n * 16) = xv * ALPHA + acc[ai][bj][m][n]; } }
    }
};
}

struct Args {
    const float* in[43];
    float* out; unsigned char* ws;
    int ph_lo, ph_hi;
};
struct Ctx { LAS unsigned char* lds; int tid, lane, wave, bid, G, gw, NGW; unsigned char* ws; };

enum { I_X = 0, I_MEM = 1, I_POS = 2, I_WKV = 3,
       L0_WIN = 4, L0_MU, L0_LW, L0_LA, L0_LG, L0_VECS, L0_WOUT, L0_NORMS, L0_FG, L0_FU, L0_FD,
       L1_WIN = 15, L1_GN, L1_WOUT, L1_NORMS, L1_ROUTER, L1_MG, L1_MU_, L1_MD,
       L2_WIN = 23, L2_MU, L2_LW, L2_LA, L2_LV, L2_LG, L2_VECS, L2_WOUT, L2_NORMS, L2_FG, L2_FU, L2_FD,
       L3_WIN = 35, L3_GN, L3_WOUT, L3_NORMS, L3_ROUTER, L3_MG, L3_MU_, L3_MD };

__device__ __forceinline__ void tr_load(f32x4 (&v)[8], const float* W, int ldw, int k0, int n0, int lane) {
#pragma unroll
    for (int i = 0; i < 8; ++i) v[i] = *(const f32x4*)(W + (size_t)(k0 + 8 * i + (lane >> 3)) * ldw + n0 + 4 * (lane & 7));
}
__device__ __forceinline__ void tr_store(const f32x4 (&v)[8], int k0, bf16* WT, int ldt, int drow0, LAS float* scr, int lane) {
#pragma unroll
    for (int i = 0; i < 8; ++i) { LAS float* d = scr + (8 * i + (lane >> 3)) * 33 + 4 * (lane & 7); d[0] = v[i][0]; d[1] = v[i][1]; d[2] = v[i][2]; d[3] = v[i][3]; }
    LDS_WAIT(); asm volatile("" ::: "memory");
    const int c = lane & 7;
#pragma unroll
    for (int j = 0; j < 4; ++j) { const int n = (lane >> 3) + 8 * j; const LAS float* s = scr + (8 * c) * 33 + n;
        u32x4 o; o.x = cvt_pk_bf16(s[0 * 33], s[1 * 33]); o.y = cvt_pk_bf16(s[2 * 33], s[3 * 33]); o.z = cvt_pk_bf16(s[4 * 33], s[5 * 33]); o.w = cvt_pk_bf16(s[6 * 33], s[7 * 33]);
        *(u32x4*)(WT + (size_t)(drow0 + n) * ldt + k0 + 8 * c) = o; }
    LDS_WAIT(); asm volatile("" ::: "memory");
}
__device__ __forceinline__ void conv_mat(const Ctx& C, const float* W, int K, int N, bf16* WT, int mode, int off, int gw0) {
    LAS float* scr = (LAS float*)(C.lds + C.wave * 16384);
    const int nblk = N / 32, items = (K / 64) * nblk;
    int start = C.gw - gw0; if (start < 0) start += C.NGW;
#define CONV_DROW(n0_) (mode == 0 ? off + (n0_) : ((n0_) / 128) * 256 + off + ((n0_) % 128))
    f32x4 va[8], vb[8];
    int it = start;
    if (it < items) tr_load(va, W, N, 64 * (it / nblk), 32 * (it % nblk), C.lane);
    while (it < items) {
        const int it1 = it + C.NGW;
        if (it1 < items) tr_load(vb, W, N, 64 * (it1 / nblk), 32 * (it1 % nblk), C.lane);
        tr_store(va, 64 * (it / nblk), WT, K, CONV_DROW(32 * (it % nblk)), scr, C.lane);
        if (it1 >= items) break;
        const int it2 = it1 + C.NGW;
        if (it2 < items) tr_load(va, W, N, 64 * (it2 / nblk), 32 * (it2 % nblk), C.lane);
        tr_store(vb, 64 * (it1 / nblk), WT, K, CONV_DROW(32 * (it1 % nblk)), scr, C.lane);
        it = it2;
    }
#undef CONV_DROW
}
__device__ __forceinline__ void conv_lora(const Ctx& C, const float* lw, const float* la, const float* lv, const float* lg, bf16* Bt) {
    for (int idx = C.bid * NTHR + C.tid; idx < 6144 * 256; idx += C.G * NTHR) {
        const int n_ = idx % 1536, rest = idx / 1536, k = rest % 256, blk = rest / 256;
        float v = 0.f;
        if (blk == 0) { if (k < 96) v = lw[k * 1536 + n_]; }
        else if (blk == 1) { if (k >= 96 && k < 192) v = la[(k - 96) * 1536 + n_]; }
        else if (blk == 2) { if (lv && k >= 192) v = lv[(k - 192) * 1536 + n_]; }
        else v = lg[k * 1536 + n_];
        Bt[(size_t)(blk * 1536 + n_) * 256 + k] = f2bf(v);
    }
}
__device__ __forceinline__ void conv_f32_bf16(const Ctx& C, const float* src, bf16* dst, size_t n8) {
    for (size_t i = (size_t)C.bid * NTHR + C.tid; i < n8; i += (size_t)C.G * NTHR) {
        const f32x4 a = ((const f32x4*)src)[2 * i], b = ((const f32x4*)src)[2 * i + 1];
        u32x4 w; w.x = cvt_pk_bf16(a[0], a[1]); w.y = cvt_pk_bf16(a[2], a[3]); w.z = cvt_pk_bf16(b[0], b[1]); w.w = cvt_pk_bf16(b[2], b[3]);
        ((u32x4*)dst)[i] = w; }
}

struct CvJob { const float* W; bf16* WT; int N, K, k0, n0, mode, off; float f8s; };
__device__ __forceinline__ void cv_load(f32x4 (&v)[8], const CvJob& J, int wave, int lane) {
    const int n = J.n0 + 4 * lane;
#pragma unroll
    for (int i = 0; i < 8; ++i) { v[i] = (f32x4){0.f, 0.f, 0.f, 0.f}; if (n < J.N) v[i] = *(const f32x4*)(J.W + (size_t)(J.k0 + 8 * wave + i) * J.N + n); }
}
__device__ __forceinline__ void cv_put(const f32x4 (&v)[8], LAS float* T, int wave, int lane) {
#pragma unroll
    for (int i = 0; i < 8; ++i) *(LAS f32x4*)(T + (8 * wave + i) * 256 + 4 * (lane ^ wave)) = v[i];
}
__device__ __forceinline__ void cv_out(const CvJob& J, const LAS float* T, int wave, int lane) {
    const int c = lane & 7;
#pragma unroll
    for (int j = 0; j < 4; ++j) { const int nl = 32 * wave + 8 * j + (lane >> 3), n = J.n0 + nl; const LAS float* s = T + (8 * c) * 256 + (nl ^ (c << 2));
        u32x4 o; o.x = cvt_pk_bf16(s[0 * 256], s[1 * 256]); o.y = cvt_pk_bf16(s[2 * 256], s[3 * 256]); o.z = cvt_pk_bf16(s[4 * 256], s[5 * 256]); o.w = cvt_pk_bf16(s[6 * 256], s[7 * 256]);
        if (n < J.N) { const int drow = J.mode == 0 ? J.off + n : (n / 128) * 256 + J.off + (n % 128);
            *(u32x4*)(J.WT + (size_t)drow * J.K + J.k0 + 8 * c) = o; } }
}
__device__ __forceinline__ void cv_out8(const CvJob& J, const LAS float* T, int wave, int lane) {
    const int c4 = lane & 3; unsigned char* W8 = (unsigned char*)J.WT;
#pragma unroll
    for (int j = 0; j < 2; ++j) { const int nl = 32 * wave + 16 * j + (lane >> 2), n = J.n0 + nl;
        float v[16];
#pragma unroll
        for (int q = 0; q < 16; ++q) { const int k = 16 * c4 + q; v[q] = T[k * 256 + (nl ^ (((k >> 3) & 7) << 2))] * J.f8s; }
        u32x4 o; o.x = pk4_fp8(v[0], v[1], v[2], v[3]); o.y = pk4_fp8(v[4], v[5], v[6], v[7]); o.z = pk4_fp8(v[8], v[9], v[10], v[11]); o.w = pk4_fp8(v[12], v[13], v[14], v[15]);
        if (n < J.N) { const int drow = J.mode == 0 ? J.off + n : (n / 128) * 256 + J.off + (n % 128);
            *(u32x4*)(W8 + (size_t)drow * J.K + J.k0 + 16 * c4) = o; } }
}
template <class Dec>
__device__ __forceinline__ void conv_run(const Ctx& C, int ntiles, const Dec& dec, const int t0 = -1, const int STR = GRID) {
    LAS float* T = (LAS float*)C.lds;
    f32x4 va[8], vb[8]; CvJob ja, jb, jc;
    int t = t0 < 0 ? C.bid : t0;
    if (t < ntiles) { dec(t, ja); cv_load(va, ja, C.wave, C.lane); }
    if (t + STR < ntiles) { dec(t + STR, jb); cv_load(vb, jb, C.wave, C.lane); }
    while (t < ntiles) {
        __syncthreads(); cv_put(va, T, C.wave, C.lane); jc = ja;
        if (t + 2 * STR < ntiles) { dec(t + 2 * STR, ja); cv_load(va, ja, C.wave, C.lane); }
        __syncthreads(); if (jc.f8s > 0.f) cv_out8(jc, T, C.wave, C.lane); else cv_out(jc, T, C.wave, C.lane);
        t += STR; if (t >= ntiles) break;
        __syncthreads(); cv_put(vb, T, C.wave, C.lane); jc = jb;
        if (t + 2 * STR < ntiles) { dec(t + 2 * STR, jb); cv_load(vb, jb, C.wave, C.lane); }
        __syncthreads(); if (jc.f8s > 0.f) cv_out8(jc, T, C.wave, C.lane); else cv_out(jc, T, C.wave, C.lane);
        t += STR;
    }
    __syncthreads();
}
struct MoeDec { const float* mg; const float* mu; const float* md; unsigned char* ws;
    __device__ __forceinline__ void operator()(int t, CvJob& J) const {
        const int j = t / 704, r = t % 704, e = j / 3, kind = j % 3;
        if (kind < 2) { J.W = (kind == 0 ? mg : mu) + (size_t)e * 2048 * 5632; J.WT = (bf16*)(ws + WS_MWGU + (size_t)e * 22 * MiB); J.N = 5632; J.K = 2048; J.mode = 1; J.off = kind * 128; J.f8s = 1024.f; J.k0 = 64 * (r / 22); J.n0 = 256 * (r % 22); }
        else { J.W = md + (size_t)e * 2048 * 5632; J.WT = (bf16*)(ws + WS_MWD + (size_t)e * 11 * MiB); J.N = 2048; J.K = 5632; J.mode = 0; J.off = 0; J.f8s = 2048.f; J.k0 = 64 * (r / 8); J.n0 = 256 * (r % 8); }
    } };
struct StaticDec { const float* const* in; unsigned char* ws;
    __device__ __forceinline__ void set(CvJob& J, const float* W, bf16* WT, int K, int N, int mode, int off, int r, float f8s = 0.f) const {
        const int nn = (N + 255) / 256; J.W = W; J.WT = WT; J.N = N; J.K = K; J.mode = mode; J.off = off; J.f8s = f8s; J.k0 = 64 * (r / nn); J.n0 = 256 * (r % nn); }
    __device__ __forceinline__ void operator()(int t, CvJob& J) const {
        int r = t;
        if (r < 128) { set(J, in[I_WKV], (bf16*)(ws + WS_WKV), 2048, 1024, 0, 0, r); return; } r -= 128;
        if (r < 704) { set(J, in[L0_WIN], (bf16*)(ws + WS_WIN), 2048, 5568, 0, 0, r); return; } r -= 704;
        if (r < 640) { set(J, in[L1_WIN], (bf16*)(ws + WS_WIN + (size_t)22 * MiB), 2048, 5120, 0, 0, r); return; } r -= 640;
        if (r < 704) { set(J, in[L2_WIN], (bf16*)(ws + WS_WIN + (size_t)44 * MiB), 2048, 5632, 0, 0, r); return; } r -= 704;
        if (r < 640) { set(J, in[L3_WIN], (bf16*)(ws + WS_WIN + (size_t)66 * MiB), 2048, 5120, 0, 0, r); return; } r -= 640;
        if (r < 256) { set(J, in[L0_WOUT], (bf16*)(ws + WS_WOUT), 2048, 2048, 0, 0, r); return; } r -= 256;
        if (r < 256) { set(J, in[L1_WOUT], (bf16*)(ws + WS_WOUT + (size_t)8 * MiB), 2048, 2048, 0, 0, r); return; } r -= 256;
        if (r < 256) { set(J, in[L2_WOUT], (bf16*)(ws + WS_WOUT + (size_t)16 * MiB), 2048, 2048, 0, 0, r); return; } r -= 256;
        if (r < 256) { set(J, in[L3_WOUT], (bf16*)(ws + WS_WOUT + (size_t)24 * MiB), 2048, 2048, 0, 0, r); return; } r -= 256;
        if (r < 704) { set(J, in[L0_FG], (bf16*)(ws + WS_WFGU), 2048, 5632, 1, 0, r, 1024.f); return; } r -= 704;
        if (r < 704) { set(J, in[L0_FU], (bf16*)(ws + WS_WFGU), 2048, 5632, 1, 128, r, 1024.f); return; } r -= 704;
        if (r < 704) { set(J, in[L0_FD], (bf16*)(ws + WS_WFD), 5632, 2048, 0, 0, r, 2048.f); return; } r -= 704;
        if (r < 704) { set(J, in[L2_FG], (bf16*)(ws + WS_WFGU + (size_t)44 * MiB), 2048, 5632, 1, 0, r, 1024.f); return; } r -= 704;
        if (r < 704) { set(J, in[L2_FU], (bf16*)(ws + WS_WFGU + (size_t)44 * MiB), 2048, 5632, 1, 128, r, 1024.f); return; } r -= 704;
        set(J, in[L2_FD], (bf16*)(ws + WS_WFD + (size_t)22 * MiB), 5632, 2048, 0, 0, r, 2048.f);
    } };

__device__ __forceinline__ void ph_prologue(const Ctx& C, const Args& A) {
    unsigned char* ws = C.ws;
    { StaticDec dec; dec.in = A.in; dec.ws = ws; conv_run(C, 8064, dec); }
    conv_lora(C, A.in[L0_LW], A.in[L0_LA], nullptr, A.in[L0_LG], (bf16*)(ws + WS_WLORA));
    conv_lora(C, A.in[L2_LW], A.in[L2_LA], A.in[L2_LV], A.in[L2_LG], (bf16*)(ws + WS_WLORA + 3 * MiB));
    { u32x4* z = (u32x4*)(ws + WS_WIN + (size_t)5568 * 2048 * 2);
      for (int i = C.bid * NTHR + C.tid; i < 64 * 2048 * 2 / 16; i += C.G * NTHR) z[i] = (u32x4){0u, 0u, 0u, 0u}; }
    { const f32x4* xs = (const f32x4*)A.in[I_X]; u32x2* hi = (u32x2*)(ws + WS_XB); unsigned* lo = (unsigned*)(ws + WS_XLO);
      for (size_t i = (size_t)C.bid * NTHR + C.tid; i < (size_t)M * D / 4; i += (size_t)C.G * NTHR) { const f32x4 o = xs[i];
          u32x2 w; w.x = cvt_pk_bf16(o[0], o[1]); w.y = cvt_pk_bf16(o[2], o[3]); hi[i] = w;
          lo[i] = pk4_fp8((o[0] - bflo(w.x)) * 8192.f, (o[1] - bfhi(w.x)) * 8192.f, (o[2] - bflo(w.y)) * 8192.f, (o[3] - bfhi(w.y)) * 8192.f); } }
    conv_f32_bf16(C, A.in[I_MEM], (bf16*)(ws + WS_MEMB), (size_t)4096 * 2048 / 8);
    { const int* pos = (const int*)A.in[I_POS]; f32x2* cs = (f32x2*)(ws + WS_CS);
      for (int idx = C.bid * NTHR + C.tid; idx < M * 64; idx += C.G * NTHR) {
          const int m = idx >> 6, i = idx & 63;
          const float pw = (float)exp2(13.287712379549449 * (double)i / 64.0);
          const float inv = 1.0f / pw;
          const float ang = (float)pos[m] * inv;
          const double x = (double)ang;
          const double n = rint(x * 0.15915494309189535);
          const double r = fma(-n, 6.283185307179586, x) - n * 2.4492935982947064e-16;
          const double r2 = r * r;
          double s = -1.0 / 121645100408832000.0;
          s = fma(s, r2, 1.0 / 355687428096000.0);
          s = fma(s, r2, -1.0 / 1307674368000.0);
          s = fma(s, r2, 1.0 / 6227020800.0);
          s = fma(s, r2, -1.0 / 39916800.0);
          s = fma(s, r2, 1.0 / 362880.0);
          s = fma(s, r2, -1.0 / 5040.0);
          s = fma(s, r2, 1.0 / 120.0);
          s = fma(s, r2, -1.0 / 6.0);
          s = fma(s * r2, r, r);
          double c = 1.0 / 2432902008176640000.0;
          c = fma(c, r2, -1.0 / 6402373705728000.0);
          c = fma(c, r2, 1.0 / 20922789888000.0);
          c = fma(c, r2, -1.0 / 87178291200.0);
          c = fma(c, r2, 1.0 / 479001600.0);
          c = fma(c, r2, -1.0 / 3628800.0);
          c = fma(c, r2, 1.0 / 40320.0);
          c = fma(c, r2, -1.0 / 720.0);
          c = fma(c, r2, 1.0 / 24.0);
          c = fma(c, r2, -0.5);
          c = fma(c, r2, 1.0);
          cs[idx] = (f32x2){(float)c, (float)s};
      } }
}

struct LnRow { u32x2 rh[8]; unsigned rl[8]; u32x2 a[8]; float w1, w2; };
__device__ __forceinline__ void ln_load(LnRow& R, const Ctx& C, int m, const void* Hp, int hmode) {
    const u32x2* hr = (const u32x2*)(C.ws + WS_XB + (size_t)m * D * 2) + C.lane;
    const unsigned* lr = (const unsigned*)(C.ws + WS_XLO + (size_t)m * D) + C.lane;
#pragma unroll
    for (int j = 0; j < 8; ++j) { R.rh[j] = hr[64 * j]; R.rl[j] = lr[64 * j]; }
    if (hmode == 0) {
        const u32x2* ar = (const u32x2*)((const bf16*)Hp + (size_t)m * D) + C.lane;
#pragma unroll
        for (int j = 0; j < 8; ++j) R.a[j] = ar[64 * j];
        R.w1 = 1.f; R.w2 = 0.f;
    } else if (hmode == 1) {
        const unsigned* ar = (const unsigned*)((const unsigned char*)Hp + (size_t)m * D) + C.lane;
#pragma unroll
        for (int j = 0; j < 8; ++j) { R.a[j].x = ar[64 * j]; R.a[j].y = 0u; }
        R.w1 = 1.f / 256.f; R.w2 = 0.f;
    } else {
        const f32x4 rt = ((const f32x4*)(C.ws + WS_ROUTE))[m];
        const int s1 = ((const int*)(C.ws + WS_SLOT1))[m], s2 = ((const int*)(C.ws + WS_SLOT2))[m];
        R.w1 = rt[1] * (1.f / 256.f); R.w2 = rt[2] * (1.f / 256.f);
        const unsigned* y1 = (const unsigned*)((const unsigned char*)Hp + (size_t)s1 * D) + C.lane;
        const unsigned* y2 = (const unsigned*)((const unsigned char*)Hp + (size_t)s2 * D) + C.lane;
#pragma unroll
        for (int j = 0; j < 8; ++j) { R.a[j].x = y1[64 * j]; R.a[j].y = y2[64 * j]; }
    }
}
__device__ __forceinline__ void ln_row(const LnRow& R, const Ctx& C, int m, const float* gain, const float* bias, int hmode, float* Xf32out, unsigned char* X8out,
                                       LAS float* rw, LAS int* hist, bool do_route) {
    const int l4 = 4 * C.lane;
    f32x4 v[8]; float s = 0.f;
#pragma unroll
    for (int j = 0; j < 8; ++j) { f32x4 f, x;
        const f32x2 l01 = __builtin_amdgcn_cvt_pk_f32_fp8(R.rl[j], false), l23 = __builtin_amdgcn_cvt_pk_f32_fp8(R.rl[j], true);
        x[0] = bflo(R.rh[j].x) + l01[0] * (1.f / 8192.f); x[1] = bfhi(R.rh[j].x) + l01[1] * (1.f / 8192.f); x[2] = bflo(R.rh[j].y) + l23[0] * (1.f / 8192.f); x[3] = bfhi(R.rh[j].y) + l23[1] * (1.f / 8192.f);
        if (hmode == 0) { f[0] = bflo(R.a[j].x); f[1] = bfhi(R.a[j].x); f[2] = bflo(R.a[j].y); f[3] = bfhi(R.a[j].y); }
        else { const f32x2 a01 = __builtin_amdgcn_cvt_pk_f32_fp8(R.a[j].x, false), a23 = __builtin_amdgcn_cvt_pk_f32_fp8(R.a[j].x, true);
            f[0] = R.w1 * a01[0]; f[1] = R.w1 * a01[1]; f[2] = R.w1 * a23[0]; f[3] = R.w1 * a23[1];
            if (hmode == 2) { const f32x2 b01 = __builtin_amdgcn_cvt_pk_f32_fp8(R.a[j].y, false), b23 = __builtin_amdgcn_cvt_pk_f32_fp8(R.a[j].y, true);
                f[0] += R.w2 * b01[0]; f[1] += R.w2 * b01[1]; f[2] += R.w2 * b23[0]; f[3] += R.w2 * b23[1]; } }
        v[j] = x * ALPHA + f; s += (v[j][0] + v[j][1]) + (v[j][2] + v[j][3]); }
    const float mean = wave_sum(s) * (1.f / D); float s2 = 0.f;
#pragma unroll
    for (int j = 0; j < 8; ++j) { v[j] = v[j] - mean; s2 += (v[j][0] * v[j][0] + v[j][1] * v[j][1]) + (v[j][2] * v[j][2] + v[j][3] * v[j][3]); }
    const float rstd = 1.0f / sqrtf(wave_sum(s2) * (1.f / D) + LN_EPS);
    float lg[8];
#pragma unroll
    for (int e = 0; e < 8; ++e) lg[e] = 0.f;
    u32x2* ho = (u32x2*)(C.ws + WS_XB + (size_t)m * D * 2) + C.lane;
    unsigned* lo = (unsigned*)(C.ws + WS_XLO + (size_t)m * D) + C.lane;
#pragma unroll
    for (int j = 0; j < 8; ++j) {
        const f32x4 gv = *((const f32x4*)(gain + 256 * j + l4)), bv = *((const f32x4*)(bias + 256 * j + l4));
        const f32x4 o = v[j] * rstd * gv + bv;
        if (Xf32out) ((f32x4*)(Xf32out + (size_t)m * D))[64 * j + C.lane] = o;
        else { u32x2 w; w.x = cvt_pk_bf16(o[0], o[1]); w.y = cvt_pk_bf16(o[2], o[3]); ho[64 * j] = w;
            lo[64 * j] = pk4_fp8((o[0] - bflo(w.x)) * 8192.f, (o[1] - bfhi(w.x)) * 8192.f, (o[2] - bflo(w.y)) * 8192.f, (o[3] - bfhi(w.y)) * 8192.f); }
        if (X8out) ((unsigned*)(X8out + (size_t)m * D))[64 * j + C.lane] = pk4_fp8(o[0] * 16.f, o[1] * 16.f, o[2] * 16.f, o[3] * 16.f);
        if (do_route) {
#pragma unroll
            for (int e = 0; e < 8; ++e) { const f32x4 we = *(const LAS f32x4*)(rw + e * 2048 + 256 * j + l4);
                lg[e] += (o[0] * we[0] + o[1] * we[1]) + (o[2] * we[2] + o[3] * we[3]); }
        }
    }
    if (do_route) {
#pragma unroll
        for (int e = 0; e < 8; ++e) lg[e] = wave_sum(lg[e]);
        int e1 = 0; float v1 = lg[0];
#pragma unroll
        for (int e = 1; e < 8; ++e) if (lg[e] > v1) { v1 = lg[e]; e1 = e; }
        int e2 = -1; float v2 = -3.0e38f;
#pragma unroll
        for (int e = 0; e < 8; ++e) if (e != e1 && lg[e] > v2) { v2 = lg[e]; e2 = e; }
        const float ex = __expf(v2 - v1); const float w1 = 1.0f / (1.0f + ex), w2 = ex / (1.0f + ex);
        if (C.lane == 0) { f32x4 rt; rt[0] = __int_as_float(e1 | (e2 << 8)); rt[1] = w1; rt[2] = w2; rt[3] = 0.f; ((f32x4*)(C.ws + WS_ROUTE))[m] = rt;
            atomicAdd((int*)&hist[e1], 1); atomicAdd((int*)&hist[e2], 1); }
    }
}
__device__ __forceinline__ void ph_ln(const Ctx& C, const void* Hp, int hmode, const float* gain, const float* bias, float* Xf32out, unsigned char* X8out,
                                      const float* router, bool do_route) {
    unsigned char* ws = C.ws;
    LAS float* rw = (LAS float*)C.lds;
    LAS int* hist = (LAS int*)(C.lds + LDS_MISC + 64);
    if (do_route) {
        for (int col = C.tid; col < 2048; col += NTHR) { const f32x4 a = ((const f32x4*)router)[2 * col], b = ((const f32x4*)router)[2 * col + 1];
            rw[0 * 2048 + col] = a[0]; rw[1 * 2048 + col] = a[1]; rw[2 * 2048 + col] = a[2]; rw[3 * 2048 + col] = a[3]; rw[4 * 2048 + col] = b[0]; rw[5 * 2048 + col] = b[1]; rw[6 * 2048 + col] = b[2]; rw[7 * 2048 + col] = b[3]; }
        if (C.tid < 8) hist[C.tid] = 0;
        int* st = (int*)(ws + WS_SLOTTOK);
        for (int i = C.bid * NTHR + C.tid; i < NSLOT; i += C.G * NTHR) st[i] = -1;
        __syncthreads();
    }
    const int m0 = C.bid * 128 + C.wave * 16;
    LnRow Ra, Rb;
    ln_load(Ra, C, m0, Hp, hmode);
#pragma unroll 1
    for (int r = 0; r < 16; r += 2) {
        ln_load(Rb, C, m0 + r + 1, Hp, hmode);
        ln_row(Ra, C, m0 + r, gain, bias, hmode, Xf32out, X8out, rw, hist, do_route);
        if (r + 2 < 16) ln_load(Ra, C, m0 + r + 2, Hp, hmode);
        ln_row(Rb, C, m0 + r + 1, gain, bias, hmode, Xf32out, X8out, rw, hist, do_route);
    }
    if (do_route) { __syncthreads(); if (C.tid < 8) ((int*)(ws + WS_CTL))[CW_CNT + C.bid * 8 + C.tid] = hist[C.tid]; }
}

__device__ __forceinline__ void ph_slots(const Ctx& C) {
    unsigned char* ws = C.ws;
    LAS int* sm = (LAS int*)(C.lds + LDS_MISC + 128);
    const int* cnt = (const int*)(ws + WS_CTL) + CW_CNT;
    if (C.tid < 8) { int tot = 0, mine = 0; for (int b = 0; b < C.G; ++b) { const int c = cnt[b * 8 + C.tid]; if (b < C.bid) mine += c; tot += c; } sm[C.tid] = tot; sm[8 + C.tid] = mine; }
    __syncthreads();
    if (C.tid == 0) { int base = 0; for (int e = 0; e < 8; ++e) { sm[16 + e] = base; base += (sm[e] + 255) & ~255; } sm[24] = base >> 8; }
    __syncthreads();
    if (C.wave == 0) {
        int off[8];
#pragma unroll
        for (int e = 0; e < 8; ++e) off[e] = sm[16 + e] + sm[8 + e];
        const unsigned long long lt = (1ull << C.lane) - 1ull;
        for (int it = 0; it < 2; ++it) {
            const int m = C.bid * 128 + it * 64 + C.lane;
            const int ee = __float_as_int(((const f32x4*)(ws + WS_ROUTE))[m][0]); const int e1 = ee & 0xff, e2 = (ee >> 8) & 0xff;
            int s1 = 0, s2 = 0;
#pragma unroll
            for (int e = 0; e < 8; ++e) { const unsigned long long m1 = __ballot(e1 == e), m2 = __ballot(e2 == e);
                const int c1 = __popcll(m1), c2 = __popcll(m2);
                if (e1 == e) s1 = off[e] + __popcll(m1 & lt);
                if (e2 == e) s2 = off[e] + c1 + __popcll(m2 & lt);
                off[e] += c1 + c2; }
            ((int*)(ws + WS_SLOT1))[m] = s1; ((int*)(ws + WS_SLOT2))[m] = s2;
            int* st = (int*)(ws + WS_SLOTTOK); st[s1] = m; st[s2] = m;
        }
    }
    if (C.bid == 0) {
        int* ctl = (int*)(ws + WS_CTL);
        if (C.tid == 0) ctl[CW_NT] = sm[24];
        if (C.tid < 264) { int e = 0;
#pragma unroll
            for (int q = 1; q < 8; ++q) if (C.tid >= (sm[16 + q] >> 8)) e = q;
            ctl[CW_TEXP + C.tid] = e; }
    }
}
__device__ __forceinline__ void ph_gather(const Ctx& C) {
    unsigned char* ws = C.ws;
    const int* st = (const int*)(ws + WS_SLOTTOK); const u32x4* xb = (const u32x4*)(ws + WS_XB); u32x4* xp = (u32x4*)(ws + WS_XPERM);
    for (int s = C.gw; s < NSLOT; s += C.NGW) { const int tok = st[s];
#pragma unroll
        for (int j = 0; j < 2; ++j) { u32x4 v = xb[(size_t)(tok < 0 ? 0 : tok) * 128 + j * 64 + C.lane]; const unsigned k = tok < 0 ? 0u : 0xffffffffu; v.x &= k; v.y &= k; v.z &= k; v.w &= k; xp[(size_t)s * 128 + j * 64 + C.lane] = v; } }
}
__device__ __forceinline__ void ph_moe_wconv(const Ctx& C, const float* mg, const float* mu, const float* md) {
    MoeDec dec; dec.mg = mg; dec.mu = mu; dec.md = md; dec.ws = C.ws; conv_run(C, 16896, dec, C.bid - 192, 64);
}

__device__ __forceinline__ void ph_memattn(const Ctx& C, const bf16* P, int ldp, int qm0) {
    unsigned char* ws = C.ws;
    const bf16* memK = (const bf16*)(ws + WS_MEMK); const bf16* memVT = (const bf16*)(ws + WS_MEMVT); bf16* mix = (bf16*)(ws + WS_MIX);
    const int g = C.lane >> 4, r16 = C.lane & 15;
    LAS unsigned char* LK = C.lds; LAS unsigned char* LV = C.lds + 65536;
    const int b = C.bid >> 4, hm = (C.bid >> 2) & 3, qb = C.bid & 3;
    __syncthreads();
    {   u32x4 st[16];
#pragma unroll
        for (int i = 0; i < 8; ++i) { const int q = C.tid + 512 * i, row = q >> 4, pc = q & 15;
            st[i] = *(const u32x4*)(memK + (size_t)(b * 256 + row) * 512 + hm * 128 + pc * 8); }
#pragma unroll
        for (int i = 0; i < 8; ++i) { const int q = C.tid + 512 * i, row = q >> 5, pc = q & 31;
            st[8 + i] = *(const u32x4*)(memVT + (size_t)(hm * 128 + row) * 4096 + b * 256 + pc * 8); }
#pragma unroll
        for (int i = 0; i < 8; ++i) { const int q = C.tid + 512 * i, row = q >> 4, pc = q & 15;
            *(LAS u32x4*)(LK + row * 256 + ((pc ^ (row & 15)) * 16)) = st[i]; }
#pragma unroll
        for (int i = 0; i < 8; ++i) { const int q = C.tid + 512 * i, row = q >> 5, pc = q & 31;
            *(LAS u32x4*)(LV + row * 512 + ((pc ^ (row & 15)) * 16)) = st[8 + i]; }
    }
    __syncthreads();
    for (int qt = 0; qt < 4; ++qt) {
        const int m0 = b * SEQ + qb * 512 + C.wave * 64 + qt * 16;
        bf16x8 qf[4];
#pragma unroll
        for (int s = 0; s < 4; ++s) qf[s] = *(const bf16x8*)(P + (size_t)(m0 + r16) * ldp + qm0 + hm * 128 + 32 * s + 8 * g);
        f32x4 sacc[16];
#pragma unroll
        for (int kt = 0; kt < 16; ++kt) { sacc[kt] = (f32x4){0.f, 0.f, 0.f, 0.f};
#pragma unroll
            for (int s = 0; s < 4; ++s) { const bf16x8 kf = *(const LAS bf16x8*)(LK + (16 * kt + r16) * 256 + (((4 * s + g) ^ r16) * 16));
                sacc[kt] = __builtin_amdgcn_mfma_f32_16x16x32_bf16(kf, qf[s], sacc[kt], 0, 0, 0); } }
        float mx = -3.0e38f;
#pragma unroll
        for (int kt = 0; kt < 16; ++kt)
#pragma unroll
            for (int j = 0; j < 4; ++j) mx = fmaxf(mx, sacc[kt][j]);
        mx = fmaxf(mx, __shfl_xor(mx, 16)); mx = fmaxf(mx, __shfl_xor(mx, 32));
        const float sc = 0.08838834764831845f * 1.4426950408889634f;
        float sum = 0.f;
#pragma unroll
        for (int kt = 0; kt < 16; ++kt)
#pragma unroll
            for (int j = 0; j < 4; ++j) { const float pv = exp2f((sacc[kt][j] - mx) * sc); sacc[kt][j] = pv; sum += pv; }
        sum += __shfl_xor(sum, 16); sum += __shfl_xor(sum, 32);
        f32x4 oacc[8];
#pragma unroll
        for (int dt = 0; dt < 8; ++dt) oacc[dt] = (f32x4){0.f, 0.f, 0.f, 0.f};
#pragma unroll
        for (int ks = 0; ks < 8; ++ks) {
            u32x4 pw; pw.x = cvt_pk_bf16(sacc[2 * ks][0], sacc[2 * ks][1]); pw.y = cvt_pk_bf16(sacc[2 * ks][2], sacc[2 * ks][3]);
            pw.z = cvt_pk_bf16(sacc[2 * ks + 1][0], sacc[2 * ks + 1][1]); pw.w = cvt_pk_bf16(sacc[2 * ks + 1][2], sacc[2 * ks + 1][3]);
            const bf16x8 pa = __builtin_bit_cast(bf16x8, pw);
#pragma unroll
            for (int dt = 0; dt < 8; ++dt) { const LAS unsigned char* vr = LV + (16 * dt + r16) * 512;
                const u32x2 lo = *(const LAS u32x2*)(vr + (((8 * ks + g) ^ (2 * r16)) * 8)), hi = *(const LAS u32x2*)(vr + (((8 * ks + 4 + g) ^ (2 * r16)) * 8));
                u32x4 vw; vw.x = lo.x; vw.y = lo.y; vw.z = hi.x; vw.w = hi.y;
                oacc[dt] = __builtin_amdgcn_mfma_f32_16x16x32_bf16(pa, __builtin_bit_cast(bf16x8, vw), oacc[dt], 0, 0, 0); } }
        float inv[4];
#pragma unroll
        for (int j = 0; j < 4; ++j) inv[j] = 1.0f / __shfl(sum, 4 * g + j);
#pragma unroll
        for (int dt = 0; dt < 8; ++dt)
#pragma unroll
            for (int j = 0; j < 4; ++j) mix[(size_t)(m0 + 4 * g + j) * D + SW + hm * 128 + 16 * dt + r16] = f2bf(oacc[dt][j] * inv[j]);
    }
    __syncthreads();
}

__device__ __forceinline__ void ph_rwkv_prep1(const Ctx& C, const float* mu, bool with_v) {
    unsigned char* ws = C.ws;
    const bf16* P = (const bf16*)(ws + WS_P); bf16* AL = (bf16*)(ws + WS_ALORA);
    const int oc0 = 8 * C.lane;
    const int XW0 = 4608, XA0 = 4704, XV0 = 4800, XG0 = with_v ? 4864 : 4800;
    int src, mode;
    if (oc0 < 96) { src = XW0 + oc0; mode = 0; } else if (oc0 < 192) { src = XA0 + oc0 - 96; mode = 1; }
    else if (oc0 < 256) { src = XV0 + oc0 - 192; mode = with_v ? 1 : 2; } else { src = XG0 + oc0 - 256; mode = 3; }
    f32x4 mu0 = (f32x4){0.f, 0.f, 0.f, 0.f}, mu1 = mu0;
    if (mode != 2) { mu0 = *(const f32x4*)(mu + src); mu1 = *(const f32x4*)(mu + src + 4); }
    for (int m = C.gw; m < M; m += C.NGW) {
        u32x4 o = (u32x4){0u, 0u, 0u, 0u};
        if (mode != 2) {
            const u32x4 cu = *(const u32x4*)(P + (size_t)m * LDP_RW + src);
            u32x4 pr = (u32x4){0u, 0u, 0u, 0u};
            if ((m & (SEQ - 1)) != 0) pr = *(const u32x4*)(P + (size_t)(m - 1) * LDP_RW + src);
            float v[8];
#pragma unroll
            for (int q = 0; q < 4; ++q) { const float c0 = bflo(cu[q]), c1 = bfhi(cu[q]), p0 = bflo(pr[q]), p1 = bfhi(pr[q]);
                const float m0 = q < 2 ? mu0[2 * q] : mu1[2 * q - 4], m1 = q < 2 ? mu0[2 * q + 1] : mu1[2 * q - 3];
                v[2 * q] = c0 + m0 * (p0 - c0); v[2 * q + 1] = c1 + m1 * (p1 - c1); }
#pragma unroll
            for (int q = 0; q < 8; ++q) { if (mode == 0) v[q] = 1.0f - 2.0f * __builtin_amdgcn_rcpf(1.0f + __expf(2.0f * v[q])); else if (mode == 3) v[q] = sigmoidf_(v[q]); }
            o.x = cvt_pk_bf16(v[0], v[1]); o.y = cvt_pk_bf16(v[2], v[3]); o.z = cvt_pk_bf16(v[4], v[5]); o.w = cvt_pk_bf16(v[6], v[7]);
        }
        *(u32x4*)(AL + (size_t)m * 512 + oc0) = o;
    }
}
__device__ __forceinline__ void ph_rwkv_prep2(const Ctx& C, const float* mu, const float* vecs, bool with_v) {
    unsigned char* ws = C.ws;
    const bf16* P = (const bf16*)(ws + WS_P); const bf16* LO = (const bf16*)(ws + WS_LORAOUT); bf16* VF = (bf16*)(ws + WS_VFIRST);
    unsigned char* SI = ws + WS_SCANIN; float* BON = (float*)(ws + WS_BONUS);
    const float* k_k = vecs + (with_v ? 3 : 2) * SW; const float* k_a = k_k + SW; const float* r_k = k_a + SW;
    const int hq = C.lane >> 4, cl = (C.lane & 15) * 4;
    for (int m = C.gw; m < M; m += C.NGW) {
        const int t = m & (SEQ - 1), b = m >> 11; const bool hp = t != 0;
        const bf16* pc = P + (size_t)m * LDP_RW; const bf16* pp = pc - LDP_RW;
#pragma unroll 2
        for (int it = 0; it < 6; ++it) {
            const int c = it * 256 + 4 * C.lane, head = 4 * it + hq;
            const u32x2 rc = *(const u32x2*)(pc + c), kc = *(const u32x2*)(pc + SW + c), vc = *(const u32x2*)(pc + 2 * SW + c);
            u32x2 rp = (u32x2){0u, 0u}, kp_ = rp, vp = rp;
            if (hp) { rp = *(const u32x2*)(pp + c); kp_ = *(const u32x2*)(pp + SW + c); vp = *(const u32x2*)(pp + 2 * SW + c); }
            const u32x2 Ew = *(const u32x2*)(LO + (size_t)m * 6144 + c), aw = *(const u32x2*)(LO + (size_t)m * 6144 + SW + c);
            u32x2 svw = (u32x2){0u, 0u}, vfw = svw;
            if (with_v) { svw = *(const u32x2*)(LO + (size_t)m * 6144 + 2 * SW + c); vfw = *(const u32x2*)(VF + (size_t)m * SW + c); }
            const f32x4 mr = *(const f32x4*)(mu + c), mk = *(const f32x4*)(mu + SW + c), mv = *(const f32x4*)(mu + 2 * SW + c);
            const f32x4 kk4 = *(const f32x4*)(k_k + c), ka4 = *(const f32x4*)(k_a + c), rk4 = *(const f32x4*)(r_k + c);
            float rm[4], km[4], vm[4], E[4], a[4], sv[4], vf[4];
#define UNPK(dst, w) dst[0] = bflo(w.x); dst[1] = bfhi(w.x); dst[2] = bflo(w.y); dst[3] = bfhi(w.y)
            float t0[4], t1[4];
            UNPK(t0, rc); UNPK(t1, rp);
#pragma unroll
            for (int j = 0; j < 4; ++j) rm[j] = t0[j] + mr[j] * (t1[j] - t0[j]);
            UNPK(t0, kc); UNPK(t1, kp_);
#pragma unroll
            for (int j = 0; j < 4; ++j) km[j] = t0[j] + mk[j] * (t1[j] - t0[j]);
            UNPK(t0, vc); UNPK(t1, vp);
#pragma unroll
            for (int j = 0; j < 4; ++j) vm[j] = t0[j] + mv[j] * (t1[j] - t0[j]);
            UNPK(E, Ew); UNPK(a, aw); UNPK(sv, svw); UNPK(vf, vfw);
#undef UNPK
            float vv[4], kkr[4], kp[4], ss = 0.f, bs = 0.f;
#pragma unroll
            for (int j = 0; j < 4; ++j) {
                vv[j] = with_v ? vm[j] + (vf[j] - vm[j]) * sv[j] : vm[j];
                kkr[j] = km[j] * kk4[j]; ss += kkr[j] * kkr[j];
                kp[j] = km[j] * (1.0f + (a[j] - 1.0f) * ka4[j]);
                bs += rm[j] * kp[j] * rk4[j]; }
            ss = row16_sum(ss); bs = row16_sum(bs);
            const float inv = 1.0f / fmaxf(sqrtf(ss), 1e-12f);
            if (!with_v) { u32x2 w; w.x = cvt_pk_bf16(vm[0], vm[1]); w.y = cvt_pk_bf16(vm[2], vm[3]); *(u32x2*)(VF + (size_t)m * SW + c) = w; }
            unsigned char* rec = SI + ((size_t)(b * 24 + head) * SEQ + t) * 896;
            f32x4 wv; float kk[4];
#pragma unroll
            for (int j = 0; j < 4; ++j) { wv[j] = __expf(-E[j]); kk[j] = kkr[j] * inv; }
            *(f32x4*)(rec + cl * 4) = wv;
            u32x2 o;
            o.x = cvt_pk_bf16(-kk[0], -kk[1]); o.y = cvt_pk_bf16(-kk[2], -kk[3]); *(u32x2*)(rec + 256 + cl * 2) = o;
            o.x = cvt_pk_bf16(kk[0] * a[0], kk[1] * a[1]); o.y = cvt_pk_bf16(kk[2] * a[2], kk[3] * a[3]); *(u32x2*)(rec + 384 + cl * 2) = o;
            o.x = cvt_pk_bf16(kp[0], kp[1]); o.y = cvt_pk_bf16(kp[2], kp[3]); *(u32x2*)(rec + 512 + cl * 2) = o;
            o.x = cvt_pk_bf16(rm[0], rm[1]); o.y = cvt_pk_bf16(rm[2], rm[3]); *(u32x2*)(rec + 640 + cl * 2) = o;
            o.x = cvt_pk_bf16(vv[0], vv[1]); o.y = cvt_pk_bf16(vv[2], vv[3]); *(u32x2*)(rec + 768 + cl * 2) = o;
            if ((C.lane & 15) == 0) BON[m * 24 + head] = bs;
        }
    }
}
__device__ __forceinline__ float fma_(float a, float b, float c) { float d; asm("v_fma_f32 %0, %1, %2, %3" : "=v"(d) : "v"(a), "v"(b), "v"(c)); return d; }
__device__ __forceinline__ float mul_(float a, float b) { float d; asm("v_mul_f32 %0, %1, %2" : "=v"(d) : "v"(a), "v"(b)); return d; }
__device__ __forceinline__ void ph_rwkv_scan(const Ctx& C, const float* mg, const float* mu, const float* md, const float* vecs, bool with_v) {
    if (C.bid >= 192) { ph_moe_wconv(C, mg, mu, md); return; }
    unsigned char* ws = C.ws;
    const unsigned char* SI = ws + WS_SCANIN;
    constexpr int TC = 16, NCH = SEQ / TC, REC = 7 * 64;
    LAS float* buf = (LAS float*)C.lds;
    LAS float* ybuf = (LAS float*)(C.lds + 114688);
    const bool scanner = C.wave < 4;
    const int slot = (C.wave >> 1) & 1;
    const int rg = C.lane >> 3, cg = C.lane & 7;
    const int rbase = 32 * (C.wave & 1) + 4 * rg;
    if (!scanner) {
        const int lw = C.wave - 4, qd = C.lane;
        const int q2 = qd - 16, lvec = 1 + (q2 >> 3), lpart = q2 & 7;
        const float* BON = (const float*)(ws + WS_BONUS); bf16* mix = (bf16*)(ws + WS_MIX); const bf16* LO = (const bf16*)(ws + WS_LORAOUT);
        const float* gn_g = vecs + (with_v ? 6 : 5) * SW; const float* gn_b = gn_g + SW;
        const int p0 = C.bid * 2, b0 = p0 / 24, h0 = p0 % 24, b1 = (p0 + 1) / 24, h1 = (p0 + 1) % 24;
        const int pr = C.lane >> 4, pc4 = 4 * (C.lane & 15);
        const f32x4 gg0 = *(const f32x4*)(gn_g + h0 * 64 + pc4), gb0 = *(const f32x4*)(gn_b + h0 * 64 + pc4), gg1 = *(const f32x4*)(gn_g + h1 * 64 + pc4), gb1 = *(const f32x4*)(gn_b + h1 * 64 + pc4);
        u32x4 st[8];
#define SCAN_ISSUE(ch_) do { _Pragma("unroll") for (int i_ = 0; i_ < 8; ++i_) { const int ps = lw + 4 * i_; \
        const int sl_ = ps >> 4, t_ = (ch_) * TC + (ps & 15); \
        st[i_] = qd < 56 ? *(const u32x4*)(SI + ((size_t)(p0 + sl_) * SEQ + t_) * 896 + qd * 16) \
                         : *(const u32x4*)(LO + (size_t)((sl_ ? b1 : b0) * SEQ + t_) * 6144 + 3 * SW + (sl_ ? h1 : h0) * 64 + (qd - 56) * 8); } } while (0)
#define SCAN_COMMIT(bsel_) do { _Pragma("unroll") for (int i_ = 0; i_ < 8; ++i_) { const int ps = lw + 4 * i_; \
        LAS float* dst = buf + (((bsel_) * 2 * TC) + ps) * REC; \
        if (qd < 16) *(LAS u32x4*)(dst + 4 * qd) = st[i_]; \
        else { LAS float* d2 = dst + lvec * 64 + lpart * 8; \
            f32x4 a_, b_; a_[0] = bflo(st[i_].x); a_[1] = bfhi(st[i_].x); a_[2] = bflo(st[i_].y); a_[3] = bfhi(st[i_].y); \
            b_[0] = bflo(st[i_].z); b_[1] = bfhi(st[i_].z); b_[2] = bflo(st[i_].w); b_[3] = bfhi(st[i_].w); \
            *(LAS f32x4*)d2 = a_; *(LAS f32x4*)(d2 + 4) = b_; } } } while (0)
#define SCAN_POST(cp_) do { _Pragma("unroll") for (int g_ = 0; g_ < 2; ++g_) { const int ps = lw + 4 * (4 * g_ + pr), sl = ps >> 4, stp = ps & 15; \
        const LAS float* rec = buf + ((((cp_) & 1) * 2 * TC) + ps) * REC; \
        const f32x4 yv = *(const LAS f32x4*)(ybuf + ((((cp_) & 1) * 2 + sl) * TC + stp) * 64 + pc4), vv = *(const LAS f32x4*)(rec + 5 * 64 + pc4), gq = *(const LAS f32x4*)(rec + 6 * 64 + pc4); \
        const int m = (sl ? b1 : b0) * SEQ + (cp_) * TC + stp, hh = sl ? h1 : h0; \
        const float bon = BON[m * 24 + hh]; \
        const float mean = row16_sum((yv[0] + yv[1]) + (yv[2] + yv[3])) * (1.f / 64.f); const f32x4 d = yv - mean; \
        const float var = row16_sum((d[0] * d[0] + d[1] * d[1]) + (d[2] * d[2] + d[3] * d[3])) * (1.f / 64.f); \
        const float rstd = 1.0f / sqrtf(var + 64e-5f); const f32x4 gg = sl ? gg1 : gg0, gb = sl ? gb1 : gb0; \
        const f32x4 o_ = (d * rstd * gg + gb + vv * bon) * gq; \
        u32x2 w_; w_.x = cvt_pk_bf16(o_[0], o_[1]); w_.y = cvt_pk_bf16(o_[2], o_[3]); \
        *(u32x2*)(mix + (size_t)m * D + hh * 64 + pc4) = w_; } } while (0)
        SCAN_ISSUE(0); SCAN_COMMIT(0);
        __syncthreads();
        for (int ch = 0; ch < NCH; ++ch) {
            if (ch + 1 < NCH) SCAN_ISSUE(ch + 1);
            if (ch > 0) SCAN_POST(ch - 1);
            if (ch + 1 < NCH) SCAN_COMMIT((ch & 1) ^ 1);
            __syncthreads();
        }
        SCAN_POST(NCH - 1);
#undef SCAN_ISSUE
#undef SCAN_COMMIT
#undef SCAN_POST
    } else {
        f32x2 S[4][4];
#pragma unroll
        for (int i = 0; i < 4; ++i)
#pragma unroll
            for (int c = 0; c < 4; ++c) S[i][c] = (f32x2){0.f, 0.f};
        __syncthreads();
        for (int ch = 0; ch < NCH; ++ch) {
            const LAS float* base = buf + (((ch & 1) * 2 + slot) * TC) * REC;
            LAS float* yb = ybuf + (((ch & 1) * 2 + slot) * TC) * 64 + rbase;
#pragma unroll 2
            for (int s = 0; s < TC; ++s) {
                const LAS float* rp = base + s * REC + 8 * cg;
                f32x2 wv[4], nv[4], bv[4], kv[4], rv[4];
                { const f32x4 x0 = *(const LAS f32x4*)(rp), x1 = *(const LAS f32x4*)(rp + 4); wv[0] = (f32x2){x0[0], x0[1]}; wv[1] = (f32x2){x0[2], x0[3]}; wv[2] = (f32x2){x1[0], x1[1]}; wv[3] = (f32x2){x1[2], x1[3]}; }
                { const f32x4 x0 = *(const LAS f32x4*)(rp + 64), x1 = *(const LAS f32x4*)(rp + 68); nv[0] = (f32x2){x0[0], x0[1]}; nv[1] = (f32x2){x0[2], x0[3]}; nv[2] = (f32x2){x1[0], x1[1]}; nv[3] = (f32x2){x1[2], x1[3]}; }
                { const f32x4 x0 = *(const LAS f32x4*)(rp + 128), x1 = *(const LAS f32x4*)(rp + 132); bv[0] = (f32x2){x0[0], x0[1]}; bv[1] = (f32x2){x0[2], x0[3]}; bv[2] = (f32x2){x1[0], x1[1]}; bv[3] = (f32x2){x1[2], x1[3]}; }
                { const f32x4 x0 = *(const LAS f32x4*)(rp + 192), x1 = *(const LAS f32x4*)(rp + 196); kv[0] = (f32x2){x0[0], x0[1]}; kv[1] = (f32x2){x0[2], x0[3]}; kv[2] = (f32x2){x1[0], x1[1]}; kv[3] = (f32x2){x1[2], x1[3]}; }
                { const f32x4 x0 = *(const LAS f32x4*)(rp + 256), x1 = *(const LAS f32x4*)(rp + 260); rv[0] = (f32x2){x0[0], x0[1]}; rv[1] = (f32x2){x0[2], x0[3]}; rv[2] = (f32x2){x1[0], x1[1]}; rv[3] = (f32x2){x1[2], x1[3]}; }
                const f32x4 vv = *(const LAS f32x4*)(base + s * REC + 320 + rbase);
                f32x4 yo;
#pragma unroll
                for (int i = 0; i < 4; ++i) {
                    f32x2 a2 = S[i][0] * nv[0];
#pragma unroll
                    for (int c = 1; c < 4; ++c) a2 = S[i][c] * nv[c] + a2;
                    float sa = a2[0] + a2[1];
                    sa = dpp_add<0xB1>(sa); sa = dpp_add<0x4E>(sa); sa = dpp_add<0x141>(sa);
                    const f32x2 sa2 = (f32x2){sa, sa}, v2 = (f32x2){vv[i], vv[i]};
                    f32x2 y2 = (f32x2){0.f, 0.f};
#pragma unroll
                    for (int c = 0; c < 4; ++c) { S[i][c] = S[i][c] * wv[c] + (sa2 * bv[c] + v2 * kv[c]); y2 = S[i][c] * rv[c] + y2; }
                    float y = y2[0] + y2[1];
                    y = dpp_add<0xB1>(y); y = dpp_add<0x4E>(y); y = dpp_add<0x141>(y);
                    yo[i] = y;
                }
                if (cg == 0) *(LAS f32x4*)(yb + s * 64) = yo;
            }
            __syncthreads();
        }
    }
}

__device__ __constant__ float RET_LG2[6] = {-0.04580368961312479f, -0.02272007650008353f, -0.011315313227834146f, -0.005646563141142063f, -0.0028205190623786626f, -0.0014095702546713536f};
__device__ __forceinline__ void ph_ret_prep(const Ctx& C) {
    unsigned char* ws = C.ws;
    const bf16* P = (const bf16*)(ws + WS_P); const f32x2* CS = (const f32x2*)(ws + WS_CS);
    bf16* QR = (bf16*)(ws + WS_QR); bf16* KR = (bf16*)(ws + WS_KR); bf16* KDT = (bf16*)(ws + WS_KDT); bf16* VT = (bf16*)(ws + WS_VT);
    for (int u = C.bid; u < 1536; u += C.G) {
        const int c = u & 15, bh = u >> 4, h = bh % 6, b = bh / 6, m0 = b * SEQ + c * 128;
        const float lg2 = RET_LG2[h];
        for (int task = C.tid; task < 1536; task += NTHR) {
            if (task < 512) {
                const bool isk = task >= 256; const int tk = task & 255, i0 = 4 * (tk & 15), tg = tk >> 4;
                const int colb = (isk ? 768 : 0) + h * 128 + i0; const float scl = isk ? 0.08838834764831845f : 1.0f;
                bf16* N = isk ? KR : QR;
                float o1[4][8], o2[4][8];
#pragma unroll
                for (int j = 0; j < 8; ++j) { const int m = m0 + tg * 8 + j;
                    const u32x2 a = *(const u32x2*)(P + (size_t)m * LDP_RET + colb), b2 = *(const u32x2*)(P + (size_t)m * LDP_RET + colb + 64);
                    const f32x4 cs01 = *(const f32x4*)(CS + (size_t)m * 64 + i0), cs23 = *(const f32x4*)(CS + (size_t)m * 64 + i0 + 2);
                    const float x1[4] = {bflo(a.x), bfhi(a.x), bflo(a.y), bfhi(a.y)}, x2[4] = {bflo(b2.x), bfhi(b2.x), bflo(b2.y), bfhi(b2.y)};
                    const float cc[4] = {cs01[0], cs01[2], cs23[0], cs23[2]}, sn[4] = {cs01[1], cs01[3], cs23[1], cs23[3]};
#pragma unroll
                    for (int q = 0; q < 4; ++q) { o1[q][j] = (x1[q] * cc[q] - x2[q] * sn[q]) * scl; o2[q][j] = (x1[q] * sn[q] + x2[q] * cc[q]) * scl; }
                    u32x2 w1, w2; w1.x = cvt_pk_bf16(o1[0][j], o1[1][j]); w1.y = cvt_pk_bf16(o1[2][j], o1[3][j]); w2.x = cvt_pk_bf16(o2[0][j], o2[1][j]); w2.y = cvt_pk_bf16(o2[2][j], o2[3][j]);
                    *(u32x2*)(N + (size_t)m * 768 + h * 128 + i0) = w1; *(u32x2*)(N + (size_t)m * 768 + h * 128 + i0 + 64) = w2; }
                if (isk) {
                    float kd[8];
#pragma unroll
                    for (int j = 0; j < 8; ++j) kd[j] = exp2f((float)(127 - (tg * 8 + j)) * lg2);
#pragma unroll
                    for (int q = 0; q < 4; ++q) {
                        u32x4 w1, w2;
                        w1.x = cvt_pk_bf16(o1[q][0] * kd[0], o1[q][1] * kd[1]); w1.y = cvt_pk_bf16(o1[q][2] * kd[2], o1[q][3] * kd[3]); w1.z = cvt_pk_bf16(o1[q][4] * kd[4], o1[q][5] * kd[5]); w1.w = cvt_pk_bf16(o1[q][6] * kd[6], o1[q][7] * kd[7]);
                        w2.x = cvt_pk_bf16(o2[q][0] * kd[0], o2[q][1] * kd[1]); w2.y = cvt_pk_bf16(o2[q][2] * kd[2], o2[q][3] * kd[3]); w2.z = cvt_pk_bf16(o2[q][4] * kd[4], o2[q][5] * kd[5]); w2.w = cvt_pk_bf16(o2[q][6] * kd[6], o2[q][7] * kd[7]);
                        *(u32x4*)(KDT + (size_t)(bh * 128 + i0 + q) * SEQ + c * 128 + tg * 8) = w1;
                        *(u32x4*)(KDT + (size_t)(bh * 128 + i0 + q + 64) * SEQ + c * 128 + tg * 8) = w2; }
                }
            } else {
                const int tv = task - 512, e0 = 4 * (tv & 63), tg = tv >> 6;
                u32x2 vin[8];
#pragma unroll
                for (int j = 0; j < 8; ++j) vin[j] = *(const u32x2*)(P + (size_t)(m0 + tg * 8 + j) * LDP_RET + 1536 + h * 256 + e0);
                u32x4 w0, w1, w2, w3;
#define PKLO(a_, b_) (((a_) & 0xffffu) | ((b_) << 16))
#define PKHI(a_, b_) (((a_) >> 16) | ((b_) & 0xffff0000u))
                w0.x = PKLO(vin[0].x, vin[1].x); w0.y = PKLO(vin[2].x, vin[3].x); w0.z = PKLO(vin[4].x, vin[5].x); w0.w = PKLO(vin[6].x, vin[7].x);
                w1.x = PKHI(vin[0].x, vin[1].x); w1.y = PKHI(vin[2].x, vin[3].x); w1.z = PKHI(vin[4].x, vin[5].x); w1.w = PKHI(vin[6].x, vin[7].x);
                w2.x = PKLO(vin[0].y, vin[1].y); w2.y = PKLO(vin[2].y, vin[3].y); w2.z = PKLO(vin[4].y, vin[5].y); w2.w = PKLO(vin[6].y, vin[7].y);
                w3.x = PKHI(vin[0].y, vin[1].y); w3.y = PKHI(vin[2].y, vin[3].y); w3.z = PKHI(vin[4].y, vin[5].y); w3.w = PKHI(vin[6].y, vin[7].y);
#undef PKLO
#undef PKHI
                bf16* vt = VT + (size_t)(bh * 256 + e0) * SEQ + c * 128 + tg * 8;
                *(u32x4*)vt = w0; *(u32x4*)(vt + SEQ) = w1; *(u32x4*)(vt + 2 * SEQ) = w2; *(u32x4*)(vt + 3 * SEQ) = w3;
            }
        }
    }
}
__device__ __forceinline__ void ph_ret_kv(const Ctx& C) {
    unsigned char* ws = C.ws;
    const bf16* KDT = (const bf16*)(ws + WS_KDT); const bf16* VT = (const bf16*)(ws + WS_VT); bf16* KVT = (bf16*)(ws + WS_KVT);
    const int g = C.lane >> 4, r16 = C.lane & 15, w = C.wave;
    LAS unsigned char* LKt = C.lds; LAS unsigned char* LV = C.lds + 32768;
    u32x4 st[12];
#define KV_ISSUE(u_) do { const int c_ = (u_) & 15, bh_ = (u_) >> 4; \
        _Pragma("unroll") for (int i = 0; i < 4; ++i) { const int q = C.tid + 512 * i, row = q >> 4, pc = q & 15; st[i] = *(const u32x4*)(KDT + (size_t)(bh_ * 128 + row) * SEQ + c_ * 128 + pc * 8); } \
        _Pragma("unroll") for (int i = 0; i < 8; ++i) { const int q = C.tid + 512 * i, row = q >> 4, pc = q & 15; st[4 + i] = *(const u32x4*)(VT + (size_t)(bh_ * 256 + row) * SEQ + c_ * 128 + pc * 8); } } while (0)
#define KV_COMMIT() do { \
        _Pragma("unroll") for (int i = 0; i < 4; ++i) { const int q = C.tid + 512 * i, row = q >> 4, pc = q & 15; *(LAS u32x4*)(LKt + row * 256 + ((pc ^ (row & 15)) * 16)) = st[i]; } \
        _Pragma("unroll") for (int i = 0; i < 8; ++i) { const int q = C.tid + 512 * i, row = q >> 4, pc = q & 15; *(LAS u32x4*)(LV + row * 256 + ((pc ^ (row & 15)) * 16)) = st[4 + i]; } } while (0)
    __syncthreads();
    if (C.bid < 1536) KV_ISSUE(C.bid);
    for (int u = C.bid; u < 1536; u += C.G) {
        __syncthreads();
        KV_COMMIT();
        if (u + C.G < 1536) KV_ISSUE(u + C.G);
        __syncthreads();
        f32x4 acc[16];
#pragma unroll
        for (int et = 0; et < 16; ++et) acc[et] = (f32x4){0.f, 0.f, 0.f, 0.f};
#pragma unroll
        for (int ks = 0; ks < 4; ++ks) {
            const bf16x8 af = *(const LAS bf16x8*)(LKt + (16 * w + r16) * 256 + (((4 * ks + g) ^ r16) * 16));
#pragma unroll
            for (int et = 0; et < 16; ++et) { const bf16x8 bf = *(const LAS bf16x8*)(LV + (16 * et + r16) * 256 + (((4 * ks + g) ^ r16) * 16));
                acc[et] = __builtin_amdgcn_mfma_f32_16x16x32_bf16(af, bf, acc[et], 0, 0, 0); } }
#pragma unroll
        for (int et = 0; et < 16; ++et) { u32x2 wv; wv.x = cvt_pk_bf16(acc[et][0], acc[et][1]); wv.y = cvt_pk_bf16(acc[et][2], acc[et][3]); *(u32x2*)(KVT + ((size_t)u * 256 + 16 * et + r16) * 128 + 16 * w + 4 * g) = wv; }
    }
    __syncthreads();
#undef KV_ISSUE
#undef KV_COMMIT
}
__device__ __forceinline__ void ph_ret_prefix(const Ctx& C) {
    unsigned char* ws = C.ws;
    const bf16* KVT = (const bf16*)(ws + WS_KVT); bf16* RTB = (bf16*)(ws + WS_RTB);
    for (int idx = C.bid * NTHR + C.tid; idx < 96 * 8192; idx += C.G * NTHR) {
        const int bh = idx >> 13, rem = idx & 8191; const int h = bh % 6;
        const float cd = exp2f(128.0f * RET_LG2[h]);
        f32x4 r = (f32x4){0.f, 0.f, 0.f, 0.f};
#pragma unroll
        for (int c = 0; c < 16; ++c) { const size_t off = ((size_t)(bh * 16 + c) * 8192 + rem) * 4;
            u32x2 w; w.x = cvt_pk_bf16(r[0], r[1]); w.y = cvt_pk_bf16(r[2], r[3]); *(u32x2*)(RTB + off) = w;
            const u32x2 kw = *(const u32x2*)(KVT + off); const f32x4 kv = (f32x4){bflo(kw.x), bfhi(kw.x), bflo(kw.y), bfhi(kw.y)}; r = r * cd + kv; }
    }
}
__device__ __forceinline__ void ph_ret_out(const Ctx& C, const float* gn) {
    unsigned char* ws = C.ws;
    const bf16* P = (const bf16*)(ws + WS_P); const bf16* QR = (const bf16*)(ws + WS_QR); const bf16* KR = (const bf16*)(ws + WS_KR);
    const bf16* VT = (const bf16*)(ws + WS_VT); const bf16* RTB = (const bf16*)(ws + WS_RTB); bf16* mix = (bf16*)(ws + WS_MIX);
    const int g = C.lane >> 4, r16 = C.lane & 15, w = C.wave;
    LAS unsigned char* LR = C.lds; LAS unsigned char* LV = C.lds + 65536;
    for (int u = C.bid; u < 1536; u += C.G) {
        const int c = u & 15, bh = u >> 4, h = bh % 6, b = bh / 6, m0 = b * SEQ + c * 128;
        const float lg2 = RET_LG2[h];
        __syncthreads();
        {   u32x4 st[16];
#pragma unroll
            for (int i = 0; i < 8; ++i) { const int q = C.tid + 512 * i, row = q >> 4, pc = q & 15;
                st[i] = *(const u32x4*)(RTB + ((size_t)u * 256 + row) * 128 + pc * 8);
                st[8 + i] = *(const u32x4*)(VT + (size_t)(bh * 256 + row) * SEQ + c * 128 + pc * 8); }
#pragma unroll
            for (int i = 0; i < 8; ++i) { const int q = C.tid + 512 * i, row = q >> 4, pc = q & 15; const int off = row * 256 + ((pc ^ (row & 15)) * 16);
                *(LAS u32x4*)(LR + off) = st[i]; *(LAS u32x4*)(LV + off) = st[8 + i]; }
        }
        __syncthreads();
        const int nl = 16 * w + r16;
        bf16x8 qf[4];
#pragma unroll
        for (int s = 0; s < 4; ++s) qf[s] = *(const bf16x8*)(QR + (size_t)(m0 + nl) * 768 + h * 128 + 32 * s + 8 * g);
        f32x4 o[16];
        const float qdec = exp2f((float)(nl + 1) * lg2);
#pragma unroll
        for (int et = 0; et < 16; ++et) { f32x4 a = (f32x4){0.f, 0.f, 0.f, 0.f};
#pragma unroll
            for (int s = 0; s < 4; ++s) { const bf16x8 rf = *(const LAS bf16x8*)(LR + (16 * et + r16) * 256 + (((4 * s + g) ^ r16) * 16));
                a = __builtin_amdgcn_mfma_f32_16x16x32_bf16(rf, qf[s], a, 0, 0, 0); }
            o[et] = a * qdec; }
        u32x2 pb[8];
#pragma unroll
        for (int mt = 0; mt < 8; ++mt) {
            pb[mt] = (u32x2){0u, 0u};
            if (mt <= w) { f32x4 a = (f32x4){0.f, 0.f, 0.f, 0.f};
#pragma unroll
                for (int s = 0; s < 4; ++s) { const bf16x8 kf = *(const bf16x8*)(KR + (size_t)(m0 + 16 * mt + r16) * 768 + h * 128 + 32 * s + 8 * g);
                    a = __builtin_amdgcn_mfma_f32_16x16x32_bf16(kf, qf[s], a, 0, 0, 0); }
#pragma unroll
                for (int j = 0; j < 4; ++j) { const int diff = nl - (16 * mt + 4 * g + j); a[j] = diff >= 0 ? a[j] * exp2f((float)diff * lg2) : 0.f; }
                pb[mt].x = cvt_pk_bf16(a[0], a[1]); pb[mt].y = cvt_pk_bf16(a[2], a[3]); }
        }
#pragma unroll
        for (int ks = 0; ks < 4; ++ks) {
            if (2 * ks <= w) {
                u32x4 pw; pw.x = pb[2 * ks].x; pw.y = pb[2 * ks].y; pw.z = pb[2 * ks + 1].x; pw.w = pb[2 * ks + 1].y;
                const bf16x8 pf = __builtin_bit_cast(bf16x8, pw);
#pragma unroll
                for (int et = 0; et < 16; ++et) { const LAS unsigned char* vr = LV + (16 * et + r16) * 256;
                    const u32x2 lo = *(const LAS u32x2*)(vr + (((8 * ks + g) ^ (2 * r16)) * 8)), hi = *(const LAS u32x2*)(vr + (((8 * ks + 4 + g) ^ (2 * r16)) * 8));
                    u32x4 vw; vw.x = lo.x; vw.y = lo.y; vw.z = hi.x; vw.w = hi.y;
                    o[et] = __builtin_amdgcn_mfma_f32_16x16x32_bf16(__builtin_bit_cast(bf16x8, vw), pf, o[et], 0, 0, 0); } }
        }
        float s1 = 0.f;
#pragma unroll
        for (int et = 0; et < 16; ++et) s1 += (o[et][0] + o[et][1]) + (o[et][2] + o[et][3]);
        s1 += __shfl_xor(s1, 16); s1 += __shfl_xor(s1, 32);
        const float mean = s1 * (1.f / 256.f); float s2 = 0.f;
#pragma unroll
        for (int et = 0; et < 16; ++et) { o[et] = o[et] - mean; s2 += (o[et][0] * o[et][0] + o[et][1] * o[et][1]) + (o[et][2] * o[et][2] + o[et][3] * o[et][3]); }
        s2 += __shfl_xor(s2, 16); s2 += __shfl_xor(s2, 32);
        const float rstd = 1.0f / sqrtf(s2 * (1.f / 256.f) + 1e-5f);
        const int m = m0 + nl;
#pragma unroll
        for (int et = 0; et < 16; ++et) { const int e = h * 256 + 16 * et + 4 * g;
            const f32x4 gg = *(const f32x4*)(gn + e), gb = *(const f32x4*)(gn + SW + e);
            const u32x2 gw_ = *(const u32x2*)(P + (size_t)m * LDP_RET + 3072 + e);
            float gt[4] = {bflo(gw_.x), bfhi(gw_.x), bflo(gw_.y), bfhi(gw_.y)}; float ov[4];
#pragma unroll
            for (int j = 0; j < 4; ++j) { const float yn = o[et][j] * rstd * gg[j] + gb[j]; ov[j] = yn * gt[j] * sigmoidf_(gt[j]); }
            u32x2 wv; wv.x = cvt_pk_bf16(ov[0], ov[1]); wv.y = cvt_pk_bf16(ov[2], ov[3]);
            *(u32x2*)(mix + (size_t)m * D + e) = wv; }
    }
    __syncthreads();
}

constexpr int PH_PER_PAIR = 23, NPH = 2 + 2 * PH_PER_PAIR;
__global__ void __launch_bounds__(NTHR, 2) fwd_kernel(Args args) {
    extern __shared__ __attribute__((aligned(16))) unsigned char lds_raw[];
    Ctx C;
    C.lds = (LAS unsigned char*)lds_raw;
    C.tid = threadIdx.x; C.lane = C.tid & 63; C.wave = __builtin_amdgcn_readfirstlane(C.tid >> 6);
    C.bid = blockIdx.x; C.G = GRID; C.gw = C.bid * NWAVES + C.wave; C.NGW = C.G * NWAVES; C.ws = args.ws;
    for (int u = C.tid; u < (LDS_BYTES - LDS_MISC) / 4; u += NTHR) ((LAS unsigned*)(C.lds + LDS_MISC))[u] = 0u;
    __syncthreads();
    const int lo = args.ph_lo, hi = args.ph_hi;
    XcdBarrier bar; bar.bar = (unsigned*)(args.ws + WS_CTL) + CW_BAR; bar.x = 0; bar.st = nullptr;
    if (hi - lo > 1) bar = xcd_barrier_post((unsigned*)(args.ws + WS_CTL) + CW_BAR, (volatile LAS unsigned*)(C.lds + LDS_MISC));
#ifndef ENMASK
#define ENMASK 0x1ffffffu
#endif
#define EN(j) ((((unsigned)(ENMASK)) >> (j)) & 1u)
#ifndef DBLMASK
#define DBLMASK 0u
#endif
#define REP(j) for (int rep_ = 0; rep_ < 1 + (int)((((unsigned)(DBLMASK)) >> (j)) & 1u); ++rep_)
#define IN(k) (lo <= (k) && (k) < hi)
#define SEAM(k) do { if (IN((k) + 1)) xcd_barrier(bar, Cq.tid == 0); } while (0)

#define PH_BEGIN Ctx Cq; Cq.lds = C.lds; Cq.lane = lane_id_asm(); Cq.wave = opq_i(C.wave); Cq.tid = Cq.wave * 64 + Cq.lane; Cq.bid = opq_i((int)blockIdx.x); Cq.G = GRID; \
        Cq.gw = Cq.bid * NWAVES + Cq.wave; Cq.NGW = Cq.G * NWAVES; Cq.ws = opq(args.ws); unsigned char* ws = Cq.ws; const int lq = opq_i(lp); (void)ws; (void)lq
    { const int lp = 0;
    REP(0) if (EN(0) && IN(0)) { PH_BEGIN; ph_prologue(Cq, args); SEAM(0); }
    REP(1) if (EN(1) && IN(1)) { PH_BEGIN;
        pg8::SchedMem S; S.G = Cq.G; S.c = Cq.bid; S.memb = (unsigned)WS_MEMB; S.wkv = (unsigned)WS_WKV;
        pg8::EpiMem E; E.O0 = (bf16*)(ws + WS_MEMK); E.O1 = (bf16*)(ws + WS_MEMVT);
        pg8::gemm_phase<pg8::EpiMem, pg8::SchedMem, true, true>(Cq.lds, Cq.tid, (const char*)ws, 2048, 2048, 2048, S, E);
        SEAM(1);
    } }
#pragma unroll 1
    for (int lp = 0; lp < 2; ++lp) {
        const int pb = 2 + lp * PH_PER_PAIR;
        REP(2) if (EN(2) && IN(pb + 0)) {
            PH_BEGIN;
            pg8::SchedPlain S; S.init(M / 256, 22, Cq.G, Cq.bid); S.A0 = (unsigned)(WS_XB); S.B0 = (unsigned)(WS_WIN + (size_t)(2 * lq) * 22 * MiB); S.at = (unsigned)(256 * 2048 * 2); S.bt = (unsigned)(256 * 2048 * 2);
            pg8::EpiBf16 E; E.O = (bf16*)(ws + WS_P); E.ldc = LDP_RW;
            pg8::gemm_phase<pg8::EpiBf16, pg8::SchedPlain, true, true>(Cq.lds, Cq.tid, (const char*)ws, 2048, 2048, 2048, S, E);
            SEAM(pb + 0);
        }
        REP(3) if (EN(3) && IN(pb + 1)) { PH_BEGIN; const bool with_v = lq == 1; ph_rwkv_prep1(Cq, args.in[lq ? L2_MU : L0_MU], with_v); ph_memattn(Cq, (const bf16*)(ws + WS_P), LDP_RW, with_v ? 5120 : 5056); SEAM(pb + 1); }
        REP(4) if (EN(4) && IN(pb + 2)) {
            PH_BEGIN; const float* vecs = args.in[lq ? L2_VECS : L0_VECS];
            pg8::SchedLora S; S.skipv = lq == 0; S.init(M / 256, lq == 0 ? 18 : 24, Cq.G, Cq.bid); S.A0 = (unsigned)(WS_ALORA); S.B0 = (unsigned)(WS_WLORA + (size_t)lq * 3 * MiB);
            pg8::EpiLora E; E.O = (bf16*)(ws + WS_LORAOUT); E.vecs = vecs;
            pg8::gemm_phase<pg8::EpiLora, pg8::SchedLora, true, true>(Cq.lds, Cq.tid, (const char*)ws, 512, 256, opq_i(256), S, E);
            SEAM(pb + 2);
        }
        REP(5) if (EN(5) && IN(pb + 3)) { PH_BEGIN; ph_rwkv_prep2(Cq, args.in[lq ? L2_MU : L0_MU], args.in[lq ? L2_VECS : L0_VECS], lq == 1); SEAM(pb + 3); }
        REP(6) if (EN(6) && IN(pb + 4)) { PH_BEGIN; ph_rwkv_scan(Cq, args.in[lq ? L3_MG : L1_MG], args.in[lq ? L3_MU_ : L1_MU_], args.in[lq ? L3_MD : L1_MD], args.in[lq ? L2_VECS : L0_VECS], lq == 1); SEAM(pb + 4); }
        REP(8) if (EN(8) && IN(pb + 6)) {
            PH_BEGIN;
            pg8::SchedPlain S; S.init(M / 256, 8, Cq.G, Cq.bid); S.A0 = (unsigned)(WS_MIX); S.B0 = (unsigned)(WS_WOUT + (size_t)(2 * lq) * 8 * MiB); S.at = (unsigned)(256 * 2048 * 2); S.bt = (unsigned)(256 * 2048 * 2);
            pg8::EpiBf16 E; E.O = (bf16*)(ws + WS_P); E.ldc = D;
            pg8::gemm_phase<pg8::EpiBf16, pg8::SchedPlain, true, true>(Cq.lds, Cq.tid, (const char*)ws, 2048, 2048, 2048, S, E);
            SEAM(pb + 6);
        }
        REP(9) if (EN(9) && IN(pb + 7)) { PH_BEGIN; const float* nr = args.in[lq ? L2_NORMS : L0_NORMS];
            ph_ln(Cq, ws + WS_P, 0, nr, nr + D, nullptr, ws + WS_X8, nullptr, false); SEAM(pb + 7); }
        REP(10) if (EN(10) && IN(pb + 8)) {
            PH_BEGIN;
            pg8::SchedPlain S; S.init(M / 256, 44, Cq.G, Cq.bid); S.A0 = (unsigned)(WS_X8); S.B0 = (unsigned)(WS_WFGU + (size_t)lq * 44 * MiB); S.at = (unsigned)(256 * 2048); S.bt = (unsigned)(256 * 2048);
            pg8::EpiSwiglu8 E; E.O = ws + WS_HID; E.ldc = DFF; E.inv = 1.0f / 16384.0f; E.so = 32.0f;
            pg8::gemm_phase<pg8::EpiSwiglu8, pg8::SchedPlain, true, true, true>(Cq.lds, Cq.tid, (const char*)ws, 1024, 1024, 1024, S, E);
            SEAM(pb + 8);
        }
        REP(11) if (EN(11) && IN(pb + 9)) {
            PH_BEGIN;
            pg8::SchedPlain S; S.init(M / 256, 8, Cq.G, Cq.bid); S.A0 = (unsigned)(WS_HID); S.B0 = (unsigned)(WS_WFD + (size_t)lq * 22 * MiB); S.at = (unsigned)(256 * DFF); S.bt = (unsigned)(256 * DFF);
            pg8::EpiFp8S E; E.O = ws + WS_P; E.ldc = D; E.sc = 1.0f / 256.0f;
            pg8::gemm_phase<pg8::EpiFp8S, pg8::SchedPlain, true, true, true>(Cq.lds, Cq.tid, (const char*)ws, DFF / 2, DFF / 2, DFF / 2, S, E);
            SEAM(pb + 9);
        }
        REP(12) if (EN(12) && IN(pb + 10)) { PH_BEGIN; const float* nr = args.in[lq ? L2_NORMS : L0_NORMS];
            ph_ln(Cq, ws + WS_P, 1, nr + 2 * D, nr + 3 * D, nullptr, nullptr, nullptr, false); SEAM(pb + 10); }
        REP(13) if (EN(13) && IN(pb + 11)) {
            PH_BEGIN;
            pg8::SchedPlain S; S.init(M / 256, 20, Cq.G, Cq.bid); S.A0 = (unsigned)(WS_XB); S.B0 = (unsigned)(WS_WIN + (size_t)(2 * lq + 1) * 22 * MiB); S.at = (unsigned)(256 * 2048 * 2); S.bt = (unsigned)(256 * 2048 * 2);
            pg8::EpiBf16 E; E.O = (bf16*)(ws + WS_P); E.ldc = LDP_RET;
            pg8::gemm_phase<pg8::EpiBf16, pg8::SchedPlain, true, true>(Cq.lds, Cq.tid, (const char*)ws, 2048, 2048, 2048, S, E);
            SEAM(pb + 11);
        }
        REP(14) if (EN(14) && IN(pb + 12)) { PH_BEGIN; ph_ret_prep(Cq); ph_memattn(Cq, (const bf16*)(ws + WS_P), LDP_RET, 4608); SEAM(pb + 12); }
        REP(15) if (EN(15) && IN(pb + 13)) { PH_BEGIN; ph_ret_kv(Cq); SEAM(pb + 13); }
        REP(16) if (EN(16) && IN(pb + 14)) { PH_BEGIN; ph_ret_prefix(Cq); SEAM(pb + 14); }
        REP(17) if (EN(17) && IN(pb + 15)) { PH_BEGIN; ph_ret_out(Cq, args.in[lq ? L3_GN : L1_GN]); SEAM(pb + 15); }
        REP(18) if (EN(18) && IN(pb + 16)) {
            PH_BEGIN;
            pg8::SchedPlain S; S.init(M / 256, 8, Cq.G, Cq.bid); S.A0 = (unsigned)(WS_MIX); S.B0 = (unsigned)(WS_WOUT + (size_t)(2 * lq + 1) * 8 * MiB); S.at = (unsigned)(256 * 2048 * 2); S.bt = (unsigned)(256 * 2048 * 2);
            pg8::EpiBf16 E; E.O = (bf16*)(ws + WS_P); E.ldc = D;
            pg8::gemm_phase<pg8::EpiBf16, pg8::SchedPlain, true, true>(Cq.lds, Cq.tid, (const char*)ws, 2048, 2048, 2048, S, E);
            SEAM(pb + 16);
        }
        REP(19) if (EN(19) && IN(pb + 17)) {
            PH_BEGIN; const float* nr = args.in[lq ? L3_NORMS : L1_NORMS];
            REP(25) { ph_ln(Cq, ws + WS_P, 0, nr, nr + D, nullptr, ws + WS_X8, args.in[lq ? L3_ROUTER : L1_ROUTER], true);
            __syncthreads(); }
            SEAM(pb + 17);
        }
        REP(20) if (EN(20) && IN(pb + 18)) { PH_BEGIN; ph_slots(Cq); SEAM(pb + 18); }
        REP(22) if (EN(22) && IN(pb + 20)) {
            PH_BEGIN;
            const int nT = __builtin_amdgcn_readfirstlane(((const int*)(ws + WS_CTL))[CW_NT]);
            pg8::SchedMoEg S; S.init(nT, 44, Cq.G, Cq.bid); S.B0 = (unsigned)(WS_MWGU); S.bt = (unsigned)(256 * 2048); S.be = (unsigned)(22 * MiB);
            S.xoff = (unsigned)WS_X8; S.zoff = (unsigned)(WS_CTL + 512 * 1024); S.texp = (const int*)(ws + WS_CTL) + CW_TEXP; S.slot_tok = (const int*)(ws + WS_SLOTTOK);
            pg8::EpiSwiglu8 E; E.O = ws + WS_HIDM; E.ldc = DFF; E.inv = 1.0f / 16384.0f; E.so = 32.0f;
            pg8::gemm_phase<pg8::EpiSwiglu8, pg8::SchedMoEg, true, true, true>(Cq.lds, Cq.tid, (const char*)ws, 1024, 1024, 1024, S, E);
            SEAM(pb + 20);
        }
        REP(23) if (EN(23) && IN(pb + 21)) {
            PH_BEGIN;
            const int nT = __builtin_amdgcn_readfirstlane(((const int*)(ws + WS_CTL))[CW_NT]);
            pg8::SchedMoE S; S.init(nT, 8, Cq.G, Cq.bid); S.A0 = (unsigned)(WS_HIDM); S.B0 = (unsigned)(WS_MWD); S.at = (unsigned)(256 * DFF); S.bt = (unsigned)(256 * DFF); S.be = (unsigned)(11 * MiB);
            S.texp = (const int*)(ws + WS_CTL) + CW_TEXP;
            pg8::EpiFp8S E; E.O = ws + WS_XPERM; E.ldc = D; E.sc = 1.0f / 256.0f;
            pg8::gemm_phase<pg8::EpiFp8S, pg8::SchedMoE, true, true, true>(Cq.lds, Cq.tid, (const char*)ws, DFF / 2, DFF / 2, DFF / 2, S, E);
            SEAM(pb + 21);
        }
        REP(24) if (EN(24) && IN(pb + 22)) {
            PH_BEGIN; const float* nr = args.in[lq ? L3_NORMS : L1_NORMS];
            ph_ln(Cq, ws + WS_XPERM, 2, nr + 2 * D, nr + 3 * D, lq == 1 ? args.out : nullptr, nullptr, nullptr, false);
            SEAM(pb + 22);
        }
    }
#undef IN
#undef SEAM
}

#ifndef MK_PER_PHASE
#define MK_PER_PHASE 0
#endif
extern "C" void kernel_launch(void* const* d_in, const int* in_sizes, int n_in, void* d_out, int out_size, void* d_ws, size_t ws_size, hipStream_t stream) {
    static int ready = 0;
    if (ready == 0) {
        ready = 1;
        if (n_in != 43 || out_size != M * D || ws_size < WS_END) { fprintf(stderr, "kernel_launch: unexpected problem (n_in %d out %d ws %zu need %zu)\n", n_in, out_size, ws_size, (size_t)WS_END); ready = -1; }
        else if (hipFuncSetAttribute((const void*)fwd_kernel, hipFuncAttributeMaxDynamicSharedMemorySize, LDS_BYTES) != hipSuccess) { fprintf(stderr, "kernel_launch: hipFuncSetAttribute failed\n"); ready = -1; }
        (void)hipGetLastError();
    }
    if (ready < 0) return;
    (void)hipMemsetAsync((char*)d_ws + WS_CTL, 0, CTL_BYTES, stream);
    Args a{};
    for (int i = 0; i < 43; ++i) a.in[i] = (const float*)d_in[i];
    a.out = (float*)d_out; a.ws = (unsigned char*)d_ws;
#if MK_PER_PHASE
    for (int p = 0; p < NPH; ++p) { a.ph_lo = p; a.ph_hi = p + 1; hipLaunchKernelGGL(fwd_kernel, dim3(GRID), dim3(NTHR), LDS_BYTES, stream, a); }
#else
    a.ph_lo = 0; a.ph_hi = NPH;
    hipLaunchKernelGGL(fwd_kernel, dim3(GRID), dim3(NTHR), LDS_BYTES, stream, a);
#endif
}
```

```cpp
#include <hip/hip_runtime.h>
#include <cstdio>
#include <cstdint>

#define LAS __attribute__((address_space(3)))
#define GAS __attribute__((address_space(1)))
typedef unsigned short bf16;
typedef short bf16x8 __attribute__((ext_vector_type(8)));
typedef float f32x4 __attribute__((ext_vector_type(4)));
typedef float f32x2 __attribute__((ext_vector_type(2)));
typedef unsigned u32x4 __attribute__((ext_vector_type(4)));
typedef unsigned u32x2 __attribute__((ext_vector_type(2)));

constexpr int M = 32768, D = 2048, SEQ = 2048, NB = 16;
constexpr int SW = 1536;
constexpr int LDP_RW = 5632, LDP_RET = 5120;
constexpr int DFF = 5632;
constexpr int NSLOT = 67584;
constexpr float ALPHA = 1.6817928305074290f;
constexpr float LN_EPS = 1e-5f;
constexpr int NWAVES = 8, NTHR = 512, GRID = 256;

constexpr size_t MiB = 1u << 20;
constexpr size_t WS_CTL = 0, CTL_BYTES = 1 * MiB;
constexpr size_t WS_WKV = 1 * MiB;
constexpr size_t WS_WIN = WS_WKV + 4 * MiB;
constexpr size_t WS_WOUT = WS_WIN + 88 * MiB;
constexpr size_t WS_WLORA = WS_WOUT + 32 * MiB;
constexpr size_t WS_WFGU = WS_WLORA + 6 * MiB;
constexpr size_t WS_WFD = WS_WFGU + 88 * MiB;
constexpr size_t WS_MEMB = WS_WFD + 44 * MiB;
constexpr size_t WS_MEMK = WS_MEMB + 16 * MiB;
constexpr size_t WS_MEMVT = WS_MEMK + 4 * MiB;
constexpr size_t WS_CS = WS_MEMVT + 4 * MiB;
constexpr size_t WS_XB = WS_CS + 16 * MiB;
constexpr size_t WS_MIX = WS_XB + 128 * MiB;
constexpr size_t WS_VFIRST = WS_MIX + 128 * MiB;
constexpr size_t WS_P = WS_VFIRST + 96 * MiB;
constexpr size_t WS_MISC = WS_P + 352 * MiB;
constexpr size_t WS_ROUTE = WS_MISC, WS_SLOT1 = WS_MISC + 512 * 1024, WS_SLOT2 = WS_SLOT1 + 128 * 1024, WS_SLOTTOK = WS_SLOT2 + 128 * 1024;
constexpr size_t WS_BONUS = WS_MISC + 2 * MiB;
constexpr size_t WS_SB = WS_BONUS + 3 * MiB;
constexpr size_t WS_ALORA = WS_SB, WS_LORAOUT = WS_SB + 32 * MiB, WS_SCANIN = WS_SB + 416 * MiB;
constexpr size_t WS_QR = WS_SB, WS_KR = WS_SB + 48 * MiB, WS_KDT = WS_SB + 96 * MiB, WS_VT = WS_SB + 144 * MiB, WS_KVT = WS_SB + 240 * MiB, WS_RTB = WS_SB + 432 * MiB;
constexpr size_t WS_HID = WS_SB;
constexpr size_t WS_XPERM = WS_SB, WS_HIDM = WS_SB + 264 * MiB, WS_MWGU = WS_SB + 1184 * MiB, WS_MWD = WS_SB + 1360 * MiB;
constexpr size_t WS_XLO = WS_SB + 1518 * MiB;
constexpr size_t WS_X8 = WS_XLO + 64 * MiB;
constexpr size_t WS_END = WS_X8 + 64 * MiB;
constexpr int CW_BAR = 4096;
constexpr int CW_CNT = 16384;
constexpr int CW_NT = 20480;
constexpr int CW_TEXP = 20544;

constexpr int RING_BYTES = 131072;
constexpr int LDS_MISC = RING_BYTES;
constexpr int LDS_BYTES = RING_BYTES + 8192;

#define LDS_WAIT() asm volatile("s_waitcnt lgkmcnt(0)" ::: "memory")
#define VM_WAIT() asm volatile("s_waitcnt vmcnt(0)" ::: "memory")
__device__ __forceinline__ unsigned cvt_pk_bf16(float lo, float hi) { unsigned r; asm volatile("v_cvt_pk_bf16_f32 %0, %1, %2" : "=v"(r) : "v"(lo), "v"(hi)); return r; }
__device__ __forceinline__ bf16 f2bf(float f) { return (bf16)(cvt_pk_bf16(f, 0.f) & 0xffffu); }
__device__ __forceinline__ float bf2f(bf16 b) { return __uint_as_float(((unsigned)b) << 16); }
__device__ __forceinline__ float bflo(unsigned w) { return __uint_as_float(w << 16); }
__device__ __forceinline__ float bfhi(unsigned w) { return __uint_as_float(w & 0xffff0000u); }
template <int CTRL> __device__ __forceinline__ float dpp_add(float x) {
    int y = __builtin_amdgcn_update_dpp(0, __float_as_int(x), CTRL, 0xf, 0xf, true);
    return x + __int_as_float(y);
}
__device__ __forceinline__ float row16_sum(float x) { x = dpp_add<0xB1>(x); x = dpp_add<0x4E>(x); x = dpp_add<0x141>(x); x = dpp_add<0x140>(x); return x; }
__device__ __forceinline__ float wave_sum(float v) {
    v = row16_sum(v);
    const float a = __int_as_float(__builtin_amdgcn_readlane(__float_as_int(v), 0)), b = __int_as_float(__builtin_amdgcn_readlane(__float_as_int(v), 16));
    const float c = __int_as_float(__builtin_amdgcn_readlane(__float_as_int(v), 32)), d = __int_as_float(__builtin_amdgcn_readlane(__float_as_int(v), 48));
    return (a + b) + (c + d);
}
__device__ __forceinline__ unsigned pk4_fp8(float a, float b, float c, float d) {
    a = __builtin_amdgcn_fmed3f(a, -448.f, 448.f); b = __builtin_amdgcn_fmed3f(b, -448.f, 448.f); c = __builtin_amdgcn_fmed3f(c, -448.f, 448.f); d = __builtin_amdgcn_fmed3f(d, -448.f, 448.f);
    unsigned w = 0; w = __builtin_amdgcn_cvt_pk_fp8_f32(a, b, w, false); w = __builtin_amdgcn_cvt_pk_fp8_f32(c, d, w, true); return w; }
__device__ __forceinline__ float sigmoidf_(float z) { return __builtin_amdgcn_rcpf(1.0f + __expf(-z)); }

__device__ __forceinline__ unsigned char* opq(unsigned char* p) { asm volatile("" : "+s"(p)); return p; }
__device__ __forceinline__ int opq_i(int v) { asm volatile("" : "+s"(v)); return v; }
__device__ __forceinline__ int opq_v(int v) { asm volatile("" : "+v"(v)); return v; }
__device__ __forceinline__ int lane_id_asm() { int l; asm volatile("v_mbcnt_lo_u32_b32 %0, -1, 0\n\tv_mbcnt_hi_u32_b32 %0, -1, %0" : "=v"(l)); return l; }
#define XB_TMO      128
#define XB_XCNT(j)  (256  + 64 * (j))
#define XB_XSUB(j)  (1280 + 64 * (j))
#define XB_XGEN(j)  (2304 + 64 * (j))
#define XB_TOP      3328
#define XB_TOPGEN   3392
#define XCD_BAR_WORDS 3456
#define XB_SPIN_CAP (1u << 18)
__device__ __forceinline__ unsigned xb_ld(unsigned* p)              { return __hip_atomic_load(p, __ATOMIC_RELAXED, __HIP_MEMORY_SCOPE_AGENT); }
__device__ __forceinline__ unsigned xb_add(unsigned* p, unsigned v) { return __hip_atomic_fetch_add(p, v, __ATOMIC_RELAXED, __HIP_MEMORY_SCOPE_AGENT); }
__device__ __forceinline__ unsigned xb_xcc_id() { return (unsigned)__builtin_amdgcn_s_getreg((3 << 11) | 20) & 0xFu; }
#define XB_SPIN(cond, bar) do { unsigned _sp = 0; while (cond) { __builtin_amdgcn_s_sleep(1); \
    if ((++_sp & 255u) == 0u) { if (xb_ld(&(bar)[XB_TMO])) break; if (_sp > XB_SPIN_CAP) { atomicAdd(&(bar)[XB_TMO], 1u); break; } } } } while (0)
struct XcdBarrier { unsigned* bar; unsigned x; volatile LAS unsigned* st; };
__device__ __forceinline__ XcdBarrier xcd_barrier_post(unsigned* bar, volatile LAS unsigned* st) {
    XcdBarrier b; b.bar = bar; b.x = xb_xcc_id(); b.st = st;
    if (threadIdx.x == 0) (void)xb_add(&bar[XB_XCNT(b.x)], 1u);
    return b;
}
__device__ __forceinline__ void xcd_barrier_complete(unsigned* bar, unsigned x, unsigned& nloc, unsigned& nx) {
    const unsigned G = gridDim.x * gridDim.y * gridDim.z;
    unsigned sum, cnt, mine, sp = 0u;
    for (;;) {
        sum = 0u; cnt = 0u; mine = 0u;
#pragma unroll
        for (unsigned j = 0; j < 16; ++j) { const unsigned c = xb_ld(&bar[XB_XCNT(j)]); sum += c; cnt += (c > 0u) ? 1u : 0u; mine = (j == x) ? c : mine; }
        if (sum == G) break;
        __builtin_amdgcn_s_sleep(1);
        if ((++sp & 255u) == 0u) { if (xb_ld(&bar[XB_TMO])) break; if (sp > XB_SPIN_CAP) { atomicAdd(&bar[XB_TMO], 1u); break; } }
    }
    nloc = mine > 0u ? mine : 1u; nx = cnt > 0u ? cnt : 1u;
}
__device__ __forceinline__ void xcd_barrier(const XcdBarrier& b, const bool leader  ) {
    asm volatile("s_waitcnt vmcnt(0)" ::: "memory");
    __syncthreads();
    if (leader) {
        unsigned* bar = b.bar;
        __builtin_amdgcn_s_waitcnt(0);
        unsigned nloc = b.st[0], nx = b.st[1];
        if (nloc == 0u) { xcd_barrier_complete(bar, b.x, nloc, nx); b.st[0] = nloc; b.st[1] = nx; }
        const unsigned old = xb_add(&bar[XB_XSUB(b.x)], 1u);
        const unsigned gen = old / nloc;
        if (old + 1u == (gen + 1u) * nloc) {
            __builtin_amdgcn_fence(__ATOMIC_RELEASE, "agent");
            asm volatile("s_waitcnt vmcnt(0)" ::: "memory");
            const unsigned og = xb_add(&bar[XB_TOP], 1u);
            const unsigned tg = og / nx;
            if (og + 1u == (tg + 1u) * nx) xb_add(&bar[XB_TOPGEN], 1u);
            else XB_SPIN(xb_ld(&bar[XB_TOPGEN]) == tg, bar);
            __builtin_amdgcn_fence(__ATOMIC_ACQUIRE, "agent");
            xb_add(&bar[XB_XGEN(b.x)], 1u);
            asm volatile("s_waitcnt vmcnt(0)" ::: "memory");
        } else {
            XB_SPIN(xb_ld(&bar[XB_XGEN(b.x)]) == gen, bar);
            __builtin_amdgcn_fence(__ATOMIC_ACQUIRE, "agent");
            asm volatile("s_waitcnt vmcnt(0)" ::: "memory");
        }
    }
    __syncthreads();
}

namespace pg8 {
constexpr int BM = 256, BK = 64, HALF = 128, HTB = HALF * BK * 2, STAGE_BYTES = 8 * HTB, NXCD = 8, WGM = 8;
__host__ __device__ __forceinline__ int lds_byte(int r, int c) { const int st = (r >> 4) * 2 + (c >> 5), rr = r & 15, cc = c & 31, ob = rr * 64 + cc * 2; return st * 1024 + (ob ^ (((ob >> 9) & 1) << 5)); }
__host__ __device__ __forceinline__ void stage_rc(int b, int& R, int& C) { const int st = b / 1024, sb = b % 1024, swz = sb ^ (((sb >> 9) & 1) << 5); R = (st >> 1) * 16 + swz / 64; C = (st & 1) * 32 + (swz % 64) / 2; }
__host__ __device__ __forceinline__ int perm32(int rho) { const int n = rho >> 4, i = rho & 15; return 8 * (i >> 2) + 4 * n + (i & 3); }
typedef int i32x8 __attribute__((ext_vector_type(8)));
typedef int i32x4_ __attribute__((ext_vector_type(4)));
__device__ __forceinline__ i32x8 cat8(bf16x8 a, bf16x8 b) { const i32x4_ x = __builtin_bit_cast(i32x4_, a), y = __builtin_bit_cast(i32x4_, b); return __builtin_shufflevector(x, y, 0, 1, 2, 3, 4, 5, 6, 7); }
__device__ __forceinline__ void mfma8(f32x4& acc, const i32x8 a, const i32x8 b) {
    asm volatile("v_mfma_scale_f32_16x16x128_f8f6f4 %0, %1, %2, %0, %3, %3 op_sel_hi:[0,0,0]" : "+v"(acc) : "v"(a), "v"(b), "v"(127)); }
struct Unit { int pm, pn, z; };
struct Order {
    int nM, nN, nwg, G, c;
    __device__ __forceinline__ void init(int nM_, int nN_, int G_, int c_) { nM = nM_; nN = nN_; nwg = nM * nN; G = G_; c = c_; }
    __device__ __forceinline__ bool next_mn(int i, Unit& u) const {
        const long L = (long)i * G + c; if (L >= nwg) return false;
        int wgid = (int)L; { const int q = nwg / NXCD, r = nwg % NXCD, xcd = wgid % NXCD, off = wgid / NXCD; wgid = (xcd < r ? xcd * (q + 1) : r * (q + 1) + (xcd - r) * q) + off; }
        const int nig = WGM * nN, gid = wgid / nig, fm = gid * WGM, gsz = (nM - fm) < WGM ? (nM - fm) : WGM;
        u.pm = fm + ((wgid % nig) % gsz); u.pn = (wgid % nig) / gsz; u.z = 0; return true;
    }
};

template <class Epi, class Sched, bool ALIGN_EPI, bool SP2, bool FP8 = false>
__device__ __forceinline__ void gemm_phase(LAS unsigned char* lds, const int tid_in, const char* base  , const int lda, const int ldb, const int K, const Sched& S, const Epi& E) {
    const int tid = tid_in, wid = __builtin_amdgcn_readfirstlane(tid >> 6), lane = tid & 63, wr = wid >> 2, wc = wid & 3, fr = lane & 15, fq = lane >> 4;
    const int nt = K / BK;
    unsigned voffA[2], voffB[2];
#pragma unroll
    for (int i = 0; i < 2; ++i) { int R, C; stage_rc(tid * 16 + i * 8192, R, C); const int Rb = Epi::PERM ? ((R & ~31) + perm32(R & 31)) : R;
        voffA[i] = (unsigned)(R * lda + C) * 2u; voffB[i] = (unsigned)(Rb * ldb + C) * 2u; }
    constexpr bool GATHER = Sched::GATHER;
    unsigned gvC[2][2], gvN[2][2];
#define PG8_GV(dst, unit) do { _Pragma("unroll") for (int hh_ = 0; hh_ < 2; ++hh_) _Pragma("unroll") for (int i_ = 0; i_ < 2; ++i_) { int R_, C_; stage_rc(tid * 16 + i_ * 8192, R_, C_); \
        dst[hh_][i_] = S.arow(unit, hh_ * HALF + R_) + (unsigned)C_ * 2u; } } while (0)
    const unsigned kstep = (unsigned)(BK * 2);
    const unsigned hstepA = (unsigned)(HALF * lda * 2), hstepB = (unsigned)(HALF * ldb * 2);
    const __amdgpu_buffer_rsrc_t rsrc = __builtin_amdgcn_make_buffer_rsrc((void*)base, 0, 0xffffffffu, 0x00020000);
    const unsigned ldsw = (unsigned)wid * 1024u;
    const int aoff = lds_byte(wr * 64 + fr, fq * 8), boff = lds_byte(wc * 32 + fr, fq * 8);
#define PG8_SA(b, h) (((b) * 2 + (h)) * HTB)
#define PG8_SB(b, h) ((4 + (b) * 2 + (h)) * HTB)
#define PG8_STAGE(bufoff, goff, voff) do { _Pragma("unroll") for (int _i = 0; _i < 2; ++_i) \
        __builtin_amdgcn_raw_ptr_buffer_load_lds(rsrc, (LAS unsigned*)(lds + (bufoff) + ldsw + _i * 8192), 16, (voff)[_i], (goff), 0, 0); } while (0)
#define PG8_STAGE_A(bufoff, aoff, hh, nx) do { if constexpr (GATHER) { unsigned gv_[2]; gv_[0] = (nx) ? gvN[hh][0] : gvC[hh][0]; gv_[1] = (nx) ? gvN[hh][1] : gvC[hh][1]; PG8_STAGE(bufoff, aoff, gv_); } \
        else { PG8_STAGE(bufoff, (aoff) + (hh) * hstepA, voffA); } } while (0)
#define PG8_LDA(dst, b, h) do { _Pragma("unroll") for (int m = 0; m < 4; ++m) _Pragma("unroll") for (int k = 0; k < 2; ++k) dst[m][k] = *(const LAS bf16x8*)(lds + PG8_SA(b, h) + aoff + m * 2048 + k * 1024); } while (0)
#define PG8_LDB(dst, b, h) do { _Pragma("unroll") for (int n = 0; n < 2; ++n) _Pragma("unroll") for (int k = 0; k < 2; ++k) dst[n][k] = *(const LAS bf16x8*)(lds + PG8_SB(b, h) + boff + n * 2048 + k * 1024); } while (0)
#define PG8_MMA(ai, bj, At, Bt) do { __builtin_amdgcn_s_setprio(1); \
        if constexpr (FP8) { _Pragma("unroll") for (int m = 0; m < 4; ++m) _Pragma("unroll") for (int n = 0; n < 2; ++n) \
            mfma8(acc[ai][bj][m][n], cat8(Bt[n][0], Bt[n][1]), cat8(At[m][0], At[m][1])); } \
        else { _Pragma("unroll") for (int m = 0; m < 4; ++m) _Pragma("unroll") for (int n = 0; n < 2; ++n) _Pragma("unroll") for (int k = 0; k < 2; ++k) \
            acc[ai][bj][m][n] = __builtin_amdgcn_mfma_f32_16x16x32_bf16(Bt[n][k], At[m][k], acc[ai][bj][m][n], 0, 0, 0); } \
        __builtin_amdgcn_s_setprio(0); } while (0)
#define PG8_WAIT_V(n) asm volatile("s_waitcnt vmcnt(" #n ")" ::: "memory")
#define PG8_WAIT_L(n) asm volatile("s_waitcnt lgkmcnt(" #n ")" ::: "memory")
#define PG8_BAR __builtin_amdgcn_s_barrier()
#define PG8_SCHED __builtin_amdgcn_sched_barrier(0)
    Unit cur, nxt; int ui = 0;
    if (!S.next(0, cur)) return;
    f32x4 acc[2][2][4][2];
#pragma unroll
    for (int a = 0; a < 2; ++a)
#pragma unroll
        for (int b = 0; b < 2; ++b)
#pragma unroll
            for (int m = 0; m < 4; ++m)
#pragma unroll
                for (int n = 0; n < 2; ++n) acc[a][b][m][n] = (f32x4){0.f, 0.f, 0.f, 0.f};
    bf16x8 At[4][2], B0[2][2], B1[2][2];
    unsigned cA = S.A(cur), cB = S.B(cur);
    if constexpr (GATHER) { PG8_GV(gvC, cur); _Pragma("unroll") for (int hh_ = 0; hh_ < 2; ++hh_) _Pragma("unroll") for (int i_ = 0; i_ < 2; ++i_) gvN[hh_][i_] = gvC[hh_][i_]; }
    if constexpr (SP2) {
        PG8_STAGE(PG8_SB(0, 0), cB, voffB); PG8_STAGE(PG8_SB(0, 1), cB + hstepB, voffB); PG8_STAGE_A(PG8_SA(0, 0), cA, 0, false); PG8_STAGE_A(PG8_SA(0, 1), cA, 1, false);
        if (wr == 1) PG8_BAR;
        PG8_WAIT_V(2); PG8_BAR;
        PG8_STAGE(PG8_SB(1, 0), cB + kstep, voffB); PG8_STAGE_A(PG8_SA(1, 0), cA + kstep, 0, false); PG8_STAGE(PG8_SB(1, 1), cB + hstepB + kstep, voffB);
        PG8_WAIT_V(6); PG8_BAR;
    } else {
        PG8_STAGE(PG8_SB(0, 0), cB, voffB); PG8_STAGE_A(PG8_SA(0, 0), cA, 0, false); PG8_STAGE(PG8_SB(0, 1), cB + hstepB, voffB); PG8_STAGE_A(PG8_SA(0, 1), cA, 1, false);
        if (wr == 1) PG8_BAR;
        PG8_WAIT_V(4); PG8_BAR;
        PG8_STAGE(PG8_SB(1, 0), cB + kstep, voffB); PG8_STAGE_A(PG8_SA(1, 0), cA + kstep, 0, false); PG8_STAGE(PG8_SB(1, 1), cB + hstepB + kstep, voffB);
        PG8_WAIT_V(6); PG8_BAR;
    }
    for (;;) {
        const bool has_next = S.next(ui + 1, nxt);
        const unsigned nA = has_next ? S.A(nxt) : cA, nB = has_next ? S.B(nxt) : cB;
        if constexpr (GATHER) { if (has_next) PG8_GV(gvN, nxt); }
        for (int t = 0; t < nt; t += 2) {
            const bool last = (t == nt - 2);
            const unsigned a1 = cA + (unsigned)(t + 1) * kstep;
            const unsigned a2 = last ? nA : cA + (unsigned)(t + 2) * kstep, b2 = last ? nB : cB + (unsigned)(t + 2) * kstep;
            const unsigned a3 = a2 + kstep, b3 = b2 + kstep;
            if constexpr (SP2) {
            PG8_LDB(B0, 0, 0); PG8_LDB(B1, 0, 1); PG8_SCHED; PG8_LDA(At, 0, 0); PG8_STAGE_A(PG8_SA(1, 1), a1, 1, false);
            PG8_WAIT_V(8); PG8_WAIT_L(0); PG8_BAR; PG8_MMA(0, 0, At, B0); PG8_MMA(0, 1, At, B1); PG8_BAR; PG8_SCHED;
            PG8_LDA(At, 0, 1); PG8_STAGE(PG8_SB(0, 0), b2, voffB); PG8_STAGE(PG8_SB(0, 1), b2 + hstepB, voffB); PG8_STAGE_A(PG8_SA(0, 0), a2, 0, last);
            PG8_WAIT_V(8); PG8_WAIT_L(0); PG8_BAR; PG8_MMA(1, 0, At, B0); PG8_MMA(1, 1, At, B1); PG8_BAR; PG8_SCHED;
            PG8_LDB(B0, 1, 0); PG8_LDB(B1, 1, 1); PG8_SCHED; PG8_LDA(At, 1, 0); PG8_STAGE_A(PG8_SA(0, 1), a2, 1, last);
            PG8_WAIT_V(8); PG8_WAIT_L(0); PG8_BAR; PG8_MMA(0, 0, At, B0); PG8_MMA(0, 1, At, B1); PG8_BAR; PG8_SCHED;
            PG8_LDA(At, 1, 1); PG8_STAGE(PG8_SB(1, 0), b3, voffB); PG8_STAGE(PG8_SB(1, 1), b3 + hstepB, voffB); PG8_STAGE_A(PG8_SA(1, 0), a3, 0, last);
            PG8_WAIT_V(8); PG8_WAIT_L(0); PG8_BAR; PG8_MMA(1, 0, At, B0); PG8_MMA(1, 1, At, B1); PG8_BAR; PG8_SCHED;
            } else {
            PG8_LDB(B0, 0, 0); PG8_SCHED; PG8_LDA(At, 0, 0); PG8_STAGE_A(PG8_SA(1, 1), a1, 1, false);
            PG8_WAIT_L(8); PG8_BAR; PG8_WAIT_L(0); PG8_MMA(0, 0, At, B0); PG8_BAR; PG8_SCHED;
            PG8_LDB(B1, 0, 1); PG8_STAGE(PG8_SB(0, 0), b2, voffB);
            PG8_BAR; PG8_WAIT_L(0); PG8_MMA(0, 1, At, B1); PG8_BAR;
            PG8_LDA(At, 0, 1); PG8_STAGE_A(PG8_SA(0, 0), a2, 0, last);
            PG8_BAR; PG8_WAIT_L(0); PG8_MMA(1, 0, At, B0); PG8_BAR; PG8_SCHED;
            PG8_STAGE(PG8_SB(0, 1), b2 + hstepB, voffB);
            PG8_WAIT_V(6); PG8_BAR; PG8_MMA(1, 1, At, B1); PG8_BAR;
            PG8_LDB(B0, 1, 0); PG8_SCHED; PG8_LDA(At, 1, 0); PG8_STAGE_A(PG8_SA(0, 1), a2, 1, last);
            PG8_WAIT_L(8); PG8_BAR; PG8_WAIT_L(0); PG8_MMA(0, 0, At, B0); PG8_BAR; PG8_SCHED;
            PG8_LDB(B1, 1, 1); PG8_STAGE(PG8_SB(1, 0), b3, voffB);
            PG8_BAR; PG8_WAIT_L(0); PG8_MMA(0, 1, At, B1); PG8_BAR;
            PG8_LDA(At, 1, 1); PG8_STAGE_A(PG8_SA(1, 0), a3, 0, last);
            PG8_BAR; PG8_WAIT_L(0); PG8_MMA(1, 0, At, B0); PG8_BAR; PG8_SCHED;
            PG8_STAGE(PG8_SB(1, 1), b3 + hstepB, voffB);
            PG8_WAIT_V(6); PG8_BAR; PG8_MMA(1, 1, At, B1); PG8_BAR;
            }
        }
        if constexpr (ALIGN_EPI) { if (wr == 0) PG8_BAR; }
        if constexpr (FP8) asm volatile("s_nop 15\n\ts_nop 15\n\ts_nop 7" ::: "memory");
        E(acc, cur, wr, wc, fr, fq);
        if (!has_next) break;
#pragma unroll
        for (int a = 0; a < 2; ++a)
#pragma unroll
            for (int b = 0; b < 2; ++b)
#pragma unroll
                for (int m = 0; m < 4; ++m)
#pragma unroll
                    for (int n = 0; n < 2; ++n) acc[a][b][m][n] = (f32x4){0.f, 0.f, 0.f, 0.f};
        cur = nxt; cA = nA; cB = nB; ++ui;
        if constexpr (GATHER) { _Pragma("unroll") for (int hh_ = 0; hh_ < 2; ++hh_) _Pragma("unroll") for (int i_ = 0; i_ < 2; ++i_) gvC[hh_][i_] = gvN[hh_][i_]; }
        if constexpr (ALIGN_EPI) { if (wr == 1) PG8_BAR; }
    }
    PG8_WAIT_V(0);
    if constexpr (!ALIGN_EPI) { if (wr == 0) PG8_BAR; }
    PG8_BAR;
#undef PG8_SA
#undef PG8_SB
#undef PG8_STAGE
#undef PG8_STAGE_A
#undef PG8_GV
#undef PG8_LDA
#undef PG8_LDB
#undef PG8_MMA
#undef PG8_WAIT_V
#undef PG8_WAIT_L
#undef PG8_BAR
#undef PG8_SCHED
}

struct SchedPlain : Order {
    static constexpr bool GATHER = false; __device__ __forceinline__ unsigned arow(const Unit&, int) const { return 0u; }
    unsigned A0, B0, at, bt;
    __device__ __forceinline__ bool next(int i, Unit& u) const { return next_mn(i, u); }
    __device__ __forceinline__ unsigned A(const Unit& u) const { return A0 + (unsigned)u.pm * at; }
    __device__ __forceinline__ unsigned B(const Unit& u) const { return B0 + (unsigned)u.pn * bt; }
};
struct SchedLora : Order {
    static constexpr bool GATHER = false; __device__ __forceinline__ unsigned arow(const Unit&, int) const { return 0u; }
    unsigned A0, B0; int skipv;
    __device__ __forceinline__ bool next(int i, Unit& u) const { if (!next_mn(i, u)) return false; if (skipv && u.pn >= 12) u.pn += 6; return true; }
    __device__ __forceinline__ unsigned A(const Unit& u) const { return A0 + (unsigned)u.pm * (256u * 512u * 2u) + (u.pn >= 18 ? 512u : 0u); }
    __device__ __forceinline__ unsigned B(const Unit& u) const { return B0 + (unsigned)u.pn * (256u * 256u * 2u); }
};
struct SchedMem {
    static constexpr bool GATHER = false; __device__ __forceinline__ unsigned arow(const Unit&, int) const { return 0u; }
    int G, c; unsigned memb, wkv;
    __device__ __forceinline__ bool next(int i, Unit& u) const {
        const int L = i * G + c; if (L >= 64) return false;
        if (L < 32) { u.z = 0; u.pm = L >> 1; u.pn = L & 1; } else { const int q = L - 32; u.z = 1; u.pm = q & 1; u.pn = q >> 1; }
        return true;
    }
    __device__ __forceinline__ unsigned A(const Unit& u) const { return u.z == 0 ? memb + (unsigned)u.pm * (256u * 2048u * 2u) : wkv + (unsigned)(2 + u.pm) * (256u * 2048u * 2u); }
    __device__ __forceinline__ unsigned B(const Unit& u) const { return u.z == 0 ? wkv + (unsigned)u.pn * (256u * 2048u * 2u) : memb + (unsigned)u.pn * (256u * 2048u * 2u); }
};
struct SchedMoE : Order {
    static constexpr bool GATHER = false; __device__ __forceinline__ unsigned arow(const Unit&, int) const { return 0u; }
    unsigned A0, B0, at, bt, be; const int* texp;
    __device__ __forceinline__ bool next(int i, Unit& u) const { if (!next_mn(i, u)) return false; u.z = __builtin_amdgcn_readfirstlane(texp[u.pm]); return true; }
    __device__ __forceinline__ unsigned A(const Unit& u) const { return A0 + (unsigned)u.pm * at; }
    __device__ __forceinline__ unsigned B(const Unit& u) const { return B0 + (unsigned)u.z * be + (unsigned)u.pn * bt; }
};

struct SchedMoEg : Order {
    static constexpr bool GATHER = true;
    unsigned B0, bt, be, xoff, zoff; const int* texp; const int* slot_tok;
    __device__ __forceinline__ bool next(int i, Unit& u) const { if (!next_mn(i, u)) return false; u.z = __builtin_amdgcn_readfirstlane(texp[u.pm]); return true; }
    __device__ __forceinline__ unsigned A(const Unit&) const { return 0u; }
    __device__ __forceinline__ unsigned B(const Unit& u) const { return B0 + (unsigned)u.z * be + (unsigned)u.pn * bt; }
    __device__ __forceinline__ unsigned arow(const Unit& u, int r) const { const int tok = slot_tok[u.pm * 256 + r]; return tok < 0 ? zoff : xoff + (unsigned)tok * 2048u; }
};

struct EpiBf16 {
    static constexpr bool PERM = true;
    bf16* O; int ldc;
    __device__ __forceinline__ void operator()(const f32x4 (&acc)[2][2][4][2], const Unit& u, int wr, int wc, int fr, int fq) const {
        const int row0 = u.pm * BM + wr * 64 + fr, col0 = u.pn * BM + wc * 32 + 8 * fq;
#pragma unroll
        for (int ai = 0; ai < 2; ++ai)
#pragma unroll
            for (int m = 0; m < 4; ++m) { bf16* rowp = O + (size_t)(row0 + ai * HALF + m * 16) * ldc + col0;
#pragma unroll
                for (int bj = 0; bj < 2; ++bj) { const f32x4 v0 = acc[ai][bj][m][0], v1 = acc[ai][bj][m][1];
                    u32x4 w; w.x = cvt_pk_bf16(v0[0], v0[1]); w.y = cvt_pk_bf16(v0[2], v0[3]); w.z = cvt_pk_bf16(v1[0], v1[1]); w.w = cvt_pk_bf16(v1[2], v1[3]);
                    *(u32x4*)(rowp + bj * HALF) = w; } }
    }
};
struct EpiMem {
    static constexpr bool PERM = true;
    bf16* O0; bf16* O1;
    __device__ __forceinline__ void operator()(const f32x4 (&acc)[2][2][4][2], const Unit& u, int wr, int wc, int fr, int fq) const {
        EpiBf16 e; e.O = u.z == 0 ? O0 : O1; e.ldc = u.z == 0 ? 512 : 4096; e(acc, u, wr, wc, fr, fq);
    }
};
struct EpiLora {
    static constexpr bool PERM = true;
    bf16* O; const float* vecs;
    __device__ __forceinline__ void operator()(const f32x4 (&acc)[2][2][4][2], const Unit& u, int wr, int wc, int fr, int fq) const {
        const int type = u.pn / 6;
        const int row0 = u.pm * BM + wr * 64 + fr, col0 = u.pn * BM + wc * 32 + 8 * fq, cb0 = (u.pn % 6) * BM + wc * 32 + 8 * fq;
        const float* bp = vecs + (type < 3 ? type : 0) * SW;
        const float sc = type == 0 ? 0.6065306597126334f : 1.0f;
#pragma unroll
        for (int bj = 0; bj < 2; ++bj) {
            f32x4 bv0 = (f32x4){0.f, 0.f, 0.f, 0.f}, bv1 = bv0;
            if (type < 3) { bv0 = *(const f32x4*)(bp + cb0 + bj * HALF); bv1 = *(const f32x4*)(bp + cb0 + bj * HALF + 4); }
#pragma unroll
            for (int ai = 0; ai < 2; ++ai)
#pragma unroll
                for (int m = 0; m < 4; ++m) { bf16* rowp = O + (size_t)(row0 + ai * HALF + m * 16) * 6144 + col0 + bj * HALF;
                    f32x4 v0_ = acc[ai][bj][m][0] + bv0, v1_ = acc[ai][bj][m][1] + bv1;
                    if (type < 3) {
#pragma unroll
                        for (int j = 0; j < 4; ++j) { v0_[j] = sc * sigmoidf_(v0_[j]); v1_[j] = sc * sigmoidf_(v1_[j]); } }
                    u32x4 w; w.x = cvt_pk_bf16(v0_[0], v0_[1]); w.y = cvt_pk_bf16(v0_[2], v0_[3]); w.z = cvt_pk_bf16(v1_[0], v1_[1]); w.w = cvt_pk_bf16(v1_[2], v1_[3]);
                    *(u32x4*)rowp = w; asm volatile("" ::: "memory"); }
        }
    }
};
struct EpiSwiglu {
    static constexpr bool PERM = true;
    bf16* O; int ldc;
    __device__ __forceinline__ void operator()(const f32x4 (&acc)[2][2][4][2], const Unit& u, int wr, int wc, int fr, int fq) const {
        const int row0 = u.pm * BM + wr * 64 + fr, col0 = u.pn * HALF + wc * 32 + 8 * fq;
#pragma unroll
        for (int ai = 0; ai < 2; ++ai)
#pragma unroll
            for (int m = 0; m < 4; ++m) { bf16* rowp = O + (size_t)(row0 + ai * HALF + m * 16) * ldc + col0;
                float h[8];
#pragma unroll
                for (int n = 0; n < 2; ++n)
#pragma unroll
                    for (int j = 0; j < 4; ++j) { const float g = acc[ai][0][m][n][j], up = acc[ai][1][m][n][j]; h[n * 4 + j] = g * sigmoidf_(g) * up; }
                u32x4 w; w.x = cvt_pk_bf16(h[0], h[1]); w.y = cvt_pk_bf16(h[2], h[3]); w.z = cvt_pk_bf16(h[4], h[5]); w.w = cvt_pk_bf16(h[6], h[7]);
                *(u32x4*)rowp = w; asm volatile("" ::: "memory"); }
    }
};
struct EpiSwiglu8 {
    static constexpr bool PERM = true;
    unsigned char* O; int ldc; float inv, so;
    __device__ __forceinline__ void operator()(const f32x4 (&acc)[2][2][4][2], const Unit& u, int wr, int wc, int fr, int fq) const {
        const int row0 = u.pm * BM + wr * 64 + fr, col0 = u.pn * HALF + wc * 32 + 8 * fq;
        const float c1 = -inv * 1.4426950408889634f, c2 = inv * inv * so;
#pragma unroll
        for (int ai = 0; ai < 2; ++ai)
#pragma unroll
            for (int m = 0; m < 4; ++m) { unsigned char* rowp = O + (size_t)(row0 + ai * HALF + m * 16) * ldc + col0;
                float h[8];
#pragma unroll
                for (int n = 0; n < 2; ++n)
#pragma unroll
                    for (int j = 0; j < 4; ++j) { const float ag = acc[ai][0][m][n][j], au = acc[ai][1][m][n][j];
                        h[n * 4 + j] = (ag * au) * __builtin_amdgcn_rcpf(1.0f + __builtin_amdgcn_exp2f(ag * c1)) * c2; }
                u32x2 w; w.x = pk4_fp8(h[0], h[1], h[2], h[3]); w.y = pk4_fp8(h[4], h[5], h[6], h[7]);
                *(u32x2*)rowp = w; asm volatile("" ::: "memory"); }
    }
};
struct EpiBf16S {
    static constexpr bool PERM = true;
    bf16* O; int ldc; float sc;
    __device__ __forceinline__ void operator()(const f32x4 (&acc)[2][2][4][2], const Unit& u, int wr, int wc, int fr, int fq) const {
        const int row0 = u.pm * BM + wr * 64 + fr, col0 = u.pn * BM + wc * 32 + 8 * fq;
#pragma unroll
        for (int ai = 0; ai < 2; ++ai)
#pragma unroll
            for (int m = 0; m < 4; ++m) { bf16* rowp = O + (size_t)(row0 + ai * HALF + m * 16) * ldc + col0;
#pragma unroll
                for (int bj = 0; bj < 2; ++bj) { const f32x4 v0 = acc[ai][bj][m][0] * sc, v1 = acc[ai][bj][m][1] * sc;
                    u32x4 w; w.x = cvt_pk_bf16(v0[0], v0[1]); w.y = cvt_pk_bf16(v0[2], v0[3]); w.z = cvt_pk_bf16(v1[0], v1[1]); w.w = cvt_pk_bf16(v1[2], v1[3]);
                    *(u32x4*)(rowp + bj * HALF) = w; } }
    }
};
struct EpiFp8S {
    static constexpr bool PERM = true;
    unsigned char* O; int ldc; float sc;
    __device__ __forceinline__ void operator()(const f32x4 (&acc)[2][2][4][2], const Unit& u, int wr, int wc, int fr, int fq) const {
        const int row0 = u.pm * BM + wr * 64 + fr, col0 = u.pn * BM + wc * 32 + 8 * fq;
#pragma unroll
        for (int ai = 0; ai < 2; ++ai)
#pragma unroll
            for (int m = 0; m < 4; ++m) { unsigned char* rowp = O + (size_t)(row0 + ai * HALF + m * 16) * ldc + col0;
#pragma unroll
                for (int bj = 0; bj < 2; ++bj) { const f32x4 v0 = acc[ai][bj][m][0] * sc, v1 = acc[ai][bj][m][1] * sc;
                    u32x2 w; w.x = pk4_fp8(v0[0], v0[1], v0[2], v0[3]); w.y = pk4_fp8(v1[0], v1[1], v1[2], v1[3]);
                    *(u32x2*)(rowp + bj * HALF) = w; } }
    }
};
struct EpiRes {
    static constexpr bool PERM = false;
    const float* X; float* T;
    __device__ __forceinline__ void operator()(const f32x4 (&acc)[2][2][4][2], const Unit& u, int wr, int wc, int fr, int fq) const {
        const int row0 = u.pm * BM + wr * 64 + fr, col0 = u.pn * BM + wc * 32 + 4 * fq;
#pragma unroll
        for (int ai = 0; ai < 2; ++ai)
#pragma unroll
            for (int m = 0; m < 4; ++m) { const size_t off = (size_t)(row0 + ai * HALF + m * 16) * D + col0;
#pragma unroll
                for (int bj = 0; bj < 2; ++bj)
#pragma unroll
                    for (int n = 0; n < 2; ++n) { const f32x4 xv = *(const f32x4*)(X + off + bj * HALF + n * 16);
                        *(f32x4*)(T + off + bj * HALF + n * 16) = xv * ALPHA + acc[ai][bj][m][n]; } }
    }
};
}

struct Args {
    const float* in[43];
    float* out; unsigned char* ws;
    int ph_lo, ph_hi;
};
struct Ctx { LAS unsigned char* lds; int tid, lane, wave, bid, G, gw, NGW; unsigned char* ws; };

enum { I_X = 0, I_MEM = 1, I_POS = 2, I_WKV = 3,
       L0_WIN = 4, L0_MU, L0_LW, L0_LA, L0_LG, L0_VECS, L0_WOUT, L0_NORMS, L0_FG, L0_FU, L0_FD,
       L1_WIN = 15, L1_GN, L1_WOUT, L1_NORMS, L1_ROUTER, L1_MG, L1_MU_, L1_MD,
       L2_WIN = 23, L2_MU, L2_LW, L2_LA, L2_LV, L2_LG, L2_VECS, L2_WOUT, L2_NORMS, L2_FG, L2_FU, L2_FD,
       L3_WIN = 35, L3_GN, L3_WOUT, L3_NORMS, L3_ROUTER, L3_MG, L3_MU_, L3_MD };

__device__ __forceinline__ void tr_load(f32x4 (&v)[8], const float* W, int ldw, int k0, int n0, int lane) {
#pragma unroll
    for (int i = 0; i < 8; ++i) v[i] = *(const f32x4*)(W + (size_t)(k0 + 8 * i + (lane >> 3)) * ldw + n0 + 4 * (lane & 7));
}
__device__ __forceinline__ void tr_store(const f32x4 (&v)[8], int k0, bf16* WT, int ldt, int drow0, LAS float* scr, int lane) {
#pragma unroll
    for (int i = 0; i < 8; ++i) { LAS float* d = scr + (8 * i + (lane >> 3)) * 33 + 4 * (lane & 7); d[0] = v[i][0]; d[1] = v[i][1]; d[2] = v[i][2]; d[3] = v[i][3]; }
    LDS_WAIT(); asm volatile("" ::: "memory");
    const int c = lane & 7;
#pragma unroll
    for (int j = 0; j < 4; ++j) { const int n = (lane >> 3) + 8 * j; const LAS float* s = scr + (8 * c) * 33 + n;
        u32x4 o; o.x = cvt_pk_bf16(s[0 * 33], s[1 * 33]); o.y = cvt_pk_bf16(s[2 * 33], s[3 * 33]); o.z = cvt_pk_bf16(s[4 * 33], s[5 * 33]); o.w = cvt_pk_bf16(s[6 * 33], s[7 * 33]);
        *(u32x4*)(WT + (size_t)(drow0 + n) * ldt + k0 + 8 * c) = o; }
    LDS_WAIT(); asm volatile("" ::: "memory");
}
__device__ __forceinline__ void conv_mat(const Ctx& C, const float* W, int K, int N, bf16* WT, int mode, int off, int gw0) {
    LAS float* scr = (LAS float*)(C.lds + C.wave * 16384);
    const int nblk = N / 32, items = (K / 64) * nblk;
    int start = C.gw - gw0; if (start < 0) start += C.NGW;
#define CONV_DROW(n0_) (mode == 0 ? off + (n0_) : ((n0_) / 128) * 256 + off + ((n0_) % 128))
    f32x4 va[8], vb[8];
    int it = start;
    if (it < items) tr_load(va, W, N, 64 * (it / nblk), 32 * (it % nblk), C.lane);
    while (it < items) {
        const int it1 = it + C.NGW;
        if (it1 < items) tr_load(vb, W, N, 64 * (it1 / nblk), 32 * (it1 % nblk), C.lane);
        tr_store(va, 64 * (it / nblk), WT, K, CONV_DROW(32 * (it % nblk)), scr, C.lane);
        if (it1 >= items) break;
        const int it2 = it1 + C.NGW;
        if (it2 < items) tr_load(va, W, N, 64 * (it2 / nblk), 32 * (it2 % nblk), C.lane);
        tr_store(vb, 64 * (it1 / nblk), WT, K, CONV_DROW(32 * (it1 % nblk)), scr, C.lane);
        it = it2;
    }
#undef CONV_DROW
}
__device__ __forceinline__ void conv_lora(const Ctx& C, const float* lw, const float* la, const float* lv, const float* lg, bf16* Bt) {
    for (int idx = C.bid * NTHR + C.tid; idx < 6144 * 256; idx += C.G * NTHR) {
        const int n_ = idx % 1536, rest = idx / 1536, k = rest % 256, blk = rest / 256;
        float v = 0.f;
        if (blk == 0) { if (k < 96) v = lw[k * 1536 + n_]; }
        else if (blk == 1) { if (k >= 96 && k < 192) v = la[(k - 96) * 1536 + n_]; }
        else if (blk == 2) { if (lv && k >= 192) v = lv[(k - 192) * 1536 + n_]; }
        else v = lg[k * 1536 + n_];
        Bt[(size_t)(blk * 1536 + n_) * 256 + k] = f2bf(v);
    }
}
__device__ __forceinline__ void conv_f32_bf16(const Ctx& C, const float* src, bf16* dst, size_t n8) {
    for (size_t i = (size_t)C.bid * NTHR + C.tid; i < n8; i += (size_t)C.G * NTHR) {
        const f32x4 a = ((const f32x4*)src)[2 * i], b = ((const f32x4*)src)[2 * i + 1];
        u32x4 w; w.x = cvt_pk_bf16(a[0], a[1]); w.y = cvt_pk_bf16(a[2], a[3]); w.z = cvt_pk_bf16(b[0], b[1]); w.w = cvt_pk_bf16(b[2], b[3]);
        ((u32x4*)dst)[i] = w; }
}

struct CvJob { const float* W; bf16* WT; int N, K, k0, n0, mode, off; float f8s; };
__device__ __forceinline__ void cv_load(f32x4 (&v)[8], const CvJob& J, int wave, int lane) {
    const int n = J.n0 + 4 * lane;
#pragma unroll
    for (int i = 0; i < 8; ++i) { v[i] = (f32x4){0.f, 0.f, 0.f, 0.f}; if (n < J.N) v[i] = *(const f32x4*)(J.W + (size_t)(J.k0 + 8 * wave + i) * J.N + n); }
}
__device__ __forceinline__ void cv_put(const f32x4 (&v)[8], LAS float* T, int wave, int lane) {
#pragma unroll
    for (int i = 0; i < 8; ++i) *(LAS f32x4*)(T + (8 * wave + i) * 256 + 4 * (lane ^ wave)) = v[i];
}
__device__ __forceinline__ void cv_out(const CvJob& J, const LAS float* T, int wave, int lane) {
    const int c = lane & 7;
#pragma unroll
    for (int j = 0; j < 4; ++j) { const int nl = 32 * wave + 8 * j + (lane >> 3), n = J.n0 + nl; const LAS float* s = T + (8 * c) * 256 + (nl ^ (c << 2));
        u32x4 o; o.x = cvt_pk_bf16(s[0 * 256], s[1 * 256]); o.y = cvt_pk_bf16(s[2 * 256], s[3 * 256]); o.z = cvt_pk_bf16(s[4 * 256], s[5 * 256]); o.w = cvt_pk_bf16(s[6 * 256], s[7 * 256]);
        if (n < J.N) { const int drow = J.mode == 0 ? J.off + n : (n / 128) * 256 + J.off + (n % 128);
            *(u32x4*)(J.WT + (size_t)drow * J.K + J.k0 + 8 * c) = o; } }
}
__device__ __forceinline__ void cv_out8(const CvJob& J, const LAS float* T, int wave, int lane) {
    const int c4 = lane & 3; unsigned char* W8 = (unsigned char*)J.WT;
#pragma unroll
    for (int j = 0; j < 2; ++j) { const int nl = 32 * wave + 16 * j + (lane >> 2), n = J.n0 + nl;
        float v[16];
#pragma unroll
        for (int q = 0; q < 16; ++q) { const int k = 16 * c4 + q; v[q] = T[k * 256 + (nl ^ (((k >> 3) & 7) << 2))] * J.f8s; }
        u32x4 o; o.x = pk4_fp8(v[0], v[1], v[2], v[3]); o.y = pk4_fp8(v[4], v[5], v[6], v[7]); o.z = pk4_fp8(v[8], v[9], v[10], v[11]); o.w = pk4_fp8(v[12], v[13], v[14], v[15]);
        if (n < J.N) { const int drow = J.mode == 0 ? J.off + n : (n / 128) * 256 + J.off + (n % 128);
            *(u32x4*)(W8 + (size_t)drow * J.K + J.k0 + 16 * c4) = o; } }
}
template <class Dec>
__device__ __forceinline__ void conv_run(const Ctx& C, int ntiles, const Dec& dec, const int t0 = -1, const int STR = GRID) {
    LAS float* T = (LAS float*)C.lds;
    f32x4 va[8], vb[8]; CvJob ja, jb, jc;
    int t = t0 < 0 ? C.bid : t0;
    if (t < ntiles) { dec(t, ja); cv_load(va, ja, C.wave, C.lane); }
    if (t + STR < ntiles) { dec(t + STR, jb); cv_load(vb, jb, C.wave, C.lane); }
    while (t < ntiles) {
        __syncthreads(); cv_put(va, T, C.wave, C.lane); jc = ja;
        if (t + 2 * STR < ntiles) { dec(t + 2 * STR, ja); cv_load(va, ja, C.wave, C.lane); }
        __syncthreads(); if (jc.f8s > 0.f) cv_out8(jc, T, C.wave, C.lane); else cv_out(jc, T, C.wave, C.lane);
        t += STR; if (t >= ntiles) break;
        __syncthreads(); cv_put(vb, T, C.wave, C.lane); jc = jb;
        if (t + 2 * STR < ntiles) { dec(t + 2 * STR, jb); cv_load(vb, jb, C.wave, C.lane); }
        __syncthreads(); if (jc.f8s > 0.f) cv_out8(jc, T, C.wave, C.lane); else cv_out(jc, T, C.wave, C.lane);
        t += STR;
    }
    __syncthreads();
}
struct MoeDec { const float* mg; const float* mu; const float* md; unsigned char* ws;
    __device__ __forceinline__ void operator()(int t, CvJob& J) const {
        const int j = t / 704, r = t % 704, e = j / 3, kind = j % 3;
        if (kind < 2) { J.W = (kind == 0 ? mg : mu) + (size_t)e * 2048 * 5632; J.WT = (bf16*)(ws + WS_MWGU + (size_t)e * 22 * MiB); J.N = 5632; J.K = 2048; J.mode = 1; J.off = kind * 128; J.f8s = 1024.f; J.k0 = 64 * (r / 22); J.n0 = 256 * (r % 22); }
        else { J.W = md + (size_t)e * 2048 * 5632; J.WT = (bf16*)(ws + WS_MWD + (size_t)e * 11 * MiB); J.N = 2048; J.K = 5632; J.mode = 0; J.off = 0; J.f8s = 2048.f; J.k0 = 64 * (r / 8); J.n0 = 256 * (r % 8); }
    } };
struct StaticDec { const float* const* in; unsigned char* ws;
    __device__ __forceinline__ void set(CvJob& J, const float* W, bf16* WT, int K, int N, int mode, int off, int r, float f8s = 0.f) const {
        const int nn = (N + 255) / 256; J.W = W; J.WT = WT; J.N = N; J.K = K; J.mode = mode; J.off = off; J.f8s = f8s; J.k0 = 64 * (r / nn); J.n0 = 256 * (r % nn); }
    __device__ __forceinline__ void operator()(int t, CvJob& J) const {
        int r = t;
        if (r < 128) { set(J, in[I_WKV], (bf16*)(ws + WS_WKV), 2048, 1024, 0, 0, r); return; } r -= 128;
        if (r < 704) { set(J, in[L0_WIN], (bf16*)(ws + WS_WIN), 2048, 5568, 0, 0, r); return; } r -= 704;
        if (r < 640) { set(J, in[L1_WIN], (bf16*)(ws + WS_WIN + (size_t)22 * MiB), 2048, 5120, 0, 0, r); return; } r -= 640;
        if (r < 704) { set(J, in[L2_WIN], (bf16*)(ws + WS_WIN + (size_t)44 * MiB), 2048, 5632, 0, 0, r); return; } r -= 704;
        if (r < 640) { set(J, in[L3_WIN], (bf16*)(ws + WS_WIN + (size_t)66 * MiB), 2048, 5120, 0, 0, r); return; } r -= 640;
        if (r < 256) { set(J, in[L0_WOUT], (bf16*)(ws + WS_WOUT), 2048, 2048, 0, 0, r); return; } r -= 256;
        if (r < 256) { set(J, in[L1_WOUT], (bf16*)(ws + WS_WOUT + (size_t)8 * MiB), 2048, 2048, 0, 0, r); return; } r -= 256;
        if (r < 256) { set(J, in[L2_WOUT], (bf16*)(ws + WS_WOUT + (size_t)16 * MiB), 2048, 2048, 0, 0, r); return; } r -= 256;
        if (r < 256) { set(J, in[L3_WOUT], (bf16*)(ws + WS_WOUT + (size_t)24 * MiB), 2048, 2048, 0, 0, r); return; } r -= 256;
        if (r < 704) { set(J, in[L0_FG], (bf16*)(ws + WS_WFGU), 2048, 5632, 1, 0, r, 1024.f); return; } r -= 704;
        if (r < 704) { set(J, in[L0_FU], (bf16*)(ws + WS_WFGU), 2048, 5632, 1, 128, r, 1024.f); return; } r -= 704;
        if (r < 704) { set(J, in[L0_FD], (bf16*)(ws + WS_WFD), 5632, 2048, 0, 0, r, 2048.f); return; } r -= 704;
        if (r < 704) { set(J, in[L2_FG], (bf16*)(ws + WS_WFGU + (size_t)44 * MiB), 2048, 5632, 1, 0, r, 1024.f); return; } r -= 704;
        if (r < 704) { set(J, in[L2_FU], (bf16*)(ws + WS_WFGU + (size_t)44 * MiB), 2048, 5632, 1, 128, r, 1024.f); return; } r -= 704;
        set(J, in[L2_FD], (bf16*)(ws + WS_WFD + (size_t)22 * MiB), 5632, 2048, 0, 0, r, 2048.f);
    } };

__device__ __forceinline__ void ph_prologue(const Ctx& C, const Args& A) {
    unsigned char* ws = C.ws;
    { StaticDec dec; dec.in = A.in; dec.ws = ws; conv_run(C, 8064, dec); }
    conv_lora(C, A.in[L0_LW], A.in[L0_LA], nullptr, A.in[L0_LG], (bf16*)(ws + WS_WLORA));
    conv_lora(C, A.in[L2_LW], A.in[L2_LA], A.in[L2_LV], A.in[L2_LG], (bf16*)(ws + WS_WLORA + 3 * MiB));
    { u32x4* z = (u32x4*)(ws + WS_WIN + (size_t)5568 * 2048 * 2);
      for (int i = C.bid * NTHR + C.tid; i < 64 * 2048 * 2 / 16; i += C.G * NTHR) z[i] = (u32x4){0u, 0u, 0u, 0u}; }
    { const f32x4* xs = (const f32x4*)A.in[I_X]; u32x2* hi = (u32x2*)(ws + WS_XB); unsigned* lo = (unsigned*)(ws + WS_XLO);
      for (size_t i = (size_t)C.bid * NTHR + C.tid; i < (size_t)M * D / 4; i += (size_t)C.G * NTHR) { const f32x4 o = xs[i];
          u32x2 w; w.x = cvt_pk_bf16(o[0], o[1]); w.y = cvt_pk_bf16(o[2], o[3]); hi[i] = w;
          lo[i] = pk4_fp8((o[0] - bflo(w.x)) * 8192.f, (o[1] - bfhi(w.x)) * 8192.f, (o[2] - bflo(w.y)) * 8192.f, (o[3] - bfhi(w.y)) * 8192.f); } }
    conv_f32_bf16(C, A.in[I_MEM], (bf16*)(ws + WS_MEMB), (size_t)4096 * 2048 / 8);
    { const int* pos = (const int*)A.in[I_POS]; f32x2* cs = (f32x2*)(ws + WS_CS);
      for (int idx = C.bid * NTHR + C.tid; idx < M * 64; idx += C.G * NTHR) {
          const int m = idx >> 6, i = idx & 63;
          const float pw = (float)exp2(13.287712379549449 * (double)i / 64.0);
          const float inv = 1.0f / pw;
          const float ang = (float)pos[m] * inv;
          const double x = (double)ang;
          const double n = rint(x * 0.15915494309189535);
          const double r = fma(-n, 6.283185307179586, x) - n * 2.4492935982947064e-16;
          const double r2 = r * r;
          double s = -1.0 / 121645100408832000.0;
          s = fma(s, r2, 1.0 / 355687428096000.0);
          s = fma(s, r2, -1.0 / 1307674368000.0);
          s = fma(s, r2, 1.0 / 6227020800.0);
          s = fma(s, r2, -1.0 / 39916800.0);
          s = fma(s, r2, 1.0 / 362880.0);
          s = fma(s, r2, -1.0 / 5040.0);
          s = fma(s, r2, 1.0 / 120.0);
          s = fma(s, r2, -1.0 / 6.0);
          s = fma(s * r2, r, r);
          double c = 1.0 / 2432902008176640000.0;
          c = fma(c, r2, -1.0 / 6402373705728000.0);
          c = fma(c, r2, 1.0 / 20922789888000.0);
          c = fma(c, r2, -1.0 / 87178291200.0);
          c = fma(c, r2, 1.0 / 479001600.0);
          c = fma(c, r2, -1.0 / 3628800.0);
          c = fma(c, r2, 1.0 / 40320.0);
          c = fma(c, r2, -1.0 / 720.0);
          c = fma(c, r2, 1.0 / 24.0);
          c = fma(c, r2, -0.5);
          c = fma(c, r2, 1.0);
          cs[idx] = (f32x2){(float)c, (float)s};
      } }
}

struct LnRow { u32x2 rh[8]; unsigned rl[8]; u32x2 a[8]; float w1, w2; };
__device__ __forceinline__ void ln_load(LnRow& R, const Ctx& C, int m, const void* Hp, int hmode) {
    const u32x2* hr = (const u32x2*)(C.ws + WS_XB + (size_t)m * D * 2) + C.lane;
    const unsigned* lr = (const unsigned*)(C.ws + WS_XLO + (size_t)m * D) + C.lane;
#pragma unroll
    for (int j = 0; j < 8; ++j) { R.rh[j] = hr[64 * j]; R.rl[j] = lr[64 * j]; }
    if (hmode == 0) {
        const u32x2* ar = (const u32x2*)((const bf16*)Hp + (size_t)m * D) + C.lane;
#pragma unroll
        for (int j = 0; j < 8; ++j) R.a[j] = ar[64 * j];
        R.w1 = 1.f; R.w2 = 0.f;
    } else if (hmode == 1) {
        const unsigned* ar = (const unsigned*)((const unsigned char*)Hp + (size_t)m * D) + C.lane;
#pragma unroll
        for (int j = 0; j < 8; ++j) { R.a[j].x = ar[64 * j]; R.a[j].y = 0u; }
        R.w1 = 1.f / 256.f; R.w2 = 0.f;
    } else {
        const f32x4 rt = ((const f32x4*)(C.ws + WS_ROUTE))[m];
        const int s1 = ((const int*)(C.ws + WS_SLOT1))[m], s2 = ((const int*)(C.ws + WS_SLOT2))[m];
        R.w1 = rt[1] * (1.f / 256.f); R.w2 = rt[2] * (1.f / 256.f);
        const unsigned* y1 = (const unsigned*)((const unsigned char*)Hp + (size_t)s1 * D) + C.lane;
        const unsigned* y2 = (const unsigned*)((const unsigned char*)Hp + (size_t)s2 * D) + C.lane;
#pragma unroll
        for (int j = 0; j < 8; ++j) { R.a[j].x = y1[64 * j]; R.a[j].y = y2[64 * j]; }
    }
}
__device__ __forceinline__ void ln_row(const LnRow& R, const Ctx& C, int m, const float* gain, const float* bias, int hmode, float* Xf32out, unsigned char* X8out,
                                       LAS float* rw, LAS int* hist, bool do_route) {
    const int l4 = 4 * C.lane;
    f32x4 v[8]; float s = 0.f;
#pragma unroll
    for (int j = 0; j < 8; ++j) { f32x4 f, x;
        const f32x2 l01 = __builtin_amdgcn_cvt_pk_f32_fp8(R.rl[j], false), l23 = __builtin_amdgcn_cvt_pk_f32_fp8(R.rl[j], true);
        x[0] = bflo(R.rh[j].x) + l01[0] * (1.f / 8192.f); x[1] = bfhi(R.rh[j].x) + l01[1] * (1.f / 8192.f); x[2] = bflo(R.rh[j].y) + l23[0] * (1.f / 8192.f); x[3] = bfhi(R.rh[j].y) + l23[1] * (1.f / 8192.f);
        if (hmode == 0) { f[0] = bflo(R.a[j].x); f[1] = bfhi(R.a[j].x); f[2] = bflo(R.a[j].y); f[3] = bfhi(R.a[j].y); }
        else { const f32x2 a01 = __builtin_amdgcn_cvt_pk_f32_fp8(R.a[j].x, false), a23 = __builtin_amdgcn_cvt_pk_f32_fp8(R.a[j].x, true);
            f[0] = R.w1 * a01[0]; f[1] = R.w1 * a01[1]; f[2] = R.w1 * a23[0]; f[3] = R.w1 * a23[1];
            if (hmode == 2) { const f32x2 b01 = __builtin_amdgcn_cvt_pk_f32_fp8(R.a[j].y, false), b23 = __builtin_amdgcn_cvt_pk_f32_fp8(R.a[j].y, true);
                f[0] += R.w2 * b01[0]; f[1] += R.w2 * b01[1]; f[2] += R.w2 * b23[0]; f[3] += R.w2 * b23[1]; } }
        v[j] = x * ALPHA + f; s += (v[j][0] + v[j][1]) + (v[j][2] + v[j][3]); }
    const float mean = wave_sum(s) * (1.f / D); float s2 = 0.f;
#pragma unroll
    for (int j = 0; j < 8; ++j) { v[j] = v[j] - mean; s2 += (v[j][0] * v[j][0] + v[j][1] * v[j][1]) + (v[j][2] * v[j][2] + v[j][3] * v[j][3]); }
    const float rstd = 1.0f / sqrtf(wave_sum(s2) * (1.f / D) + LN_EPS);
    float lg[8];
#pragma unroll
    for (int e = 0; e < 8; ++e) lg[e] = 0.f;
    u32x2* ho = (u32x2*)(C.ws + WS_XB + (size_t)m * D * 2) + C.lane;
    unsigned* lo = (unsigned*)(C.ws + WS_XLO + (size_t)m * D) + C.lane;
#pragma unroll
    for (int j = 0; j < 8; ++j) {
        const f32x4 gv = *((const f32x4*)(gain + 256 * j + l4)), bv = *((const f32x4*)(bias + 256 * j + l4));
        const f32x4 o = v[j] * rstd * gv + bv;
        if (Xf32out) ((f32x4*)(Xf32out + (size_t)m * D))[64 * j + C.lane] = o;
        else { u32x2 w; w.x = cvt_pk_bf16(o[0], o[1]); w.y = cvt_pk_bf16(o[2], o[3]); ho[64 * j] = w;
            lo[64 * j] = pk4_fp8((o[0] - bflo(w.x)) * 8192.f, (o[1] - bfhi(w.x)) * 8192.f, (o[2] - bflo(w.y)) * 8192.f, (o[3] - bfhi(w.y)) * 8192.f); }
        if (X8out) ((unsigned*)(X8out + (size_t)m * D))[64 * j + C.lane] = pk4_fp8(o[0] * 16.f, o[1] * 16.f, o[2] * 16.f, o[3] * 16.f);
        if (do_route) {
#pragma unroll
            for (int e = 0; e < 8; ++e) { const f32x4 we = *(const LAS f32x4*)(rw + e * 2048 + 256 * j + l4);
                lg[e] += (o[0] * we[0] + o[1] * we[1]) + (o[2] * we[2] + o[3] * we[3]); }
        }
    }
    if (do_route) {
#pragma unroll
        for (int e = 0; e < 8; ++e) lg[e] = wave_sum(lg[e]);
        int e1 = 0; float v1 = lg[0];
#pragma unroll
        for (int e = 1; e < 8; ++e) if (lg[e] > v1) { v1 = lg[e]; e1 = e; }
        int e2 = -1; float v2 = -3.0e38f;
#pragma unroll
        for (int e = 0; e < 8; ++e) if (e != e1 && lg[e] > v2) { v2 = lg[e]; e2 = e; }
        const float ex = __expf(v2 - v1); const float w1 = 1.0f / (1.0f + ex), w2 = ex / (1.0f + ex);
        if (C.lane == 0) { f32x4 rt; rt[0] = __int_as_float(e1 | (e2 << 8)); rt[1] = w1; rt[2] = w2; rt[3] = 0.f; ((f32x4*)(C.ws + WS_ROUTE))[m] = rt;
            atomicAdd((int*)&hist[e1], 1); atomicAdd((int*)&hist[e2], 1); }
    }
}
__device__ __forceinline__ void ph_ln(const Ctx& C, const void* Hp, int hmode, const float* gain, const float* bias, float* Xf32out, unsigned char* X8out,
                                      const float* router, bool do_route) {
    unsigned char* ws = C.ws;
    LAS float* rw = (LAS float*)C.lds;
    LAS int* hist = (LAS int*)(C.lds + LDS_MISC + 64);
    if (do_route) {
        for (int col = C.tid; col < 2048; col += NTHR) { const f32x4 a = ((const f32x4*)router)[2 * col], b = ((const f32x4*)router)[2 * col + 1];
            rw[0 * 2048 + col] = a[0]; rw[1 * 2048 + col] = a[1]; rw[2 * 2048 + col] = a[2]; rw[3 * 2048 + col] = a[3]; rw[4 * 2048 + col] = b[0]; rw[5 * 2048 + col] = b[1]; rw[6 * 2048 + col] = b[2]; rw[7 * 2048 + col] = b[3]; }
        if (C.tid < 8) hist[C.tid] = 0;
        int* st = (int*)(ws + WS_SLOTTOK);
        for (int i = C.bid * NTHR + C.tid; i < NSLOT; i += C.G * NTHR) st[i] = -1;
        __syncthreads();
    }
    const int m0 = C.bid * 128 + C.wave * 16;
    LnRow Ra, Rb;
    ln_load(Ra, C, m0, Hp, hmode);
#pragma unroll 1
    for (int r = 0; r < 16; r += 2) {
        ln_load(Rb, C, m0 + r + 1, Hp, hmode);
        ln_row(Ra, C, m0 + r, gain, bias, hmode, Xf32out, X8out, rw, hist, do_route);
        if (r + 2 < 16) ln_load(Ra, C, m0 + r + 2, Hp, hmode);
        ln_row(Rb, C, m0 + r + 1, gain, bias, hmode, Xf32out, X8out, rw, hist, do_route);
    }
    if (do_route) { __syncthreads(); if (C.tid < 8) ((int*)(ws + WS_CTL))[CW_CNT + C.bid * 8 + C.tid] = hist[C.tid]; }
}

__device__ __forceinline__ void ph_slots(const Ctx& C) {
    unsigned char* ws = C.ws;
    LAS int* sm = (LAS int*)(C.lds + LDS_MISC + 128);
    const int* cnt = (const int*)(ws + WS_CTL) + CW_CNT;
    if (C.tid < 8) { int tot = 0, mine = 0; for (int b = 0; b < C.G; ++b) { const int c = cnt[b * 8 + C.tid]; if (b < C.bid) mine += c; tot += c; } sm[C.tid] = tot; sm[8 + C.tid] = mine; }
    __syncthreads();
    if (C.tid == 0) { int base = 0; for (int e = 0; e < 8; ++e) { sm[16 + e] = base; base += (sm[e] + 255) & ~255; } sm[24] = base >> 8; }
    __syncthreads();
    if (C.wave == 0) {
        int off[8];
#pragma unroll
        for (int e = 0; e < 8; ++e) off[e] = sm[16 + e] + sm[8 + e];
        const unsigned long long lt = (1ull << C.lane) - 1ull;
        for (int it = 0; it < 2; ++it) {
            const int m = C.bid * 128 + it * 64 + C.lane;
            const int ee = __float_as_int(((const f32x4*)(ws + WS_ROUTE))[m][0]); const int e1 = ee & 0xff, e2 = (ee >> 8) & 0xff;
            int s1 = 0, s2 = 0;
#pragma unroll
            for (int e = 0; e < 8; ++e) { const unsigned long long m1 = __ballot(e1 == e), m2 = __ballot(e2 == e);
                const int c1 = __popcll(m1), c2 = __popcll(m2);
                if (e1 == e) s1 = off[e] + __popcll(m1 & lt);
                if (e2 == e) s2 = off[e] + c1 + __popcll(m2 & lt);
                off[e] += c1 + c2; }
            ((int*)(ws + WS_SLOT1))[m] = s1; ((int*)(ws + WS_SLOT2))[m] = s2;
            int* st = (int*)(ws + WS_SLOTTOK); st[s1] = m; st[s2] = m;
        }
    }
    if (C.bid == 0) {
        int* ctl = (int*)(ws + WS_CTL);
        if (C.tid == 0) ctl[CW_NT] = sm[24];
        if (C.tid < 264) { int e = 0;
#pragma unroll
            for (int q = 1; q < 8; ++q) if (C.tid >= (sm[16 + q] >> 8)) e = q;
            ctl[CW_TEXP + C.tid] = e; }
    }
}
__device__ __forceinline__ void ph_gather(const Ctx& C) {
    unsigned char* ws = C.ws;
    const int* st = (const int*)(ws + WS_SLOTTOK); const u32x4* xb = (const u32x4*)(ws + WS_XB); u32x4* xp = (u32x4*)(ws + WS_XPERM);
    for (int s = C.gw; s < NSLOT; s += C.NGW) { const int tok = st[s];
#pragma unroll
        for (int j = 0; j < 2; ++j) { u32x4 v = xb[(size_t)(tok < 0 ? 0 : tok) * 128 + j * 64 + C.lane]; const unsigned k = tok < 0 ? 0u : 0xffffffffu; v.x &= k; v.y &= k; v.z &= k; v.w &= k; xp[(size_t)s * 128 + j * 64 + C.lane] = v; } }
}
__device__ __forceinline__ void ph_moe_wconv(const Ctx& C, const float* mg, const float* mu, const float* md) {
    MoeDec dec; dec.mg = mg; dec.mu = mu; dec.md = md; dec.ws = C.ws; conv_run(C, 16896, dec, C.bid - 192, 64);
}

__device__ __forceinline__ void ph_memattn(const Ctx& C, const bf16* P, int ldp, int qm0) {
    unsigned char* ws = C.ws;
    const bf16* memK = (const bf16*)(ws + WS_MEMK); const bf16* memVT = (const bf16*)(ws + WS_MEMVT); bf16* mix = (bf16*)(ws + WS_MIX);
    const int g = C.lane >> 4, r16 = C.lane & 15;
    LAS unsigned char* LK = C.lds; LAS unsigned char* LV = C.lds + 65536;
    const int b = C.bid >> 4, hm = (C.bid >> 2) & 3, qb = C.bid & 3;
    __syncthreads();
    {   u32x4 st[16];
#pragma unroll
        for (int i = 0; i < 8; ++i) { const int q = C.tid + 512 * i, row = q >> 4, pc = q & 15;
            st[i] = *(const u32x4*)(memK + (size_t)(b * 256 + row) * 512 + hm * 128 + pc * 8); }
#pragma unroll
        for (int i = 0; i < 8; ++i) { const int q = C.tid + 512 * i, row = q >> 5, pc = q & 31;
            st[8 + i] = *(const u32x4*)(memVT + (size_t)(hm * 128 + row) * 4096 + b * 256 + pc * 8); }
#pragma unroll
        for (int i = 0; i < 8; ++i) { const int q = C.tid + 512 * i, row = q >> 4, pc = q & 15;
            *(LAS u32x4*)(LK + row * 256 + ((pc ^ (row & 15)) * 16)) = st[i]; }
#pragma unroll
        for (int i = 0; i < 8; ++i) { const int q = C.tid + 512 * i, row = q >> 5, pc = q & 31;
            *(LAS u32x4*)(LV + row * 512 + ((pc ^ (row & 15)) * 16)) = st[8 + i]; }
    }
    __syncthreads();
    for (int qt = 0; qt < 4; ++qt) {
        const int m0 = b * SEQ + qb * 512 + C.wave * 64 + qt * 16;
        bf16x8 qf[4];
#pragma unroll
        for (int s = 0; s < 4; ++s) qf[s] = *(const bf16x8*)(P + (size_t)(m0 + r16) * ldp + qm0 + hm * 128 + 32 * s + 8 * g);
        f32x4 sacc[16];
#pragma unroll
        for (int kt = 0; kt < 16; ++kt) { sacc[kt] = (f32x4){0.f, 0.f, 0.f, 0.f};
#pragma unroll
            for (int s = 0; s < 4; ++s) { const bf16x8 kf = *(const LAS bf16x8*)(LK + (16 * kt + r16) * 256 + (((4 * s + g) ^ r16) * 16));
                sacc[kt] = __builtin_amdgcn_mfma_f32_16x16x32_bf16(kf, qf[s], sacc[kt], 0, 0, 0); } }
        float mx = -3.0e38f;
#pragma unroll
        for (int kt = 0; kt < 16; ++kt)
#pragma unroll
            for (int j = 0; j < 4; ++j) mx = fmaxf(mx, sacc[kt][j]);
        mx = fmaxf(mx, __shfl_xor(mx, 16)); mx = fmaxf(mx, __shfl_xor(mx, 32));
        const float sc = 0.08838834764831845f * 1.4426950408889634f;
        float sum = 0.f;
#pragma unroll
        for (int kt = 0; kt < 16; ++kt)
#pragma unroll
            for (int j = 0; j < 4; ++j) { const float pv = exp2f((sacc[kt][j] - mx) * sc); sacc[kt][j] = pv; sum += pv; }
        sum += __shfl_xor(sum, 16); sum += __shfl_xor(sum, 32);
        f32x4 oacc[8];
#pragma unroll
        for (int dt = 0; dt < 8; ++dt) oacc[dt] = (f32x4){0.f, 0.f, 0.f, 0.f};
#pragma unroll
        for (int ks = 0; ks < 8; ++ks) {
            u32x4 pw; pw.x = cvt_pk_bf16(sacc[2 * ks][0], sacc[2 * ks][1]); pw.y = cvt_pk_bf16(sacc[2 * ks][2], sacc[2 * ks][3]);
            pw.z = cvt_pk_bf16(sacc[2 * ks + 1][0], sacc[2 * ks + 1][1]); pw.w = cvt_pk_bf16(sacc[2 * ks + 1][2], sacc[2 * ks + 1][3]);
            const bf16x8 pa = __builtin_bit_cast(bf16x8, pw);
#pragma unroll
            for (int dt = 0; dt < 8; ++dt) { const LAS unsigned char* vr = LV + (16 * dt + r16) * 512;
                const u32x2 lo = *(const LAS u32x2*)(vr + (((8 * ks + g) ^ (2 * r16)) * 8)), hi = *(const LAS u32x2*)(vr + (((8 * ks + 4 + g) ^ (2 * r16)) * 8));
                u32x4 vw; vw.x = lo.x; vw.y = lo.y; vw.z = hi.x; vw.w = hi.y;
                oacc[dt] = __builtin_amdgcn_mfma_f32_16x16x32_bf16(pa, __builtin_bit_cast(bf16x8, vw), oacc[dt], 0, 0, 0); } }
        float inv[4];
#pragma unroll
        for (int j = 0; j < 4; ++j) inv[j] = 1.0f / __shfl(sum, 4 * g + j);
#pragma unroll
        for (int dt = 0; dt < 8; ++dt)
#pragma unroll
            for (int j = 0; j < 4; ++j) mix[(size_t)(m0 + 4 * g + j) * D + SW + hm * 128 + 16 * dt + r16] = f2bf(oacc[dt][j] * inv[j]);
    }
    __syncthreads();
}

__device__ __forceinline__ void ph_rwkv_prep1(const Ctx& C, const float* mu, bool with_v) {
    unsigned char* ws = C.ws;
    const bf16* P = (const bf16*)(ws + WS_P); bf16* AL = (bf16*)(ws + WS_ALORA);
    const int oc0 = 8 * C.lane;
    const int XW0 = 4608, XA0 = 4704, XV0 = 4800, XG0 = with_v ? 4864 : 4800;
    int src, mode;
    if (oc0 < 96) { src = XW0 + oc0; mode = 0; } else if (oc0 < 192) { src = XA0 + oc0 - 96; mode = 1; }
    else if (oc0 < 256) { src = XV0 + oc0 - 192; mode = with_v ? 1 : 2; } else { src = XG0 + oc0 - 256; mode = 3; }
    f32x4 mu0 = (f32x4){0.f, 0.f, 0.f, 0.f}, mu1 = mu0;
    if (mode != 2) { mu0 = *(const f32x4*)(mu + src); mu1 = *(const f32x4*)(mu + src + 4); }
    for (int m = C.gw; m < M; m += C.NGW) {
        u32x4 o = (u32x4){0u, 0u, 0u, 0u};
        if (mode != 2) {
            const u32x4 cu = *(const u32x4*)(P + (size_t)m * LDP_RW + src);
            u32x4 pr = (u32x4){0u, 0u, 0u, 0u};
            if ((m & (SEQ - 1)) != 0) pr = *(const u32x4*)(P + (size_t)(m - 1) * LDP_RW + src);
            float v[8];
#pragma unroll
            for (int q = 0; q < 4; ++q) { const float c0 = bflo(cu[q]), c1 = bfhi(cu[q]), p0 = bflo(pr[q]), p1 = bfhi(pr[q]);
                const float m0 = q < 2 ? mu0[2 * q] : mu1[2 * q - 4], m1 = q < 2 ? mu0[2 * q + 1] : mu1[2 * q - 3];
                v[2 * q] = c0 + m0 * (p0 - c0); v[2 * q + 1] = c1 + m1 * (p1 - c1); }
#pragma unroll
            for (int q = 0; q < 8; ++q) { if (mode == 0) v[q] = 1.0f - 2.0f * __builtin_amdgcn_rcpf(1.0f + __expf(2.0f * v[q])); else if (mode == 3) v[q] = sigmoidf_(v[q]); }
            o.x = cvt_pk_bf16(v[0], v[1]); o.y = cvt_pk_bf16(v[2], v[3]); o.z = cvt_pk_bf16(v[4], v[5]); o.w = cvt_pk_bf16(v[6], v[7]);
        }
        *(u32x4*)(AL + (size_t)m * 512 + oc0) = o;
    }
}
__device__ __forceinline__ void ph_rwkv_prep2(const Ctx& C, const float* mu, const float* vecs, bool with_v) {
    unsigned char* ws = C.ws;
    const bf16* P = (const bf16*)(ws + WS_P); const bf16* LO = (const bf16*)(ws + WS_LORAOUT); bf16* VF = (bf16*)(ws + WS_VFIRST);
    unsigned char* SI = ws + WS_SCANIN; float* BON = (float*)(ws + WS_BONUS);
    const float* k_k = vecs + (with_v ? 3 : 2) * SW; const float* k_a = k_k + SW; const float* r_k = k_a + SW;
    const int hq = C.lane >> 4, cl = (C.lane & 15) * 4;
    for (int m = C.gw; m < M; m += C.NGW) {
        const int t = m & (SEQ - 1), b = m >> 11; const bool hp = t != 0;
        const bf16* pc = P + (size_t)m * LDP_RW; const bf16* pp = pc - LDP_RW;
#pragma unroll 2
        for (int it = 0; it < 6; ++it) {
            const int c = it * 256 + 4 * C.lane, head = 4 * it + hq;
            const u32x2 rc = *(const u32x2*)(pc + c), kc = *(const u32x2*)(pc + SW + c), vc = *(const u32x2*)(pc + 2 * SW + c);
            u32x2 rp = (u32x2){0u, 0u}, kp_ = rp, vp = rp;
            if (hp) { rp = *(const u32x2*)(pp + c); kp_ = *(const u32x2*)(pp + SW + c); vp = *(const u32x2*)(pp + 2 * SW + c); }
            const u32x2 Ew = *(const u32x2*)(LO + (size_t)m * 6144 + c), aw = *(const u32x2*)(LO + (size_t)m * 6144 + SW + c);
            u32x2 svw = (u32x2){0u, 0u}, vfw = svw;
            if (with_v) { svw = *(const u32x2*)(LO + (size_t)m * 6144 + 2 * SW + c); vfw = *(const u32x2*)(VF + (size_t)m * SW + c); }
            const f32x4 mr = *(const f32x4*)(mu + c), mk = *(const f32x4*)(mu + SW + c), mv = *(const f32x4*)(mu + 2 * SW + c);
            const f32x4 kk4 = *(const f32x4*)(k_k + c), ka4 = *(const f32x4*)(k_a + c), rk4 = *(const f32x4*)(r_k + c);
            float rm[4], km[4], vm[4], E[4], a[4], sv[4], vf[4];
#define UNPK(dst, w) dst[0] = bflo(w.x); dst[1] = bfhi(w.x); dst[2] = bflo(w.y); dst[3] = bfhi(w.y)
            float t0[4], t1[4];
            UNPK(t0, rc); UNPK(t1, rp);
#pragma unroll
            for (int j = 0; j < 4; ++j) rm[j] = t0[j] + mr[j] * (t1[j] - t0[j]);
            UNPK(t0, kc); UNPK(t1, kp_);
#pragma unroll
            for (int j = 0; j < 4; ++j) km[j] = t0[j] + mk[j] * (t1[j] - t0[j]);
            UNPK(t0, vc); UNPK(t1, vp);
#pragma unroll
            for (int j = 0; j < 4; ++j) vm[j] = t0[j] + mv[j] * (t1[j] - t0[j]);
            UNPK(E, Ew); UNPK(a, aw); UNPK(sv, svw); UNPK(vf, vfw);
#undef UNPK
            float vv[4], kkr[4], kp[4], ss = 0.f, bs = 0.f;
#pragma unroll
            for (int j = 0; j < 4; ++j) {
                vv[j] = with_v ? vm[j] + (vf[j] - vm[j]) * sv[j] : vm[j];
                kkr[j] = km[j] * kk4[j]; ss += kkr[j] * kkr[j];
                kp[j] = km[j] * (1.0f + (a[j] - 1.0f) * ka4[j]);
                bs += rm[j] * kp[j] * rk4[j]; }
            ss = row16_sum(ss); bs = row16_sum(bs);
            const float inv = 1.0f / fmaxf(sqrtf(ss), 1e-12f);
            if (!with_v) { u32x2 w; w.x = cvt_pk_bf16(vm[0], vm[1]); w.y = cvt_pk_bf16(vm[2], vm[3]); *(u32x2*)(VF + (size_t)m * SW + c) = w; }
            unsigned char* rec = SI + ((size_t)(b * 24 + head) * SEQ + t) * 896;
            f32x4 wv; float kk[4];
#pragma unroll
            for (int j = 0; j < 4; ++j) { wv[j] = __expf(-E[j]); kk[j] = kkr[j] * inv; }
            *(f32x4*)(rec + cl * 4) = wv;
            u32x2 o;
            o.x = cvt_pk_bf16(-kk[0], -kk[1]); o.y = cvt_pk_bf16(-kk[2], -kk[3]); *(u32x2*)(rec + 256 + cl * 2) = o;
            o.x = cvt_pk_bf16(kk[0] * a[0], kk[1] * a[1]); o.y = cvt_pk_bf16(kk[2] * a[2], kk[3] * a[3]); *(u32x2*)(rec + 384 + cl * 2) = o;
            o.x = cvt_pk_bf16(kp[0], kp[1]); o.y = cvt_pk_bf16(kp[2], kp[3]); *(u32x2*)(rec + 512 + cl * 2) = o;
            o.x = cvt_pk_bf16(rm[0], rm[1]); o.y = cvt_pk_bf16(rm[2], rm[3]); *(u32x2*)(rec + 640 + cl * 2) = o;
            o.x = cvt_pk_bf16(vv[0], vv[1]); o.y = cvt_pk_bf16(vv[2], vv[3]); *(u32x2*)(rec + 768 + cl * 2) = o;
            if ((C.lane & 15) == 0) BON[m * 24 + head] = bs;
        }
    }
}
__device__ __forceinline__ float fma_(float a, float b, float c) { float d; asm("v_fma_f32 %0, %1, %2, %3" : "=v"(d) : "v"(a), "v"(b), "v"(c)); return d; }
__device__ __forceinline__ float mul_(float a, float b) { float d; asm("v_mul_f32 %0, %1, %2" : "=v"(d) : "v"(a), "v"(b)); return d; }
__device__ __forceinline__ void ph_rwkv_scan(const Ctx& C, const float* mg, const float* mu, const float* md, const float* vecs, bool with_v) {
    if (C.bid >= 192) { ph_moe_wconv(C, mg, mu, md); return; }
    unsigned char* ws = C.ws;
    const unsigned char* SI = ws + WS_SCANIN;
    constexpr int TC = 16, NCH = SEQ / TC, REC = 7 * 64;
    LAS float* buf = (LAS float*)C.lds;
    LAS float* ybuf = (LAS float*)(C.lds + 114688);
    const bool scanner = C.wave < 4;
    const int slot = (C.wave >> 1) & 1;
    const int rg = C.lane >> 3, cg = C.lane & 7;
    const int rbase = 32 * (C.wave & 1) + 4 * rg;
    if (!scanner) {
        const int lw = C.wave - 4, qd = C.lane;
        const int q2 = qd - 16, lvec = 1 + (q2 >> 3), lpart = q2 & 7;
        const float* BON = (const float*)(ws + WS_BONUS); bf16* mix = (bf16*)(ws + WS_MIX); const bf16* LO = (const bf16*)(ws + WS_LORAOUT);
        const float* gn_g = vecs + (with_v ? 6 : 5) * SW; const float* gn_b = gn_g + SW;
        const int p0 = C.bid * 2, b0 = p0 / 24, h0 = p0 % 24, b1 = (p0 + 1) / 24, h1 = (p0 + 1) % 24;
        const int pr = C.lane >> 4, pc4 = 4 * (C.lane & 15);
        const f32x4 gg0 = *(const f32x4*)(gn_g + h0 * 64 + pc4), gb0 = *(const f32x4*)(gn_b + h0 * 64 + pc4), gg1 = *(const f32x4*)(gn_g + h1 * 64 + pc4), gb1 = *(const f32x4*)(gn_b + h1 * 64 + pc4);
        u32x4 st[8];
#define SCAN_ISSUE(ch_) do { _Pragma("unroll") for (int i_ = 0; i_ < 8; ++i_) { const int ps = lw + 4 * i_; \
        const int sl_ = ps >> 4, t_ = (ch_) * TC + (ps & 15); \
        st[i_] = qd < 56 ? *(const u32x4*)(SI + ((size_t)(p0 + sl_) * SEQ + t_) * 896 + qd * 16) \
                         : *(const u32x4*)(LO + (size_t)((sl_ ? b1 : b0) * SEQ + t_) * 6144 + 3 * SW + (sl_ ? h1 : h0) * 64 + (qd - 56) * 8); } } while (0)
#define SCAN_COMMIT(bsel_) do { _Pragma("unroll") for (int i_ = 0; i_ < 8; ++i_) { const int ps = lw + 4 * i_; \
        LAS float* dst = buf + (((bsel_) * 2 * TC) + ps) * REC; \
        if (qd < 16) *(LAS u32x4*)(dst + 4 * qd) = st[i_]; \
        else { LAS float* d2 = dst + lvec * 64 + lpart * 8; \
            f32x4 a_, b_; a_[0] = bflo(st[i_].x); a_[1] = bfhi(st[i_].x); a_[2] = bflo(st[i_].y); a_[3] = bfhi(st[i_].y); \
            b_[0] = bflo(st[i_].z); b_[1] = bfhi(st[i_].z); b_[2] = bflo(st[i_].w); b_[3] = bfhi(st[i_].w); \
            *(LAS f32x4*)d2 = a_; *(LAS f32x4*)(d2 + 4) = b_; } } } while (0)
#define SCAN_POST(cp_) do { _Pragma("unroll") for (int g_ = 0; g_ < 2; ++g_) { const int ps = lw + 4 * (4 * g_ + pr), sl = ps >> 4, stp = ps & 15; \
        const LAS float* rec = buf + ((((cp_) & 1) * 2 * TC) + ps) * REC; \
        const f32x4 yv = *(const LAS f32x4*)(ybuf + ((((cp_) & 1) * 2 + sl) * TC + stp) * 64 + pc4), vv = *(const LAS f32x4*)(rec + 5 * 64 + pc4), gq = *(const LAS f32x4*)(rec + 6 * 64 + pc4); \
        const int m = (sl ? b1 : b0) * SEQ + (cp_) * TC + stp, hh = sl ? h1 : h0; \
        const float bon = BON[m * 24 + hh]; \
        const float mean = row16_sum((yv[0] + yv[1]) + (yv[2] + yv[3])) * (1.f / 64.f); const f32x4 d = yv - mean; \
        const float var = row16_sum((d[0] * d[0] + d[1] * d[1]) + (d[2] * d[2] + d[3] * d[3])) * (1.f / 64.f); \
        const float rstd = 1.0f / sqrtf(var + 64e-5f); const f32x4 gg = sl ? gg1 : gg0, gb = sl ? gb1 : gb0; \
        const f32x4 o_ = (d * rstd * gg + gb + vv * bon) * gq; \
        u32x2 w_; w_.x = cvt_pk_bf16(o_[0], o_[1]); w_.y = cvt_pk_bf16(o_[2], o_[3]); \
        *(u32x2*)(mix + (size_t)m * D + hh * 64 + pc4) = w_; } } while (0)
        SCAN_ISSUE(0); SCAN_COMMIT(0);
        __syncthreads();
        for (int ch = 0; ch < NCH; ++ch) {
            if (ch + 1 < NCH) SCAN_ISSUE(ch + 1);
            if (ch > 0) SCAN_POST(ch - 1);
            if (ch + 1 < NCH) SCAN_COMMIT((ch & 1) ^ 1);
            __syncthreads();
        }
        SCAN_POST(NCH - 1);
#undef SCAN_ISSUE
#undef SCAN_COMMIT
#undef SCAN_POST
    } else {
        f32x2 S[4][4];
#pragma unroll
        for (int i = 0; i < 4; ++i)
#pragma unroll
            for (int c = 0; c < 4; ++c) S[i][c] = (f32x2){0.f, 0.f};
        __syncthreads();
        for (int ch = 0; ch < NCH; ++ch) {
            const LAS float* base = buf + (((ch & 1) * 2 + slot) * TC) * REC;
            LAS float* yb = ybuf + (((ch & 1) * 2 + slot) * TC) * 64 + rbase;
#pragma unroll 2
            for (int s = 0; s < TC; ++s) {
                const LAS float* rp = base + s * REC + 8 * cg;
                f32x2 wv[4], nv[4], bv[4], kv[4], rv[4];
                { const f32x4 x0 = *(const LAS f32x4*)(rp), x1 = *(const LAS f32x4*)(rp + 4); wv[0] = (f32x2){x0[0], x0[1]}; wv[1] = (f32x2){x0[2], x0[3]}; wv[2] = (f32x2){x1[0], x1[1]}; wv[3] = (f32x2){x1[2], x1[3]}; }
                { const f32x4 x0 = *(const LAS f32x4*)(rp + 64), x1 = *(const LAS f32x4*)(rp + 68); nv[0] = (f32x2){x0[0], x0[1]}; nv[1] = (f32x2){x0[2], x0[3]}; nv[2] = (f32x2){x1[0], x1[1]}; nv[3] = (f32x2){x1[2], x1[3]}; }
                { const f32x4 x0 = *(const LAS f32x4*)(rp + 128), x1 = *(const LAS f32x4*)(rp + 132); bv[0] = (f32x2){x0[0], x0[1]}; bv[1] = (f32x2){x0[2], x0[3]}; bv[2] = (f32x2){x1[0], x1[1]}; bv[3] = (f32x2){x1[2], x1[3]}; }
                { const f32x4 x0 = *(const LAS f32x4*)(rp + 192), x1 = *(const LAS f32x4*)(rp + 196); kv[0] = (f32x2){x0[0], x0[1]}; kv[1] = (f32x2){x0[2], x0[3]}; kv[2] = (f32x2){x1[0], x1[1]}; kv[3] = (f32x2){x1[2], x1[3]}; }
                { const f32x4 x0 = *(const LAS f32x4*)(rp + 256), x1 = *(const LAS f32x4*)(rp + 260); rv[0] = (f32x2){x0[0], x0[1]}; rv[1] = (f32x2){x0[2], x0[3]}; rv[2] = (f32x2){x1[0], x1[1]}; rv[3] = (f32x2){x1[2], x1[3]}; }
                const f32x4 vv = *(const LAS f32x4*)(base + s * REC + 320 + rbase);
                f32x4 yo;
#pragma unroll
                for (int i = 0; i < 4; ++i) {
                    f32x2 a2 = S[i][0] * nv[0];
#pragma unroll
                    for (int c = 1; c < 4; ++c) a2 = S[i][c] * nv[c] + a2;
                    float sa = a2[0] + a2[1];
                    sa = dpp_add<0xB1>(sa); sa = dpp_add<0x4E>(sa); sa = dpp_add<0x141>(sa);
                    const f32x2 sa2 = (f32x2){sa, sa}, v2 = (f32x2){vv[i], vv[i]};
                    f32x2 y2 = (f32x2){0.f, 0.f};
#pragma unroll
                    for (int c = 0; c < 4; ++c) { S[i][c] = S[i][c] * wv[c] + (sa2 * bv[c] + v2 * kv[c]); y2 = S[i][c] * rv[c] + y2; }
                    float y = y2[0] + y2[1];
                    y = dpp_add<0xB1>(y); y = dpp_add<0x4E>(y); y = dpp_add<0x141>(y);
                    yo[i] = y;
                }
                if (cg == 0) *(LAS f32x4*)(yb + s * 64) = yo;
            }
            __syncthreads();
        }
    }
}

__device__ __constant__ float RET_LG2[6] = {-0.04580368961312479f, -0.02272007650008353f, -0.011315313227834146f, -0.005646563141142063f, -0.0028205190623786626f, -0.0014095702546713536f};
__device__ __forceinline__ void ph_ret_prep(const Ctx& C) {
    unsigned char* ws = C.ws;
    const bf16* P = (const bf16*)(ws + WS_P); const f32x2* CS = (const f32x2*)(ws + WS_CS);
    bf16* QR = (bf16*)(ws + WS_QR); bf16* KR = (bf16*)(ws + WS_KR); bf16* VT = (bf16*)(ws + WS_VT); bf16* KVT = (bf16*)(ws + WS_KVT);
    LAS unsigned char* LKt = C.lds; LAS unsigned char* LV = C.lds + 32768;
    const int g = C.lane >> 4, r16 = C.lane & 15, w = C.wave;
    __syncthreads();
    for (int u = C.bid; u < 1536; u += C.G) {
        const int c = u & 15, bh = u >> 4, h = bh % 6, b = bh / 6, m0 = b * SEQ + c * 128;
        const float lg2 = RET_LG2[h];
        __syncthreads();
        for (int task = C.tid; task < 1536; task += NTHR) {
            if (task < 512) {
                const bool isk = task >= 256; const int tk = task & 255, i0 = 4 * (tk & 15), tg = tk >> 4;
                const int colb = (isk ? 768 : 0) + h * 128 + i0; const float scl = isk ? 0.08838834764831845f : 1.0f;
                bf16* N = isk ? KR : QR;
                float o1[4][8], o2[4][8];
#pragma unroll
                for (int j = 0; j < 8; ++j) { const int m = m0 + tg * 8 + j;
                    const u32x2 a = *(const u32x2*)(P + (size_t)m * LDP_RET + colb), b2 = *(const u32x2*)(P + (size_t)m * LDP_RET + colb + 64);
                    const f32x4 cs01 = *(const f32x4*)(CS + (size_t)m * 64 + i0), cs23 = *(const f32x4*)(CS + (size_t)m * 64 + i0 + 2);
                    const float x1[4] = {bflo(a.x), bfhi(a.x), bflo(a.y), bfhi(a.y)}, x2[4] = {bflo(b2.x), bfhi(b2.x), bflo(b2.y), bfhi(b2.y)};
                    const float cc[4] = {cs01[0], cs01[2], cs23[0], cs23[2]}, sn[4] = {cs01[1], cs01[3], cs23[1], cs23[3]};
#pragma unroll
                    for (int q = 0; q < 4; ++q) { o1[q][j] = (x1[q] * cc[q] - x2[q] * sn[q]) * scl; o2[q][j] = (x1[q] * sn[q] + x2[q] * cc[q]) * scl; }
                    u32x2 w1, w2; w1.x = cvt_pk_bf16(o1[0][j], o1[1][j]); w1.y = cvt_pk_bf16(o1[2][j], o1[3][j]); w2.x = cvt_pk_bf16(o2[0][j], o2[1][j]); w2.y = cvt_pk_bf16(o2[2][j], o2[3][j]);
                    *(u32x2*)(N + (size_t)m * 768 + h * 128 + i0) = w1; *(u32x2*)(N + (size_t)m * 768 + h * 128 + i0 + 64) = w2; }
                if (isk) {
                    float kd[8];
#pragma unroll
                    for (int j = 0; j < 8; ++j) kd[j] = exp2f((float)(127 - (tg * 8 + j)) * lg2);
#pragma unroll
                    for (int q = 0; q < 4; ++q) {
                        u32x4 w1, w2;
                        w1.x = cvt_pk_bf16(o1[q][0] * kd[0], o1[q][1] * kd[1]); w1.y = cvt_pk_bf16(o1[q][2] * kd[2], o1[q][3] * kd[3]); w1.z = cvt_pk_bf16(o1[q][4] * kd[4], o1[q][5] * kd[5]); w1.w = cvt_pk_bf16(o1[q][6] * kd[6], o1[q][7] * kd[7]);
                        w2.x = cvt_pk_bf16(o2[q][0] * kd[0], o2[q][1] * kd[1]); w2.y = cvt_pk_bf16(o2[q][2] * kd[2], o2[q][3] * kd[3]); w2.z = cvt_pk_bf16(o2[q][4] * kd[4], o2[q][5] * kd[5]); w2.w = cvt_pk_bf16(o2[q][6] * kd[6], o2[q][7] * kd[7]);
                        *(LAS u32x4*)(LKt + (i0 + q) * 256 + ((tg ^ ((i0 + q) & 15)) * 16)) = w1;
                        *(LAS u32x4*)(LKt + (i0 + q + 64) * 256 + ((tg ^ ((i0 + q + 64) & 15)) * 16)) = w2; }
                }
            } else {
                const int tv = task - 512, e0 = 4 * (tv & 63), tg = tv >> 6;
                u32x2 vin[8];
#pragma unroll
                for (int j = 0; j < 8; ++j) vin[j] = *(const u32x2*)(P + (size_t)(m0 + tg * 8 + j) * LDP_RET + 1536 + h * 256 + e0);
                u32x4 w0, w1, w2, w3;
#define PKLO(a_, b_) (((a_) & 0xffffu) | ((b_) << 16))
#define PKHI(a_, b_) (((a_) >> 16) | ((b_) & 0xffff0000u))
                w0.x = PKLO(vin[0].x, vin[1].x); w0.y = PKLO(vin[2].x, vin[3].x); w0.z = PKLO(vin[4].x, vin[5].x); w0.w = PKLO(vin[6].x, vin[7].x);
                w1.x = PKHI(vin[0].x, vin[1].x); w1.y = PKHI(vin[2].x, vin[3].x); w1.z = PKHI(vin[4].x, vin[5].x); w1.w = PKHI(vin[6].x, vin[7].x);
                w2.x = PKLO(vin[0].y, vin[1].y); w2.y = PKLO(vin[2].y, vin[3].y); w2.z = PKLO(vin[4].y, vin[5].y); w2.w = PKLO(vin[6].y, vin[7].y);
                w3.x = PKHI(vin[0].y, vin[1].y); w3.y = PKHI(vin[2].y, vin[3].y); w3.z = PKHI(vin[4].y, vin[5].y); w3.w = PKHI(vin[6].y, vin[7].y);
#undef PKLO
#undef PKHI
                bf16* vt = VT + (size_t)(bh * 256 + e0) * SEQ + c * 128 + tg * 8;
                *(u32x4*)vt = w0; *(u32x4*)(vt + SEQ) = w1; *(u32x4*)(vt + 2 * SEQ) = w2; *(u32x4*)(vt + 3 * SEQ) = w3;
                *(LAS u32x4*)(LV + (e0 + 0) * 256 + ((tg ^ ((e0 + 0) & 15)) * 16)) = w0; *(LAS u32x4*)(LV + (e0 + 1) * 256 + ((tg ^ ((e0 + 1) & 15)) * 16)) = w1;
                *(LAS u32x4*)(LV + (e0 + 2) * 256 + ((tg ^ ((e0 + 2) & 15)) * 16)) = w2; *(LAS u32x4*)(LV + (e0 + 3) * 256 + ((tg ^ ((e0 + 3) & 15)) * 16)) = w3;
            }
        }
        __syncthreads();
        {   f32x4 acc[16];
#pragma unroll
            for (int et = 0; et < 16; ++et) acc[et] = (f32x4){0.f, 0.f, 0.f, 0.f};
#pragma unroll
            for (int ks = 0; ks < 4; ++ks) {
                const bf16x8 af = *(const LAS bf16x8*)(LKt + (16 * w + r16) * 256 + (((4 * ks + g) ^ r16) * 16));
#pragma unroll
                for (int et = 0; et < 16; ++et) { const bf16x8 bf = *(const LAS bf16x8*)(LV + (16 * et + r16) * 256 + (((4 * ks + g) ^ r16) * 16));
                    acc[et] = __builtin_amdgcn_mfma_f32_16x16x32_bf16(af, bf, acc[et], 0, 0, 0); } }
#pragma unroll
            for (int et = 0; et < 16; ++et) { u32x2 wv; wv.x = cvt_pk_bf16(acc[et][0], acc[et][1]); wv.y = cvt_pk_bf16(acc[et][2], acc[et][3]); *(u32x2*)(KVT + ((size_t)u * 256 + 16 * et + r16) * 128 + 16 * w + 4 * g) = wv; }
        }
    }
    __syncthreads();
}
__device__ __forceinline__ void ph_ret_kv(const Ctx& C) {
    unsigned char* ws = C.ws;
    const bf16* KDT = (const bf16*)(ws + WS_KDT); const bf16* VT = (const bf16*)(ws + WS_VT); bf16* KVT = (bf16*)(ws + WS_KVT);
    const int g = C.lane >> 4, r16 = C.lane & 15, w = C.wave;
    LAS unsigned char* LKt = C.lds; LAS unsigned char* LV = C.lds + 32768;
    u32x4 st[12];
#define KV_ISSUE(u_) do { const int c_ = (u_) & 15, bh_ = (u_) >> 4; \
        _Pragma("unroll") for (int i = 0; i < 4; ++i) { const int q = C.tid + 512 * i, row = q >> 4, pc = q & 15; st[i] = *(const u32x4*)(KDT + (size_t)(bh_ * 128 + row) * SEQ + c_ * 128 + pc * 8); } \
        _Pragma("unroll") for (int i = 0; i < 8; ++i) { const int q = C.tid + 512 * i, row = q >> 4, pc = q & 15; st[4 + i] = *(const u32x4*)(VT + (size_t)(bh_ * 256 + row) * SEQ + c_ * 128 + pc * 8); } } while (0)
#define KV_COMMIT() do { \
        _Pragma("unroll") for (int i = 0; i < 4; ++i) { const int q = C.tid + 512 * i, row = q >> 4, pc = q & 15; *(LAS u32x4*)(LKt + row * 256 + ((pc ^ (row & 15)) * 16)) = st[i]; } \
        _Pragma("unroll") for (int i = 0; i < 8; ++i) { const int q = C.tid + 512 * i, row = q >> 4, pc = q & 15; *(LAS u32x4*)(LV + row * 256 + ((pc ^ (row & 15)) * 16)) = st[4 + i]; } } while (0)
    __syncthreads();
    if (C.bid < 1536) KV_ISSUE(C.bid);
    for (int u = C.bid; u < 1536; u += C.G) {
        __syncthreads();
        KV_COMMIT();
        if (u + C.G < 1536) KV_ISSUE(u + C.G);
        __syncthreads();
        f32x4 acc[16];
#pragma unroll
        for (int et = 0; et < 16; ++et) acc[et] = (f32x4){0.f, 0.f, 0.f, 0.f};
#pragma unroll
        for (int ks = 0; ks < 4; ++ks) {
            const bf16x8 af = *(const LAS bf16x8*)(LKt + (16 * w + r16) * 256 + (((4 * ks + g) ^ r16) * 16));
#pragma unroll
            for (int et = 0; et < 16; ++et) { const bf16x8 bf = *(const LAS bf16x8*)(LV + (16 * et + r16) * 256 + (((4 * ks + g) ^ r16) * 16));
                acc[et] = __builtin_amdgcn_mfma_f32_16x16x32_bf16(af, bf, acc[et], 0, 0, 0); } }
#pragma unroll
        for (int et = 0; et < 16; ++et) { u32x2 wv; wv.x = cvt_pk_bf16(acc[et][0], acc[et][1]); wv.y = cvt_pk_bf16(acc[et][2], acc[et][3]); *(u32x2*)(KVT + ((size_t)u * 256 + 16 * et + r16) * 128 + 16 * w + 4 * g) = wv; }
    }
    __syncthreads();
#undef KV_ISSUE
#undef KV_COMMIT
}
__device__ __forceinline__ void ph_ret_prefix(const Ctx& C) {
    unsigned char* ws = C.ws;
    const bf16* KVT = (const bf16*)(ws + WS_KVT); bf16* RTB = (bf16*)(ws + WS_RTB);
    for (int idx = C.bid * NTHR + C.tid; idx < 96 * 8192; idx += C.G * NTHR) {
        const int bh = idx >> 13, rem = idx & 8191; const int h = bh % 6;
        const float cd = exp2f(128.0f * RET_LG2[h]);
        f32x4 r = (f32x4){0.f, 0.f, 0.f, 0.f};
#pragma unroll
        for (int c = 0; c < 16; ++c) { const size_t off = ((size_t)(bh * 16 + c) * 8192 + rem) * 4;
            u32x2 w; w.x = cvt_pk_bf16(r[0], r[1]); w.y = cvt_pk_bf16(r[2], r[3]); *(u32x2*)(RTB + off) = w;
            const u32x2 kw = *(const u32x2*)(KVT + off); const f32x4 kv = (f32x4){bflo(kw.x), bfhi(kw.x), bflo(kw.y), bfhi(kw.y)}; r = r * cd + kv; }
    }
}
__device__ __forceinline__ void ph_ret_out(const Ctx& C, const float* gn) {
    unsigned char* ws = C.ws;
    const bf16* P = (const bf16*)(ws + WS_P); const bf16* QR = (const bf16*)(ws + WS_QR); const bf16* KR = (const bf16*)(ws + WS_KR);
    const bf16* VT = (const bf16*)(ws + WS_VT); const bf16* RTB = (const bf16*)(ws + WS_RTB); bf16* mix = (bf16*)(ws + WS_MIX);
    const int g = C.lane >> 4, r16 = C.lane & 15, w = C.wave;
    LAS unsigned char* LR = C.lds; LAS unsigned char* LV = C.lds + 65536;
    for (int u = C.bid; u < 1536; u += C.G) {
        const int c = u & 15, bh = u >> 4, h = bh % 6, b = bh / 6, m0 = b * SEQ + c * 128;
        const float lg2 = RET_LG2[h];
        __syncthreads();
        {   u32x4 st[16];
#pragma unroll
            for (int i = 0; i < 8; ++i) { const int q = C.tid + 512 * i, row = q >> 4, pc = q & 15;
                st[i] = *(const u32x4*)(RTB + ((size_t)u * 256 + row) * 128 + pc * 8);
                st[8 + i] = *(const u32x4*)(VT + (size_t)(bh * 256 + row) * SEQ + c * 128 + pc * 8); }
#pragma unroll
            for (int i = 0; i < 8; ++i) { const int q = C.tid + 512 * i, row = q >> 4, pc = q & 15; const int off = row * 256 + ((pc ^ (row & 15)) * 16);
                *(LAS u32x4*)(LR + off) = st[i]; *(LAS u32x4*)(LV + off) = st[8 + i]; }
        }
        __syncthreads();
        const int nl = 16 * w + r16;
        bf16x8 qf[4];
#pragma unroll
        for (int s = 0; s < 4; ++s) qf[s] = *(const bf16x8*)(QR + (size_t)(m0 + nl) * 768 + h * 128 + 32 * s + 8 * g);
        u32x2 gwv[16];
#pragma unroll
        for (int et = 0; et < 16; ++et) gwv[et] = *(const u32x2*)(P + (size_t)(m0 + nl) * LDP_RET + 3072 + h * 256 + 16 * et + 4 * g);
        f32x4 o[16];
        const float qdec = exp2f((float)(nl + 1) * lg2);
#pragma unroll
        for (int et = 0; et < 16; ++et) { f32x4 a = (f32x4){0.f, 0.f, 0.f, 0.f};
#pragma unroll
            for (int s = 0; s < 4; ++s) { const bf16x8 rf = *(const LAS bf16x8*)(LR + (16 * et + r16) * 256 + (((4 * s + g) ^ r16) * 16));
                a = __builtin_amdgcn_mfma_f32_16x16x32_bf16(rf, qf[s], a, 0, 0, 0); }
            o[et] = a * qdec; }
        u32x2 pb[8];
#pragma unroll
        for (int mt = 0; mt < 8; ++mt) {
            pb[mt] = (u32x2){0u, 0u};
            if (mt <= w) { f32x4 a = (f32x4){0.f, 0.f, 0.f, 0.f};
#pragma unroll
                for (int s = 0; s < 4; ++s) { const bf16x8 kf = *(const bf16x8*)(KR + (size_t)(m0 + 16 * mt + r16) * 768 + h * 128 + 32 * s + 8 * g);
                    a = __builtin_amdgcn_mfma_f32_16x16x32_bf16(kf, qf[s], a, 0, 0, 0); }
#pragma unroll
                for (int j = 0; j < 4; ++j) { const int diff = nl - (16 * mt + 4 * g + j); a[j] = diff >= 0 ? a[j] * exp2f((float)diff * lg2) : 0.f; }
                pb[mt].x = cvt_pk_bf16(a[0], a[1]); pb[mt].y = cvt_pk_bf16(a[2], a[3]); }
        }
#pragma unroll
        for (int ks = 0; ks < 4; ++ks) {
            if (2 * ks <= w) {
                u32x4 pw; pw.x = pb[2 * ks].x; pw.y = pb[2 * ks].y; pw.z = pb[2 * ks + 1].x; pw.w = pb[2 * ks + 1].y;
                const bf16x8 pf = __builtin_bit_cast(bf16x8, pw);
#pragma unroll
                for (int et = 0; et < 16; ++et) { const LAS unsigned char* vr = LV + (16 * et + r16) * 256;
                    const u32x2 lo = *(const LAS u32x2*)(vr + (((8 * ks + g) ^ (2 * r16)) * 8)), hi = *(const LAS u32x2*)(vr + (((8 * ks + 4 + g) ^ (2 * r16)) * 8));
                    u32x4 vw; vw.x = lo.x; vw.y = lo.y; vw.z = hi.x; vw.w = hi.y;
                    o[et] = __builtin_amdgcn_mfma_f32_16x16x32_bf16(__builtin_bit_cast(bf16x8, vw), pf, o[et], 0, 0, 0); } }
        }
        float s1 = 0.f;
#pragma unroll
        for (int et = 0; et < 16; ++et) s1 += (o[et][0] + o[et][1]) + (o[et][2] + o[et][3]);
        s1 += __shfl_xor(s1, 16); s1 += __shfl_xor(s1, 32);
        const float mean = s1 * (1.f / 256.f); float s2 = 0.f;
#pragma unroll
        for (int et = 0; et < 16; ++et) { o[et] = o[et] - mean; s2 += (o[et][0] * o[et][0] + o[et][1] * o[et][1]) + (o[et][2] * o[et][2] + o[et][3] * o[et][3]); }
        s2 += __shfl_xor(s2, 16); s2 += __shfl_xor(s2, 32);
        const float rstd = 1.0f / sqrtf(s2 * (1.f / 256.f) + 1e-5f);
        const int m = m0 + nl;
#pragma unroll
        for (int et = 0; et < 16; ++et) { const int e = h * 256 + 16 * et + 4 * g;
            const f32x4 gg = *(const f32x4*)(gn + e), gb = *(const f32x4*)(gn + SW + e);
            const u32x2 gw_ = gwv[et];
            float gt[4] = {bflo(gw_.x), bfhi(gw_.x), bflo(gw_.y), bfhi(gw_.y)}; float ov[4];
#pragma unroll
            for (int j = 0; j < 4; ++j) { const float yn = o[et][j] * rstd * gg[j] + gb[j]; ov[j] = yn * gt[j] * sigmoidf_(gt[j]); }
            u32x2 wv; wv.x = cvt_pk_bf16(ov[0], ov[1]); wv.y = cvt_pk_bf16(ov[2], ov[3]);
            *(u32x2*)(mix + (size_t)m * D + e) = wv; }
    }
    __syncthreads();
}

constexpr int PH_PER_PAIR = 23, NPH = 2 + 2 * PH_PER_PAIR;
__global__ void __launch_bounds__(NTHR, 2) fwd_kernel(Args args) {
    extern __shared__ __attribute__((aligned(16))) unsigned char lds_raw[];
    Ctx C;
    C.lds = (LAS unsigned char*)lds_raw;
    C.tid = threadIdx.x; C.lane = C.tid & 63; C.wave = __builtin_amdgcn_readfirstlane(C.tid >> 6);
    C.bid = blockIdx.x; C.G = GRID; C.gw = C.bid * NWAVES + C.wave; C.NGW = C.G * NWAVES; C.ws = args.ws;
    for (int u = C.tid; u < (LDS_BYTES - LDS_MISC) / 4; u += NTHR) ((LAS unsigned*)(C.lds + LDS_MISC))[u] = 0u;
    __syncthreads();
    const int lo = args.ph_lo, hi = args.ph_hi;
    XcdBarrier bar; bar.bar = (unsigned*)(args.ws + WS_CTL) + CW_BAR; bar.x = 0; bar.st = nullptr;
    if (hi - lo > 1) bar = xcd_barrier_post((unsigned*)(args.ws + WS_CTL) + CW_BAR, (volatile LAS unsigned*)(C.lds + LDS_MISC));
#ifndef ENMASK
#define ENMASK 0x1ffffffu
#endif
#define EN(j) ((((unsigned)(ENMASK)) >> (j)) & 1u)
#ifndef DBLMASK
#define DBLMASK 0u
#endif
#define REP(j) for (int rep_ = 0; rep_ < 1 + (int)((((unsigned)(DBLMASK)) >> (j)) & 1u); ++rep_)
#define IN(k) (lo <= (k) && (k) < hi)
#define SEAM(k) do { if (IN((k) + 1)) xcd_barrier(bar, Cq.tid == 0); } while (0)

#define PH_BEGIN Ctx Cq; Cq.lds = C.lds; Cq.lane = lane_id_asm(); Cq.wave = opq_i(C.wave); Cq.tid = Cq.wave * 64 + Cq.lane; Cq.bid = opq_i((int)blockIdx.x); Cq.G = GRID; \
        Cq.gw = Cq.bid * NWAVES + Cq.wave; Cq.NGW = Cq.G * NWAVES; Cq.ws = opq(args.ws); unsigned char* ws = Cq.ws; const int lq = opq_i(lp); (void)ws; (void)lq
    { const int lp = 0;
    REP(0) if (EN(0) && IN(0)) { PH_BEGIN; ph_prologue(Cq, args); SEAM(0); }
    REP(1) if (EN(1) && IN(1)) { PH_BEGIN;
        pg8::SchedMem S; S.G = Cq.G; S.c = Cq.bid; S.memb = (unsigned)WS_MEMB; S.wkv = (unsigned)WS_WKV;
        pg8::EpiMem E; E.O0 = (bf16*)(ws + WS_MEMK); E.O1 = (bf16*)(ws + WS_MEMVT);
        pg8::gemm_phase<pg8::EpiMem, pg8::SchedMem, true, true>(Cq.lds, Cq.tid, (const char*)ws, 2048, 2048, 2048, S, E);
        SEAM(1);
    } }
#pragma unroll 1
    for (int lp = 0; lp < 2; ++lp) {
        const int pb = 2 + lp * PH_PER_PAIR;
        REP(2) if (EN(2) && IN(pb + 0)) {
            PH_BEGIN;
            pg8::SchedPlain S; S.init(M / 256, 22, Cq.G, Cq.bid); S.A0 = (unsigned)(WS_XB); S.B0 = (unsigned)(WS_WIN + (size_t)(2 * lq) * 22 * MiB); S.at = (unsigned)(256 * 2048 * 2); S.bt = (unsigned)(256 * 2048 * 2);
            pg8::EpiBf16 E; E.O = (bf16*)(ws + WS_P); E.ldc = LDP_RW;
            pg8::gemm_phase<pg8::EpiBf16, pg8::SchedPlain, true, true>(Cq.lds, Cq.tid, (const char*)ws, 2048, 2048, 2048, S, E);
            SEAM(pb + 0);
        }
        REP(3) if (EN(3) && IN(pb + 1)) { PH_BEGIN; const bool with_v = lq == 1; ph_rwkv_prep1(Cq, args.in[lq ? L2_MU : L0_MU], with_v); ph_memattn(Cq, (const bf16*)(ws + WS_P), LDP_RW, with_v ? 5120 : 5056); SEAM(pb + 1); }
        REP(4) if (EN(4) && IN(pb + 2)) {
            PH_BEGIN; const float* vecs = args.in[lq ? L2_VECS : L0_VECS];
            pg8::SchedLora S; S.skipv = lq == 0; S.init(M / 256, lq == 0 ? 18 : 24, Cq.G, Cq.bid); S.A0 = (unsigned)(WS_ALORA); S.B0 = (unsigned)(WS_WLORA + (size_t)lq * 3 * MiB);
            pg8::EpiLora E; E.O = (bf16*)(ws + WS_LORAOUT); E.vecs = vecs;
            pg8::gemm_phase<pg8::EpiLora, pg8::SchedLora, true, true>(Cq.lds, Cq.tid, (const char*)ws, 512, 256, opq_i(256), S, E);
            SEAM(pb + 2);
        }
        REP(5) if (EN(5) && IN(pb + 3)) { PH_BEGIN; ph_rwkv_prep2(Cq, args.in[lq ? L2_MU : L0_MU], args.in[lq ? L2_VECS : L0_VECS], lq == 1); SEAM(pb + 3); }
        REP(6) if (EN(6) && IN(pb + 4)) { PH_BEGIN; ph_rwkv_scan(Cq, args.in[lq ? L3_MG : L1_MG], args.in[lq ? L3_MU_ : L1_MU_], args.in[lq ? L3_MD : L1_MD], args.in[lq ? L2_VECS : L0_VECS], lq == 1); SEAM(pb + 4); }
        REP(8) if (EN(8) && IN(pb + 6)) {
            PH_BEGIN;
            pg8::SchedPlain S; S.init(M / 256, 8, Cq.G, Cq.bid); S.A0 = (unsigned)(WS_MIX); S.B0 = (unsigned)(WS_WOUT + (size_t)(2 * lq) * 8 * MiB); S.at = (unsigned)(256 * 2048 * 2); S.bt = (unsigned)(256 * 2048 * 2);
            pg8::EpiBf16 E; E.O = (bf16*)(ws + WS_P); E.ldc = D;
            pg8::gemm_phase<pg8::EpiBf16, pg8::SchedPlain, true, true>(Cq.lds, Cq.tid, (const char*)ws, 2048, 2048, 2048, S, E);
            SEAM(pb + 6);
        }
        REP(9) if (EN(9) && IN(pb + 7)) { PH_BEGIN; const float* nr = args.in[lq ? L2_NORMS : L0_NORMS];
            ph_ln(Cq, ws + WS_P, 0, nr, nr + D, nullptr, ws + WS_X8, nullptr, false); SEAM(pb + 7); }
        REP(10) if (EN(10) && IN(pb + 8)) {
            PH_BEGIN;
            pg8::SchedPlain S; S.init(M / 256, 44, Cq.G, Cq.bid); S.A0 = (unsigned)(WS_X8); S.B0 = (unsigned)(WS_WFGU + (size_t)lq * 44 * MiB); S.at = (unsigned)(256 * 2048); S.bt = (unsigned)(256 * 2048);
            pg8::EpiSwiglu8 E; E.O = ws + WS_HID; E.ldc = DFF; E.inv = 1.0f / 16384.0f; E.so = 32.0f;
            pg8::gemm_phase<pg8::EpiSwiglu8, pg8::SchedPlain, true, true, true>(Cq.lds, Cq.tid, (const char*)ws, 1024, 1024, 1024, S, E);
            SEAM(pb + 8);
        }
        REP(11) if (EN(11) && IN(pb + 9)) {
            PH_BEGIN;
            pg8::SchedPlain S; S.init(M / 256, 8, Cq.G, Cq.bid); S.A0 = (unsigned)(WS_HID); S.B0 = (unsigned)(WS_WFD + (size_t)lq * 22 * MiB); S.at = (unsigned)(256 * DFF); S.bt = (unsigned)(256 * DFF);
            pg8::EpiFp8S E; E.O = ws + WS_P; E.ldc = D; E.sc = 1.0f / 256.0f;
            pg8::gemm_phase<pg8::EpiFp8S, pg8::SchedPlain, true, true, true>(Cq.lds, Cq.tid, (const char*)ws, DFF / 2, DFF / 2, DFF / 2, S, E);
            SEAM(pb + 9);
        }
        REP(12) if (EN(12) && IN(pb + 10)) { PH_BEGIN; const float* nr = args.in[lq ? L2_NORMS : L0_NORMS];
            ph_ln(Cq, ws + WS_P, 1, nr + 2 * D, nr + 3 * D, nullptr, nullptr, nullptr, false); SEAM(pb + 10); }
        REP(13) if (EN(13) && IN(pb + 11)) {
            PH_BEGIN;
            pg8::SchedPlain S; S.init(M / 256, 20, Cq.G, Cq.bid); S.A0 = (unsigned)(WS_XB); S.B0 = (unsigned)(WS_WIN + (size_t)(2 * lq + 1) * 22 * MiB); S.at = (unsigned)(256 * 2048 * 2); S.bt = (unsigned)(256 * 2048 * 2);
            pg8::EpiBf16 E; E.O = (bf16*)(ws + WS_P); E.ldc = LDP_RET;
            pg8::gemm_phase<pg8::EpiBf16, pg8::SchedPlain, true, true>(Cq.lds, Cq.tid, (const char*)ws, 2048, 2048, 2048, S, E);
            SEAM(pb + 11);
        }
        REP(14) if (EN(14) && IN(pb + 12)) { PH_BEGIN; ph_ret_prep(Cq); ph_memattn(Cq, (const bf16*)(ws + WS_P), LDP_RET, 4608); SEAM(pb + 12); }
        REP(16) if (EN(16) && IN(pb + 14)) { PH_BEGIN; ph_ret_prefix(Cq); SEAM(pb + 14); }
        REP(17) if (EN(17) && IN(pb + 15)) { PH_BEGIN; ph_ret_out(Cq, args.in[lq ? L3_GN : L1_GN]); SEAM(pb + 15); }
        REP(18) if (EN(18) && IN(pb + 16)) {
            PH_BEGIN;
            pg8::SchedPlain S; S.init(M / 256, 8, Cq.G, Cq.bid); S.A0 = (unsigned)(WS_MIX); S.B0 = (unsigned)(WS_WOUT + (size_t)(2 * lq + 1) * 8 * MiB); S.at = (unsigned)(256 * 2048 * 2); S.bt = (unsigned)(256 * 2048 * 2);
            pg8::EpiBf16 E; E.O = (bf16*)(ws + WS_P); E.ldc = D;
            pg8::gemm_phase<pg8::EpiBf16, pg8::SchedPlain, true, true>(Cq.lds, Cq.tid, (const char*)ws, 2048, 2048, 2048, S, E);
            SEAM(pb + 16);
        }
        REP(19) if (EN(19) && IN(pb + 17)) {
            PH_BEGIN; const float* nr = args.in[lq ? L3_NORMS : L1_NORMS];
            REP(25) { ph_ln(Cq, ws + WS_P, 0, nr, nr + D, nullptr, ws + WS_X8, args.in[lq ? L3_ROUTER : L1_ROUTER], true);
            __syncthreads(); }
            SEAM(pb + 17);
        }
        REP(20) if (EN(20) && IN(pb + 18)) { PH_BEGIN; ph_slots(Cq); SEAM(pb + 18); }
        REP(22) if (EN(22) && IN(pb + 20)) {
            PH_BEGIN;
            const int nT = __builtin_amdgcn_readfirstlane(((const int*)(ws + WS_CTL))[CW_NT]);
            pg8::SchedMoEg S; S.init(nT, 44, Cq.G, Cq.bid); S.B0 = (unsigned)(WS_MWGU); S.bt = (unsigned)(256 * 2048); S.be = (unsigned)(22 * MiB);
            S.xoff = (unsigned)WS_X8; S.zoff = (unsigned)(WS_CTL + 512 * 1024); S.texp = (const int*)(ws + WS_CTL) + CW_TEXP; S.slot_tok = (const int*)(ws + WS_SLOTTOK);
            pg8::EpiSwiglu8 E; E.O = ws + WS_HIDM; E.ldc = DFF; E.inv = 1.0f / 16384.0f; E.so = 32.0f;
            pg8::gemm_phase<pg8::EpiSwiglu8, pg8::SchedMoEg, true, true, true>(Cq.lds, Cq.tid, (const char*)ws, 1024, 1024, 1024, S, E);
            SEAM(pb + 20);
        }
        REP(23) if (EN(23) && IN(pb + 21)) {
            PH_BEGIN;
            const int nT = __builtin_amdgcn_readfirstlane(((const int*)(ws + WS_CTL))[CW_NT]);
            pg8::SchedMoE S; S.init(nT, 8, Cq.G, Cq.bid); S.A0 = (unsigned)(WS_HIDM); S.B0 = (unsigned)(WS_MWD); S.at = (unsigned)(256 * DFF); S.bt = (unsigned)(256 * DFF); S.be = (unsigned)(11 * MiB);
            S.texp = (const int*)(ws + WS_CTL) + CW_TEXP;
            pg8::EpiFp8S E; E.O = ws + WS_XPERM; E.ldc = D; E.sc = 1.0f / 256.0f;
            pg8::gemm_phase<pg8::EpiFp8S, pg8::SchedMoE, true, true, true>(Cq.lds, Cq.tid, (const char*)ws, DFF / 2, DFF / 2, DFF / 2, S, E);
            SEAM(pb + 21);
        }
        REP(24) if (EN(24) && IN(pb + 22)) {
            PH_BEGIN; const float* nr = args.in[lq ? L3_NORMS : L1_NORMS];
            ph_ln(Cq, ws + WS_XPERM, 2, nr + 2 * D, nr + 3 * D, lq == 1 ? args.out : nullptr, nullptr, nullptr, false);
            SEAM(pb + 22);
        }
    }
#undef IN
#undef SEAM
}

#ifndef MK_PER_PHASE
#define MK_PER_PHASE 0
#endif
extern "C" void kernel_launch(void* const* d_in, const int* in_sizes, int n_in, void* d_out, int out_size, void* d_ws, size_t ws_size, hipStream_t stream) {
    static int ready = 0;
    if (ready == 0) {
        ready = 1;
        if (n_in != 43 || out_size != M * D || ws_size < WS_END) { fprintf(stderr, "kernel_launch: unexpected problem (n_in %d out %d ws %zu need %zu)\n", n_in, out_size, ws_size, (size_t)WS_END); ready = -1; }
        else if (hipFuncSetAttribute((const void*)fwd_kernel, hipFuncAttributeMaxDynamicSharedMemorySize, LDS_BYTES) != hipSuccess) { fprintf(stderr, "kernel_launch: hipFuncSetAttribute failed\n"); ready = -1; }
        (void)hipGetLastError();
    }
    if (ready < 0) return;
    (void)hipMemsetAsync((char*)d_ws + WS_CTL, 0, CTL_BYTES, stream);
    Args a{};
    for (int i = 0; i < 43; ++i) a.in[i] = (const float*)d_in[i];
    a.out = (float*)d_out; a.ws = (unsigned char*)d_ws;
#if MK_PER_PHASE
    for (int p = 0; p < NPH; ++p) { a.ph_lo = p; a.ph_hi = p + 1; hipLaunchKernelGGL(fwd_kernel, dim3(GRID), dim3(NTHR), LDS_BYTES, stream, a); }
#else
    a.ph_lo = 0; a.ph_hi = NPH;
    hipLaunchKernelGGL(fwd_kernel, dim3(GRID), dim3(NTHR), LDS_BYTES, stream, a);
#endif
}
```

```cpp
#include <hip/hip_runtime.h>
#include <cstdio>
#include <cstdint>

#define LAS __attribute__((address_space(3)))
#define GAS __attribute__((address_space(1)))
typedef unsigned short bf16;
typedef short bf16x8 __attribute__((ext_vector_type(8)));
typedef float f32x4 __attribute__((ext_vector_type(4)));
typedef float f32x2 __attribute__((ext_vector_type(2)));
typedef unsigned u32x4 __attribute__((ext_vector_type(4)));
typedef unsigned u32x2 __attribute__((ext_vector_type(2)));

constexpr int M = 32768, D = 2048, SEQ = 2048, NB = 16;
constexpr int SW = 1536;
constexpr int LDP_RW = 5632, LDP_RET = 5120;
constexpr int DFF = 5632;
constexpr int NSLOT = 67584;
constexpr float ALPHA = 1.6817928305074290f;
constexpr float LN_EPS = 1e-5f;
constexpr int NWAVES = 8, NTHR = 512, GRID = 256;

constexpr size_t MiB = 1u << 20;
constexpr size_t WS_CTL = 0, CTL_BYTES = 1 * MiB;
constexpr size_t WS_WKV = 1 * MiB;
constexpr size_t WS_WIN = WS_WKV + 4 * MiB;
constexpr size_t WS_WOUT = WS_WIN + 88 * MiB;
constexpr size_t WS_WLORA = WS_WOUT + 32 * MiB;
constexpr size_t WS_WFGU = WS_WLORA + 6 * MiB;
constexpr size_t WS_WFD = WS_WFGU + 88 * MiB;
constexpr size_t WS_MEMB = WS_WFD + 44 * MiB;
constexpr size_t WS_MEMK = WS_MEMB + 16 * MiB;
constexpr size_t WS_MEMVT = WS_MEMK + 4 * MiB;
constexpr size_t WS_CS = WS_MEMVT + 4 * MiB;
constexpr size_t WS_XB = WS_CS + 16 * MiB;
constexpr size_t WS_MIX = WS_XB + 128 * MiB;
constexpr size_t WS_VFIRST = WS_MIX + 128 * MiB;
constexpr size_t WS_P = WS_VFIRST + 96 * MiB;
constexpr size_t WS_MISC = WS_P + 352 * MiB;
constexpr size_t WS_ROUTE = WS_MISC, WS_SLOT1 = WS_MISC + 512 * 1024, WS_SLOT2 = WS_SLOT1 + 128 * 1024, WS_SLOTTOK = WS_SLOT2 + 128 * 1024;
constexpr size_t WS_BONUS = WS_MISC + 2 * MiB;
constexpr size_t WS_SB = WS_BONUS + 3 * MiB;
constexpr size_t WS_ALORA = WS_SB, WS_LORAOUT = WS_SB + 32 * MiB, WS_SCANIN = WS_SB + 416 * MiB;
constexpr size_t WS_QR = WS_SB, WS_KR = WS_SB + 48 * MiB, WS_KDT = WS_SB + 96 * MiB, WS_VT = WS_SB + 144 * MiB, WS_KVT = WS_SB + 240 * MiB, WS_RTB = WS_SB + 432 * MiB;
constexpr size_t WS_HID = WS_SB;
constexpr size_t WS_XPERM = WS_SB, WS_HIDM = WS_SB + 264 * MiB, WS_MWGU = WS_SB + 1184 * MiB, WS_MWD = WS_SB + 1360 * MiB;
constexpr size_t WS_XLO = WS_SB + 1518 * MiB;
constexpr size_t WS_X8 = WS_XLO + 64 * MiB;
constexpr size_t WS_END = WS_X8 + 64 * MiB;
constexpr int CW_BAR = 4096;
constexpr int CW_CNT = 16384;
constexpr int CW_NT = 20480;
constexpr int CW_TEXP = 20544;

constexpr int RING_BYTES = 131072;
constexpr int LDS_MISC = RING_BYTES;
constexpr int LDS_BYTES = RING_BYTES + 8192;

#define LDS_WAIT() asm volatile("s_waitcnt lgkmcnt(0)" ::: "memory")
#define VM_WAIT() asm volatile("s_waitcnt vmcnt(0)" ::: "memory")
__device__ __forceinline__ unsigned cvt_pk_bf16(float lo, float hi) { unsigned r; asm volatile("v_cvt_pk_bf16_f32 %0, %1, %2" : "=v"(r) : "v"(lo), "v"(hi)); return r; }
__device__ __forceinline__ bf16 f2bf(float f) { return (bf16)(cvt_pk_bf16(f, 0.f) & 0xffffu); }
__device__ __forceinline__ float bf2f(bf16 b) { return __uint_as_float(((unsigned)b) << 16); }
__device__ __forceinline__ float bflo(unsigned w) { return __uint_as_float(w << 16); }
__device__ __forceinline__ float bfhi(unsigned w) { return __uint_as_float(w & 0xffff0000u); }
template <int CTRL> __device__ __forceinline__ float dpp_add(float x) {
    int y = __builtin_amdgcn_update_dpp(0, __float_as_int(x), CTRL, 0xf, 0xf, true);
    return x + __int_as_float(y);
}
__device__ __forceinline__ float row16_sum(float x) { x = dpp_add<0xB1>(x); x = dpp_add<0x4E>(x); x = dpp_add<0x141>(x); x = dpp_add<0x140>(x); return x; }
__device__ __forceinline__ float wave_sum(float v) {
    v = row16_sum(v);
    const float a = __int_as_float(__builtin_amdgcn_readlane(__float_as_int(v), 0)), b = __int_as_float(__builtin_amdgcn_readlane(__float_as_int(v), 16));
    const float c = __int_as_float(__builtin_amdgcn_readlane(__float_as_int(v), 32)), d = __int_as_float(__builtin_amdgcn_readlane(__float_as_int(v), 48));
    return (a + b) + (c + d);
}
__device__ __forceinline__ unsigned pk4_fp8(float a, float b, float c, float d) {
    a = __builtin_amdgcn_fmed3f(a, -448.f, 448.f); b = __builtin_amdgcn_fmed3f(b, -448.f, 448.f); c = __builtin_amdgcn_fmed3f(c, -448.f, 448.f); d = __builtin_amdgcn_fmed3f(d, -448.f, 448.f);
    unsigned w = 0; w = __builtin_amdgcn_cvt_pk_fp8_f32(a, b, w, false); w = __builtin_amdgcn_cvt_pk_fp8_f32(c, d, w, true); return w; }
__device__ __forceinline__ float sigmoidf_(float z) { return __builtin_amdgcn_rcpf(1.0f + __expf(-z)); }

__device__ __forceinline__ unsigned char* opq(unsigned char* p) { asm volatile("" : "+s"(p)); return p; }
__device__ __forceinline__ int opq_i(int v) { asm volatile("" : "+s"(v)); return v; }
__device__ __forceinline__ int opq_v(int v) { asm volatile("" : "+v"(v)); return v; }
__device__ __forceinline__ int lane_id_asm() { int l; asm volatile("v_mbcnt_lo_u32_b32 %0, -1, 0\n\tv_mbcnt_hi_u32_b32 %0, -1, %0" : "=v"(l)); return l; }
__device__ __forceinline__ float shx(float v, int lane, int m) { return __builtin_bit_cast(float, __builtin_amdgcn_ds_bpermute((lane ^ m) << 2, __builtin_bit_cast(int, v))); }
__device__ __forceinline__ float shl(float v, int src) { return __builtin_bit_cast(float, __builtin_amdgcn_ds_bpermute(src << 2, __builtin_bit_cast(int, v))); }
#define XB_TMO      128
#define XB_XCNT(j)  (256  + 64 * (j))
#define XB_XSUB(j)  (1280 + 64 * (j))
#define XB_XGEN(j)  (2304 + 64 * (j))
#define XB_TOP      3328
#define XB_TOPGEN   3392
#define XCD_BAR_WORDS 3456
#define XB_SPIN_CAP (1u << 18)
__device__ __forceinline__ unsigned xb_ld(unsigned* p)              { return __hip_atomic_load(p, __ATOMIC_RELAXED, __HIP_MEMORY_SCOPE_AGENT); }
__device__ __forceinline__ unsigned xb_add(unsigned* p, unsigned v) { return __hip_atomic_fetch_add(p, v, __ATOMIC_RELAXED, __HIP_MEMORY_SCOPE_AGENT); }
__device__ __forceinline__ unsigned xb_xcc_id() { return (unsigned)__builtin_amdgcn_s_getreg((3 << 11) | 20) & 0xFu; }
#define XB_SPIN(cond, bar) do { unsigned _sp = 0; while (cond) { __builtin_amdgcn_s_sleep(1); \
    if ((++_sp & 255u) == 0u) { if (xb_ld(&(bar)[XB_TMO])) break; if (_sp > XB_SPIN_CAP) { atomicAdd(&(bar)[XB_TMO], 1u); break; } } } } while (0)
struct XcdBarrier { unsigned* bar; unsigned x; volatile LAS unsigned* st; };
__device__ __forceinline__ XcdBarrier xcd_barrier_post(unsigned* bar, volatile LAS unsigned* st) {
    XcdBarrier b; b.bar = bar; b.x = xb_xcc_id(); b.st = st;
    if (threadIdx.x == 0) (void)xb_add(&bar[XB_XCNT(b.x)], 1u);
    return b;
}
__device__ __forceinline__ void xcd_barrier_complete(unsigned* bar, unsigned x, unsigned& nloc, unsigned& nx) {
    const unsigned G = gridDim.x * gridDim.y * gridDim.z;
    unsigned sum, cnt, mine, sp = 0u;
    for (;;) {
        sum = 0u; cnt = 0u; mine = 0u;
#pragma unroll
        for (unsigned j = 0; j < 16; ++j) { const unsigned c = xb_ld(&bar[XB_XCNT(j)]); sum += c; cnt += (c > 0u) ? 1u : 0u; mine = (j == x) ? c : mine; }
        if (sum == G) break;
        __builtin_amdgcn_s_sleep(1);
        if ((++sp & 255u) == 0u) { if (xb_ld(&bar[XB_TMO])) break; if (sp > XB_SPIN_CAP) { atomicAdd(&bar[XB_TMO], 1u); break; } }
    }
    nloc = mine > 0u ? mine : 1u; nx = cnt > 0u ? cnt : 1u;
}
__device__ __forceinline__ void xcd_barrier(const XcdBarrier& b, const bool leader  ) {
    asm volatile("s_waitcnt vmcnt(0)" ::: "memory");
    __syncthreads();
    if (leader) {
        unsigned* bar = b.bar;
        __builtin_amdgcn_s_waitcnt(0);
        unsigned nloc = b.st[0], nx = b.st[1];
        if (nloc == 0u) { xcd_barrier_complete(bar, b.x, nloc, nx); b.st[0] = nloc; b.st[1] = nx; }
        const unsigned old = xb_add(&bar[XB_XSUB(b.x)], 1u);
        const unsigned gen = old / nloc;
        if (old + 1u == (gen + 1u) * nloc) {
            __builtin_amdgcn_fence(__ATOMIC_RELEASE, "agent");
            asm volatile("s_waitcnt vmcnt(0)" ::: "memory");
            const unsigned og = xb_add(&bar[XB_TOP], 1u);
            const unsigned tg = og / nx;
            if (og + 1u == (tg + 1u) * nx) xb_add(&bar[XB_TOPGEN], 1u);
            else XB_SPIN(xb_ld(&bar[XB_TOPGEN]) == tg, bar);
            __builtin_amdgcn_fence(__ATOMIC_ACQUIRE, "agent");
            xb_add(&bar[XB_XGEN(b.x)], 1u);
            asm volatile("s_waitcnt vmcnt(0)" ::: "memory");
        } else {
            XB_SPIN(xb_ld(&bar[XB_XGEN(b.x)]) == gen, bar);
            __builtin_amdgcn_fence(__ATOMIC_ACQUIRE, "agent");
            asm volatile("s_waitcnt vmcnt(0)" ::: "memory");
        }
    }
    __syncthreads();
}

namespace pg8 {
constexpr int BM = 256, BK = 64, HALF = 128, HTB = HALF * BK * 2, STAGE_BYTES = 8 * HTB, NXCD = 8, WGM = 8;
__host__ __device__ __forceinline__ int lds_byte(int r, int c) { const int st = (r >> 4) * 2 + (c >> 5), rr = r & 15, cc = c & 31, ob = rr * 64 + cc * 2; return st * 1024 + (ob ^ (((ob >> 9) & 1) << 5)); }
__host__ __device__ __forceinline__ void stage_rc(int b, int& R, int& C) { const int st = b / 1024, sb = b % 1024, swz = sb ^ (((sb >> 9) & 1) << 5); R = (st >> 1) * 16 + swz / 64; C = (st & 1) * 32 + (swz % 64) / 2; }
__host__ __device__ __forceinline__ int perm32(int rho) { const int n = rho >> 4, i = rho & 15; return 8 * (i >> 2) + 4 * n + (i & 3); }
typedef int i32x8 __attribute__((ext_vector_type(8)));
typedef int i32x4_ __attribute__((ext_vector_type(4)));
__device__ __forceinline__ i32x8 cat8(bf16x8 a, bf16x8 b) { const i32x4_ x = __builtin_bit_cast(i32x4_, a), y = __builtin_bit_cast(i32x4_, b); return __builtin_shufflevector(x, y, 0, 1, 2, 3, 4, 5, 6, 7); }
__device__ __forceinline__ void mfma8(f32x4& acc, const i32x8 a, const i32x8 b) {
    asm volatile("v_mfma_scale_f32_16x16x128_f8f6f4 %0, %1, %2, %0, %3, %3 op_sel_hi:[0,0,0]" : "+v"(acc) : "v"(a), "v"(b), "v"(127)); }
struct Unit { int pm, pn, z; };
struct Order {
    int nM, nN, nwg, G, c;
    __device__ __forceinline__ void init(int nM_, int nN_, int G_, int c_) { nM = nM_; nN = nN_; nwg = nM * nN; G = G_; c = c_; }
    __device__ __forceinline__ bool next_mn(int i, Unit& u) const {
        const long L = (long)i * G + c; if (L >= nwg) return false;
        int wgid = (int)L; { const int q = nwg / NXCD, r = nwg % NXCD, xcd = wgid % NXCD, off = wgid / NXCD; wgid = (xcd < r ? xcd * (q + 1) : r * (q + 1) + (xcd - r) * q) + off; }
        const int nig = WGM * nN, gid = wgid / nig, fm = gid * WGM, gsz = (nM - fm) < WGM ? (nM - fm) : WGM;
        u.pm = fm + ((wgid % nig) % gsz); u.pn = (wgid % nig) / gsz; u.z = 0; return true;
    }
};

template <class Epi, class Sched, bool ALIGN_EPI, bool SP2, bool FP8 = false>
__device__ __forceinline__ void gemm_phase(LAS unsigned char* lds, const int tid_in, const char* base  , const int lda, const int ldb, const int K, const Sched& S, const Epi& E) {
    const int tid = tid_in, wid = __builtin_amdgcn_readfirstlane(tid >> 6), lane = tid & 63, wr = wid >> 2, wc = wid & 3, fr = lane & 15, fq = lane >> 4;
    const int nt = K / BK;
    unsigned voffA[2], voffB[2];
#pragma unroll
    for (int i = 0; i < 2; ++i) { int R, C; stage_rc(tid * 16 + i * 8192, R, C); const int Rb = Epi::PERM ? ((R & ~31) + perm32(R & 31)) : R;
        voffA[i] = (unsigned)(R * lda + C) * 2u; voffB[i] = (unsigned)(Rb * ldb + C) * 2u; }
    constexpr bool GATHER = Sched::GATHER;
    unsigned gvC[2][2], gvN[2][2];
#define PG8_GV(dst, unit) do { _Pragma("unroll") for (int hh_ = 0; hh_ < 2; ++hh_) _Pragma("unroll") for (int i_ = 0; i_ < 2; ++i_) { int R_, C_; stage_rc(tid * 16 + i_ * 8192, R_, C_); \
        dst[hh_][i_] = S.arow(unit, hh_ * HALF + R_) + (unsigned)C_ * 2u; } } while (0)
    const unsigned kstep = (unsigned)(BK * 2);
    const unsigned hstepA = (unsigned)(HALF * lda * 2), hstepB = (unsigned)(HALF * ldb * 2);
    const __amdgpu_buffer_rsrc_t rsrc = __builtin_amdgcn_make_buffer_rsrc((void*)base, 0, 0xffffffffu, 0x00020000);
    const unsigned ldsw = (unsigned)wid * 1024u;
    const int aoff = lds_byte(wr * 64 + fr, fq * 8), boff = lds_byte(wc * 32 + fr, fq * 8);
#define PG8_SA(b, h) (((b) * 2 + (h)) * HTB)
#define PG8_SB(b, h) ((4 + (b) * 2 + (h)) * HTB)
#define PG8_STAGE(bufoff, goff, voff) do { _Pragma("unroll") for (int _i = 0; _i < 2; ++_i) \
        __builtin_amdgcn_raw_ptr_buffer_load_lds(rsrc, (LAS unsigned*)(lds + (bufoff) + ldsw + _i * 8192), 16, (voff)[_i], (goff), 0, 0); } while (0)
#define PG8_STAGE_A(bufoff, aoff, hh, nx) do { if constexpr (GATHER) { unsigned gv_[2]; gv_[0] = (nx) ? gvN[hh][0] : gvC[hh][0]; gv_[1] = (nx) ? gvN[hh][1] : gvC[hh][1]; PG8_STAGE(bufoff, aoff, gv_); } \
        else { PG8_STAGE(bufoff, (aoff) + (hh) * hstepA, voffA); } } while (0)
#define PG8_LDA(dst, b, h) do { _Pragma("unroll") for (int m = 0; m < 4; ++m) _Pragma("unroll") for (int k = 0; k < 2; ++k) dst[m][k] = *(const LAS bf16x8*)(lds + PG8_SA(b, h) + aoff + m * 2048 + k * 1024); } while (0)
#define PG8_LDB(dst, b, h) do { _Pragma("unroll") for (int n = 0; n < 2; ++n) _Pragma("unroll") for (int k = 0; k < 2; ++k) dst[n][k] = *(const LAS bf16x8*)(lds + PG8_SB(b, h) + boff + n * 2048 + k * 1024); } while (0)
#define PG8_MMA(ai, bj, At, Bt) do { __builtin_amdgcn_s_setprio(1); \
        if constexpr (FP8) { _Pragma("unroll") for (int m = 0; m < 4; ++m) _Pragma("unroll") for (int n = 0; n < 2; ++n) \
            mfma8(acc[ai][bj][m][n], cat8(Bt[n][0], Bt[n][1]), cat8(At[m][0], At[m][1])); } \
        else { _Pragma("unroll") for (int m = 0; m < 4; ++m) _Pragma("unroll") for (int n = 0; n < 2; ++n) _Pragma("unroll") for (int k = 0; k < 2; ++k) \
            acc[ai][bj][m][n] = __builtin_amdgcn_mfma_f32_16x16x32_bf16(Bt[n][k], At[m][k], acc[ai][bj][m][n], 0, 0, 0); } \
        __builtin_amdgcn_s_setprio(0); } while (0)
#define PG8_WAIT_V(n) asm volatile("s_waitcnt vmcnt(" #n ")" ::: "memory")
#define PG8_WAIT_L(n) asm volatile("s_waitcnt lgkmcnt(" #n ")" ::: "memory")
#define PG8_BAR __builtin_amdgcn_s_barrier()
#define PG8_SCHED __builtin_amdgcn_sched_barrier(0)
    Unit cur, nxt; int ui = 0;
    if (!S.next(0, cur)) return;
    f32x4 acc[2][2][4][2];
#pragma unroll
    for (int a = 0; a < 2; ++a)
#pragma unroll
        for (int b = 0; b < 2; ++b)
#pragma unroll
            for (int m = 0; m < 4; ++m)
#pragma unroll
                for (int n = 0; n < 2; ++n) acc[a][b][m][n] = (f32x4){0.f, 0.f, 0.f, 0.f};
    bf16x8 At[4][2], B0[2][2], B1[2][2];
    unsigned cA = S.A(cur), cB = S.B(cur);
    if constexpr (GATHER) { PG8_GV(gvC, cur); _Pragma("unroll") for (int hh_ = 0; hh_ < 2; ++hh_) _Pragma("unroll") for (int i_ = 0; i_ < 2; ++i_) gvN[hh_][i_] = gvC[hh_][i_]; }
    if constexpr (SP2) {
        PG8_STAGE(PG8_SB(0, 0), cB, voffB); PG8_STAGE(PG8_SB(0, 1), cB + hstepB, voffB); PG8_STAGE_A(PG8_SA(0, 0), cA, 0, false); PG8_STAGE_A(PG8_SA(0, 1), cA, 1, false);
        if (wr == 1) PG8_BAR;
        PG8_WAIT_V(2); PG8_BAR;
        PG8_STAGE(PG8_SB(1, 0), cB + kstep, voffB); PG8_STAGE_A(PG8_SA(1, 0), cA + kstep, 0, false); PG8_STAGE(PG8_SB(1, 1), cB + hstepB + kstep, voffB);
        PG8_WAIT_V(6); PG8_BAR;
    } else {
        PG8_STAGE(PG8_SB(0, 0), cB, voffB); PG8_STAGE_A(PG8_SA(0, 0), cA, 0, false); PG8_STAGE(PG8_SB(0, 1), cB + hstepB, voffB); PG8_STAGE_A(PG8_SA(0, 1), cA, 1, false);
        if (wr == 1) PG8_BAR;
        PG8_WAIT_V(4); PG8_BAR;
        PG8_STAGE(PG8_SB(1, 0), cB + kstep, voffB); PG8_STAGE_A(PG8_SA(1, 0), cA + kstep, 0, false); PG8_STAGE(PG8_SB(1, 1), cB + hstepB + kstep, voffB);
        PG8_WAIT_V(6); PG8_BAR;
    }
    for (;;) {
        const bool has_next = S.next(ui + 1, nxt);
        const unsigned nA = has_next ? S.A(nxt) : cA, nB = has_next ? S.B(nxt) : cB;
        if constexpr (GATHER) { if (has_next) PG8_GV(gvN, nxt); }
        for (int t = 0; t < nt; t += 2) {
            const bool last = (t == nt - 2);
            const unsigned a1 = cA + (unsigned)(t + 1) * kstep;
            const unsigned a2 = last ? nA : cA + (unsigned)(t + 2) * kstep, b2 = last ? nB : cB + (unsigned)(t + 2) * kstep;
            const unsigned a3 = a2 + kstep, b3 = b2 + kstep;
            if constexpr (SP2) {
            PG8_LDB(B0, 0, 0); PG8_LDB(B1, 0, 1); PG8_SCHED; PG8_LDA(At, 0, 0); PG8_STAGE_A(PG8_SA(1, 1), a1, 1, false);
            PG8_WAIT_V(8); PG8_WAIT_L(0); PG8_BAR; PG8_MMA(0, 0, At, B0); PG8_MMA(0, 1, At, B1); PG8_BAR; PG8_SCHED;
            PG8_LDA(At, 0, 1); PG8_STAGE(PG8_SB(0, 0), b2, voffB); PG8_STAGE(PG8_SB(0, 1), b2 + hstepB, voffB); PG8_STAGE_A(PG8_SA(0, 0), a2, 0, last);
            PG8_WAIT_V(8); PG8_WAIT_L(0); PG8_BAR; PG8_MMA(1, 0, At, B0); PG8_MMA(1, 1, At, B1); PG8_BAR; PG8_SCHED;
            PG8_LDB(B0, 1, 0); PG8_LDB(B1, 1, 1); PG8_SCHED; PG8_LDA(At, 1, 0); PG8_STAGE_A(PG8_SA(0, 1), a2, 1, last);
            PG8_WAIT_V(8); PG8_WAIT_L(0); PG8_BAR; PG8_MMA(0, 0, At, B0); PG8_MMA(0, 1, At, B1); PG8_BAR; PG8_SCHED;
            PG8_LDA(At, 1, 1); PG8_STAGE(PG8_SB(1, 0), b3, voffB); PG8_STAGE(PG8_SB(1, 1), b3 + hstepB, voffB); PG8_STAGE_A(PG8_SA(1, 0), a3, 0, last);
            PG8_WAIT_V(8); PG8_WAIT_L(0); PG8_BAR; PG8_MMA(1, 0, At, B0); PG8_MMA(1, 1, At, B1); PG8_BAR; PG8_SCHED;
            } else {
            PG8_LDB(B0, 0, 0); PG8_SCHED; PG8_LDA(At, 0, 0); PG8_STAGE_A(PG8_SA(1, 1), a1, 1, false);
            PG8_WAIT_L(8); PG8_BAR; PG8_WAIT_L(0); PG8_MMA(0, 0, At, B0); PG8_BAR; PG8_SCHED;
            PG8_LDB(B1, 0, 1); PG8_STAGE(PG8_SB(0, 0), b2, voffB);
            PG8_BAR; PG8_WAIT_L(0); PG8_MMA(0, 1, At, B1); PG8_BAR;
            PG8_LDA(At, 0, 1); PG8_STAGE_A(PG8_SA(0, 0), a2, 0, last);
            PG8_BAR; PG8_WAIT_L(0); PG8_MMA(1, 0, At, B0); PG8_BAR; PG8_SCHED;
            PG8_STAGE(PG8_SB(0, 1), b2 + hstepB, voffB);
            PG8_WAIT_V(6); PG8_BAR; PG8_MMA(1, 1, At, B1); PG8_BAR;
            PG8_LDB(B0, 1, 0); PG8_SCHED; PG8_LDA(At, 1, 0); PG8_STAGE_A(PG8_SA(0, 1), a2, 1, last);
            PG8_WAIT_L(8); PG8_BAR; PG8_WAIT_L(0); PG8_MMA(0, 0, At, B0); PG8_BAR; PG8_SCHED;
            PG8_LDB(B1, 1, 1); PG8_STAGE(PG8_SB(1, 0), b3, voffB);
            PG8_BAR; PG8_WAIT_L(0); PG8_MMA(0, 1, At, B1); PG8_BAR;
            PG8_LDA(At, 1, 1); PG8_STAGE_A(PG8_SA(1, 0), a3, 0, last);
            PG8_BAR; PG8_WAIT_L(0); PG8_MMA(1, 0, At, B0); PG8_BAR; PG8_SCHED;
            PG8_STAGE(PG8_SB(1, 1), b3 + hstepB, voffB);
            PG8_WAIT_V(6); PG8_BAR; PG8_MMA(1, 1, At, B1); PG8_BAR;
            }
        }
        if constexpr (ALIGN_EPI) { if (wr == 0) PG8_BAR; }
        if constexpr (FP8) asm volatile("s_nop 15\n\ts_nop 15\n\ts_nop 7" ::: "memory");
        E(acc, cur, wr, wc, fr, fq);
        if (!has_next) break;
#pragma unroll
        for (int a = 0; a < 2; ++a)
#pragma unroll
            for (int b = 0; b < 2; ++b)
#pragma unroll
                for (int m = 0; m < 4; ++m)
#pragma unroll
                    for (int n = 0; n < 2; ++n) acc[a][b][m][n] = (f32x4){0.f, 0.f, 0.f, 0.f};
        cur = nxt; cA = nA; cB = nB; ++ui;
        if constexpr (GATHER) { _Pragma("unroll") for (int hh_ = 0; hh_ < 2; ++hh_) _Pragma("unroll") for (int i_ = 0; i_ < 2; ++i_) gvC[hh_][i_] = gvN[hh_][i_]; }
        if constexpr (ALIGN_EPI) { if (wr == 1) PG8_BAR; }
    }
    PG8_WAIT_V(0);
    if constexpr (!ALIGN_EPI) { if (wr == 0) PG8_BAR; }
    PG8_BAR;
#undef PG8_SA
#undef PG8_SB
#undef PG8_STAGE
#undef PG8_STAGE_A
#undef PG8_GV
#undef PG8_LDA
#undef PG8_LDB
#undef PG8_MMA
#undef PG8_WAIT_V
#undef PG8_WAIT_L
#undef PG8_BAR
#undef PG8_SCHED
}

struct SchedPlain : Order {
    static constexpr bool GATHER = false; __device__ __forceinline__ unsigned arow(const Unit&, int) const { return 0u; }
    unsigned A0, B0, at, bt;
    __device__ __forceinline__ bool next(int i, Unit& u) const { return next_mn(i, u); }
    __device__ __forceinline__ unsigned A(const Unit& u) const { return A0 + (unsigned)u.pm * at; }
    __device__ __forceinline__ unsigned B(const Unit& u) const { return B0 + (unsigned)u.pn * bt; }
};
struct SchedLora : Order {
    static constexpr bool GATHER = false; __device__ __forceinline__ unsigned arow(const Unit&, int) const { return 0u; }
    unsigned A0, B0; int skipv;
    __device__ __forceinline__ bool next(int i, Unit& u) const { if (!next_mn(i, u)) return false; if (skipv && u.pn >= 12) u.pn += 6; return true; }
    __device__ __forceinline__ unsigned A(const Unit& u) const { return A0 + (unsigned)u.pm * (256u * 512u * 2u) + (u.pn >= 18 ? 512u : 0u); }
    __device__ __forceinline__ unsigned B(const Unit& u) const { return B0 + (unsigned)u.pn * (256u * 256u * 2u); }
};
struct SchedMem {
    static constexpr bool GATHER = false; __device__ __forceinline__ unsigned arow(const Unit&, int) const { return 0u; }
    int G, c; unsigned memb, wkv;
    __device__ __forceinline__ bool next(int i, Unit& u) const {
        const int L = i * G + c; if (L >= 64) return false;
        if (L < 32) { u.z = 0; u.pm = L >> 1; u.pn = L & 1; } else { const int q = L - 32; u.z = 1; u.pm = q & 1; u.pn = q >> 1; }
        return true;
    }
    __device__ __forceinline__ unsigned A(const Unit& u) const { return u.z == 0 ? memb + (unsigned)u.pm * (256u * 2048u * 2u) : wkv + (unsigned)(2 + u.pm) * (256u * 2048u * 2u); }
    __device__ __forceinline__ unsigned B(const Unit& u) const { return u.z == 0 ? wkv + (unsigned)u.pn * (256u * 2048u * 2u) : memb + (unsigned)u.pn * (256u * 2048u * 2u); }
};
struct SchedMoE : Order {
    static constexpr bool GATHER = false; __device__ __forceinline__ unsigned arow(const Unit&, int) const { return 0u; }
    unsigned A0, B0, at, bt, be; const int* texp;
    __device__ __forceinline__ bool next(int i, Unit& u) const { if (!next_mn(i, u)) return false; u.z = __builtin_amdgcn_readfirstlane(texp[u.pm]); return true; }
    __device__ __forceinline__ unsigned A(const Unit& u) const { return A0 + (unsigned)u.pm * at; }
    __device__ __forceinline__ unsigned B(const Unit& u) const { return B0 + (unsigned)u.z * be + (unsigned)u.pn * bt; }
};

struct SchedMoEg : Order {
    static constexpr bool GATHER = true;
    unsigned B0, bt, be, xoff, zoff; const int* texp; const int* slot_tok;
    __device__ __forceinline__ bool next(int i, Unit& u) const { if (!next_mn(i, u)) return false; u.z = __builtin_amdgcn_readfirstlane(texp[u.pm]); return true; }
    __device__ __forceinline__ unsigned A(const Unit&) const { return 0u; }
    __device__ __forceinline__ unsigned B(const Unit& u) const { return B0 + (unsigned)u.z * be + (unsigned)u.pn * bt; }
    __device__ __forceinline__ unsigned arow(const Unit& u, int r) const { const int tok = slot_tok[u.pm * 256 + r]; return tok < 0 ? zoff : xoff + (unsigned)tok * 2048u; }
};

struct EpiBf16 {
    static constexpr bool PERM = true;
    bf16* O; int ldc;
    __device__ __forceinline__ void operator()(const f32x4 (&acc)[2][2][4][2], const Unit& u, int wr, int wc, int fr, int fq) const {
        const int row0 = u.pm * BM + wr * 64 + fr, col0 = u.pn * BM + wc * 32 + 8 * fq;
#pragma unroll
        for (int ai = 0; ai < 2; ++ai)
#pragma unroll
            for (int m = 0; m < 4; ++m) { bf16* rowp = O + (size_t)(row0 + ai * HALF + m * 16) * ldc + col0;
#pragma unroll
                for (int bj = 0; bj < 2; ++bj) { const f32x4 v0 = acc[ai][bj][m][0], v1 = acc[ai][bj][m][1];
                    u32x4 w; w.x = cvt_pk_bf16(v0[0], v0[1]); w.y = cvt_pk_bf16(v0[2], v0[3]); w.z = cvt_pk_bf16(v1[0], v1[1]); w.w = cvt_pk_bf16(v1[2], v1[3]);
                    *(u32x4*)(rowp + bj * HALF) = w; } }
    }
};
struct EpiMem {
    static constexpr bool PERM = true;
    bf16* O0; bf16* O1;
    __device__ __forceinline__ void operator()(const f32x4 (&acc)[2][2][4][2], const Unit& u, int wr, int wc, int fr, int fq) const {
        EpiBf16 e; e.O = u.z == 0 ? O0 : O1; e.ldc = u.z == 0 ? 512 : 4096; e(acc, u, wr, wc, fr, fq);
    }
};
struct EpiLora {
    static constexpr bool PERM = true;
    bf16* O; const float* vecs;
    __device__ __forceinline__ void operator()(const f32x4 (&acc)[2][2][4][2], const Unit& u, int wr, int wc, int fr, int fq) const {
        const int type = u.pn / 6;
        const int row0 = u.pm * BM + wr * 64 + fr, col0 = u.pn * BM + wc * 32 + 8 * fq, cb0 = (u.pn % 6) * BM + wc * 32 + 8 * fq;
        const float* bp = vecs + (type < 3 ? type : 0) * SW;
        const float sc = type == 0 ? 0.6065306597126334f : 1.0f;
#pragma unroll
        for (int bj = 0; bj < 2; ++bj) {
            f32x4 bv0 = (f32x4){0.f, 0.f, 0.f, 0.f}, bv1 = bv0;
            if (type < 3) { bv0 = *(const f32x4*)(bp + cb0 + bj * HALF); bv1 = *(const f32x4*)(bp + cb0 + bj * HALF + 4); }
#pragma unroll
            for (int ai = 0; ai < 2; ++ai)
#pragma unroll
                for (int m = 0; m < 4; ++m) { bf16* rowp = O + (size_t)(row0 + ai * HALF + m * 16) * 6144 + col0 + bj * HALF;
                    f32x4 v0_ = acc[ai][bj][m][0] + bv0, v1_ = acc[ai][bj][m][1] + bv1;
                    if (type < 3) {
#pragma unroll
                        for (int j = 0; j < 4; ++j) { v0_[j] = sc * sigmoidf_(v0_[j]); v1_[j] = sc * sigmoidf_(v1_[j]); } }
                    u32x4 w; w.x = cvt_pk_bf16(v0_[0], v0_[1]); w.y = cvt_pk_bf16(v0_[2], v0_[3]); w.z = cvt_pk_bf16(v1_[0], v1_[1]); w.w = cvt_pk_bf16(v1_[2], v1_[3]);
                    *(u32x4*)rowp = w; asm volatile("" ::: "memory"); }
        }
    }
};
struct EpiSwiglu {
    static constexpr bool PERM = true;
    bf16* O; int ldc;
    __device__ __forceinline__ void operator()(const f32x4 (&acc)[2][2][4][2], const Unit& u, int wr, int wc, int fr, int fq) const {
        const int row0 = u.pm * BM + wr * 64 + fr, col0 = u.pn * HALF + wc * 32 + 8 * fq;
#pragma unroll
        for (int ai = 0; ai < 2; ++ai)
#pragma unroll
            for (int m = 0; m < 4; ++m) { bf16* rowp = O + (size_t)(row0 + ai * HALF + m * 16) * ldc + col0;
                float h[8];
#pragma unroll
                for (int n = 0; n < 2; ++n)
#pragma unroll
                    for (int j = 0; j < 4; ++j) { const float g = acc[ai][0][m][n][j], up = acc[ai][1][m][n][j]; h[n * 4 + j] = g * sigmoidf_(g) * up; }
                u32x4 w; w.x = cvt_pk_bf16(h[0], h[1]); w.y = cvt_pk_bf16(h[2], h[3]); w.z = cvt_pk_bf16(h[4], h[5]); w.w = cvt_pk_bf16(h[6], h[7]);
                *(u32x4*)rowp = w; asm volatile("" ::: "memory"); }
    }
};
struct EpiSwiglu8 {
    static constexpr bool PERM = true;
    unsigned char* O; int ldc; float inv, so;
    __device__ __forceinline__ void operator()(const f32x4 (&acc)[2][2][4][2], const Unit& u, int wr, int wc, int fr, int fq) const {
        const int row0 = u.pm * BM + wr * 64 + fr, col0 = u.pn * HALF + wc * 32 + 8 * fq;
        const float c1 = -inv * 1.4426950408889634f, c2 = inv * inv * so;
#pragma unroll
        for (int ai = 0; ai < 2; ++ai)
#pragma unroll
            for (int m = 0; m < 4; ++m) { unsigned char* rowp = O + (size_t)(row0 + ai * HALF + m * 16) * ldc + col0;
                float h[8];
#pragma unroll
                for (int n = 0; n < 2; ++n)
#pragma unroll
                    for (int j = 0; j < 4; ++j) { const float ag = acc[ai][0][m][n][j], au = acc[ai][1][m][n][j];
                        h[n * 4 + j] = (ag * au) * __builtin_amdgcn_rcpf(1.0f + __builtin_amdgcn_exp2f(ag * c1)) * c2; }
                u32x2 w; w.x = pk4_fp8(h[0], h[1], h[2], h[3]); w.y = pk4_fp8(h[4], h[5], h[6], h[7]);
                *(u32x2*)rowp = w; asm volatile("" ::: "memory"); }
    }
};
struct EpiBf16S {
    static constexpr bool PERM = true;
    bf16* O; int ldc; float sc;
    __device__ __forceinline__ void operator()(const f32x4 (&acc)[2][2][4][2], const Unit& u, int wr, int wc, int fr, int fq) const {
        const int row0 = u.pm * BM + wr * 64 + fr, col0 = u.pn * BM + wc * 32 + 8 * fq;
#pragma unroll
        for (int ai = 0; ai < 2; ++ai)
#pragma unroll
            for (int m = 0; m < 4; ++m) { bf16* rowp = O + (size_t)(row0 + ai * HALF + m * 16) * ldc + col0;
#pragma unroll
                for (int bj = 0; bj < 2; ++bj) { const f32x4 v0 = acc[ai][bj][m][0] * sc, v1 = acc[ai][bj][m][1] * sc;
                    u32x4 w; w.x = cvt_pk_bf16(v0[0], v0[1]); w.y = cvt_pk_bf16(v0[2], v0[3]); w.z = cvt_pk_bf16(v1[0], v1[1]); w.w = cvt_pk_bf16(v1[2], v1[3]);
                    *(u32x4*)(rowp + bj * HALF) = w; } }
    }
};
struct EpiFp8S {
    static constexpr bool PERM = true;
    unsigned char* O; int ldc; float sc;
    __device__ __forceinline__ void operator()(const f32x4 (&acc)[2][2][4][2], const Unit& u, int wr, int wc, int fr, int fq) const {
        const int row0 = u.pm * BM + wr * 64 + fr, col0 = u.pn * BM + wc * 32 + 8 * fq;
#pragma unroll
        for (int ai = 0; ai < 2; ++ai)
#pragma unroll
            for (int m = 0; m < 4; ++m) { unsigned char* rowp = O + (size_t)(row0 + ai * HALF + m * 16) * ldc + col0;
#pragma unroll
                for (int bj = 0; bj < 2; ++bj) { const f32x4 v0 = acc[ai][bj][m][0] * sc, v1 = acc[ai][bj][m][1] * sc;
                    u32x2 w; w.x = pk4_fp8(v0[0], v0[1], v0[2], v0[3]); w.y = pk4_fp8(v1[0], v1[1], v1[2], v1[3]);
                    *(u32x2*)(rowp + bj * HALF) = w; } }
    }
};
struct EpiRes {
    static constexpr bool PERM = false;
    const float* X; float* T;
    __device__ __forceinline__ void operator()(const f32x4 (&acc)[2][2][4][2], const Unit& u, int wr, int wc, int fr, int fq) const {
        const int row0 = u.pm * BM + wr * 64 + fr, col0 = u.pn * BM + wc * 32 + 4 * fq;
#pragma unroll
        for (int ai = 0; ai < 2; ++ai)
#pragma unroll
            for (int m = 0; m < 4; ++m) { const size_t off = (size_t)(row0 + ai * HALF + m * 16) * D + col0;
#pragma unroll
                for (int bj = 0; bj < 2; ++bj)
#pragma unroll
                    for (int n = 0; n < 2; ++n) { const f32x4 xv = *(const f32x4*)(X + off + bj * HALF + n * 16);
                        *(f32x4*)(T + off + bj * HALF + n * 16) = xv * ALPHA + acc[ai][bj][m][n]; } }
    }
};
}

struct Args {
    const float* in[43];
    float* out; unsigned char* ws;
    int ph_lo, ph_hi;
};
struct Ctx { LAS unsigned char* lds; int tid, lane, wave, bid, G, gw, NGW; unsigned char* ws; };

enum { I_X = 0, I_MEM = 1, I_POS = 2, I_WKV = 3,
       L0_WIN = 4, L0_MU, L0_LW, L0_LA, L0_LG, L0_VECS, L0_WOUT, L0_NORMS, L0_FG, L0_FU, L0_FD,
       L1_WIN = 15, L1_GN, L1_WOUT, L1_NORMS, L1_ROUTER, L1_MG, L1_MU_, L1_MD,
       L2_WIN = 23, L2_MU, L2_LW, L2_LA, L2_LV, L2_LG, L2_VECS, L2_WOUT, L2_NORMS, L2_FG, L2_FU, L2_FD,
       L3_WIN = 35, L3_GN, L3_WOUT, L3_NORMS, L3_ROUTER, L3_MG, L3_MU_, L3_MD };

__device__ __forceinline__ void tr_load(f32x4 (&v)[8], const float* W, int ldw, int k0, int n0, int lane) {
#pragma unroll
    for (int i = 0; i < 8; ++i) v[i] = *(const f32x4*)(W + (size_t)(k0 + 8 * i + (lane >> 3)) * ldw + n0 + 4 * (lane & 7));
}
__device__ __forceinline__ void tr_store(const f32x4 (&v)[8], int k0, bf16* WT, int ldt, int drow0, LAS float* scr, int lane) {
#pragma unroll
    for (int i = 0; i < 8; ++i) { LAS float* d = scr + (8 * i + (lane >> 3)) * 33 + 4 * (lane & 7); d[0] = v[i][0]; d[1] = v[i][1]; d[2] = v[i][2]; d[3] = v[i][3]; }
    LDS_WAIT(); asm volatile("" ::: "memory");
    const int c = lane & 7;
#pragma unroll
    for (int j = 0; j < 4; ++j) { const int n = (lane >> 3) + 8 * j; const LAS float* s = scr + (8 * c) * 33 + n;
        u32x4 o; o.x = cvt_pk_bf16(s[0 * 33], s[1 * 33]); o.y = cvt_pk_bf16(s[2 * 33], s[3 * 33]); o.z = cvt_pk_bf16(s[4 * 33], s[5 * 33]); o.w = cvt_pk_bf16(s[6 * 33], s[7 * 33]);
        *(u32x4*)(WT + (size_t)(drow0 + n) * ldt + k0 + 8 * c) = o; }
    LDS_WAIT(); asm volatile("" ::: "memory");
}
__device__ __forceinline__ void conv_mat(const Ctx& C, const float* W, int K, int N, bf16* WT, int mode, int off, int gw0) {
    LAS float* scr = (LAS float*)(C.lds + C.wave * 16384);
    const int nblk = N / 32, items = (K / 64) * nblk;
    int start = C.gw - gw0; if (start < 0) start += C.NGW;
#define CONV_DROW(n0_) (mode == 0 ? off + (n0_) : ((n0_) / 128) * 256 + off + ((n0_) % 128))
    f32x4 va[8], vb[8];
    int it = start;
    if (it < items) tr_load(va, W, N, 64 * (it / nblk), 32 * (it % nblk), C.lane);
    while (it < items) {
        const int it1 = it + C.NGW;
        if (it1 < items) tr_load(vb, W, N, 64 * (it1 / nblk), 32 * (it1 % nblk), C.lane);
        tr_store(va, 64 * (it / nblk), WT, K, CONV_DROW(32 * (it % nblk)), scr, C.lane);
        if (it1 >= items) break;
        const int it2 = it1 + C.NGW;
        if (it2 < items) tr_load(va, W, N, 64 * (it2 / nblk), 32 * (it2 % nblk), C.lane);
        tr_store(vb, 64 * (it1 / nblk), WT, K, CONV_DROW(32 * (it1 % nblk)), scr, C.lane);
        it = it2;
    }
#undef CONV_DROW
}
__device__ __forceinline__ void conv_lora(const Ctx& C, const float* lw, const float* la, const float* lv, const float* lg, bf16* Bt) {
    for (int idx = C.bid * NTHR + C.tid; idx < 6144 * 256; idx += C.G * NTHR) {
        const int n_ = idx % 1536, rest = idx / 1536, k = rest % 256, blk = rest / 256;
        float v = 0.f;
        if (blk == 0) { if (k < 96) v = lw[k * 1536 + n_]; }
        else if (blk == 1) { if (k >= 96 && k < 192) v = la[(k - 96) * 1536 + n_]; }
        else if (blk == 2) { if (lv && k >= 192) v = lv[(k - 192) * 1536 + n_]; }
        else v = lg[k * 1536 + n_];
        Bt[(size_t)(blk * 1536 + n_) * 256 + k] = f2bf(v);
    }
}
__device__ __forceinline__ void conv_f32_bf16(const Ctx& C, const float* src, bf16* dst, size_t n8) {
    const size_t T = (size_t)C.G * NTHR;
    for (size_t i0 = (size_t)C.bid * NTHR + C.tid; i0 < n8; i0 += 4 * T) { f32x4 av[4], bv[4];
#pragma unroll
        for (int q = 0; q < 4; ++q) { av[q] = ((const f32x4*)src)[2 * (i0 + q * T)]; bv[q] = ((const f32x4*)src)[2 * (i0 + q * T) + 1]; }
#pragma unroll
        for (int q = 0; q < 4; ++q) { const f32x4 a = av[q], b = bv[q];
            u32x4 w; w.x = cvt_pk_bf16(a[0], a[1]); w.y = cvt_pk_bf16(a[2], a[3]); w.z = cvt_pk_bf16(b[0], b[1]); w.w = cvt_pk_bf16(b[2], b[3]);
            ((u32x4*)dst)[i0 + q * T] = w; } }
}

struct CvJob { const float* W; bf16* WT; int N, K, k0, n0, mode, off; float f8s; };
__device__ __forceinline__ void cv_load(f32x4 (&v)[8], const CvJob& J, int wave, int lane) {
    const int n = J.n0 + 4 * lane;
#pragma unroll
    for (int i = 0; i < 8; ++i) { v[i] = (f32x4){0.f, 0.f, 0.f, 0.f}; if (n < J.N) v[i] = *(const f32x4*)(J.W + (size_t)(J.k0 + 8 * wave + i) * J.N + n); }
}
__device__ __forceinline__ void cv_put(const f32x4 (&v)[8], LAS float* T, int wave, int lane) {
#pragma unroll
    for (int i = 0; i < 8; ++i) *(LAS f32x4*)(T + (8 * wave + i) * 256 + 4 * (lane ^ wave)) = v[i];
}
__device__ __forceinline__ void cv_out(const CvJob& J, const LAS float* T, int wave, int lane) {
    const int c = lane & 7;
#pragma unroll
    for (int j = 0; j < 4; ++j) { const int nl = 32 * wave + 8 * j + (lane >> 3), n = J.n0 + nl; const LAS float* s = T + (8 * c) * 256 + (nl ^ (c << 2));
        u32x4 o; o.x = cvt_pk_bf16(s[0 * 256], s[1 * 256]); o.y = cvt_pk_bf16(s[2 * 256], s[3 * 256]); o.z = cvt_pk_bf16(s[4 * 256], s[5 * 256]); o.w = cvt_pk_bf16(s[6 * 256], s[7 * 256]);
        if (n < J.N) { const int drow = J.mode == 0 ? J.off + n : (n / 128) * 256 + J.off + (n % 128);
            *(u32x4*)(J.WT + (size_t)drow * J.K + J.k0 + 8 * c) = o; } }
}
__device__ __forceinline__ void cv_out8(const CvJob& J, const LAS float* T, int wave, int lane) {
    const int c4 = lane & 3; unsigned char* W8 = (unsigned char*)J.WT;
#pragma unroll
    for (int j = 0; j < 2; ++j) { const int nl = 32 * wave + 16 * j + (lane >> 2), n = J.n0 + nl;
        float v[16];
#pragma unroll
        for (int q = 0; q < 16; ++q) { const int k = 16 * c4 + q; v[q] = T[k * 256 + (nl ^ (((k >> 3) & 7) << 2))] * J.f8s; }
        u32x4 o; o.x = pk4_fp8(v[0], v[1], v[2], v[3]); o.y = pk4_fp8(v[4], v[5], v[6], v[7]); o.z = pk4_fp8(v[8], v[9], v[10], v[11]); o.w = pk4_fp8(v[12], v[13], v[14], v[15]);
        if (n < J.N) { const int drow = J.mode == 0 ? J.off + n : (n / 128) * 256 + J.off + (n % 128);
            *(u32x4*)(W8 + (size_t)drow * J.K + J.k0 + 16 * c4) = o; } }
}
template <class Dec>
__device__ __forceinline__ void conv_run(const Ctx& C, int ntiles, const Dec& dec, const int t0 = -1, const int STR = GRID) {
    LAS float* T = (LAS float*)C.lds;
    f32x4 va[8], vb[8]; CvJob ja, jb, jc;
    int t = t0 < 0 ? C.bid : t0;
    if (t < ntiles) { dec(t, ja); cv_load(va, ja, C.wave, C.lane); }
    if (t + STR < ntiles) { dec(t + STR, jb); cv_load(vb, jb, C.wave, C.lane); }
    while (t < ntiles) {
        __syncthreads(); cv_put(va, T, C.wave, C.lane); jc = ja;
        if (t + 2 * STR < ntiles) { dec(t + 2 * STR, ja); cv_load(va, ja, C.wave, C.lane); }
        __syncthreads(); if (jc.f8s > 0.f) cv_out8(jc, T, C.wave, C.lane); else cv_out(jc, T, C.wave, C.lane);
        t += STR; if (t >= ntiles) break;
        __syncthreads(); cv_put(vb, T, C.wave, C.lane); jc = jb;
        if (t + 2 * STR < ntiles) { dec(t + 2 * STR, jb); cv_load(vb, jb, C.wave, C.lane); }
        __syncthreads(); if (jc.f8s > 0.f) cv_out8(jc, T, C.wave, C.lane); else cv_out(jc, T, C.wave, C.lane);
        t += STR;
    }
    __syncthreads();
}
struct MoeDec { const float* mg; const float* mu; const float* md; unsigned char* ws;
    __device__ __forceinline__ void operator()(int t, CvJob& J) const {
        const int j = t / 704, r = t % 704, e = j / 3, kind = j % 3;
        if (kind < 2) { J.W = (kind == 0 ? mg : mu) + (size_t)e * 2048 * 5632; J.WT = (bf16*)(ws + WS_MWGU + (size_t)e * 22 * MiB); J.N = 5632; J.K = 2048; J.mode = 1; J.off = kind * 128; J.f8s = 1024.f; J.k0 = 64 * (r / 22); J.n0 = 256 * (r % 22); }
        else { J.W = md + (size_t)e * 2048 * 5632; J.WT = (bf16*)(ws + WS_MWD + (size_t)e * 11 * MiB); J.N = 2048; J.K = 5632; J.mode = 0; J.off = 0; J.f8s = 2048.f; J.k0 = 64 * (r / 8); J.n0 = 256 * (r % 8); }
    } };
struct StaticDec { const float* const* in; unsigned char* ws;
    __device__ __forceinline__ void set(CvJob& J, const float* W, bf16* WT, int K, int N, int mode, int off, int r, float f8s = 0.f) const {
        const int nn = (N + 255) / 256; J.W = W; J.WT = WT; J.N = N; J.K = K; J.mode = mode; J.off = off; J.f8s = f8s; J.k0 = 64 * (r / nn); J.n0 = 256 * (r % nn); }
    __device__ __forceinline__ void operator()(int t, CvJob& J) const {
        int r = t;
        if (r < 128) { set(J, in[I_WKV], (bf16*)(ws + WS_WKV), 2048, 1024, 0, 0, r); return; } r -= 128;
        set(J, in[L0_WIN], (bf16*)(ws + WS_WIN), 2048, 5568, 0, 0, r);
    } };

struct SlotDec { const float* const* in; unsigned char* ws; int lq; MoeDec moe; StaticDec sd;
    __device__ __forceinline__ void operator()(int t, CvJob& J) const {
        if (t < 16896) { moe(t, J); return; }
        int r = t - 16896; const size_t l = (size_t)lq;
        if (r < 704) { sd.set(J, lq ? in[L2_FG] : in[L0_FG], (bf16*)(ws + WS_WFGU + l * 44 * MiB), 2048, 5632, 1, 0, r, 1024.f); return; } r -= 704;
        if (r < 704) { sd.set(J, lq ? in[L2_FU] : in[L0_FU], (bf16*)(ws + WS_WFGU + l * 44 * MiB), 2048, 5632, 1, 128, r, 1024.f); return; } r -= 704;
        if (r < 704) { sd.set(J, lq ? in[L2_FD] : in[L0_FD], (bf16*)(ws + WS_WFD + l * 22 * MiB), 5632, 2048, 0, 0, r, 2048.f); return; } r -= 704;
        if (r < 256) { sd.set(J, lq ? in[L2_WOUT] : in[L0_WOUT], (bf16*)(ws + WS_WOUT + l * 16 * MiB), 2048, 2048, 0, 0, r); return; } r -= 256;
        if (r < 256) { sd.set(J, lq ? in[L3_WOUT] : in[L1_WOUT], (bf16*)(ws + WS_WOUT + (l * 16 + 8) * MiB), 2048, 2048, 0, 0, r); return; } r -= 256;
        if (r < 640) { sd.set(J, lq ? in[L3_WIN] : in[L1_WIN], (bf16*)(ws + WS_WIN + (l * 44 + 22) * MiB), 2048, 5120, 0, 0, r); return; } r -= 640;
        sd.set(J, in[L2_WIN], (bf16*)(ws + WS_WIN + (size_t)44 * MiB), 2048, 5632, 0, 0, r);
    } };

__device__ __forceinline__ void ph_prologue(const Ctx& C, const Args& A) {
    unsigned char* ws = C.ws;
    { StaticDec dec; dec.in = A.in; dec.ws = ws; conv_run(C, 832, dec); }
    conv_lora(C, A.in[L0_LW], A.in[L0_LA], nullptr, A.in[L0_LG], (bf16*)(ws + WS_WLORA));
    conv_lora(C, A.in[L2_LW], A.in[L2_LA], A.in[L2_LV], A.in[L2_LG], (bf16*)(ws + WS_WLORA + 3 * MiB));
    { u32x4* z = (u32x4*)(ws + WS_WIN + (size_t)5568 * 2048 * 2);
      for (int i = C.bid * NTHR + C.tid; i < 64 * 2048 * 2 / 16; i += C.G * NTHR) z[i] = (u32x4){0u, 0u, 0u, 0u}; }
    { const f32x4* xs = (const f32x4*)A.in[I_X]; u32x2* hi = (u32x2*)(ws + WS_XB); unsigned* lo = (unsigned*)(ws + WS_XLO);
      const size_t T = (size_t)C.G * NTHR;
      for (size_t i0 = (size_t)C.bid * NTHR + C.tid; i0 < (size_t)M * D / 4; i0 += 8 * T) { f32x4 ov[8];
#pragma unroll
          for (int q = 0; q < 8; ++q) ov[q] = xs[i0 + q * T];
#pragma unroll
          for (int q = 0; q < 8; ++q) { const f32x4 o = ov[q]; const size_t i = i0 + q * T;
              u32x2 w; w.x = cvt_pk_bf16(o[0], o[1]); w.y = cvt_pk_bf16(o[2], o[3]); hi[i] = w;
              lo[i] = pk4_fp8((o[0] - bflo(w.x)) * 8192.f, (o[1] - bfhi(w.x)) * 8192.f, (o[2] - bflo(w.y)) * 8192.f, (o[3] - bfhi(w.y)) * 8192.f); } } }
    conv_f32_bf16(C, A.in[I_MEM], (bf16*)(ws + WS_MEMB), (size_t)4096 * 2048 / 8);
    { const int* pos = (const int*)A.in[I_POS]; f32x2* cs = (f32x2*)(ws + WS_CS);
      for (int idx = C.bid * NTHR + C.tid; idx < M * 64; idx += C.G * NTHR) {
          const int m = idx >> 6, i = idx & 63;
          const float pw = (float)exp2(13.287712379549449 * (double)i / 64.0);
          const float inv = 1.0f / pw;
          const float ang = (float)pos[m] * inv;
          const double x = (double)ang;
          const double n = rint(x * 0.15915494309189535);
          const double r = fma(-n, 6.283185307179586, x) - n * 2.4492935982947064e-16;
          const double r2 = r * r;
          double s = -1.0 / 121645100408832000.0;
          s = fma(s, r2, 1.0 / 355687428096000.0);
          s = fma(s, r2, -1.0 / 1307674368000.0);
          s = fma(s, r2, 1.0 / 6227020800.0);
          s = fma(s, r2, -1.0 / 39916800.0);
          s = fma(s, r2, 1.0 / 362880.0);
          s = fma(s, r2, -1.0 / 5040.0);
          s = fma(s, r2, 1.0 / 120.0);
          s = fma(s, r2, -1.0 / 6.0);
          s = fma(s * r2, r, r);
          double c = 1.0 / 2432902008176640000.0;
          c = fma(c, r2, -1.0 / 6402373705728000.0);
          c = fma(c, r2, 1.0 / 20922789888000.0);
          c = fma(c, r2, -1.0 / 87178291200.0);
          c = fma(c, r2, 1.0 / 479001600.0);
          c = fma(c, r2, -1.0 / 3628800.0);
          c = fma(c, r2, 1.0 / 40320.0);
          c = fma(c, r2, -1.0 / 720.0);
          c = fma(c, r2, 1.0 / 24.0);
          c = fma(c, r2, -0.5);
          c = fma(c, r2, 1.0);
          cs[idx] = (f32x2){(float)c, (float)s};
      } }
}

struct LnRow { u32x2 rh[8]; unsigned rl[8]; u32x2 a[8]; float w1, w2; };
__device__ __forceinline__ void ln_load(LnRow& R, const Ctx& C, int m, const void* Hp, int hmode, int s1, int s2, float w1, float w2) {
    const u32x2* hr = (const u32x2*)(C.ws + WS_XB + (size_t)m * D * 2) + C.lane;
    const unsigned* lr = (const unsigned*)(C.ws + WS_XLO + (size_t)m * D) + C.lane;
#pragma unroll
    for (int j = 0; j < 8; ++j) { R.rh[j] = hr[64 * j]; R.rl[j] = lr[64 * j]; }
    if (hmode == 0) {
        const u32x2* ar = (const u32x2*)((const bf16*)Hp + (size_t)m * D) + C.lane;
#pragma unroll
        for (int j = 0; j < 8; ++j) R.a[j] = ar[64 * j];
        R.w1 = 1.f; R.w2 = 0.f;
    } else if (hmode == 1) {
        const unsigned* ar = (const unsigned*)((const unsigned char*)Hp + (size_t)m * D) + C.lane;
#pragma unroll
        for (int j = 0; j < 8; ++j) { R.a[j].x = ar[64 * j]; R.a[j].y = 0u; }
        R.w1 = 1.f / 256.f; R.w2 = 0.f;
    } else {
        R.w1 = w1; R.w2 = w2;
        const unsigned* y1 = (const unsigned*)((const unsigned char*)Hp + (size_t)s1 * D) + C.lane;
        const unsigned* y2 = (const unsigned*)((const unsigned char*)Hp + (size_t)s2 * D) + C.lane;
#pragma unroll
        for (int j = 0; j < 8; ++j) { R.a[j].x = y1[64 * j]; R.a[j].y = y2[64 * j]; }
    }
}
__device__ __forceinline__ void ln_row(const LnRow& R, const Ctx& C, int m, const float* gain, const float* bias, int hmode, float* Xf32out, unsigned char* X8out,
                                       LAS float* rw, LAS int* hist, bool do_route) {
    const int l4 = 4 * C.lane;
    f32x4 v[8]; float s = 0.f;
#pragma unroll
    for (int j = 0; j < 8; ++j) { f32x4 f, x;
        const f32x2 l01 = __builtin_amdgcn_cvt_pk_f32_fp8(R.rl[j], false), l23 = __builtin_amdgcn_cvt_pk_f32_fp8(R.rl[j], true);
        x[0] = bflo(R.rh[j].x) + l01[0] * (1.f / 8192.f); x[1] = bfhi(R.rh[j].x) + l01[1] * (1.f / 8192.f); x[2] = bflo(R.rh[j].y) + l23[0] * (1.f / 8192.f); x[3] = bfhi(R.rh[j].y) + l23[1] * (1.f / 8192.f);
        if (hmode == 0) { f[0] = bflo(R.a[j].x); f[1] = bfhi(R.a[j].x); f[2] = bflo(R.a[j].y); f[3] = bfhi(R.a[j].y); }
        else { const f32x2 a01 = __builtin_amdgcn_cvt_pk_f32_fp8(R.a[j].x, false), a23 = __builtin_amdgcn_cvt_pk_f32_fp8(R.a[j].x, true);
            f[0] = R.w1 * a01[0]; f[1] = R.w1 * a01[1]; f[2] = R.w1 * a23[0]; f[3] = R.w1 * a23[1];
            if (hmode == 2) { const f32x2 b01 = __builtin_amdgcn_cvt_pk_f32_fp8(R.a[j].y, false), b23 = __builtin_amdgcn_cvt_pk_f32_fp8(R.a[j].y, true);
                f[0] += R.w2 * b01[0]; f[1] += R.w2 * b01[1]; f[2] += R.w2 * b23[0]; f[3] += R.w2 * b23[1]; } }
        v[j] = x * ALPHA + f; s += (v[j][0] + v[j][1]) + (v[j][2] + v[j][3]); }
    const float mean = wave_sum(s) * (1.f / D); float s2 = 0.f;
#pragma unroll
    for (int j = 0; j < 8; ++j) { v[j] = v[j] - mean; s2 += (v[j][0] * v[j][0] + v[j][1] * v[j][1]) + (v[j][2] * v[j][2] + v[j][3] * v[j][3]); }
    const float rstd = 1.0f / sqrtf(wave_sum(s2) * (1.f / D) + LN_EPS);
    float lg[8];
#pragma unroll
    for (int e = 0; e < 8; ++e) lg[e] = 0.f;
    u32x2* ho = (u32x2*)(C.ws + WS_XB + (size_t)m * D * 2) + C.lane;
    unsigned* lo = (unsigned*)(C.ws + WS_XLO + (size_t)m * D) + C.lane;
#pragma unroll
    for (int j = 0; j < 8; ++j) {
        const f32x4 gv = *((const f32x4*)(gain + 256 * j + l4)), bv = *((const f32x4*)(bias + 256 * j + l4));
        const f32x4 o = v[j] * rstd * gv + bv;
        if (Xf32out) ((f32x4*)(Xf32out + (size_t)m * D))[64 * j + C.lane] = o;
        else { u32x2 w; w.x = cvt_pk_bf16(o[0], o[1]); w.y = cvt_pk_bf16(o[2], o[3]); ho[64 * j] = w;
            lo[64 * j] = pk4_fp8((o[0] - bflo(w.x)) * 8192.f, (o[1] - bfhi(w.x)) * 8192.f, (o[2] - bflo(w.y)) * 8192.f, (o[3] - bfhi(w.y)) * 8192.f); }
        if (X8out) ((unsigned*)(X8out + (size_t)m * D))[64 * j + C.lane] = pk4_fp8(o[0] * 16.f, o[1] * 16.f, o[2] * 16.f, o[3] * 16.f);
        if (do_route) {
#pragma unroll
            for (int e = 0; e < 8; ++e) { const f32x4 we = *(const LAS f32x4*)(rw + e * 2048 + 256 * j + l4);
                lg[e] += (o[0] * we[0] + o[1] * we[1]) + (o[2] * we[2] + o[3] * we[3]); }
        }
    }
    if (do_route) {
#pragma unroll
        for (int e = 0; e < 8; ++e) lg[e] = wave_sum(lg[e]);
        int e1 = 0; float v1 = lg[0];
#pragma unroll
        for (int e = 1; e < 8; ++e) if (lg[e] > v1) { v1 = lg[e]; e1 = e; }
        int e2 = -1; float v2 = -3.0e38f;
#pragma unroll
        for (int e = 0; e < 8; ++e) if (e != e1 && lg[e] > v2) { v2 = lg[e]; e2 = e; }
        const float ex = __expf(v2 - v1); const float w1 = 1.0f / (1.0f + ex), w2 = ex / (1.0f + ex);
        if (C.lane == 0) { f32x4 rt; rt[0] = __int_as_float(e1 | (e2 << 8)); rt[1] = w1; rt[2] = w2; rt[3] = 0.f; ((f32x4*)(C.ws + WS_ROUTE))[m] = rt;
            atomicAdd((int*)&hist[e1], 1); atomicAdd((int*)&hist[e2], 1); }
    }
}
__device__ __forceinline__ void ph_ln(const Ctx& C, const void* Hp, int hmode, const float* gain, const float* bias, float* Xf32out, unsigned char* X8out,
                                      const float* router, bool do_route) {
    unsigned char* ws = C.ws;
    LAS float* rw = (LAS float*)C.lds;
    LAS int* hist = (LAS int*)(C.lds + LDS_MISC + 64);
    if (do_route) {
        for (int col = C.tid; col < 2048; col += NTHR) { const f32x4 a = ((const f32x4*)router)[2 * col], b = ((const f32x4*)router)[2 * col + 1];
            rw[0 * 2048 + col] = a[0]; rw[1 * 2048 + col] = a[1]; rw[2 * 2048 + col] = a[2]; rw[3 * 2048 + col] = a[3]; rw[4 * 2048 + col] = b[0]; rw[5 * 2048 + col] = b[1]; rw[6 * 2048 + col] = b[2]; rw[7 * 2048 + col] = b[3]; }
        if (C.tid < 8) hist[C.tid] = 0;
        int* st = (int*)(ws + WS_SLOTTOK);
        for (int i = C.bid * NTHR + C.tid; i < NSLOT; i += C.G * NTHR) st[i] = -1;
        __syncthreads();
    }
    const int m0 = C.bid * 128 + C.wave * 16;
    LnRow Ra, Rb;
    int s1v = 0, s2v = 0, w1v = 0, w2v = 0;
    if (hmode == 2) { const int mr = m0 + (C.lane & 15); const f32x4 rt = ((const f32x4*)(ws + WS_ROUTE))[mr];
        s1v = ((const int*)(ws + WS_SLOT1))[mr]; s2v = ((const int*)(ws + WS_SLOT2))[mr]; w1v = __float_as_int(rt[1] * (1.f / 256.f)); w2v = __float_as_int(rt[2] * (1.f / 256.f)); }
#define LN_LOAD(R_, r_) ln_load(R_, C, m0 + (r_), Hp, hmode, __builtin_amdgcn_readlane(s1v, (r_)), __builtin_amdgcn_readlane(s2v, (r_)), __int_as_float(__builtin_amdgcn_readlane(w1v, (r_))), __int_as_float(__builtin_amdgcn_readlane(w2v, (r_))))
    LN_LOAD(Ra, 0);
#pragma unroll 1
    for (int r = 0; r < 16; r += 2) {
        LN_LOAD(Rb, r + 1);
        ln_row(Ra, C, m0 + r, gain, bias, hmode, Xf32out, X8out, rw, hist, do_route);
        if (r + 2 < 16) LN_LOAD(Ra, r + 2);
        ln_row(Rb, C, m0 + r + 1, gain, bias, hmode, Xf32out, X8out, rw, hist, do_route);
    }
#undef LN_LOAD
    if (do_route) { __syncthreads(); if (C.tid < 8) ((int*)(ws + WS_CTL))[CW_CNT + C.bid * 8 + C.tid] = hist[C.tid]; }
}

__device__ __forceinline__ void ph_slots(const Ctx& C) {
    unsigned char* ws = C.ws;
    LAS int* sm = (LAS int*)(C.lds + LDS_MISC + 128);
    const int* cnt = (const int*)(ws + WS_CTL) + CW_CNT;
    if (C.tid < 8) { int tot = 0, mine = 0; for (int b = 0; b < C.G; ++b) { const int c = cnt[b * 8 + C.tid]; if (b < C.bid) mine += c; tot += c; } sm[C.tid] = tot; sm[8 + C.tid] = mine; }
    __syncthreads();
    if (C.tid == 0) { int base = 0; for (int e = 0; e < 8; ++e) { sm[16 + e] = base; base += (sm[e] + 255) & ~255; } sm[24] = base >> 8; }
    __syncthreads();
    if (C.wave == 0) {
        int off[8];
#pragma unroll
        for (int e = 0; e < 8; ++e) off[e] = sm[16 + e] + sm[8 + e];
        const unsigned long long lt = (1ull << C.lane) - 1ull;
        for (int it = 0; it < 2; ++it) {
            const int m = C.bid * 128 + it * 64 + C.lane;
            const int ee = __float_as_int(((const f32x4*)(ws + WS_ROUTE))[m][0]); const int e1 = ee & 0xff, e2 = (ee >> 8) & 0xff;
            int s1 = 0, s2 = 0;
#pragma unroll
            for (int e = 0; e < 8; ++e) { const unsigned long long m1 = __ballot(e1 == e), m2 = __ballot(e2 == e);
                const int c1 = __popcll(m1), c2 = __popcll(m2);
                if (e1 == e) s1 = off[e] + __popcll(m1 & lt);
                if (e2 == e) s2 = off[e] + c1 + __popcll(m2 & lt);
                off[e] += c1 + c2; }
            ((int*)(ws + WS_SLOT1))[m] = s1; ((int*)(ws + WS_SLOT2))[m] = s2;
            int* st = (int*)(ws + WS_SLOTTOK); st[s1] = m; st[s2] = m;
        }
    }
    if (C.bid == 0) {
        int* ctl = (int*)(ws + WS_CTL);
        if (C.tid == 0) ctl[CW_NT] = sm[24];
        if (C.tid < 264) { int e = 0;
#pragma unroll
            for (int q = 1; q < 8; ++q) if (C.tid >= (sm[16 + q] >> 8)) e = q;
            ctl[CW_TEXP + C.tid] = e; }
    }
}
__device__ __forceinline__ void ph_gather(const Ctx& C) {
    unsigned char* ws = C.ws;
    const int* st = (const int*)(ws + WS_SLOTTOK); const u32x4* xb = (const u32x4*)(ws + WS_XB); u32x4* xp = (u32x4*)(ws + WS_XPERM);
    for (int s = C.gw; s < NSLOT; s += C.NGW) { const int tok = st[s];
#pragma unroll
        for (int j = 0; j < 2; ++j) { u32x4 v = xb[(size_t)(tok < 0 ? 0 : tok) * 128 + j * 64 + C.lane]; const unsigned k = tok < 0 ? 0u : 0xffffffffu; v.x &= k; v.y &= k; v.z &= k; v.w &= k; xp[(size_t)s * 128 + j * 64 + C.lane] = v; } }
}
__device__ __forceinline__ void ph_moe_wconv(const Ctx& C, const float* mg, const float* mu, const float* md, const float* const* in, int lq) {
    SlotDec dec; dec.in = in; dec.ws = C.ws; dec.lq = lq; dec.moe.mg = mg; dec.moe.mu = mu; dec.moe.md = md; dec.moe.ws = C.ws; dec.sd.in = in; dec.sd.ws = C.ws;
    conv_run(C, lq ? 20160 : 20864, dec, C.bid - 192, 64);
}

__device__ __forceinline__ void ph_memattn(const Ctx& C, const bf16* P, int ldp, int qm0) {
    unsigned char* ws = C.ws;
    const bf16* memK = (const bf16*)(ws + WS_MEMK); const bf16* memVT = (const bf16*)(ws + WS_MEMVT); bf16* mix = (bf16*)(ws + WS_MIX);
    const int g = C.lane >> 4, r16 = C.lane & 15;
    LAS unsigned char* LK = C.lds; LAS unsigned char* LV = C.lds + 65536;
    const int b = C.bid >> 4, hm = (C.bid >> 2) & 3, qb = C.bid & 3;
    __syncthreads();
    {   u32x4 st[16];
#pragma unroll
        for (int i = 0; i < 8; ++i) { const int q = C.tid + 512 * i, row = q >> 4, pc = q & 15;
            st[i] = *(const u32x4*)(memK + (size_t)(b * 256 + row) * 512 + hm * 128 + pc * 8); }
#pragma unroll
        for (int i = 0; i < 8; ++i) { const int q = C.tid + 512 * i, row = q >> 5, pc = q & 31;
            st[8 + i] = *(const u32x4*)(memVT + (size_t)(hm * 128 + row) * 4096 + b * 256 + pc * 8); }
#pragma unroll
        for (int i = 0; i < 8; ++i) { const int q = C.tid + 512 * i, row = q >> 4, pc = q & 15;
            *(LAS u32x4*)(LK + row * 256 + ((pc ^ (row & 15)) * 16)) = st[i]; }
#pragma unroll
        for (int i = 0; i < 8; ++i) { const int q = C.tid + 512 * i, row = q >> 5, pc = q & 31;
            *(LAS u32x4*)(LV + row * 512 + ((pc ^ (row & 15)) * 16)) = st[8 + i]; }
    }
    __syncthreads();
    for (int qt = 0; qt < 4; ++qt) {
        const int m0 = b * SEQ + qb * 512 + C.wave * 64 + qt * 16;
        bf16x8 qf[4];
#pragma unroll
        for (int s = 0; s < 4; ++s) qf[s] = *(const bf16x8*)(P + (size_t)(m0 + r16) * ldp + qm0 + hm * 128 + 32 * s + 8 * g);
        f32x4 sacc[16];
#pragma unroll
        for (int kt = 0; kt < 16; ++kt) { sacc[kt] = (f32x4){0.f, 0.f, 0.f, 0.f};
#pragma unroll
            for (int s = 0; s < 4; ++s) { const bf16x8 kf = *(const LAS bf16x8*)(LK + (16 * kt + r16) * 256 + (((4 * s + g) ^ r16) * 16));
                sacc[kt] = __builtin_amdgcn_mfma_f32_16x16x32_bf16(kf, qf[s], sacc[kt], 0, 0, 0); } }
        float mx = -3.0e38f;
#pragma unroll
        for (int kt = 0; kt < 16; ++kt)
#pragma unroll
            for (int j = 0; j < 4; ++j) mx = fmaxf(mx, sacc[kt][j]);
        mx = fmaxf(mx, shx(mx, C.lane, 16)); mx = fmaxf(mx, shx(mx, C.lane, 32));
        const float sc = 0.08838834764831845f * 1.4426950408889634f;
        float sum = 0.f;
#pragma unroll
        for (int kt = 0; kt < 16; ++kt)
#pragma unroll
            for (int j = 0; j < 4; ++j) { const float pv = exp2f((sacc[kt][j] - mx) * sc); sacc[kt][j] = pv; sum += pv; }
        sum += shx(sum, C.lane, 16); sum += shx(sum, C.lane, 32);
        f32x4 oacc[8];
#pragma unroll
        for (int dt = 0; dt < 8; ++dt) oacc[dt] = (f32x4){0.f, 0.f, 0.f, 0.f};
#pragma unroll
        for (int ks = 0; ks < 8; ++ks) {
            u32x4 pw; pw.x = cvt_pk_bf16(sacc[2 * ks][0], sacc[2 * ks][1]); pw.y = cvt_pk_bf16(sacc[2 * ks][2], sacc[2 * ks][3]);
            pw.z = cvt_pk_bf16(sacc[2 * ks + 1][0], sacc[2 * ks + 1][1]); pw.w = cvt_pk_bf16(sacc[2 * ks + 1][2], sacc[2 * ks + 1][3]);
            const bf16x8 pa = __builtin_bit_cast(bf16x8, pw);
#pragma unroll
            for (int dt = 0; dt < 8; ++dt) { const LAS unsigned char* vr = LV + (16 * dt + r16) * 512;
                const u32x2 lo = *(const LAS u32x2*)(vr + (((8 * ks + g) ^ (2 * r16)) * 8)), hi = *(const LAS u32x2*)(vr + (((8 * ks + 4 + g) ^ (2 * r16)) * 8));
                u32x4 vw; vw.x = lo.x; vw.y = lo.y; vw.z = hi.x; vw.w = hi.y;
                oacc[dt] = __builtin_amdgcn_mfma_f32_16x16x32_bf16(pa, __builtin_bit_cast(bf16x8, vw), oacc[dt], 0, 0, 0); } }
        float inv[4];
#pragma unroll
        for (int j = 0; j < 4; ++j) inv[j] = 1.0f / shl(sum, 4 * g + j);
#pragma unroll
        for (int dt = 0; dt < 8; ++dt)
#pragma unroll
            for (int j = 0; j < 4; ++j) mix[(size_t)(m0 + 4 * g + j) * D + SW + hm * 128 + 16 * dt + r16] = f2bf(oacc[dt][j] * inv[j]);
    }
    __syncthreads();
}

__device__ __forceinline__ void ph_rwkv_prep1(const Ctx& C, const float* mu, bool with_v) {
    unsigned char* ws = C.ws;
    const bf16* P = (const bf16*)(ws + WS_P); bf16* AL = (bf16*)(ws + WS_ALORA);
    const int oc0 = 8 * C.lane;
    const int XW0 = 4608, XA0 = 4704, XV0 = 4800, XG0 = with_v ? 4864 : 4800;
    int src, mode;
    if (oc0 < 96) { src = XW0 + oc0; mode = 0; } else if (oc0 < 192) { src = XA0 + oc0 - 96; mode = 1; }
    else if (oc0 < 256) { src = XV0 + oc0 - 192; mode = with_v ? 1 : 2; } else { src = XG0 + oc0 - 256; mode = 3; }
    f32x4 mu0 = (f32x4){0.f, 0.f, 0.f, 0.f}, mu1 = mu0;
    if (mode != 2) { mu0 = *(const f32x4*)(mu + src); mu1 = *(const f32x4*)(mu + src + 4); }
    for (int mb = C.gw; mb < M; mb += 4 * C.NGW) {
        u32x4 cu4[4], pr4[4];
#pragma unroll
        for (int i = 0; i < 4; ++i) { const int m = mb + i * C.NGW; cu4[i] = (u32x4){0u, 0u, 0u, 0u}; pr4[i] = cu4[i];
            if (mode != 2) { cu4[i] = *(const u32x4*)(P + (size_t)m * LDP_RW + src);
                if ((m & (SEQ - 1)) != 0) pr4[i] = *(const u32x4*)(P + (size_t)(m - 1) * LDP_RW + src); } }
#pragma unroll
        for (int i = 0; i < 4; ++i) { const int m = mb + i * C.NGW; const u32x4 cu = cu4[i], pr = pr4[i];
            u32x4 o = (u32x4){0u, 0u, 0u, 0u};
            if (mode != 2) {
                float v[8];
#pragma unroll
                for (int q = 0; q < 4; ++q) { const float c0 = bflo(cu[q]), c1 = bfhi(cu[q]), p0 = bflo(pr[q]), p1 = bfhi(pr[q]);
                    const float m0 = q < 2 ? mu0[2 * q] : mu1[2 * q - 4], m1 = q < 2 ? mu0[2 * q + 1] : mu1[2 * q - 3];
                    v[2 * q] = c0 + m0 * (p0 - c0); v[2 * q + 1] = c1 + m1 * (p1 - c1); }
#pragma unroll
                for (int q = 0; q < 8; ++q) { if (mode == 0) v[q] = 1.0f - 2.0f * __builtin_amdgcn_rcpf(1.0f + __expf(2.0f * v[q])); else if (mode == 3) v[q] = sigmoidf_(v[q]); }
                o.x = cvt_pk_bf16(v[0], v[1]); o.y = cvt_pk_bf16(v[2], v[3]); o.z = cvt_pk_bf16(v[4], v[5]); o.w = cvt_pk_bf16(v[6], v[7]);
            }
            *(u32x4*)(AL + (size_t)m * 512 + oc0) = o; }
    }
}
__device__ __forceinline__ void ph_rwkv_prep2(const Ctx& C, const float* mu, const float* vecs, bool with_v) {
    unsigned char* ws = C.ws;
    const bf16* P = (const bf16*)(ws + WS_P); const bf16* LO = (const bf16*)(ws + WS_LORAOUT); bf16* VF = (bf16*)(ws + WS_VFIRST);
    unsigned char* SI = ws + WS_SCANIN; float* BON = (float*)(ws + WS_BONUS);
    const float* k_k = vecs + (with_v ? 3 : 2) * SW; const float* k_a = k_k + SW; const float* r_k = k_a + SW;
    const int hq = C.lane >> 4, cl = (C.lane & 15) * 4;
    for (int m = C.gw; m < M; m += C.NGW) {
        const int t = m & (SEQ - 1), b = m >> 11; const bool hp = t != 0;
        const bf16* pc = P + (size_t)m * LDP_RW; const bf16* pp = pc - LDP_RW;
#pragma unroll 2
        for (int it = 0; it < 6; ++it) {
            const int c = it * 256 + 4 * C.lane, head = 4 * it + hq;
            const u32x2 rc = *(const u32x2*)(pc + c), kc = *(const u32x2*)(pc + SW + c), vc = *(const u32x2*)(pc + 2 * SW + c);
            u32x2 rp = (u32x2){0u, 0u}, kp_ = rp, vp = rp;
            if (hp) { rp = *(const u32x2*)(pp + c); kp_ = *(const u32x2*)(pp + SW + c); vp = *(const u32x2*)(pp + 2 * SW + c); }
            const u32x2 Ew = *(const u32x2*)(LO + (size_t)m * 6144 + c), aw = *(const u32x2*)(LO + (size_t)m * 6144 + SW + c);
            u32x2 svw = (u32x2){0u, 0u}, vfw = svw;
            if (with_v) { svw = *(const u32x2*)(LO + (size_t)m * 6144 + 2 * SW + c); vfw = *(const u32x2*)(VF + (size_t)m * SW + c); }
            const f32x4 mr = *(const f32x4*)(mu + c), mk = *(const f32x4*)(mu + SW + c), mv = *(const f32x4*)(mu + 2 * SW + c);
            const f32x4 kk4 = *(const f32x4*)(k_k + c), ka4 = *(const f32x4*)(k_a + c), rk4 = *(const f32x4*)(r_k + c);
            float rm[4], km[4], vm[4], E[4], a[4], sv[4], vf[4];
#define UNPK(dst, w) dst[0] = bflo(w.x); dst[1] = bfhi(w.x); dst[2] = bflo(w.y); dst[3] = bfhi(w.y)
            float t0[4], t1[4];
            UNPK(t0, rc); UNPK(t1, rp);
#pragma unroll
            for (int j = 0; j < 4; ++j) rm[j] = t0[j] + mr[j] * (t1[j] - t0[j]);
            UNPK(t0, kc); UNPK(t1, kp_);
#pragma unroll
            for (int j = 0; j < 4; ++j) km[j] = t0[j] + mk[j] * (t1[j] - t0[j]);
            UNPK(t0, vc); UNPK(t1, vp);
#pragma unroll
            for (int j = 0; j < 4; ++j) vm[j] = t0[j] + mv[j] * (t1[j] - t0[j]);
            UNPK(E, Ew); UNPK(a, aw); UNPK(sv, svw); UNPK(vf, vfw);
#undef UNPK
            float vv[4], kkr[4], kp[4], ss = 0.f, bs = 0.f;
#pragma unroll
            for (int j = 0; j < 4; ++j) {
                vv[j] = with_v ? vm[j] + (vf[j] - vm[j]) * sv[j] : vm[j];
                kkr[j] = km[j] * kk4[j]; ss += kkr[j] * kkr[j];
                kp[j] = km[j] * (1.0f + (a[j] - 1.0f) * ka4[j]);
                bs += rm[j] * kp[j] * rk4[j]; }
            ss = row16_sum(ss); bs = row16_sum(bs);
            const float inv = 1.0f / fmaxf(sqrtf(ss), 1e-12f);
            if (!with_v) { u32x2 w; w.x = cvt_pk_bf16(vm[0], vm[1]); w.y = cvt_pk_bf16(vm[2], vm[3]); *(u32x2*)(VF + (size_t)m * SW + c) = w; }
            unsigned char* rec = SI + ((size_t)(b * 24 + head) * SEQ + t) * 896;
            f32x4 wv; float kk[4];
#pragma unroll
            for (int j = 0; j < 4; ++j) { wv[j] = __expf(-E[j]); kk[j] = kkr[j] * inv; }
            *(f32x4*)(rec + cl * 4) = wv;
            u32x2 o;
            o.x = cvt_pk_bf16(-kk[0], -kk[1]); o.y = cvt_pk_bf16(-kk[2], -kk[3]); *(u32x2*)(rec + 256 + cl * 2) = o;
            o.x = cvt_pk_bf16(kk[0] * a[0], kk[1] * a[1]); o.y = cvt_pk_bf16(kk[2] * a[2], kk[3] * a[3]); *(u32x2*)(rec + 384 + cl * 2) = o;
            o.x = cvt_pk_bf16(kp[0], kp[1]); o.y = cvt_pk_bf16(kp[2], kp[3]); *(u32x2*)(rec + 512 + cl * 2) = o;
            o.x = cvt_pk_bf16(rm[0], rm[1]); o.y = cvt_pk_bf16(rm[2], rm[3]); *(u32x2*)(rec + 640 + cl * 2) = o;
            o.x = cvt_pk_bf16(vv[0], vv[1]); o.y = cvt_pk_bf16(vv[2], vv[3]); *(u32x2*)(rec + 768 + cl * 2) = o;
            if ((C.lane & 15) == 0) BON[m * 24 + head] = bs;
        }
    }
}
__device__ __forceinline__ float fma_(float a, float b, float c) { float d; asm("v_fma_f32 %0, %1, %2, %3" : "=v"(d) : "v"(a), "v"(b), "v"(c)); return d; }
__device__ __forceinline__ float mul_(float a, float b) { float d; asm("v_mul_f32 %0, %1, %2" : "=v"(d) : "v"(a), "v"(b)); return d; }
__device__ __forceinline__ void ph_rwkv_scan(const Ctx& C, const float* mg, const float* mu, const float* md, const float* vecs, bool with_v, const float* const* in, int lq) {
    if (C.bid >= 192) { ph_moe_wconv(C, mg, mu, md, in, lq); return; }
    unsigned char* ws = C.ws;
    const unsigned char* SI = ws + WS_SCANIN;
    constexpr int TC = 16, NCH = SEQ / TC, REC = 7 * 64;
    LAS float* buf = (LAS float*)C.lds;
    LAS float* ybuf = (LAS float*)(C.lds + 114688);
    const bool scanner = C.wave < 4;
    const int slot = (C.wave >> 1) & 1;
    const int rg = C.lane >> 3, cg = C.lane & 7;
    const int rbase = 32 * (C.wave & 1) + 4 * rg;
    if (!scanner) {
        const int lw = C.wave - 4, qd = C.lane;
        const int q2 = qd - 16, lvec = 1 + (q2 >> 3), lpart = q2 & 7;
        const float* BON = (const float*)(ws + WS_BONUS); bf16* mix = (bf16*)(ws + WS_MIX); const bf16* LO = (const bf16*)(ws + WS_LORAOUT);
        const float* gn_g = vecs + (with_v ? 6 : 5) * SW; const float* gn_b = gn_g + SW;
        const int p0 = C.bid * 2, b0 = p0 / 24, h0 = p0 % 24, b1 = (p0 + 1) / 24, h1 = (p0 + 1) % 24;
        const int pr = C.lane >> 4, pc4 = 4 * (C.lane & 15);
        const f32x4 gg0 = *(const f32x4*)(gn_g + h0 * 64 + pc4), gb0 = *(const f32x4*)(gn_b + h0 * 64 + pc4), gg1 = *(const f32x4*)(gn_g + h1 * 64 + pc4), gb1 = *(const f32x4*)(gn_b + h1 * 64 + pc4);
        u32x4 st[8];
#define SCAN_ISSUE(ch_) do { _Pragma("unroll") for (int i_ = 0; i_ < 8; ++i_) { const int ps = lw + 4 * i_; \
        const int sl_ = ps >> 4, t_ = (ch_) * TC + (ps & 15); \
        st[i_] = qd < 56 ? *(const u32x4*)(SI + ((size_t)(p0 + sl_) * SEQ + t_) * 896 + qd * 16) \
                         : *(const u32x4*)(LO + (size_t)((sl_ ? b1 : b0) * SEQ + t_) * 6144 + 3 * SW + (sl_ ? h1 : h0) * 64 + (qd - 56) * 8); } } while (0)
#define SCAN_COMMIT(bsel_) do { _Pragma("unroll") for (int i_ = 0; i_ < 8; ++i_) { const int ps = lw + 4 * i_; \
        LAS float* dst = buf + (((bsel_) * 2 * TC) + ps) * REC; \
        if (qd < 16) *(LAS u32x4*)(dst + 4 * qd) = st[i_]; \
        else { LAS float* d2 = dst + lvec * 64 + lpart * 8; \
            f32x4 a_, b_; a_[0] = bflo(st[i_].x); a_[1] = bfhi(st[i_].x); a_[2] = bflo(st[i_].y); a_[3] = bfhi(st[i_].y); \
            b_[0] = bflo(st[i_].z); b_[1] = bfhi(st[i_].z); b_[2] = bflo(st[i_].w); b_[3] = bfhi(st[i_].w); \
            *(LAS f32x4*)d2 = a_; *(LAS f32x4*)(d2 + 4) = b_; } } } while (0)
#define SCAN_POST(cp_) do { _Pragma("unroll") for (int g_ = 0; g_ < 2; ++g_) { const int ps = lw + 4 * (4 * g_ + pr), sl = ps >> 4, stp = ps & 15; \
        const LAS float* rec = buf + ((((cp_) & 1) * 2 * TC) + ps) * REC; \
        const f32x4 yv = *(const LAS f32x4*)(ybuf + ((((cp_) & 1) * 2 + sl) * TC + stp) * 64 + pc4), vv = *(const LAS f32x4*)(rec + 5 * 64 + pc4), gq = *(const LAS f32x4*)(rec + 6 * 64 + pc4); \
        const int m = (sl ? b1 : b0) * SEQ + (cp_) * TC + stp, hh = sl ? h1 : h0; \
        const float bon = BON[m * 24 + hh]; \
        const float mean = row16_sum((yv[0] + yv[1]) + (yv[2] + yv[3])) * (1.f / 64.f); const f32x4 d = yv - mean; \
        const float var = row16_sum((d[0] * d[0] + d[1] * d[1]) + (d[2] * d[2] + d[3] * d[3])) * (1.f / 64.f); \
        const float rstd = 1.0f / sqrtf(var + 64e-5f); const f32x4 gg = sl ? gg1 : gg0, gb = sl ? gb1 : gb0; \
        const f32x4 o_ = (d * rstd * gg + gb + vv * bon) * gq; \
        u32x2 w_; w_.x = cvt_pk_bf16(o_[0], o_[1]); w_.y = cvt_pk_bf16(o_[2], o_[3]); \
        *(u32x2*)(mix + (size_t)m * D + hh * 64 + pc4) = w_; } } while (0)
        SCAN_ISSUE(0); SCAN_COMMIT(0);
        __syncthreads();
        for (int ch = 0; ch < NCH; ++ch) {
            if (ch + 1 < NCH) SCAN_ISSUE(ch + 1);
            if (ch > 0) SCAN_POST(ch - 1);
            if (ch + 1 < NCH) SCAN_COMMIT((ch & 1) ^ 1);
            __syncthreads();
        }
        SCAN_POST(NCH - 1);
#undef SCAN_ISSUE
#undef SCAN_COMMIT
#undef SCAN_POST
    } else {
        f32x2 S[4][4];
#pragma unroll
        for (int i = 0; i < 4; ++i)
#pragma unroll
            for (int c = 0; c < 4; ++c) S[i][c] = (f32x2){0.f, 0.f};
        __syncthreads();
        for (int ch = 0; ch < NCH; ++ch) {
            const LAS float* base = buf + (((ch & 1) * 2 + slot) * TC) * REC;
            LAS float* yb = ybuf + (((ch & 1) * 2 + slot) * TC) * 64 + rbase;
#pragma unroll 2
            for (int s = 0; s < TC; ++s) {
                const LAS float* rp = base + s * REC + 8 * cg;
                f32x2 wv[4], nv[4], bv[4], kv[4], rv[4];
                { const f32x4 x0 = *(const LAS f32x4*)(rp), x1 = *(const LAS f32x4*)(rp + 4); wv[0] = (f32x2){x0[0], x0[1]}; wv[1] = (f32x2){x0[2], x0[3]}; wv[2] = (f32x2){x1[0], x1[1]}; wv[3] = (f32x2){x1[2], x1[3]}; }
                { const f32x4 x0 = *(const LAS f32x4*)(rp + 64), x1 = *(const LAS f32x4*)(rp + 68); nv[0] = (f32x2){x0[0], x0[1]}; nv[1] = (f32x2){x0[2], x0[3]}; nv[2] = (f32x2){x1[0], x1[1]}; nv[3] = (f32x2){x1[2], x1[3]}; }
                { const f32x4 x0 = *(const LAS f32x4*)(rp + 128), x1 = *(const LAS f32x4*)(rp + 132); bv[0] = (f32x2){x0[0], x0[1]}; bv[1] = (f32x2){x0[2], x0[3]}; bv[2] = (f32x2){x1[0], x1[1]}; bv[3] = (f32x2){x1[2], x1[3]}; }
                { const f32x4 x0 = *(const LAS f32x4*)(rp + 192), x1 = *(const LAS f32x4*)(rp + 196); kv[0] = (f32x2){x0[0], x0[1]}; kv[1] = (f32x2){x0[2], x0[3]}; kv[2] = (f32x2){x1[0], x1[1]}; kv[3] = (f32x2){x1[2], x1[3]}; }
                { const f32x4 x0 = *(const LAS f32x4*)(rp + 256), x1 = *(const LAS f32x4*)(rp + 260); rv[0] = (f32x2){x0[0], x0[1]}; rv[1] = (f32x2){x0[2], x0[3]}; rv[2] = (f32x2){x1[0], x1[1]}; rv[3] = (f32x2){x1[2], x1[3]}; }
                const f32x4 vv = *(const LAS f32x4*)(base + s * REC + 320 + rbase);
                f32x4 yo;
#pragma unroll
                for (int i = 0; i < 4; ++i) {
                    f32x2 a2 = S[i][0] * nv[0];
#pragma unroll
                    for (int c = 1; c < 4; ++c) a2 = S[i][c] * nv[c] + a2;
                    float sa = a2[0] + a2[1];
                    sa = dpp_add<0xB1>(sa); sa = dpp_add<0x4E>(sa); sa = dpp_add<0x141>(sa);
                    const f32x2 sa2 = (f32x2){sa, sa}, v2 = (f32x2){vv[i], vv[i]};
                    f32x2 y2 = (f32x2){0.f, 0.f};
#pragma unroll
                    for (int c = 0; c < 4; ++c) { S[i][c] = S[i][c] * wv[c] + (sa2 * bv[c] + v2 * kv[c]); y2 = S[i][c] * rv[c] + y2; }
                    float y = y2[0] + y2[1];
                    y = dpp_add<0xB1>(y); y = dpp_add<0x4E>(y); y = dpp_add<0x141>(y);
                    yo[i] = y;
                }
                if (cg == 0) *(LAS f32x4*)(yb + s * 64) = yo;
            }
            __syncthreads();
        }
    }
}

__device__ __constant__ float RET_LG2[6] = {-0.04580368961312479f, -0.02272007650008353f, -0.011315313227834146f, -0.005646563141142063f, -0.0028205190623786626f, -0.0014095702546713536f};
__device__ __forceinline__ void ph_ret_prep(const Ctx& C) {
    unsigned char* ws = C.ws;
    const bf16* P = (const bf16*)(ws + WS_P); const f32x2* CS = (const f32x2*)(ws + WS_CS);
    bf16* QR = (bf16*)(ws + WS_QR); bf16* KR = (bf16*)(ws + WS_KR); bf16* VT = (bf16*)(ws + WS_VT); bf16* KVT = (bf16*)(ws + WS_KVT);
    LAS unsigned char* LKt = C.lds; LAS unsigned char* LV = C.lds + 32768;
    const int g = C.lane >> 4, r16 = C.lane & 15, w = C.wave;
    __syncthreads();
    for (int u = C.bid; u < 1536; u += C.G) {
        const int c = u & 15, bh = u >> 4, h = bh % 6, b = bh / 6, m0 = b * SEQ + c * 128;
        const float lg2 = RET_LG2[h];
        __syncthreads();
        for (int task = C.tid; task < 1536; task += NTHR) {
            if (task < 512) {
                const bool isk = task >= 256; const int tk = task & 255, i0 = 4 * (tk & 15), tg = tk >> 4;
                const int colb = (isk ? 768 : 0) + h * 128 + i0; const float scl = isk ? 0.08838834764831845f : 1.0f;
                bf16* N = isk ? KR : QR;
                float o1[4][8], o2[4][8];
#pragma unroll
                for (int j = 0; j < 8; ++j) { const int m = m0 + tg * 8 + j;
                    const u32x2 a = *(const u32x2*)(P + (size_t)m * LDP_RET + colb), b2 = *(const u32x2*)(P + (size_t)m * LDP_RET + colb + 64);
                    const f32x4 cs01 = *(const f32x4*)(CS + (size_t)m * 64 + i0), cs23 = *(const f32x4*)(CS + (size_t)m * 64 + i0 + 2);
                    const float x1[4] = {bflo(a.x), bfhi(a.x), bflo(a.y), bfhi(a.y)}, x2[4] = {bflo(b2.x), bfhi(b2.x), bflo(b2.y), bfhi(b2.y)};
                    const float cc[4] = {cs01[0], cs01[2], cs23[0], cs23[2]}, sn[4] = {cs01[1], cs01[3], cs23[1], cs23[3]};
#pragma unroll
                    for (int q = 0; q < 4; ++q) { o1[q][j] = (x1[q] * cc[q] - x2[q] * sn[q]) * scl; o2[q][j] = (x1[q] * sn[q] + x2[q] * cc[q]) * scl; }
                    u32x2 w1, w2; w1.x = cvt_pk_bf16(o1[0][j], o1[1][j]); w1.y = cvt_pk_bf16(o1[2][j], o1[3][j]); w2.x = cvt_pk_bf16(o2[0][j], o2[1][j]); w2.y = cvt_pk_bf16(o2[2][j], o2[3][j]);
                    *(u32x2*)(N + (size_t)m * 768 + h * 128 + i0) = w1; *(u32x2*)(N + (size_t)m * 768 + h * 128 + i0 + 64) = w2; }
                if (isk) {
                    float kd[8];
#pragma unroll
                    for (int j = 0; j < 8; ++j) kd[j] = exp2f((float)(127 - (tg * 8 + j)) * lg2);
#pragma unroll
                    for (int q = 0; q < 4; ++q) {
                        u32x4 w1, w2;
                        w1.x = cvt_pk_bf16(o1[q][0] * kd[0], o1[q][1] * kd[1]); w1.y = cvt_pk_bf16(o1[q][2] * kd[2], o1[q][3] * kd[3]); w1.z = cvt_pk_bf16(o1[q][4] * kd[4], o1[q][5] * kd[5]); w1.w = cvt_pk_bf16(o1[q][6] * kd[6], o1[q][7] * kd[7]);
                        w2.x = cvt_pk_bf16(o2[q][0] * kd[0], o2[q][1] * kd[1]); w2.y = cvt_pk_bf16(o2[q][2] * kd[2], o2[q][3] * kd[3]); w2.z = cvt_pk_bf16(o2[q][4] * kd[4], o2[q][5] * kd[5]); w2.w = cvt_pk_bf16(o2[q][6] * kd[6], o2[q][7] * kd[7]);
                        *(LAS u32x4*)(LKt + (i0 + q) * 256 + ((tg ^ ((i0 + q) & 15)) * 16)) = w1;
                        *(LAS u32x4*)(LKt + (i0 + q + 64) * 256 + ((tg ^ ((i0 + q + 64) & 15)) * 16)) = w2; }
                }
            } else {
                const int tv = task - 512, e0 = 4 * (tv & 63), tg = tv >> 6;
                u32x2 vin[8];
#pragma unroll
                for (int j = 0; j < 8; ++j) vin[j] = *(const u32x2*)(P + (size_t)(m0 + tg * 8 + j) * LDP_RET + 1536 + h * 256 + e0);
                u32x4 w0, w1, w2, w3;
#define PKLO(a_, b_) (((a_) & 0xffffu) | ((b_) << 16))
#define PKHI(a_, b_) (((a_) >> 16) | ((b_) & 0xffff0000u))
                w0.x = PKLO(vin[0].x, vin[1].x); w0.y = PKLO(vin[2].x, vin[3].x); w0.z = PKLO(vin[4].x, vin[5].x); w0.w = PKLO(vin[6].x, vin[7].x);
                w1.x = PKHI(vin[0].x, vin[1].x); w1.y = PKHI(vin[2].x, vin[3].x); w1.z = PKHI(vin[4].x, vin[5].x); w1.w = PKHI(vin[6].x, vin[7].x);
                w2.x = PKLO(vin[0].y, vin[1].y); w2.y = PKLO(vin[2].y, vin[3].y); w2.z = PKLO(vin[4].y, vin[5].y); w2.w = PKLO(vin[6].y, vin[7].y);
                w3.x = PKHI(vin[0].y, vin[1].y); w3.y = PKHI(vin[2].y, vin[3].y); w3.z = PKHI(vin[4].y, vin[5].y); w3.w = PKHI(vin[6].y, vin[7].y);
#undef PKLO
#undef PKHI
                bf16* vt = VT + (size_t)(bh * 256 + e0) * SEQ + c * 128 + tg * 8;
                *(u32x4*)vt = w0; *(u32x4*)(vt + SEQ) = w1; *(u32x4*)(vt + 2 * SEQ) = w2; *(u32x4*)(vt + 3 * SEQ) = w3;
                *(LAS u32x4*)(LV + (e0 + 0) * 256 + ((tg ^ ((e0 + 0) & 15)) * 16)) = w0; *(LAS u32x4*)(LV + (e0 + 1) * 256 + ((tg ^ ((e0 + 1) & 15)) * 16)) = w1;
                *(LAS u32x4*)(LV + (e0 + 2) * 256 + ((tg ^ ((e0 + 2) & 15)) * 16)) = w2; *(LAS u32x4*)(LV + (e0 + 3) * 256 + ((tg ^ ((e0 + 3) & 15)) * 16)) = w3;
            }
        }
        __syncthreads();
        {   f32x4 acc[16];
#pragma unroll
            for (int et = 0; et < 16; ++et) acc[et] = (f32x4){0.f, 0.f, 0.f, 0.f};
#pragma unroll
            for (int ks = 0; ks < 4; ++ks) {
                const bf16x8 af = *(const LAS bf16x8*)(LKt + (16 * w + r16) * 256 + (((4 * ks + g) ^ r16) * 16));
#pragma unroll
                for (int et = 0; et < 16; ++et) { const bf16x8 bf = *(const LAS bf16x8*)(LV + (16 * et + r16) * 256 + (((4 * ks + g) ^ r16) * 16));
                    acc[et] = __builtin_amdgcn_mfma_f32_16x16x32_bf16(af, bf, acc[et], 0, 0, 0); } }
#pragma unroll
            for (int et = 0; et < 16; ++et) { u32x2 wv; wv.x = cvt_pk_bf16(acc[et][0], acc[et][1]); wv.y = cvt_pk_bf16(acc[et][2], acc[et][3]); *(u32x2*)(KVT + ((size_t)u * 256 + 16 * et + r16) * 128 + 16 * w + 4 * g) = wv; }
        }
    }
    __syncthreads();
}
__device__ __forceinline__ void ph_ret_kv(const Ctx& C) {
    unsigned char* ws = C.ws;
    const bf16* KDT = (const bf16*)(ws + WS_KDT); const bf16* VT = (const bf16*)(ws + WS_VT); bf16* KVT = (bf16*)(ws + WS_KVT);
    const int g = C.lane >> 4, r16 = C.lane & 15, w = C.wave;
    LAS unsigned char* LKt = C.lds; LAS unsigned char* LV = C.lds + 32768;
    u32x4 st[12];
#define KV_ISSUE(u_) do { const int c_ = (u_) & 15, bh_ = (u_) >> 4; \
        _Pragma("unroll") for (int i = 0; i < 4; ++i) { const int q = C.tid + 512 * i, row = q >> 4, pc = q & 15; st[i] = *(const u32x4*)(KDT + (size_t)(bh_ * 128 + row) * SEQ + c_ * 128 + pc * 8); } \
        _Pragma("unroll") for (int i = 0; i < 8; ++i) { const int q = C.tid + 512 * i, row = q >> 4, pc = q & 15; st[4 + i] = *(const u32x4*)(VT + (size_t)(bh_ * 256 + row) * SEQ + c_ * 128 + pc * 8); } } while (0)
#define KV_COMMIT() do { \
        _Pragma("unroll") for (int i = 0; i < 4; ++i) { const int q = C.tid + 512 * i, row = q >> 4, pc = q & 15; *(LAS u32x4*)(LKt + row * 256 + ((pc ^ (row & 15)) * 16)) = st[i]; } \
        _Pragma("unroll") for (int i = 0; i < 8; ++i) { const int q = C.tid + 512 * i, row = q >> 4, pc = q & 15; *(LAS u32x4*)(LV + row * 256 + ((pc ^ (row & 15)) * 16)) = st[4 + i]; } } while (0)
    __syncthreads();
    if (C.bid < 1536) KV_ISSUE(C.bid);
    for (int u = C.bid; u < 1536; u += C.G) {
        __syncthreads();
        KV_COMMIT();
        if (u + C.G < 1536) KV_ISSUE(u + C.G);
        __syncthreads();
        f32x4 acc[16];
#pragma unroll
        for (int et = 0; et < 16; ++et) acc[et] = (f32x4){0.f, 0.f, 0.f, 0.f};
#pragma unroll
        for (int ks = 0; ks < 4; ++ks) {
            const bf16x8 af = *(const LAS bf16x8*)(LKt + (16 * w + r16) * 256 + (((4 * ks + g) ^ r16) * 16));
#pragma unroll
            for (int et = 0; et < 16; ++et) { const bf16x8 bf = *(const LAS bf16x8*)(LV + (16 * et + r16) * 256 + (((4 * ks + g) ^ r16) * 16));
                acc[et] = __builtin_amdgcn_mfma_f32_16x16x32_bf16(af, bf, acc[et], 0, 0, 0); } }
#pragma unroll
        for (int et = 0; et < 16; ++et) { u32x2 wv; wv.x = cvt_pk_bf16(acc[et][0], acc[et][1]); wv.y = cvt_pk_bf16(acc[et][2], acc[et][3]); *(u32x2*)(KVT + ((size_t)u * 256 + 16 * et + r16) * 128 + 16 * w + 4 * g) = wv; }
    }
    __syncthreads();
#undef KV_ISSUE
#undef KV_COMMIT
}
__device__ __forceinline__ void ph_ret_prefix(const Ctx& C) {
    unsigned char* ws = C.ws;
    const bf16* KVT = (const bf16*)(ws + WS_KVT); bf16* RTB = (bf16*)(ws + WS_RTB);
    for (int idx = C.bid * NTHR + C.tid; idx < 96 * 8192; idx += C.G * NTHR) {
        const int bh = idx >> 13, rem = idx & 8191; const int h = bh % 6;
        const float cd = exp2f(128.0f * RET_LG2[h]);
        f32x4 r = (f32x4){0.f, 0.f, 0.f, 0.f};
        u32x2 kwv[15];
#pragma unroll
        for (int c = 0; c < 15; ++c) kwv[c] = *(const u32x2*)(KVT + ((size_t)(bh * 16 + c) * 8192 + rem) * 4);
#pragma unroll
        for (int c = 0; c < 16; ++c) { const size_t off = ((size_t)(bh * 16 + c) * 8192 + rem) * 4;
            u32x2 w; w.x = cvt_pk_bf16(r[0], r[1]); w.y = cvt_pk_bf16(r[2], r[3]); *(u32x2*)(RTB + off) = w;
            if (c < 15) { const u32x2 kw = kwv[c]; const f32x4 kv = (f32x4){bflo(kw.x), bfhi(kw.x), bflo(kw.y), bfhi(kw.y)}; r = r * cd + kv; } }
    }
}
#define LDS_BAR() asm volatile("s_waitcnt lgkmcnt(0)\n\ts_barrier" ::: "memory")
__device__ __forceinline__ void ph_ret_out(const Ctx& C, const float* gn) {
    unsigned char* ws = C.ws;
    const bf16* P = (const bf16*)(ws + WS_P); const bf16* QR = (const bf16*)(ws + WS_QR); const bf16* KR = (const bf16*)(ws + WS_KR);
    const bf16* VT = (const bf16*)(ws + WS_VT); const bf16* RTB = (const bf16*)(ws + WS_RTB); bf16* mix = (bf16*)(ws + WS_MIX);
    const int g = C.lane >> 4, r16 = C.lane & 15, w = C.wave;
    LAS unsigned char* LR = C.lds; LAS unsigned char* LV = C.lds + 65536;
    for (int u = C.bid; u < 1536; u += C.G) {
        const int c = u & 15, bh = u >> 4, h = bh % 6, b = bh / 6, m0 = b * SEQ + c * 128;
        const float lg2 = RET_LG2[h];
        LDS_BAR();
        const int nl = 16 * w + r16;
        u32x4 kst[4];
        bf16x8 qf[4];
        u32x2 gwv[16];
        {   u32x4 st[16];
#pragma unroll
            for (int i = 0; i < 8; ++i) { const int q = C.tid + 512 * i, row = q >> 4, pc = q & 15;
                st[i] = *(const u32x4*)(RTB + ((size_t)u * 256 + row) * 128 + pc * 8);
                st[8 + i] = *(const u32x4*)(VT + (size_t)(bh * 256 + row) * SEQ + c * 128 + pc * 8); }
#pragma unroll
            for (int s = 0; s < 4; ++s) qf[s] = *(const bf16x8*)(QR + (size_t)(m0 + nl) * 768 + h * 128 + 32 * s + 8 * g);
#pragma unroll
            for (int i = 0; i < 8; ++i) { const int q = C.tid + 512 * i, row = q >> 4, pc = q & 15; const int off = row * 256 + ((pc ^ (row & 15)) * 16);
                *(LAS u32x4*)(LR + off) = st[i]; *(LAS u32x4*)(LV + off) = st[8 + i]; }
        }
#pragma unroll
        for (int i = 0; i < 4; ++i) { const int q = C.tid + 512 * i, row = q >> 4, pc = q & 15;
            kst[i] = *(const u32x4*)(KR + (size_t)(m0 + row) * 768 + h * 128 + pc * 8); }
        LDS_BAR();
        f32x4 o[16];
        const float qdec = exp2f((float)(nl + 1) * lg2);
#pragma unroll
        for (int et = 0; et < 16; ++et) { f32x4 a = (f32x4){0.f, 0.f, 0.f, 0.f};
#pragma unroll
            for (int s = 0; s < 4; ++s) { const bf16x8 rf = *(const LAS bf16x8*)(LR + (16 * et + r16) * 256 + (((4 * s + g) ^ r16) * 16));
                a = __builtin_amdgcn_mfma_f32_16x16x32_bf16(rf, qf[s], a, 0, 0, 0); }
            o[et] = a * qdec;
            if ((et & 3) == 3) __builtin_amdgcn_sched_barrier(0); }
        LDS_BAR();
#pragma unroll
        for (int i = 0; i < 4; ++i) { const int q = C.tid + 512 * i, row = q >> 4, pc = q & 15; *(LAS u32x4*)(LR + row * 256 + ((pc ^ (row & 15)) * 16)) = kst[i]; }
#pragma unroll
        for (int et = 0; et < 16; ++et) gwv[et] = *(const u32x2*)(P + (size_t)(m0 + nl) * LDP_RET + 3072 + h * 256 + 16 * et + 4 * g);
        LDS_BAR();
        const float fd0 = (float)opq_v(nl - 4 * g);
        u32x2 pb[8];
#pragma unroll
        for (int mt = 0; mt < 8; ++mt) {
            pb[mt] = (u32x2){0u, 0u};
            if (mt <= w) { f32x4 a = (f32x4){0.f, 0.f, 0.f, 0.f};
#pragma unroll
                for (int s = 0; s < 4; ++s) { const bf16x8 kf = *(const LAS bf16x8*)(LR + (16 * mt + r16) * 256 + (((4 * s + g) ^ r16) * 16));
                    a = __builtin_amdgcn_mfma_f32_16x16x32_bf16(kf, qf[s], a, 0, 0, 0); }
#pragma unroll
                for (int j = 0; j < 4; ++j) { const float fd = fd0 - (float)(16 * mt + j); a[j] = fd >= 0.f ? a[j] * exp2f(fd * lg2) : 0.f; }
                pb[mt].x = cvt_pk_bf16(a[0], a[1]); pb[mt].y = cvt_pk_bf16(a[2], a[3]); }
        }
#pragma unroll
        for (int ks = 0; ks < 4; ++ks) {
            if (2 * ks <= w) {
                u32x4 pw; pw.x = pb[2 * ks].x; pw.y = pb[2 * ks].y; pw.z = pb[2 * ks + 1].x; pw.w = pb[2 * ks + 1].y;
                const bf16x8 pf = __builtin_bit_cast(bf16x8, pw);
#pragma unroll
                for (int et = 0; et < 16; ++et) { const LAS unsigned char* vr = LV + (16 * et + r16) * 256;
                    const u32x2 lo = *(const LAS u32x2*)(vr + (((8 * ks + g) ^ (2 * r16)) * 8)), hi = *(const LAS u32x2*)(vr + (((8 * ks + 4 + g) ^ (2 * r16)) * 8));
                    u32x4 vw; vw.x = lo.x; vw.y = lo.y; vw.z = hi.x; vw.w = hi.y;
                    o[et] = __builtin_amdgcn_mfma_f32_16x16x32_bf16(__builtin_bit_cast(bf16x8, vw), pf, o[et], 0, 0, 0); } }
        }
        float s1 = 0.f;
#pragma unroll
        for (int et = 0; et < 16; ++et) s1 += (o[et][0] + o[et][1]) + (o[et][2] + o[et][3]);
        s1 += shx(s1, C.lane, 16); s1 += shx(s1, C.lane, 32);
        const float mean = s1 * (1.f / 256.f); float s2 = 0.f;
#pragma unroll
        for (int et = 0; et < 16; ++et) { o[et] = o[et] - mean; s2 += (o[et][0] * o[et][0] + o[et][1] * o[et][1]) + (o[et][2] * o[et][2] + o[et][3] * o[et][3]); }
        s2 += shx(s2, C.lane, 16); s2 += shx(s2, C.lane, 32);
        const float rstd = 1.0f / sqrtf(s2 * (1.f / 256.f) + 1e-5f);
        const int m = m0 + nl;
#pragma unroll
        for (int et = 0; et < 16; ++et) { const int e = h * 256 + 16 * et + 4 * g;
            const f32x4 gg = *(const f32x4*)(gn + e), gb = *(const f32x4*)(gn + SW + e);
            const u32x2 gw_ = gwv[et];
            float gt[4] = {bflo(gw_.x), bfhi(gw_.x), bflo(gw_.y), bfhi(gw_.y)}; float ov[4];
#pragma unroll
            for (int j = 0; j < 4; ++j) { const float yn = o[et][j] * rstd * gg[j] + gb[j]; ov[j] = yn * gt[j] * sigmoidf_(gt[j]); }
            u32x2 wv; wv.x = cvt_pk_bf16(ov[0], ov[1]); wv.y = cvt_pk_bf16(ov[2], ov[3]);
            *(u32x2*)(mix + (size_t)m * D + e) = wv; }
    }
    __syncthreads();
}

constexpr int PH_PER_PAIR = 23, NPH = 2 + 2 * PH_PER_PAIR;
__global__ void __launch_bounds__(NTHR, 2) fwd_kernel(Args args) {
    extern __shared__ __attribute__((aligned(16))) unsigned char lds_raw[];
    Ctx C;
    C.lds = (LAS unsigned char*)lds_raw;
    C.tid = threadIdx.x; C.lane = C.tid & 63; C.wave = __builtin_amdgcn_readfirstlane(C.tid >> 6);
    C.bid = blockIdx.x; C.G = GRID; C.gw = C.bid * NWAVES + C.wave; C.NGW = C.G * NWAVES; C.ws = args.ws;
    for (int u = C.tid; u < (LDS_BYTES - LDS_MISC) / 4; u += NTHR) ((LAS unsigned*)(C.lds + LDS_MISC))[u] = 0u;
    __syncthreads();
    const int lo = args.ph_lo, hi = args.ph_hi;
    XcdBarrier bar; bar.bar = (unsigned*)(args.ws + WS_CTL) + CW_BAR; bar.x = 0; bar.st = nullptr;
    if (hi - lo > 1) bar = xcd_barrier_post((unsigned*)(args.ws + WS_CTL) + CW_BAR, (volatile LAS unsigned*)(C.lds + LDS_MISC));
#ifndef ENMASK
#define ENMASK 0x1ffffffu
#endif
#define EN(j) ((((unsigned)(ENMASK)) >> (j)) & 1u)
#ifndef DBLMASK
#define DBLMASK 0u
#endif
#define REP(j) for (int rep_ = 0; rep_ < 1 + (int)((((unsigned)(DBLMASK)) >> (j)) & 1u); ++rep_)
#define IN(k) (lo <= (k) && (k) < hi)
#define SEAM(k) do { if (IN((k) + 1)) xcd_barrier(bar, (lane_id_asm() == 0) && (Cq.wave == 0)); } while (0)

#define PH_BEGIN Ctx Cq; Cq.lds = C.lds; Cq.lane = lane_id_asm(); Cq.wave = opq_i(C.wave); Cq.tid = Cq.wave * 64 + Cq.lane; Cq.bid = opq_i((int)blockIdx.x); Cq.G = GRID; \
        Cq.gw = Cq.bid * NWAVES + Cq.wave; Cq.NGW = Cq.G * NWAVES; Cq.ws = opq(args.ws); unsigned char* ws = Cq.ws; const int lq = opq_i(lp); (void)ws; (void)lq
    { const int lp = 0;
    REP(0) if (EN(0) && IN(0)) { PH_BEGIN; ph_prologue(Cq, args); SEAM(0); }
    REP(1) if (EN(1) && IN(1)) { PH_BEGIN;
        pg8::SchedMem S; S.G = Cq.G; S.c = Cq.bid; S.memb = (unsigned)WS_MEMB; S.wkv = (unsigned)WS_WKV;
        pg8::EpiMem E; E.O0 = (bf16*)(ws + WS_MEMK); E.O1 = (bf16*)(ws + WS_MEMVT);
        pg8::gemm_phase<pg8::EpiMem, pg8::SchedMem, true, true>(Cq.lds, Cq.tid, (const char*)ws, 2048, 2048, 2048, S, E);
        SEAM(1);
    } }
#pragma unroll 1
    for (int lp = 0; lp < 2; ++lp) {
        const int pb = 2 + lp * PH_PER_PAIR;
        REP(2) if (EN(2) && IN(pb + 0)) {
            PH_BEGIN;
            pg8::SchedPlain S; S.init(M / 256, 22, Cq.G, Cq.bid); S.A0 = (unsigned)(WS_XB); S.B0 = (unsigned)(WS_WIN + (size_t)(2 * lq) * 22 * MiB); S.at = (unsigned)(256 * 2048 * 2); S.bt = (unsigned)(256 * 2048 * 2);
            pg8::EpiBf16 E; E.O = (bf16*)(ws + WS_P); E.ldc = LDP_RW;
            pg8::gemm_phase<pg8::EpiBf16, pg8::SchedPlain, true, true>(Cq.lds, Cq.tid, (const char*)ws, 2048, 2048, 2048, S, E);
            SEAM(pb + 0);
        }
        REP(3) if (EN(3) && IN(pb + 1)) { PH_BEGIN; const bool with_v = lq == 1; ph_rwkv_prep1(Cq, args.in[lq ? L2_MU : L0_MU], with_v); ph_memattn(Cq, (const bf16*)(ws + WS_P), LDP_RW, with_v ? 5120 : 5056); SEAM(pb + 1); }
        REP(4) if (EN(4) && IN(pb + 2)) {
            PH_BEGIN; const float* vecs = args.in[lq ? L2_VECS : L0_VECS];
            pg8::SchedLora S; S.skipv = lq == 0; S.init(M / 256, lq == 0 ? 18 : 24, Cq.G, Cq.bid); S.A0 = (unsigned)(WS_ALORA); S.B0 = (unsigned)(WS_WLORA + (size_t)lq * 3 * MiB);
            pg8::EpiLora E; E.O = (bf16*)(ws + WS_LORAOUT); E.vecs = vecs;
            pg8::gemm_phase<pg8::EpiLora, pg8::SchedLora, true, true>(Cq.lds, Cq.tid, (const char*)ws, 512, 256, opq_i(256), S, E);
            SEAM(pb + 2);
        }
        REP(5) if (EN(5) && IN(pb + 3)) { PH_BEGIN; ph_rwkv_prep2(Cq, args.in[lq ? L2_MU : L0_MU], args.in[lq ? L2_VECS : L0_VECS], lq == 1); SEAM(pb + 3); }
        REP(6) if (EN(6) && IN(pb + 4)) { PH_BEGIN; ph_rwkv_scan(Cq, args.in[lq ? L3_MG : L1_MG], args.in[lq ? L3_MU_ : L1_MU_], args.in[lq ? L3_MD : L1_MD], args.in[lq ? L2_VECS : L0_VECS], lq == 1, args.in, lq); SEAM(pb + 4); }
        REP(8) if (EN(8) && IN(pb + 6)) {
            PH_BEGIN;
            pg8::SchedPlain S; S.init(M / 256, 8, Cq.G, Cq.bid); S.A0 = (unsigned)(WS_MIX); S.B0 = (unsigned)(WS_WOUT + (size_t)(2 * lq) * 8 * MiB); S.at = (unsigned)(256 * 2048 * 2); S.bt = (unsigned)(256 * 2048 * 2);
            pg8::EpiBf16 E; E.O = (bf16*)(ws + WS_P); E.ldc = D;
            pg8::gemm_phase<pg8::EpiBf16, pg8::SchedPlain, true, true>(Cq.lds, Cq.tid, (const char*)ws, 2048, 2048, 2048, S, E);
            SEAM(pb + 6);
        }
        REP(9) if (EN(9) && IN(pb + 7)) { PH_BEGIN; const float* nr = args.in[lq ? L2_NORMS : L0_NORMS];
            ph_ln(Cq, ws + WS_P, 0, nr, nr + D, nullptr, ws + WS_X8, nullptr, false); SEAM(pb + 7); }
        REP(10) if (EN(10) && IN(pb + 8)) {
            PH_BEGIN;
            pg8::SchedPlain S; S.init(M / 256, 44, Cq.G, Cq.bid); S.A0 = (unsigned)(WS_X8); S.B0 = (unsigned)(WS_WFGU + (size_t)lq * 44 * MiB); S.at = (unsigned)(256 * 2048); S.bt = (unsigned)(256 * 2048);
            pg8::EpiSwiglu8 E; E.O = ws + WS_HID; E.ldc = DFF; E.inv = 1.0f / 16384.0f; E.so = 32.0f;
            pg8::gemm_phase<pg8::EpiSwiglu8, pg8::SchedPlain, true, true, true>(Cq.lds, Cq.tid, (const char*)ws, 1024, 1024, 1024, S, E);
            SEAM(pb + 8);
        }
        REP(11) if (EN(11) && IN(pb + 9)) {
            PH_BEGIN;
            pg8::SchedPlain S; S.init(M / 256, 8, Cq.G, Cq.bid); S.A0 = (unsigned)(WS_HID); S.B0 = (unsigned)(WS_WFD + (size_t)lq * 22 * MiB); S.at = (unsigned)(256 * DFF); S.bt = (unsigned)(256 * DFF);
            pg8::EpiFp8S E; E.O = ws + WS_P; E.ldc = D; E.sc = 1.0f / 256.0f;
            pg8::gemm_phase<pg8::EpiFp8S, pg8::SchedPlain, true, true, true>(Cq.lds, Cq.tid, (const char*)ws, DFF / 2, DFF / 2, DFF / 2, S, E);
            SEAM(pb + 9);
        }
        REP(12) if (EN(12) && IN(pb + 10)) { PH_BEGIN; const float* nr = args.in[lq ? L2_NORMS : L0_NORMS];
            ph_ln(Cq, ws + WS_P, 1, nr + 2 * D, nr + 3 * D, nullptr, nullptr, nullptr, false); SEAM(pb + 10); }
        REP(13) if (EN(13) && IN(pb + 11)) {
            PH_BEGIN;
            pg8::SchedPlain S; S.init(M / 256, 20, Cq.G, Cq.bid); S.A0 = (unsigned)(WS_XB); S.B0 = (unsigned)(WS_WIN + (size_t)(2 * lq + 1) * 22 * MiB); S.at = (unsigned)(256 * 2048 * 2); S.bt = (unsigned)(256 * 2048 * 2);
            pg8::EpiBf16 E; E.O = (bf16*)(ws + WS_P); E.ldc = LDP_RET;
            pg8::gemm_phase<pg8::EpiBf16, pg8::SchedPlain, true, true>(Cq.lds, Cq.tid, (const char*)ws, 2048, 2048, 2048, S, E);
            SEAM(pb + 11);
        }
        REP(14) if (EN(14) && IN(pb + 12)) { PH_BEGIN; ph_ret_prep(Cq); ph_memattn(Cq, (const bf16*)(ws + WS_P), LDP_RET, 4608); SEAM(pb + 12); }
        REP(16) if (EN(16) && IN(pb + 14)) { PH_BEGIN; ph_ret_prefix(Cq); SEAM(pb + 14); }
        REP(17) if (EN(17) && IN(pb + 15)) { PH_BEGIN; ph_ret_out(Cq, args.in[lq ? L3_GN : L1_GN]); SEAM(pb + 15); }
        REP(18) if (EN(18) && IN(pb + 16)) {
            PH_BEGIN;
            pg8::SchedPlain S; S.init(M / 256, 8, Cq.G, Cq.bid); S.A0 = (unsigned)(WS_MIX); S.B0 = (unsigned)(WS_WOUT + (size_t)(2 * lq + 1) * 8 * MiB); S.at = (unsigned)(256 * 2048 * 2); S.bt = (unsigned)(256 * 2048 * 2);
            pg8::EpiBf16 E; E.O = (bf16*)(ws + WS_P); E.ldc = D;
            pg8::gemm_phase<pg8::EpiBf16, pg8::SchedPlain, true, true>(Cq.lds, Cq.tid, (const char*)ws, 2048, 2048, 2048, S, E);
            SEAM(pb + 16);
        }
        REP(19) if (EN(19) && IN(pb + 17)) {
            PH_BEGIN; const float* nr = args.in[lq ? L3_NORMS : L1_NORMS];
            REP(25) { ph_ln(Cq, ws + WS_P, 0, nr, nr + D, nullptr, ws + WS_X8, args.in[lq ? L3_ROUTER : L1_ROUTER], true);
            __syncthreads(); }
            SEAM(pb + 17);
        }
        REP(20) if (EN(20) && IN(pb + 18)) { PH_BEGIN; ph_slots(Cq); SEAM(pb + 18); }
        REP(22) if (EN(22) && IN(pb + 20)) {
            PH_BEGIN;
            const int nT = __builtin_amdgcn_readfirstlane(((const int*)(ws + WS_CTL))[CW_NT]);
            pg8::SchedMoEg S; S.init(nT, 44, Cq.G, Cq.bid); S.B0 = (unsigned)(WS_MWGU); S.bt = (unsigned)(256 * 2048); S.be = (unsigned)(22 * MiB);
            S.xoff = (unsigned)WS_X8; S.zoff = (unsigned)(WS_CTL + 512 * 1024); S.texp = (const int*)(ws + WS_CTL) + CW_TEXP; S.slot_tok = (const int*)(ws + WS_SLOTTOK);
            pg8::EpiSwiglu8 E; E.O = ws + WS_HIDM; E.ldc = DFF; E.inv = 1.0f / 16384.0f; E.so = 32.0f;
            pg8::gemm_phase<pg8::EpiSwiglu8, pg8::SchedMoEg, true, true, true>(Cq.lds, Cq.tid, (const char*)ws, 1024, 1024, 1024, S, E);
            SEAM(pb + 20);
        }
        REP(23) if (EN(23) && IN(pb + 21)) {
            PH_BEGIN;
            const int nT = __builtin_amdgcn_readfirstlane(((const int*)(ws + WS_CTL))[CW_NT]);
            pg8::SchedMoE S; S.init(nT, 8, Cq.G, Cq.bid); S.A0 = (unsigned)(WS_HIDM); S.B0 = (unsigned)(WS_MWD); S.at = (unsigned)(256 * DFF); S.bt = (unsigned)(256 * DFF); S.be = (unsigned)(11 * MiB);
            S.texp = (const int*)(ws + WS_CTL) + CW_TEXP;
            pg8::EpiFp8S E; E.O = ws + WS_XPERM; E.ldc = D; E.sc = 1.0f / 256.0f;
            pg8::gemm_phase<pg8::EpiFp8S, pg8::SchedMoE, true, true, true>(Cq.lds, Cq.tid, (const char*)ws, DFF / 2, DFF / 2, DFF / 2, S, E);
            SEAM(pb + 21);
        }
        REP(24) if (EN(24) && IN(pb + 22)) {
            PH_BEGIN; const float* nr = args.in[lq ? L3_NORMS : L1_NORMS];
            ph_ln(Cq, ws + WS_XPERM, 2, nr + 2 * D, nr + 3 * D, lq == 1 ? args.out : nullptr, nullptr, nullptr, false);
            SEAM(pb + 22);
        }
    }
#undef IN
#undef SEAM
}

#ifndef MK_PER_PHASE
#define MK_PER_PHASE 0
#endif
extern "C" void kernel_launch(void* const* d_in, const int* in_sizes, int n_in, void* d_out, int out_size, void* d_ws, size_t ws_size, hipStream_t stream) {
    static int ready = 0;
    if (ready == 0) {
        ready = 1;
        if (n_in != 43 || out_size != M * D || ws_size < WS_END) { fprintf(stderr, "kernel_launch: unexpected problem (n_in %d out %d ws %zu need %zu)\n", n_in, out_size, ws_size, (size_t)WS_END); ready = -1; }
        else if (hipFuncSetAttribute((const void*)fwd_kernel, hipFuncAttributeMaxDynamicSharedMemorySize, LDS_BYTES) != hipSuccess) { fprintf(stderr, "kernel_launch: hipFuncSetAttribute failed\n"); ready = -1; }
        (void)hipGetLastError();
    }
    if (ready < 0) return;
    (void)hipMemsetAsync((char*)d_ws + WS_CTL, 0, CTL_BYTES, stream);
    Args a{};
    for (int i = 0; i < 43; ++i) a.in[i] = (const float*)d_in[i];
    a.out = (float*)d_out; a.ws = (unsigned char*)d_ws;
#if MK_PER_PHASE
    for (int p = 0; p < NPH; ++p) { a.ph_lo = p; a.ph_hi = p + 1; hipLaunchKernelGGL(fwd_kernel, dim3(GRID), dim3(NTHR), LDS_BYTES, stream, a); }
#else
    a.ph_lo = 0; a.ph_hi = NPH;
    hipLaunchKernelGGL(fwd_kernel, dim3(GRID), dim3(NTHR), LDS_BYTES, stream, a);
#endif
}
```

```cpp
#include <hip/hip_runtime.h>
#include <cstdio>
#include <cstdint>

#define LAS __attribute__((address_space(3)))
#define GAS __attribute__((address_space(1)))
typedef unsigned short bf16;
typedef short bf16x8 __attribute__((ext_vector_type(8)));
typedef float f32x4 __attribute__((ext_vector_type(4)));
typedef float f32x2 __attribute__((ext_vector_type(2)));
typedef unsigned u32x4 __attribute__((ext_vector_type(4)));
typedef unsigned u32x2 __attribute__((ext_vector_type(2)));

constexpr int M = 32768, D = 2048, SEQ = 2048, NB = 16;
constexpr int SW = 1536;
constexpr int LDP_RW = 5632, LDP_RET = 5120;
constexpr int DFF = 5632;
constexpr int NSLOT = 67584;
constexpr float ALPHA = 1.6817928305074290f;
constexpr float LN_EPS = 1e-5f;
constexpr int NWAVES = 8, NTHR = 512, GRID = 256;

constexpr size_t MiB = 1u << 20;
constexpr size_t WS_CTL = 0, CTL_BYTES = 1 * MiB;
constexpr size_t WS_WKV = 1 * MiB;
constexpr size_t WS_WIN = WS_WKV + 4 * MiB;
constexpr size_t WS_WOUT = WS_WIN + 88 * MiB;
constexpr size_t WS_WLORA = WS_WOUT + 32 * MiB;
constexpr size_t WS_WFGU = WS_WLORA + 6 * MiB;
constexpr size_t WS_WFD = WS_WFGU + 88 * MiB;
constexpr size_t WS_MEMB = WS_WFD + 44 * MiB;
constexpr size_t WS_MEMK = WS_MEMB + 16 * MiB;
constexpr size_t WS_MEMVT = WS_MEMK + 4 * MiB;
constexpr size_t WS_CS = WS_MEMVT + 4 * MiB;
constexpr size_t WS_XB = WS_CS + 16 * MiB;
constexpr size_t WS_MIX = WS_XB + 128 * MiB;
constexpr size_t WS_VFIRST = WS_MIX + 128 * MiB;
constexpr size_t WS_P = WS_VFIRST + 96 * MiB;
constexpr size_t WS_MISC = WS_P + 352 * MiB;
constexpr size_t WS_ROUTE = WS_MISC, WS_SLOT1 = WS_MISC + 512 * 1024, WS_SLOT2 = WS_SLOT1 + 128 * 1024, WS_SLOTTOK = WS_SLOT2 + 128 * 1024;
constexpr size_t WS_BONUS = WS_MISC + 2 * MiB;
constexpr size_t WS_SB = WS_BONUS + 3 * MiB;
constexpr size_t WS_ALORA = WS_SB, WS_LORAOUT = WS_SB + 32 * MiB, WS_SCANIN = WS_SB + 416 * MiB;
constexpr size_t WS_QR = WS_SB, WS_KR = WS_SB + 48 * MiB, WS_KDT = WS_SB + 96 * MiB, WS_VT = WS_SB + 144 * MiB, WS_KVT = WS_SB + 240 * MiB, WS_RTB = WS_SB + 432 * MiB;
constexpr size_t WS_HID = WS_SB;
constexpr size_t WS_XPERM = WS_SB, WS_HIDM = WS_SB + 264 * MiB, WS_MWGU = WS_SB + 1184 * MiB, WS_MWD = WS_SB + 1360 * MiB;
constexpr size_t WS_XLO = WS_SB + 1518 * MiB;
constexpr size_t WS_X8 = WS_XLO + 64 * MiB;
constexpr size_t WS_END = WS_X8 + 64 * MiB;
constexpr int CW_BAR = 4096;
constexpr int CW_CNT = 16384;
constexpr int CW_NT = 20480;
constexpr int CW_TEXP = 20544;

constexpr int RING_BYTES = 131072;
constexpr int LDS_MISC = RING_BYTES;
constexpr int LDS_BYTES = RING_BYTES + 8192;

#define LDS_WAIT() asm volatile("s_waitcnt lgkmcnt(0)" ::: "memory")
#define VM_WAIT() asm volatile("s_waitcnt vmcnt(0)" ::: "memory")
__device__ __forceinline__ unsigned cvt_pk_bf16(float lo, float hi) { unsigned r; asm volatile("v_cvt_pk_bf16_f32 %0, %1, %2" : "=v"(r) : "v"(lo), "v"(hi)); return r; }
__device__ __forceinline__ bf16 f2bf(float f) { return (bf16)(cvt_pk_bf16(f, 0.f) & 0xffffu); }
__device__ __forceinline__ float bf2f(bf16 b) { return __uint_as_float(((unsigned)b) << 16); }
__device__ __forceinline__ float bflo(unsigned w) { return __uint_as_float(w << 16); }
__device__ __forceinline__ float bfhi(unsigned w) { return __uint_as_float(w & 0xffff0000u); }
template <int CTRL> __device__ __forceinline__ float dpp_add(float x) {
    int y = __builtin_amdgcn_update_dpp(0, __float_as_int(x), CTRL, 0xf, 0xf, true);
    return x + __int_as_float(y);
}
__device__ __forceinline__ float row16_sum(float x) { x = dpp_add<0xB1>(x); x = dpp_add<0x4E>(x); x = dpp_add<0x141>(x); x = dpp_add<0x140>(x); return x; }
__device__ __forceinline__ float wave_sum(float v) {
    v = row16_sum(v);
    const float a = __int_as_float(__builtin_amdgcn_readlane(__float_as_int(v), 0)), b = __int_as_float(__builtin_amdgcn_readlane(__float_as_int(v), 16));
    const float c = __int_as_float(__builtin_amdgcn_readlane(__float_as_int(v), 32)), d = __int_as_float(__builtin_amdgcn_readlane(__float_as_int(v), 48));
    return (a + b) + (c + d);
}
__device__ __forceinline__ unsigned pk4_fp8(float a, float b, float c, float d) {
    a = __builtin_amdgcn_fmed3f(a, -448.f, 448.f); b = __builtin_amdgcn_fmed3f(b, -448.f, 448.f); c = __builtin_amdgcn_fmed3f(c, -448.f, 448.f); d = __builtin_amdgcn_fmed3f(d, -448.f, 448.f);
    unsigned w = 0; w = __builtin_amdgcn_cvt_pk_fp8_f32(a, b, w, false); w = __builtin_amdgcn_cvt_pk_fp8_f32(c, d, w, true); return w; }
__device__ __forceinline__ float sigmoidf_(float z) { return __builtin_amdgcn_rcpf(1.0f + __expf(-z)); }

__device__ __forceinline__ unsigned char* opq(unsigned char* p) { asm volatile("" : "+s"(p)); return p; }
__device__ __forceinline__ int opq_i(int v) { asm volatile("" : "+s"(v)); return v; }
__device__ __forceinline__ int opq_v(int v) { asm volatile("" : "+v"(v)); return v; }
__device__ __forceinline__ int lane_id_asm() { int l; asm volatile("v_mbcnt_lo_u32_b32 %0, -1, 0\n\tv_mbcnt_hi_u32_b32 %0, -1, %0" : "=v"(l)); return l; }
__device__ __forceinline__ float shx(float v, int lane, int m) { return __builtin_bit_cast(float, __builtin_amdgcn_ds_bpermute((lane ^ m) << 2, __builtin_bit_cast(int, v))); }
__device__ __forceinline__ float shl(float v, int src) { return __builtin_bit_cast(float, __builtin_amdgcn_ds_bpermute(src << 2, __builtin_bit_cast(int, v))); }
#define XB_TMO      128
#define XB_XCNT(j)  (256  + 64 * (j))
#define XB_XSUB(j)  (1280 + 64 * (j))
#define XB_XGEN(j)  (2304 + 64 * (j))
#define XB_TOP      3328
#define XB_TOPGEN   3392
#define XCD_BAR_WORDS 3456
#define XB_SPIN_CAP (1u << 18)
__device__ __forceinline__ unsigned xb_ld(unsigned* p)              { return __hip_atomic_load(p, __ATOMIC_RELAXED, __HIP_MEMORY_SCOPE_AGENT); }
__device__ __forceinline__ unsigned xb_add(unsigned* p, unsigned v) { return __hip_atomic_fetch_add(p, v, __ATOMIC_RELAXED, __HIP_MEMORY_SCOPE_AGENT); }
__device__ __forceinline__ unsigned xb_xcc_id() { return (unsigned)__builtin_amdgcn_s_getreg((3 << 11) | 20) & 0xFu; }
#define XB_SPIN(cond, bar) do { unsigned _sp = 0; while (cond) { __builtin_amdgcn_s_sleep(1); \
    if ((++_sp & 255u) == 0u) { if (xb_ld(&(bar)[XB_TMO])) break; if (_sp > XB_SPIN_CAP) { atomicAdd(&(bar)[XB_TMO], 1u); break; } } } } while (0)
struct XcdBarrier { unsigned* bar; unsigned x; volatile LAS unsigned* st; };
__device__ __forceinline__ XcdBarrier xcd_barrier_post(unsigned* bar, volatile LAS unsigned* st) {
    XcdBarrier b; b.bar = bar; b.x = xb_xcc_id(); b.st = st;
    if (threadIdx.x == 0) (void)xb_add(&bar[XB_XCNT(b.x)], 1u);
    return b;
}
__device__ __forceinline__ void xcd_barrier_complete(unsigned* bar, unsigned x, unsigned& nloc, unsigned& nx) {
    const unsigned G = gridDim.x * gridDim.y * gridDim.z;
    unsigned sum, cnt, mine, sp = 0u;
    for (;;) {
        sum = 0u; cnt = 0u; mine = 0u;
#pragma unroll
        for (unsigned j = 0; j < 16; ++j) { const unsigned c = xb_ld(&bar[XB_XCNT(j)]); sum += c; cnt += (c > 0u) ? 1u : 0u; mine = (j == x) ? c : mine; }
        if (sum == G) break;
        __builtin_amdgcn_s_sleep(1);
        if ((++sp & 255u) == 0u) { if (xb_ld(&bar[XB_TMO])) break; if (sp > XB_SPIN_CAP) { atomicAdd(&bar[XB_TMO], 1u); break; } }
    }
    nloc = mine > 0u ? mine : 1u; nx = cnt > 0u ? cnt : 1u;
}
__device__ __forceinline__ void xcd_barrier(const XcdBarrier& b, const bool leader  ) {
    asm volatile("s_waitcnt vmcnt(0)" ::: "memory");
    __syncthreads();
    if (leader) {
        unsigned* bar = b.bar;
        __builtin_amdgcn_s_waitcnt(0);
        unsigned nloc = b.st[0], nx = b.st[1];
        if (nloc == 0u) { xcd_barrier_complete(bar, b.x, nloc, nx); b.st[0] = nloc; b.st[1] = nx; }
        const unsigned old = xb_add(&bar[XB_XSUB(b.x)], 1u);
        const unsigned gen = old / nloc;
        if (old + 1u == (gen + 1u) * nloc) {
            __builtin_amdgcn_fence(__ATOMIC_RELEASE, "agent");
            asm volatile("s_waitcnt vmcnt(0)" ::: "memory");
            const unsigned og = xb_add(&bar[XB_TOP], 1u);
            const unsigned tg = og / nx;
            if (og + 1u == (tg + 1u) * nx) xb_add(&bar[XB_TOPGEN], 1u);
            else XB_SPIN(xb_ld(&bar[XB_TOPGEN]) == tg, bar);
            __builtin_amdgcn_fence(__ATOMIC_ACQUIRE, "agent");
            xb_add(&bar[XB_XGEN(b.x)], 1u);
            asm volatile("s_waitcnt vmcnt(0)" ::: "memory");
        } else {
            XB_SPIN(xb_ld(&bar[XB_XGEN(b.x)]) == gen, bar);
            __builtin_amdgcn_fence(__ATOMIC_ACQUIRE, "agent");
            asm volatile("s_waitcnt vmcnt(0)" ::: "memory");
        }
    }
    __syncthreads();
}

namespace pg8 {
constexpr int BM = 256, BK = 64, HALF = 128, HTB = HALF * BK * 2, STAGE_BYTES = 8 * HTB, NXCD = 8, WGM = 8;
__host__ __device__ __forceinline__ int lds_byte(int r, int c) { const int st = (r >> 4) * 2 + (c >> 5), rr = r & 15, cc = c & 31, ob = rr * 64 + cc * 2; return st * 1024 + (ob ^ (((ob >> 9) & 1) << 5)); }
__host__ __device__ __forceinline__ void stage_rc(int b, int& R, int& C) { const int st = b / 1024, sb = b % 1024, swz = sb ^ (((sb >> 9) & 1) << 5); R = (st >> 1) * 16 + swz / 64; C = (st & 1) * 32 + (swz % 64) / 2; }
__host__ __device__ __forceinline__ int perm32(int rho) { const int n = rho >> 4, i = rho & 15; return 8 * (i >> 2) + 4 * n + (i & 3); }
typedef int i32x8 __attribute__((ext_vector_type(8)));
typedef int i32x4_ __attribute__((ext_vector_type(4)));
__device__ __forceinline__ i32x8 cat8(bf16x8 a, bf16x8 b) { const i32x4_ x = __builtin_bit_cast(i32x4_, a), y = __builtin_bit_cast(i32x4_, b); return __builtin_shufflevector(x, y, 0, 1, 2, 3, 4, 5, 6, 7); }
__device__ __forceinline__ void mfma8(f32x4& acc, const i32x8 a, const i32x8 b) {
    asm volatile("v_mfma_scale_f32_16x16x128_f8f6f4 %0, %1, %2, %0, %3, %3 op_sel_hi:[0,0,0]" : "+v"(acc) : "v"(a), "v"(b), "v"(127)); }
struct Unit { int pm, pn, z; };
struct Order {
    int nM, nN, nwg, G, c;
    __device__ __forceinline__ void init(int nM_, int nN_, int G_, int c_) { nM = nM_; nN = nN_; nwg = nM * nN; G = G_; c = c_; }
    __device__ __forceinline__ bool next_mn(int i, Unit& u) const {
        const long L = (long)i * G + c; if (L >= nwg) return false;
        int wgid = (int)L; { const int q = nwg / NXCD, r = nwg % NXCD, xcd = wgid % NXCD, off = wgid / NXCD; wgid = (xcd < r ? xcd * (q + 1) : r * (q + 1) + (xcd - r) * q) + off; }
        const int nig = WGM * nN, gid = wgid / nig, fm = gid * WGM, gsz = (nM - fm) < WGM ? (nM - fm) : WGM;
        u.pm = fm + ((wgid % nig) % gsz); u.pn = (wgid % nig) / gsz; u.z = 0; return true;
    }
};

template <class Epi, class Sched, bool ALIGN_EPI, bool SP2, bool FP8 = false>
__device__ __forceinline__ void gemm_phase(LAS unsigned char* lds, const int tid_in, const char* base  , const int lda, const int ldb, const int K, const Sched& S, const Epi& E) {
    const int tid = tid_in, wid = __builtin_amdgcn_readfirstlane(tid >> 6), lane = tid & 63, wr = wid >> 2, wc = wid & 3, fr = lane & 15, fq = lane >> 4;
    const int nt = K / BK;
    unsigned voffA[2], voffB[2];
#pragma unroll
    for (int i = 0; i < 2; ++i) { int R, C; stage_rc(tid * 16 + i * 8192, R, C); const int Rb = Epi::PERM ? ((R & ~31) + perm32(R & 31)) : R;
        voffA[i] = (unsigned)(R * lda + C) * 2u; voffB[i] = (unsigned)(Rb * ldb + C) * 2u; }
    constexpr bool GATHER = Sched::GATHER;
    unsigned gvC[2][2], gvN[2][2];
#define PG8_GV(dst, unit) do { _Pragma("unroll") for (int hh_ = 0; hh_ < 2; ++hh_) _Pragma("unroll") for (int i_ = 0; i_ < 2; ++i_) { int R_, C_; stage_rc(tid * 16 + i_ * 8192, R_, C_); \
        dst[hh_][i_] = S.arow(unit, hh_ * HALF + R_) + (unsigned)C_ * 2u; } } while (0)
    const unsigned kstep = (unsigned)(BK * 2);
    const unsigned hstepA = (unsigned)(HALF * lda * 2), hstepB = (unsigned)(HALF * ldb * 2);
    const __amdgpu_buffer_rsrc_t rsrc = __builtin_amdgcn_make_buffer_rsrc((void*)base, 0, 0xffffffffu, 0x00020000);
    const unsigned ldsw = (unsigned)wid * 1024u;
    const int aoff = lds_byte(wr * 64 + fr, fq * 8), boff = lds_byte(wc * 32 + fr, fq * 8);
#define PG8_SA(b, h) (((b) * 2 + (h)) * HTB)
#define PG8_SB(b, h) ((4 + (b) * 2 + (h)) * HTB)
#define PG8_STAGE(bufoff, goff, voff) do { _Pragma("unroll") for (int _i = 0; _i < 2; ++_i) \
        __builtin_amdgcn_raw_ptr_buffer_load_lds(rsrc, (LAS unsigned*)(lds + (bufoff) + ldsw + _i * 8192), 16, (voff)[_i], (goff), 0, 0); } while (0)
#define PG8_STAGE_A(bufoff, aoff, hh, nx) do { if constexpr (GATHER) { unsigned gv_[2]; gv_[0] = (nx) ? gvN[hh][0] : gvC[hh][0]; gv_[1] = (nx) ? gvN[hh][1] : gvC[hh][1]; PG8_STAGE(bufoff, aoff, gv_); } \
        else { PG8_STAGE(bufoff, (aoff) + (hh) * hstepA, voffA); } } while (0)
#define PG8_LDA(dst, b, h) do { _Pragma("unroll") for (int m = 0; m < 4; ++m) _Pragma("unroll") for (int k = 0; k < 2; ++k) dst[m][k] = *(const LAS bf16x8*)(lds + PG8_SA(b, h) + aoff + m * 2048 + k * 1024); } while (0)
#define PG8_LDB(dst, b, h) do { _Pragma("unroll") for (int n = 0; n < 2; ++n) _Pragma("unroll") for (int k = 0; k < 2; ++k) dst[n][k] = *(const LAS bf16x8*)(lds + PG8_SB(b, h) + boff + n * 2048 + k * 1024); } while (0)
#define PG8_MMA(ai, bj, At, Bt) do { __builtin_amdgcn_s_setprio(1); \
        if constexpr (FP8) { _Pragma("unroll") for (int m = 0; m < 4; ++m) _Pragma("unroll") for (int n = 0; n < 2; ++n) \
            mfma8(acc[ai][bj][m][n], cat8(Bt[n][0], Bt[n][1]), cat8(At[m][0], At[m][1])); } \
        else { _Pragma("unroll") for (int m = 0; m < 4; ++m) _Pragma("unroll") for (int n = 0; n < 2; ++n) _Pragma("unroll") for (int k = 0; k < 2; ++k) \
            acc[ai][bj][m][n] = __builtin_amdgcn_mfma_f32_16x16x32_bf16(Bt[n][k], At[m][k], acc[ai][bj][m][n], 0, 0, 0); } \
        __builtin_amdgcn_s_setprio(0); } while (0)
#define PG8_WAIT_V(n) asm volatile("s_waitcnt vmcnt(" #n ")" ::: "memory")
#define PG8_WAIT_L(n) asm volatile("s_waitcnt lgkmcnt(" #n ")" ::: "memory")
#define PG8_BAR __builtin_amdgcn_s_barrier()
#define PG8_SCHED __builtin_amdgcn_sched_barrier(0)
    Unit cur, nxt; int ui = 0;
    if (!S.next(0, cur)) return;
    f32x4 acc[2][2][4][2];
#pragma unroll
    for (int a = 0; a < 2; ++a)
#pragma unroll
        for (int b = 0; b < 2; ++b)
#pragma unroll
            for (int m = 0; m < 4; ++m)
#pragma unroll
                for (int n = 0; n < 2; ++n) acc[a][b][m][n] = (f32x4){0.f, 0.f, 0.f, 0.f};
    bf16x8 At[4][2], B0[2][2], B1[2][2];
    unsigned cA = S.A(cur), cB = S.B(cur);
    if constexpr (GATHER) { PG8_GV(gvC, cur); _Pragma("unroll") for (int hh_ = 0; hh_ < 2; ++hh_) _Pragma("unroll") for (int i_ = 0; i_ < 2; ++i_) gvN[hh_][i_] = gvC[hh_][i_]; }
    if constexpr (SP2) {
        PG8_STAGE(PG8_SB(0, 0), cB, voffB); PG8_STAGE(PG8_SB(0, 1), cB + hstepB, voffB); PG8_STAGE_A(PG8_SA(0, 0), cA, 0, false); PG8_STAGE_A(PG8_SA(0, 1), cA, 1, false);
        if (wr == 1) PG8_BAR;
        PG8_WAIT_V(2); PG8_BAR;
        PG8_STAGE(PG8_SB(1, 0), cB + kstep, voffB); PG8_STAGE_A(PG8_SA(1, 0), cA + kstep, 0, false); PG8_STAGE(PG8_SB(1, 1), cB + hstepB + kstep, voffB);
        PG8_WAIT_V(6); PG8_BAR;
    } else {
        PG8_STAGE(PG8_SB(0, 0), cB, voffB); PG8_STAGE_A(PG8_SA(0, 0), cA, 0, false); PG8_STAGE(PG8_SB(0, 1), cB + hstepB, voffB); PG8_STAGE_A(PG8_SA(0, 1), cA, 1, false);
        if (wr == 1) PG8_BAR;
        PG8_WAIT_V(4); PG8_BAR;
        PG8_STAGE(PG8_SB(1, 0), cB + kstep, voffB); PG8_STAGE_A(PG8_SA(1, 0), cA + kstep, 0, false); PG8_STAGE(PG8_SB(1, 1), cB + hstepB + kstep, voffB);
        PG8_WAIT_V(6); PG8_BAR;
    }
    for (;;) {
        const bool has_next = S.next(ui + 1, nxt);
        const unsigned nA = has_next ? S.A(nxt) : cA, nB = has_next ? S.B(nxt) : cB;
        if constexpr (GATHER) { if (has_next) PG8_GV(gvN, nxt); }
        for (int t = 0; t < nt; t += 2) {
            const bool last = (t == nt - 2);
            const unsigned a1 = cA + (unsigned)(t + 1) * kstep;
            const unsigned a2 = last ? nA : cA + (unsigned)(t + 2) * kstep, b2 = last ? nB : cB + (unsigned)(t + 2) * kstep;
            const unsigned a3 = a2 + kstep, b3 = b2 + kstep;
            if constexpr (SP2) {
            PG8_LDB(B0, 0, 0); PG8_LDB(B1, 0, 1); PG8_SCHED; PG8_LDA(At, 0, 0); PG8_STAGE_A(PG8_SA(1, 1), a1, 1, false);
            PG8_WAIT_V(8); PG8_WAIT_L(0); PG8_BAR; PG8_MMA(0, 0, At, B0); PG8_MMA(0, 1, At, B1); PG8_BAR; PG8_SCHED;
            PG8_LDA(At, 0, 1); PG8_STAGE(PG8_SB(0, 0), b2, voffB); PG8_STAGE(PG8_SB(0, 1), b2 + hstepB, voffB); PG8_STAGE_A(PG8_SA(0, 0), a2, 0, last);
            PG8_WAIT_V(8); PG8_WAIT_L(0); PG8_BAR; PG8_MMA(1, 0, At, B0); PG8_MMA(1, 1, At, B1); PG8_BAR; PG8_SCHED;
            PG8_LDB(B0, 1, 0); PG8_LDB(B1, 1, 1); PG8_SCHED; PG8_LDA(At, 1, 0); PG8_STAGE_A(PG8_SA(0, 1), a2, 1, last);
            PG8_WAIT_V(8); PG8_WAIT_L(0); PG8_BAR; PG8_MMA(0, 0, At, B0); PG8_MMA(0, 1, At, B1); PG8_BAR; PG8_SCHED;
            PG8_LDA(At, 1, 1); PG8_STAGE(PG8_SB(1, 0), b3, voffB); PG8_STAGE(PG8_SB(1, 1), b3 + hstepB, voffB); PG8_STAGE_A(PG8_SA(1, 0), a3, 0, last);
            PG8_WAIT_V(8); PG8_WAIT_L(0); PG8_BAR; PG8_MMA(1, 0, At, B0); PG8_MMA(1, 1, At, B1); PG8_BAR; PG8_SCHED;
            } else {
            PG8_LDB(B0, 0, 0); PG8_SCHED; PG8_LDA(At, 0, 0); PG8_STAGE_A(PG8_SA(1, 1), a1, 1, false);
            PG8_WAIT_L(8); PG8_BAR; PG8_WAIT_L(0); PG8_MMA(0, 0, At, B0); PG8_BAR; PG8_SCHED;
            PG8_LDB(B1, 0, 1); PG8_STAGE(PG8_SB(0, 0), b2, voffB);
            PG8_BAR; PG8_WAIT_L(0); PG8_MMA(0, 1, At, B1); PG8_BAR;
            PG8_LDA(At, 0, 1); PG8_STAGE_A(PG8_SA(0, 0), a2, 0, last);
            PG8_BAR; PG8_WAIT_L(0); PG8_MMA(1, 0, At, B0); PG8_BAR; PG8_SCHED;
            PG8_STAGE(PG8_SB(0, 1), b2 + hstepB, voffB);
            PG8_WAIT_V(6); PG8_BAR; PG8_MMA(1, 1, At, B1); PG8_BAR;
            PG8_LDB(B0, 1, 0); PG8_SCHED; PG8_LDA(At, 1, 0); PG8_STAGE_A(PG8_SA(0, 1), a2, 1, last);
            PG8_WAIT_L(8); PG8_BAR; PG8_WAIT_L(0); PG8_MMA(0, 0, At, B0); PG8_BAR; PG8_SCHED;
            PG8_LDB(B1, 1, 1); PG8_STAGE(PG8_SB(1, 0), b3, voffB);
            PG8_BAR; PG8_WAIT_L(0); PG8_MMA(0, 1, At, B1); PG8_BAR;
            PG8_LDA(At, 1, 1); PG8_STAGE_A(PG8_SA(1, 0), a3, 0, last);
            PG8_BAR; PG8_WAIT_L(0); PG8_MMA(1, 0, At, B0); PG8_BAR; PG8_SCHED;
            PG8_STAGE(PG8_SB(1, 1), b3 + hstepB, voffB);
            PG8_WAIT_V(6); PG8_BAR; PG8_MMA(1, 1, At, B1); PG8_BAR;
            }
        }
        if constexpr (ALIGN_EPI) { if (wr == 0) PG8_BAR; }
        if constexpr (FP8) asm volatile("s_nop 15\n\ts_nop 15\n\ts_nop 7" ::: "memory");
        E(acc, cur, wr, wc, fr, fq);
        if (!has_next) break;
#pragma unroll
        for (int a = 0; a < 2; ++a)
#pragma unroll
            for (int b = 0; b < 2; ++b)
#pragma unroll
                for (int m = 0; m < 4; ++m)
#pragma unroll
                    for (int n = 0; n < 2; ++n) acc[a][b][m][n] = (f32x4){0.f, 0.f, 0.f, 0.f};
        cur = nxt; cA = nA; cB = nB; ++ui;
        if constexpr (GATHER) { _Pragma("unroll") for (int hh_ = 0; hh_ < 2; ++hh_) _Pragma("unroll") for (int i_ = 0; i_ < 2; ++i_) gvC[hh_][i_] = gvN[hh_][i_]; }
        if constexpr (ALIGN_EPI) { if (wr == 1) PG8_BAR; }
    }
    PG8_WAIT_V(0);
    if constexpr (!ALIGN_EPI) { if (wr == 0) PG8_BAR; }
    PG8_BAR;
#undef PG8_SA
#undef PG8_SB
#undef PG8_STAGE
#undef PG8_STAGE_A
#undef PG8_GV
#undef PG8_LDA
#undef PG8_LDB
#undef PG8_MMA
#undef PG8_WAIT_V
#undef PG8_WAIT_L
#undef PG8_BAR
#undef PG8_SCHED
}

struct SchedPlain : Order {
    static constexpr bool GATHER = false; __device__ __forceinline__ unsigned arow(const Unit&, int) const { return 0u; }
    unsigned A0, B0, at, bt;
    __device__ __forceinline__ bool next(int i, Unit& u) const { return next_mn(i, u); }
    __device__ __forceinline__ unsigned A(const Unit& u) const { return A0 + (unsigned)u.pm * at; }
    __device__ __forceinline__ unsigned B(const Unit& u) const { return B0 + (unsigned)u.pn * bt; }
};
struct SchedLora : Order {
    static constexpr bool GATHER = false; __device__ __forceinline__ unsigned arow(const Unit&, int) const { return 0u; }
    unsigned A0, B0; int skipv;
    __device__ __forceinline__ bool next(int i, Unit& u) const { if (!next_mn(i, u)) return false; if (skipv && u.pn >= 12) u.pn += 6; return true; }
    __device__ __forceinline__ unsigned A(const Unit& u) const { return A0 + (unsigned)u.pm * (256u * 512u * 2u) + (u.pn >= 18 ? 512u : 0u); }
    __device__ __forceinline__ unsigned B(const Unit& u) const { return B0 + (unsigned)u.pn * (256u * 256u * 2u); }
};
struct SchedMem {
    static constexpr bool GATHER = false; __device__ __forceinline__ unsigned arow(const Unit&, int) const { return 0u; }
    int G, c; unsigned memb, wkv;
    __device__ __forceinline__ bool next(int i, Unit& u) const {
        const int L = i * G + c; if (L >= 64) return false;
        if (L < 32) { u.z = 0; u.pm = L >> 1; u.pn = L & 1; } else { const int q = L - 32; u.z = 1; u.pm = q & 1; u.pn = q >> 1; }
        return true;
    }
    __device__ __forceinline__ unsigned A(const Unit& u) const { return u.z == 0 ? memb + (unsigned)u.pm * (256u * 2048u * 2u) : wkv + (unsigned)(2 + u.pm) * (256u * 2048u * 2u); }
    __device__ __forceinline__ unsigned B(const Unit& u) const { return u.z == 0 ? wkv + (unsigned)u.pn * (256u * 2048u * 2u) : memb + (unsigned)u.pn * (256u * 2048u * 2u); }
};
struct SchedMoE : Order {
    static constexpr bool GATHER = false; __device__ __forceinline__ unsigned arow(const Unit&, int) const { return 0u; }
    unsigned A0, B0, at, bt, be; const int* texp;
    __device__ __forceinline__ bool next(int i, Unit& u) const { if (!next_mn(i, u)) return false; u.z = __builtin_amdgcn_readfirstlane(texp[u.pm]); return true; }
    __device__ __forceinline__ unsigned A(const Unit& u) const { return A0 + (unsigned)u.pm * at; }
    __device__ __forceinline__ unsigned B(const Unit& u) const { return B0 + (unsigned)u.z * be + (unsigned)u.pn * bt; }
};

struct SchedMoEg : Order {
    static constexpr bool GATHER = true;
    unsigned B0, bt, be, xoff, zoff; const int* texp; const int* slot_tok;
    __device__ __forceinline__ bool next(int i, Unit& u) const { if (!next_mn(i, u)) return false; u.z = __builtin_amdgcn_readfirstlane(texp[u.pm]); return true; }
    __device__ __forceinline__ unsigned A(const Unit&) const { return 0u; }
    __device__ __forceinline__ unsigned B(const Unit& u) const { return B0 + (unsigned)u.z * be + (unsigned)u.pn * bt; }
    __device__ __forceinline__ unsigned arow(const Unit& u, int r) const { const int tok = slot_tok[u.pm * 256 + r]; return tok < 0 ? zoff : xoff + (unsigned)tok * 2048u; }
};

struct EpiBf16 {
    static constexpr bool PERM = true;
    bf16* O; int ldc;
    __device__ __forceinline__ void operator()(const f32x4 (&acc)[2][2][4][2], const Unit& u, int wr, int wc, int fr, int fq) const {
        const int row0 = u.pm * BM + wr * 64 + fr, col0 = u.pn * BM + wc * 32 + 8 * fq;
#pragma unroll
        for (int ai = 0; ai < 2; ++ai)
#pragma unroll
            for (int m = 0; m < 4; ++m) { bf16* rowp = O + (size_t)(row0 + ai * HALF + m * 16) * ldc + col0;
#pragma unroll
                for (int bj = 0; bj < 2; ++bj) { const f32x4 v0 = acc[ai][bj][m][0], v1 = acc[ai][bj][m][1];
                    u32x4 w; w.x = cvt_pk_bf16(v0[0], v0[1]); w.y = cvt_pk_bf16(v0[2], v0[3]); w.z = cvt_pk_bf16(v1[0], v1[1]); w.w = cvt_pk_bf16(v1[2], v1[3]);
                    *(u32x4*)(rowp + bj * HALF) = w; } }
    }
};
struct EpiMem {
    static constexpr bool PERM = true;
    bf16* O0; bf16* O1;
    __device__ __forceinline__ void operator()(const f32x4 (&acc)[2][2][4][2], const Unit& u, int wr, int wc, int fr, int fq) const {
        EpiBf16 e; e.O = u.z == 0 ? O0 : O1; e.ldc = u.z == 0 ? 512 : 4096; e(acc, u, wr, wc, fr, fq);
    }
};
struct EpiLora {
    static constexpr bool PERM = true;
    bf16* O; const float* vecs;
    __device__ __forceinline__ void operator()(const f32x4 (&acc)[2][2][4][2], const Unit& u, int wr, int wc, int fr, int fq) const {
        const int type = u.pn / 6;
        const int row0 = u.pm * BM + wr * 64 + fr, col0 = u.pn * BM + wc * 32 + 8 * fq, cb0 = (u.pn % 6) * BM + wc * 32 + 8 * fq;
        const float* bp = vecs + (type < 3 ? type : 0) * SW;
        const float sc = type == 0 ? 0.6065306597126334f : 1.0f;
#pragma unroll
        for (int bj = 0; bj < 2; ++bj) {
            f32x4 bv0 = (f32x4){0.f, 0.f, 0.f, 0.f}, bv1 = bv0;
            if (type < 3) { bv0 = *(const f32x4*)(bp + cb0 + bj * HALF); bv1 = *(const f32x4*)(bp + cb0 + bj * HALF + 4); }
#pragma unroll
            for (int ai = 0; ai < 2; ++ai)
#pragma unroll
                for (int m = 0; m < 4; ++m) { bf16* rowp = O + (size_t)(row0 + ai * HALF + m * 16) * 6144 + col0 + bj * HALF;
                    f32x4 v0_ = acc[ai][bj][m][0] + bv0, v1_ = acc[ai][bj][m][1] + bv1;
                    if (type < 3) {
#pragma unroll
                        for (int j = 0; j < 4; ++j) { v0_[j] = sc * sigmoidf_(v0_[j]); v1_[j] = sc * sigmoidf_(v1_[j]); } }
                    u32x4 w; w.x = cvt_pk_bf16(v0_[0], v0_[1]); w.y = cvt_pk_bf16(v0_[2], v0_[3]); w.z = cvt_pk_bf16(v1_[0], v1_[1]); w.w = cvt_pk_bf16(v1_[2], v1_[3]);
                    *(u32x4*)rowp = w; asm volatile("" ::: "memory"); }
        }
    }
};
struct EpiSwiglu {
    static constexpr bool PERM = true;
    bf16* O; int ldc;
    __device__ __forceinline__ void operator()(const f32x4 (&acc)[2][2][4][2], const Unit& u, int wr, int wc, int fr, int fq) const {
        const int row0 = u.pm * BM + wr * 64 + fr, col0 = u.pn * HALF + wc * 32 + 8 * fq;
#pragma unroll
        for (int ai = 0; ai < 2; ++ai)
#pragma unroll
            for (int m = 0; m < 4; ++m) { bf16* rowp = O + (size_t)(row0 + ai * HALF + m * 16) * ldc + col0;
                float h[8];
#pragma unroll
                for (int n = 0; n < 2; ++n)
#pragma unroll
                    for (int j = 0; j < 4; ++j) { const float g = acc[ai][0][m][n][j], up = acc[ai][1][m][n][j]; h[n * 4 + j] = g * sigmoidf_(g) * up; }
                u32x4 w; w.x = cvt_pk_bf16(h[0], h[1]); w.y = cvt_pk_bf16(h[2], h[3]); w.z = cvt_pk_bf16(h[4], h[5]); w.w = cvt_pk_bf16(h[6], h[7]);
                *(u32x4*)rowp = w; asm volatile("" ::: "memory"); }
    }
};
struct EpiSwiglu8 {
    static constexpr bool PERM = true;
    unsigned char* O; int ldc; float inv, so;
    __device__ __forceinline__ void operator()(const f32x4 (&acc)[2][2][4][2], const Unit& u, int wr, int wc, int fr, int fq) const {
        const int row0 = u.pm * BM + wr * 64 + fr, col0 = u.pn * HALF + wc * 32 + 8 * fq;
        const float c1 = -inv * 1.4426950408889634f, c2 = inv * inv * so;
#pragma unroll
        for (int ai = 0; ai < 2; ++ai)
#pragma unroll
            for (int m = 0; m < 4; ++m) { unsigned char* rowp = O + (size_t)(row0 + ai * HALF + m * 16) * ldc + col0;
                float h[8];
#pragma unroll
                for (int n = 0; n < 2; ++n)
#pragma unroll
                    for (int j = 0; j < 4; ++j) { const float ag = acc[ai][0][m][n][j], au = acc[ai][1][m][n][j];
                        h[n * 4 + j] = (ag * au) * __builtin_amdgcn_rcpf(1.0f + __builtin_amdgcn_exp2f(ag * c1)) * c2; }
                u32x2 w; w.x = pk4_fp8(h[0], h[1], h[2], h[3]); w.y = pk4_fp8(h[4], h[5], h[6], h[7]);
                *(u32x2*)rowp = w; asm volatile("" ::: "memory"); }
    }
};
struct EpiBf16S {
    static constexpr bool PERM = true;
    bf16* O; int ldc; float sc;
    __device__ __forceinline__ void operator()(const f32x4 (&acc)[2][2][4][2], const Unit& u, int wr, int wc, int fr, int fq) const {
        const int row0 = u.pm * BM + wr * 64 + fr, col0 = u.pn * BM + wc * 32 + 8 * fq;
#pragma unroll
        for (int ai = 0; ai < 2; ++ai)
#pragma unroll
            for (int m = 0; m < 4; ++m) { bf16* rowp = O + (size_t)(row0 + ai * HALF + m * 16) * ldc + col0;
#pragma unroll
                for (int bj = 0; bj < 2; ++bj) { const f32x4 v0 = acc[ai][bj][m][0] * sc, v1 = acc[ai][bj][m][1] * sc;
                    u32x4 w; w.x = cvt_pk_bf16(v0[0], v0[1]); w.y = cvt_pk_bf16(v0[2], v0[3]); w.z = cvt_pk_bf16(v1[0], v1[1]); w.w = cvt_pk_bf16(v1[2], v1[3]);
                    *(u32x4*)(rowp + bj * HALF) = w; } }
    }
};
struct EpiFp8S {
    static constexpr bool PERM = true;
    unsigned char* O; int ldc; float sc;
    __device__ __forceinline__ void operator()(const f32x4 (&acc)[2][2][4][2], const Unit& u, int wr, int wc, int fr, int fq) const {
        const int row0 = u.pm * BM + wr * 64 + fr, col0 = u.pn * BM + wc * 32 + 8 * fq;
#pragma unroll
        for (int ai = 0; ai < 2; ++ai)
#pragma unroll
            for (int m = 0; m < 4; ++m) { unsigned char* rowp = O + (size_t)(row0 + ai * HALF + m * 16) * ldc + col0;
#pragma unroll
                for (int bj = 0; bj < 2; ++bj) { const f32x4 v0 = acc[ai][bj][m][0] * sc, v1 = acc[ai][bj][m][1] * sc;
                    u32x2 w; w.x = pk4_fp8(v0[0], v0[1], v0[2], v0[3]); w.y = pk4_fp8(v1[0], v1[1], v1[2], v1[3]);
                    *(u32x2*)(rowp + bj * HALF) = w; } }
    }
};
struct EpiRes {
    static constexpr bool PERM = false;
    const float* X; float* T;
    __device__ __forceinline__ void operator()(const f32x4 (&acc)[2][2][4][2], const Unit& u, int wr, int wc, int fr, int fq) const {
        const int row0 = u.pm * BM + wr * 64 + fr, col0 = u.pn * BM + wc * 32 + 4 * fq;
#pragma unroll
        for (int ai = 0; ai < 2; ++ai)
#pragma unroll
            for (int m = 0; m < 4; ++m) { const size_t off = (size_t)(row0 + ai * HALF + m * 16) * D + col0;
#pragma unroll
                for (int bj = 0; bj < 2; ++bj)
#pragma unroll
                    for (int n = 0; n < 2; ++n) { const f32x4 xv = *(const f32x4*)(X + off + bj * HALF + n * 16);
                        *(f32x4*)(T + off + bj * HALF + n * 16) = xv * ALPHA + acc[ai][bj][m][n]; } }
    }
};
}

struct Args {
    const float* in[43];
    float* out; unsigned char* ws;
    int ph_lo, ph_hi;
};
struct Ctx { LAS unsigned char* lds; int tid, lane, wave, bid, G, gw, NGW; unsigned char* ws; };

enum { I_X = 0, I_MEM = 1, I_POS = 2, I_WKV = 3,
       L0_WIN = 4, L0_MU, L0_LW, L0_LA, L0_LG, L0_VECS, L0_WOUT, L0_NORMS, L0_FG, L0_FU, L0_FD,
       L1_WIN = 15, L1_GN, L1_WOUT, L1_NORMS, L1_ROUTER, L1_MG, L1_MU_, L1_MD,
       L2_WIN = 23, L2_MU, L2_LW, L2_LA, L2_LV, L2_LG, L2_VECS, L2_WOUT, L2_NORMS, L2_FG, L2_FU, L2_FD,
       L3_WIN = 35, L3_GN, L3_WOUT, L3_NORMS, L3_ROUTER, L3_MG, L3_MU_, L3_MD };

__device__ __forceinline__ void tr_load(f32x4 (&v)[8], const float* W, int ldw, int k0, int n0, int lane) {
#pragma unroll
    for (int i = 0; i < 8; ++i) v[i] = *(const f32x4*)(W + (size_t)(k0 + 8 * i + (lane >> 3)) * ldw + n0 + 4 * (lane & 7));
}
__device__ __forceinline__ void tr_store(const f32x4 (&v)[8], int k0, bf16* WT, int ldt, int drow0, LAS float* scr, int lane) {
#pragma unroll
    for (int i = 0; i < 8; ++i) { LAS float* d = scr + (8 * i + (lane >> 3)) * 33 + 4 * (lane & 7); d[0] = v[i][0]; d[1] = v[i][1]; d[2] = v[i][2]; d[3] = v[i][3]; }
    LDS_WAIT(); asm volatile("" ::: "memory");
    const int c = lane & 7;
#pragma unroll
    for (int j = 0; j < 4; ++j) { const int n = (lane >> 3) + 8 * j; const LAS float* s = scr + (8 * c) * 33 + n;
        u32x4 o; o.x = cvt_pk_bf16(s[0 * 33], s[1 * 33]); o.y = cvt_pk_bf16(s[2 * 33], s[3 * 33]); o.z = cvt_pk_bf16(s[4 * 33], s[5 * 33]); o.w = cvt_pk_bf16(s[6 * 33], s[7 * 33]);
        *(u32x4*)(WT + (size_t)(drow0 + n) * ldt + k0 + 8 * c) = o; }
    LDS_WAIT(); asm volatile("" ::: "memory");
}
__device__ __forceinline__ void conv_mat(const Ctx& C, const float* W, int K, int N, bf16* WT, int mode, int off, int gw0) {
    LAS float* scr = (LAS float*)(C.lds + C.wave * 16384);
    const int nblk = N / 32, items = (K / 64) * nblk;
    int start = C.gw - gw0; if (start < 0) start += C.NGW;
#define CONV_DROW(n0_) (mode == 0 ? off + (n0_) : ((n0_) / 128) * 256 + off + ((n0_) % 128))
    f32x4 va[8], vb[8];
    int it = start;
    if (it < items) tr_load(va, W, N, 64 * (it / nblk), 32 * (it % nblk), C.lane);
    while (it < items) {
        const int it1 = it + C.NGW;
        if (it1 < items) tr_load(vb, W, N, 64 * (it1 / nblk), 32 * (it1 % nblk), C.lane);
        tr_store(va, 64 * (it / nblk), WT, K, CONV_DROW(32 * (it % nblk)), scr, C.lane);
        if (it1 >= items) break;
        const int it2 = it1 + C.NGW;
        if (it2 < items) tr_load(va, W, N, 64 * (it2 / nblk), 32 * (it2 % nblk), C.lane);
        tr_store(vb, 64 * (it1 / nblk), WT, K, CONV_DROW(32 * (it1 % nblk)), scr, C.lane);
        it = it2;
    }
#undef CONV_DROW
}
__device__ __forceinline__ void conv_lora(const Ctx& C, const float* lw, const float* la, const float* lv, const float* lg, bf16* Bt) {
    for (int idx = C.bid * NTHR + C.tid; idx < 6144 * 256; idx += C.G * NTHR) {
        const int n_ = idx % 1536, rest = idx / 1536, k = rest % 256, blk = rest / 256;
        float v = 0.f;
        if (blk == 0) { if (k < 96) v = lw[k * 1536 + n_]; }
        else if (blk == 1) { if (k >= 96 && k < 192) v = la[(k - 96) * 1536 + n_]; }
        else if (blk == 2) { if (lv && k >= 192) v = lv[(k - 192) * 1536 + n_]; }
        else v = lg[k * 1536 + n_];
        Bt[(size_t)(blk * 1536 + n_) * 256 + k] = f2bf(v);
    }
}
__device__ __forceinline__ void conv_f32_bf16(const Ctx& C, const float* src, bf16* dst, size_t n8) {
    const size_t T = (size_t)C.G * NTHR;
    for (size_t i0 = (size_t)C.bid * NTHR + C.tid; i0 < n8; i0 += 4 * T) { f32x4 av[4], bv[4];
#pragma unroll
        for (int q = 0; q < 4; ++q) { av[q] = ((const f32x4*)src)[2 * (i0 + q * T)]; bv[q] = ((const f32x4*)src)[2 * (i0 + q * T) + 1]; }
#pragma unroll
        for (int q = 0; q < 4; ++q) { const f32x4 a = av[q], b = bv[q];
            u32x4 w; w.x = cvt_pk_bf16(a[0], a[1]); w.y = cvt_pk_bf16(a[2], a[3]); w.z = cvt_pk_bf16(b[0], b[1]); w.w = cvt_pk_bf16(b[2], b[3]);
            ((u32x4*)dst)[i0 + q * T] = w; } }
}

struct CvJob { const float* W; bf16* WT; int N, K, k0, n0, mode, off; float f8s; };
__device__ __forceinline__ void cv_load(f32x4 (&v)[8], const CvJob& J, int wave, int lane) {
    const int n = J.n0 + 4 * lane;
#pragma unroll
    for (int i = 0; i < 8; ++i) { v[i] = (f32x4){0.f, 0.f, 0.f, 0.f}; if (n < J.N) v[i] = *(const f32x4*)(J.W + (size_t)(J.k0 + 8 * wave + i) * J.N + n); }
}
__device__ __forceinline__ void cv_put(const f32x4 (&v)[8], LAS float* T, int wave, int lane) {
#pragma unroll
    for (int i = 0; i < 8; ++i) *(LAS f32x4*)(T + (8 * wave + i) * 256 + 4 * (lane ^ wave)) = v[i];
}
__device__ __forceinline__ void cv_out(const CvJob& J, const LAS float* T, int wave, int lane) {
    const int c = lane & 7;
#pragma unroll
    for (int j = 0; j < 4; ++j) { const int nl = 32 * wave + 8 * j + (lane >> 3), n = J.n0 + nl; const LAS float* s = T + (8 * c) * 256 + (nl ^ (c << 2));
        u32x4 o; o.x = cvt_pk_bf16(s[0 * 256], s[1 * 256]); o.y = cvt_pk_bf16(s[2 * 256], s[3 * 256]); o.z = cvt_pk_bf16(s[4 * 256], s[5 * 256]); o.w = cvt_pk_bf16(s[6 * 256], s[7 * 256]);
        if (n < J.N) { const int drow = J.mode == 0 ? J.off + n : (n / 128) * 256 + J.off + (n % 128);
            *(u32x4*)(J.WT + (size_t)drow * J.K + J.k0 + 8 * c) = o; } }
}
__device__ __forceinline__ void cv_out8(const CvJob& J, const LAS float* T, int wave, int lane) {
    const int c4 = lane & 3; unsigned char* W8 = (unsigned char*)J.WT;
#pragma unroll
    for (int j = 0; j < 2; ++j) { const int nl = 32 * wave + 16 * j + (lane >> 2), n = J.n0 + nl;
        float v[16];
#pragma unroll
        for (int q = 0; q < 16; ++q) { const int k = 16 * c4 + q; v[q] = T[k * 256 + (nl ^ (((k >> 3) & 7) << 2))] * J.f8s; }
        u32x4 o; o.x = pk4_fp8(v[0], v[1], v[2], v[3]); o.y = pk4_fp8(v[4], v[5], v[6], v[7]); o.z = pk4_fp8(v[8], v[9], v[10], v[11]); o.w = pk4_fp8(v[12], v[13], v[14], v[15]);
        if (n < J.N) { const int drow = J.mode == 0 ? J.off + n : (n / 128) * 256 + J.off + (n % 128);
            *(u32x4*)(W8 + (size_t)drow * J.K + J.k0 + 16 * c4) = o; } }
}
template <class Dec>
__device__ __forceinline__ void conv_run(const Ctx& C, int ntiles, const Dec& dec, const int t0 = -1, const int STR = GRID) {
    LAS float* T = (LAS float*)C.lds;
    f32x4 va[8], vb[8]; CvJob ja, jb, jc;
    int t = t0 < 0 ? C.bid : t0;
    if (t < ntiles) { dec(t, ja); cv_load(va, ja, C.wave, C.lane); }
    if (t + STR < ntiles) { dec(t + STR, jb); cv_load(vb, jb, C.wave, C.lane); }
    while (t < ntiles) {
        __syncthreads(); cv_put(va, T, C.wave, C.lane); jc = ja;
        if (t + 2 * STR < ntiles) { dec(t + 2 * STR, ja); cv_load(va, ja, C.wave, C.lane); }
        __syncthreads(); if (jc.f8s > 0.f) cv_out8(jc, T, C.wave, C.lane); else cv_out(jc, T, C.wave, C.lane);
        t += STR; if (t >= ntiles) break;
        __syncthreads(); cv_put(vb, T, C.wave, C.lane); jc = jb;
        if (t + 2 * STR < ntiles) { dec(t + 2 * STR, jb); cv_load(vb, jb, C.wave, C.lane); }
        __syncthreads(); if (jc.f8s > 0.f) cv_out8(jc, T, C.wave, C.lane); else cv_out(jc, T, C.wave, C.lane);
        t += STR;
    }
    __syncthreads();
}
struct MoeDec { const float* mg; const float* mu; const float* md; unsigned char* ws;
    __device__ __forceinline__ void operator()(int t, CvJob& J) const {
        const int j = t / 704, r = t % 704, e = j / 3, kind = j % 3;
        if (kind < 2) { J.W = (kind == 0 ? mg : mu) + (size_t)e * 2048 * 5632; J.WT = (bf16*)(ws + WS_MWGU + (size_t)e * 22 * MiB); J.N = 5632; J.K = 2048; J.mode = 1; J.off = kind * 128; J.f8s = 1024.f; J.k0 = 64 * (r / 22); J.n0 = 256 * (r % 22); }
        else { J.W = md + (size_t)e * 2048 * 5632; J.WT = (bf16*)(ws + WS_MWD + (size_t)e * 11 * MiB); J.N = 2048; J.K = 5632; J.mode = 0; J.off = 0; J.f8s = 2048.f; J.k0 = 64 * (r / 8); J.n0 = 256 * (r % 8); }
    } };
struct StaticDec { const float* const* in; unsigned char* ws;
    __device__ __forceinline__ void set(CvJob& J, const float* W, bf16* WT, int K, int N, int mode, int off, int r, float f8s = 0.f) const {
        const int nn = (N + 255) / 256; J.W = W; J.WT = WT; J.N = N; J.K = K; J.mode = mode; J.off = off; J.f8s = f8s; J.k0 = 64 * (r / nn); J.n0 = 256 * (r % nn); }
    __device__ __forceinline__ void operator()(int t, CvJob& J) const {
        int r = t;
        if (r < 128) { set(J, in[I_WKV], (bf16*)(ws + WS_WKV), 2048, 1024, 0, 0, r); return; } r -= 128;
        set(J, in[L0_WIN], (bf16*)(ws + WS_WIN), 2048, 5568, 0, 0, r);
    } };

struct SlotDec { const float* const* in; unsigned char* ws; int lq; MoeDec moe; StaticDec sd;
    __device__ __forceinline__ void operator()(int t, CvJob& J) const {
        if (t < 16896) { moe(t, J); return; }
        int r = t - 16896; const size_t l = (size_t)lq;
        if (r < 704) { sd.set(J, lq ? in[L2_FG] : in[L0_FG], (bf16*)(ws + WS_WFGU + l * 44 * MiB), 2048, 5632, 1, 0, r, 1024.f); return; } r -= 704;
        if (r < 704) { sd.set(J, lq ? in[L2_FU] : in[L0_FU], (bf16*)(ws + WS_WFGU + l * 44 * MiB), 2048, 5632, 1, 128, r, 1024.f); return; } r -= 704;
        if (r < 704) { sd.set(J, lq ? in[L2_FD] : in[L0_FD], (bf16*)(ws + WS_WFD + l * 22 * MiB), 5632, 2048, 0, 0, r, 2048.f); return; } r -= 704;
        if (r < 256) { sd.set(J, lq ? in[L2_WOUT] : in[L0_WOUT], (bf16*)(ws + WS_WOUT + l * 16 * MiB), 2048, 2048, 0, 0, r); return; } r -= 256;
        if (r < 256) { sd.set(J, lq ? in[L3_WOUT] : in[L1_WOUT], (bf16*)(ws + WS_WOUT + (l * 16 + 8) * MiB), 2048, 2048, 0, 0, r); return; } r -= 256;
        if (r < 640) { sd.set(J, lq ? in[L3_WIN] : in[L1_WIN], (bf16*)(ws + WS_WIN + (l * 44 + 22) * MiB), 2048, 5120, 0, 0, r); return; } r -= 640;
        sd.set(J, in[L2_WIN], (bf16*)(ws + WS_WIN + (size_t)44 * MiB), 2048, 5632, 0, 0, r);
    } };

__device__ __forceinline__ void ph_prologue(const Ctx& C, const Args& A) {
    unsigned char* ws = C.ws;
    { StaticDec dec; dec.in = A.in; dec.ws = ws; conv_run(C, 832, dec); }
    conv_lora(C, A.in[L0_LW], A.in[L0_LA], nullptr, A.in[L0_LG], (bf16*)(ws + WS_WLORA));
    conv_lora(C, A.in[L2_LW], A.in[L2_LA], A.in[L2_LV], A.in[L2_LG], (bf16*)(ws + WS_WLORA + 3 * MiB));
    { u32x4* z = (u32x4*)(ws + WS_WIN + (size_t)5568 * 2048 * 2);
      for (int i = C.bid * NTHR + C.tid; i < 64 * 2048 * 2 / 16; i += C.G * NTHR) z[i] = (u32x4){0u, 0u, 0u, 0u}; }
    { const f32x4* xs = (const f32x4*)A.in[I_X]; u32x2* hi = (u32x2*)(ws + WS_XB); unsigned* lo = (unsigned*)(ws + WS_XLO);
      const size_t T = (size_t)C.G * NTHR;
      for (size_t i0 = (size_t)C.bid * NTHR + C.tid; i0 < (size_t)M * D / 4; i0 += 8 * T) { f32x4 ov[8];
#pragma unroll
          for (int q = 0; q < 8; ++q) ov[q] = xs[i0 + q * T];
#pragma unroll
          for (int q = 0; q < 8; ++q) { const f32x4 o = ov[q]; const size_t i = i0 + q * T;
              u32x2 w; w.x = cvt_pk_bf16(o[0], o[1]); w.y = cvt_pk_bf16(o[2], o[3]); hi[i] = w;
              lo[i] = pk4_fp8((o[0] - bflo(w.x)) * 8192.f, (o[1] - bfhi(w.x)) * 8192.f, (o[2] - bflo(w.y)) * 8192.f, (o[3] - bfhi(w.y)) * 8192.f); } } }
    conv_f32_bf16(C, A.in[I_MEM], (bf16*)(ws + WS_MEMB), (size_t)4096 * 2048 / 8);
    { const int* pos = (const int*)A.in[I_POS]; f32x2* cs = (f32x2*)(ws + WS_CS);
      for (int idx = C.bid * NTHR + C.tid; idx < M * 64; idx += C.G * NTHR) {
          const int m = idx >> 6, i = idx & 63;
          const float pw = (float)exp2(13.287712379549449 * (double)i / 64.0);
          const float inv = 1.0f / pw;
          const float ang = (float)pos[m] * inv;
          const double x = (double)ang;
          const double n = rint(x * 0.15915494309189535);
          const double r = fma(-n, 6.283185307179586, x) - n * 2.4492935982947064e-16;
          const double r2 = r * r;
          double s = -1.0 / 121645100408832000.0;
          s = fma(s, r2, 1.0 / 355687428096000.0);
          s = fma(s, r2, -1.0 / 1307674368000.0);
          s = fma(s, r2, 1.0 / 6227020800.0);
          s = fma(s, r2, -1.0 / 39916800.0);
          s = fma(s, r2, 1.0 / 362880.0);
          s = fma(s, r2, -1.0 / 5040.0);
          s = fma(s, r2, 1.0 / 120.0);
          s = fma(s, r2, -1.0 / 6.0);
          s = fma(s * r2, r, r);
          double c = 1.0 / 2432902008176640000.0;
          c = fma(c, r2, -1.0 / 6402373705728000.0);
          c = fma(c, r2, 1.0 / 20922789888000.0);
          c = fma(c, r2, -1.0 / 87178291200.0);
          c = fma(c, r2, 1.0 / 479001600.0);
          c = fma(c, r2, -1.0 / 3628800.0);
          c = fma(c, r2, 1.0 / 40320.0);
          c = fma(c, r2, -1.0 / 720.0);
          c = fma(c, r2, 1.0 / 24.0);
          c = fma(c, r2, -0.5);
          c = fma(c, r2, 1.0);
          cs[idx] = (f32x2){(float)c, (float)s};
      } }
}

struct LnRow { u32x2 rh[8]; unsigned rl[8]; u32x2 a[8]; float w1, w2; };
__device__ __forceinline__ void ln_load(LnRow& R, const Ctx& C, int m, const void* Hp, int hmode, int s1, int s2, float w1, float w2) {
    const u32x2* hr = (const u32x2*)(C.ws + WS_XB + (size_t)m * D * 2) + C.lane;
    const unsigned* lr = (const unsigned*)(C.ws + (hmode == 0 ? WS_XLO : WS_X8) + (size_t)m * D) + C.lane;
#pragma unroll
    for (int j = 0; j < 8; ++j) { R.rh[j] = hr[64 * j]; R.rl[j] = lr[64 * j]; }
    if (hmode == 0) {
        const u32x2* ar = (const u32x2*)((const bf16*)Hp + (size_t)m * D) + C.lane;
#pragma unroll
        for (int j = 0; j < 8; ++j) R.a[j] = ar[64 * j];
        R.w1 = 1.f; R.w2 = 0.f;
    } else if (hmode == 1) {
        const unsigned* ar = (const unsigned*)((const unsigned char*)Hp + (size_t)m * D) + C.lane;
#pragma unroll
        for (int j = 0; j < 8; ++j) { R.a[j].x = ar[64 * j]; R.a[j].y = 0u; }
        R.w1 = 1.f / 256.f; R.w2 = 0.f;
    } else {
        R.w1 = w1; R.w2 = w2;
        const unsigned* y1 = (const unsigned*)((const unsigned char*)Hp + (size_t)s1 * D) + C.lane;
        const unsigned* y2 = (const unsigned*)((const unsigned char*)Hp + (size_t)s2 * D) + C.lane;
#pragma unroll
        for (int j = 0; j < 8; ++j) { R.a[j].x = y1[64 * j]; R.a[j].y = y2[64 * j]; }
    }
}
__device__ __forceinline__ void ln_row(const LnRow& R, const Ctx& C, int m, const float* gain, const float* bias, int hmode, float* Xf32out, unsigned char* X8out,
                                       LAS float* rw, LAS int* hist, bool do_route) {
    const int l4 = 4 * C.lane;
    f32x4 v[8]; float s = 0.f;
#pragma unroll
    for (int j = 0; j < 8; ++j) { f32x4 f, x;
        const f32x2 l01 = __builtin_amdgcn_cvt_pk_f32_fp8(R.rl[j], false), l23 = __builtin_amdgcn_cvt_pk_f32_fp8(R.rl[j], true);
        const float ls = hmode == 0 ? (1.f / 8192.f) : (1.f / 16.f);
        x[0] = bflo(R.rh[j].x) + l01[0] * ls; x[1] = bfhi(R.rh[j].x) + l01[1] * ls; x[2] = bflo(R.rh[j].y) + l23[0] * ls; x[3] = bfhi(R.rh[j].y) + l23[1] * ls;
        if (hmode == 0) { f[0] = bflo(R.a[j].x); f[1] = bfhi(R.a[j].x); f[2] = bflo(R.a[j].y); f[3] = bfhi(R.a[j].y); }
        else { const f32x2 a01 = __builtin_amdgcn_cvt_pk_f32_fp8(R.a[j].x, false), a23 = __builtin_amdgcn_cvt_pk_f32_fp8(R.a[j].x, true);
            f[0] = R.w1 * a01[0]; f[1] = R.w1 * a01[1]; f[2] = R.w1 * a23[0]; f[3] = R.w1 * a23[1];
            if (hmode == 2) { const f32x2 b01 = __builtin_amdgcn_cvt_pk_f32_fp8(R.a[j].y, false), b23 = __builtin_amdgcn_cvt_pk_f32_fp8(R.a[j].y, true);
                f[0] += R.w2 * b01[0]; f[1] += R.w2 * b01[1]; f[2] += R.w2 * b23[0]; f[3] += R.w2 * b23[1]; } }
        v[j] = x * ALPHA + f; s += (v[j][0] + v[j][1]) + (v[j][2] + v[j][3]); }
    const float mean = wave_sum(s) * (1.f / D); float s2 = 0.f;
#pragma unroll
    for (int j = 0; j < 8; ++j) { v[j] = v[j] - mean; s2 += (v[j][0] * v[j][0] + v[j][1] * v[j][1]) + (v[j][2] * v[j][2] + v[j][3] * v[j][3]); }
    const float rstd = 1.0f / sqrtf(wave_sum(s2) * (1.f / D) + LN_EPS);
    float lg[8];
#pragma unroll
    for (int e = 0; e < 8; ++e) lg[e] = 0.f;
    u32x2* ho = (u32x2*)(C.ws + WS_XB + (size_t)m * D * 2) + C.lane;
    unsigned* lo = (unsigned*)(C.ws + WS_XLO + (size_t)m * D) + C.lane;
#pragma unroll
    for (int j = 0; j < 8; ++j) {
        const f32x4 gv = *((const f32x4*)(gain + 256 * j + l4)), bv = *((const f32x4*)(bias + 256 * j + l4));
        const f32x4 o = v[j] * rstd * gv + bv;
        if (Xf32out) ((f32x4*)(Xf32out + (size_t)m * D))[64 * j + C.lane] = o;
        else if (X8out) {
            const unsigned p8 = pk4_fp8(o[0] * 16.f, o[1] * 16.f, o[2] * 16.f, o[3] * 16.f);
            ((unsigned*)(X8out + (size_t)m * D))[64 * j + C.lane] = p8;
            const f32x2 d01 = __builtin_amdgcn_cvt_pk_f32_fp8(p8, false), d23 = __builtin_amdgcn_cvt_pk_f32_fp8(p8, true);
            u32x2 w; w.x = cvt_pk_bf16(o[0] - d01[0] * (1.f / 16.f), o[1] - d01[1] * (1.f / 16.f)); w.y = cvt_pk_bf16(o[2] - d23[0] * (1.f / 16.f), o[3] - d23[1] * (1.f / 16.f)); ho[64 * j] = w; }
        else { u32x2 w; w.x = cvt_pk_bf16(o[0], o[1]); w.y = cvt_pk_bf16(o[2], o[3]); ho[64 * j] = w;
            lo[64 * j] = pk4_fp8((o[0] - bflo(w.x)) * 8192.f, (o[1] - bfhi(w.x)) * 8192.f, (o[2] - bflo(w.y)) * 8192.f, (o[3] - bfhi(w.y)) * 8192.f); }
        if (do_route) {
#pragma unroll
            for (int e = 0; e < 8; ++e) { const f32x4 we = *(const LAS f32x4*)(rw + e * 2048 + 256 * j + l4);
                lg[e] += (o[0] * we[0] + o[1] * we[1]) + (o[2] * we[2] + o[3] * we[3]); }
        }
    }
    if (do_route) {
#pragma unroll
        for (int e = 0; e < 8; ++e) lg[e] = wave_sum(lg[e]);
        int e1 = 0; float v1 = lg[0];
#pragma unroll
        for (int e = 1; e < 8; ++e) if (lg[e] > v1) { v1 = lg[e]; e1 = e; }
        int e2 = -1; float v2 = -3.0e38f;
#pragma unroll
        for (int e = 0; e < 8; ++e) if (e != e1 && lg[e] > v2) { v2 = lg[e]; e2 = e; }
        const float ex = __expf(v2 - v1); const float w1 = 1.0f / (1.0f + ex), w2 = ex / (1.0f + ex);
        if (C.lane == 0) { f32x4 rt; rt[0] = __int_as_float(e1 | (e2 << 8)); rt[1] = w1; rt[2] = w2; rt[3] = 0.f; ((f32x4*)(C.ws + WS_ROUTE))[m] = rt;
            atomicAdd((int*)&hist[e1], 1); atomicAdd((int*)&hist[e2], 1); }
    }
}
__device__ __forceinline__ void ph_ln(const Ctx& C, const void* Hp, int hmode, const float* gain, const float* bias, float* Xf32out, unsigned char* X8out,
                                      const float* router, bool do_route) {
    unsigned char* ws = C.ws;
    LAS float* rw = (LAS float*)C.lds;
    LAS int* hist = (LAS int*)(C.lds + LDS_MISC + 64);
    if (do_route) {
        for (int col = C.tid; col < 2048; col += NTHR) { const f32x4 a = ((const f32x4*)router)[2 * col], b = ((const f32x4*)router)[2 * col + 1];
            rw[0 * 2048 + col] = a[0]; rw[1 * 2048 + col] = a[1]; rw[2 * 2048 + col] = a[2]; rw[3 * 2048 + col] = a[3]; rw[4 * 2048 + col] = b[0]; rw[5 * 2048 + col] = b[1]; rw[6 * 2048 + col] = b[2]; rw[7 * 2048 + col] = b[3]; }
        if (C.tid < 8) hist[C.tid] = 0;
        int* st = (int*)(ws + WS_SLOTTOK);
        for (int i = C.bid * NTHR + C.tid; i < NSLOT; i += C.G * NTHR) st[i] = -1;
        __syncthreads();
    }
    const int m0 = C.bid * 128 + C.wave * 16;
    LnRow Ra, Rb;
    int s1v = 0, s2v = 0, w1v = 0, w2v = 0;
    if (hmode == 2) { const int mr = m0 + (C.lane & 15); const f32x4 rt = ((const f32x4*)(ws + WS_ROUTE))[mr];
        s1v = ((const int*)(ws + WS_SLOT1))[mr]; s2v = ((const int*)(ws + WS_SLOT2))[mr]; w1v = __float_as_int(rt[1] * (1.f / 256.f)); w2v = __float_as_int(rt[2] * (1.f / 256.f)); }
#define LN_LOAD(R_, r_) ln_load(R_, C, m0 + (r_), Hp, hmode, __builtin_amdgcn_readlane(s1v, (r_)), __builtin_amdgcn_readlane(s2v, (r_)), __int_as_float(__builtin_amdgcn_readlane(w1v, (r_))), __int_as_float(__builtin_amdgcn_readlane(w2v, (r_))))
    LN_LOAD(Ra, 0);
#pragma unroll 1
    for (int r = 0; r < 16; r += 2) {
        LN_LOAD(Rb, r + 1);
        ln_row(Ra, C, m0 + r, gain, bias, hmode, Xf32out, X8out, rw, hist, do_route);
        if (r + 2 < 16) LN_LOAD(Ra, r + 2);
        ln_row(Rb, C, m0 + r + 1, gain, bias, hmode, Xf32out, X8out, rw, hist, do_route);
    }
#undef LN_LOAD
    if (do_route) { __syncthreads(); if (C.tid < 8) ((int*)(ws + WS_CTL))[CW_CNT + C.bid * 8 + C.tid] = hist[C.tid]; }
}

__device__ __forceinline__ void ph_slots(const Ctx& C) {
    unsigned char* ws = C.ws;
    LAS int* sm = (LAS int*)(C.lds + LDS_MISC + 128);
    const int* cnt = (const int*)(ws + WS_CTL) + CW_CNT;
    if (C.tid < 8) { int tot = 0, mine = 0; for (int b = 0; b < C.G; ++b) { const int c = cnt[b * 8 + C.tid]; if (b < C.bid) mine += c; tot += c; } sm[C.tid] = tot; sm[8 + C.tid] = mine; }
    __syncthreads();
    if (C.tid == 0) { int base = 0; for (int e = 0; e < 8; ++e) { sm[16 + e] = base; base += (sm[e] + 255) & ~255; } sm[24] = base >> 8; }
    __syncthreads();
    if (C.wave == 0) {
        int off[8];
#pragma unroll
        for (int e = 0; e < 8; ++e) off[e] = sm[16 + e] + sm[8 + e];
        const unsigned long long lt = (1ull << C.lane) - 1ull;
        for (int it = 0; it < 2; ++it) {
            const int m = C.bid * 128 + it * 64 + C.lane;
            const int ee = __float_as_int(((const f32x4*)(ws + WS_ROUTE))[m][0]); const int e1 = ee & 0xff, e2 = (ee >> 8) & 0xff;
            int s1 = 0, s2 = 0;
#pragma unroll
            for (int e = 0; e < 8; ++e) { const unsigned long long m1 = __ballot(e1 == e), m2 = __ballot(e2 == e);
                const int c1 = __popcll(m1), c2 = __popcll(m2);
                if (e1 == e) s1 = off[e] + __popcll(m1 & lt);
                if (e2 == e) s2 = off[e] + c1 + __popcll(m2 & lt);
                off[e] += c1 + c2; }
            ((int*)(ws + WS_SLOT1))[m] = s1; ((int*)(ws + WS_SLOT2))[m] = s2;
            int* st = (int*)(ws + WS_SLOTTOK); st[s1] = m; st[s2] = m;
        }
    }
    if (C.bid == 0) {
        int* ctl = (int*)(ws + WS_CTL);
        if (C.tid == 0) ctl[CW_NT] = sm[24];
        if (C.tid < 264) { int e = 0;
#pragma unroll
            for (int q = 1; q < 8; ++q) if (C.tid >= (sm[16 + q] >> 8)) e = q;
            ctl[CW_TEXP + C.tid] = e; }
    }
}
__device__ __forceinline__ void ph_gather(const Ctx& C) {
    unsigned char* ws = C.ws;
    const int* st = (const int*)(ws + WS_SLOTTOK); const u32x4* xb = (const u32x4*)(ws + WS_XB); u32x4* xp = (u32x4*)(ws + WS_XPERM);
    for (int s = C.gw; s < NSLOT; s += C.NGW) { const int tok = st[s];
#pragma unroll
        for (int j = 0; j < 2; ++j) { u32x4 v = xb[(size_t)(tok < 0 ? 0 : tok) * 128 + j * 64 + C.lane]; const unsigned k = tok < 0 ? 0u : 0xffffffffu; v.x &= k; v.y &= k; v.z &= k; v.w &= k; xp[(size_t)s * 128 + j * 64 + C.lane] = v; } }
}
__device__ __forceinline__ void ph_moe_wconv(const Ctx& C, const float* mg, const float* mu, const float* md, const float* const* in, int lq) {
    SlotDec dec; dec.in = in; dec.ws = C.ws; dec.lq = lq; dec.moe.mg = mg; dec.moe.mu = mu; dec.moe.md = md; dec.moe.ws = C.ws; dec.sd.in = in; dec.sd.ws = C.ws;
    conv_run(C, lq ? 20160 : 20864, dec, C.bid - 192, 64);
}

__device__ __forceinline__ void ph_memattn(const Ctx& C, const bf16* P, int ldp, int qm0) {
    unsigned char* ws = C.ws;
    const bf16* memK = (const bf16*)(ws + WS_MEMK); const bf16* memVT = (const bf16*)(ws + WS_MEMVT); bf16* mix = (bf16*)(ws + WS_MIX);
    const int g = C.lane >> 4, r16 = C.lane & 15;
    LAS unsigned char* LK = C.lds; LAS unsigned char* LV = C.lds + 65536;
    const int b = C.bid >> 4, hm = (C.bid >> 2) & 3, qb = C.bid & 3;
    __syncthreads();
    {   u32x4 st[16];
#pragma unroll
        for (int i = 0; i < 8; ++i) { const int q = C.tid + 512 * i, row = q >> 4, pc = q & 15;
            st[i] = *(const u32x4*)(memK + (size_t)(b * 256 + row) * 512 + hm * 128 + pc * 8); }
#pragma unroll
        for (int i = 0; i < 8; ++i) { const int q = C.tid + 512 * i, row = q >> 5, pc = q & 31;
            st[8 + i] = *(const u32x4*)(memVT + (size_t)(hm * 128 + row) * 4096 + b * 256 + pc * 8); }
#pragma unroll
        for (int i = 0; i < 8; ++i) { const int q = C.tid + 512 * i, row = q >> 4, pc = q & 15;
            *(LAS u32x4*)(LK + row * 256 + ((pc ^ (row & 15)) * 16)) = st[i]; }
#pragma unroll
        for (int i = 0; i < 8; ++i) { const int q = C.tid + 512 * i, row = q >> 5, pc = q & 31;
            *(LAS u32x4*)(LV + row * 512 + ((pc ^ (row & 15)) * 16)) = st[8 + i]; }
    }
    __syncthreads();
    for (int qt = 0; qt < 4; ++qt) {
        const int m0 = b * SEQ + qb * 512 + C.wave * 64 + qt * 16;
        bf16x8 qf[4];
#pragma unroll
        for (int s = 0; s < 4; ++s) qf[s] = *(const bf16x8*)(P + (size_t)(m0 + r16) * ldp + qm0 + hm * 128 + 32 * s + 8 * g);
        f32x4 sacc[16];
#pragma unroll
        for (int kt = 0; kt < 16; ++kt) { sacc[kt] = (f32x4){0.f, 0.f, 0.f, 0.f};
#pragma unroll
            for (int s = 0; s < 4; ++s) { const bf16x8 kf = *(const LAS bf16x8*)(LK + (16 * kt + r16) * 256 + (((4 * s + g) ^ r16) * 16));
                sacc[kt] = __builtin_amdgcn_mfma_f32_16x16x32_bf16(kf, qf[s], sacc[kt], 0, 0, 0); } }
        float mx = -3.0e38f;
#pragma unroll
        for (int kt = 0; kt < 16; ++kt)
#pragma unroll
            for (int j = 0; j < 4; ++j) mx = fmaxf(mx, sacc[kt][j]);
        mx = fmaxf(mx, shx(mx, C.lane, 16)); mx = fmaxf(mx, shx(mx, C.lane, 32));
        const float sc = 0.08838834764831845f * 1.4426950408889634f;
        float sum = 0.f;
#pragma unroll
        for (int kt = 0; kt < 16; ++kt)
#pragma unroll
            for (int j = 0; j < 4; ++j) { const float pv = exp2f((sacc[kt][j] - mx) * sc); sacc[kt][j] = pv; sum += pv; }
        sum += shx(sum, C.lane, 16); sum += shx(sum, C.lane, 32);
        f32x4 oacc[8];
#pragma unroll
        for (int dt = 0; dt < 8; ++dt) oacc[dt] = (f32x4){0.f, 0.f, 0.f, 0.f};
#pragma unroll
        for (int ks = 0; ks < 8; ++ks) {
            u32x4 pw; pw.x = cvt_pk_bf16(sacc[2 * ks][0], sacc[2 * ks][1]); pw.y = cvt_pk_bf16(sacc[2 * ks][2], sacc[2 * ks][3]);
            pw.z = cvt_pk_bf16(sacc[2 * ks + 1][0], sacc[2 * ks + 1][1]); pw.w = cvt_pk_bf16(sacc[2 * ks + 1][2], sacc[2 * ks + 1][3]);
            const bf16x8 pa = __builtin_bit_cast(bf16x8, pw);
#pragma unroll
            for (int dt = 0; dt < 8; ++dt) { const LAS unsigned char* vr = LV + (16 * dt + r16) * 512;
                const u32x2 lo = *(const LAS u32x2*)(vr + (((8 * ks + g) ^ (2 * r16)) * 8)), hi = *(const LAS u32x2*)(vr + (((8 * ks + 4 + g) ^ (2 * r16)) * 8));
                u32x4 vw; vw.x = lo.x; vw.y = lo.y; vw.z = hi.x; vw.w = hi.y;
                oacc[dt] = __builtin_amdgcn_mfma_f32_16x16x32_bf16(pa, __builtin_bit_cast(bf16x8, vw), oacc[dt], 0, 0, 0); } }
        float inv[4];
#pragma unroll
        for (int j = 0; j < 4; ++j) inv[j] = 1.0f / shl(sum, 4 * g + j);
#pragma unroll
        for (int dt = 0; dt < 8; ++dt)
#pragma unroll
            for (int j = 0; j < 4; ++j) mix[(size_t)(m0 + 4 * g + j) * D + SW + hm * 128 + 16 * dt + r16] = f2bf(oacc[dt][j] * inv[j]);
    }
    __syncthreads();
}

__device__ __forceinline__ void ph_rwkv_prep1(const Ctx& C, const float* mu, bool with_v) {
    unsigned char* ws = C.ws;
    const bf16* P = (const bf16*)(ws + WS_P); bf16* AL = (bf16*)(ws + WS_ALORA);
    const int oc0 = 8 * C.lane;
    const int XW0 = 4608, XA0 = 4704, XV0 = 4800, XG0 = with_v ? 4864 : 4800;
    int src, mode;
    if (oc0 < 96) { src = XW0 + oc0; mode = 0; } else if (oc0 < 192) { src = XA0 + oc0 - 96; mode = 1; }
    else if (oc0 < 256) { src = XV0 + oc0 - 192; mode = with_v ? 1 : 2; } else { src = XG0 + oc0 - 256; mode = 3; }
    f32x4 mu0 = (f32x4){0.f, 0.f, 0.f, 0.f}, mu1 = mu0;
    if (mode != 2) { mu0 = *(const f32x4*)(mu + src); mu1 = *(const f32x4*)(mu + src + 4); }
    for (int mb = C.gw; mb < M; mb += 4 * C.NGW) {
        u32x4 cu4[4], pr4[4];
#pragma unroll
        for (int i = 0; i < 4; ++i) { const int m = mb + i * C.NGW; cu4[i] = (u32x4){0u, 0u, 0u, 0u}; pr4[i] = cu4[i];
            if (mode != 2) { cu4[i] = *(const u32x4*)(P + (size_t)m * LDP_RW + src);
                if ((m & (SEQ - 1)) != 0) pr4[i] = *(const u32x4*)(P + (size_t)(m - 1) * LDP_RW + src); } }
#pragma unroll
        for (int i = 0; i < 4; ++i) { const int m = mb + i * C.NGW; const u32x4 cu = cu4[i], pr = pr4[i];
            u32x4 o = (u32x4){0u, 0u, 0u, 0u};
            if (mode != 2) {
                float v[8];
#pragma unroll
                for (int q = 0; q < 4; ++q) { const float c0 = bflo(cu[q]), c1 = bfhi(cu[q]), p0 = bflo(pr[q]), p1 = bfhi(pr[q]);
                    const float m0 = q < 2 ? mu0[2 * q] : mu1[2 * q - 4], m1 = q < 2 ? mu0[2 * q + 1] : mu1[2 * q - 3];
                    v[2 * q] = c0 + m0 * (p0 - c0); v[2 * q + 1] = c1 + m1 * (p1 - c1); }
#pragma unroll
                for (int q = 0; q < 8; ++q) { if (mode == 0) v[q] = 1.0f - 2.0f * __builtin_amdgcn_rcpf(1.0f + __expf(2.0f * v[q])); else if (mode == 3) v[q] = sigmoidf_(v[q]); }
                o.x = cvt_pk_bf16(v[0], v[1]); o.y = cvt_pk_bf16(v[2], v[3]); o.z = cvt_pk_bf16(v[4], v[5]); o.w = cvt_pk_bf16(v[6], v[7]);
            }
            *(u32x4*)(AL + (size_t)m * 512 + oc0) = o; }
    }
}
__device__ __forceinline__ void ph_rwkv_prep2(const Ctx& C, const float* mu, const float* vecs, bool with_v) {
    unsigned char* ws = C.ws;
    const bf16* P = (const bf16*)(ws + WS_P); const bf16* LO = (const bf16*)(ws + WS_LORAOUT); bf16* VF = (bf16*)(ws + WS_VFIRST);
    unsigned char* SI = ws + WS_SCANIN; float* BON = (float*)(ws + WS_BONUS);
    const float* k_k = vecs + (with_v ? 3 : 2) * SW; const float* k_a = k_k + SW; const float* r_k = k_a + SW;
    const int hq = C.lane >> 4, cl = (C.lane & 15) * 4;
    for (int m = C.gw; m < M; m += C.NGW) {
        const int t = m & (SEQ - 1), b = m >> 11; const bool hp = t != 0;
        const bf16* pc = P + (size_t)m * LDP_RW; const bf16* pp = pc - LDP_RW;
#pragma unroll 2
        for (int it = 0; it < 6; ++it) {
            const int c = it * 256 + 4 * C.lane, head = 4 * it + hq;
            const u32x2 rc = *(const u32x2*)(pc + c), kc = *(const u32x2*)(pc + SW + c), vc = *(const u32x2*)(pc + 2 * SW + c);
            u32x2 rp = (u32x2){0u, 0u}, kp_ = rp, vp = rp;
            if (hp) { rp = *(const u32x2*)(pp + c); kp_ = *(const u32x2*)(pp + SW + c); vp = *(const u32x2*)(pp + 2 * SW + c); }
            const u32x2 Ew = *(const u32x2*)(LO + (size_t)m * 6144 + c), aw = *(const u32x2*)(LO + (size_t)m * 6144 + SW + c);
            u32x2 svw = (u32x2){0u, 0u}, vfw = svw;
            if (with_v) { svw = *(const u32x2*)(LO + (size_t)m * 6144 + 2 * SW + c); vfw = *(const u32x2*)(VF + (size_t)m * SW + c); }
            const f32x4 mr = *(const f32x4*)(mu + c), mk = *(const f32x4*)(mu + SW + c), mv = *(const f32x4*)(mu + 2 * SW + c);
            const f32x4 kk4 = *(const f32x4*)(k_k + c), ka4 = *(const f32x4*)(k_a + c), rk4 = *(const f32x4*)(r_k + c);
            float rm[4], km[4], vm[4], E[4], a[4], sv[4], vf[4];
#define UNPK(dst, w) dst[0] = bflo(w.x); dst[1] = bfhi(w.x); dst[2] = bflo(w.y); dst[3] = bfhi(w.y)
            float t0[4], t1[4];
            UNPK(t0, rc); UNPK(t1, rp);
#pragma unroll
            for (int j = 0; j < 4; ++j) rm[j] = t0[j] + mr[j] * (t1[j] - t0[j]);
            UNPK(t0, kc); UNPK(t1, kp_);
#pragma unroll
            for (int j = 0; j < 4; ++j) km[j] = t0[j] + mk[j] * (t1[j] - t0[j]);
            UNPK(t0, vc); UNPK(t1, vp);
#pragma unroll
            for (int j = 0; j < 4; ++j) vm[j] = t0[j] + mv[j] * (t1[j] - t0[j]);
            UNPK(E, Ew); UNPK(a, aw); UNPK(sv, svw); UNPK(vf, vfw);
#undef UNPK
            float vv[4], kkr[4], kp[4], ss = 0.f, bs = 0.f;
#pragma unroll
            for (int j = 0; j < 4; ++j) {
                vv[j] = with_v ? vm[j] + (vf[j] - vm[j]) * sv[j] : vm[j];
                kkr[j] = km[j] * kk4[j]; ss += kkr[j] * kkr[j];
                kp[j] = km[j] * (1.0f + (a[j] - 1.0f) * ka4[j]);
                bs += rm[j] * kp[j] * rk4[j]; }
            ss = row16_sum(ss); bs = row16_sum(bs);
            const float inv = 1.0f / fmaxf(sqrtf(ss), 1e-12f);
            if (!with_v) { u32x2 w; w.x = cvt_pk_bf16(vm[0], vm[1]); w.y = cvt_pk_bf16(vm[2], vm[3]); *(u32x2*)(VF + (size_t)m * SW + c) = w; }
            unsigned char* rec = SI + ((size_t)(b * 24 + head) * SEQ + t) * 896;
            f32x4 wv; float kk[4];
#pragma unroll
            for (int j = 0; j < 4; ++j) { wv[j] = __expf(-E[j]); kk[j] = kkr[j] * inv; }
            *(f32x4*)(rec + cl * 4) = wv;
            u32x2 o;
            o.x = cvt_pk_bf16(-kk[0], -kk[1]); o.y = cvt_pk_bf16(-kk[2], -kk[3]); *(u32x2*)(rec + 256 + cl * 2) = o;
            o.x = cvt_pk_bf16(kk[0] * a[0], kk[1] * a[1]); o.y = cvt_pk_bf16(kk[2] * a[2], kk[3] * a[3]); *(u32x2*)(rec + 384 + cl * 2) = o;
            o.x = cvt_pk_bf16(kp[0], kp[1]); o.y = cvt_pk_bf16(kp[2], kp[3]); *(u32x2*)(rec + 512 + cl * 2) = o;
            o.x = cvt_pk_bf16(rm[0], rm[1]); o.y = cvt_pk_bf16(rm[2], rm[3]); *(u32x2*)(rec + 640 + cl * 2) = o;
            o.x = cvt_pk_bf16(vv[0], vv[1]); o.y = cvt_pk_bf16(vv[2], vv[3]); *(u32x2*)(rec + 768 + cl * 2) = o;
            if ((C.lane & 15) == 0) BON[m * 24 + head] = bs;
        }
    }
}
__device__ __forceinline__ float fma_(float a, float b, float c) { float d; asm("v_fma_f32 %0, %1, %2, %3" : "=v"(d) : "v"(a), "v"(b), "v"(c)); return d; }
__device__ __forceinline__ float mul_(float a, float b) { float d; asm("v_mul_f32 %0, %1, %2" : "=v"(d) : "v"(a), "v"(b)); return d; }
__device__ __forceinline__ void ph_rwkv_scan(const Ctx& C, const float* mg, const float* mu, const float* md, const float* vecs, bool with_v, const float* const* in, int lq) {
    if (C.bid >= 192) { ph_moe_wconv(C, mg, mu, md, in, lq); return; }
    unsigned char* ws = C.ws;
    const unsigned char* SI = ws + WS_SCANIN;
    constexpr int TC = 16, NCH = SEQ / TC, REC = 7 * 64;
    LAS float* buf = (LAS float*)C.lds;
    LAS float* ybuf = (LAS float*)(C.lds + 114688);
    const bool scanner = C.wave < 4;
    const int slot = (C.wave >> 1) & 1;
    const int rg = C.lane >> 3, cg = C.lane & 7;
    const int rbase = 32 * (C.wave & 1) + 4 * rg;
    if (!scanner) {
        const int lw = C.wave - 4, qd = C.lane;
        const int q2 = qd - 16, lvec = 1 + (q2 >> 3), lpart = q2 & 7;
        const float* BON = (const float*)(ws + WS_BONUS); bf16* mix = (bf16*)(ws + WS_MIX); const bf16* LO = (const bf16*)(ws + WS_LORAOUT);
        const float* gn_g = vecs + (with_v ? 6 : 5) * SW; const float* gn_b = gn_g + SW;
        const int p0 = C.bid * 2, b0 = p0 / 24, h0 = p0 % 24, b1 = (p0 + 1) / 24, h1 = (p0 + 1) % 24;
        const int pr = C.lane >> 4, pc4 = 4 * (C.lane & 15);
        const f32x4 gg0 = *(const f32x4*)(gn_g + h0 * 64 + pc4), gb0 = *(const f32x4*)(gn_b + h0 * 64 + pc4), gg1 = *(const f32x4*)(gn_g + h1 * 64 + pc4), gb1 = *(const f32x4*)(gn_b + h1 * 64 + pc4);
        u32x4 st[8];
#define SCAN_ISSUE(ch_) do { _Pragma("unroll") for (int i_ = 0; i_ < 8; ++i_) { const int ps = lw + 4 * i_; \
        const int sl_ = ps >> 4, t_ = (ch_) * TC + (ps & 15); \
        st[i_] = qd < 56 ? *(const u32x4*)(SI + ((size_t)(p0 + sl_) * SEQ + t_) * 896 + qd * 16) \
                         : *(const u32x4*)(LO + (size_t)((sl_ ? b1 : b0) * SEQ + t_) * 6144 + 3 * SW + (sl_ ? h1 : h0) * 64 + (qd - 56) * 8); } } while (0)
#define SCAN_COMMIT(bsel_) do { _Pragma("unroll") for (int i_ = 0; i_ < 8; ++i_) { const int ps = lw + 4 * i_; \
        LAS float* dst = buf + (((bsel_) * 2 * TC) + ps) * REC; \
        if (qd < 16) *(LAS u32x4*)(dst + 4 * qd) = st[i_]; \
        else { LAS float* d2 = dst + lvec * 64 + lpart * 8; \
            f32x4 a_, b_; a_[0] = bflo(st[i_].x); a_[1] = bfhi(st[i_].x); a_[2] = bflo(st[i_].y); a_[3] = bfhi(st[i_].y); \
            b_[0] = bflo(st[i_].z); b_[1] = bfhi(st[i_].z); b_[2] = bflo(st[i_].w); b_[3] = bfhi(st[i_].w); \
            *(LAS f32x4*)d2 = a_; *(LAS f32x4*)(d2 + 4) = b_; } } } while (0)
#define SCAN_POST(cp_) do { _Pragma("unroll") for (int g_ = 0; g_ < 2; ++g_) { const int ps = lw + 4 * (4 * g_ + pr), sl = ps >> 4, stp = ps & 15; \
        const LAS float* rec = buf + ((((cp_) & 1) * 2 * TC) + ps) * REC; \
        const f32x4 yv = *(const LAS f32x4*)(ybuf + ((((cp_) & 1) * 2 + sl) * TC + stp) * 64 + pc4), vv = *(const LAS f32x4*)(rec + 5 * 64 + pc4), gq = *(const LAS f32x4*)(rec + 6 * 64 + pc4); \
        const int m = (sl ? b1 : b0) * SEQ + (cp_) * TC + stp, hh = sl ? h1 : h0; \
        const float bon = BON[m * 24 + hh]; \
        const float mean = row16_sum((yv[0] + yv[1]) + (yv[2] + yv[3])) * (1.f / 64.f); const f32x4 d = yv - mean; \
        const float var = row16_sum((d[0] * d[0] + d[1] * d[1]) + (d[2] * d[2] + d[3] * d[3])) * (1.f / 64.f); \
        const float rstd = 1.0f / sqrtf(var + 64e-5f); const f32x4 gg = sl ? gg1 : gg0, gb = sl ? gb1 : gb0; \
        const f32x4 o_ = (d * rstd * gg + gb + vv * bon) * gq; \
        u32x2 w_; w_.x = cvt_pk_bf16(o_[0], o_[1]); w_.y = cvt_pk_bf16(o_[2], o_[3]); \
        *(u32x2*)(mix + (size_t)m * D + hh * 64 + pc4) = w_; } } while (0)
        SCAN_ISSUE(0); SCAN_COMMIT(0);
        __syncthreads();
        for (int ch = 0; ch < NCH; ++ch) {
            if (ch + 1 < NCH) SCAN_ISSUE(ch + 1);
            if (ch > 0) SCAN_POST(ch - 1);
            if (ch + 1 < NCH) SCAN_COMMIT((ch & 1) ^ 1);
            __syncthreads();
        }
        SCAN_POST(NCH - 1);
#undef SCAN_ISSUE
#undef SCAN_COMMIT
#undef SCAN_POST
    } else {
        f32x2 S[4][4];
#pragma unroll
        for (int i = 0; i < 4; ++i)
#pragma unroll
            for (int c = 0; c < 4; ++c) S[i][c] = (f32x2){0.f, 0.f};
        __syncthreads();
        for (int ch = 0; ch < NCH; ++ch) {
            const LAS float* base = buf + (((ch & 1) * 2 + slot) * TC) * REC;
            LAS float* yb = ybuf + (((ch & 1) * 2 + slot) * TC) * 64 + rbase;
#pragma unroll 2
            for (int s = 0; s < TC; ++s) {
                const LAS float* rp = base + s * REC + 8 * cg;
                f32x2 wv[4], nv[4], bv[4], kv[4], rv[4];
                { const f32x4 x0 = *(const LAS f32x4*)(rp), x1 = *(const LAS f32x4*)(rp + 4); wv[0] = (f32x2){x0[0], x0[1]}; wv[1] = (f32x2){x0[2], x0[3]}; wv[2] = (f32x2){x1[0], x1[1]}; wv[3] = (f32x2){x1[2], x1[3]}; }
                { const f32x4 x0 = *(const LAS f32x4*)(rp + 64), x1 = *(const LAS f32x4*)(rp + 68); nv[0] = (f32x2){x0[0], x0[1]}; nv[1] = (f32x2){x0[2], x0[3]}; nv[2] = (f32x2){x1[0], x1[1]}; nv[3] = (f32x2){x1[2], x1[3]}; }
                { const f32x4 x0 = *(const LAS f32x4*)(rp + 128), x1 = *(const LAS f32x4*)(rp + 132); bv[0] = (f32x2){x0[0], x0[1]}; bv[1] = (f32x2){x0[2], x0[3]}; bv[2] = (f32x2){x1[0], x1[1]}; bv[3] = (f32x2){x1[2], x1[3]}; }
                { const f32x4 x0 = *(const LAS f32x4*)(rp + 192), x1 = *(const LAS f32x4*)(rp + 196); kv[0] = (f32x2){x0[0], x0[1]}; kv[1] = (f32x2){x0[2], x0[3]}; kv[2] = (f32x2){x1[0], x1[1]}; kv[3] = (f32x2){x1[2], x1[3]}; }
                { const f32x4 x0 = *(const LAS f32x4*)(rp + 256), x1 = *(const LAS f32x4*)(rp + 260); rv[0] = (f32x2){x0[0], x0[1]}; rv[1] = (f32x2){x0[2], x0[3]}; rv[2] = (f32x2){x1[0], x1[1]}; rv[3] = (f32x2){x1[2], x1[3]}; }
                const f32x4 vv = *(const LAS f32x4*)(base + s * REC + 320 + rbase);
                f32x4 yo;
#pragma unroll
                for (int i = 0; i < 4; ++i) {
                    f32x2 a2 = S[i][0] * nv[0];
#pragma unroll
                    for (int c = 1; c < 4; ++c) a2 = S[i][c] * nv[c] + a2;
                    float sa = a2[0] + a2[1];
                    sa = dpp_add<0xB1>(sa); sa = dpp_add<0x4E>(sa); sa = dpp_add<0x141>(sa);
                    const f32x2 sa2 = (f32x2){sa, sa}, v2 = (f32x2){vv[i], vv[i]};
                    f32x2 y2 = (f32x2){0.f, 0.f};
#pragma unroll
                    for (int c = 0; c < 4; ++c) { S[i][c] = S[i][c] * wv[c] + (sa2 * bv[c] + v2 * kv[c]); y2 = S[i][c] * rv[c] + y2; }
                    float y = y2[0] + y2[1];
                    y = dpp_add<0xB1>(y); y = dpp_add<0x4E>(y); y = dpp_add<0x141>(y);
                    yo[i] = y;
                }
                if (cg == 0) *(LAS f32x4*)(yb + s * 64) = yo;
            }
            __syncthreads();
        }
    }
}

__device__ __constant__ float RET_LG2[6] = {-0.04580368961312479f, -0.02272007650008353f, -0.011315313227834146f, -0.005646563141142063f, -0.0028205190623786626f, -0.0014095702546713536f};
__device__ __forceinline__ void ph_ret_prep(const Ctx& C) {
    unsigned char* ws = C.ws;
    const bf16* P = (const bf16*)(ws + WS_P); const f32x2* CS = (const f32x2*)(ws + WS_CS);
    bf16* QR = (bf16*)(ws + WS_QR); bf16* KR = (bf16*)(ws + WS_KR); bf16* VT = (bf16*)(ws + WS_VT); bf16* KVT = (bf16*)(ws + WS_KVT);
    LAS unsigned char* LKt = C.lds; LAS unsigned char* LV = C.lds + 32768;
    const int g = C.lane >> 4, r16 = C.lane & 15, w = C.wave;
    __syncthreads();
    for (int u = C.bid; u < 1536; u += C.G) {
        const int c = u & 15, bh = u >> 4, h = bh % 6, b = bh / 6, m0 = b * SEQ + c * 128;
        const float lg2 = RET_LG2[h];
        __syncthreads();
        for (int task = C.tid; task < 1536; task += NTHR) {
            if (task < 512) {
                const bool isk = task >= 256; const int tk = task & 255, i0 = 4 * (tk & 15), tg = tk >> 4;
                const int colb = (isk ? 768 : 0) + h * 128 + i0; const float scl = isk ? 0.08838834764831845f : 1.0f;
                bf16* N = isk ? KR : QR;
                float o1[4][8], o2[4][8];
#pragma unroll
                for (int j = 0; j < 8; ++j) { const int m = m0 + tg * 8 + j;
                    const u32x2 a = *(const u32x2*)(P + (size_t)m * LDP_RET + colb), b2 = *(const u32x2*)(P + (size_t)m * LDP_RET + colb + 64);
                    const f32x4 cs01 = *(const f32x4*)(CS + (size_t)m * 64 + i0), cs23 = *(const f32x4*)(CS + (size_t)m * 64 + i0 + 2);
                    const float x1[4] = {bflo(a.x), bfhi(a.x), bflo(a.y), bfhi(a.y)}, x2[4] = {bflo(b2.x), bfhi(b2.x), bflo(b2.y), bfhi(b2.y)};
                    const float cc[4] = {cs01[0], cs01[2], cs23[0], cs23[2]}, sn[4] = {cs01[1], cs01[3], cs23[1], cs23[3]};
#pragma unroll
                    for (int q = 0; q < 4; ++q) { o1[q][j] = (x1[q] * cc[q] - x2[q] * sn[q]) * scl; o2[q][j] = (x1[q] * sn[q] + x2[q] * cc[q]) * scl; }
                    u32x2 w1, w2; w1.x = cvt_pk_bf16(o1[0][j], o1[1][j]); w1.y = cvt_pk_bf16(o1[2][j], o1[3][j]); w2.x = cvt_pk_bf16(o2[0][j], o2[1][j]); w2.y = cvt_pk_bf16(o2[2][j], o2[3][j]);
                    *(u32x2*)(N + (size_t)m * 768 + h * 128 + i0) = w1; *(u32x2*)(N + (size_t)m * 768 + h * 128 + i0 + 64) = w2; }
                if (isk) {
                    float kd[8];
#pragma unroll
                    for (int j = 0; j < 8; ++j) kd[j] = exp2f((float)(127 - (tg * 8 + j)) * lg2);
#pragma unroll
                    for (int q = 0; q < 4; ++q) {
                        u32x4 w1, w2;
                        w1.x = cvt_pk_bf16(o1[q][0] * kd[0], o1[q][1] * kd[1]); w1.y = cvt_pk_bf16(o1[q][2] * kd[2], o1[q][3] * kd[3]); w1.z = cvt_pk_bf16(o1[q][4] * kd[4], o1[q][5] * kd[5]); w1.w = cvt_pk_bf16(o1[q][6] * kd[6], o1[q][7] * kd[7]);
                        w2.x = cvt_pk_bf16(o2[q][0] * kd[0], o2[q][1] * kd[1]); w2.y = cvt_pk_bf16(o2[q][2] * kd[2], o2[q][3] * kd[3]); w2.z = cvt_pk_bf16(o2[q][4] * kd[4], o2[q][5] * kd[5]); w2.w = cvt_pk_bf16(o2[q][6] * kd[6], o2[q][7] * kd[7]);
                        *(LAS u32x4*)(LKt + (i0 + q) * 256 + ((tg ^ ((i0 + q) & 15)) * 16)) = w1;
                        *(LAS u32x4*)(LKt + (i0 + q + 64) * 256 + ((tg ^ ((i0 + q + 64) & 15)) * 16)) = w2; }
                }
            } else {
                const int tv = task - 512, e0 = 4 * (tv & 63), tg = tv >> 6;
                u32x2 vin[8];
#pragma unroll
                for (int j = 0; j < 8; ++j) vin[j] = *(const u32x2*)(P + (size_t)(m0 + tg * 8 + j) * LDP_RET + 1536 + h * 256 + e0);
                u32x4 w0, w1, w2, w3;
#define PKLO(a_, b_) (((a_) & 0xffffu) | ((b_) << 16))
#define PKHI(a_, b_) (((a_) >> 16) | ((b_) & 0xffff0000u))
                w0.x = PKLO(vin[0].x, vin[1].x); w0.y = PKLO(vin[2].x, vin[3].x); w0.z = PKLO(vin[4].x, vin[5].x); w0.w = PKLO(vin[6].x, vin[7].x);
                w1.x = PKHI(vin[0].x, vin[1].x); w1.y = PKHI(vin[2].x, vin[3].x); w1.z = PKHI(vin[4].x, vin[5].x); w1.w = PKHI(vin[6].x, vin[7].x);
                w2.x = PKLO(vin[0].y, vin[1].y); w2.y = PKLO(vin[2].y, vin[3].y); w2.z = PKLO(vin[4].y, vin[5].y); w2.w = PKLO(vin[6].y, vin[7].y);
                w3.x = PKHI(vin[0].y, vin[1].y); w3.y = PKHI(vin[2].y, vin[3].y); w3.z = PKHI(vin[4].y, vin[5].y); w3.w = PKHI(vin[6].y, vin[7].y);
#undef PKLO
#undef PKHI
                bf16* vt = VT + (size_t)(bh * 256 + e0) * SEQ + c * 128 + tg * 8;
                *(u32x4*)vt = w0; *(u32x4*)(vt + SEQ) = w1; *(u32x4*)(vt + 2 * SEQ) = w2; *(u32x4*)(vt + 3 * SEQ) = w3;
                *(LAS u32x4*)(LV + (e0 + 0) * 256 + ((tg ^ ((e0 + 0) & 15)) * 16)) = w0; *(LAS u32x4*)(LV + (e0 + 1) * 256 + ((tg ^ ((e0 + 1) & 15)) * 16)) = w1;
                *(LAS u32x4*)(LV + (e0 + 2) * 256 + ((tg ^ ((e0 + 2) & 15)) * 16)) = w2; *(LAS u32x4*)(LV + (e0 + 3) * 256 + ((tg ^ ((e0 + 3) & 15)) * 16)) = w3;
            }
        }
        __syncthreads();
        {   f32x4 acc[16];
#pragma unroll
            for (int et = 0; et < 16; ++et) acc[et] = (f32x4){0.f, 0.f, 0.f, 0.f};
#pragma unroll
            for (int ks = 0; ks < 4; ++ks) {
                const bf16x8 af = *(const LAS bf16x8*)(LKt + (16 * w + r16) * 256 + (((4 * ks + g) ^ r16) * 16));
#pragma unroll
                for (int et = 0; et < 16; ++et) { const bf16x8 bf = *(const LAS bf16x8*)(LV + (16 * et + r16) * 256 + (((4 * ks + g) ^ r16) * 16));
                    acc[et] = __builtin_amdgcn_mfma_f32_16x16x32_bf16(af, bf, acc[et], 0, 0, 0); } }
#pragma unroll
            for (int et = 0; et < 16; ++et) { u32x2 wv; wv.x = cvt_pk_bf16(acc[et][0], acc[et][1]); wv.y = cvt_pk_bf16(acc[et][2], acc[et][3]); *(u32x2*)(KVT + ((size_t)u * 256 + 16 * et + r16) * 128 + 16 * w + 4 * g) = wv; }
        }
    }
    __syncthreads();
}
__device__ __forceinline__ void ph_ret_kv(const Ctx& C) {
    unsigned char* ws = C.ws;
    const bf16* KDT = (const bf16*)(ws + WS_KDT); const bf16* VT = (const bf16*)(ws + WS_VT); bf16* KVT = (bf16*)(ws + WS_KVT);
    const int g = C.lane >> 4, r16 = C.lane & 15, w = C.wave;
    LAS unsigned char* LKt = C.lds; LAS unsigned char* LV = C.lds + 32768;
    u32x4 st[12];
#define KV_ISSUE(u_) do { const int c_ = (u_) & 15, bh_ = (u_) >> 4; \
        _Pragma("unroll") for (int i = 0; i < 4; ++i) { const int q = C.tid + 512 * i, row = q >> 4, pc = q & 15; st[i] = *(const u32x4*)(KDT + (size_t)(bh_ * 128 + row) * SEQ + c_ * 128 + pc * 8); } \
        _Pragma("unroll") for (int i = 0; i < 8; ++i) { const int q = C.tid + 512 * i, row = q >> 4, pc = q & 15; st[4 + i] = *(const u32x4*)(VT + (size_t)(bh_ * 256 + row) * SEQ + c_ * 128 + pc * 8); } } while (0)
#define KV_COMMIT() do { \
        _Pragma("unroll") for (int i = 0; i < 4; ++i) { const int q = C.tid + 512 * i, row = q >> 4, pc = q & 15; *(LAS u32x4*)(LKt + row * 256 + ((pc ^ (row & 15)) * 16)) = st[i]; } \
        _Pragma("unroll") for (int i = 0; i < 8; ++i) { const int q = C.tid + 512 * i, row = q >> 4, pc = q & 15; *(LAS u32x4*)(LV + row * 256 + ((pc ^ (row & 15)) * 16)) = st[4 + i]; } } while (0)
    __syncthreads();
    if (C.bid < 1536) KV_ISSUE(C.bid);
    for (int u = C.bid; u < 1536; u += C.G) {
        __syncthreads();
        KV_COMMIT();
        if (u + C.G < 1536) KV_ISSUE(u + C.G);
        __syncthreads();
        f32x4 acc[16];
#pragma unroll
        for (int et = 0; et < 16; ++et) acc[et] = (f32x4){0.f, 0.f, 0.f, 0.f};
#pragma unroll
        for (int ks = 0; ks < 4; ++ks) {
            const bf16x8 af = *(const LAS bf16x8*)(LKt + (16 * w + r16) * 256 + (((4 * ks + g) ^ r16) * 16));
#pragma unroll
            for (int et = 0; et < 16; ++et) { const bf16x8 bf = *(const LAS bf16x8*)(LV + (16 * et + r16) * 256 + (((4 * ks + g) ^ r16) * 16));
                acc[et] = __builtin_amdgcn_mfma_f32_16x16x32_bf16(af, bf, acc[et], 0, 0, 0); } }
#pragma unroll
        for (int et = 0; et < 16; ++et) { u32x2 wv; wv.x = cvt_pk_bf16(acc[et][0], acc[et][1]); wv.y = cvt_pk_bf16(acc[et][2], acc[et][3]); *(u32x2*)(KVT + ((size_t)u * 256 + 16 * et + r16) * 128 + 16 * w + 4 * g) = wv; }
    }
    __syncthreads();
#undef KV_ISSUE
#undef KV_COMMIT
}
__device__ __forceinline__ void ph_ret_prefix(const Ctx& C) {
    unsigned char* ws = C.ws;
    const bf16* KVT = (const bf16*)(ws + WS_KVT); bf16* RTB = (bf16*)(ws + WS_RTB);
    for (int idx = C.bid * NTHR + C.tid; idx < 96 * 8192; idx += C.G * NTHR) {
        const int bh = idx >> 13, rem = idx & 8191; const int h = bh % 6;
        const float cd = exp2f(128.0f * RET_LG2[h]);
        f32x4 r = (f32x4){0.f, 0.f, 0.f, 0.f};
        u32x2 kwv[15];
#pragma unroll
        for (int c = 0; c < 15; ++c) kwv[c] = *(const u32x2*)(KVT + ((size_t)(bh * 16 + c) * 8192 + rem) * 4);
#pragma unroll
        for (int c = 0; c < 16; ++c) { const size_t off = ((size_t)(bh * 16 + c) * 8192 + rem) * 4;
            u32x2 w; w.x = cvt_pk_bf16(r[0], r[1]); w.y = cvt_pk_bf16(r[2], r[3]); *(u32x2*)(RTB + off) = w;
            if (c < 15) { const u32x2 kw = kwv[c]; const f32x4 kv = (f32x4){bflo(kw.x), bfhi(kw.x), bflo(kw.y), bfhi(kw.y)}; r = r * cd + kv; } }
    }
}
#define LDS_BAR() asm volatile("s_waitcnt lgkmcnt(0)\n\ts_barrier" ::: "memory")
__device__ __forceinline__ void ph_ret_out(const Ctx& C, const float* gn) {
    unsigned char* ws = C.ws;
    const bf16* P = (const bf16*)(ws + WS_P); const bf16* QR = (const bf16*)(ws + WS_QR); const bf16* KR = (const bf16*)(ws + WS_KR);
    const bf16* VT = (const bf16*)(ws + WS_VT); const bf16* RTB = (const bf16*)(ws + WS_RTB); bf16* mix = (bf16*)(ws + WS_MIX);
    const int g = C.lane >> 4, r16 = C.lane & 15, w = C.wave;
    LAS unsigned char* LR = C.lds; LAS unsigned char* LV = C.lds + 65536;
    for (int u = C.bid; u < 1536; u += C.G) {
        const int c = u & 15, bh = u >> 4, h = bh % 6, b = bh / 6, m0 = b * SEQ + c * 128;
        const float lg2 = RET_LG2[h];
        LDS_BAR();
        const int nl = 16 * w + r16;
        u32x4 kst[4];
        bf16x8 qf[4];
        u32x2 gwv[16];
        {   u32x4 st[16];
#pragma unroll
            for (int i = 0; i < 8; ++i) { const int q = C.tid + 512 * i, row = q >> 4, pc = q & 15;
                st[i] = *(const u32x4*)(RTB + ((size_t)u * 256 + row) * 128 + pc * 8);
                st[8 + i] = *(const u32x4*)(VT + (size_t)(bh * 256 + row) * SEQ + c * 128 + pc * 8); }
#pragma unroll
            for (int s = 0; s < 4; ++s) qf[s] = *(const bf16x8*)(QR + (size_t)(m0 + nl) * 768 + h * 128 + 32 * s + 8 * g);
#pragma unroll
            for (int i = 0; i < 8; ++i) { const int q = C.tid + 512 * i, row = q >> 4, pc = q & 15; const int off = row * 256 + ((pc ^ (row & 15)) * 16);
                *(LAS u32x4*)(LR + off) = st[i]; *(LAS u32x4*)(LV + off) = st[8 + i]; }
        }
#pragma unroll
        for (int i = 0; i < 4; ++i) { const int q = C.tid + 512 * i, row = q >> 4, pc = q & 15;
            kst[i] = *(const u32x4*)(KR + (size_t)(m0 + row) * 768 + h * 128 + pc * 8); }
        LDS_BAR();
        f32x4 o[16];
        const float qdec = exp2f((float)(nl + 1) * lg2);
#pragma unroll
        for (int et = 0; et < 16; ++et) { f32x4 a = (f32x4){0.f, 0.f, 0.f, 0.f};
#pragma unroll
            for (int s = 0; s < 4; ++s) { const bf16x8 rf = *(const LAS bf16x8*)(LR + (16 * et + r16) * 256 + (((4 * s + g) ^ r16) * 16));
                a = __builtin_amdgcn_mfma_f32_16x16x32_bf16(rf, qf[s], a, 0, 0, 0); }
            o[et] = a * qdec;
            if ((et & 3) == 3) __builtin_amdgcn_sched_barrier(0); }
        LDS_BAR();
#pragma unroll
        for (int i = 0; i < 4; ++i) { const int q = C.tid + 512 * i, row = q >> 4, pc = q & 15; *(LAS u32x4*)(LR + row * 256 + ((pc ^ (row & 15)) * 16)) = kst[i]; }
#pragma unroll
        for (int et = 0; et < 16; ++et) gwv[et] = *(const u32x2*)(P + (size_t)(m0 + nl) * LDP_RET + 3072 + h * 256 + 16 * et + 4 * g);
        LDS_BAR();
        const float fd0 = (float)opq_v(nl - 4 * g);
        u32x2 pb[8];
#pragma unroll
        for (int mt = 0; mt < 8; ++mt) {
            pb[mt] = (u32x2){0u, 0u};
            if (mt <= w) { f32x4 a = (f32x4){0.f, 0.f, 0.f, 0.f};
#pragma unroll
                for (int s = 0; s < 4; ++s) { const bf16x8 kf = *(const LAS bf16x8*)(LR + (16 * mt + r16) * 256 + (((4 * s + g) ^ r16) * 16));
                    a = __builtin_amdgcn_mfma_f32_16x16x32_bf16(kf, qf[s], a, 0, 0, 0); }
#pragma unroll
                for (int j = 0; j < 4; ++j) { const float fd = fd0 - (float)(16 * mt + j); a[j] = fd >= 0.f ? a[j] * exp2f(fd * lg2) : 0.f; }
                pb[mt].x = cvt_pk_bf16(a[0], a[1]); pb[mt].y = cvt_pk_bf16(a[2], a[3]); }
        }
#pragma unroll
        for (int ks = 0; ks < 4; ++ks) {
            if (2 * ks <= w) {
                u32x4 pw; pw.x = pb[2 * ks].x; pw.y = pb[2 * ks].y; pw.z = pb[2 * ks + 1].x; pw.w = pb[2 * ks + 1].y;
                const bf16x8 pf = __builtin_bit_cast(bf16x8, pw);
#pragma unroll
                for (int et = 0; et < 16; ++et) { const LAS unsigned char* vr = LV + (16 * et + r16) * 256;
                    const u32x2 lo = *(const LAS u32x2*)(vr + (((8 * ks + g) ^ (2 * r16)) * 8)), hi = *(const LAS u32x2*)(vr + (((8 * ks + 4 + g) ^ (2 * r16)) * 8));
                    u32x4 vw; vw.x = lo.x; vw.y = lo.y; vw.z = hi.x; vw.w = hi.y;
                    o[et] = __builtin_amdgcn_mfma_f32_16x16x32_bf16(__builtin_bit_cast(bf16x8, vw), pf, o[et], 0, 0, 0); } }
        }
        float s1 = 0.f;
#pragma unroll
        for (int et = 0; et < 16; ++et) s1 += (o[et][0] + o[et][1]) + (o[et][2] + o[et][3]);
        s1 += shx(s1, C.lane, 16); s1 += shx(s1, C.lane, 32);
        const float mean = s1 * (1.f / 256.f); float s2 = 0.f;
#pragma unroll
        for (int et = 0; et < 16; ++et) { o[et] = o[et] - mean; s2 += (o[et][0] * o[et][0] + o[et][1] * o[et][1]) + (o[et][2] * o[et][2] + o[et][3] * o[et][3]); }
        s2 += shx(s2, C.lane, 16); s2 += shx(s2, C.lane, 32);
        const float rstd = 1.0f / sqrtf(s2 * (1.f / 256.f) + 1e-5f);
        const int m = m0 + nl;
#pragma unroll
        for (int et = 0; et < 16; ++et) { const int e = h * 256 + 16 * et + 4 * g;
            const f32x4 gg = *(const f32x4*)(gn + e), gb = *(const f32x4*)(gn + SW + e);
            const u32x2 gw_ = gwv[et];
            float gt[4] = {bflo(gw_.x), bfhi(gw_.x), bflo(gw_.y), bfhi(gw_.y)}; float ov[4];
#pragma unroll
            for (int j = 0; j < 4; ++j) { const float yn = o[et][j] * rstd * gg[j] + gb[j]; ov[j] = yn * gt[j] * sigmoidf_(gt[j]); }
            u32x2 wv; wv.x = cvt_pk_bf16(ov[0], ov[1]); wv.y = cvt_pk_bf16(ov[2], ov[3]);
            *(u32x2*)(mix + (size_t)m * D + e) = wv; }
    }
    __syncthreads();
}

constexpr int PH_PER_PAIR = 23, NPH = 2 + 2 * PH_PER_PAIR;
__global__ void __launch_bounds__(NTHR, 2) fwd_kernel(Args args) {
    extern __shared__ __attribute__((aligned(16))) unsigned char lds_raw[];
    Ctx C;
    C.lds = (LAS unsigned char*)lds_raw;
    C.tid = threadIdx.x; C.lane = C.tid & 63; C.wave = __builtin_amdgcn_readfirstlane(C.tid >> 6);
    C.bid = blockIdx.x; C.G = GRID; C.gw = C.bid * NWAVES + C.wave; C.NGW = C.G * NWAVES; C.ws = args.ws;
    for (int u = C.tid; u < (LDS_BYTES - LDS_MISC) / 4; u += NTHR) ((LAS unsigned*)(C.lds + LDS_MISC))[u] = 0u;
    __syncthreads();
    const int lo = args.ph_lo, hi = args.ph_hi;
    XcdBarrier bar; bar.bar = (unsigned*)(args.ws + WS_CTL) + CW_BAR; bar.x = 0; bar.st = nullptr;
    if (hi - lo > 1) bar = xcd_barrier_post((unsigned*)(args.ws + WS_CTL) + CW_BAR, (volatile LAS unsigned*)(C.lds + LDS_MISC));
#ifndef ENMASK
#define ENMASK 0x1ffffffu
#endif
#define EN(j) ((((unsigned)(ENMASK)) >> (j)) & 1u)
#ifndef DBLMASK
#define DBLMASK 0u
#endif
#define REP(j) for (int rep_ = 0; rep_ < 1 + (int)((((unsigned)(DBLMASK)) >> (j)) & 1u); ++rep_)
#define IN(k) (lo <= (k) && (k) < hi)
#define SEAM(k) do { if (IN((k) + 1)) xcd_barrier(bar, (lane_id_asm() == 0) && (Cq.wave == 0)); } while (0)

#define PH_BEGIN Ctx Cq; Cq.lds = C.lds; Cq.lane = lane_id_asm(); Cq.wave = opq_i(C.wave); Cq.tid = Cq.wave * 64 + Cq.lane; Cq.bid = opq_i((int)blockIdx.x); Cq.G = GRID; \
        Cq.gw = Cq.bid * NWAVES + Cq.wave; Cq.NGW = Cq.G * NWAVES; Cq.ws = opq(args.ws); unsigned char* ws = Cq.ws; const int lq = opq_i(lp); (void)ws; (void)lq
    { const int lp = 0;
    REP(0) if (EN(0) && IN(0)) { PH_BEGIN; ph_prologue(Cq, args); SEAM(0); }
    REP(1) if (EN(1) && IN(1)) { PH_BEGIN;
        pg8::SchedMem S; S.G = Cq.G; S.c = Cq.bid; S.memb = (unsigned)WS_MEMB; S.wkv = (unsigned)WS_WKV;
        pg8::EpiMem E; E.O0 = (bf16*)(ws + WS_MEMK); E.O1 = (bf16*)(ws + WS_MEMVT);
        pg8::gemm_phase<pg8::EpiMem, pg8::SchedMem, true, true>(Cq.lds, Cq.tid, (const char*)ws, 2048, 2048, 2048, S, E);
        SEAM(1);
    } }
#pragma unroll 1
    for (int lp = 0; lp < 2; ++lp) {
        const int pb = 2 + lp * PH_PER_PAIR;
        REP(2) if (EN(2) && IN(pb + 0)) {
            PH_BEGIN;
            pg8::SchedPlain S; S.init(M / 256, 22, Cq.G, Cq.bid); S.A0 = (unsigned)(WS_XB); S.B0 = (unsigned)(WS_WIN + (size_t)(2 * lq) * 22 * MiB); S.at = (unsigned)(256 * 2048 * 2); S.bt = (unsigned)(256 * 2048 * 2);
            pg8::EpiBf16 E; E.O = (bf16*)(ws + WS_P); E.ldc = LDP_RW;
            pg8::gemm_phase<pg8::EpiBf16, pg8::SchedPlain, true, true>(Cq.lds, Cq.tid, (const char*)ws, 2048, 2048, 2048, S, E);
            SEAM(pb + 0);
        }
        REP(3) if (EN(3) && IN(pb + 1)) { PH_BEGIN; const bool with_v = lq == 1; ph_rwkv_prep1(Cq, args.in[lq ? L2_MU : L0_MU], with_v); ph_memattn(Cq, (const bf16*)(ws + WS_P), LDP_RW, with_v ? 5120 : 5056); SEAM(pb + 1); }
        REP(4) if (EN(4) && IN(pb + 2)) {
            PH_BEGIN; const float* vecs = args.in[lq ? L2_VECS : L0_VECS];
            pg8::SchedLora S; S.skipv = lq == 0; S.init(M / 256, lq == 0 ? 18 : 24, Cq.G, Cq.bid); S.A0 = (unsigned)(WS_ALORA); S.B0 = (unsigned)(WS_WLORA + (size_t)lq * 3 * MiB);
            pg8::EpiLora E; E.O = (bf16*)(ws + WS_LORAOUT); E.vecs = vecs;
            pg8::gemm_phase<pg8::EpiLora, pg8::SchedLora, true, true>(Cq.lds, Cq.tid, (const char*)ws, 512, 256, opq_i(256), S, E);
            SEAM(pb + 2);
        }
        REP(5) if (EN(5) && IN(pb + 3)) { PH_BEGIN; ph_rwkv_prep2(Cq, args.in[lq ? L2_MU : L0_MU], args.in[lq ? L2_VECS : L0_VECS], lq == 1); SEAM(pb + 3); }
        REP(6) if (EN(6) && IN(pb + 4)) { PH_BEGIN; ph_rwkv_scan(Cq, args.in[lq ? L3_MG : L1_MG], args.in[lq ? L3_MU_ : L1_MU_], args.in[lq ? L3_MD : L1_MD], args.in[lq ? L2_VECS : L0_VECS], lq == 1, args.in, lq); SEAM(pb + 4); }
        REP(8) if (EN(8) && IN(pb + 6)) {
            PH_BEGIN;
            pg8::SchedPlain S; S.init(M / 256, 8, Cq.G, Cq.bid); S.A0 = (unsigned)(WS_MIX); S.B0 = (unsigned)(WS_WOUT + (size_t)(2 * lq) * 8 * MiB); S.at = (unsigned)(256 * 2048 * 2); S.bt = (unsigned)(256 * 2048 * 2);
            pg8::EpiBf16 E; E.O = (bf16*)(ws + WS_P); E.ldc = D;
            pg8::gemm_phase<pg8::EpiBf16, pg8::SchedPlain, true, true>(Cq.lds, Cq.tid, (const char*)ws, 2048, 2048, 2048, S, E);
            SEAM(pb + 6);
        }
        REP(9) if (EN(9) && IN(pb + 7)) { PH_BEGIN; const float* nr = args.in[lq ? L2_NORMS : L0_NORMS];
            ph_ln(Cq, ws + WS_P, 0, nr, nr + D, nullptr, ws + WS_X8, nullptr, false); SEAM(pb + 7); }
        REP(10) if (EN(10) && IN(pb + 8)) {
            PH_BEGIN;
            pg8::SchedPlain S; S.init(M / 256, 44, Cq.G, Cq.bid); S.A0 = (unsigned)(WS_X8); S.B0 = (unsigned)(WS_WFGU + (size_t)lq * 44 * MiB); S.at = (unsigned)(256 * 2048); S.bt = (unsigned)(256 * 2048);
            pg8::EpiSwiglu8 E; E.O = ws + WS_HID; E.ldc = DFF; E.inv = 1.0f / 16384.0f; E.so = 32.0f;
            pg8::gemm_phase<pg8::EpiSwiglu8, pg8::SchedPlain, true, true, true>(Cq.lds, Cq.tid, (const char*)ws, 1024, 1024, 1024, S, E);
            SEAM(pb + 8);
        }
        REP(11) if (EN(11) && IN(pb + 9)) {
            PH_BEGIN;
            pg8::SchedPlain S; S.init(M / 256, 8, Cq.G, Cq.bid); S.A0 = (unsigned)(WS_HID); S.B0 = (unsigned)(WS_WFD + (size_t)lq * 22 * MiB); S.at = (unsigned)(256 * DFF); S.bt = (unsigned)(256 * DFF);
            pg8::EpiFp8S E; E.O = ws + WS_P; E.ldc = D; E.sc = 1.0f / 256.0f;
            pg8::gemm_phase<pg8::EpiFp8S, pg8::SchedPlain, true, true, true>(Cq.lds, Cq.tid, (const char*)ws, DFF / 2, DFF / 2, DFF / 2, S, E);
            SEAM(pb + 9);
        }
        REP(12) if (EN(12) && IN(pb + 10)) { PH_BEGIN; const float* nr = args.in[lq ? L2_NORMS : L0_NORMS];
            ph_ln(Cq, ws + WS_P, 1, nr + 2 * D, nr + 3 * D, nullptr, nullptr, nullptr, false); SEAM(pb + 10); }
        REP(13) if (EN(13) && IN(pb + 11)) {
            PH_BEGIN;
            pg8::SchedPlain S; S.init(M / 256, 20, Cq.G, Cq.bid); S.A0 = (unsigned)(WS_XB); S.B0 = (unsigned)(WS_WIN + (size_t)(2 * lq + 1) * 22 * MiB); S.at = (unsigned)(256 * 2048 * 2); S.bt = (unsigned)(256 * 2048 * 2);
            pg8::EpiBf16 E; E.O = (bf16*)(ws + WS_P); E.ldc = LDP_RET;
            pg8::gemm_phase<pg8::EpiBf16, pg8::SchedPlain, true, true>(Cq.lds, Cq.tid, (const char*)ws, 2048, 2048, 2048, S, E);
            SEAM(pb + 11);
        }
        REP(14) if (EN(14) && IN(pb + 12)) { PH_BEGIN; ph_ret_prep(Cq); ph_memattn(Cq, (const bf16*)(ws + WS_P), LDP_RET, 4608); SEAM(pb + 12); }
        REP(16) if (EN(16) && IN(pb + 14)) { PH_BEGIN; ph_ret_prefix(Cq); SEAM(pb + 14); }
        REP(17) if (EN(17) && IN(pb + 15)) { PH_BEGIN; ph_ret_out(Cq, args.in[lq ? L3_GN : L1_GN]); SEAM(pb + 15); }
        REP(18) if (EN(18) && IN(pb + 16)) {
            PH_BEGIN;
            pg8::SchedPlain S; S.init(M / 256, 8, Cq.G, Cq.bid); S.A0 = (unsigned)(WS_MIX); S.B0 = (unsigned)(WS_WOUT + (size_t)(2 * lq + 1) * 8 * MiB); S.at = (unsigned)(256 * 2048 * 2); S.bt = (unsigned)(256 * 2048 * 2);
            pg8::EpiBf16 E; E.O = (bf16*)(ws + WS_P); E.ldc = D;
            pg8::gemm_phase<pg8::EpiBf16, pg8::SchedPlain, true, true>(Cq.lds, Cq.tid, (const char*)ws, 2048, 2048, 2048, S, E);
            SEAM(pb + 16);
        }
        REP(19) if (EN(19) && IN(pb + 17)) {
            PH_BEGIN; const float* nr = args.in[lq ? L3_NORMS : L1_NORMS];
            REP(25) { ph_ln(Cq, ws + WS_P, 0, nr, nr + D, nullptr, ws + WS_X8, args.in[lq ? L3_ROUTER : L1_ROUTER], true);
            __syncthreads(); }
            SEAM(pb + 17);
        }
        REP(20) if (EN(20) && IN(pb + 18)) { PH_BEGIN; ph_slots(Cq); SEAM(pb + 18); }
        REP(22) if (EN(22) && IN(pb + 20)) {
            PH_BEGIN;
            const int nT = __builtin_amdgcn_readfirstlane(((const int*)(ws + WS_CTL))[CW_NT]);
            pg8::SchedMoEg S; S.init(nT, 44, Cq.G, Cq.bid); S.B0 = (unsigned)(WS_MWGU); S.bt = (unsigned)(256 * 2048); S.be = (unsigned)(22 * MiB);
            S.xoff = (unsigned)WS_X8; S.zoff = (unsigned)(WS_CTL + 512 * 1024); S.texp = (const int*)(ws + WS_CTL) + CW_TEXP; S.slot_tok = (const int*)(ws + WS_SLOTTOK);
            pg8::EpiSwiglu8 E; E.O = ws + WS_HIDM; E.ldc = DFF; E.inv = 1.0f / 16384.0f; E.so = 32.0f;
            pg8::gemm_phase<pg8::EpiSwiglu8, pg8::SchedMoEg, true, true, true>(Cq.lds, Cq.tid, (const char*)ws, 1024, 1024, 1024, S, E);
            SEAM(pb + 20);
        }
        REP(23) if (EN(23) && IN(pb + 21)) {
            PH_BEGIN;
            const int nT = __builtin_amdgcn_readfirstlane(((const int*)(ws + WS_CTL))[CW_NT]);
            pg8::SchedMoE S; S.init(nT, 8, Cq.G, Cq.bid); S.A0 = (unsigned)(WS_HIDM); S.B0 = (unsigned)(WS_MWD); S.at = (unsigned)(256 * DFF); S.bt = (unsigned)(256 * DFF); S.be = (unsigned)(11 * MiB);
            S.texp = (const int*)(ws + WS_CTL) + CW_TEXP;
            pg8::EpiFp8S E; E.O = ws + WS_XPERM; E.ldc = D; E.sc = 1.0f / 256.0f;
            pg8::gemm_phase<pg8::EpiFp8S, pg8::SchedMoE, true, true, true>(Cq.lds, Cq.tid, (const char*)ws, DFF / 2, DFF / 2, DFF / 2, S, E);
            SEAM(pb + 21);
        }
        REP(24) if (EN(24) && IN(pb + 22)) {
            PH_BEGIN; const float* nr = args.in[lq ? L3_NORMS : L1_NORMS];
            ph_ln(Cq, ws + WS_XPERM, 2, nr + 2 * D, nr + 3 * D, lq == 1 ? args.out : nullptr, nullptr, nullptr, false);
            SEAM(pb + 22);
        }
    }
#undef IN
#undef SEAM
}

#ifndef MK_PER_PHASE
#define MK_PER_PHASE 0
#endif
extern "C" void kernel_launch(void* const* d_in, const int* in_sizes, int n_in, void* d_out, int out_size, void* d_ws, size_t ws_size, hipStream_t stream) {
    static int ready = 0;
    if (ready == 0) {
        ready = 1;
        if (n_in != 43 || out_size != M * D || ws_size < WS_END) { fprintf(stderr, "kernel_launch: unexpected problem (n_in %d out %d ws %zu need %zu)\n", n_in, out_size, ws_size, (size_t)WS_END); ready = -1; }
        else if (hipFuncSetAttribute((const void*)fwd_kernel, hipFuncAttributeMaxDynamicSharedMemorySize, LDS_BYTES) != hipSuccess) { fprintf(stderr, "kernel_launch: hipFuncSetAttribute failed\n"); ready = -1; }
        (void)hipGetLastError();
    }
    if (ready < 0) return;
    (void)hipMemsetAsync((char*)d_ws + WS_CTL, 0, CTL_BYTES, stream);
    Args a{};
    for (int i = 0; i < 43; ++i) a.in[i] = (const float*)d_in[i];
    a.out = (float*)d_out; a.ws = (unsigned char*)d_ws;
#if MK_PER_PHASE
    for (int p = 0; p < NPH; ++p) { a.ph_lo = p; a.ph_hi = p + 1; hipLaunchKernelGGL(fwd_kernel, dim3(GRID), dim3(NTHR), LDS_BYTES, stream, a); }
#else
    a.ph_lo = 0; a.ph_hi = NPH;
    hipLaunchKernelGGL(fwd_kernel, dim3(GRID), dim3(NTHR), LDS_BYTES, stream, a);
#endif
}
```

```cpp
#include <hip/hip_runtime.h>
#include <cstdio>
#include <cstdint>

#define LAS __attribute__((address_space(3)))
#define GAS __attribute__((address_space(1)))
typedef unsigned short bf16;
typedef short bf16x8 __attribute__((ext_vector_type(8)));
typedef float f32x4 __attribute__((ext_vector_type(4)));
typedef float f32x2 __attribute__((ext_vector_type(2)));
typedef unsigned u32x4 __attribute__((ext_vector_type(4)));
typedef unsigned u32x2 __attribute__((ext_vector_type(2)));

constexpr int M = 32768, D = 2048, SEQ = 2048, NB = 16;
constexpr int SW = 1536;
constexpr int LDP_RW = 5632, LDP_RET = 5120;
constexpr int DFF = 5632;
constexpr int NSLOT = 67584;
constexpr float ALPHA = 1.6817928305074290f;
constexpr float LN_EPS = 1e-5f;
constexpr int NWAVES = 8, NTHR = 512, GRID = 256;

constexpr size_t MiB = 1u << 20;
constexpr size_t WS_CTL = 0, CTL_BYTES = 1 * MiB;
constexpr size_t WS_WKV = 1 * MiB;
constexpr size_t WS_WIN = WS_WKV + 4 * MiB;
constexpr size_t WS_WOUT = WS_WIN + 88 * MiB;
constexpr size_t WS_WLORA = WS_WOUT + 32 * MiB;
constexpr size_t WS_WFGU = WS_WLORA + 6 * MiB;
constexpr size_t WS_WFD = WS_WFGU + 88 * MiB;
constexpr size_t WS_MEMB = WS_WFD + 44 * MiB;
constexpr size_t WS_MEMK = WS_MEMB + 16 * MiB;
constexpr size_t WS_MEMVT = WS_MEMK + 4 * MiB;
constexpr size_t WS_CS = WS_MEMVT + 4 * MiB;
constexpr size_t WS_XB = WS_CS + 16 * MiB;
constexpr size_t WS_MIX = WS_XB + 128 * MiB;
constexpr size_t WS_VFIRST = WS_MIX + 128 * MiB;
constexpr size_t WS_P = WS_VFIRST + 96 * MiB;
constexpr size_t WS_MISC = WS_P + 352 * MiB;
constexpr size_t WS_ROUTE = WS_MISC, WS_SLOT1 = WS_MISC + 512 * 1024, WS_SLOT2 = WS_SLOT1 + 128 * 1024, WS_SLOTTOK = WS_SLOT2 + 128 * 1024;
constexpr size_t WS_BONUS = WS_MISC + 2 * MiB;
constexpr size_t WS_SB = WS_BONUS + 3 * MiB;
constexpr size_t WS_ALORA = WS_SB, WS_LORAOUT = WS_SB + 32 * MiB, WS_SCANIN = WS_SB + 416 * MiB;
constexpr size_t WS_QR = WS_SB, WS_KR = WS_SB + 48 * MiB, WS_KDT = WS_SB + 96 * MiB, WS_VT = WS_SB + 144 * MiB, WS_KVT = WS_SB + 240 * MiB, WS_RTB = WS_SB + 432 * MiB;
constexpr size_t WS_HID = WS_SB;
constexpr size_t WS_XPERM = WS_SB, WS_HIDM = WS_SB + 264 * MiB, WS_MWGU = WS_SB + 1184 * MiB, WS_MWD = WS_SB + 1360 * MiB;
constexpr size_t WS_XLO = WS_SB + 1518 * MiB;
constexpr size_t WS_X8 = WS_XLO + 64 * MiB;
constexpr size_t WS_END = WS_X8 + 64 * MiB;
constexpr int CW_BAR = 4096;
constexpr int CW_CNT = 16384;
constexpr int CW_NT = 20480;
constexpr int CW_TEXP = 20544;

constexpr int RING_BYTES = 131072;
constexpr int LDS_MISC = RING_BYTES;
constexpr int LDS_BYTES = RING_BYTES + 8192;

#define LDS_WAIT() asm volatile("s_waitcnt lgkmcnt(0)" ::: "memory")
#define VM_WAIT() asm volatile("s_waitcnt vmcnt(0)" ::: "memory")
__device__ __forceinline__ unsigned cvt_pk_bf16(float lo, float hi) { unsigned r; asm volatile("v_cvt_pk_bf16_f32 %0, %1, %2" : "=v"(r) : "v"(lo), "v"(hi)); return r; }
__device__ __forceinline__ bf16 f2bf(float f) { return (bf16)(cvt_pk_bf16(f, 0.f) & 0xffffu); }
__device__ __forceinline__ float bf2f(bf16 b) { return __uint_as_float(((unsigned)b) << 16); }
__device__ __forceinline__ float bflo(unsigned w) { return __uint_as_float(w << 16); }
__device__ __forceinline__ float bfhi(unsigned w) { return __uint_as_float(w & 0xffff0000u); }
template <int CTRL> __device__ __forceinline__ float dpp_add(float x) {
    int y = __builtin_amdgcn_update_dpp(0, __float_as_int(x), CTRL, 0xf, 0xf, true);
    return x + __int_as_float(y);
}
__device__ __forceinline__ float row16_sum(float x) { x = dpp_add<0xB1>(x); x = dpp_add<0x4E>(x); x = dpp_add<0x141>(x); x = dpp_add<0x140>(x); return x; }
__device__ __forceinline__ float wave_sum(float v) {
    v = row16_sum(v);
    const float a = __int_as_float(__builtin_amdgcn_readlane(__float_as_int(v), 0)), b = __int_as_float(__builtin_amdgcn_readlane(__float_as_int(v), 16));
    const float c = __int_as_float(__builtin_amdgcn_readlane(__float_as_int(v), 32)), d = __int_as_float(__builtin_amdgcn_readlane(__float_as_int(v), 48));
    return (a + b) + (c + d);
}
__device__ __forceinline__ unsigned pk4_fp8(float a, float b, float c, float d) {
    a = __builtin_amdgcn_fmed3f(a, -448.f, 448.f); b = __builtin_amdgcn_fmed3f(b, -448.f, 448.f); c = __builtin_amdgcn_fmed3f(c, -448.f, 448.f); d = __builtin_amdgcn_fmed3f(d, -448.f, 448.f);
    unsigned w = 0; w = __builtin_amdgcn_cvt_pk_fp8_f32(a, b, w, false); w = __builtin_amdgcn_cvt_pk_fp8_f32(c, d, w, true); return w; }
__device__ __forceinline__ float sigmoidf_(float z) { return __builtin_amdgcn_rcpf(1.0f + __expf(-z)); }

__device__ __forceinline__ unsigned char* opq(unsigned char* p) { asm volatile("" : "+s"(p)); return p; }
__device__ __forceinline__ int opq_i(int v) { asm volatile("" : "+s"(v)); return v; }
__device__ __forceinline__ int opq_v(int v) { asm volatile("" : "+v"(v)); return v; }
__device__ __forceinline__ int lane_id_asm() { int l; asm volatile("v_mbcnt_lo_u32_b32 %0, -1, 0\n\tv_mbcnt_hi_u32_b32 %0, -1, %0" : "=v"(l)); return l; }
typedef _Float16 h16x2 __attribute__((ext_vector_type(2)));
__device__ __forceinline__ float shx(float v, int lane, int m) { return __builtin_bit_cast(float, __builtin_amdgcn_ds_bpermute((lane ^ m) << 2, __builtin_bit_cast(int, v))); }
__device__ __forceinline__ float shl(float v, int src) { return __builtin_bit_cast(float, __builtin_amdgcn_ds_bpermute(src << 2, __builtin_bit_cast(int, v))); }
#define XB_TMO      128
#define XB_XCNT(j)  (256  + 64 * (j))
#define XB_XSUB(j)  (1280 + 64 * (j))
#define XB_XGEN(j)  (2304 + 64 * (j))
#define XB_TOP      3328
#define XB_TOPGEN   3392
#define XCD_BAR_WORDS 3456
#define XB_SPIN_CAP (1u << 18)
__device__ __forceinline__ unsigned xb_ld(unsigned* p)              { return __hip_atomic_load(p, __ATOMIC_RELAXED, __HIP_MEMORY_SCOPE_AGENT); }
__device__ __forceinline__ unsigned xb_add(unsigned* p, unsigned v) { return __hip_atomic_fetch_add(p, v, __ATOMIC_RELAXED, __HIP_MEMORY_SCOPE_AGENT); }
__device__ __forceinline__ unsigned xb_xcc_id() { return (unsigned)__builtin_amdgcn_s_getreg((3 << 11) | 20) & 0xFu; }
#define XB_SPIN(cond, bar) do { unsigned _sp = 0; while (cond) { __builtin_amdgcn_s_sleep(1); \
    if ((++_sp & 255u) == 0u) { if (xb_ld(&(bar)[XB_TMO])) break; if (_sp > XB_SPIN_CAP) { atomicAdd(&(bar)[XB_TMO], 1u); break; } } } } while (0)
struct XcdBarrier { unsigned* bar; unsigned x; volatile LAS unsigned* st; };
__device__ __forceinline__ XcdBarrier xcd_barrier_post(unsigned* bar, volatile LAS unsigned* st) {
    XcdBarrier b; b.bar = bar; b.x = xb_xcc_id(); b.st = st;
    if (threadIdx.x == 0) (void)xb_add(&bar[XB_XCNT(b.x)], 1u);
    return b;
}
__device__ __forceinline__ void xcd_barrier_complete(unsigned* bar, unsigned x, unsigned& nloc, unsigned& nx) {
    const unsigned G = gridDim.x * gridDim.y * gridDim.z;
    unsigned sum, cnt, mine, sp = 0u;
    for (;;) {
        sum = 0u; cnt = 0u; mine = 0u;
#pragma unroll
        for (unsigned j = 0; j < 16; ++j) { const unsigned c = xb_ld(&bar[XB_XCNT(j)]); sum += c; cnt += (c > 0u) ? 1u : 0u; mine = (j == x) ? c : mine; }
        if (sum == G) break;
        __builtin_amdgcn_s_sleep(1);
        if ((++sp & 255u) == 0u) { if (xb_ld(&bar[XB_TMO])) break; if (sp > XB_SPIN_CAP) { atomicAdd(&bar[XB_TMO], 1u); break; } }
    }
    nloc = mine > 0u ? mine : 1u; nx = cnt > 0u ? cnt : 1u;
}
__device__ __forceinline__ void xcd_barrier(const XcdBarrier& b, const bool leader  ) {
    asm volatile("s_waitcnt vmcnt(0)" ::: "memory");
    __syncthreads();
    if (leader) {
        unsigned* bar = b.bar;
        __builtin_amdgcn_s_waitcnt(0);
        unsigned nloc = b.st[0], nx = b.st[1];
        if (nloc == 0u) { xcd_barrier_complete(bar, b.x, nloc, nx); b.st[0] = nloc; b.st[1] = nx; }
        const unsigned old = xb_add(&bar[XB_XSUB(b.x)], 1u);
        const unsigned gen = old / nloc;
        if (old + 1u == (gen + 1u) * nloc) {
            __builtin_amdgcn_fence(__ATOMIC_RELEASE, "agent");
            asm volatile("s_waitcnt vmcnt(0)" ::: "memory");
            const unsigned og = xb_add(&bar[XB_TOP], 1u);
            const unsigned tg = og / nx;
            if (og + 1u == (tg + 1u) * nx) xb_add(&bar[XB_TOPGEN], 1u);
            else XB_SPIN(xb_ld(&bar[XB_TOPGEN]) == tg, bar);
            __builtin_amdgcn_fence(__ATOMIC_ACQUIRE, "agent");
            xb_add(&bar[XB_XGEN(b.x)], 1u);
            asm volatile("s_waitcnt vmcnt(0)" ::: "memory");
        } else {
            XB_SPIN(xb_ld(&bar[XB_XGEN(b.x)]) == gen, bar);
            __builtin_amdgcn_fence(__ATOMIC_ACQUIRE, "agent");
            asm volatile("s_waitcnt vmcnt(0)" ::: "memory");
        }
    }
    __syncthreads();
}

namespace pg8 {
constexpr int BM = 256, BK = 64, HALF = 128, HTB = HALF * BK * 2, STAGE_BYTES = 8 * HTB, NXCD = 8, WGM = 8;
__host__ __device__ __forceinline__ int lds_byte(int r, int c) { const int st = (r >> 4) * 2 + (c >> 5), rr = r & 15, cc = c & 31, ob = rr * 64 + cc * 2; return st * 1024 + (ob ^ (((ob >> 9) & 1) << 5)); }
__host__ __device__ __forceinline__ void stage_rc(int b, int& R, int& C) { const int st = b / 1024, sb = b % 1024, swz = sb ^ (((sb >> 9) & 1) << 5); R = (st >> 1) * 16 + swz / 64; C = (st & 1) * 32 + (swz % 64) / 2; }
__host__ __device__ __forceinline__ int perm32(int rho) { const int n = rho >> 4, i = rho & 15; return 8 * (i >> 2) + 4 * n + (i & 3); }
typedef int i32x8 __attribute__((ext_vector_type(8)));
typedef int i32x4_ __attribute__((ext_vector_type(4)));
__device__ __forceinline__ i32x8 cat8(bf16x8 a, bf16x8 b) { const i32x4_ x = __builtin_bit_cast(i32x4_, a), y = __builtin_bit_cast(i32x4_, b); return __builtin_shufflevector(x, y, 0, 1, 2, 3, 4, 5, 6, 7); }
__device__ __forceinline__ void mfma8(f32x4& acc, const i32x8 a, const i32x8 b) {
    asm volatile("v_mfma_scale_f32_16x16x128_f8f6f4 %0, %1, %2, %0, %3, %3 op_sel_hi:[0,0,0]" : "+v"(acc) : "v"(a), "v"(b), "v"(127)); }
struct Unit { int pm, pn, z; };
struct Order {
    int nM, nN, nwg, G, c;
    __device__ __forceinline__ void init(int nM_, int nN_, int G_, int c_) { nM = nM_; nN = nN_; nwg = nM * nN; G = G_; c = c_; }
    __device__ __forceinline__ bool next_mn(int i, Unit& u) const {
        const long L = (long)i * G + c; if (L >= nwg) return false;
        int wgid = (int)L; { const int q = nwg / NXCD, r = nwg % NXCD, xcd = wgid % NXCD, off = wgid / NXCD; wgid = (xcd < r ? xcd * (q + 1) : r * (q + 1) + (xcd - r) * q) + off; }
        const int nig = WGM * nN, gid = wgid / nig, fm = gid * WGM, gsz = (nM - fm) < WGM ? (nM - fm) : WGM;
        u.pm = fm + ((wgid % nig) % gsz); u.pn = (wgid % nig) / gsz; u.z = 0; return true;
    }
};

template <class Epi, class Sched, bool ALIGN_EPI, bool SP2, bool FP8 = false>
__device__ __forceinline__ void gemm_phase(LAS unsigned char* lds, const int tid_in, const char* base  , const int lda, const int ldb, const int K, const Sched& S, const Epi& E) {
    const int tid = tid_in, wid = __builtin_amdgcn_readfirstlane(tid >> 6), lane = tid & 63, wr = wid >> 2, wc = wid & 3, fr = lane & 15, fq = lane >> 4;
    const int nt = K / BK;
    unsigned voffA[2], voffB[2];
#pragma unroll
    for (int i = 0; i < 2; ++i) { int R, C; stage_rc(tid * 16 + i * 8192, R, C); const int Rb = Epi::PERM ? ((R & ~31) + perm32(R & 31)) : R;
        voffA[i] = (unsigned)(R * lda + C) * 2u; voffB[i] = (unsigned)(Rb * ldb + C) * 2u; }
    constexpr bool GATHER = Sched::GATHER;
    unsigned gvC[2][2], gvN[2][2];
#define PG8_GV(dst, unit) do { _Pragma("unroll") for (int hh_ = 0; hh_ < 2; ++hh_) _Pragma("unroll") for (int i_ = 0; i_ < 2; ++i_) { int R_, C_; stage_rc(tid * 16 + i_ * 8192, R_, C_); \
        dst[hh_][i_] = S.arow(unit, hh_ * HALF + R_) + (unsigned)C_ * 2u; } } while (0)
    const unsigned kstep = (unsigned)(BK * 2);
    const unsigned hstepA = (unsigned)(HALF * lda * 2), hstepB = (unsigned)(HALF * ldb * 2);
    const __amdgpu_buffer_rsrc_t rsrc = __builtin_amdgcn_make_buffer_rsrc((void*)base, 0, 0xffffffffu, 0x00020000);
    const unsigned ldsw = (unsigned)wid * 1024u;
    const int aoff = lds_byte(wr * 64 + fr, fq * 8), boff = lds_byte(wc * 32 + fr, fq * 8);
#define PG8_SA(b, h) (((b) * 2 + (h)) * HTB)
#define PG8_SB(b, h) ((4 + (b) * 2 + (h)) * HTB)
#define PG8_STAGE(bufoff, goff, voff) do { _Pragma("unroll") for (int _i = 0; _i < 2; ++_i) \
        __builtin_amdgcn_raw_ptr_buffer_load_lds(rsrc, (LAS unsigned*)(lds + (bufoff) + ldsw + _i * 8192), 16, (voff)[_i], (goff), 0, 0); } while (0)
#define PG8_STAGE_A(bufoff, aoff, hh, nx) do { if constexpr (GATHER) { unsigned gv_[2]; gv_[0] = (nx) ? gvN[hh][0] : gvC[hh][0]; gv_[1] = (nx) ? gvN[hh][1] : gvC[hh][1]; PG8_STAGE(bufoff, aoff, gv_); } \
        else { PG8_STAGE(bufoff, (aoff) + (hh) * hstepA, voffA); } } while (0)
#define PG8_LDA(dst, b, h) do { _Pragma("unroll") for (int m = 0; m < 4; ++m) _Pragma("unroll") for (int k = 0; k < 2; ++k) dst[m][k] = *(const LAS bf16x8*)(lds + PG8_SA(b, h) + aoff + m * 2048 + k * 1024); } while (0)
#define PG8_LDB(dst, b, h) do { _Pragma("unroll") for (int n = 0; n < 2; ++n) _Pragma("unroll") for (int k = 0; k < 2; ++k) dst[n][k] = *(const LAS bf16x8*)(lds + PG8_SB(b, h) + boff + n * 2048 + k * 1024); } while (0)
#define PG8_MMA(ai, bj, At, Bt) do { __builtin_amdgcn_s_setprio(1); \
        if constexpr (FP8) { _Pragma("unroll") for (int m = 0; m < 4; ++m) _Pragma("unroll") for (int n = 0; n < 2; ++n) \
            mfma8(acc[ai][bj][m][n], cat8(Bt[n][0], Bt[n][1]), cat8(At[m][0], At[m][1])); } \
        else { _Pragma("unroll") for (int m = 0; m < 4; ++m) _Pragma("unroll") for (int n = 0; n < 2; ++n) _Pragma("unroll") for (int k = 0; k < 2; ++k) \
            acc[ai][bj][m][n] = __builtin_amdgcn_mfma_f32_16x16x32_bf16(Bt[n][k], At[m][k], acc[ai][bj][m][n], 0, 0, 0); } \
        __builtin_amdgcn_s_setprio(0); } while (0)
#define PG8_WAIT_V(n) asm volatile("s_waitcnt vmcnt(" #n ")" ::: "memory")
#define PG8_WAIT_L(n) asm volatile("s_waitcnt lgkmcnt(" #n ")" ::: "memory")
#define PG8_BAR __builtin_amdgcn_s_barrier()
#define PG8_SCHED __builtin_amdgcn_sched_barrier(0)
    Unit cur, nxt; int ui = 0;
    if (!S.next(0, cur)) return;
    f32x4 acc[2][2][4][2];
#pragma unroll
    for (int a = 0; a < 2; ++a)
#pragma unroll
        for (int b = 0; b < 2; ++b)
#pragma unroll
            for (int m = 0; m < 4; ++m)
#pragma unroll
                for (int n = 0; n < 2; ++n) acc[a][b][m][n] = (f32x4){0.f, 0.f, 0.f, 0.f};
    bf16x8 At[4][2], B0[2][2], B1[2][2];
    unsigned cA = S.A(cur), cB = S.B(cur);
    if constexpr (GATHER) { PG8_GV(gvC, cur); _Pragma("unroll") for (int hh_ = 0; hh_ < 2; ++hh_) _Pragma("unroll") for (int i_ = 0; i_ < 2; ++i_) gvN[hh_][i_] = gvC[hh_][i_]; }
    if constexpr (SP2) {
        PG8_STAGE(PG8_SB(0, 0), cB, voffB); PG8_STAGE(PG8_SB(0, 1), cB + hstepB, voffB); PG8_STAGE_A(PG8_SA(0, 0), cA, 0, false); PG8_STAGE_A(PG8_SA(0, 1), cA, 1, false);
        if (wr == 1) PG8_BAR;
        PG8_WAIT_V(2); PG8_BAR;
        PG8_STAGE(PG8_SB(1, 0), cB + kstep, voffB); PG8_STAGE_A(PG8_SA(1, 0), cA + kstep, 0, false); PG8_STAGE(PG8_SB(1, 1), cB + hstepB + kstep, voffB);
        PG8_WAIT_V(6); PG8_BAR;
    } else {
        PG8_STAGE(PG8_SB(0, 0), cB, voffB); PG8_STAGE_A(PG8_SA(0, 0), cA, 0, false); PG8_STAGE(PG8_SB(0, 1), cB + hstepB, voffB); PG8_STAGE_A(PG8_SA(0, 1), cA, 1, false);
        if (wr == 1) PG8_BAR;
        PG8_WAIT_V(4); PG8_BAR;
        PG8_STAGE(PG8_SB(1, 0), cB + kstep, voffB); PG8_STAGE_A(PG8_SA(1, 0), cA + kstep, 0, false); PG8_STAGE(PG8_SB(1, 1), cB + hstepB + kstep, voffB);
        PG8_WAIT_V(6); PG8_BAR;
    }
    for (;;) {
        const bool has_next = S.next(ui + 1, nxt);
        const unsigned nA = has_next ? S.A(nxt) : cA, nB = has_next ? S.B(nxt) : cB;
        if constexpr (GATHER) { if (has_next) PG8_GV(gvN, nxt); }
        for (int t = 0; t < nt; t += 2) {
            const bool last = (t == nt - 2);
            const unsigned a1 = cA + (unsigned)(t + 1) * kstep;
            const unsigned a2 = last ? nA : cA + (unsigned)(t + 2) * kstep, b2 = last ? nB : cB + (unsigned)(t + 2) * kstep;
            const unsigned a3 = a2 + kstep, b3 = b2 + kstep;
            if constexpr (SP2) {
            PG8_LDB(B0, 0, 0); PG8_LDB(B1, 0, 1); PG8_SCHED; PG8_LDA(At, 0, 0); PG8_STAGE_A(PG8_SA(1, 1), a1, 1, false);
            PG8_WAIT_V(8); PG8_WAIT_L(0); PG8_BAR; PG8_MMA(0, 0, At, B0); PG8_MMA(0, 1, At, B1); PG8_BAR; PG8_SCHED;
            PG8_LDA(At, 0, 1); PG8_STAGE(PG8_SB(0, 0), b2, voffB); PG8_STAGE(PG8_SB(0, 1), b2 + hstepB, voffB); PG8_STAGE_A(PG8_SA(0, 0), a2, 0, last);
            PG8_WAIT_V(8); PG8_WAIT_L(0); PG8_BAR; PG8_MMA(1, 0, At, B0); PG8_MMA(1, 1, At, B1); PG8_BAR; PG8_SCHED;
            PG8_LDB(B0, 1, 0); PG8_LDB(B1, 1, 1); PG8_SCHED; PG8_LDA(At, 1, 0); PG8_STAGE_A(PG8_SA(0, 1), a2, 1, last);
            PG8_WAIT_V(8); PG8_WAIT_L(0); PG8_BAR; PG8_MMA(0, 0, At, B0); PG8_MMA(0, 1, At, B1); PG8_BAR; PG8_SCHED;
            PG8_LDA(At, 1, 1); PG8_STAGE(PG8_SB(1, 0), b3, voffB); PG8_STAGE(PG8_SB(1, 1), b3 + hstepB, voffB); PG8_STAGE_A(PG8_SA(1, 0), a3, 0, last);
            PG8_WAIT_V(8); PG8_WAIT_L(0); PG8_BAR; PG8_MMA(1, 0, At, B0); PG8_MMA(1, 1, At, B1); PG8_BAR; PG8_SCHED;
            } else {
            PG8_LDB(B0, 0, 0); PG8_SCHED; PG8_LDA(At, 0, 0); PG8_STAGE_A(PG8_SA(1, 1), a1, 1, false);
            PG8_WAIT_L(8); PG8_BAR; PG8_WAIT_L(0); PG8_MMA(0, 0, At, B0); PG8_BAR; PG8_SCHED;
            PG8_LDB(B1, 0, 1); PG8_STAGE(PG8_SB(0, 0), b2, voffB);
            PG8_BAR; PG8_WAIT_L(0); PG8_MMA(0, 1, At, B1); PG8_BAR;
            PG8_LDA(At, 0, 1); PG8_STAGE_A(PG8_SA(0, 0), a2, 0, last);
            PG8_BAR; PG8_WAIT_L(0); PG8_MMA(1, 0, At, B0); PG8_BAR; PG8_SCHED;
            PG8_STAGE(PG8_SB(0, 1), b2 + hstepB, voffB);
            PG8_WAIT_V(6); PG8_BAR; PG8_MMA(1, 1, At, B1); PG8_BAR;
            PG8_LDB(B0, 1, 0); PG8_SCHED; PG8_LDA(At, 1, 0); PG8_STAGE_A(PG8_SA(0, 1), a2, 1, last);
            PG8_WAIT_L(8); PG8_BAR; PG8_WAIT_L(0); PG8_MMA(0, 0, At, B0); PG8_BAR; PG8_SCHED;
            PG8_LDB(B1, 1, 1); PG8_STAGE(PG8_SB(1, 0), b3, voffB);
            PG8_BAR; PG8_WAIT_L(0); PG8_MMA(0, 1, At, B1); PG8_BAR;
            PG8_LDA(At, 1, 1); PG8_STAGE_A(PG8_SA(1, 0), a3, 0, last);
            PG8_BAR; PG8_WAIT_L(0); PG8_MMA(1, 0, At, B0); PG8_BAR; PG8_SCHED;
            PG8_STAGE(PG8_SB(1, 1), b3 + hstepB, voffB);
            PG8_WAIT_V(6); PG8_BAR; PG8_MMA(1, 1, At, B1); PG8_BAR;
            }
        }
        if constexpr (ALIGN_EPI) { if (wr == 0) PG8_BAR; }
        if constexpr (FP8) asm volatile("s_nop 15\n\ts_nop 15\n\ts_nop 7" ::: "memory");
        E(acc, cur, wr, wc, fr, fq);
        if (!has_next) break;
#pragma unroll
        for (int a = 0; a < 2; ++a)
#pragma unroll
            for (int b = 0; b < 2; ++b)
#pragma unroll
                for (int m = 0; m < 4; ++m)
#pragma unroll
                    for (int n = 0; n < 2; ++n) acc[a][b][m][n] = (f32x4){0.f, 0.f, 0.f, 0.f};
        cur = nxt; cA = nA; cB = nB; ++ui;
        if constexpr (GATHER) { _Pragma("unroll") for (int hh_ = 0; hh_ < 2; ++hh_) _Pragma("unroll") for (int i_ = 0; i_ < 2; ++i_) gvC[hh_][i_] = gvN[hh_][i_]; }
        if constexpr (ALIGN_EPI) { if (wr == 1) PG8_BAR; }
    }
    PG8_WAIT_V(0);
    if constexpr (!ALIGN_EPI) { if (wr == 0) PG8_BAR; }
    PG8_BAR;
#undef PG8_SA
#undef PG8_SB
#undef PG8_STAGE
#undef PG8_STAGE_A
#undef PG8_GV
#undef PG8_LDA
#undef PG8_LDB
#undef PG8_MMA
#undef PG8_WAIT_V
#undef PG8_WAIT_L
#undef PG8_BAR
#undef PG8_SCHED
}

struct SchedPlain : Order {
    static constexpr bool GATHER = false; __device__ __forceinline__ unsigned arow(const Unit&, int) const { return 0u; }
    unsigned A0, B0, at, bt;
    __device__ __forceinline__ bool next(int i, Unit& u) const { return next_mn(i, u); }
    __device__ __forceinline__ unsigned A(const Unit& u) const { return A0 + (unsigned)u.pm * at; }
    __device__ __forceinline__ unsigned B(const Unit& u) const { return B0 + (unsigned)u.pn * bt; }
};
struct SchedLora : Order {
    static constexpr bool GATHER = false; __device__ __forceinline__ unsigned arow(const Unit&, int) const { return 0u; }
    unsigned A0, B0; int skipv;
    __device__ __forceinline__ bool next(int i, Unit& u) const { if (!next_mn(i, u)) return false; if (skipv && u.pn >= 12) u.pn += 6; return true; }
    __device__ __forceinline__ unsigned A(const Unit& u) const { return A0 + (unsigned)u.pm * (256u * 512u * 2u) + (u.pn >= 18 ? 512u : 0u); }
    __device__ __forceinline__ unsigned B(const Unit& u) const { return B0 + (unsigned)u.pn * (256u * 256u * 2u); }
};
struct SchedMem {
    static constexpr bool GATHER = false; __device__ __forceinline__ unsigned arow(const Unit&, int) const { return 0u; }
    int G, c; unsigned memb, wkv;
    __device__ __forceinline__ bool next(int i, Unit& u) const {
        const int L = i * G + c; if (L >= 64) return false;
        if (L < 32) { u.z = 0; u.pm = L >> 1; u.pn = L & 1; } else { const int q = L - 32; u.z = 1; u.pm = q & 1; u.pn = q >> 1; }
        return true;
    }
    __device__ __forceinline__ unsigned A(const Unit& u) const { return u.z == 0 ? memb + (unsigned)u.pm * (256u * 2048u * 2u) : wkv + (unsigned)(2 + u.pm) * (256u * 2048u * 2u); }
    __device__ __forceinline__ unsigned B(const Unit& u) const { return u.z == 0 ? wkv + (unsigned)u.pn * (256u * 2048u * 2u) : memb + (unsigned)u.pn * (256u * 2048u * 2u); }
};
struct SchedMoE : Order {
    static constexpr bool GATHER = false; __device__ __forceinline__ unsigned arow(const Unit&, int) const { return 0u; }
    unsigned A0, B0, at, bt, be; const int* texp;
    __device__ __forceinline__ bool next(int i, Unit& u) const { if (!next_mn(i, u)) return false; u.z = __builtin_amdgcn_readfirstlane(texp[u.pm]); return true; }
    __device__ __forceinline__ unsigned A(const Unit& u) const { return A0 + (unsigned)u.pm * at; }
    __device__ __forceinline__ unsigned B(const Unit& u) const { return B0 + (unsigned)u.z * be + (unsigned)u.pn * bt; }
};

struct SchedMoEg : Order {
    static constexpr bool GATHER = true;
    unsigned B0, bt, be, xoff, zoff; const int* texp; const int* slot_tok;
    __device__ __forceinline__ bool next(int i, Unit& u) const { if (!next_mn(i, u)) return false; u.z = __builtin_amdgcn_readfirstlane(texp[u.pm]); return true; }
    __device__ __forceinline__ unsigned A(const Unit&) const { return 0u; }
    __device__ __forceinline__ unsigned B(const Unit& u) const { return B0 + (unsigned)u.z * be + (unsigned)u.pn * bt; }
    __device__ __forceinline__ unsigned arow(const Unit& u, int r) const { const int tok = slot_tok[u.pm * 256 + r]; return tok < 0 ? zoff : xoff + (unsigned)tok * 2048u; }
};

struct EpiBf16 {
    static constexpr bool PERM = true;
    bf16* O; int ldc;
    __device__ __forceinline__ void operator()(const f32x4 (&acc)[2][2][4][2], const Unit& u, int wr, int wc, int fr, int fq) const {
        const int row0 = u.pm * BM + wr * 64 + fr, col0 = u.pn * BM + wc * 32 + 8 * fq;
#pragma unroll
        for (int ai = 0; ai < 2; ++ai)
#pragma unroll
            for (int m = 0; m < 4; ++m) { bf16* rowp = O + (size_t)(row0 + ai * HALF + m * 16) * ldc + col0;
#pragma unroll
                for (int bj = 0; bj < 2; ++bj) { const f32x4 v0 = acc[ai][bj][m][0], v1 = acc[ai][bj][m][1];
                    u32x4 w; w.x = cvt_pk_bf16(v0[0], v0[1]); w.y = cvt_pk_bf16(v0[2], v0[3]); w.z = cvt_pk_bf16(v1[0], v1[1]); w.w = cvt_pk_bf16(v1[2], v1[3]);
                    *(u32x4*)(rowp + bj * HALF) = w; } }
    }
};
struct EpiMem {
    static constexpr bool PERM = true;
    bf16* O0; bf16* O1;
    __device__ __forceinline__ void operator()(const f32x4 (&acc)[2][2][4][2], const Unit& u, int wr, int wc, int fr, int fq) const {
        EpiBf16 e; e.O = u.z == 0 ? O0 : O1; e.ldc = u.z == 0 ? 512 : 4096; e(acc, u, wr, wc, fr, fq);
    }
};
struct EpiLora {
    static constexpr bool PERM = true;
    bf16* O; const float* vecs;
    __device__ __forceinline__ void operator()(const f32x4 (&acc)[2][2][4][2], const Unit& u, int wr, int wc, int fr, int fq) const {
        const int type = u.pn / 6;
        const int row0 = u.pm * BM + wr * 64 + fr, col0 = u.pn * BM + wc * 32 + 8 * fq, cb0 = (u.pn % 6) * BM + wc * 32 + 8 * fq;
        const float* bp = vecs + (type < 3 ? type : 0) * SW;
        const float sc = type == 0 ? 0.6065306597126334f : 1.0f;
#pragma unroll
        for (int bj = 0; bj < 2; ++bj) {
            f32x4 bv0 = (f32x4){0.f, 0.f, 0.f, 0.f}, bv1 = bv0;
            if (type < 3) { bv0 = *(const f32x4*)(bp + cb0 + bj * HALF); bv1 = *(const f32x4*)(bp + cb0 + bj * HALF + 4); }
#pragma unroll
            for (int ai = 0; ai < 2; ++ai)
#pragma unroll
                for (int m = 0; m < 4; ++m) { bf16* rowp = O + (size_t)(row0 + ai * HALF + m * 16) * 6144 + col0 + bj * HALF;
                    f32x4 v0_ = acc[ai][bj][m][0] + bv0, v1_ = acc[ai][bj][m][1] + bv1;
                    if (type < 3) {
#pragma unroll
                        for (int j = 0; j < 4; ++j) { v0_[j] = sc * sigmoidf_(v0_[j]); v1_[j] = sc * sigmoidf_(v1_[j]); } }
                    u32x4 w; w.x = cvt_pk_bf16(v0_[0], v0_[1]); w.y = cvt_pk_bf16(v0_[2], v0_[3]); w.z = cvt_pk_bf16(v1_[0], v1_[1]); w.w = cvt_pk_bf16(v1_[2], v1_[3]);
                    *(u32x4*)rowp = w; asm volatile("" ::: "memory"); }
        }
    }
};
struct EpiSwiglu {
    static constexpr bool PERM = true;
    bf16* O; int ldc;
    __device__ __forceinline__ void operator()(const f32x4 (&acc)[2][2][4][2], const Unit& u, int wr, int wc, int fr, int fq) const {
        const int row0 = u.pm * BM + wr * 64 + fr, col0 = u.pn * HALF + wc * 32 + 8 * fq;
#pragma unroll
        for (int ai = 0; ai < 2; ++ai)
#pragma unroll
            for (int m = 0; m < 4; ++m) { bf16* rowp = O + (size_t)(row0 + ai * HALF + m * 16) * ldc + col0;
                float h[8];
#pragma unroll
                for (int n = 0; n < 2; ++n)
#pragma unroll
                    for (int j = 0; j < 4; ++j) { const float g = acc[ai][0][m][n][j], up = acc[ai][1][m][n][j]; h[n * 4 + j] = g * sigmoidf_(g) * up; }
                u32x4 w; w.x = cvt_pk_bf16(h[0], h[1]); w.y = cvt_pk_bf16(h[2], h[3]); w.z = cvt_pk_bf16(h[4], h[5]); w.w = cvt_pk_bf16(h[6], h[7]);
                *(u32x4*)rowp = w; asm volatile("" ::: "memory"); }
    }
};
struct EpiSwiglu8 {
    static constexpr bool PERM = true;
    unsigned char* O; int ldc; float inv, so;
    __device__ __forceinline__ void operator()(const f32x4 (&acc)[2][2][4][2], const Unit& u, int wr, int wc, int fr, int fq) const {
        const int row0 = u.pm * BM + wr * 64 + fr, col0 = u.pn * HALF + wc * 32 + 8 * fq;
        const float c1 = -inv * 1.4426950408889634f, c2 = inv * inv * so;
#pragma unroll
        for (int ai = 0; ai < 2; ++ai)
#pragma unroll
            for (int m = 0; m < 4; ++m) { unsigned char* rowp = O + (size_t)(row0 + ai * HALF + m * 16) * ldc + col0;
                float h[8];
#pragma unroll
                for (int n = 0; n < 2; ++n)
#pragma unroll
                    for (int j = 0; j < 4; ++j) { const float ag = acc[ai][0][m][n][j], au = acc[ai][1][m][n][j];
                        h[n * 4 + j] = (ag * au) * __builtin_amdgcn_rcpf(1.0f + __builtin_amdgcn_exp2f(ag * c1)) * c2; }
                u32x2 w; w.x = pk4_fp8(h[0], h[1], h[2], h[3]); w.y = pk4_fp8(h[4], h[5], h[6], h[7]);
                *(u32x2*)rowp = w; asm volatile("" ::: "memory"); }
    }
};
struct EpiBf16S {
    static constexpr bool PERM = true;
    bf16* O; int ldc; float sc;
    __device__ __forceinline__ void operator()(const f32x4 (&acc)[2][2][4][2], const Unit& u, int wr, int wc, int fr, int fq) const {
        const int row0 = u.pm * BM + wr * 64 + fr, col0 = u.pn * BM + wc * 32 + 8 * fq;
#pragma unroll
        for (int ai = 0; ai < 2; ++ai)
#pragma unroll
            for (int m = 0; m < 4; ++m) { bf16* rowp = O + (size_t)(row0 + ai * HALF + m * 16) * ldc + col0;
#pragma unroll
                for (int bj = 0; bj < 2; ++bj) { const f32x4 v0 = acc[ai][bj][m][0] * sc, v1 = acc[ai][bj][m][1] * sc;
                    u32x4 w; w.x = cvt_pk_bf16(v0[0], v0[1]); w.y = cvt_pk_bf16(v0[2], v0[3]); w.z = cvt_pk_bf16(v1[0], v1[1]); w.w = cvt_pk_bf16(v1[2], v1[3]);
                    *(u32x4*)(rowp + bj * HALF) = w; } }
    }
};
struct EpiFp8S {
    static constexpr bool PERM = true;
    unsigned char* O; int ldc; float sc;
    __device__ __forceinline__ void operator()(const f32x4 (&acc)[2][2][4][2], const Unit& u, int wr, int wc, int fr, int fq) const {
        const int row0 = u.pm * BM + wr * 64 + fr, col0 = u.pn * BM + wc * 32 + 8 * fq;
#pragma unroll
        for (int ai = 0; ai < 2; ++ai)
#pragma unroll
            for (int m = 0; m < 4; ++m) { unsigned char* rowp = O + (size_t)(row0 + ai * HALF + m * 16) * ldc + col0;
#pragma unroll
                for (int bj = 0; bj < 2; ++bj) { const f32x4 v0 = acc[ai][bj][m][0] * sc, v1 = acc[ai][bj][m][1] * sc;
                    u32x2 w; w.x = pk4_fp8(v0[0], v0[1], v0[2], v0[3]); w.y = pk4_fp8(v1[0], v1[1], v1[2], v1[3]);
                    *(u32x2*)(rowp + bj * HALF) = w; } }
    }
};
struct EpiRes {
    static constexpr bool PERM = false;
    const float* X; float* T;
    __device__ __forceinline__ void operator()(const f32x4 (&acc)[2][2][4][2], const Unit& u, int wr, int wc, int fr, int fq) const {
        const int row0 = u.pm * BM + wr * 64 + fr, col0 = u.pn * BM + wc * 32 + 4 * fq;
#pragma unroll
        for (int ai = 0; ai < 2; ++ai)
#pragma unroll
            for (int m = 0; m < 4; ++m) { const size_t off = (size_t)(row0 + ai * HALF + m * 16) * D + col0;
#pragma unroll
                for (int bj = 0; bj < 2; ++bj)
#pragma unroll
                    for (int n = 0; n < 2; ++n) { const f32x4 xv = *(const f32x4*)(X + off + bj * HALF + n * 16);
                        *(f32x4*)(T + off + bj * HALF + n * 16) = xv * ALPHA + acc[ai][bj][m][n]; } }
    }
};
}

struct Args {
    const float* in[43];
    float* out; unsigned char* ws;
    int ph_lo, ph_hi;
};
struct Ctx { LAS unsigned char* lds; int tid, lane, wave, bid, G, gw, NGW; unsigned char* ws; };

enum { I_X = 0, I_MEM = 1, I_POS = 2, I_WKV = 3,
       L0_WIN = 4, L0_MU, L0_LW, L0_LA, L0_LG, L0_VECS, L0_WOUT, L0_NORMS, L0_FG, L0_FU, L0_FD,
       L1_WIN = 15, L1_GN, L1_WOUT, L1_NORMS, L1_ROUTER, L1_MG, L1_MU_, L1_MD,
       L2_WIN = 23, L2_MU, L2_LW, L2_LA, L2_LV, L2_LG, L2_VECS, L2_WOUT, L2_NORMS, L2_FG, L2_FU, L2_FD,
       L3_WIN = 35, L3_GN, L3_WOUT, L3_NORMS, L3_ROUTER, L3_MG, L3_MU_, L3_MD };

__device__ __forceinline__ void tr_load(f32x4 (&v)[8], const float* W, int ldw, int k0, int n0, int lane) {
#pragma unroll
    for (int i = 0; i < 8; ++i) v[i] = *(const f32x4*)(W + (size_t)(k0 + 8 * i + (lane >> 3)) * ldw + n0 + 4 * (lane & 7));
}
__device__ __forceinline__ void tr_store(const f32x4 (&v)[8], int k0, bf16* WT, int ldt, int drow0, LAS float* scr, int lane) {
#pragma unroll
    for (int i = 0; i < 8; ++i) { LAS float* d = scr + (8 * i + (lane >> 3)) * 33 + 4 * (lane & 7); d[0] = v[i][0]; d[1] = v[i][1]; d[2] = v[i][2]; d[3] = v[i][3]; }
    LDS_WAIT(); asm volatile("" ::: "memory");
    const int c = lane & 7;
#pragma unroll
    for (int j = 0; j < 4; ++j) { const int n = (lane >> 3) + 8 * j; const LAS float* s = scr + (8 * c) * 33 + n;
        u32x4 o; o.x = cvt_pk_bf16(s[0 * 33], s[1 * 33]); o.y = cvt_pk_bf16(s[2 * 33], s[3 * 33]); o.z = cvt_pk_bf16(s[4 * 33], s[5 * 33]); o.w = cvt_pk_bf16(s[6 * 33], s[7 * 33]);
        *(u32x4*)(WT + (size_t)(drow0 + n) * ldt + k0 + 8 * c) = o; }
    LDS_WAIT(); asm volatile("" ::: "memory");
}
__device__ __forceinline__ void conv_mat(const Ctx& C, const float* W, int K, int N, bf16* WT, int mode, int off, int gw0) {
    LAS float* scr = (LAS float*)(C.lds + C.wave * 16384);
    const int nblk = N / 32, items = (K / 64) * nblk;
    int start = C.gw - gw0; if (start < 0) start += C.NGW;
#define CONV_DROW(n0_) (mode == 0 ? off + (n0_) : ((n0_) / 128) * 256 + off + ((n0_) % 128))
    f32x4 va[8], vb[8];
    int it = start;
    if (it < items) tr_load(va, W, N, 64 * (it / nblk), 32 * (it % nblk), C.lane);
    while (it < items) {
        const int it1 = it + C.NGW;
        if (it1 < items) tr_load(vb, W, N, 64 * (it1 / nblk), 32 * (it1 % nblk), C.lane);
        tr_store(va, 64 * (it / nblk), WT, K, CONV_DROW(32 * (it % nblk)), scr, C.lane);
        if (it1 >= items) break;
        const int it2 = it1 + C.NGW;
        if (it2 < items) tr_load(va, W, N, 64 * (it2 / nblk), 32 * (it2 % nblk), C.lane);
        tr_store(vb, 64 * (it1 / nblk), WT, K, CONV_DROW(32 * (it1 % nblk)), scr, C.lane);
        it = it2;
    }
#undef CONV_DROW
}
__device__ __forceinline__ void conv_lora(const Ctx& C, const float* lw, const float* la, const float* lv, const float* lg, bf16* Bt) {
    for (int idx = C.bid * NTHR + C.tid; idx < 6144 * 256; idx += C.G * NTHR) {
        const int n_ = idx % 1536, rest = idx / 1536, k = rest % 256, blk = rest / 256;
        float v = 0.f;
        if (blk == 0) { if (k < 96) v = lw[k * 1536 + n_]; }
        else if (blk == 1) { if (k >= 96 && k < 192) v = la[(k - 96) * 1536 + n_]; }
        else if (blk == 2) { if (lv && k >= 192) v = lv[(k - 192) * 1536 + n_]; }
        else v = lg[k * 1536 + n_];
        Bt[(size_t)(blk * 1536 + n_) * 256 + k] = f2bf(v);
    }
}
__device__ __forceinline__ void conv_f32_bf16(const Ctx& C, const float* src, bf16* dst, size_t n8) {
    const size_t T = (size_t)C.G * NTHR;
    for (size_t i0 = (size_t)C.bid * NTHR + C.tid; i0 < n8; i0 += 4 * T) { f32x4 av[4], bv[4];
#pragma unroll
        for (int q = 0; q < 4; ++q) { av[q] = ((const f32x4*)src)[2 * (i0 + q * T)]; bv[q] = ((const f32x4*)src)[2 * (i0 + q * T) + 1]; }
#pragma unroll
        for (int q = 0; q < 4; ++q) { const f32x4 a = av[q], b = bv[q];
            u32x4 w; w.x = cvt_pk_bf16(a[0], a[1]); w.y = cvt_pk_bf16(a[2], a[3]); w.z = cvt_pk_bf16(b[0], b[1]); w.w = cvt_pk_bf16(b[2], b[3]);
            ((u32x4*)dst)[i0 + q * T] = w; } }
}

struct CvJob { const float* W; bf16* WT; int N, K, k0, n0, mode, off; float f8s; };
__device__ __forceinline__ void cv_load(f32x4 (&v)[8], const CvJob& J, int wave, int lane) {
    const int n = J.n0 + 4 * lane;
#pragma unroll
    for (int i = 0; i < 8; ++i) { v[i] = (f32x4){0.f, 0.f, 0.f, 0.f}; if (n < J.N) v[i] = *(const f32x4*)(J.W + (size_t)(J.k0 + 8 * wave + i) * J.N + n); }
}
__device__ __forceinline__ void cv_put(const f32x4 (&v)[8], LAS float* T, int wave, int lane) {
#pragma unroll
    for (int i = 0; i < 8; ++i) *(LAS f32x4*)(T + (8 * wave + i) * 256 + 4 * (lane ^ wave)) = v[i];
}
__device__ __forceinline__ void cv_out(const CvJob& J, const LAS float* T, int wave, int lane) {
    const int c = lane & 7;
#pragma unroll
    for (int j = 0; j < 4; ++j) { const int nl = 32 * wave + 8 * j + (lane >> 3), n = J.n0 + nl; const LAS float* s = T + (8 * c) * 256 + (nl ^ (c << 2));
        u32x4 o; o.x = cvt_pk_bf16(s[0 * 256], s[1 * 256]); o.y = cvt_pk_bf16(s[2 * 256], s[3 * 256]); o.z = cvt_pk_bf16(s[4 * 256], s[5 * 256]); o.w = cvt_pk_bf16(s[6 * 256], s[7 * 256]);
        if (n < J.N) { const int drow = J.mode == 0 ? J.off + n : (n / 128) * 256 + J.off + (n % 128);
            *(u32x4*)(J.WT + (size_t)drow * J.K + J.k0 + 8 * c) = o; } }
}
__device__ __forceinline__ void cv_out8(const CvJob& J, const LAS float* T, int wave, int lane) {
    const int c4 = lane & 3; unsigned char* W8 = (unsigned char*)J.WT;
#pragma unroll
    for (int j = 0; j < 2; ++j) { const int nl = 32 * wave + 16 * j + (lane >> 2), n = J.n0 + nl;
        float v[16];
#pragma unroll
        for (int q = 0; q < 16; ++q) { const int k = 16 * c4 + q; v[q] = T[k * 256 + (nl ^ (((k >> 3) & 7) << 2))] * J.f8s; }
        u32x4 o; o.x = pk4_fp8(v[0], v[1], v[2], v[3]); o.y = pk4_fp8(v[4], v[5], v[6], v[7]); o.z = pk4_fp8(v[8], v[9], v[10], v[11]); o.w = pk4_fp8(v[12], v[13], v[14], v[15]);
        if (n < J.N) { const int drow = J.mode == 0 ? J.off + n : (n / 128) * 256 + J.off + (n % 128);
            *(u32x4*)(W8 + (size_t)drow * J.K + J.k0 + 16 * c4) = o; } }
}
template <class Dec>
__device__ __forceinline__ void conv_run(const Ctx& C, int ntiles, const Dec& dec, const int t0 = -1, const int STR = GRID) {
    LAS float* T = (LAS float*)C.lds;
    f32x4 va[8], vb[8]; CvJob ja, jb, jc;
    int t = t0 < 0 ? C.bid : t0;
    if (t < ntiles) { dec(t, ja); cv_load(va, ja, C.wave, C.lane); }
    if (t + STR < ntiles) { dec(t + STR, jb); cv_load(vb, jb, C.wave, C.lane); }
    while (t < ntiles) {
        __syncthreads(); cv_put(va, T, C.wave, C.lane); jc = ja;
        if (t + 2 * STR < ntiles) { dec(t + 2 * STR, ja); cv_load(va, ja, C.wave, C.lane); }
        __syncthreads(); if (jc.f8s > 0.f) cv_out8(jc, T, C.wave, C.lane); else cv_out(jc, T, C.wave, C.lane);
        t += STR; if (t >= ntiles) break;
        __syncthreads(); cv_put(vb, T, C.wave, C.lane); jc = jb;
        if (t + 2 * STR < ntiles) { dec(t + 2 * STR, jb); cv_load(vb, jb, C.wave, C.lane); }
        __syncthreads(); if (jc.f8s > 0.f) cv_out8(jc, T, C.wave, C.lane); else cv_out(jc, T, C.wave, C.lane);
        t += STR;
    }
    __syncthreads();
}
struct MoeDec { const float* mg; const float* mu; const float* md; unsigned char* ws;
    __device__ __forceinline__ void operator()(int t, CvJob& J) const {
        const int j = t / 704, r = t % 704, e = j / 3, kind = j % 3;
        if (kind < 2) { J.W = (kind == 0 ? mg : mu) + (size_t)e * 2048 * 5632; J.WT = (bf16*)(ws + WS_MWGU + (size_t)e * 22 * MiB); J.N = 5632; J.K = 2048; J.mode = 1; J.off = kind * 128; J.f8s = 1024.f; J.k0 = 64 * (r / 22); J.n0 = 256 * (r % 22); }
        else { J.W = md + (size_t)e * 2048 * 5632; J.WT = (bf16*)(ws + WS_MWD + (size_t)e * 11 * MiB); J.N = 2048; J.K = 5632; J.mode = 0; J.off = 0; J.f8s = 2048.f; J.k0 = 64 * (r / 8); J.n0 = 256 * (r % 8); }
    } };
struct StaticDec { const float* const* in; unsigned char* ws;
    __device__ __forceinline__ void set(CvJob& J, const float* W, bf16* WT, int K, int N, int mode, int off, int r, float f8s = 0.f) const {
        const int nn = (N + 255) / 256; J.W = W; J.WT = WT; J.N = N; J.K = K; J.mode = mode; J.off = off; J.f8s = f8s; J.k0 = 64 * (r / nn); J.n0 = 256 * (r % nn); }
    __device__ __forceinline__ void operator()(int t, CvJob& J) const {
        int r = t;
        if (r < 128) { set(J, in[I_WKV], (bf16*)(ws + WS_WKV), 2048, 1024, 0, 0, r); return; } r -= 128;
        set(J, in[L0_WIN], (bf16*)(ws + WS_WIN), 2048, 5568, 0, 0, r);
    } };

struct SlotDec { const float* const* in; unsigned char* ws; int lq; MoeDec moe; StaticDec sd;
    __device__ __forceinline__ void operator()(int t, CvJob& J) const {
        if (t < 16896) { moe(t, J); return; }
        int r = t - 16896; const size_t l = (size_t)lq;
        if (r < 704) { sd.set(J, lq ? in[L2_FG] : in[L0_FG], (bf16*)(ws + WS_WFGU + l * 44 * MiB), 2048, 5632, 1, 0, r, 1024.f); return; } r -= 704;
        if (r < 704) { sd.set(J, lq ? in[L2_FU] : in[L0_FU], (bf16*)(ws + WS_WFGU + l * 44 * MiB), 2048, 5632, 1, 128, r, 1024.f); return; } r -= 704;
        if (r < 704) { sd.set(J, lq ? in[L2_FD] : in[L0_FD], (bf16*)(ws + WS_WFD + l * 22 * MiB), 5632, 2048, 0, 0, r, 2048.f); return; } r -= 704;
        if (r < 256) { sd.set(J, lq ? in[L2_WOUT] : in[L0_WOUT], (bf16*)(ws + WS_WOUT + l * 16 * MiB), 2048, 2048, 0, 0, r); return; } r -= 256;
        if (r < 256) { sd.set(J, lq ? in[L3_WOUT] : in[L1_WOUT], (bf16*)(ws + WS_WOUT + (l * 16 + 8) * MiB), 2048, 2048, 0, 0, r); return; } r -= 256;
        if (r < 640) { sd.set(J, lq ? in[L3_WIN] : in[L1_WIN], (bf16*)(ws + WS_WIN + (l * 44 + 22) * MiB), 2048, 5120, 0, 0, r); return; } r -= 640;
        sd.set(J, in[L2_WIN], (bf16*)(ws + WS_WIN + (size_t)44 * MiB), 2048, 5632, 0, 0, r);
    } };

__device__ __forceinline__ void ph_prologue(const Ctx& C, const Args& A) {
    unsigned char* ws = C.ws;
    { StaticDec dec; dec.in = A.in; dec.ws = ws; conv_run(C, 832, dec); }
    conv_lora(C, A.in[L0_LW], A.in[L0_LA], nullptr, A.in[L0_LG], (bf16*)(ws + WS_WLORA));
    conv_lora(C, A.in[L2_LW], A.in[L2_LA], A.in[L2_LV], A.in[L2_LG], (bf16*)(ws + WS_WLORA + 3 * MiB));
    { u32x4* z = (u32x4*)(ws + WS_WIN + (size_t)5568 * 2048 * 2);
      for (int i = C.bid * NTHR + C.tid; i < 64 * 2048 * 2 / 16; i += C.G * NTHR) z[i] = (u32x4){0u, 0u, 0u, 0u}; }
    { const f32x4* xs = (const f32x4*)A.in[I_X]; u32x2* hi = (u32x2*)(ws + WS_XB); unsigned* lo = (unsigned*)(ws + WS_XLO);
      const size_t T = (size_t)C.G * NTHR;
      for (size_t i0 = (size_t)C.bid * NTHR + C.tid; i0 < (size_t)M * D / 4; i0 += 8 * T) { f32x4 ov[8];
#pragma unroll
          for (int q = 0; q < 8; ++q) ov[q] = xs[i0 + q * T];
#pragma unroll
          for (int q = 0; q < 8; ++q) { const f32x4 o = ov[q]; const size_t i = i0 + q * T;
              u32x2 w; w.x = cvt_pk_bf16(o[0], o[1]); w.y = cvt_pk_bf16(o[2], o[3]); hi[i] = w;
              lo[i] = pk4_fp8((o[0] - bflo(w.x)) * 8192.f, (o[1] - bfhi(w.x)) * 8192.f, (o[2] - bflo(w.y)) * 8192.f, (o[3] - bfhi(w.y)) * 8192.f); } } }
    conv_f32_bf16(C, A.in[I_MEM], (bf16*)(ws + WS_MEMB), (size_t)4096 * 2048 / 8);
    { const int* pos = (const int*)A.in[I_POS]; f32x2* cs = (f32x2*)(ws + WS_CS);
      for (int idx = C.bid * NTHR + C.tid; idx < M * 64; idx += C.G * NTHR) {
          const int m = idx >> 6, i = idx & 63;
          const float pw = (float)exp2(13.287712379549449 * (double)i / 64.0);
          const float inv = 1.0f / pw;
          const float ang = (float)pos[m] * inv;
          const double x = (double)ang;
          const double n = rint(x * 0.15915494309189535);
          const double r = fma(-n, 6.283185307179586, x) - n * 2.4492935982947064e-16;
          const double r2 = r * r;
          double s = -1.0 / 121645100408832000.0;
          s = fma(s, r2, 1.0 / 355687428096000.0);
          s = fma(s, r2, -1.0 / 1307674368000.0);
          s = fma(s, r2, 1.0 / 6227020800.0);
          s = fma(s, r2, -1.0 / 39916800.0);
          s = fma(s, r2, 1.0 / 362880.0);
          s = fma(s, r2, -1.0 / 5040.0);
          s = fma(s, r2, 1.0 / 120.0);
          s = fma(s, r2, -1.0 / 6.0);
          s = fma(s * r2, r, r);
          double c = 1.0 / 2432902008176640000.0;
          c = fma(c, r2, -1.0 / 6402373705728000.0);
          c = fma(c, r2, 1.0 / 20922789888000.0);
          c = fma(c, r2, -1.0 / 87178291200.0);
          c = fma(c, r2, 1.0 / 479001600.0);
          c = fma(c, r2, -1.0 / 3628800.0);
          c = fma(c, r2, 1.0 / 40320.0);
          c = fma(c, r2, -1.0 / 720.0);
          c = fma(c, r2, 1.0 / 24.0);
          c = fma(c, r2, -0.5);
          c = fma(c, r2, 1.0);
          cs[idx] = (f32x2){(float)c, (float)s};
      } }
}

struct LnRow { u32x2 rh[8]; unsigned rl[8]; u32x2 a[8]; float w1, w2; };
__device__ __forceinline__ void ln_load(LnRow& R, const Ctx& C, int m, const void* Hp, int hmode, int s1, int s2, float w1, float w2) {
    const u32x2* hr = (const u32x2*)(C.ws + WS_XB + (size_t)m * D * 2) + C.lane;
    const unsigned* lr = (const unsigned*)(C.ws + (hmode == 0 ? WS_XLO : WS_X8) + (size_t)m * D) + C.lane;
#pragma unroll
    for (int j = 0; j < 8; ++j) { R.rh[j] = hr[64 * j]; R.rl[j] = lr[64 * j]; }
    if (hmode == 0) {
        const u32x2* ar = (const u32x2*)((const bf16*)Hp + (size_t)m * D) + C.lane;
#pragma unroll
        for (int j = 0; j < 8; ++j) R.a[j] = ar[64 * j];
        R.w1 = 1.f; R.w2 = 0.f;
    } else if (hmode == 1) {
        const unsigned* ar = (const unsigned*)((const unsigned char*)Hp + (size_t)m * D) + C.lane;
#pragma unroll
        for (int j = 0; j < 8; ++j) { R.a[j].x = ar[64 * j]; R.a[j].y = 0u; }
        R.w1 = 1.f / 256.f; R.w2 = 0.f;
    } else {
        R.w1 = w1; R.w2 = w2;
        const unsigned* y1 = (const unsigned*)((const unsigned char*)Hp + (size_t)s1 * D) + C.lane;
        const unsigned* y2 = (const unsigned*)((const unsigned char*)Hp + (size_t)s2 * D) + C.lane;
#pragma unroll
        for (int j = 0; j < 8; ++j) { R.a[j].x = y1[64 * j]; R.a[j].y = y2[64 * j]; }
    }
}
__device__ __forceinline__ void ln_row(const LnRow& R, const Ctx& C, int m, const float* gain, const float* bias, int hmode, float* Xf32out, unsigned char* X8out,
                                       LAS float* rw, LAS int* hist, bool do_route) {
    const int l4 = 4 * C.lane;
    f32x4 v[8]; float s = 0.f;
#pragma unroll
    for (int j = 0; j < 8; ++j) { f32x4 f, x;
        const f32x2 l01 = __builtin_amdgcn_cvt_pk_f32_fp8(R.rl[j], false), l23 = __builtin_amdgcn_cvt_pk_f32_fp8(R.rl[j], true);
        const float ls = hmode == 0 ? (1.f / 8192.f) : (1.f / 16.f);
        x[0] = bflo(R.rh[j].x) + l01[0] * ls; x[1] = bfhi(R.rh[j].x) + l01[1] * ls; x[2] = bflo(R.rh[j].y) + l23[0] * ls; x[3] = bfhi(R.rh[j].y) + l23[1] * ls;
        if (hmode == 0) { f[0] = bflo(R.a[j].x); f[1] = bfhi(R.a[j].x); f[2] = bflo(R.a[j].y); f[3] = bfhi(R.a[j].y); }
        else { const f32x2 a01 = __builtin_amdgcn_cvt_pk_f32_fp8(R.a[j].x, false), a23 = __builtin_amdgcn_cvt_pk_f32_fp8(R.a[j].x, true);
            f[0] = R.w1 * a01[0]; f[1] = R.w1 * a01[1]; f[2] = R.w1 * a23[0]; f[3] = R.w1 * a23[1];
            if (hmode == 2) { const f32x2 b01 = __builtin_amdgcn_cvt_pk_f32_fp8(R.a[j].y, false), b23 = __builtin_amdgcn_cvt_pk_f32_fp8(R.a[j].y, true);
                f[0] += R.w2 * b01[0]; f[1] += R.w2 * b01[1]; f[2] += R.w2 * b23[0]; f[3] += R.w2 * b23[1]; } }
        v[j] = x * ALPHA + f; s += (v[j][0] + v[j][1]) + (v[j][2] + v[j][3]); }
    const float mean = wave_sum(s) * (1.f / D); float s2 = 0.f;
#pragma unroll
    for (int j = 0; j < 8; ++j) { v[j] = v[j] - mean; s2 += (v[j][0] * v[j][0] + v[j][1] * v[j][1]) + (v[j][2] * v[j][2] + v[j][3] * v[j][3]); }
    const float rstd = 1.0f / sqrtf(wave_sum(s2) * (1.f / D) + LN_EPS);
    float lg[8];
#pragma unroll
    for (int e = 0; e < 8; ++e) lg[e] = 0.f;
    u32x2* ho = (u32x2*)(C.ws + WS_XB + (size_t)m * D * 2) + C.lane;
    unsigned* lo = (unsigned*)(C.ws + WS_XLO + (size_t)m * D) + C.lane;
#pragma unroll
    for (int j = 0; j < 8; ++j) {
        const f32x4 gv = *((const f32x4*)(gain + 256 * j + l4)), bv = *((const f32x4*)(bias + 256 * j + l4));
        const f32x4 o = v[j] * rstd * gv + bv;
        if (Xf32out) ((f32x4*)(Xf32out + (size_t)m * D))[64 * j + C.lane] = o;
        else if (X8out) {
            const unsigned p8 = pk4_fp8(o[0] * 16.f, o[1] * 16.f, o[2] * 16.f, o[3] * 16.f);
            ((unsigned*)(X8out + (size_t)m * D))[64 * j + C.lane] = p8;
            const f32x2 d01 = __builtin_amdgcn_cvt_pk_f32_fp8(p8, false), d23 = __builtin_amdgcn_cvt_pk_f32_fp8(p8, true);
            u32x2 w; w.x = cvt_pk_bf16(o[0] - d01[0] * (1.f / 16.f), o[1] - d01[1] * (1.f / 16.f)); w.y = cvt_pk_bf16(o[2] - d23[0] * (1.f / 16.f), o[3] - d23[1] * (1.f / 16.f)); ho[64 * j] = w; }
        else { u32x2 w; w.x = cvt_pk_bf16(o[0], o[1]); w.y = cvt_pk_bf16(o[2], o[3]); ho[64 * j] = w;
            lo[64 * j] = pk4_fp8((o[0] - bflo(w.x)) * 8192.f, (o[1] - bfhi(w.x)) * 8192.f, (o[2] - bflo(w.y)) * 8192.f, (o[3] - bfhi(w.y)) * 8192.f); }
        if (do_route) {
#pragma unroll
            for (int e = 0; e < 8; ++e) { const f32x4 we = *(const LAS f32x4*)(rw + e * 2048 + 256 * j + l4);
                lg[e] += (o[0] * we[0] + o[1] * we[1]) + (o[2] * we[2] + o[3] * we[3]); }
        }
    }
    if (do_route) {
#pragma unroll
        for (int e = 0; e < 8; ++e) lg[e] = wave_sum(lg[e]);
        int e1 = 0; float v1 = lg[0];
#pragma unroll
        for (int e = 1; e < 8; ++e) if (lg[e] > v1) { v1 = lg[e]; e1 = e; }
        int e2 = -1; float v2 = -3.0e38f;
#pragma unroll
        for (int e = 0; e < 8; ++e) if (e != e1 && lg[e] > v2) { v2 = lg[e]; e2 = e; }
        const float ex = __expf(v2 - v1); const float w1 = 1.0f / (1.0f + ex), w2 = ex / (1.0f + ex);
        if (C.lane == 0) { f32x4 rt; rt[0] = __int_as_float(e1 | (e2 << 8)); rt[1] = w1; rt[2] = w2; rt[3] = 0.f; ((f32x4*)(C.ws + WS_ROUTE))[m] = rt;
            atomicAdd((int*)&hist[e1], 1); atomicAdd((int*)&hist[e2], 1); }
    }
}
__device__ __forceinline__ void ph_ln(const Ctx& C, const void* Hp, int hmode, const float* gain, const float* bias, float* Xf32out, unsigned char* X8out,
                                      const float* router, bool do_route) {
    unsigned char* ws = C.ws;
    LAS float* rw = (LAS float*)C.lds;
    LAS int* hist = (LAS int*)(C.lds + LDS_MISC + 64);
    if (do_route) {
        for (int col = C.tid; col < 2048; col += NTHR) { const f32x4 a = ((const f32x4*)router)[2 * col], b = ((const f32x4*)router)[2 * col + 1];
            rw[0 * 2048 + col] = a[0]; rw[1 * 2048 + col] = a[1]; rw[2 * 2048 + col] = a[2]; rw[3 * 2048 + col] = a[3]; rw[4 * 2048 + col] = b[0]; rw[5 * 2048 + col] = b[1]; rw[6 * 2048 + col] = b[2]; rw[7 * 2048 + col] = b[3]; }
        if (C.tid < 8) hist[C.tid] = 0;
        int* st = (int*)(ws + WS_SLOTTOK);
        for (int i = C.bid * NTHR + C.tid; i < NSLOT; i += C.G * NTHR) st[i] = -1;
        __syncthreads();
    }
    const int m0 = C.bid * 128 + C.wave * 16;
    LnRow Ra, Rb;
    int s1v = 0, s2v = 0, w1v = 0, w2v = 0;
    if (hmode == 2) { const int mr = m0 + (C.lane & 15); const f32x4 rt = ((const f32x4*)(ws + WS_ROUTE))[mr];
        s1v = ((const int*)(ws + WS_SLOT1))[mr]; s2v = ((const int*)(ws + WS_SLOT2))[mr]; w1v = __float_as_int(rt[1] * (1.f / 256.f)); w2v = __float_as_int(rt[2] * (1.f / 256.f)); }
#define LN_LOAD(R_, r_) ln_load(R_, C, m0 + (r_), Hp, hmode, __builtin_amdgcn_readlane(s1v, (r_)), __builtin_amdgcn_readlane(s2v, (r_)), __int_as_float(__builtin_amdgcn_readlane(w1v, (r_))), __int_as_float(__builtin_amdgcn_readlane(w2v, (r_))))
    LN_LOAD(Ra, 0);
#pragma unroll 1
    for (int r = 0; r < 16; r += 2) {
        LN_LOAD(Rb, r + 1);
        ln_row(Ra, C, m0 + r, gain, bias, hmode, Xf32out, X8out, rw, hist, do_route);
        if (r + 2 < 16) LN_LOAD(Ra, r + 2);
        ln_row(Rb, C, m0 + r + 1, gain, bias, hmode, Xf32out, X8out, rw, hist, do_route);
    }
#undef LN_LOAD
    if (do_route) { __syncthreads(); if (C.tid < 8) ((int*)(ws + WS_CTL))[CW_CNT + C.bid * 8 + C.tid] = hist[C.tid]; }
}

__device__ __forceinline__ void ph_slots(const Ctx& C) {
    unsigned char* ws = C.ws;
    LAS int* sm = (LAS int*)(C.lds + LDS_MISC + 128);
    const int* cnt = (const int*)(ws + WS_CTL) + CW_CNT;
    if (C.tid < 8) { int tot = 0, mine = 0; for (int b = 0; b < C.G; ++b) { const int c = cnt[b * 8 + C.tid]; if (b < C.bid) mine += c; tot += c; } sm[C.tid] = tot; sm[8 + C.tid] = mine; }
    __syncthreads();
    if (C.tid == 0) { int base = 0; for (int e = 0; e < 8; ++e) { sm[16 + e] = base; base += (sm[e] + 255) & ~255; } sm[24] = base >> 8; }
    __syncthreads();
    if (C.wave == 0) {
        int off[8];
#pragma unroll
        for (int e = 0; e < 8; ++e) off[e] = sm[16 + e] + sm[8 + e];
        const unsigned long long lt = (1ull << C.lane) - 1ull;
        for (int it = 0; it < 2; ++it) {
            const int m = C.bid * 128 + it * 64 + C.lane;
            const int ee = __float_as_int(((const f32x4*)(ws + WS_ROUTE))[m][0]); const int e1 = ee & 0xff, e2 = (ee >> 8) & 0xff;
            int s1 = 0, s2 = 0;
#pragma unroll
            for (int e = 0; e < 8; ++e) { const unsigned long long m1 = __ballot(e1 == e), m2 = __ballot(e2 == e);
                const int c1 = __popcll(m1), c2 = __popcll(m2);
                if (e1 == e) s1 = off[e] + __popcll(m1 & lt);
                if (e2 == e) s2 = off[e] + c1 + __popcll(m2 & lt);
                off[e] += c1 + c2; }
            ((int*)(ws + WS_SLOT1))[m] = s1; ((int*)(ws + WS_SLOT2))[m] = s2;
            int* st = (int*)(ws + WS_SLOTTOK); st[s1] = m; st[s2] = m;
        }
    }
    if (C.bid == 0) {
        int* ctl = (int*)(ws + WS_CTL);
        if (C.tid == 0) ctl[CW_NT] = sm[24];
        if (C.tid < 264) { int e = 0;
#pragma unroll
            for (int q = 1; q < 8; ++q) if (C.tid >= (sm[16 + q] >> 8)) e = q;
            ctl[CW_TEXP + C.tid] = e; }
    }
}
__device__ __forceinline__ void ph_gather(const Ctx& C) {
    unsigned char* ws = C.ws;
    const int* st = (const int*)(ws + WS_SLOTTOK); const u32x4* xb = (const u32x4*)(ws + WS_XB); u32x4* xp = (u32x4*)(ws + WS_XPERM);
    for (int s = C.gw; s < NSLOT; s += C.NGW) { const int tok = st[s];
#pragma unroll
        for (int j = 0; j < 2; ++j) { u32x4 v = xb[(size_t)(tok < 0 ? 0 : tok) * 128 + j * 64 + C.lane]; const unsigned k = tok < 0 ? 0u : 0xffffffffu; v.x &= k; v.y &= k; v.z &= k; v.w &= k; xp[(size_t)s * 128 + j * 64 + C.lane] = v; } }
}
__device__ __forceinline__ void ph_moe_wconv(const Ctx& C, const float* mg, const float* mu, const float* md, const float* const* in, int lq) {
    SlotDec dec; dec.in = in; dec.ws = C.ws; dec.lq = lq; dec.moe.mg = mg; dec.moe.mu = mu; dec.moe.md = md; dec.moe.ws = C.ws; dec.sd.in = in; dec.sd.ws = C.ws;
    conv_run(C, lq ? 20160 : 20864, dec, C.bid - 192, 64);
}

__device__ __forceinline__ void ph_memattn(const Ctx& C, const bf16* P, int ldp, int qm0) {
    unsigned char* ws = C.ws;
    const bf16* memK = (const bf16*)(ws + WS_MEMK); const bf16* memVT = (const bf16*)(ws + WS_MEMVT); bf16* mix = (bf16*)(ws + WS_MIX);
    const int g = C.lane >> 4, r16 = C.lane & 15;
    LAS unsigned char* LK = C.lds; LAS unsigned char* LV = C.lds + 65536;
    const int b = C.bid >> 4, hm = (C.bid >> 2) & 3, qb = C.bid & 3;
    __syncthreads();
    {   u32x4 st[16];
#pragma unroll
        for (int i = 0; i < 8; ++i) { const int q = C.tid + 512 * i, row = q >> 4, pc = q & 15;
            st[i] = *(const u32x4*)(memK + (size_t)(b * 256 + row) * 512 + hm * 128 + pc * 8); }
#pragma unroll
        for (int i = 0; i < 8; ++i) { const int q = C.tid + 512 * i, row = q >> 5, pc = q & 31;
            st[8 + i] = *(const u32x4*)(memVT + (size_t)(hm * 128 + row) * 4096 + b * 256 + pc * 8); }
#pragma unroll
        for (int i = 0; i < 8; ++i) { const int q = C.tid + 512 * i, row = q >> 4, pc = q & 15;
            *(LAS u32x4*)(LK + row * 256 + ((pc ^ (row & 15)) * 16)) = st[i]; }
#pragma unroll
        for (int i = 0; i < 8; ++i) { const int q = C.tid + 512 * i, row = q >> 5, pc = q & 31;
            *(LAS u32x4*)(LV + row * 512 + ((pc ^ (row & 15)) * 16)) = st[8 + i]; }
    }
    __syncthreads();
    for (int qt = 0; qt < 4; ++qt) {
        const int m0 = b * SEQ + qb * 512 + C.wave * 64 + qt * 16;
        bf16x8 qf[4];
#pragma unroll
        for (int s = 0; s < 4; ++s) qf[s] = *(const bf16x8*)(P + (size_t)(m0 + r16) * ldp + qm0 + hm * 128 + 32 * s + 8 * g);
        f32x4 sacc[16];
#pragma unroll
        for (int kt = 0; kt < 16; ++kt) { sacc[kt] = (f32x4){0.f, 0.f, 0.f, 0.f};
#pragma unroll
            for (int s = 0; s < 4; ++s) { const bf16x8 kf = *(const LAS bf16x8*)(LK + (16 * kt + r16) * 256 + (((4 * s + g) ^ r16) * 16));
                sacc[kt] = __builtin_amdgcn_mfma_f32_16x16x32_bf16(kf, qf[s], sacc[kt], 0, 0, 0); } }
        float mx = -3.0e38f;
#pragma unroll
        for (int kt = 0; kt < 16; ++kt)
#pragma unroll
            for (int j = 0; j < 4; ++j) mx = fmaxf(mx, sacc[kt][j]);
        mx = fmaxf(mx, shx(mx, C.lane, 16)); mx = fmaxf(mx, shx(mx, C.lane, 32));
        const float sc = 0.08838834764831845f * 1.4426950408889634f;
        float sum = 0.f;
#pragma unroll
        for (int kt = 0; kt < 16; ++kt)
#pragma unroll
            for (int j = 0; j < 4; ++j) { const float pv = exp2f((sacc[kt][j] - mx) * sc); sacc[kt][j] = pv; sum += pv; }
        sum += shx(sum, C.lane, 16); sum += shx(sum, C.lane, 32);
        f32x4 oacc[8];
#pragma unroll
        for (int dt = 0; dt < 8; ++dt) oacc[dt] = (f32x4){0.f, 0.f, 0.f, 0.f};
#pragma unroll
        for (int ks = 0; ks < 8; ++ks) {
            u32x4 pw; pw.x = cvt_pk_bf16(sacc[2 * ks][0], sacc[2 * ks][1]); pw.y = cvt_pk_bf16(sacc[2 * ks][2], sacc[2 * ks][3]);
            pw.z = cvt_pk_bf16(sacc[2 * ks + 1][0], sacc[2 * ks + 1][1]); pw.w = cvt_pk_bf16(sacc[2 * ks + 1][2], sacc[2 * ks + 1][3]);
            const bf16x8 pa = __builtin_bit_cast(bf16x8, pw);
#pragma unroll
            for (int dt = 0; dt < 8; ++dt) { const LAS unsigned char* vr = LV + (16 * dt + r16) * 512;
                const u32x2 lo = *(const LAS u32x2*)(vr + (((8 * ks + g) ^ (2 * r16)) * 8)), hi = *(const LAS u32x2*)(vr + (((8 * ks + 4 + g) ^ (2 * r16)) * 8));
                u32x4 vw; vw.x = lo.x; vw.y = lo.y; vw.z = hi.x; vw.w = hi.y;
                oacc[dt] = __builtin_amdgcn_mfma_f32_16x16x32_bf16(pa, __builtin_bit_cast(bf16x8, vw), oacc[dt], 0, 0, 0); } }
        float inv[4];
#pragma unroll
        for (int j = 0; j < 4; ++j) inv[j] = 1.0f / shl(sum, 4 * g + j);
#pragma unroll
        for (int dt = 0; dt < 8; ++dt)
#pragma unroll
            for (int j = 0; j < 4; ++j) mix[(size_t)(m0 + 4 * g + j) * D + SW + hm * 128 + 16 * dt + r16] = f2bf(oacc[dt][j] * inv[j]);
    }
    __syncthreads();
}

__device__ __forceinline__ void ph_rwkv_prep1(const Ctx& C, const float* mu, bool with_v) {
    unsigned char* ws = C.ws;
    const bf16* P = (const bf16*)(ws + WS_P); bf16* AL = (bf16*)(ws + WS_ALORA);
    const int oc0 = 8 * C.lane;
    const int XW0 = 4608, XA0 = 4704, XV0 = 4800, XG0 = with_v ? 4864 : 4800;
    int src, mode;
    if (oc0 < 96) { src = XW0 + oc0; mode = 0; } else if (oc0 < 192) { src = XA0 + oc0 - 96; mode = 1; }
    else if (oc0 < 256) { src = XV0 + oc0 - 192; mode = with_v ? 1 : 2; } else { src = XG0 + oc0 - 256; mode = 3; }
    f32x4 mu0 = (f32x4){0.f, 0.f, 0.f, 0.f}, mu1 = mu0;
    if (mode != 2) { mu0 = *(const f32x4*)(mu + src); mu1 = *(const f32x4*)(mu + src + 4); }
    for (int mb = C.gw; mb < M; mb += 4 * C.NGW) {
        u32x4 cu4[4], pr4[4];
#pragma unroll
        for (int i = 0; i < 4; ++i) { const int m = mb + i * C.NGW; cu4[i] = (u32x4){0u, 0u, 0u, 0u}; pr4[i] = cu4[i];
            if (mode != 2) { cu4[i] = *(const u32x4*)(P + (size_t)m * LDP_RW + src);
                if ((m & (SEQ - 1)) != 0) pr4[i] = *(const u32x4*)(P + (size_t)(m - 1) * LDP_RW + src); } }
#pragma unroll
        for (int i = 0; i < 4; ++i) { const int m = mb + i * C.NGW; const u32x4 cu = cu4[i], pr = pr4[i];
            u32x4 o = (u32x4){0u, 0u, 0u, 0u};
            if (mode != 2) {
                float v[8];
#pragma unroll
                for (int q = 0; q < 4; ++q) { const float c0 = bflo(cu[q]), c1 = bfhi(cu[q]), p0 = bflo(pr[q]), p1 = bfhi(pr[q]);
                    const float m0 = q < 2 ? mu0[2 * q] : mu1[2 * q - 4], m1 = q < 2 ? mu0[2 * q + 1] : mu1[2 * q - 3];
                    v[2 * q] = c0 + m0 * (p0 - c0); v[2 * q + 1] = c1 + m1 * (p1 - c1); }
#pragma unroll
                for (int q = 0; q < 8; ++q) { if (mode == 0) v[q] = 1.0f - 2.0f * __builtin_amdgcn_rcpf(1.0f + __expf(2.0f * v[q])); else if (mode == 3) v[q] = sigmoidf_(v[q]); }
                o.x = cvt_pk_bf16(v[0], v[1]); o.y = cvt_pk_bf16(v[2], v[3]); o.z = cvt_pk_bf16(v[4], v[5]); o.w = cvt_pk_bf16(v[6], v[7]);
            }
            *(u32x4*)(AL + (size_t)m * 512 + oc0) = o; }
    }
}
__device__ __forceinline__ void ph_rwkv_prep2(const Ctx& C, const float* mu, const float* vecs, bool with_v) {
    unsigned char* ws = C.ws;
    const bf16* P = (const bf16*)(ws + WS_P); const bf16* LO = (const bf16*)(ws + WS_LORAOUT); bf16* VF = (bf16*)(ws + WS_VFIRST);
    unsigned char* SI = ws + WS_SCANIN; float* BON = (float*)(ws + WS_BONUS);
    const float* k_k = vecs + (with_v ? 3 : 2) * SW; const float* k_a = k_k + SW; const float* r_k = k_a + SW;
    const int hq = C.lane >> 4, cl = (C.lane & 15) * 4;
    for (int m = C.gw; m < M; m += C.NGW) {
        const int t = m & (SEQ - 1), b = m >> 11; const bool hp = t != 0;
        const bf16* pc = P + (size_t)m * LDP_RW; const bf16* pp = pc - LDP_RW;
#pragma unroll 2
        for (int it = 0; it < 6; ++it) {
            const int c = it * 256 + 4 * C.lane, head = 4 * it + hq;
            const u32x2 rc = *(const u32x2*)(pc + c), kc = *(const u32x2*)(pc + SW + c), vc = *(const u32x2*)(pc + 2 * SW + c);
            u32x2 rp = (u32x2){0u, 0u}, kp_ = rp, vp = rp;
            if (hp) { rp = *(const u32x2*)(pp + c); kp_ = *(const u32x2*)(pp + SW + c); vp = *(const u32x2*)(pp + 2 * SW + c); }
            const u32x2 Ew = *(const u32x2*)(LO + (size_t)m * 6144 + c), aw = *(const u32x2*)(LO + (size_t)m * 6144 + SW + c);
            u32x2 svw = (u32x2){0u, 0u}, vfw = svw;
            if (with_v) { svw = *(const u32x2*)(LO + (size_t)m * 6144 + 2 * SW + c); vfw = *(const u32x2*)(VF + (size_t)m * SW + c); }
            const f32x4 mr = *(const f32x4*)(mu + c), mk = *(const f32x4*)(mu + SW + c), mv = *(const f32x4*)(mu + 2 * SW + c);
            const f32x4 kk4 = *(const f32x4*)(k_k + c), ka4 = *(const f32x4*)(k_a + c), rk4 = *(const f32x4*)(r_k + c);
            float rm[4], km[4], vm[4], E[4], a[4], sv[4], vf[4];
#define UNPK(dst, w) dst[0] = bflo(w.x); dst[1] = bfhi(w.x); dst[2] = bflo(w.y); dst[3] = bfhi(w.y)
            float t0[4], t1[4];
            UNPK(t0, rc); UNPK(t1, rp);
#pragma unroll
            for (int j = 0; j < 4; ++j) rm[j] = t0[j] + mr[j] * (t1[j] - t0[j]);
            UNPK(t0, kc); UNPK(t1, kp_);
#pragma unroll
            for (int j = 0; j < 4; ++j) km[j] = t0[j] + mk[j] * (t1[j] - t0[j]);
            UNPK(t0, vc); UNPK(t1, vp);
#pragma unroll
            for (int j = 0; j < 4; ++j) vm[j] = t0[j] + mv[j] * (t1[j] - t0[j]);
            UNPK(E, Ew); UNPK(a, aw); UNPK(sv, svw); UNPK(vf, vfw);
#undef UNPK
            float vv[4], kkr[4], kp[4], ss = 0.f, bs = 0.f;
#pragma unroll
            for (int j = 0; j < 4; ++j) {
                vv[j] = with_v ? vm[j] + (vf[j] - vm[j]) * sv[j] : vm[j];
                kkr[j] = km[j] * kk4[j]; ss += kkr[j] * kkr[j];
                kp[j] = km[j] * (1.0f + (a[j] - 1.0f) * ka4[j]);
                bs += rm[j] * kp[j] * rk4[j]; }
            ss = row16_sum(ss); bs = row16_sum(bs);
            const float inv = 1.0f / fmaxf(sqrtf(ss), 1e-12f);
            if (!with_v) { u32x2 w; w.x = cvt_pk_bf16(vm[0], vm[1]); w.y = cvt_pk_bf16(vm[2], vm[3]); *(u32x2*)(VF + (size_t)m * SW + c) = w; }
            unsigned char* rec = SI + ((size_t)(b * 24 + head) * SEQ + t) * 768;
            float uw[4], kk[4];
#pragma unroll
            for (int j = 0; j < 4; ++j) { uw[j] = 1.0f - __expf(-E[j]); kk[j] = kkr[j] * inv; }
            u32x2 o;
            { const h16x2 u01 = __builtin_convertvector((f32x2){uw[0], uw[1]}, h16x2), u23 = __builtin_convertvector((f32x2){uw[2], uw[3]}, h16x2);
              o.x = __builtin_bit_cast(unsigned, u01); o.y = __builtin_bit_cast(unsigned, u23); *(u32x2*)(rec + cl * 2) = o; }
            o.x = cvt_pk_bf16(-kk[0], -kk[1]); o.y = cvt_pk_bf16(-kk[2], -kk[3]); *(u32x2*)(rec + 128 + cl * 2) = o;
            o.x = cvt_pk_bf16(kk[0] * a[0], kk[1] * a[1]); o.y = cvt_pk_bf16(kk[2] * a[2], kk[3] * a[3]); *(u32x2*)(rec + 256 + cl * 2) = o;
            o.x = cvt_pk_bf16(kp[0], kp[1]); o.y = cvt_pk_bf16(kp[2], kp[3]); *(u32x2*)(rec + 384 + cl * 2) = o;
            o.x = cvt_pk_bf16(rm[0], rm[1]); o.y = cvt_pk_bf16(rm[2], rm[3]); *(u32x2*)(rec + 512 + cl * 2) = o;
            o.x = cvt_pk_bf16(vv[0], vv[1]); o.y = cvt_pk_bf16(vv[2], vv[3]); *(u32x2*)(rec + 640 + cl * 2) = o;
            if ((C.lane & 15) == 0) BON[m * 24 + head] = bs;
        }
    }
}
__device__ __forceinline__ float fma_(float a, float b, float c) { float d; asm("v_fma_f32 %0, %1, %2, %3" : "=v"(d) : "v"(a), "v"(b), "v"(c)); return d; }
__device__ __forceinline__ float mul_(float a, float b) { float d; asm("v_mul_f32 %0, %1, %2" : "=v"(d) : "v"(a), "v"(b)); return d; }
__device__ __forceinline__ void ph_rwkv_scan(const Ctx& C, const float* mg, const float* mu, const float* md, const float* vecs, bool with_v, const float* const* in, int lq) {
    if (C.bid >= 192) { ph_moe_wconv(C, mg, mu, md, in, lq); return; }
    unsigned char* ws = C.ws;
    const unsigned char* SI = ws + WS_SCANIN;
    constexpr int TC = 16, NCH = SEQ / TC, REC = 7 * 64;
    LAS float* buf = (LAS float*)C.lds;
    LAS float* ybuf = (LAS float*)(C.lds + 114688);
    const bool scanner = C.wave < 4;
    const int slot = (C.wave >> 1) & 1;
    const int rg = C.lane >> 3, cg = C.lane & 7;
    const int rbase = 32 * (C.wave & 1) + 4 * rg;
    if (!scanner) {
        const int lw = C.wave - 4, qd = C.lane;
        const int q2 = qd - 8, lvec = 1 + (q2 >> 3), lpart = q2 & 7;
        const float* BON = (const float*)(ws + WS_BONUS); bf16* mix = (bf16*)(ws + WS_MIX); const bf16* LO = (const bf16*)(ws + WS_LORAOUT);
        const float* gn_g = vecs + (with_v ? 6 : 5) * SW; const float* gn_b = gn_g + SW;
        const int p0 = C.bid * 2, b0 = p0 / 24, h0 = p0 % 24, b1 = (p0 + 1) / 24, h1 = (p0 + 1) % 24;
        const int pr = C.lane >> 4, pc4 = 4 * (C.lane & 15);
        const f32x4 gg0 = *(const f32x4*)(gn_g + h0 * 64 + pc4), gb0 = *(const f32x4*)(gn_b + h0 * 64 + pc4), gg1 = *(const f32x4*)(gn_g + h1 * 64 + pc4), gb1 = *(const f32x4*)(gn_b + h1 * 64 + pc4);
        u32x4 st[8];
#define SCAN_ISSUE(ch_) do { _Pragma("unroll") for (int i_ = 0; i_ < 8; ++i_) { const int ps = lw + 4 * i_; \
        const int sl_ = ps >> 4, t_ = (ch_) * TC + (ps & 15); \
        st[i_] = qd < 48 ? *(const u32x4*)(SI + ((size_t)(p0 + sl_) * SEQ + t_) * 768 + qd * 16) \
                         : *(const u32x4*)(LO + (size_t)((sl_ ? b1 : b0) * SEQ + t_) * 6144 + 3 * SW + (sl_ ? h1 : h0) * 64 + ((qd - 48) & 7) * 8); } } while (0)
#define SCAN_COMMIT(bsel_) do { _Pragma("unroll") for (int i_ = 0; i_ < 8; ++i_) { const int ps = lw + 4 * i_; \
        LAS float* dst = buf + (((bsel_) * 2 * TC) + ps) * REC; \
        if (qd < 8) { f32x4 a_, b_; const unsigned sx_ = st[i_].x, sy_ = st[i_].y, sz_ = st[i_].z, sw_ = st[i_].w;     \
            { const f32x2 t0_ = __builtin_convertvector(__builtin_bit_cast(h16x2, sx_), f32x2), t1_ = __builtin_convertvector(__builtin_bit_cast(h16x2, sy_), f32x2); \
              a_[0] = 1.0f - t0_[0]; a_[1] = 1.0f - t0_[1]; a_[2] = 1.0f - t1_[0]; a_[3] = 1.0f - t1_[1]; } \
            { const f32x2 t0_ = __builtin_convertvector(__builtin_bit_cast(h16x2, sz_), f32x2), t1_ = __builtin_convertvector(__builtin_bit_cast(h16x2, sw_), f32x2); \
              b_[0] = 1.0f - t0_[0]; b_[1] = 1.0f - t0_[1]; b_[2] = 1.0f - t1_[0]; b_[3] = 1.0f - t1_[1]; } \
            *(LAS f32x4*)(dst + 8 * qd) = a_; *(LAS f32x4*)(dst + 8 * qd + 4) = b_; } \
        else if (qd < 56) { LAS float* d2 = dst + lvec * 64 + lpart * 8; \
            f32x4 a_, b_; a_[0] = bflo(st[i_].x); a_[1] = bfhi(st[i_].x); a_[2] = bflo(st[i_].y); a_[3] = bfhi(st[i_].y); \
            b_[0] = bflo(st[i_].z); b_[1] = bfhi(st[i_].z); b_[2] = bflo(st[i_].w); b_[3] = bfhi(st[i_].w); \
            *(LAS f32x4*)d2 = a_; *(LAS f32x4*)(d2 + 4) = b_; } } } while (0)
#define SCAN_POST(cp_) do { _Pragma("unroll") for (int g_ = 0; g_ < 2; ++g_) { const int ps = lw + 4 * (4 * g_ + pr), sl = ps >> 4, stp = ps & 15; \
        const LAS float* rec = buf + ((((cp_) & 1) * 2 * TC) + ps) * REC; \
        const f32x4 yv = *(const LAS f32x4*)(ybuf + ((((cp_) & 1) * 2 + sl) * TC + stp) * 64 + pc4), vv = *(const LAS f32x4*)(rec + 5 * 64 + pc4), gq = *(const LAS f32x4*)(rec + 6 * 64 + pc4); \
        const int m = (sl ? b1 : b0) * SEQ + (cp_) * TC + stp, hh = sl ? h1 : h0; \
        const float bon = BON[m * 24 + hh]; \
        const float mean = row16_sum((yv[0] + yv[1]) + (yv[2] + yv[3])) * (1.f / 64.f); const f32x4 d = yv - mean; \
        const float var = row16_sum((d[0] * d[0] + d[1] * d[1]) + (d[2] * d[2] + d[3] * d[3])) * (1.f / 64.f); \
        const float rstd = 1.0f / sqrtf(var + 64e-5f); const f32x4 gg = sl ? gg1 : gg0, gb = sl ? gb1 : gb0; \
        const f32x4 o_ = (d * rstd * gg + gb + vv * bon) * gq; \
        u32x2 w_; w_.x = cvt_pk_bf16(o_[0], o_[1]); w_.y = cvt_pk_bf16(o_[2], o_[3]); \
        *(u32x2*)(mix + (size_t)m * D + hh * 64 + pc4) = w_; } } while (0)
        SCAN_ISSUE(0); SCAN_COMMIT(0);
        __syncthreads();
        for (int ch = 0; ch < NCH; ++ch) {
            if (ch + 1 < NCH) SCAN_ISSUE(ch + 1);
            if (ch > 0) SCAN_POST(ch - 1);
            if (ch + 1 < NCH) SCAN_COMMIT((ch & 1) ^ 1);
            __syncthreads();
        }
        SCAN_POST(NCH - 1);
#undef SCAN_ISSUE
#undef SCAN_COMMIT
#undef SCAN_POST
    } else {
        f32x2 S[4][4];
#pragma unroll
        for (int i = 0; i < 4; ++i)
#pragma unroll
            for (int c = 0; c < 4; ++c) S[i][c] = (f32x2){0.f, 0.f};
        __syncthreads();
        for (int ch = 0; ch < NCH; ++ch) {
            const LAS float* base = buf + (((ch & 1) * 2 + slot) * TC) * REC;
            LAS float* yb = ybuf + (((ch & 1) * 2 + slot) * TC) * 64 + rbase;
#pragma unroll 2
            for (int s = 0; s < TC; ++s) {
                const LAS float* rp = base + s * REC + 8 * cg;
                f32x2 wv[4], nv[4], bv[4], kv[4], rv[4];
                { const f32x4 x0 = *(const LAS f32x4*)(rp), x1 = *(const LAS f32x4*)(rp + 4); wv[0] = (f32x2){x0[0], x0[1]}; wv[1] = (f32x2){x0[2], x0[3]}; wv[2] = (f32x2){x1[0], x1[1]}; wv[3] = (f32x2){x1[2], x1[3]}; }
                { const f32x4 x0 = *(const LAS f32x4*)(rp + 64), x1 = *(const LAS f32x4*)(rp + 68); nv[0] = (f32x2){x0[0], x0[1]}; nv[1] = (f32x2){x0[2], x0[3]}; nv[2] = (f32x2){x1[0], x1[1]}; nv[3] = (f32x2){x1[2], x1[3]}; }
                { const f32x4 x0 = *(const LAS f32x4*)(rp + 128), x1 = *(const LAS f32x4*)(rp + 132); bv[0] = (f32x2){x0[0], x0[1]}; bv[1] = (f32x2){x0[2], x0[3]}; bv[2] = (f32x2){x1[0], x1[1]}; bv[3] = (f32x2){x1[2], x1[3]}; }
                { const f32x4 x0 = *(const LAS f32x4*)(rp + 192), x1 = *(const LAS f32x4*)(rp + 196); kv[0] = (f32x2){x0[0], x0[1]}; kv[1] = (f32x2){x0[2], x0[3]}; kv[2] = (f32x2){x1[0], x1[1]}; kv[3] = (f32x2){x1[2], x1[3]}; }
                { const f32x4 x0 = *(const LAS f32x4*)(rp + 256), x1 = *(const LAS f32x4*)(rp + 260); rv[0] = (f32x2){x0[0], x0[1]}; rv[1] = (f32x2){x0[2], x0[3]}; rv[2] = (f32x2){x1[0], x1[1]}; rv[3] = (f32x2){x1[2], x1[3]}; }
                const f32x4 vv = *(const LAS f32x4*)(base + s * REC + 320 + rbase);
                f32x4 yo;
#pragma unroll
                for (int i = 0; i < 4; ++i) {
                    f32x2 a2 = S[i][0] * nv[0];
#pragma unroll
                    for (int c = 1; c < 4; ++c) a2 = S[i][c] * nv[c] + a2;
                    float sa = a2[0] + a2[1];
                    sa = dpp_add<0xB1>(sa); sa = dpp_add<0x4E>(sa); sa = dpp_add<0x141>(sa);
                    const f32x2 sa2 = (f32x2){sa, sa}, v2 = (f32x2){vv[i], vv[i]};
                    f32x2 y2 = (f32x2){0.f, 0.f};
#pragma unroll
                    for (int c = 0; c < 4; ++c) { S[i][c] = S[i][c] * wv[c] + (sa2 * bv[c] + v2 * kv[c]); y2 = S[i][c] * rv[c] + y2; }
                    float y = y2[0] + y2[1];
                    y = dpp_add<0xB1>(y); y = dpp_add<0x4E>(y); y = dpp_add<0x141>(y);
                    yo[i] = y;
                }
                if (cg == 0) *(LAS f32x4*)(yb + s * 64) = yo;
            }
            __syncthreads();
        }
    }
}

__device__ __constant__ float RET_LG2[6] = {-0.04580368961312479f, -0.02272007650008353f, -0.011315313227834146f, -0.005646563141142063f, -0.0028205190623786626f, -0.0014095702546713536f};
__device__ __forceinline__ void ph_ret_prep(const Ctx& C) {
    unsigned char* ws = C.ws;
    const bf16* P = (const bf16*)(ws + WS_P); const f32x2* CS = (const f32x2*)(ws + WS_CS);
    bf16* QR = (bf16*)(ws + WS_QR); bf16* KR = (bf16*)(ws + WS_KR); bf16* VT = (bf16*)(ws + WS_VT); bf16* KVT = (bf16*)(ws + WS_KVT);
    LAS unsigned char* LKt = C.lds; LAS unsigned char* LV = C.lds + 32768;
    const int g = C.lane >> 4, r16 = C.lane & 15, w = C.wave;
    __syncthreads();
    for (int u = C.bid; u < 1536; u += C.G) {
        const int c = u & 15, bh = u >> 4, h = bh % 6, b = bh / 6, m0 = b * SEQ + c * 128;
        const float lg2 = RET_LG2[h];
        __syncthreads();
        for (int task = C.tid; task < 1536; task += NTHR) {
            if (task < 512) {
                const bool isk = task >= 256; const int tk = task & 255, i0 = 4 * (tk & 15), tg = tk >> 4;
                const int colb = (isk ? 768 : 0) + h * 128 + i0; const float scl = isk ? 0.08838834764831845f : 1.0f;
                bf16* N = isk ? KR : QR;
                float o1[4][8], o2[4][8];
#pragma unroll
                for (int j = 0; j < 8; ++j) { const int m = m0 + tg * 8 + j;
                    const u32x2 a = *(const u32x2*)(P + (size_t)m * LDP_RET + colb), b2 = *(const u32x2*)(P + (size_t)m * LDP_RET + colb + 64);
                    const f32x4 cs01 = *(const f32x4*)(CS + (size_t)m * 64 + i0), cs23 = *(const f32x4*)(CS + (size_t)m * 64 + i0 + 2);
                    const float x1[4] = {bflo(a.x), bfhi(a.x), bflo(a.y), bfhi(a.y)}, x2[4] = {bflo(b2.x), bfhi(b2.x), bflo(b2.y), bfhi(b2.y)};
                    const float cc[4] = {cs01[0], cs01[2], cs23[0], cs23[2]}, sn[4] = {cs01[1], cs01[3], cs23[1], cs23[3]};
#pragma unroll
                    for (int q = 0; q < 4; ++q) { o1[q][j] = (x1[q] * cc[q] - x2[q] * sn[q]) * scl; o2[q][j] = (x1[q] * sn[q] + x2[q] * cc[q]) * scl; }
                    u32x2 w1, w2; w1.x = cvt_pk_bf16(o1[0][j], o1[1][j]); w1.y = cvt_pk_bf16(o1[2][j], o1[3][j]); w2.x = cvt_pk_bf16(o2[0][j], o2[1][j]); w2.y = cvt_pk_bf16(o2[2][j], o2[3][j]);
                    *(u32x2*)(N + (size_t)m * 768 + h * 128 + i0) = w1; *(u32x2*)(N + (size_t)m * 768 + h * 128 + i0 + 64) = w2; }
                if (isk) {
                    float kd[8];
#pragma unroll
                    for (int j = 0; j < 8; ++j) kd[j] = exp2f((float)(127 - (tg * 8 + j)) * lg2);
#pragma unroll
                    for (int q = 0; q < 4; ++q) {
                        u32x4 w1, w2;
                        w1.x = cvt_pk_bf16(o1[q][0] * kd[0], o1[q][1] * kd[1]); w1.y = cvt_pk_bf16(o1[q][2] * kd[2], o1[q][3] * kd[3]); w1.z = cvt_pk_bf16(o1[q][4] * kd[4], o1[q][5] * kd[5]); w1.w = cvt_pk_bf16(o1[q][6] * kd[6], o1[q][7] * kd[7]);
                        w2.x = cvt_pk_bf16(o2[q][0] * kd[0], o2[q][1] * kd[1]); w2.y = cvt_pk_bf16(o2[q][2] * kd[2], o2[q][3] * kd[3]); w2.z = cvt_pk_bf16(o2[q][4] * kd[4], o2[q][5] * kd[5]); w2.w = cvt_pk_bf16(o2[q][6] * kd[6], o2[q][7] * kd[7]);
                        *(LAS u32x4*)(LKt + (i0 + q) * 256 + ((tg ^ ((i0 + q) & 15)) * 16)) = w1;
                        *(LAS u32x4*)(LKt + (i0 + q + 64) * 256 + ((tg ^ ((i0 + q + 64) & 15)) * 16)) = w2; }
                }
            } else {
                const int tv = task - 512, e0 = 4 * (tv & 63), tg = tv >> 6;
                u32x2 vin[8];
#pragma unroll
                for (int j = 0; j < 8; ++j) vin[j] = *(const u32x2*)(P + (size_t)(m0 + tg * 8 + j) * LDP_RET + 1536 + h * 256 + e0);
                u32x4 w0, w1, w2, w3;
#define PKLO(a_, b_) (((a_) & 0xffffu) | ((b_) << 16))
#define PKHI(a_, b_) (((a_) >> 16) | ((b_) & 0xffff0000u))
                w0.x = PKLO(vin[0].x, vin[1].x); w0.y = PKLO(vin[2].x, vin[3].x); w0.z = PKLO(vin[4].x, vin[5].x); w0.w = PKLO(vin[6].x, vin[7].x);
                w1.x = PKHI(vin[0].x, vin[1].x); w1.y = PKHI(vin[2].x, vin[3].x); w1.z = PKHI(vin[4].x, vin[5].x); w1.w = PKHI(vin[6].x, vin[7].x);
                w2.x = PKLO(vin[0].y, vin[1].y); w2.y = PKLO(vin[2].y, vin[3].y); w2.z = PKLO(vin[4].y, vin[5].y); w2.w = PKLO(vin[6].y, vin[7].y);
                w3.x = PKHI(vin[0].y, vin[1].y); w3.y = PKHI(vin[2].y, vin[3].y); w3.z = PKHI(vin[4].y, vin[5].y); w3.w = PKHI(vin[6].y, vin[7].y);
#undef PKLO
#undef PKHI
                bf16* vt = VT + (size_t)(bh * 256 + e0) * SEQ + c * 128 + tg * 8;
                *(u32x4*)vt = w0; *(u32x4*)(vt + SEQ) = w1; *(u32x4*)(vt + 2 * SEQ) = w2; *(u32x4*)(vt + 3 * SEQ) = w3;
                *(LAS u32x4*)(LV + (e0 + 0) * 256 + ((tg ^ ((e0 + 0) & 15)) * 16)) = w0; *(LAS u32x4*)(LV + (e0 + 1) * 256 + ((tg ^ ((e0 + 1) & 15)) * 16)) = w1;
                *(LAS u32x4*)(LV + (e0 + 2) * 256 + ((tg ^ ((e0 + 2) & 15)) * 16)) = w2; *(LAS u32x4*)(LV + (e0 + 3) * 256 + ((tg ^ ((e0 + 3) & 15)) * 16)) = w3;
            }
        }
        __syncthreads();
        {   f32x4 acc[16];
#pragma unroll
            for (int et = 0; et < 16; ++et) acc[et] = (f32x4){0.f, 0.f, 0.f, 0.f};
#pragma unroll
            for (int ks = 0; ks < 4; ++ks) {
                const bf16x8 af = *(const LAS bf16x8*)(LKt + (16 * w + r16) * 256 + (((4 * ks + g) ^ r16) * 16));
#pragma unroll
                for (int et = 0; et < 16; ++et) { const bf16x8 bf = *(const LAS bf16x8*)(LV + (16 * et + r16) * 256 + (((4 * ks + g) ^ r16) * 16));
                    acc[et] = __builtin_amdgcn_mfma_f32_16x16x32_bf16(af, bf, acc[et], 0, 0, 0); } }
#pragma unroll
            for (int et = 0; et < 16; ++et) { u32x2 wv; wv.x = cvt_pk_bf16(acc[et][0], acc[et][1]); wv.y = cvt_pk_bf16(acc[et][2], acc[et][3]); *(u32x2*)(KVT + ((size_t)u * 256 + 16 * et + r16) * 128 + 16 * w + 4 * g) = wv; }
        }
    }
    __syncthreads();
}
__device__ __forceinline__ void ph_ret_kv(const Ctx& C) {
    unsigned char* ws = C.ws;
    const bf16* KDT = (const bf16*)(ws + WS_KDT); const bf16* VT = (const bf16*)(ws + WS_VT); bf16* KVT = (bf16*)(ws + WS_KVT);
    const int g = C.lane >> 4, r16 = C.lane & 15, w = C.wave;
    LAS unsigned char* LKt = C.lds; LAS unsigned char* LV = C.lds + 32768;
    u32x4 st[12];
#define KV_ISSUE(u_) do { const int c_ = (u_) & 15, bh_ = (u_) >> 4; \
        _Pragma("unroll") for (int i = 0; i < 4; ++i) { const int q = C.tid + 512 * i, row = q >> 4, pc = q & 15; st[i] = *(const u32x4*)(KDT + (size_t)(bh_ * 128 + row) * SEQ + c_ * 128 + pc * 8); } \
        _Pragma("unroll") for (int i = 0; i < 8; ++i) { const int q = C.tid + 512 * i, row = q >> 4, pc = q & 15; st[4 + i] = *(const u32x4*)(VT + (size_t)(bh_ * 256 + row) * SEQ + c_ * 128 + pc * 8); } } while (0)
#define KV_COMMIT() do { \
        _Pragma("unroll") for (int i = 0; i < 4; ++i) { const int q = C.tid + 512 * i, row = q >> 4, pc = q & 15; *(LAS u32x4*)(LKt + row * 256 + ((pc ^ (row & 15)) * 16)) = st[i]; } \
        _Pragma("unroll") for (int i = 0; i < 8; ++i) { const int q = C.tid + 512 * i, row = q >> 4, pc = q & 15; *(LAS u32x4*)(LV + row * 256 + ((pc ^ (row & 15)) * 16)) = st[4 + i]; } } while (0)
    __syncthreads();
    if (C.bid < 1536) KV_ISSUE(C.bid);
    for (int u = C.bid; u < 1536; u += C.G) {
        __syncthreads();
        KV_COMMIT();
        if (u + C.G < 1536) KV_ISSUE(u + C.G);
        __syncthreads();
        f32x4 acc[16];
#pragma unroll
        for (int et = 0; et < 16; ++et) acc[et] = (f32x4){0.f, 0.f, 0.f, 0.f};
#pragma unroll
        for (int ks = 0; ks < 4; ++ks) {
            const bf16x8 af = *(const LAS bf16x8*)(LKt + (16 * w + r16) * 256 + (((4 * ks + g) ^ r16) * 16));
#pragma unroll
            for (int et = 0; et < 16; ++et) { const bf16x8 bf = *(const LAS bf16x8*)(LV + (16 * et + r16) * 256 + (((4 * ks + g) ^ r16) * 16));
                acc[et] = __builtin_amdgcn_mfma_f32_16x16x32_bf16(af, bf, acc[et], 0, 0, 0); } }
#pragma unroll
        for (int et = 0; et < 16; ++et) { u32x2 wv; wv.x = cvt_pk_bf16(acc[et][0], acc[et][1]); wv.y = cvt_pk_bf16(acc[et][2], acc[et][3]); *(u32x2*)(KVT + ((size_t)u * 256 + 16 * et + r16) * 128 + 16 * w + 4 * g) = wv; }
    }
    __syncthreads();
#undef KV_ISSUE
#undef KV_COMMIT
}
__device__ __forceinline__ void ph_ret_prefix(const Ctx& C) {
    unsigned char* ws = C.ws;
    const bf16* KVT = (const bf16*)(ws + WS_KVT); bf16* RTB = (bf16*)(ws + WS_RTB);
    for (int idx = C.bid * NTHR + C.tid; idx < 96 * 8192; idx += C.G * NTHR) {
        const int bh = idx >> 13, rem = idx & 8191; const int h = bh % 6;
        const float cd = exp2f(128.0f * RET_LG2[h]);
        f32x4 r = (f32x4){0.f, 0.f, 0.f, 0.f};
        u32x2 kwv[15];
#pragma unroll
        for (int c = 0; c < 15; ++c) kwv[c] = *(const u32x2*)(KVT + ((size_t)(bh * 16 + c) * 8192 + rem) * 4);
#pragma unroll
        for (int c = 0; c < 16; ++c) { const size_t off = ((size_t)(bh * 16 + c) * 8192 + rem) * 4;
            u32x2 w; w.x = cvt_pk_bf16(r[0], r[1]); w.y = cvt_pk_bf16(r[2], r[3]); *(u32x2*)(RTB + off) = w;
            if (c < 15) { const u32x2 kw = kwv[c]; const f32x4 kv = (f32x4){bflo(kw.x), bfhi(kw.x), bflo(kw.y), bfhi(kw.y)}; r = r * cd + kv; } }
    }
}
#define LDS_BAR() asm volatile("s_waitcnt lgkmcnt(0)\n\ts_barrier" ::: "memory")
__device__ __forceinline__ void ph_ret_out(const Ctx& C, const float* gn) {
    unsigned char* ws = C.ws;
    const bf16* P = (const bf16*)(ws + WS_P); const bf16* QR = (const bf16*)(ws + WS_QR); const bf16* KR = (const bf16*)(ws + WS_KR);
    const bf16* VT = (const bf16*)(ws + WS_VT); const bf16* RTB = (const bf16*)(ws + WS_RTB); bf16* mix = (bf16*)(ws + WS_MIX);
    const int g = C.lane >> 4, r16 = C.lane & 15, w = C.wave;
    LAS unsigned char* LR = C.lds; LAS unsigned char* LV = C.lds + 65536;
    for (int u = C.bid; u < 1536; u += C.G) {
        const int c = u & 15, bh = u >> 4, h = bh % 6, b = bh / 6, m0 = b * SEQ + c * 128;
        const float lg2 = RET_LG2[h];
        LDS_BAR();
        const int nl = 16 * w + r16;
        u32x4 kst[4];
        bf16x8 qf[4];
        u32x2 gwv[16];
        {   u32x4 st[16];
#pragma unroll
            for (int i = 0; i < 8; ++i) { const int q = C.tid + 512 * i, row = q >> 4, pc = q & 15;
                st[i] = *(const u32x4*)(RTB + ((size_t)u * 256 + row) * 128 + pc * 8);
                st[8 + i] = *(const u32x4*)(VT + (size_t)(bh * 256 + row) * SEQ + c * 128 + pc * 8); }
#pragma unroll
            for (int s = 0; s < 4; ++s) qf[s] = *(const bf16x8*)(QR + (size_t)(m0 + nl) * 768 + h * 128 + 32 * s + 8 * g);
#pragma unroll
            for (int i = 0; i < 8; ++i) { const int q = C.tid + 512 * i, row = q >> 4, pc = q & 15; const int off = row * 256 + ((pc ^ (row & 15)) * 16);
                *(LAS u32x4*)(LR + off) = st[i]; *(LAS u32x4*)(LV + off) = st[8 + i]; }
        }
#pragma unroll
        for (int i = 0; i < 4; ++i) { const int q = C.tid + 512 * i, row = q >> 4, pc = q & 15;
            kst[i] = *(const u32x4*)(KR + (size_t)(m0 + row) * 768 + h * 128 + pc * 8); }
        LDS_BAR();
        f32x4 o[16];
        const float qdec = exp2f((float)(nl + 1) * lg2);
#pragma unroll
        for (int et = 0; et < 16; ++et) { f32x4 a = (f32x4){0.f, 0.f, 0.f, 0.f};
#pragma unroll
            for (int s = 0; s < 4; ++s) { const bf16x8 rf = *(const LAS bf16x8*)(LR + (16 * et + r16) * 256 + (((4 * s + g) ^ r16) * 16));
                a = __builtin_amdgcn_mfma_f32_16x16x32_bf16(rf, qf[s], a, 0, 0, 0); }
            o[et] = a * qdec;
            if ((et & 3) == 3) __builtin_amdgcn_sched_barrier(0); }
        LDS_BAR();
#pragma unroll
        for (int i = 0; i < 4; ++i) { const int q = C.tid + 512 * i, row = q >> 4, pc = q & 15; *(LAS u32x4*)(LR + row * 256 + ((pc ^ (row & 15)) * 16)) = kst[i]; }
#pragma unroll
        for (int et = 0; et < 16; ++et) gwv[et] = *(const u32x2*)(P + (size_t)(m0 + nl) * LDP_RET + 3072 + h * 256 + 16 * et + 4 * g);
        LDS_BAR();
        const float fd0 = (float)opq_v(nl - 4 * g);
        u32x2 pb[8];
#pragma unroll
        for (int mt = 0; mt < 8; ++mt) {
            pb[mt] = (u32x2){0u, 0u};
            if (mt <= w) { f32x4 a = (f32x4){0.f, 0.f, 0.f, 0.f};
#pragma unroll
                for (int s = 0; s < 4; ++s) { const bf16x8 kf = *(const LAS bf16x8*)(LR + (16 * mt + r16) * 256 + (((4 * s + g) ^ r16) * 16));
                    a = __builtin_amdgcn_mfma_f32_16x16x32_bf16(kf, qf[s], a, 0, 0, 0); }
#pragma unroll
                for (int j = 0; j < 4; ++j) { const float fd = fd0 - (float)(16 * mt + j); a[j] = fd >= 0.f ? a[j] * exp2f(fd * lg2) : 0.f; }
                pb[mt].x = cvt_pk_bf16(a[0], a[1]); pb[mt].y = cvt_pk_bf16(a[2], a[3]); }
        }
#pragma unroll
        for (int ks = 0; ks < 4; ++ks) {
            if (2 * ks <= w) {
                u32x4 pw; pw.x = pb[2 * ks].x; pw.y = pb[2 * ks].y; pw.z = pb[2 * ks + 1].x; pw.w = pb[2 * ks + 1].y;
                const bf16x8 pf = __builtin_bit_cast(bf16x8, pw);
#pragma unroll
                for (int et = 0; et < 16; ++et) { const LAS unsigned char* vr = LV + (16 * et + r16) * 256;
                    const u32x2 lo = *(const LAS u32x2*)(vr + (((8 * ks + g) ^ (2 * r16)) * 8)), hi = *(const LAS u32x2*)(vr + (((8 * ks + 4 + g) ^ (2 * r16)) * 8));
                    u32x4 vw; vw.x = lo.x; vw.y = lo.y; vw.z = hi.x; vw.w = hi.y;
                    o[et] = __builtin_amdgcn_mfma_f32_16x16x32_bf16(__builtin_bit_cast(bf16x8, vw), pf, o[et], 0, 0, 0); } }
        }
        float s1 = 0.f;
#pragma unroll
        for (int et = 0; et < 16; ++et) s1 += (o[et][0] + o[et][1]) + (o[et][2] + o[et][3]);
        s1 += shx(s1, C.lane, 16); s1 += shx(s1, C.lane, 32);
        const float mean = s1 * (1.f / 256.f); float s2 = 0.f;
#pragma unroll
        for (int et = 0; et < 16; ++et) { o[et] = o[et] - mean; s2 += (o[et][0] * o[et][0] + o[et][1] * o[et][1]) + (o[et][2] * o[et][2] + o[et][3] * o[et][3]); }
        s2 += shx(s2, C.lane, 16); s2 += shx(s2, C.lane, 32);
        const float rstd = 1.0f / sqrtf(s2 * (1.f / 256.f) + 1e-5f);
        const int m = m0 + nl;
#pragma unroll
        for (int et = 0; et < 16; ++et) { const int e = h * 256 + 16 * et + 4 * g;
            const f32x4 gg = *(const f32x4*)(gn + e), gb = *(const f32x4*)(gn + SW + e);
            const u32x2 gw_ = gwv[et];
            float gt[4] = {bflo(gw_.x), bfhi(gw_.x), bflo(gw_.y), bfhi(gw_.y)}; float ov[4];
#pragma unroll
            for (int j = 0; j < 4; ++j) { const float yn = o[et][j] * rstd * gg[j] + gb[j]; ov[j] = yn * gt[j] * sigmoidf_(gt[j]); }
            u32x2 wv; wv.x = cvt_pk_bf16(ov[0], ov[1]); wv.y = cvt_pk_bf16(ov[2], ov[3]);
            *(u32x2*)(mix + (size_t)m * D + e) = wv; }
    }
    __syncthreads();
}

constexpr int PH_PER_PAIR = 23, NPH = 2 + 2 * PH_PER_PAIR;
__global__ void __launch_bounds__(NTHR, 2) fwd_kernel(Args args) {
    extern __shared__ __attribute__((aligned(16))) unsigned char lds_raw[];
    Ctx C;
    C.lds = (LAS unsigned char*)lds_raw;
    C.tid = threadIdx.x; C.lane = C.tid & 63; C.wave = __builtin_amdgcn_readfirstlane(C.tid >> 6);
    C.bid = blockIdx.x; C.G = GRID; C.gw = C.bid * NWAVES + C.wave; C.NGW = C.G * NWAVES; C.ws = args.ws;
    for (int u = C.tid; u < (LDS_BYTES - LDS_MISC) / 4; u += NTHR) ((LAS unsigned*)(C.lds + LDS_MISC))[u] = 0u;
    __syncthreads();
    const int lo = args.ph_lo, hi = args.ph_hi;
    XcdBarrier bar; bar.bar = (unsigned*)(args.ws + WS_CTL) + CW_BAR; bar.x = 0; bar.st = nullptr;
    if (hi - lo > 1) bar = xcd_barrier_post((unsigned*)(args.ws + WS_CTL) + CW_BAR, (volatile LAS unsigned*)(C.lds + LDS_MISC));
#ifndef ENMASK
#define ENMASK 0x1ffffffu
#endif
#define EN(j) ((((unsigned)(ENMASK)) >> (j)) & 1u)
#ifndef DBLMASK
#define DBLMASK 0u
#endif
#define REP(j) for (int rep_ = 0; rep_ < 1 + (int)((((unsigned)(DBLMASK)) >> (j)) & 1u); ++rep_)
#define IN(k) (lo <= (k) && (k) < hi)
#define SEAM(k) do { if (IN((k) + 1)) xcd_barrier(bar, (lane_id_asm() == 0) && (Cq.wave == 0)); } while (0)

#define PH_BEGIN Ctx Cq; Cq.lds = C.lds; Cq.lane = lane_id_asm(); Cq.wave = opq_i(C.wave); Cq.tid = Cq.wave * 64 + Cq.lane; Cq.bid = opq_i((int)blockIdx.x); Cq.G = GRID; \
        Cq.gw = Cq.bid * NWAVES + Cq.wave; Cq.NGW = Cq.G * NWAVES; Cq.ws = opq(args.ws); unsigned char* ws = Cq.ws; const int lq = opq_i(lp); (void)ws; (void)lq
    { const int lp = 0;
    REP(0) if (EN(0) && IN(0)) { PH_BEGIN; ph_prologue(Cq, args); SEAM(0); }
    REP(1) if (EN(1) && IN(1)) { PH_BEGIN;
        pg8::SchedMem S; S.G = Cq.G; S.c = Cq.bid; S.memb = (unsigned)WS_MEMB; S.wkv = (unsigned)WS_WKV;
        pg8::EpiMem E; E.O0 = (bf16*)(ws + WS_MEMK); E.O1 = (bf16*)(ws + WS_MEMVT);
        pg8::gemm_phase<pg8::EpiMem, pg8::SchedMem, true, true>(Cq.lds, Cq.tid, (const char*)ws, 2048, 2048, 2048, S, E);
        SEAM(1);
    } }
#pragma unroll 1
    for (int lp = 0; lp < 2; ++lp) {
        const int pb = 2 + lp * PH_PER_PAIR;
        REP(2) if (EN(2) && IN(pb + 0)) {
            PH_BEGIN;
            pg8::SchedPlain S; S.init(M / 256, 22, Cq.G, Cq.bid); S.A0 = (unsigned)(WS_XB); S.B0 = (unsigned)(WS_WIN + (size_t)(2 * lq) * 22 * MiB); S.at = (unsigned)(256 * 2048 * 2); S.bt = (unsigned)(256 * 2048 * 2);
            pg8::EpiBf16 E; E.O = (bf16*)(ws + WS_P); E.ldc = LDP_RW;
            pg8::gemm_phase<pg8::EpiBf16, pg8::SchedPlain, true, true>(Cq.lds, Cq.tid, (const char*)ws, 2048, 2048, 2048, S, E);
            SEAM(pb + 0);
        }
        REP(3) if (EN(3) && IN(pb + 1)) { PH_BEGIN; const bool with_v = lq == 1; ph_rwkv_prep1(Cq, args.in[lq ? L2_MU : L0_MU], with_v); ph_memattn(Cq, (const bf16*)(ws + WS_P), LDP_RW, with_v ? 5120 : 5056); SEAM(pb + 1); }
        REP(4) if (EN(4) && IN(pb + 2)) {
            PH_BEGIN; const float* vecs = args.in[lq ? L2_VECS : L0_VECS];
            pg8::SchedLora S; S.skipv = lq == 0; S.init(M / 256, lq == 0 ? 18 : 24, Cq.G, Cq.bid); S.A0 = (unsigned)(WS_ALORA); S.B0 = (unsigned)(WS_WLORA + (size_t)lq * 3 * MiB);
            pg8::EpiLora E; E.O = (bf16*)(ws + WS_LORAOUT); E.vecs = vecs;
            pg8::gemm_phase<pg8::EpiLora, pg8::SchedLora, true, true>(Cq.lds, Cq.tid, (const char*)ws, 512, 256, opq_i(256), S, E);
            SEAM(pb + 2);
        }
        REP(5) if (EN(5) && IN(pb + 3)) { PH_BEGIN; ph_rwkv_prep2(Cq, args.in[lq ? L2_MU : L0_MU], args.in[lq ? L2_VECS : L0_VECS], lq == 1); SEAM(pb + 3); }
        REP(6) if (EN(6) && IN(pb + 4)) { PH_BEGIN; ph_rwkv_scan(Cq, args.in[lq ? L3_MG : L1_MG], args.in[lq ? L3_MU_ : L1_MU_], args.in[lq ? L3_MD : L1_MD], args.in[lq ? L2_VECS : L0_VECS], lq == 1, args.in, lq); SEAM(pb + 4); }
        REP(8) if (EN(8) && IN(pb + 6)) {
            PH_BEGIN;
            pg8::SchedPlain S; S.init(M / 256, 8, Cq.G, Cq.bid); S.A0 = (unsigned)(WS_MIX); S.B0 = (unsigned)(WS_WOUT + (size_t)(2 * lq) * 8 * MiB); S.at = (unsigned)(256 * 2048 * 2); S.bt = (unsigned)(256 * 2048 * 2);
            pg8::EpiBf16 E; E.O = (bf16*)(ws + WS_P); E.ldc = D;
            pg8::gemm_phase<pg8::EpiBf16, pg8::SchedPlain, true, true>(Cq.lds, Cq.tid, (const char*)ws, 2048, 2048, 2048, S, E);
            SEAM(pb + 6);
        }
        REP(9) if (EN(9) && IN(pb + 7)) { PH_BEGIN; const float* nr = args.in[lq ? L2_NORMS : L0_NORMS];
            ph_ln(Cq, ws + WS_P, 0, nr, nr + D, nullptr, ws + WS_X8, nullptr, false); SEAM(pb + 7); }
        REP(10) if (EN(10) && IN(pb + 8)) {
            PH_BEGIN;
            pg8::SchedPlain S; S.init(M / 256, 44, Cq.G, Cq.bid); S.A0 = (unsigned)(WS_X8); S.B0 = (unsigned)(WS_WFGU + (size_t)lq * 44 * MiB); S.at = (unsigned)(256 * 2048); S.bt = (unsigned)(256 * 2048);
            pg8::EpiSwiglu8 E; E.O = ws + WS_HID; E.ldc = DFF; E.inv = 1.0f / 16384.0f; E.so = 32.0f;
            pg8::gemm_phase<pg8::EpiSwiglu8, pg8::SchedPlain, true, true, true>(Cq.lds, Cq.tid, (const char*)ws, 1024, 1024, 1024, S, E);
            SEAM(pb + 8);
        }
        REP(11) if (EN(11) && IN(pb + 9)) {
            PH_BEGIN;
            pg8::SchedPlain S; S.init(M / 256, 8, Cq.G, Cq.bid); S.A0 = (unsigned)(WS_HID); S.B0 = (unsigned)(WS_WFD + (size_t)lq * 22 * MiB); S.at = (unsigned)(256 * DFF); S.bt = (unsigned)(256 * DFF);
            pg8::EpiFp8S E; E.O = ws + WS_P; E.ldc = D; E.sc = 1.0f / 256.0f;
            pg8::gemm_phase<pg8::EpiFp8S, pg8::SchedPlain, true, true, true>(Cq.lds, Cq.tid, (const char*)ws, DFF / 2, DFF / 2, DFF / 2, S, E);
            SEAM(pb + 9);
        }
        REP(12) if (EN(12) && IN(pb + 10)) { PH_BEGIN; const float* nr = args.in[lq ? L2_NORMS : L0_NORMS];
            ph_ln(Cq, ws + WS_P, 1, nr + 2 * D, nr + 3 * D, nullptr, nullptr, nullptr, false); SEAM(pb + 10); }
        REP(13) if (EN(13) && IN(pb + 11)) {
            PH_BEGIN;
            pg8::SchedPlain S; S.init(M / 256, 20, Cq.G, Cq.bid); S.A0 = (unsigned)(WS_XB); S.B0 = (unsigned)(WS_WIN + (size_t)(2 * lq + 1) * 22 * MiB); S.at = (unsigned)(256 * 2048 * 2); S.bt = (unsigned)(256 * 2048 * 2);
            pg8::EpiBf16 E; E.O = (bf16*)(ws + WS_P); E.ldc = LDP_RET;
            pg8::gemm_phase<pg8::EpiBf16, pg8::SchedPlain, true, true>(Cq.lds, Cq.tid, (const char*)ws, 2048, 2048, 2048, S, E);
            SEAM(pb + 11);
        }
        REP(14) if (EN(14) && IN(pb + 12)) { PH_BEGIN; ph_ret_prep(Cq); ph_memattn(Cq, (const bf16*)(ws + WS_P), LDP_RET, 4608); SEAM(pb + 12); }
        REP(16) if (EN(16) && IN(pb + 14)) { PH_BEGIN; ph_ret_prefix(Cq); SEAM(pb + 14); }
        REP(17) if (EN(17) && IN(pb + 15)) { PH_BEGIN; ph_ret_out(Cq, args.in[lq ? L3_GN : L1_GN]); SEAM(pb + 15); }
        REP(18) if (EN(18) && IN(pb + 16)) {
            PH_BEGIN;
            pg8::SchedPlain S; S.init(M / 256, 8, Cq.G, Cq.bid); S.A0 = (unsigned)(WS_MIX); S.B0 = (unsigned)(WS_WOUT + (size_t)(2 * lq + 1) * 8 * MiB); S.at = (unsigned)(256 * 2048 * 2); S.bt = (unsigned)(256 * 2048 * 2);
            pg8::EpiBf16 E; E.O = (bf16*)(ws + WS_P); E.ldc = D;
            pg8::gemm_phase<pg8::EpiBf16, pg8::SchedPlain, true, true>(Cq.lds, Cq.tid, (const char*)ws, 2048, 2048, 2048, S, E);
            SEAM(pb + 16);
        }
        REP(19) if (EN(19) && IN(pb + 17)) {
            PH_BEGIN; const float* nr = args.in[lq ? L3_NORMS : L1_NORMS];
            REP(25) { ph_ln(Cq, ws + WS_P, 0, nr, nr + D, nullptr, ws + WS_X8, args.in[lq ? L3_ROUTER : L1_ROUTER], true);
            __syncthreads(); }
            SEAM(pb + 17);
        }
        REP(20) if (EN(20) && IN(pb + 18)) { PH_BEGIN; ph_slots(Cq); SEAM(pb + 18); }
        REP(22) if (EN(22) && IN(pb + 20)) {
            PH_BEGIN;
            const int nT = __builtin_amdgcn_readfirstlane(((const int*)(ws + WS_CTL))[CW_NT]);
            pg8::SchedMoEg S; S.init(nT, 44, Cq.G, Cq.bid); S.B0 = (unsigned)(WS_MWGU); S.bt = (unsigned)(256 * 2048); S.be = (unsigned)(22 * MiB);
            S.xoff = (unsigned)WS_X8; S.zoff = (unsigned)(WS_CTL + 512 * 1024); S.texp = (const int*)(ws + WS_CTL) + CW_TEXP; S.slot_tok = (const int*)(ws + WS_SLOTTOK);
            pg8::EpiSwiglu8 E; E.O = ws + WS_HIDM; E.ldc = DFF; E.inv = 1.0f / 16384.0f; E.so = 32.0f;
            pg8::gemm_phase<pg8::EpiSwiglu8, pg8::SchedMoEg, true, true, true>(Cq.lds, Cq.tid, (const char*)ws, 1024, 1024, 1024, S, E);
            SEAM(pb + 20);
        }
        REP(23) if (EN(23) && IN(pb + 21)) {
            PH_BEGIN;
            const int nT = __builtin_amdgcn_readfirstlane(((const int*)(ws + WS_CTL))[CW_NT]);
            pg8::SchedMoE S; S.init(nT, 8, Cq.G, Cq.bid); S.A0 = (unsigned)(WS_HIDM); S.B0 = (unsigned)(WS_MWD); S.at = (unsigned)(256 * DFF); S.bt = (unsigned)(256 * DFF); S.be = (unsigned)(11 * MiB);
            S.texp = (const int*)(ws + WS_CTL) + CW_TEXP;
            pg8::EpiFp8S E; E.O = ws + WS_XPERM; E.ldc = D; E.sc = 1.0f / 256.0f;
            pg8::gemm_phase<pg8::EpiFp8S, pg8::SchedMoE, true, true, true>(Cq.lds, Cq.tid, (const char*)ws, DFF / 2, DFF / 2, DFF / 2, S, E);
            SEAM(pb + 21);
        }
        REP(24) if (EN(24) && IN(pb + 22)) {
            PH_BEGIN; const float* nr = args.in[lq ? L3_NORMS : L1_NORMS];
            ph_ln(Cq, ws + WS_XPERM, 2, nr + 2 * D, nr + 3 * D, lq == 1 ? args.out : nullptr, nullptr, nullptr, false);
            SEAM(pb + 22);
        }
    }
#undef IN
#undef SEAM
}

#ifndef MK_PER_PHASE
#define MK_PER_PHASE 0
#endif
extern "C" void kernel_launch(void* const* d_in, const int* in_sizes, int n_in, void* d_out, int out_size, void* d_ws, size_t ws_size, hipStream_t stream) {
    static int ready = 0;
    if (ready == 0) {
        ready = 1;
        if (n_in != 43 || out_size != M * D || ws_size < WS_END) { fprintf(stderr, "kernel_launch: unexpected problem (n_in %d out %d ws %zu need %zu)\n", n_in, out_size, ws_size, (size_t)WS_END); ready = -1; }
        else if (hipFuncSetAttribute((const void*)fwd_kernel, hipFuncAttributeMaxDynamicSharedMemorySize, LDS_BYTES) != hipSuccess) { fprintf(stderr, "kernel_launch: hipFuncSetAttribute failed\n"); ready = -1; }
        (void)hipGetLastError();
    }
    if (ready < 0) return;
    (void)hipMemsetAsync((char*)d_ws + WS_CTL, 0, CTL_BYTES, stream);
    Args a{};
    for (int i = 0; i < 43; ++i) a.in[i] = (const float*)d_in[i];
    a.out = (float*)d_out; a.ws = (unsigned char*)d_ws;
#if MK_PER_PHASE
    for (int p = 0; p < NPH; ++p) { a.ph_lo = p; a.ph_hi = p + 1; hipLaunchKernelGGL(fwd_kernel, dim3(GRID), dim3(NTHR), LDS_BYTES, stream, a); }
#else
    a.ph_lo = 0; a.ph_hi = NPH;
    hipLaunchKernelGGL(fwd_kernel, dim3(GRID), dim3(NTHR), LDS_BYTES, stream, a);
#endif
}
```

```cpp
#include <hip/hip_runtime.h>
#include <cstdio>
#include <cstdint>

#define LAS __attribute__((address_space(3)))
#define GAS __attribute__((address_space(1)))
typedef unsigned short bf16;
typedef short bf16x8 __attribute__((ext_vector_type(8)));
typedef float f32x4 __attribute__((ext_vector_type(4)));
typedef float f32x2 __attribute__((ext_vector_type(2)));
typedef unsigned u32x4 __attribute__((ext_vector_type(4)));
typedef unsigned u32x2 __attribute__((ext_vector_type(2)));

constexpr int M = 32768, D = 2048, SEQ = 2048, NB = 16;
constexpr int SW = 1536;
constexpr int LDP_RW = 5632, LDP_RET = 5120;
constexpr int DFF = 5632;
constexpr int NSLOT = 67584;
constexpr float ALPHA = 1.6817928305074290f;
constexpr float LN_EPS = 1e-5f;
constexpr int NWAVES = 8, NTHR = 512, GRID = 256;

constexpr size_t MiB = 1u << 20;
constexpr size_t WS_CTL = 0, CTL_BYTES = 1 * MiB;
constexpr size_t WS_WKV = 1 * MiB;
constexpr size_t WS_WIN = WS_WKV + 4 * MiB;
constexpr size_t WS_WOUT = WS_WIN + 88 * MiB;
constexpr size_t WS_WLORA = WS_WOUT + 32 * MiB;
constexpr size_t WS_WFGU = WS_WLORA + 6 * MiB;
constexpr size_t WS_WFD = WS_WFGU + 88 * MiB;
constexpr size_t WS_MEMB = WS_WFD + 44 * MiB;
constexpr size_t WS_MEMK = WS_MEMB + 16 * MiB;
constexpr size_t WS_MEMVT = WS_MEMK + 4 * MiB;
constexpr size_t WS_CS = WS_MEMVT + 4 * MiB;
constexpr size_t WS_XB = WS_CS + 16 * MiB;
constexpr size_t WS_MIX = WS_XB + 128 * MiB;
constexpr size_t WS_VFIRST = WS_MIX + 128 * MiB;
constexpr size_t WS_P = WS_VFIRST + 96 * MiB;
constexpr size_t WS_MISC = WS_P + 352 * MiB;
constexpr size_t WS_ROUTE = WS_MISC, WS_SLOT1 = WS_MISC + 512 * 1024, WS_SLOT2 = WS_SLOT1 + 128 * 1024, WS_SLOTTOK = WS_SLOT2 + 128 * 1024;
constexpr size_t WS_BONUS = WS_MISC + 2 * MiB;
constexpr size_t WS_SB = WS_BONUS + 3 * MiB;
constexpr size_t WS_ALORA = WS_SB, WS_LORAOUT = WS_SB + 32 * MiB, WS_SCANIN = WS_SB + 416 * MiB;
constexpr size_t WS_QR = WS_SB, WS_KR = WS_SB + 48 * MiB, WS_KDT = WS_SB + 96 * MiB, WS_VT = WS_SB + 144 * MiB, WS_KVT = WS_SB + 240 * MiB, WS_RTB = WS_SB + 432 * MiB;
constexpr size_t WS_HID = WS_SB;
constexpr size_t WS_XPERM = WS_SB, WS_HIDM = WS_SB + 264 * MiB, WS_MWGU = WS_SB + 1184 * MiB, WS_MWD = WS_SB + 1360 * MiB;
constexpr size_t WS_XLO = WS_SB + 1518 * MiB;
constexpr size_t WS_X8 = WS_XLO + 64 * MiB;
constexpr size_t WS_END = WS_X8 + 64 * MiB;
constexpr int CW_BAR = 4096;
constexpr int CW_CNT = 16384;
constexpr int CW_NT = 20480;
constexpr int CW_TEXP = 20544;

constexpr int RING_BYTES = 131072;
constexpr int LDS_MISC = RING_BYTES;
constexpr int LDS_BYTES = RING_BYTES + 8192;

#define LDS_WAIT() asm volatile("s_waitcnt lgkmcnt(0)" ::: "memory")
#define VM_WAIT() asm volatile("s_waitcnt vmcnt(0)" ::: "memory")
__device__ __forceinline__ unsigned cvt_pk_bf16(float lo, float hi) { unsigned r; asm volatile("v_cvt_pk_bf16_f32 %0, %1, %2" : "=v"(r) : "v"(lo), "v"(hi)); return r; }
__device__ __forceinline__ bf16 f2bf(float f) { return (bf16)(cvt_pk_bf16(f, 0.f) & 0xffffu); }
__device__ __forceinline__ float bf2f(bf16 b) { return __uint_as_float(((unsigned)b) << 16); }
__device__ __forceinline__ float bflo(unsigned w) { return __uint_as_float(w << 16); }
__device__ __forceinline__ float bfhi(unsigned w) { return __uint_as_float(w & 0xffff0000u); }
template <int CTRL> __device__ __forceinline__ float dpp_add(float x) {
    int y = __builtin_amdgcn_update_dpp(0, __float_as_int(x), CTRL, 0xf, 0xf, true);
    return x + __int_as_float(y);
}
__device__ __forceinline__ float row16_sum(float x) { x = dpp_add<0xB1>(x); x = dpp_add<0x4E>(x); x = dpp_add<0x141>(x); x = dpp_add<0x140>(x); return x; }
__device__ __forceinline__ float wave_sum(float v) {
    v = row16_sum(v);
    const float a = __int_as_float(__builtin_amdgcn_readlane(__float_as_int(v), 0)), b = __int_as_float(__builtin_amdgcn_readlane(__float_as_int(v), 16));
    const float c = __int_as_float(__builtin_amdgcn_readlane(__float_as_int(v), 32)), d = __int_as_float(__builtin_amdgcn_readlane(__float_as_int(v), 48));
    return (a + b) + (c + d);
}
__device__ __forceinline__ unsigned pk4_fp8(float a, float b, float c, float d) {
    a = __builtin_amdgcn_fmed3f(a, -448.f, 448.f); b = __builtin_amdgcn_fmed3f(b, -448.f, 448.f); c = __builtin_amdgcn_fmed3f(c, -448.f, 448.f); d = __builtin_amdgcn_fmed3f(d, -448.f, 448.f);
    unsigned w = 0; w = __builtin_amdgcn_cvt_pk_fp8_f32(a, b, w, false); w = __builtin_amdgcn_cvt_pk_fp8_f32(c, d, w, true); return w; }
__device__ __forceinline__ float sigmoidf_(float z) { return __builtin_amdgcn_rcpf(1.0f + __expf(-z)); }

__device__ __forceinline__ unsigned char* opq(unsigned char* p) { asm volatile("" : "+s"(p)); return p; }
__device__ __forceinline__ int opq_i(int v) { asm volatile("" : "+s"(v)); return v; }
__device__ __forceinline__ int opq_v(int v) { asm volatile("" : "+v"(v)); return v; }
__device__ __forceinline__ int lane_id_asm() { int l; asm volatile("v_mbcnt_lo_u32_b32 %0, -1, 0\n\tv_mbcnt_hi_u32_b32 %0, -1, %0" : "=v"(l)); return l; }
typedef _Float16 h16x2 __attribute__((ext_vector_type(2)));
__device__ __forceinline__ float shx(float v, int lane, int m) { return __builtin_bit_cast(float, __builtin_amdgcn_ds_bpermute((lane ^ m) << 2, __builtin_bit_cast(int, v))); }
__device__ __forceinline__ float shl(float v, int src) { return __builtin_bit_cast(float, __builtin_amdgcn_ds_bpermute(src << 2, __builtin_bit_cast(int, v))); }
#define XB_TMO      128
#define XB_XCNT(j)  (256  + 64 * (j))
#define XB_XSUB(j)  (1280 + 64 * (j))
#define XB_XGEN(j)  (2304 + 64 * (j))
#define XB_TOP      3328
#define XB_TOPGEN   3392
#define XCD_BAR_WORDS 3456
#define XB_SPIN_CAP (1u << 18)
__device__ __forceinline__ unsigned xb_ld(unsigned* p)              { return __hip_atomic_load(p, __ATOMIC_RELAXED, __HIP_MEMORY_SCOPE_AGENT); }
__device__ __forceinline__ unsigned xb_add(unsigned* p, unsigned v) { return __hip_atomic_fetch_add(p, v, __ATOMIC_RELAXED, __HIP_MEMORY_SCOPE_AGENT); }
__device__ __forceinline__ unsigned xb_xcc_id() { return (unsigned)__builtin_amdgcn_s_getreg((3 << 11) | 20) & 0xFu; }
#define XB_SPIN(cond, bar) do { unsigned _sp = 0; while (cond) { __builtin_amdgcn_s_sleep(1); \
    if ((++_sp & 255u) == 0u) { if (xb_ld(&(bar)[XB_TMO])) break; if (_sp > XB_SPIN_CAP) { atomicAdd(&(bar)[XB_TMO], 1u); break; } } } } while (0)
struct XcdBarrier { unsigned* bar; unsigned x; volatile LAS unsigned* st; };
__device__ __forceinline__ XcdBarrier xcd_barrier_post(unsigned* bar, volatile LAS unsigned* st) {
    XcdBarrier b; b.bar = bar; b.x = xb_xcc_id(); b.st = st;
    if (threadIdx.x == 0) (void)xb_add(&bar[XB_XCNT(b.x)], 1u);
    return b;
}
__device__ __forceinline__ void xcd_barrier_complete(unsigned* bar, unsigned x, unsigned& nloc, unsigned& nx) {
    const unsigned G = gridDim.x * gridDim.y * gridDim.z;
    unsigned sum, cnt, mine, sp = 0u;
    for (;;) {
        sum = 0u; cnt = 0u; mine = 0u;
#pragma unroll
        for (unsigned j = 0; j < 16; ++j) { const unsigned c = xb_ld(&bar[XB_XCNT(j)]); sum += c; cnt += (c > 0u) ? 1u : 0u; mine = (j == x) ? c : mine; }
        if (sum == G) break;
        __builtin_amdgcn_s_sleep(1);
        if ((++sp & 255u) == 0u) { if (xb_ld(&bar[XB_TMO])) break; if (sp > XB_SPIN_CAP) { atomicAdd(&bar[XB_TMO], 1u); break; } }
    }
    nloc = mine > 0u ? mine : 1u; nx = cnt > 0u ? cnt : 1u;
}
__device__ __forceinline__ void xcd_barrier(const XcdBarrier& b, const bool leader  ) {
    asm volatile("s_waitcnt vmcnt(0)" ::: "memory");
    __syncthreads();
    if (leader) {
        unsigned* bar = b.bar;
        __builtin_amdgcn_s_waitcnt(0);
        unsigned nloc = b.st[0], nx = b.st[1];
        if (nloc == 0u) { xcd_barrier_complete(bar, b.x, nloc, nx); b.st[0] = nloc; b.st[1] = nx; }
        const unsigned old = xb_add(&bar[XB_XSUB(b.x)], 1u);
        const unsigned gen = old / nloc;
        if (old + 1u == (gen + 1u) * nloc) {
            __builtin_amdgcn_fence(__ATOMIC_RELEASE, "agent");
            asm volatile("s_waitcnt vmcnt(0)" ::: "memory");
            const unsigned og = xb_add(&bar[XB_TOP], 1u);
            const unsigned tg = og / nx;
            if (og + 1u == (tg + 1u) * nx) xb_add(&bar[XB_TOPGEN], 1u);
            else XB_SPIN(xb_ld(&bar[XB_TOPGEN]) == tg, bar);
            __builtin_amdgcn_fence(__ATOMIC_ACQUIRE, "agent");
            xb_add(&bar[XB_XGEN(b.x)], 1u);
            asm volatile("s_waitcnt vmcnt(0)" ::: "memory");
        } else {
            XB_SPIN(xb_ld(&bar[XB_XGEN(b.x)]) == gen, bar);
            __builtin_amdgcn_fence(__ATOMIC_ACQUIRE, "agent");
            asm volatile("s_waitcnt vmcnt(0)" ::: "memory");
        }
    }
    __syncthreads();
}

namespace pg8 {
constexpr int BM = 256, BK = 64, HALF = 128, HTB = HALF * BK * 2, STAGE_BYTES = 8 * HTB, NXCD = 8, WGM = 8;
__host__ __device__ __forceinline__ int lds_byte(int r, int c) { const int st = (r >> 4) * 2 + (c >> 5), rr = r & 15, cc = c & 31, ob = rr * 64 + cc * 2; return st * 1024 + (ob ^ (((ob >> 9) & 1) << 5)); }
__host__ __device__ __forceinline__ void stage_rc(int b, int& R, int& C) { const int st = b / 1024, sb = b % 1024, swz = sb ^ (((sb >> 9) & 1) << 5); R = (st >> 1) * 16 + swz / 64; C = (st & 1) * 32 + (swz % 64) / 2; }
__host__ __device__ __forceinline__ int perm32(int rho) { const int n = rho >> 4, i = rho & 15; return 8 * (i >> 2) + 4 * n + (i & 3); }
typedef int i32x8 __attribute__((ext_vector_type(8)));
typedef int i32x4_ __attribute__((ext_vector_type(4)));
__device__ __forceinline__ i32x8 cat8(bf16x8 a, bf16x8 b) { const i32x4_ x = __builtin_bit_cast(i32x4_, a), y = __builtin_bit_cast(i32x4_, b); return __builtin_shufflevector(x, y, 0, 1, 2, 3, 4, 5, 6, 7); }
__device__ __forceinline__ void mfma8(f32x4& acc, const i32x8 a, const i32x8 b) {
    asm volatile("v_mfma_scale_f32_16x16x128_f8f6f4 %0, %1, %2, %0, %3, %3 op_sel_hi:[0,0,0]" : "+v"(acc) : "v"(a), "v"(b), "v"(127)); }
struct Unit { int pm, pn, z; };
struct Order {
    int nM, nN, nwg, G, c;
    __device__ __forceinline__ void init(int nM_, int nN_, int G_, int c_) { nM = nM_; nN = nN_; nwg = nM * nN; G = G_; c = c_; }
    __device__ __forceinline__ bool next_mn(int i, Unit& u) const {
        const long L = (long)i * G + c; if (L >= nwg) return false;
        int wgid = (int)L; { const int q = nwg / NXCD, r = nwg % NXCD, xcd = wgid % NXCD, off = wgid / NXCD; wgid = (xcd < r ? xcd * (q + 1) : r * (q + 1) + (xcd - r) * q) + off; }
        const int nig = WGM * nN, gid = wgid / nig, fm = gid * WGM, gsz = (nM - fm) < WGM ? (nM - fm) : WGM;
        u.pm = fm + ((wgid % nig) % gsz); u.pn = (wgid % nig) / gsz; u.z = 0; return true;
    }
};

template <class Epi, class Sched, bool ALIGN_EPI, bool SP2, bool FP8 = false>
__device__ __forceinline__ void gemm_phase(LAS unsigned char* lds, const int tid_in, const char* base  , const int lda, const int ldb, const int K, const Sched& S, const Epi& E) {
    const int tid = tid_in, wid = __builtin_amdgcn_readfirstlane(tid >> 6), lane = tid & 63, wr = wid >> 2, wc = wid & 3, fr = lane & 15, fq = lane >> 4;
    const int nt = K / BK;
    unsigned voffA[2], voffB[2];
#pragma unroll
    for (int i = 0; i < 2; ++i) { int R, C; stage_rc(tid * 16 + i * 8192, R, C); const int Rb = Epi::PERM ? ((R & ~31) + perm32(R & 31)) : R;
        voffA[i] = (unsigned)(R * lda + C) * 2u; voffB[i] = (unsigned)(Rb * ldb + C) * 2u; }
    constexpr bool GATHER = Sched::GATHER;
    unsigned gvC[2][2], gvN[2][2];
#define PG8_GV(dst, unit) do { _Pragma("unroll") for (int hh_ = 0; hh_ < 2; ++hh_) _Pragma("unroll") for (int i_ = 0; i_ < 2; ++i_) { int R_, C_; stage_rc(tid * 16 + i_ * 8192, R_, C_); \
        dst[hh_][i_] = S.arow(unit, hh_ * HALF + R_) + (unsigned)C_ * 2u; } } while (0)
    const unsigned kstep = (unsigned)(BK * 2);
    const unsigned hstepA = (unsigned)(HALF * lda * 2), hstepB = (unsigned)(HALF * ldb * 2);
    const __amdgpu_buffer_rsrc_t rsrc = __builtin_amdgcn_make_buffer_rsrc((void*)base, 0, 0xffffffffu, 0x00020000);
    const unsigned ldsw = (unsigned)wid * 1024u;
    const int aoff = lds_byte(wr * 64 + fr, fq * 8), boff = lds_byte(wc * 32 + fr, fq * 8);
#define PG8_SA(b, h) (((b) * 2 + (h)) * HTB)
#define PG8_SB(b, h) ((4 + (b) * 2 + (h)) * HTB)
#define PG8_STAGE(bufoff, goff, voff) do { _Pragma("unroll") for (int _i = 0; _i < 2; ++_i) \
        __builtin_amdgcn_raw_ptr_buffer_load_lds(rsrc, (LAS unsigned*)(lds + (bufoff) + ldsw + _i * 8192), 16, (voff)[_i], (goff), 0, 0); } while (0)
#define PG8_STAGE_A(bufoff, aoff, hh, nx) do { if constexpr (GATHER) { unsigned gv_[2]; gv_[0] = (nx) ? gvN[hh][0] : gvC[hh][0]; gv_[1] = (nx) ? gvN[hh][1] : gvC[hh][1]; PG8_STAGE(bufoff, aoff, gv_); } \
        else { PG8_STAGE(bufoff, (aoff) + (hh) * hstepA, voffA); } } while (0)
#define PG8_LDA(dst, b, h) do { _Pragma("unroll") for (int m = 0; m < 4; ++m) _Pragma("unroll") for (int k = 0; k < 2; ++k) dst[m][k] = *(const LAS bf16x8*)(lds + PG8_SA(b, h) + aoff + m * 2048 + k * 1024); } while (0)
#define PG8_LDB(dst, b, h) do { _Pragma("unroll") for (int n = 0; n < 2; ++n) _Pragma("unroll") for (int k = 0; k < 2; ++k) dst[n][k] = *(const LAS bf16x8*)(lds + PG8_SB(b, h) + boff + n * 2048 + k * 1024); } while (0)
#define PG8_MMA(ai, bj, At, Bt) do { __builtin_amdgcn_s_setprio(1); \
        if constexpr (FP8) { _Pragma("unroll") for (int m = 0; m < 4; ++m) _Pragma("unroll") for (int n = 0; n < 2; ++n) \
            mfma8(acc[ai][bj][m][n], cat8(Bt[n][0], Bt[n][1]), cat8(At[m][0], At[m][1])); } \
        else { _Pragma("unroll") for (int m = 0; m < 4; ++m) _Pragma("unroll") for (int n = 0; n < 2; ++n) _Pragma("unroll") for (int k = 0; k < 2; ++k) \
            acc[ai][bj][m][n] = __builtin_amdgcn_mfma_f32_16x16x32_bf16(Bt[n][k], At[m][k], acc[ai][bj][m][n], 0, 0, 0); } \
        __builtin_amdgcn_s_setprio(0); } while (0)
#define PG8_WAIT_V(n) asm volatile("s_waitcnt vmcnt(" #n ")" ::: "memory")
#define PG8_WAIT_L(n) asm volatile("s_waitcnt lgkmcnt(" #n ")" ::: "memory")
#define PG8_BAR __builtin_amdgcn_s_barrier()
#define PG8_SCHED __builtin_amdgcn_sched_barrier(0)
    Unit cur, nxt; int ui = 0;
    if (!S.next(0, cur)) return;
    f32x4 acc[2][2][4][2];
#pragma unroll
    for (int a = 0; a < 2; ++a)
#pragma unroll
        for (int b = 0; b < 2; ++b)
#pragma unroll
            for (int m = 0; m < 4; ++m)
#pragma unroll
                for (int n = 0; n < 2; ++n) acc[a][b][m][n] = (f32x4){0.f, 0.f, 0.f, 0.f};
    bf16x8 At[4][2], B0[2][2], B1[2][2];
    unsigned cA = S.A(cur), cB = S.B(cur);
    if constexpr (GATHER) { PG8_GV(gvC, cur); _Pragma("unroll") for (int hh_ = 0; hh_ < 2; ++hh_) _Pragma("unroll") for (int i_ = 0; i_ < 2; ++i_) gvN[hh_][i_] = gvC[hh_][i_]; }
    if constexpr (SP2) {
        PG8_STAGE(PG8_SB(0, 0), cB, voffB); PG8_STAGE(PG8_SB(0, 1), cB + hstepB, voffB); PG8_STAGE_A(PG8_SA(0, 0), cA, 0, false); PG8_STAGE_A(PG8_SA(0, 1), cA, 1, false);
        if (wr == 1) PG8_BAR;
        PG8_WAIT_V(2); PG8_BAR;
        PG8_STAGE(PG8_SB(1, 0), cB + kstep, voffB); PG8_STAGE_A(PG8_SA(1, 0), cA + kstep, 0, false); PG8_STAGE(PG8_SB(1, 1), cB + hstepB + kstep, voffB);
        PG8_WAIT_V(6); PG8_BAR;
    } else {
        PG8_STAGE(PG8_SB(0, 0), cB, voffB); PG8_STAGE_A(PG8_SA(0, 0), cA, 0, false); PG8_STAGE(PG8_SB(0, 1), cB + hstepB, voffB); PG8_STAGE_A(PG8_SA(0, 1), cA, 1, false);
        if (wr == 1) PG8_BAR;
        PG8_WAIT_V(4); PG8_BAR;
        PG8_STAGE(PG8_SB(1, 0), cB + kstep, voffB); PG8_STAGE_A(PG8_SA(1, 0), cA + kstep, 0, false); PG8_STAGE(PG8_SB(1, 1), cB + hstepB + kstep, voffB);
        PG8_WAIT_V(6); PG8_BAR;
    }
    for (;;) {
        const bool has_next = S.next(ui + 1, nxt);
        const unsigned nA = has_next ? S.A(nxt) : cA, nB = has_next ? S.B(nxt) : cB;
        if constexpr (GATHER) { if (has_next) PG8_GV(gvN, nxt); }
        for (int t = 0; t < nt; t += 2) {
            const bool last = (t == nt - 2);
            const unsigned a1 = cA + (unsigned)(t + 1) * kstep;
            const unsigned a2 = last ? nA : cA + (unsigned)(t + 2) * kstep, b2 = last ? nB : cB + (unsigned)(t + 2) * kstep;
            const unsigned a3 = a2 + kstep, b3 = b2 + kstep;
            if constexpr (SP2) {
            PG8_LDB(B0, 0, 0); PG8_LDB(B1, 0, 1); PG8_SCHED; PG8_LDA(At, 0, 0); PG8_STAGE_A(PG8_SA(1, 1), a1, 1, false);
            PG8_WAIT_V(8); PG8_WAIT_L(0); PG8_BAR; PG8_MMA(0, 0, At, B0); PG8_MMA(0, 1, At, B1); PG8_BAR; PG8_SCHED;
            PG8_LDA(At, 0, 1); PG8_STAGE(PG8_SB(0, 0), b2, voffB); PG8_STAGE(PG8_SB(0, 1), b2 + hstepB, voffB); PG8_STAGE_A(PG8_SA(0, 0), a2, 0, last);
            PG8_WAIT_V(8); PG8_WAIT_L(0); PG8_BAR; PG8_MMA(1, 0, At, B0); PG8_MMA(1, 1, At, B1); PG8_BAR; PG8_SCHED;
            PG8_LDB(B0, 1, 0); PG8_LDB(B1, 1, 1); PG8_SCHED; PG8_LDA(At, 1, 0); PG8_STAGE_A(PG8_SA(0, 1), a2, 1, last);
            PG8_WAIT_V(8); PG8_WAIT_L(0); PG8_BAR; PG8_MMA(0, 0, At, B0); PG8_MMA(0, 1, At, B1); PG8_BAR; PG8_SCHED;
            PG8_LDA(At, 1, 1); PG8_STAGE(PG8_SB(1, 0), b3, voffB); PG8_STAGE(PG8_SB(1, 1), b3 + hstepB, voffB); PG8_STAGE_A(PG8_SA(1, 0), a3, 0, last);
            PG8_WAIT_V(8); PG8_WAIT_L(0); PG8_BAR; PG8_MMA(1, 0, At, B0); PG8_MMA(1, 1, At, B1); PG8_BAR; PG8_SCHED;
            } else {
            PG8_LDB(B0, 0, 0); PG8_SCHED; PG8_LDA(At, 0, 0); PG8_STAGE_A(PG8_SA(1, 1), a1, 1, false);
            PG8_WAIT_L(8); PG8_BAR; PG8_WAIT_L(0); PG8_MMA(0, 0, At, B0); PG8_BAR; PG8_SCHED;
            PG8_LDB(B1, 0, 1); PG8_STAGE(PG8_SB(0, 0), b2, voffB);
            PG8_BAR; PG8_WAIT_L(0); PG8_MMA(0, 1, At, B1); PG8_BAR;
            PG8_LDA(At, 0, 1); PG8_STAGE_A(PG8_SA(0, 0), a2, 0, last);
            PG8_BAR; PG8_WAIT_L(0); PG8_MMA(1, 0, At, B0); PG8_BAR; PG8_SCHED;
            PG8_STAGE(PG8_SB(0, 1), b2 + hstepB, voffB);
            PG8_WAIT_V(6); PG8_BAR; PG8_MMA(1, 1, At, B1); PG8_BAR;
            PG8_LDB(B0, 1, 0); PG8_SCHED; PG8_LDA(At, 1, 0); PG8_STAGE_A(PG8_SA(0, 1), a2, 1, last);
            PG8_WAIT_L(8); PG8_BAR; PG8_WAIT_L(0); PG8_MMA(0, 0, At, B0); PG8_BAR; PG8_SCHED;
            PG8_LDB(B1, 1, 1); PG8_STAGE(PG8_SB(1, 0), b3, voffB);
            PG8_BAR; PG8_WAIT_L(0); PG8_MMA(0, 1, At, B1); PG8_BAR;
            PG8_LDA(At, 1, 1); PG8_STAGE_A(PG8_SA(1, 0), a3, 0, last);
            PG8_BAR; PG8_WAIT_L(0); PG8_MMA(1, 0, At, B0); PG8_BAR; PG8_SCHED;
            PG8_STAGE(PG8_SB(1, 1), b3 + hstepB, voffB);
            PG8_WAIT_V(6); PG8_BAR; PG8_MMA(1, 1, At, B1); PG8_BAR;
            }
        }
        if constexpr (ALIGN_EPI) { if (wr == 0) PG8_BAR; }
        if constexpr (FP8) asm volatile("s_nop 15\n\ts_nop 15\n\ts_nop 7" ::: "memory");
        E(acc, cur, wr, wc, fr, fq);
        if (!has_next) break;
#pragma unroll
        for (int a = 0; a < 2; ++a)
#pragma unroll
            for (int b = 0; b < 2; ++b)
#pragma unroll
                for (int m = 0; m < 4; ++m)
#pragma unroll
                    for (int n = 0; n < 2; ++n) acc[a][b][m][n] = (f32x4){0.f, 0.f, 0.f, 0.f};
        cur = nxt; cA = nA; cB = nB; ++ui;
        if constexpr (GATHER) { _Pragma("unroll") for (int hh_ = 0; hh_ < 2; ++hh_) _Pragma("unroll") for (int i_ = 0; i_ < 2; ++i_) gvC[hh_][i_] = gvN[hh_][i_]; }
        if constexpr (ALIGN_EPI) { if (wr == 1) PG8_BAR; }
    }
    PG8_WAIT_V(0);
    if constexpr (!ALIGN_EPI) { if (wr == 0) PG8_BAR; }
    PG8_BAR;
#undef PG8_SA
#undef PG8_SB
#undef PG8_STAGE
#undef PG8_STAGE_A
#undef PG8_GV
#undef PG8_LDA
#undef PG8_LDB
#undef PG8_MMA
#undef PG8_WAIT_V
#undef PG8_WAIT_L
#undef PG8_BAR
#undef PG8_SCHED
}

struct SchedPlain : Order {
    static constexpr bool GATHER = false; __device__ __forceinline__ unsigned arow(const Unit&, int) const { return 0u; }
    unsigned A0, B0, at, bt;
    __device__ __forceinline__ bool next(int i, Unit& u) const { return next_mn(i, u); }
    __device__ __forceinline__ unsigned A(const Unit& u) const { return A0 + (unsigned)u.pm * at; }
    __device__ __forceinline__ unsigned B(const Unit& u) const { return B0 + (unsigned)u.pn * bt; }
};
struct SchedLora : Order {
    static constexpr bool GATHER = false; __device__ __forceinline__ unsigned arow(const Unit&, int) const { return 0u; }
    unsigned A0, B0; int skipv;
    __device__ __forceinline__ bool next(int i, Unit& u) const { if (!next_mn(i, u)) return false; if (skipv && u.pn >= 12) u.pn += 6; return true; }
    __device__ __forceinline__ unsigned A(const Unit& u) const { return A0 + (unsigned)u.pm * (256u * 512u * 2u) + (u.pn >= 18 ? 512u : 0u); }
    __device__ __forceinline__ unsigned B(const Unit& u) const { return B0 + (unsigned)u.pn * (256u * 256u * 2u); }
};
struct SchedMem {
    static constexpr bool GATHER = false; __device__ __forceinline__ unsigned arow(const Unit&, int) const { return 0u; }
    int G, c; unsigned memb, wkv;
    __device__ __forceinline__ bool next(int i, Unit& u) const {
        const int L = i * G + c; if (L >= 64) return false;
        if (L < 32) { u.z = 0; u.pm = L >> 1; u.pn = L & 1; } else { const int q = L - 32; u.z = 1; u.pm = q & 1; u.pn = q >> 1; }
        return true;
    }
    __device__ __forceinline__ unsigned A(const Unit& u) const { return u.z == 0 ? memb + (unsigned)u.pm * (256u * 2048u * 2u) : wkv + (unsigned)(2 + u.pm) * (256u * 2048u * 2u); }
    __device__ __forceinline__ unsigned B(const Unit& u) const { return u.z == 0 ? wkv + (unsigned)u.pn * (256u * 2048u * 2u) : memb + (unsigned)u.pn * (256u * 2048u * 2u); }
};
struct SchedMoE : Order {
    static constexpr bool GATHER = false; __device__ __forceinline__ unsigned arow(const Unit&, int) const { return 0u; }
    unsigned A0, B0, at, bt, be; const int* texp;
    __device__ __forceinline__ bool next(int i, Unit& u) const { if (!next_mn(i, u)) return false; u.z = __builtin_amdgcn_readfirstlane(texp[u.pm]); return true; }
    __device__ __forceinline__ unsigned A(const Unit& u) const { return A0 + (unsigned)u.pm * at; }
    __device__ __forceinline__ unsigned B(const Unit& u) const { return B0 + (unsigned)u.z * be + (unsigned)u.pn * bt; }
};

struct SchedMoEg : Order {
    static constexpr bool GATHER = true;
    unsigned B0, bt, be, xoff, zoff; const int* texp; const int* slot_tok;
    __device__ __forceinline__ bool next(int i, Unit& u) const { if (!next_mn(i, u)) return false; u.z = __builtin_amdgcn_readfirstlane(texp[u.pm]); return true; }
    __device__ __forceinline__ unsigned A(const Unit&) const { return 0u; }
    __device__ __forceinline__ unsigned B(const Unit& u) const { return B0 + (unsigned)u.z * be + (unsigned)u.pn * bt; }
    __device__ __forceinline__ unsigned arow(const Unit& u, int r) const { const int tok = slot_tok[u.pm * 256 + r]; return tok < 0 ? zoff : xoff + (unsigned)tok * 2048u; }
};

struct EpiBf16 {
    static constexpr bool PERM = true;
    bf16* O; int ldc;
    __device__ __forceinline__ void operator()(const f32x4 (&acc)[2][2][4][2], const Unit& u, int wr, int wc, int fr, int fq) const {
        const int row0 = u.pm * BM + wr * 64 + fr, col0 = u.pn * BM + wc * 32 + 8 * fq;
#pragma unroll
        for (int ai = 0; ai < 2; ++ai)
#pragma unroll
            for (int m = 0; m < 4; ++m) { bf16* rowp = O + (size_t)(row0 + ai * HALF + m * 16) * ldc + col0;
#pragma unroll
                for (int bj = 0; bj < 2; ++bj) { const f32x4 v0 = acc[ai][bj][m][0], v1 = acc[ai][bj][m][1];
                    u32x4 w; w.x = cvt_pk_bf16(v0[0], v0[1]); w.y = cvt_pk_bf16(v0[2], v0[3]); w.z = cvt_pk_bf16(v1[0], v1[1]); w.w = cvt_pk_bf16(v1[2], v1[3]);
                    *(u32x4*)(rowp + bj * HALF) = w; } }
    }
};
struct EpiMem {
    static constexpr bool PERM = true;
    bf16* O0; bf16* O1;
    __device__ __forceinline__ void operator()(const f32x4 (&acc)[2][2][4][2], const Unit& u, int wr, int wc, int fr, int fq) const {
        EpiBf16 e; e.O = u.z == 0 ? O0 : O1; e.ldc = u.z == 0 ? 512 : 4096; e(acc, u, wr, wc, fr, fq);
    }
};
struct EpiLora {
    static constexpr bool PERM = true;
    bf16* O; const float* vecs;
    __device__ __forceinline__ void operator()(const f32x4 (&acc)[2][2][4][2], const Unit& u, int wr, int wc, int fr, int fq) const {
        const int type = u.pn / 6;
        const int row0 = u.pm * BM + wr * 64 + fr, col0 = u.pn * BM + wc * 32 + 8 * fq, cb0 = (u.pn % 6) * BM + wc * 32 + 8 * fq;
        const float* bp = vecs + (type < 3 ? type : 0) * SW;
        const float sc = type == 0 ? 0.6065306597126334f : 1.0f;
#pragma unroll
        for (int bj = 0; bj < 2; ++bj) {
            f32x4 bv0 = (f32x4){0.f, 0.f, 0.f, 0.f}, bv1 = bv0;
            if (type < 3) { bv0 = *(const f32x4*)(bp + cb0 + bj * HALF); bv1 = *(const f32x4*)(bp + cb0 + bj * HALF + 4); }
#pragma unroll
            for (int ai = 0; ai < 2; ++ai)
#pragma unroll
                for (int m = 0; m < 4; ++m) { bf16* rowp = O + (size_t)(row0 + ai * HALF + m * 16) * 6144 + col0 + bj * HALF;
                    f32x4 v0_ = acc[ai][bj][m][0] + bv0, v1_ = acc[ai][bj][m][1] + bv1;
                    if (type < 3) {
#pragma unroll
                        for (int j = 0; j < 4; ++j) { v0_[j] = sc * sigmoidf_(v0_[j]); v1_[j] = sc * sigmoidf_(v1_[j]); } }
                    u32x4 w; w.x = cvt_pk_bf16(v0_[0], v0_[1]); w.y = cvt_pk_bf16(v0_[2], v0_[3]); w.z = cvt_pk_bf16(v1_[0], v1_[1]); w.w = cvt_pk_bf16(v1_[2], v1_[3]);
                    *(u32x4*)rowp = w; asm volatile("" ::: "memory"); }
        }
    }
};
struct EpiSwiglu {
    static constexpr bool PERM = true;
    bf16* O; int ldc;
    __device__ __forceinline__ void operator()(const f32x4 (&acc)[2][2][4][2], const Unit& u, int wr, int wc, int fr, int fq) const {
        const int row0 = u.pm * BM + wr * 64 + fr, col0 = u.pn * HALF + wc * 32 + 8 * fq;
#pragma unroll
        for (int ai = 0; ai < 2; ++ai)
#pragma unroll
            for (int m = 0; m < 4; ++m) { bf16* rowp = O + (size_t)(row0 + ai * HALF + m * 16) * ldc + col0;
                float h[8];
#pragma unroll
                for (int n = 0; n < 2; ++n)
#pragma unroll
                    for (int j = 0; j < 4; ++j) { const float g = acc[ai][0][m][n][j], up = acc[ai][1][m][n][j]; h[n * 4 + j] = g * sigmoidf_(g) * up; }
                u32x4 w; w.x = cvt_pk_bf16(h[0], h[1]); w.y = cvt_pk_bf16(h[2], h[3]); w.z = cvt_pk_bf16(h[4], h[5]); w.w = cvt_pk_bf16(h[6], h[7]);
                *(u32x4*)rowp = w; asm volatile("" ::: "memory"); }
    }
};
struct EpiSwiglu8 {
    static constexpr bool PERM = true;
    unsigned char* O; int ldc; float inv, so;
    __device__ __forceinline__ void operator()(const f32x4 (&acc)[2][2][4][2], const Unit& u, int wr, int wc, int fr, int fq) const {
        const int row0 = u.pm * BM + wr * 64 + fr, col0 = u.pn * HALF + wc * 32 + 8 * fq;
        const float c1 = -inv * 1.4426950408889634f, c2 = inv * inv * so;
#pragma unroll
        for (int ai = 0; ai < 2; ++ai)
#pragma unroll
            for (int m = 0; m < 4; ++m) { unsigned char* rowp = O + (size_t)(row0 + ai * HALF + m * 16) * ldc + col0;
                float h[8];
#pragma unroll
                for (int n = 0; n < 2; ++n)
#pragma unroll
                    for (int j = 0; j < 4; ++j) { const float ag = acc[ai][0][m][n][j], au = acc[ai][1][m][n][j];
                        h[n * 4 + j] = (ag * au) * __builtin_amdgcn_rcpf(1.0f + __builtin_amdgcn_exp2f(ag * c1)) * c2; }
                u32x2 w; w.x = pk4_fp8(h[0], h[1], h[2], h[3]); w.y = pk4_fp8(h[4], h[5], h[6], h[7]);
                *(u32x2*)rowp = w; asm volatile("" ::: "memory"); }
    }
};
struct EpiBf16S {
    static constexpr bool PERM = true;
    bf16* O; int ldc; float sc;
    __device__ __forceinline__ void operator()(const f32x4 (&acc)[2][2][4][2], const Unit& u, int wr, int wc, int fr, int fq) const {
        const int row0 = u.pm * BM + wr * 64 + fr, col0 = u.pn * BM + wc * 32 + 8 * fq;
#pragma unroll
        for (int ai = 0; ai < 2; ++ai)
#pragma unroll
            for (int m = 0; m < 4; ++m) { bf16* rowp = O + (size_t)(row0 + ai * HALF + m * 16) * ldc + col0;
#pragma unroll
                for (int bj = 0; bj < 2; ++bj) { const f32x4 v0 = acc[ai][bj][m][0] * sc, v1 = acc[ai][bj][m][1] * sc;
                    u32x4 w; w.x = cvt_pk_bf16(v0[0], v0[1]); w.y = cvt_pk_bf16(v0[2], v0[3]); w.z = cvt_pk_bf16(v1[0], v1[1]); w.w = cvt_pk_bf16(v1[2], v1[3]);
                    *(u32x4*)(rowp + bj * HALF) = w; } }
    }
};
struct EpiFp8S {
    static constexpr bool PERM = true;
    unsigned char* O; int ldc; float sc;
    __device__ __forceinline__ void operator()(const f32x4 (&acc)[2][2][4][2], const Unit& u, int wr, int wc, int fr, int fq) const {
        const int row0 = u.pm * BM + wr * 64 + fr, col0 = u.pn * BM + wc * 32 + 8 * fq;
#pragma unroll
        for (int ai = 0; ai < 2; ++ai)
#pragma unroll
            for (int m = 0; m < 4; ++m) { unsigned char* rowp = O + (size_t)(row0 + ai * HALF + m * 16) * ldc + col0;
#pragma unroll
                for (int bj = 0; bj < 2; ++bj) { const f32x4 v0 = acc[ai][bj][m][0] * sc, v1 = acc[ai][bj][m][1] * sc;
                    u32x2 w; w.x = pk4_fp8(v0[0], v0[1], v0[2], v0[3]); w.y = pk4_fp8(v1[0], v1[1], v1[2], v1[3]);
                    *(u32x2*)(rowp + bj * HALF) = w; } }
    }
};
struct EpiRes {
    static constexpr bool PERM = false;
    const float* X; float* T;
    __device__ __forceinline__ void operator()(const f32x4 (&acc)[2][2][4][2], const Unit& u, int wr, int wc, int fr, int fq) const {
        const int row0 = u.pm * BM + wr * 64 + fr, col0 = u.pn * BM + wc * 32 + 4 * fq;
#pragma unroll
        for (int ai = 0; ai < 2; ++ai)
#pragma unroll
            for (int m = 0; m < 4; ++m) { const size_t off = (size_t)(row0 + ai * HALF + m * 16) * D + col0;
#pragma unroll
                for (int bj = 0; bj < 2; ++bj)
#pragma unroll
                    for (int n = 0; n < 2; ++n) { const f32x4 xv = *(const f32x4*)(X + off + bj * HALF + n * 16);
                        *(f32x4*)(T + off + bj * HALF + n * 16) = xv * ALPHA + acc[ai][bj][m][n]; } }
    }
};
}

struct Args {
    const float* in[43];
    float* out; unsigned char* ws;
    int ph_lo, ph_hi;
};
struct Ctx { LAS unsigned char* lds; int tid, lane, wave, bid, G, gw, NGW; unsigned char* ws; };

enum { I_X = 0, I_MEM = 1, I_POS = 2, I_WKV = 3,
       L0_WIN = 4, L0_MU, L0_LW, L0_LA, L0_LG, L0_VECS, L0_WOUT, L0_NORMS, L0_FG, L0_FU, L0_FD,
       L1_WIN = 15, L1_GN, L1_WOUT, L1_NORMS, L1_ROUTER, L1_MG, L1_MU_, L1_MD,
       L2_WIN = 23, L2_MU, L2_LW, L2_LA, L2_LV, L2_LG, L2_VECS, L2_WOUT, L2_NORMS, L2_FG, L2_FU, L2_FD,
       L3_WIN = 35, L3_GN, L3_WOUT, L3_NORMS, L3_ROUTER, L3_MG, L3_MU_, L3_MD };

__device__ __forceinline__ void tr_load(f32x4 (&v)[8], const float* W, int ldw, int k0, int n0, int lane) {
#pragma unroll
    for (int i = 0; i < 8; ++i) v[i] = *(const f32x4*)(W + (size_t)(k0 + 8 * i + (lane >> 3)) * ldw + n0 + 4 * (lane & 7));
}
__device__ __forceinline__ void tr_store(const f32x4 (&v)[8], int k0, bf16* WT, int ldt, int drow0, LAS float* scr, int lane) {
#pragma unroll
    for (int i = 0; i < 8; ++i) { LAS float* d = scr + (8 * i + (lane >> 3)) * 33 + 4 * (lane & 7); d[0] = v[i][0]; d[1] = v[i][1]; d[2] = v[i][2]; d[3] = v[i][3]; }
    LDS_WAIT(); asm volatile("" ::: "memory");
    const int c = lane & 7;
#pragma unroll
    for (int j = 0; j < 4; ++j) { const int n = (lane >> 3) + 8 * j; const LAS float* s = scr + (8 * c) * 33 + n;
        u32x4 o; o.x = cvt_pk_bf16(s[0 * 33], s[1 * 33]); o.y = cvt_pk_bf16(s[2 * 33], s[3 * 33]); o.z = cvt_pk_bf16(s[4 * 33], s[5 * 33]); o.w = cvt_pk_bf16(s[6 * 33], s[7 * 33]);
        *(u32x4*)(WT + (size_t)(drow0 + n) * ldt + k0 + 8 * c) = o; }
    LDS_WAIT(); asm volatile("" ::: "memory");
}
__device__ __forceinline__ void conv_mat(const Ctx& C, const float* W, int K, int N, bf16* WT, int mode, int off, int gw0) {
    LAS float* scr = (LAS float*)(C.lds + C.wave * 16384);
    const int nblk = N / 32, items = (K / 64) * nblk;
    int start = C.gw - gw0; if (start < 0) start += C.NGW;
#define CONV_DROW(n0_) (mode == 0 ? off + (n0_) : ((n0_) / 128) * 256 + off + ((n0_) % 128))
    f32x4 va[8], vb[8];
    int it = start;
    if (it < items) tr_load(va, W, N, 64 * (it / nblk), 32 * (it % nblk), C.lane);
    while (it < items) {
        const int it1 = it + C.NGW;
        if (it1 < items) tr_load(vb, W, N, 64 * (it1 / nblk), 32 * (it1 % nblk), C.lane);
        tr_store(va, 64 * (it / nblk), WT, K, CONV_DROW(32 * (it % nblk)), scr, C.lane);
        if (it1 >= items) break;
        const int it2 = it1 + C.NGW;
        if (it2 < items) tr_load(va, W, N, 64 * (it2 / nblk), 32 * (it2 % nblk), C.lane);
        tr_store(vb, 64 * (it1 / nblk), WT, K, CONV_DROW(32 * (it1 % nblk)), scr, C.lane);
        it = it2;
    }
#undef CONV_DROW
}
__device__ __forceinline__ void conv_lora(const Ctx& C, const float* lw, const float* la, const float* lv, const float* lg, bf16* Bt) {
    for (int idx = C.bid * NTHR + C.tid; idx < 6144 * 256; idx += C.G * NTHR) {
        const int n_ = idx % 1536, rest = idx / 1536, k = rest % 256, blk = rest / 256;
        float v = 0.f;
        if (blk == 0) { if (k < 96) v = lw[k * 1536 + n_]; }
        else if (blk == 1) { if (k >= 96 && k < 192) v = la[(k - 96) * 1536 + n_]; }
        else if (blk == 2) { if (lv && k >= 192) v = lv[(k - 192) * 1536 + n_]; }
        else v = lg[k * 1536 + n_];
        Bt[(size_t)(blk * 1536 + n_) * 256 + k] = f2bf(v);
    }
}
__device__ __forceinline__ void conv_f32_bf16(const Ctx& C, const float* src, bf16* dst, size_t n8) {
    const size_t T = (size_t)C.G * NTHR;
    for (size_t i0 = (size_t)C.bid * NTHR + C.tid; i0 < n8; i0 += 4 * T) { f32x4 av[4], bv[4];
#pragma unroll
        for (int q = 0; q < 4; ++q) { av[q] = ((const f32x4*)src)[2 * (i0 + q * T)]; bv[q] = ((const f32x4*)src)[2 * (i0 + q * T) + 1]; }
#pragma unroll
        for (int q = 0; q < 4; ++q) { const f32x4 a = av[q], b = bv[q];
            u32x4 w; w.x = cvt_pk_bf16(a[0], a[1]); w.y = cvt_pk_bf16(a[2], a[3]); w.z = cvt_pk_bf16(b[0], b[1]); w.w = cvt_pk_bf16(b[2], b[3]);
            ((u32x4*)dst)[i0 + q * T] = w; } }
}

struct CvJob { const float* W; bf16* WT; int N, K, k0, n0, mode, off; float f8s; };
__device__ __forceinline__ void cv_load(f32x4 (&v)[8], const CvJob& J, int wave, int lane) {
    const int n = J.n0 + 4 * lane;
#pragma unroll
    for (int i = 0; i < 8; ++i) { v[i] = (f32x4){0.f, 0.f, 0.f, 0.f}; if (n < J.N) v[i] = *(const f32x4*)(J.W + (size_t)(J.k0 + 8 * wave + i) * J.N + n); }
}
__device__ __forceinline__ void cv_put(const f32x4 (&v)[8], LAS float* T, int wave, int lane) {
#pragma unroll
    for (int i = 0; i < 8; ++i) *(LAS f32x4*)(T + (8 * wave + i) * 256 + 4 * (lane ^ wave)) = v[i];
}
__device__ __forceinline__ void cv_out(const CvJob& J, const LAS float* T, int wave, int lane) {
    const int c = lane & 7;
#pragma unroll
    for (int j = 0; j < 4; ++j) { const int nl = 32 * wave + 8 * j + (lane >> 3), n = J.n0 + nl; const LAS float* s = T + (8 * c) * 256 + (nl ^ (c << 2));
        u32x4 o; o.x = cvt_pk_bf16(s[0 * 256], s[1 * 256]); o.y = cvt_pk_bf16(s[2 * 256], s[3 * 256]); o.z = cvt_pk_bf16(s[4 * 256], s[5 * 256]); o.w = cvt_pk_bf16(s[6 * 256], s[7 * 256]);
        if (n < J.N) { const int drow = J.mode == 0 ? J.off + n : (n / 128) * 256 + J.off + (n % 128);
            *(u32x4*)(J.WT + (size_t)drow * J.K + J.k0 + 8 * c) = o; } }
}
__device__ __forceinline__ void cv_out8(const CvJob& J, const LAS float* T, int wave, int lane) {
    const int c4 = lane & 3; unsigned char* W8 = (unsigned char*)J.WT;
#pragma unroll
    for (int j = 0; j < 2; ++j) { const int nl = 32 * wave + 16 * j + (lane >> 2), n = J.n0 + nl;
        float v[16];
#pragma unroll
        for (int q = 0; q < 16; ++q) { const int k = 16 * c4 + q; v[q] = T[k * 256 + (nl ^ (((k >> 3) & 7) << 2))] * J.f8s; }
        u32x4 o; o.x = pk4_fp8(v[0], v[1], v[2], v[3]); o.y = pk4_fp8(v[4], v[5], v[6], v[7]); o.z = pk4_fp8(v[8], v[9], v[10], v[11]); o.w = pk4_fp8(v[12], v[13], v[14], v[15]);
        if (n < J.N) { const int drow = J.mode == 0 ? J.off + n : (n / 128) * 256 + J.off + (n % 128);
            *(u32x4*)(W8 + (size_t)drow * J.K + J.k0 + 16 * c4) = o; } }
}
template <class Dec>
__device__ __forceinline__ void conv_run(const Ctx& C, int ntiles, const Dec& dec, const int t0 = -1, const int STR = GRID) {
    LAS float* T = (LAS float*)C.lds;
    f32x4 va[8], vb[8]; CvJob ja, jb, jc;
    int t = t0 < 0 ? C.bid : t0;
    if (t < ntiles) { dec(t, ja); cv_load(va, ja, C.wave, C.lane); }
    if (t + STR < ntiles) { dec(t + STR, jb); cv_load(vb, jb, C.wave, C.lane); }
    while (t < ntiles) {
        __syncthreads(); cv_put(va, T, C.wave, C.lane); jc = ja;
        if (t + 2 * STR < ntiles) { dec(t + 2 * STR, ja); cv_load(va, ja, C.wave, C.lane); }
        __syncthreads(); if (jc.f8s > 0.f) cv_out8(jc, T, C.wave, C.lane); else cv_out(jc, T, C.wave, C.lane);
        t += STR; if (t >= ntiles) break;
        __syncthreads(); cv_put(vb, T, C.wave, C.lane); jc = jb;
        if (t + 2 * STR < ntiles) { dec(t + 2 * STR, jb); cv_load(vb, jb, C.wave, C.lane); }
        __syncthreads(); if (jc.f8s > 0.f) cv_out8(jc, T, C.wave, C.lane); else cv_out(jc, T, C.wave, C.lane);
        t += STR;
    }
    __syncthreads();
}
struct MoeDec { const float* mg; const float* mu; const float* md; unsigned char* ws;
    __device__ __forceinline__ void operator()(int t, CvJob& J) const {
        const int j = t / 704, r = t % 704, e = j / 3, kind = j % 3;
        if (kind < 2) { J.W = (kind == 0 ? mg : mu) + (size_t)e * 2048 * 5632; J.WT = (bf16*)(ws + WS_MWGU + (size_t)e * 22 * MiB); J.N = 5632; J.K = 2048; J.mode = 1; J.off = kind * 128; J.f8s = 1024.f; J.k0 = 64 * (r / 22); J.n0 = 256 * (r % 22); }
        else { J.W = md + (size_t)e * 2048 * 5632; J.WT = (bf16*)(ws + WS_MWD + (size_t)e * 11 * MiB); J.N = 2048; J.K = 5632; J.mode = 0; J.off = 0; J.f8s = 2048.f; J.k0 = 64 * (r / 8); J.n0 = 256 * (r % 8); }
    } };
struct StaticDec { const float* const* in; unsigned char* ws;
    __device__ __forceinline__ void set(CvJob& J, const float* W, bf16* WT, int K, int N, int mode, int off, int r, float f8s = 0.f) const {
        const int nn = (N + 255) / 256; J.W = W; J.WT = WT; J.N = N; J.K = K; J.mode = mode; J.off = off; J.f8s = f8s; J.k0 = 64 * (r / nn); J.n0 = 256 * (r % nn); }
    __device__ __forceinline__ void operator()(int t, CvJob& J) const {
        int r = t;
        if (r < 128) { set(J, in[I_WKV], (bf16*)(ws + WS_WKV), 2048, 1024, 0, 0, r); return; } r -= 128;
        set(J, in[L0_WIN], (bf16*)(ws + WS_WIN), 2048, 5568, 0, 0, r);
    } };

struct SlotDec { const float* const* in; unsigned char* ws; int lq; MoeDec moe; StaticDec sd;
    __device__ __forceinline__ void operator()(int t, CvJob& J) const {
        if (t < 16896) { moe(t, J); return; }
        int r = t - 16896; const size_t l = (size_t)lq;
        if (r < 704) { sd.set(J, lq ? in[L2_FG] : in[L0_FG], (bf16*)(ws + WS_WFGU + l * 44 * MiB), 2048, 5632, 1, 0, r, 1024.f); return; } r -= 704;
        if (r < 704) { sd.set(J, lq ? in[L2_FU] : in[L0_FU], (bf16*)(ws + WS_WFGU + l * 44 * MiB), 2048, 5632, 1, 128, r, 1024.f); return; } r -= 704;
        if (r < 704) { sd.set(J, lq ? in[L2_FD] : in[L0_FD], (bf16*)(ws + WS_WFD + l * 22 * MiB), 5632, 2048, 0, 0, r, 2048.f); return; } r -= 704;
        if (r < 256) { sd.set(J, lq ? in[L2_WOUT] : in[L0_WOUT], (bf16*)(ws + WS_WOUT + l * 16 * MiB), 2048, 2048, 0, 0, r); return; } r -= 256;
        if (r < 256) { sd.set(J, lq ? in[L3_WOUT] : in[L1_WOUT], (bf16*)(ws + WS_WOUT + (l * 16 + 8) * MiB), 2048, 2048, 0, 0, r); return; } r -= 256;
        if (r < 640) { sd.set(J, lq ? in[L3_WIN] : in[L1_WIN], (bf16*)(ws + WS_WIN + (l * 44 + 22) * MiB), 2048, 5120, 0, 0, r); return; } r -= 640;
        sd.set(J, in[L2_WIN], (bf16*)(ws + WS_WIN + (size_t)44 * MiB), 2048, 5632, 0, 0, r);
    } };

__device__ __forceinline__ void ph_prologue(const Ctx& C, const Args& A) {
    unsigned char* ws = C.ws;
    { StaticDec dec; dec.in = A.in; dec.ws = ws; conv_run(C, 832, dec); }
    conv_lora(C, A.in[L0_LW], A.in[L0_LA], nullptr, A.in[L0_LG], (bf16*)(ws + WS_WLORA));
    conv_lora(C, A.in[L2_LW], A.in[L2_LA], A.in[L2_LV], A.in[L2_LG], (bf16*)(ws + WS_WLORA + 3 * MiB));
    { u32x4* z = (u32x4*)(ws + WS_WIN + (size_t)5568 * 2048 * 2);
      for (int i = C.bid * NTHR + C.tid; i < 64 * 2048 * 2 / 16; i += C.G * NTHR) z[i] = (u32x4){0u, 0u, 0u, 0u}; }
    { const f32x4* xs = (const f32x4*)A.in[I_X]; u32x2* hi = (u32x2*)(ws + WS_XB); unsigned* lo = (unsigned*)(ws + WS_XLO);
      const size_t T = (size_t)C.G * NTHR;
      for (size_t i0 = (size_t)C.bid * NTHR + C.tid; i0 < (size_t)M * D / 4; i0 += 8 * T) { f32x4 ov[8];
#pragma unroll
          for (int q = 0; q < 8; ++q) ov[q] = xs[i0 + q * T];
#pragma unroll
          for (int q = 0; q < 8; ++q) { const f32x4 o = ov[q]; const size_t i = i0 + q * T;
              u32x2 w; w.x = cvt_pk_bf16(o[0], o[1]); w.y = cvt_pk_bf16(o[2], o[3]); hi[i] = w;
              lo[i] = pk4_fp8((o[0] - bflo(w.x)) * 8192.f, (o[1] - bfhi(w.x)) * 8192.f, (o[2] - bflo(w.y)) * 8192.f, (o[3] - bfhi(w.y)) * 8192.f); } } }
    conv_f32_bf16(C, A.in[I_MEM], (bf16*)(ws + WS_MEMB), (size_t)4096 * 2048 / 8);
    { const int* pos = (const int*)A.in[I_POS]; f32x2* cs = (f32x2*)(ws + WS_CS);
      for (int idx = C.bid * NTHR + C.tid; idx < M * 64; idx += C.G * NTHR) {
          const int m = idx >> 6, i = idx & 63;
          const float pw = (float)exp2(13.287712379549449 * (double)i / 64.0);
          const float inv = 1.0f / pw;
          const float ang = (float)pos[m] * inv;
          const double x = (double)ang;
          const double n = rint(x * 0.15915494309189535);
          const double r = fma(-n, 6.283185307179586, x) - n * 2.4492935982947064e-16;
          const double r2 = r * r;
          double s = -1.0 / 121645100408832000.0;
          s = fma(s, r2, 1.0 / 355687428096000.0);
          s = fma(s, r2, -1.0 / 1307674368000.0);
          s = fma(s, r2, 1.0 / 6227020800.0);
          s = fma(s, r2, -1.0 / 39916800.0);
          s = fma(s, r2, 1.0 / 362880.0);
          s = fma(s, r2, -1.0 / 5040.0);
          s = fma(s, r2, 1.0 / 120.0);
          s = fma(s, r2, -1.0 / 6.0);
          s = fma(s * r2, r, r);
          double c = 1.0 / 2432902008176640000.0;
          c = fma(c, r2, -1.0 / 6402373705728000.0);
          c = fma(c, r2, 1.0 / 20922789888000.0);
          c = fma(c, r2, -1.0 / 87178291200.0);
          c = fma(c, r2, 1.0 / 479001600.0);
          c = fma(c, r2, -1.0 / 3628800.0);
          c = fma(c, r2, 1.0 / 40320.0);
          c = fma(c, r2, -1.0 / 720.0);
          c = fma(c, r2, 1.0 / 24.0);
          c = fma(c, r2, -0.5);
          c = fma(c, r2, 1.0);
          cs[idx] = (f32x2){(float)c, (float)s};
      } }
}

struct LnRow { u32x2 rh[8]; unsigned rl[8]; u32x2 a[8]; float w1, w2; };
__device__ __forceinline__ void ln_load(LnRow& R, const Ctx& C, int m, const void* Hp, int hmode, int s1, int s2, float w1, float w2) {
    const u32x2* hr = (const u32x2*)(C.ws + WS_XB + (size_t)m * D * 2) + C.lane;
    const unsigned* lr = (const unsigned*)(C.ws + (hmode == 0 ? WS_XLO : WS_X8) + (size_t)m * D) + C.lane;
#pragma unroll
    for (int j = 0; j < 8; ++j) { R.rh[j] = hr[64 * j]; R.rl[j] = lr[64 * j]; }
    if (hmode == 0) {
        const u32x2* ar = (const u32x2*)((const bf16*)Hp + (size_t)m * D) + C.lane;
#pragma unroll
        for (int j = 0; j < 8; ++j) R.a[j] = ar[64 * j];
        R.w1 = 1.f; R.w2 = 0.f;
    } else if (hmode == 1) {
        const unsigned* ar = (const unsigned*)((const unsigned char*)Hp + (size_t)m * D) + C.lane;
#pragma unroll
        for (int j = 0; j < 8; ++j) { R.a[j].x = ar[64 * j]; R.a[j].y = 0u; }
        R.w1 = 1.f / 256.f; R.w2 = 0.f;
    } else {
        R.w1 = w1; R.w2 = w2;
        const unsigned* y1 = (const unsigned*)((const unsigned char*)Hp + (size_t)s1 * D) + C.lane;
        const unsigned* y2 = (const unsigned*)((const unsigned char*)Hp + (size_t)s2 * D) + C.lane;
#pragma unroll
        for (int j = 0; j < 8; ++j) { R.a[j].x = y1[64 * j]; R.a[j].y = y2[64 * j]; }
    }
}
__device__ __forceinline__ void ln_row(const LnRow& R, const Ctx& C, int m, const float* gain, const float* bias, int hmode, float* Xf32out, unsigned char* X8out,
                                       LAS float* rw, LAS int* hist, bool do_route) {
    const int l4 = 4 * C.lane;
    f32x4 v[8]; float s = 0.f;
#pragma unroll
    for (int j = 0; j < 8; ++j) { f32x4 f, x;
        const f32x2 l01 = __builtin_amdgcn_cvt_pk_f32_fp8(R.rl[j], false), l23 = __builtin_amdgcn_cvt_pk_f32_fp8(R.rl[j], true);
        const float ls = hmode == 0 ? (1.f / 8192.f) : (1.f / 16.f);
        x[0] = bflo(R.rh[j].x) + l01[0] * ls; x[1] = bfhi(R.rh[j].x) + l01[1] * ls; x[2] = bflo(R.rh[j].y) + l23[0] * ls; x[3] = bfhi(R.rh[j].y) + l23[1] * ls;
        if (hmode == 0) { f[0] = bflo(R.a[j].x); f[1] = bfhi(R.a[j].x); f[2] = bflo(R.a[j].y); f[3] = bfhi(R.a[j].y); }
        else { const f32x2 a01 = __builtin_amdgcn_cvt_pk_f32_fp8(R.a[j].x, false), a23 = __builtin_amdgcn_cvt_pk_f32_fp8(R.a[j].x, true);
            f[0] = R.w1 * a01[0]; f[1] = R.w1 * a01[1]; f[2] = R.w1 * a23[0]; f[3] = R.w1 * a23[1];
            if (hmode == 2) { const f32x2 b01 = __builtin_amdgcn_cvt_pk_f32_fp8(R.a[j].y, false), b23 = __builtin_amdgcn_cvt_pk_f32_fp8(R.a[j].y, true);
                f[0] += R.w2 * b01[0]; f[1] += R.w2 * b01[1]; f[2] += R.w2 * b23[0]; f[3] += R.w2 * b23[1]; } }
        v[j] = x * ALPHA + f; s += (v[j][0] + v[j][1]) + (v[j][2] + v[j][3]); }
    const float mean = wave_sum(s) * (1.f / D); float s2 = 0.f;
#pragma unroll
    for (int j = 0; j < 8; ++j) { v[j] = v[j] - mean; s2 += (v[j][0] * v[j][0] + v[j][1] * v[j][1]) + (v[j][2] * v[j][2] + v[j][3] * v[j][3]); }
    const float rstd = 1.0f / sqrtf(wave_sum(s2) * (1.f / D) + LN_EPS);
    float lg[8];
#pragma unroll
    for (int e = 0; e < 8; ++e) lg[e] = 0.f;
    u32x2* ho = (u32x2*)(C.ws + WS_XB + (size_t)m * D * 2) + C.lane;
    unsigned* lo = (unsigned*)(C.ws + WS_XLO + (size_t)m * D) + C.lane;
#pragma unroll
    for (int j = 0; j < 8; ++j) {
        const f32x4 gv = *((const f32x4*)(gain + 256 * j + l4)), bv = *((const f32x4*)(bias + 256 * j + l4));
        const f32x4 o = v[j] * rstd * gv + bv;
        if (Xf32out) ((f32x4*)(Xf32out + (size_t)m * D))[64 * j + C.lane] = o;
        else if (X8out) {
            const unsigned p8 = pk4_fp8(o[0] * 16.f, o[1] * 16.f, o[2] * 16.f, o[3] * 16.f);
            ((unsigned*)(X8out + (size_t)m * D))[64 * j + C.lane] = p8;
            const f32x2 d01 = __builtin_amdgcn_cvt_pk_f32_fp8(p8, false), d23 = __builtin_amdgcn_cvt_pk_f32_fp8(p8, true);
            u32x2 w; w.x = cvt_pk_bf16(o[0] - d01[0] * (1.f / 16.f), o[1] - d01[1] * (1.f / 16.f)); w.y = cvt_pk_bf16(o[2] - d23[0] * (1.f / 16.f), o[3] - d23[1] * (1.f / 16.f)); ho[64 * j] = w; }
        else { u32x2 w; w.x = cvt_pk_bf16(o[0], o[1]); w.y = cvt_pk_bf16(o[2], o[3]); ho[64 * j] = w;
            lo[64 * j] = pk4_fp8((o[0] - bflo(w.x)) * 8192.f, (o[1] - bfhi(w.x)) * 8192.f, (o[2] - bflo(w.y)) * 8192.f, (o[3] - bfhi(w.y)) * 8192.f); }
        if (do_route) {
#pragma unroll
            for (int e = 0; e < 8; ++e) { const f32x4 we = *(const LAS f32x4*)(rw + e * 2048 + 256 * j + l4);
                lg[e] += (o[0] * we[0] + o[1] * we[1]) + (o[2] * we[2] + o[3] * we[3]); }
        }
    }
    if (do_route) {
#pragma unroll
        for (int e = 0; e < 8; ++e) lg[e] = wave_sum(lg[e]);
        int e1 = 0; float v1 = lg[0];
#pragma unroll
        for (int e = 1; e < 8; ++e) if (lg[e] > v1) { v1 = lg[e]; e1 = e; }
        int e2 = -1; float v2 = -3.0e38f;
#pragma unroll
        for (int e = 0; e < 8; ++e) if (e != e1 && lg[e] > v2) { v2 = lg[e]; e2 = e; }
        const float ex = __expf(v2 - v1); const float w1 = 1.0f / (1.0f + ex), w2 = ex / (1.0f + ex);
        if (C.lane == 0) { f32x4 rt; rt[0] = __int_as_float(e1 | (e2 << 8)); rt[1] = w1; rt[2] = w2; rt[3] = 0.f; ((f32x4*)(C.ws + WS_ROUTE))[m] = rt;
            atomicAdd((int*)&hist[e1], 1); atomicAdd((int*)&hist[e2], 1); }
    }
}
__device__ __forceinline__ void ph_ln(const Ctx& C, const void* Hp, int hmode, const float* gain, const float* bias, float* Xf32out, unsigned char* X8out,
                                      const float* router, bool do_route) {
    unsigned char* ws = C.ws;
    LAS float* rw = (LAS float*)C.lds;
    LAS int* hist = (LAS int*)(C.lds + LDS_MISC + 64);
    if (do_route) {
        for (int col = C.tid; col < 2048; col += NTHR) { const f32x4 a = ((const f32x4*)router)[2 * col], b = ((const f32x4*)router)[2 * col + 1];
            rw[0 * 2048 + col] = a[0]; rw[1 * 2048 + col] = a[1]; rw[2 * 2048 + col] = a[2]; rw[3 * 2048 + col] = a[3]; rw[4 * 2048 + col] = b[0]; rw[5 * 2048 + col] = b[1]; rw[6 * 2048 + col] = b[2]; rw[7 * 2048 + col] = b[3]; }
        if (C.tid < 8) hist[C.tid] = 0;
        int* st = (int*)(ws + WS_SLOTTOK);
        for (int i = C.bid * NTHR + C.tid; i < NSLOT; i += C.G * NTHR) st[i] = -1;
        __syncthreads();
    }
    const int m0 = C.bid * 128 + C.wave * 16;
    LnRow Ra, Rb;
    int s1v = 0, s2v = 0, w1v = 0, w2v = 0;
    if (hmode == 2) { const int mr = m0 + (C.lane & 15); const f32x4 rt = ((const f32x4*)(ws + WS_ROUTE))[mr];
        s1v = ((const int*)(ws + WS_SLOT1))[mr]; s2v = ((const int*)(ws + WS_SLOT2))[mr]; w1v = __float_as_int(rt[1] * (1.f / 256.f)); w2v = __float_as_int(rt[2] * (1.f / 256.f)); }
#define LN_LOAD(R_, r_) ln_load(R_, C, m0 + (r_), Hp, hmode, __builtin_amdgcn_readlane(s1v, (r_)), __builtin_amdgcn_readlane(s2v, (r_)), __int_as_float(__builtin_amdgcn_readlane(w1v, (r_))), __int_as_float(__builtin_amdgcn_readlane(w2v, (r_))))
    LN_LOAD(Ra, 0);
#pragma unroll 1
    for (int r = 0; r < 16; r += 2) {
        LN_LOAD(Rb, r + 1);
        ln_row(Ra, C, m0 + r, gain, bias, hmode, Xf32out, X8out, rw, hist, do_route);
        if (r + 2 < 16) LN_LOAD(Ra, r + 2);
        ln_row(Rb, C, m0 + r + 1, gain, bias, hmode, Xf32out, X8out, rw, hist, do_route);
    }
#undef LN_LOAD
    if (do_route) { __syncthreads(); if (C.tid < 8) ((int*)(ws + WS_CTL))[CW_CNT + C.bid * 8 + C.tid] = hist[C.tid]; }
}

__device__ __forceinline__ void ph_slots(const Ctx& C) {
    unsigned char* ws = C.ws;
    LAS int* sm = (LAS int*)(C.lds + LDS_MISC + 128);
    const int* cnt = (const int*)(ws + WS_CTL) + CW_CNT;
    if (C.tid < 8) { int tot = 0, mine = 0; for (int b = 0; b < C.G; ++b) { const int c = cnt[b * 8 + C.tid]; if (b < C.bid) mine += c; tot += c; } sm[C.tid] = tot; sm[8 + C.tid] = mine; }
    __syncthreads();
    if (C.tid == 0) { int base = 0; for (int e = 0; e < 8; ++e) { sm[16 + e] = base; base += (sm[e] + 255) & ~255; } sm[24] = base >> 8; }
    __syncthreads();
    if (C.wave == 0) {
        int off[8];
#pragma unroll
        for (int e = 0; e < 8; ++e) off[e] = sm[16 + e] + sm[8 + e];
        const unsigned long long lt = (1ull << C.lane) - 1ull;
        for (int it = 0; it < 2; ++it) {
            const int m = C.bid * 128 + it * 64 + C.lane;
            const int ee = __float_as_int(((const f32x4*)(ws + WS_ROUTE))[m][0]); const int e1 = ee & 0xff, e2 = (ee >> 8) & 0xff;
            int s1 = 0, s2 = 0;
#pragma unroll
            for (int e = 0; e < 8; ++e) { const unsigned long long m1 = __ballot(e1 == e), m2 = __ballot(e2 == e);
                const int c1 = __popcll(m1), c2 = __popcll(m2);
                if (e1 == e) s1 = off[e] + __popcll(m1 & lt);
                if (e2 == e) s2 = off[e] + c1 + __popcll(m2 & lt);
                off[e] += c1 + c2; }
            ((int*)(ws + WS_SLOT1))[m] = s1; ((int*)(ws + WS_SLOT2))[m] = s2;
            int* st = (int*)(ws + WS_SLOTTOK); st[s1] = m; st[s2] = m;
        }
    }
    if (C.bid == 0) {
        int* ctl = (int*)(ws + WS_CTL);
        if (C.tid == 0) ctl[CW_NT] = sm[24];
        if (C.tid < 264) { int e = 0;
#pragma unroll
            for (int q = 1; q < 8; ++q) if (C.tid >= (sm[16 + q] >> 8)) e = q;
            ctl[CW_TEXP + C.tid] = e; }
    }
}
__device__ __forceinline__ void ph_gather(const Ctx& C) {
    unsigned char* ws = C.ws;
    const int* st = (const int*)(ws + WS_SLOTTOK); const u32x4* xb = (const u32x4*)(ws + WS_XB); u32x4* xp = (u32x4*)(ws + WS_XPERM);
    for (int s = C.gw; s < NSLOT; s += C.NGW) { const int tok = st[s];
#pragma unroll
        for (int j = 0; j < 2; ++j) { u32x4 v = xb[(size_t)(tok < 0 ? 0 : tok) * 128 + j * 64 + C.lane]; const unsigned k = tok < 0 ? 0u : 0xffffffffu; v.x &= k; v.y &= k; v.z &= k; v.w &= k; xp[(size_t)s * 128 + j * 64 + C.lane] = v; } }
}
__device__ __forceinline__ void ph_moe_wconv(const Ctx& C, const float* mg, const float* mu, const float* md, const float* const* in, int lq) {
    SlotDec dec; dec.in = in; dec.ws = C.ws; dec.lq = lq; dec.moe.mg = mg; dec.moe.mu = mu; dec.moe.md = md; dec.moe.ws = C.ws; dec.sd.in = in; dec.sd.ws = C.ws;
    conv_run(C, lq ? 20160 : 20864, dec, C.bid - 192, 64);
}

__device__ __forceinline__ void ph_memattn(const Ctx& C, const bf16* P, int ldp, int qm0) {
    unsigned char* ws = C.ws;
    const bf16* memK = (const bf16*)(ws + WS_MEMK); const bf16* memVT = (const bf16*)(ws + WS_MEMVT); bf16* mix = (bf16*)(ws + WS_MIX);
    const int g = C.lane >> 4, r16 = C.lane & 15;
    LAS unsigned char* LK = C.lds; LAS unsigned char* LV = C.lds + 65536;
    const int b = C.bid >> 4, hm = (C.bid >> 2) & 3, qb = C.bid & 3;
    __syncthreads();
    {   u32x4 st[16];
#pragma unroll
        for (int i = 0; i < 8; ++i) { const int q = C.tid + 512 * i, row = q >> 4, pc = q & 15;
            st[i] = *(const u32x4*)(memK + (size_t)(b * 256 + row) * 512 + hm * 128 + pc * 8); }
#pragma unroll
        for (int i = 0; i < 8; ++i) { const int q = C.tid + 512 * i, row = q >> 5, pc = q & 31;
            st[8 + i] = *(const u32x4*)(memVT + (size_t)(hm * 128 + row) * 4096 + b * 256 + pc * 8); }
#pragma unroll
        for (int i = 0; i < 8; ++i) { const int q = C.tid + 512 * i, row = q >> 4, pc = q & 15;
            *(LAS u32x4*)(LK + row * 256 + ((pc ^ (row & 15)) * 16)) = st[i]; }
#pragma unroll
        for (int i = 0; i < 8; ++i) { const int q = C.tid + 512 * i, row = q >> 5, pc = q & 31;
            *(LAS u32x4*)(LV + row * 512 + ((pc ^ (row & 15)) * 16)) = st[8 + i]; }
    }
    __syncthreads();
    for (int qt = 0; qt < 4; ++qt) {
        const int m0 = b * SEQ + qb * 512 + C.wave * 64 + qt * 16;
        bf16x8 qf[4];
#pragma unroll
        for (int s = 0; s < 4; ++s) qf[s] = *(const bf16x8*)(P + (size_t)(m0 + r16) * ldp + qm0 + hm * 128 + 32 * s + 8 * g);
        f32x4 sacc[16];
#pragma unroll
        for (int kt = 0; kt < 16; ++kt) { sacc[kt] = (f32x4){0.f, 0.f, 0.f, 0.f};
#pragma unroll
            for (int s = 0; s < 4; ++s) { const bf16x8 kf = *(const LAS bf16x8*)(LK + (16 * kt + r16) * 256 + (((4 * s + g) ^ r16) * 16));
                sacc[kt] = __builtin_amdgcn_mfma_f32_16x16x32_bf16(kf, qf[s], sacc[kt], 0, 0, 0); } }
        float mx = -3.0e38f;
#pragma unroll
        for (int kt = 0; kt < 16; ++kt)
#pragma unroll
            for (int j = 0; j < 4; ++j) mx = fmaxf(mx, sacc[kt][j]);
        mx = fmaxf(mx, shx(mx, C.lane, 16)); mx = fmaxf(mx, shx(mx, C.lane, 32));
        const float sc = 0.08838834764831845f * 1.4426950408889634f;
        float sum = 0.f;
#pragma unroll
        for (int kt = 0; kt < 16; ++kt)
#pragma unroll
            for (int j = 0; j < 4; ++j) { const float pv = exp2f((sacc[kt][j] - mx) * sc); sacc[kt][j] = pv; sum += pv; }
        sum += shx(sum, C.lane, 16); sum += shx(sum, C.lane, 32);
        f32x4 oacc[8];
#pragma unroll
        for (int dt = 0; dt < 8; ++dt) oacc[dt] = (f32x4){0.f, 0.f, 0.f, 0.f};
#pragma unroll
        for (int ks = 0; ks < 8; ++ks) {
            u32x4 pw; pw.x = cvt_pk_bf16(sacc[2 * ks][0], sacc[2 * ks][1]); pw.y = cvt_pk_bf16(sacc[2 * ks][2], sacc[2 * ks][3]);
            pw.z = cvt_pk_bf16(sacc[2 * ks + 1][0], sacc[2 * ks + 1][1]); pw.w = cvt_pk_bf16(sacc[2 * ks + 1][2], sacc[2 * ks + 1][3]);
            const bf16x8 pa = __builtin_bit_cast(bf16x8, pw);
#pragma unroll
            for (int dt = 0; dt < 8; ++dt) { const LAS unsigned char* vr = LV + (16 * dt + r16) * 512;
                const u32x2 lo = *(const LAS u32x2*)(vr + (((8 * ks + g) ^ (2 * r16)) * 8)), hi = *(const LAS u32x2*)(vr + (((8 * ks + 4 + g) ^ (2 * r16)) * 8));
                u32x4 vw; vw.x = lo.x; vw.y = lo.y; vw.z = hi.x; vw.w = hi.y;
                oacc[dt] = __builtin_amdgcn_mfma_f32_16x16x32_bf16(pa, __builtin_bit_cast(bf16x8, vw), oacc[dt], 0, 0, 0); } }
        float inv[4];
#pragma unroll
        for (int j = 0; j < 4; ++j) inv[j] = 1.0f / shl(sum, 4 * g + j);
#pragma unroll
        for (int dt = 0; dt < 8; ++dt)
#pragma unroll
            for (int j = 0; j < 4; ++j) mix[(size_t)(m0 + 4 * g + j) * D + SW + hm * 128 + 16 * dt + r16] = f2bf(oacc[dt][j] * inv[j]);
    }
    __syncthreads();
}

__device__ __forceinline__ void ph_rwkv_prep1(const Ctx& C, const float* mu, bool with_v) {
    unsigned char* ws = C.ws;
    const bf16* P = (const bf16*)(ws + WS_P); bf16* AL = (bf16*)(ws + WS_ALORA);
    const int oc0 = 8 * C.lane;
    const int XW0 = 4608, XA0 = 4704, XV0 = 4800, XG0 = with_v ? 4864 : 4800;
    int src, mode;
    if (oc0 < 96) { src = XW0 + oc0; mode = 0; } else if (oc0 < 192) { src = XA0 + oc0 - 96; mode = 1; }
    else if (oc0 < 256) { src = XV0 + oc0 - 192; mode = with_v ? 1 : 2; } else { src = XG0 + oc0 - 256; mode = 3; }
    f32x4 mu0 = (f32x4){0.f, 0.f, 0.f, 0.f}, mu1 = mu0;
    if (mode != 2) { mu0 = *(const f32x4*)(mu + src); mu1 = *(const f32x4*)(mu + src + 4); }
    for (int mb = C.gw; mb < M; mb += 4 * C.NGW) {
        u32x4 cu4[4], pr4[4];
#pragma unroll
        for (int i = 0; i < 4; ++i) { const int m = mb + i * C.NGW; cu4[i] = (u32x4){0u, 0u, 0u, 0u}; pr4[i] = cu4[i];
            if (mode != 2) { cu4[i] = *(const u32x4*)(P + (size_t)m * LDP_RW + src);
                if ((m & (SEQ - 1)) != 0) pr4[i] = *(const u32x4*)(P + (size_t)(m - 1) * LDP_RW + src); } }
#pragma unroll
        for (int i = 0; i < 4; ++i) { const int m = mb + i * C.NGW; const u32x4 cu = cu4[i], pr = pr4[i];
            u32x4 o = (u32x4){0u, 0u, 0u, 0u};
            if (mode != 2) {
                float v[8];
#pragma unroll
                for (int q = 0; q < 4; ++q) { const float c0 = bflo(cu[q]), c1 = bfhi(cu[q]), p0 = bflo(pr[q]), p1 = bfhi(pr[q]);
                    const float m0 = q < 2 ? mu0[2 * q] : mu1[2 * q - 4], m1 = q < 2 ? mu0[2 * q + 1] : mu1[2 * q - 3];
                    v[2 * q] = c0 + m0 * (p0 - c0); v[2 * q + 1] = c1 + m1 * (p1 - c1); }
#pragma unroll
                for (int q = 0; q < 8; ++q) { if (mode == 0) v[q] = 1.0f - 2.0f * __builtin_amdgcn_rcpf(1.0f + __expf(2.0f * v[q])); else if (mode == 3) v[q] = sigmoidf_(v[q]); }
                o.x = cvt_pk_bf16(v[0], v[1]); o.y = cvt_pk_bf16(v[2], v[3]); o.z = cvt_pk_bf16(v[4], v[5]); o.w = cvt_pk_bf16(v[6], v[7]);
            }
            *(u32x4*)(AL + (size_t)m * 512 + oc0) = o; }
    }
}
__device__ __forceinline__ void ph_rwkv_prep2(const Ctx& C, const float* mu, const float* vecs, bool with_v) {
    unsigned char* ws = C.ws;
    const bf16* P = (const bf16*)(ws + WS_P); const bf16* LO = (const bf16*)(ws + WS_LORAOUT); bf16* VF = (bf16*)(ws + WS_VFIRST);
    unsigned char* SI = ws + WS_SCANIN; float* BON = (float*)(ws + WS_BONUS);
    const float* k_k = vecs + (with_v ? 3 : 2) * SW; const float* k_a = k_k + SW; const float* r_k = k_a + SW;
    const int hq = C.lane >> 4, cl = (C.lane & 15) * 4;
    for (int m = C.gw; m < M; m += C.NGW) {
        const int t = m & (SEQ - 1), b = m >> 11; const bool hp = t != 0;
        const bf16* pc = P + (size_t)m * LDP_RW; const bf16* pp = pc - LDP_RW;
#pragma unroll 2
        for (int it = 0; it < 6; ++it) {
            const int c = it * 256 + 4 * C.lane, head = 4 * it + hq;
            const u32x2 rc = *(const u32x2*)(pc + c), kc = *(const u32x2*)(pc + SW + c), vc = *(const u32x2*)(pc + 2 * SW + c);
            u32x2 rp = (u32x2){0u, 0u}, kp_ = rp, vp = rp;
            if (hp) { rp = *(const u32x2*)(pp + c); kp_ = *(const u32x2*)(pp + SW + c); vp = *(const u32x2*)(pp + 2 * SW + c); }
            const u32x2 Ew = *(const u32x2*)(LO + (size_t)m * 6144 + c), aw = *(const u32x2*)(LO + (size_t)m * 6144 + SW + c);
            u32x2 svw = (u32x2){0u, 0u}, vfw = svw;
            if (with_v) { svw = *(const u32x2*)(LO + (size_t)m * 6144 + 2 * SW + c); vfw = *(const u32x2*)(VF + (size_t)m * SW + c); }
            const f32x4 mr = *(const f32x4*)(mu + c), mk = *(const f32x4*)(mu + SW + c), mv = *(const f32x4*)(mu + 2 * SW + c);
            const f32x4 kk4 = *(const f32x4*)(k_k + c), ka4 = *(const f32x4*)(k_a + c), rk4 = *(const f32x4*)(r_k + c);
            float rm[4], km[4], vm[4], E[4], a[4], sv[4], vf[4];
#define UNPK(dst, w) dst[0] = bflo(w.x); dst[1] = bfhi(w.x); dst[2] = bflo(w.y); dst[3] = bfhi(w.y)
            float t0[4], t1[4];
            UNPK(t0, rc); UNPK(t1, rp);
#pragma unroll
            for (int j = 0; j < 4; ++j) rm[j] = t0[j] + mr[j] * (t1[j] - t0[j]);
            UNPK(t0, kc); UNPK(t1, kp_);
#pragma unroll
            for (int j = 0; j < 4; ++j) km[j] = t0[j] + mk[j] * (t1[j] - t0[j]);
            UNPK(t0, vc); UNPK(t1, vp);
#pragma unroll
            for (int j = 0; j < 4; ++j) vm[j] = t0[j] + mv[j] * (t1[j] - t0[j]);
            UNPK(E, Ew); UNPK(a, aw); UNPK(sv, svw); UNPK(vf, vfw);
#undef UNPK
            float vv[4], kkr[4], kp[4], ss = 0.f, bs = 0.f;
#pragma unroll
            for (int j = 0; j < 4; ++j) {
                vv[j] = with_v ? vm[j] + (vf[j] - vm[j]) * sv[j] : vm[j];
                kkr[j] = km[j] * kk4[j]; ss += kkr[j] * kkr[j];
                kp[j] = km[j] * (1.0f + (a[j] - 1.0f) * ka4[j]);
                bs += rm[j] * kp[j] * rk4[j]; }
            ss = row16_sum(ss); bs = row16_sum(bs);
            const float inv = 1.0f / fmaxf(sqrtf(ss), 1e-12f);
            if (!with_v) { u32x2 w; w.x = cvt_pk_bf16(vm[0], vm[1]); w.y = cvt_pk_bf16(vm[2], vm[3]); *(u32x2*)(VF + (size_t)m * SW + c) = w; }
            unsigned char* rec = SI + ((size_t)(b * 24 + head) * SEQ + t) * 768;
            float uw[4], kk[4];
#pragma unroll
            for (int j = 0; j < 4; ++j) { uw[j] = 1.0f - __expf(-E[j]); kk[j] = kkr[j] * inv; }
            u32x2 o;
            { const h16x2 u01 = __builtin_convertvector((f32x2){uw[0], uw[1]}, h16x2), u23 = __builtin_convertvector((f32x2){uw[2], uw[3]}, h16x2);
              o.x = __builtin_bit_cast(unsigned, u01); o.y = __builtin_bit_cast(unsigned, u23); *(u32x2*)(rec + cl * 2) = o; }
            o.x = cvt_pk_bf16(-kk[0], -kk[1]); o.y = cvt_pk_bf16(-kk[2], -kk[3]); *(u32x2*)(rec + 128 + cl * 2) = o;
            o.x = cvt_pk_bf16(kk[0] * a[0], kk[1] * a[1]); o.y = cvt_pk_bf16(kk[2] * a[2], kk[3] * a[3]); *(u32x2*)(rec + 256 + cl * 2) = o;
            o.x = cvt_pk_bf16(kp[0], kp[1]); o.y = cvt_pk_bf16(kp[2], kp[3]); *(u32x2*)(rec + 384 + cl * 2) = o;
            o.x = cvt_pk_bf16(rm[0], rm[1]); o.y = cvt_pk_bf16(rm[2], rm[3]); *(u32x2*)(rec + 512 + cl * 2) = o;
            o.x = cvt_pk_bf16(vv[0], vv[1]); o.y = cvt_pk_bf16(vv[2], vv[3]); *(u32x2*)(rec + 640 + cl * 2) = o;
            if ((C.lane & 15) == 0) BON[m * 24 + head] = bs;
        }
    }
}
__device__ __forceinline__ float fma_(float a, float b, float c) { float d; asm("v_fma_f32 %0, %1, %2, %3" : "=v"(d) : "v"(a), "v"(b), "v"(c)); return d; }
__device__ __forceinline__ float mul_(float a, float b) { float d; asm("v_mul_f32 %0, %1, %2" : "=v"(d) : "v"(a), "v"(b)); return d; }
__device__ __forceinline__ void ph_rwkv_scan(const Ctx& C, const float* mg, const float* mu, const float* md, const float* vecs, bool with_v, const float* const* in, int lq) {
    if (C.bid >= 192) { ph_moe_wconv(C, mg, mu, md, in, lq); return; }
    unsigned char* ws = C.ws;
    const unsigned char* SI = ws + WS_SCANIN;
    constexpr int TC = 16, NCH = SEQ / TC, REC = 7 * 64;
    LAS float* buf = (LAS float*)C.lds;
    LAS float* ybuf = (LAS float*)(C.lds + 114688);
    const bool scanner = C.wave < 4;
    const int slot = (C.wave >> 1) & 1;
    const int rg = C.lane >> 3, cg = C.lane & 7;
    const int rbase = 32 * (C.wave & 1) + 4 * rg;
    if (!scanner) {
        const int lw = C.wave - 4, qd = C.lane;
        const int q2 = qd - 8, lvec = 1 + (q2 >> 3), lpart = q2 & 7;
        const float* BON = (const float*)(ws + WS_BONUS); bf16* mix = (bf16*)(ws + WS_MIX); const bf16* LO = (const bf16*)(ws + WS_LORAOUT);
        const float* gn_g = vecs + (with_v ? 6 : 5) * SW; const float* gn_b = gn_g + SW;
        const int p0 = C.bid * 2, b0 = p0 / 24, h0 = p0 % 24, b1 = (p0 + 1) / 24, h1 = (p0 + 1) % 24;
        const int pr = C.lane >> 4, pc4 = 4 * (C.lane & 15);
        const f32x4 gg0 = *(const f32x4*)(gn_g + h0 * 64 + pc4), gb0 = *(const f32x4*)(gn_b + h0 * 64 + pc4), gg1 = *(const f32x4*)(gn_g + h1 * 64 + pc4), gb1 = *(const f32x4*)(gn_b + h1 * 64 + pc4);
        u32x4 st[8];
#define SCAN_ISSUE(ch_) do { _Pragma("unroll") for (int i_ = 0; i_ < 8; ++i_) { const int ps = lw + 4 * i_; \
        const int sl_ = ps >> 4, t_ = (ch_) * TC + (ps & 15); \
        st[i_] = qd < 48 ? *(const u32x4*)(SI + ((size_t)(p0 + sl_) * SEQ + t_) * 768 + qd * 16) \
                         : *(const u32x4*)(LO + (size_t)((sl_ ? b1 : b0) * SEQ + t_) * 6144 + 3 * SW + (sl_ ? h1 : h0) * 64 + ((qd - 48) & 7) * 8); } } while (0)
#define SCAN_COMMIT(bsel_) do { _Pragma("unroll") for (int i_ = 0; i_ < 8; ++i_) { const int ps = lw + 4 * i_; \
        LAS float* dst = buf + (((bsel_) * 2 * TC) + ps) * REC; \
        if (qd < 8) { f32x4 a_, b_; const unsigned sx_ = st[i_].x, sy_ = st[i_].y, sz_ = st[i_].z, sw_ = st[i_].w;     \
            { const f32x2 t0_ = __builtin_convertvector(__builtin_bit_cast(h16x2, sx_), f32x2), t1_ = __builtin_convertvector(__builtin_bit_cast(h16x2, sy_), f32x2); \
              a_[0] = 1.0f - t0_[0]; a_[1] = 1.0f - t0_[1]; a_[2] = 1.0f - t1_[0]; a_[3] = 1.0f - t1_[1]; } \
            { const f32x2 t0_ = __builtin_convertvector(__builtin_bit_cast(h16x2, sz_), f32x2), t1_ = __builtin_convertvector(__builtin_bit_cast(h16x2, sw_), f32x2); \
              b_[0] = 1.0f - t0_[0]; b_[1] = 1.0f - t0_[1]; b_[2] = 1.0f - t1_[0]; b_[3] = 1.0f - t1_[1]; } \
            *(LAS f32x4*)(dst + 8 * qd) = a_; *(LAS f32x4*)(dst + 8 * qd + 4) = b_; } \
        else if (qd < 56) { LAS float* d2 = dst + lvec * 64 + lpart * 8; \
            f32x4 a_, b_; a_[0] = bflo(st[i_].x); a_[1] = bfhi(st[i_].x); a_[2] = bflo(st[i_].y); a_[3] = bfhi(st[i_].y); \
            b_[0] = bflo(st[i_].z); b_[1] = bfhi(st[i_].z); b_[2] = bflo(st[i_].w); b_[3] = bfhi(st[i_].w); \
            *(LAS f32x4*)d2 = a_; *(LAS f32x4*)(d2 + 4) = b_; } } } while (0)
#define SCAN_POST(cp_) do { _Pragma("unroll") for (int g_ = 0; g_ < 2; ++g_) { const int ps = lw + 4 * (4 * g_ + pr), sl = ps >> 4, stp = ps & 15; \
        const LAS float* rec = buf + ((((cp_) & 1) * 2 * TC) + ps) * REC; \
        const f32x4 yv = *(const LAS f32x4*)(ybuf + ((((cp_) & 1) * 2 + sl) * TC + stp) * 64 + pc4), vv = *(const LAS f32x4*)(rec + 5 * 64 + pc4), gq = *(const LAS f32x4*)(rec + 6 * 64 + pc4); \
        const int m = (sl ? b1 : b0) * SEQ + (cp_) * TC + stp, hh = sl ? h1 : h0; \
        const float bon = BON[m * 24 + hh]; \
        const float mean = row16_sum((yv[0] + yv[1]) + (yv[2] + yv[3])) * (1.f / 64.f); const f32x4 d = yv - mean; \
        const float var = row16_sum((d[0] * d[0] + d[1] * d[1]) + (d[2] * d[2] + d[3] * d[3])) * (1.f / 64.f); \
        const float rstd = 1.0f / sqrtf(var + 64e-5f); const f32x4 gg = sl ? gg1 : gg0, gb = sl ? gb1 : gb0; \
        const f32x4 o_ = (d * rstd * gg + gb + vv * bon) * gq; \
        u32x2 w_; w_.x = cvt_pk_bf16(o_[0], o_[1]); w_.y = cvt_pk_bf16(o_[2], o_[3]); \
        *(u32x2*)(mix + (size_t)m * D + hh * 64 + pc4) = w_; } } while (0)
        SCAN_ISSUE(0); SCAN_COMMIT(0);
        __syncthreads();
        for (int ch = 0; ch < NCH; ++ch) {
            if (ch + 1 < NCH) SCAN_ISSUE(ch + 1);
            if (ch > 0) SCAN_POST(ch - 1);
            if (ch + 1 < NCH) SCAN_COMMIT((ch & 1) ^ 1);
            __syncthreads();
        }
        SCAN_POST(NCH - 1);
#undef SCAN_ISSUE
#undef SCAN_COMMIT
#undef SCAN_POST
    } else {
        f32x2 S[4][4];
#pragma unroll
        for (int i = 0; i < 4; ++i)
#pragma unroll
            for (int c = 0; c < 4; ++c) S[i][c] = (f32x2){0.f, 0.f};
        __syncthreads();
        for (int ch = 0; ch < NCH; ++ch) {
            const LAS float* base = buf + (((ch & 1) * 2 + slot) * TC) * REC;
            LAS float* yb = ybuf + (((ch & 1) * 2 + slot) * TC) * 64 + rbase;
#pragma unroll 2
            for (int s = 0; s < TC; ++s) {
                const LAS float* rp = base + s * REC + 8 * cg;
                f32x2 wv[4], nv[4], bv[4], kv[4], rv[4];
                { const f32x4 x0 = *(const LAS f32x4*)(rp), x1 = *(const LAS f32x4*)(rp + 4); wv[0] = (f32x2){x0[0], x0[1]}; wv[1] = (f32x2){x0[2], x0[3]}; wv[2] = (f32x2){x1[0], x1[1]}; wv[3] = (f32x2){x1[2], x1[3]}; }
                { const f32x4 x0 = *(const LAS f32x4*)(rp + 64), x1 = *(const LAS f32x4*)(rp + 68); nv[0] = (f32x2){x0[0], x0[1]}; nv[1] = (f32x2){x0[2], x0[3]}; nv[2] = (f32x2){x1[0], x1[1]}; nv[3] = (f32x2){x1[2], x1[3]}; }
                { const f32x4 x0 = *(const LAS f32x4*)(rp + 128), x1 = *(const LAS f32x4*)(rp + 132); bv[0] = (f32x2){x0[0], x0[1]}; bv[1] = (f32x2){x0[2], x0[3]}; bv[2] = (f32x2){x1[0], x1[1]}; bv[3] = (f32x2){x1[2], x1[3]}; }
                { const f32x4 x0 = *(const LAS f32x4*)(rp + 192), x1 = *(const LAS f32x4*)(rp + 196); kv[0] = (f32x2){x0[0], x0[1]}; kv[1] = (f32x2){x0[2], x0[3]}; kv[2] = (f32x2){x1[0], x1[1]}; kv[3] = (f32x2){x1[2], x1[3]}; }
                { const f32x4 x0 = *(const LAS f32x4*)(rp + 256), x1 = *(const LAS f32x4*)(rp + 260); rv[0] = (f32x2){x0[0], x0[1]}; rv[1] = (f32x2){x0[2], x0[3]}; rv[2] = (f32x2){x1[0], x1[1]}; rv[3] = (f32x2){x1[2], x1[3]}; }
                const f32x4 vv = *(const LAS f32x4*)(base + s * REC + 320 + rbase);
                f32x4 yo;
#pragma unroll
                for (int i = 0; i < 4; ++i) {
                    f32x2 a2 = S[i][0] * nv[0];
#pragma unroll
                    for (int c = 1; c < 4; ++c) a2 = S[i][c] * nv[c] + a2;
                    float sa = a2[0] + a2[1];
                    sa = dpp_add<0xB1>(sa); sa = dpp_add<0x4E>(sa); sa = dpp_add<0x141>(sa);
                    const f32x2 sa2 = (f32x2){sa, sa}, v2 = (f32x2){vv[i], vv[i]};
                    f32x2 y2 = (f32x2){0.f, 0.f};
#pragma unroll
                    for (int c = 0; c < 4; ++c) { S[i][c] = S[i][c] * wv[c] + (sa2 * bv[c] + v2 * kv[c]); y2 = S[i][c] * rv[c] + y2; }
                    float y = y2[0] + y2[1];
                    y = dpp_add<0xB1>(y); y = dpp_add<0x4E>(y); y = dpp_add<0x141>(y);
                    yo[i] = y;
                }
                if (cg == 0) *(LAS f32x4*)(yb + s * 64) = yo;
            }
            __syncthreads();
        }
    }
}

__device__ __constant__ float RET_LG2[6] = {-0.04580368961312479f, -0.02272007650008353f, -0.011315313227834146f, -0.005646563141142063f, -0.0028205190623786626f, -0.0014095702546713536f};
__device__ __forceinline__ void ph_ret_prep(const Ctx& C) {
    unsigned char* ws = C.ws;
    const bf16* P = (const bf16*)(ws + WS_P); const f32x2* CS = (const f32x2*)(ws + WS_CS);
    bf16* QR = (bf16*)(ws + WS_QR); bf16* KR = (bf16*)(ws + WS_KR); bf16* VT = (bf16*)(ws + WS_VT); bf16* KVT = (bf16*)(ws + WS_KVT);
    LAS unsigned char* LKt = C.lds; LAS unsigned char* LV = C.lds + 32768;
    const int g = C.lane >> 4, r16 = C.lane & 15, w = C.wave;
    __syncthreads();
    for (int u = C.bid; u < 1536; u += C.G) {
        const int c = u & 15, bh = u >> 4, h = bh % 6, b = bh / 6, m0 = b * SEQ + c * 128;
        const float lg2 = RET_LG2[h];
        __syncthreads();
        for (int task = C.tid; task < 1536; task += NTHR) {
            if (task < 512) {
                const bool isk = task >= 256; const int tk = task & 255, i0 = 4 * (tk & 15), tg = tk >> 4;
                const int colb = (isk ? 768 : 0) + h * 128 + i0; const float scl = isk ? 0.08838834764831845f : 1.0f;
                bf16* N = isk ? KR : QR;
                float o1[4][8], o2[4][8];
#pragma unroll
                for (int j = 0; j < 8; ++j) { const int m = m0 + tg * 8 + j;
                    const u32x2 a = *(const u32x2*)(P + (size_t)m * LDP_RET + colb), b2 = *(const u32x2*)(P + (size_t)m * LDP_RET + colb + 64);
                    const f32x4 cs01 = *(const f32x4*)(CS + (size_t)m * 64 + i0), cs23 = *(const f32x4*)(CS + (size_t)m * 64 + i0 + 2);
                    const float x1[4] = {bflo(a.x), bfhi(a.x), bflo(a.y), bfhi(a.y)}, x2[4] = {bflo(b2.x), bfhi(b2.x), bflo(b2.y), bfhi(b2.y)};
                    const float cc[4] = {cs01[0], cs01[2], cs23[0], cs23[2]}, sn[4] = {cs01[1], cs01[3], cs23[1], cs23[3]};
#pragma unroll
                    for (int q = 0; q < 4; ++q) { o1[q][j] = (x1[q] * cc[q] - x2[q] * sn[q]) * scl; o2[q][j] = (x1[q] * sn[q] + x2[q] * cc[q]) * scl; }
                    u32x2 w1, w2; w1.x = cvt_pk_bf16(o1[0][j], o1[1][j]); w1.y = cvt_pk_bf16(o1[2][j], o1[3][j]); w2.x = cvt_pk_bf16(o2[0][j], o2[1][j]); w2.y = cvt_pk_bf16(o2[2][j], o2[3][j]);
                    *(u32x2*)(N + (size_t)m * 768 + h * 128 + i0) = w1; *(u32x2*)(N + (size_t)m * 768 + h * 128 + i0 + 64) = w2; }
                if (isk) {
                    float kd[8];
#pragma unroll
                    for (int j = 0; j < 8; ++j) kd[j] = exp2f((float)(127 - (tg * 8 + j)) * lg2);
#pragma unroll
                    for (int q = 0; q < 4; ++q) {
                        u32x4 w1, w2;
                        w1.x = cvt_pk_bf16(o1[q][0] * kd[0], o1[q][1] * kd[1]); w1.y = cvt_pk_bf16(o1[q][2] * kd[2], o1[q][3] * kd[3]); w1.z = cvt_pk_bf16(o1[q][4] * kd[4], o1[q][5] * kd[5]); w1.w = cvt_pk_bf16(o1[q][6] * kd[6], o1[q][7] * kd[7]);
                        w2.x = cvt_pk_bf16(o2[q][0] * kd[0], o2[q][1] * kd[1]); w2.y = cvt_pk_bf16(o2[q][2] * kd[2], o2[q][3] * kd[3]); w2.z = cvt_pk_bf16(o2[q][4] * kd[4], o2[q][5] * kd[5]); w2.w = cvt_pk_bf16(o2[q][6] * kd[6], o2[q][7] * kd[7]);
                        *(LAS u32x4*)(LKt + (i0 + q) * 256 + ((tg ^ ((i0 + q) & 15)) * 16)) = w1;
                        *(LAS u32x4*)(LKt + (i0 + q + 64) * 256 + ((tg ^ ((i0 + q + 64) & 15)) * 16)) = w2; }
                }
            } else {
                const int tv = task - 512, e0 = 4 * (tv & 63), tg = tv >> 6;
                u32x2 vin[8];
#pragma unroll
                for (int j = 0; j < 8; ++j) vin[j] = *(const u32x2*)(P + (size_t)(m0 + tg * 8 + j) * LDP_RET + 1536 + h * 256 + e0);
                u32x4 w0, w1, w2, w3;
#define PKLO(a_, b_) (((a_) & 0xffffu) | ((b_) << 16))
#define PKHI(a_, b_) (((a_) >> 16) | ((b_) & 0xffff0000u))
                w0.x = PKLO(vin[0].x, vin[1].x); w0.y = PKLO(vin[2].x, vin[3].x); w0.z = PKLO(vin[4].x, vin[5].x); w0.w = PKLO(vin[6].x, vin[7].x);
                w1.x = PKHI(vin[0].x, vin[1].x); w1.y = PKHI(vin[2].x, vin[3].x); w1.z = PKHI(vin[4].x, vin[5].x); w1.w = PKHI(vin[6].x, vin[7].x);
                w2.x = PKLO(vin[0].y, vin[1].y); w2.y = PKLO(vin[2].y, vin[3].y); w2.z = PKLO(vin[4].y, vin[5].y); w2.w = PKLO(vin[6].y, vin[7].y);
                w3.x = PKHI(vin[0].y, vin[1].y); w3.y = PKHI(vin[2].y, vin[3].y); w3.z = PKHI(vin[4].y, vin[5].y); w3.w = PKHI(vin[6].y, vin[7].y);
#undef PKLO
#undef PKHI
                *(LAS u32x4*)(LV + (e0 + 0) * 256 + ((tg ^ ((e0 + 0) & 15)) * 16)) = w0; *(LAS u32x4*)(LV + (e0 + 1) * 256 + ((tg ^ ((e0 + 1) & 15)) * 16)) = w1;
                *(LAS u32x4*)(LV + (e0 + 2) * 256 + ((tg ^ ((e0 + 2) & 15)) * 16)) = w2; *(LAS u32x4*)(LV + (e0 + 3) * 256 + ((tg ^ ((e0 + 3) & 15)) * 16)) = w3;
            }
        }
        __syncthreads();
        {   f32x4 acc[16];
#pragma unroll
            for (int et = 0; et < 16; ++et) acc[et] = (f32x4){0.f, 0.f, 0.f, 0.f};
#pragma unroll
            for (int ks = 0; ks < 4; ++ks) {
                const bf16x8 af = *(const LAS bf16x8*)(LKt + (16 * w + r16) * 256 + (((4 * ks + g) ^ r16) * 16));
#pragma unroll
                for (int et = 0; et < 16; ++et) { const bf16x8 bf = *(const LAS bf16x8*)(LV + (16 * et + r16) * 256 + (((4 * ks + g) ^ r16) * 16));
                    acc[et] = __builtin_amdgcn_mfma_f32_16x16x32_bf16(af, bf, acc[et], 0, 0, 0); } }
#pragma unroll
            for (int et = 0; et < 16; ++et) { u32x2 wv; wv.x = cvt_pk_bf16(acc[et][0], acc[et][1]); wv.y = cvt_pk_bf16(acc[et][2], acc[et][3]); *(u32x2*)(KVT + ((size_t)u * 256 + 16 * et + r16) * 128 + 16 * w + 4 * g) = wv; }
        }
    }
    __syncthreads();
}
__device__ __forceinline__ void ph_ret_kv(const Ctx& C) {
    unsigned char* ws = C.ws;
    const bf16* KDT = (const bf16*)(ws + WS_KDT); const bf16* VT = (const bf16*)(ws + WS_VT); bf16* KVT = (bf16*)(ws + WS_KVT);
    const int g = C.lane >> 4, r16 = C.lane & 15, w = C.wave;
    LAS unsigned char* LKt = C.lds; LAS unsigned char* LV = C.lds + 32768;
    u32x4 st[12];
#define KV_ISSUE(u_) do { const int c_ = (u_) & 15, bh_ = (u_) >> 4; \
        _Pragma("unroll") for (int i = 0; i < 4; ++i) { const int q = C.tid + 512 * i, row = q >> 4, pc = q & 15; st[i] = *(const u32x4*)(KDT + (size_t)(bh_ * 128 + row) * SEQ + c_ * 128 + pc * 8); } \
        _Pragma("unroll") for (int i = 0; i < 8; ++i) { const int q = C.tid + 512 * i, row = q >> 4, pc = q & 15; st[4 + i] = *(const u32x4*)(VT + (size_t)(bh_ * 256 + row) * SEQ + c_ * 128 + pc * 8); } } while (0)
#define KV_COMMIT() do { \
        _Pragma("unroll") for (int i = 0; i < 4; ++i) { const int q = C.tid + 512 * i, row = q >> 4, pc = q & 15; *(LAS u32x4*)(LKt + row * 256 + ((pc ^ (row & 15)) * 16)) = st[i]; } \
        _Pragma("unroll") for (int i = 0; i < 8; ++i) { const int q = C.tid + 512 * i, row = q >> 4, pc = q & 15; *(LAS u32x4*)(LV + row * 256 + ((pc ^ (row & 15)) * 16)) = st[4 + i]; } } while (0)
    __syncthreads();
    if (C.bid < 1536) KV_ISSUE(C.bid);
    for (int u = C.bid; u < 1536; u += C.G) {
        __syncthreads();
        KV_COMMIT();
        if (u + C.G < 1536) KV_ISSUE(u + C.G);
        __syncthreads();
        f32x4 acc[16];
#pragma unroll
        for (int et = 0; et < 16; ++et) acc[et] = (f32x4){0.f, 0.f, 0.f, 0.f};
#pragma unroll
        for (int ks = 0; ks < 4; ++ks) {
            const bf16x8 af = *(const LAS bf16x8*)(LKt + (16 * w + r16) * 256 + (((4 * ks + g) ^ r16) * 16));
#pragma unroll
            for (int et = 0; et < 16; ++et) { const bf16x8 bf = *(const LAS bf16x8*)(LV + (16 * et + r16) * 256 + (((4 * ks + g) ^ r16) * 16));
                acc[et] = __builtin_amdgcn_mfma_f32_16x16x32_bf16(af, bf, acc[et], 0, 0, 0); } }
#pragma unroll
        for (int et = 0; et < 16; ++et) { u32x2 wv; wv.x = cvt_pk_bf16(acc[et][0], acc[et][1]); wv.y = cvt_pk_bf16(acc[et][2], acc[et][3]); *(u32x2*)(KVT + ((size_t)u * 256 + 16 * et + r16) * 128 + 16 * w + 4 * g) = wv; }
    }
    __syncthreads();
#undef KV_ISSUE
#undef KV_COMMIT
}
__device__ __forceinline__ void ph_ret_prefix(const Ctx& C) {
    unsigned char* ws = C.ws;
    const bf16* KVT = (const bf16*)(ws + WS_KVT); bf16* RTB = (bf16*)(ws + WS_RTB);
    for (int idx = C.bid * NTHR + C.tid; idx < 96 * 8192; idx += C.G * NTHR) {
        const int bh = idx >> 13, rem = idx & 8191; const int h = bh % 6;
        const float cd = exp2f(128.0f * RET_LG2[h]);
        f32x4 r = (f32x4){0.f, 0.f, 0.f, 0.f};
        u32x2 kwv[15];
#pragma unroll
        for (int c = 0; c < 15; ++c) kwv[c] = *(const u32x2*)(KVT + ((size_t)(bh * 16 + c) * 8192 + rem) * 4);
#pragma unroll
        for (int c = 0; c < 16; ++c) { const size_t off = ((size_t)(bh * 16 + c) * 8192 + rem) * 4;
            u32x2 w; w.x = cvt_pk_bf16(r[0], r[1]); w.y = cvt_pk_bf16(r[2], r[3]); *(u32x2*)(RTB + off) = w;
            if (c < 15) { const u32x2 kw = kwv[c]; const f32x4 kv = (f32x4){bflo(kw.x), bfhi(kw.x), bflo(kw.y), bfhi(kw.y)}; r = r * cd + kv; } }
    }
}
#define LDS_BAR() asm volatile("s_waitcnt lgkmcnt(0)\n\ts_barrier" ::: "memory")
__device__ __forceinline__ void ret_v_lds(const u32x2 (&vin)[8], LAS unsigned char* LV, int e0, int tg) {
    u32x4 w0, w1, w2, w3;
#define PKLO(a_, b_) (((a_) & 0xffffu) | ((b_) << 16))
#define PKHI(a_, b_) (((a_) >> 16) | ((b_) & 0xffff0000u))
    w0.x = PKLO(vin[0].x, vin[1].x); w0.y = PKLO(vin[2].x, vin[3].x); w0.z = PKLO(vin[4].x, vin[5].x); w0.w = PKLO(vin[6].x, vin[7].x);
    w1.x = PKHI(vin[0].x, vin[1].x); w1.y = PKHI(vin[2].x, vin[3].x); w1.z = PKHI(vin[4].x, vin[5].x); w1.w = PKHI(vin[6].x, vin[7].x);
    w2.x = PKLO(vin[0].y, vin[1].y); w2.y = PKLO(vin[2].y, vin[3].y); w2.z = PKLO(vin[4].y, vin[5].y); w2.w = PKLO(vin[6].y, vin[7].y);
    w3.x = PKHI(vin[0].y, vin[1].y); w3.y = PKHI(vin[2].y, vin[3].y); w3.z = PKHI(vin[4].y, vin[5].y); w3.w = PKHI(vin[6].y, vin[7].y);
#undef PKLO
#undef PKHI
    *(LAS u32x4*)(LV + (e0 + 0) * 256 + ((tg ^ ((e0 + 0) & 15)) * 16)) = w0; *(LAS u32x4*)(LV + (e0 + 1) * 256 + ((tg ^ ((e0 + 1) & 15)) * 16)) = w1;
    *(LAS u32x4*)(LV + (e0 + 2) * 256 + ((tg ^ ((e0 + 2) & 15)) * 16)) = w2; *(LAS u32x4*)(LV + (e0 + 3) * 256 + ((tg ^ ((e0 + 3) & 15)) * 16)) = w3;
}
__device__ __forceinline__ void ph_ret_out(const Ctx& C, const float* gn) {
    unsigned char* ws = C.ws;
    const bf16* P = (const bf16*)(ws + WS_P); const bf16* QR = (const bf16*)(ws + WS_QR); const bf16* KR = (const bf16*)(ws + WS_KR);
    const bf16* VT = (const bf16*)(ws + WS_VT); const bf16* RTB = (const bf16*)(ws + WS_RTB); bf16* mix = (bf16*)(ws + WS_MIX);
    const int g = C.lane >> 4, r16 = C.lane & 15, w = C.wave;
    LAS unsigned char* LR = C.lds; LAS unsigned char* LV = C.lds + 65536;
    for (int u = C.bid; u < 1536; u += C.G) {
        const int c = u & 15, bh = u >> 4, h = bh % 6, b = bh / 6, m0 = b * SEQ + c * 128;
        const float lg2 = RET_LG2[h];
        LDS_BAR();
        const int nl = 16 * w + r16;
        u32x4 kst[4];
        bf16x8 qf[4];
        u32x2 gwv[16];
        {   u32x4 st[8]; u32x2 vinA[8], vinB[8];
            const int e0v = 4 * (C.tid & 63), tgv = C.tid >> 6;
#pragma unroll
            for (int i = 0; i < 8; ++i) { const int q = C.tid + 512 * i, row = q >> 4, pc = q & 15;
                st[i] = *(const u32x4*)(RTB + ((size_t)u * 256 + row) * 128 + pc * 8); }
#pragma unroll
            for (int j = 0; j < 8; ++j) { vinA[j] = *(const u32x2*)(P + (size_t)(m0 + tgv * 8 + j) * LDP_RET + 1536 + h * 256 + e0v);
                vinB[j] = *(const u32x2*)(P + (size_t)(m0 + tgv * 8 + 64 + j) * LDP_RET + 1536 + h * 256 + e0v); }
#pragma unroll
            for (int s = 0; s < 4; ++s) qf[s] = *(const bf16x8*)(QR + (size_t)(m0 + nl) * 768 + h * 128 + 32 * s + 8 * g);
#pragma unroll
            for (int i = 0; i < 8; ++i) { const int q = C.tid + 512 * i, row = q >> 4, pc = q & 15; const int off = row * 256 + ((pc ^ (row & 15)) * 16);
                *(LAS u32x4*)(LR + off) = st[i]; }
            ret_v_lds(vinA, LV, e0v, tgv); ret_v_lds(vinB, LV, e0v, tgv + 8);
        }
#pragma unroll
        for (int i = 0; i < 4; ++i) { const int q = C.tid + 512 * i, row = q >> 4, pc = q & 15;
            kst[i] = *(const u32x4*)(KR + (size_t)(m0 + row) * 768 + h * 128 + pc * 8); }
        LDS_BAR();
        f32x4 o[16];
        const float qdec = exp2f((float)(nl + 1) * lg2);
#pragma unroll
        for (int et = 0; et < 16; ++et) { f32x4 a = (f32x4){0.f, 0.f, 0.f, 0.f};
#pragma unroll
            for (int s = 0; s < 4; ++s) { const bf16x8 rf = *(const LAS bf16x8*)(LR + (16 * et + r16) * 256 + (((4 * s + g) ^ r16) * 16));
                a = __builtin_amdgcn_mfma_f32_16x16x32_bf16(rf, qf[s], a, 0, 0, 0); }
            o[et] = a * qdec;
            if ((et & 3) == 3) __builtin_amdgcn_sched_barrier(0); }
        LDS_BAR();
#pragma unroll
        for (int i = 0; i < 4; ++i) { const int q = C.tid + 512 * i, row = q >> 4, pc = q & 15; *(LAS u32x4*)(LR + row * 256 + ((pc ^ (row & 15)) * 16)) = kst[i]; }
#pragma unroll
        for (int et = 0; et < 16; ++et) gwv[et] = *(const u32x2*)(P + (size_t)(m0 + nl) * LDP_RET + 3072 + h * 256 + 16 * et + 4 * g);
        LDS_BAR();
        const float fd0 = (float)opq_v(nl - 4 * g);
        u32x2 pb[8];
#pragma unroll
        for (int mt = 0; mt < 8; ++mt) {
            pb[mt] = (u32x2){0u, 0u};
            if (mt <= w) { f32x4 a = (f32x4){0.f, 0.f, 0.f, 0.f};
#pragma unroll
                for (int s = 0; s < 4; ++s) { const bf16x8 kf = *(const LAS bf16x8*)(LR + (16 * mt + r16) * 256 + (((4 * s + g) ^ r16) * 16));
                    a = __builtin_amdgcn_mfma_f32_16x16x32_bf16(kf, qf[s], a, 0, 0, 0); }
#pragma unroll
                for (int j = 0; j < 4; ++j) { const float fd = fd0 - (float)(16 * mt + j); a[j] = fd >= 0.f ? a[j] * exp2f(fd * lg2) : 0.f; }
                pb[mt].x = cvt_pk_bf16(a[0], a[1]); pb[mt].y = cvt_pk_bf16(a[2], a[3]); }
        }
#pragma unroll
        for (int ks = 0; ks < 4; ++ks) {
            if (2 * ks <= w) {
                u32x4 pw; pw.x = pb[2 * ks].x; pw.y = pb[2 * ks].y; pw.z = pb[2 * ks + 1].x; pw.w = pb[2 * ks + 1].y;
                const bf16x8 pf = __builtin_bit_cast(bf16x8, pw);
#pragma unroll
                for (int et = 0; et < 16; ++et) { const LAS unsigned char* vr = LV + (16 * et + r16) * 256;
                    const u32x2 lo = *(const LAS u32x2*)(vr + (((8 * ks + g) ^ (2 * r16)) * 8)), hi = *(const LAS u32x2*)(vr + (((8 * ks + 4 + g) ^ (2 * r16)) * 8));
                    u32x4 vw; vw.x = lo.x; vw.y = lo.y; vw.z = hi.x; vw.w = hi.y;
                    o[et] = __builtin_amdgcn_mfma_f32_16x16x32_bf16(__builtin_bit_cast(bf16x8, vw), pf, o[et], 0, 0, 0); } }
        }
        float s1 = 0.f;
#pragma unroll
        for (int et = 0; et < 16; ++et) s1 += (o[et][0] + o[et][1]) + (o[et][2] + o[et][3]);
        s1 += shx(s1, C.lane, 16); s1 += shx(s1, C.lane, 32);
        const float mean = s1 * (1.f / 256.f); float s2 = 0.f;
#pragma unroll
        for (int et = 0; et < 16; ++et) { o[et] = o[et] - mean; s2 += (o[et][0] * o[et][0] + o[et][1] * o[et][1]) + (o[et][2] * o[et][2] + o[et][3] * o[et][3]); }
        s2 += shx(s2, C.lane, 16); s2 += shx(s2, C.lane, 32);
        const float rstd = 1.0f / sqrtf(s2 * (1.f / 256.f) + 1e-5f);
        const int m = m0 + nl;
#pragma unroll
        for (int et = 0; et < 16; ++et) { const int e = h * 256 + 16 * et + 4 * g;
            const f32x4 gg = *(const f32x4*)(gn + e), gb = *(const f32x4*)(gn + SW + e);
            const u32x2 gw_ = gwv[et];
            float gt[4] = {bflo(gw_.x), bfhi(gw_.x), bflo(gw_.y), bfhi(gw_.y)}; float ov[4];
#pragma unroll
            for (int j = 0; j < 4; ++j) { const float yn = o[et][j] * rstd * gg[j] + gb[j]; ov[j] = yn * gt[j] * sigmoidf_(gt[j]); }
            u32x2 wv; wv.x = cvt_pk_bf16(ov[0], ov[1]); wv.y = cvt_pk_bf16(ov[2], ov[3]);
            *(u32x2*)(mix + (size_t)m * D + e) = wv; }
    }
    __syncthreads();
}

constexpr int PH_PER_PAIR = 23, NPH = 2 + 2 * PH_PER_PAIR;
__global__ void __launch_bounds__(NTHR, 2) fwd_kernel(Args args) {
    extern __shared__ __attribute__((aligned(16))) unsigned char lds_raw[];
    Ctx C;
    C.lds = (LAS unsigned char*)lds_raw;
    C.tid = threadIdx.x; C.lane = C.tid & 63; C.wave = __builtin_amdgcn_readfirstlane(C.tid >> 6);
    C.bid = blockIdx.x; C.G = GRID; C.gw = C.bid * NWAVES + C.wave; C.NGW = C.G * NWAVES; C.ws = args.ws;
    for (int u = C.tid; u < (LDS_BYTES - LDS_MISC) / 4; u += NTHR) ((LAS unsigned*)(C.lds + LDS_MISC))[u] = 0u;
    __syncthreads();
    const int lo = args.ph_lo, hi = args.ph_hi;
    XcdBarrier bar; bar.bar = (unsigned*)(args.ws + WS_CTL) + CW_BAR; bar.x = 0; bar.st = nullptr;
    if (hi - lo > 1) bar = xcd_barrier_post((unsigned*)(args.ws + WS_CTL) + CW_BAR, (volatile LAS unsigned*)(C.lds + LDS_MISC));
#ifndef ENMASK
#define ENMASK 0x1ffffffu
#endif
#define EN(j) ((((unsigned)(ENMASK)) >> (j)) & 1u)
#ifndef DBLMASK
#define DBLMASK 0u
#endif
#define REP(j) for (int rep_ = 0; rep_ < 1 + (int)((((unsigned)(DBLMASK)) >> (j)) & 1u); ++rep_)
#define IN(k) (lo <= (k) && (k) < hi)
#define SEAM(k) do { if (IN((k) + 1)) xcd_barrier(bar, (lane_id_asm() == 0) && (Cq.wave == 0)); } while (0)

#define PH_BEGIN Ctx Cq; Cq.lds = C.lds; Cq.lane = lane_id_asm(); Cq.wave = opq_i(C.wave); Cq.tid = Cq.wave * 64 + Cq.lane; Cq.bid = opq_i((int)blockIdx.x); Cq.G = GRID; \
        Cq.gw = Cq.bid * NWAVES + Cq.wave; Cq.NGW = Cq.G * NWAVES; Cq.ws = opq(args.ws); unsigned char* ws = Cq.ws; const int lq = opq_i(lp); (void)ws; (void)lq
    { const int lp = 0;
    REP(0) if (EN(0) && IN(0)) { PH_BEGIN; ph_prologue(Cq, args); SEAM(0); }
    REP(1) if (EN(1) && IN(1)) { PH_BEGIN;
        pg8::SchedMem S; S.G = Cq.G; S.c = Cq.bid; S.memb = (unsigned)WS_MEMB; S.wkv = (unsigned)WS_WKV;
        pg8::EpiMem E; E.O0 = (bf16*)(ws + WS_MEMK); E.O1 = (bf16*)(ws + WS_MEMVT);
        pg8::gemm_phase<pg8::EpiMem, pg8::SchedMem, true, true>(Cq.lds, Cq.tid, (const char*)ws, 2048, 2048, 2048, S, E);
        SEAM(1);
    } }
#pragma unroll 1
    for (int lp = 0; lp < 2; ++lp) {
        const int pb = 2 + lp * PH_PER_PAIR;
        REP(2) if (EN(2) && IN(pb + 0)) {
            PH_BEGIN;
            pg8::SchedPlain S; S.init(M / 256, 22, Cq.G, Cq.bid); S.A0 = (unsigned)(WS_XB); S.B0 = (unsigned)(WS_WIN + (size_t)(2 * lq) * 22 * MiB); S.at = (unsigned)(256 * 2048 * 2); S.bt = (unsigned)(256 * 2048 * 2);
            pg8::EpiBf16 E; E.O = (bf16*)(ws + WS_P); E.ldc = LDP_RW;
            pg8::gemm_phase<pg8::EpiBf16, pg8::SchedPlain, true, true>(Cq.lds, Cq.tid, (const char*)ws, 2048, 2048, 2048, S, E);
            SEAM(pb + 0);
        }
        REP(3) if (EN(3) && IN(pb + 1)) { PH_BEGIN; const bool with_v = lq == 1; ph_rwkv_prep1(Cq, args.in[lq ? L2_MU : L0_MU], with_v); ph_memattn(Cq, (const bf16*)(ws + WS_P), LDP_RW, with_v ? 5120 : 5056); SEAM(pb + 1); }
        REP(4) if (EN(4) && IN(pb + 2)) {
            PH_BEGIN; const float* vecs = args.in[lq ? L2_VECS : L0_VECS];
            pg8::SchedLora S; S.skipv = lq == 0; S.init(M / 256, lq == 0 ? 18 : 24, Cq.G, Cq.bid); S.A0 = (unsigned)(WS_ALORA); S.B0 = (unsigned)(WS_WLORA + (size_t)lq * 3 * MiB);
            pg8::EpiLora E; E.O = (bf16*)(ws + WS_LORAOUT); E.vecs = vecs;
            pg8::gemm_phase<pg8::EpiLora, pg8::SchedLora, true, true>(Cq.lds, Cq.tid, (const char*)ws, 512, 256, opq_i(256), S, E);
            SEAM(pb + 2);
        }
        REP(5) if (EN(5) && IN(pb + 3)) { PH_BEGIN; ph_rwkv_prep2(Cq, args.in[lq ? L2_MU : L0_MU], args.in[lq ? L2_VECS : L0_VECS], lq == 1); SEAM(pb + 3); }
        REP(6) if (EN(6) && IN(pb + 4)) { PH_BEGIN; ph_rwkv_scan(Cq, args.in[lq ? L3_MG : L1_MG], args.in[lq ? L3_MU_ : L1_MU_], args.in[lq ? L3_MD : L1_MD], args.in[lq ? L2_VECS : L0_VECS], lq == 1, args.in, lq); SEAM(pb + 4); }
        REP(8) if (EN(8) && IN(pb + 6)) {
            PH_BEGIN;
            pg8::SchedPlain S; S.init(M / 256, 8, Cq.G, Cq.bid); S.A0 = (unsigned)(WS_MIX); S.B0 = (unsigned)(WS_WOUT + (size_t)(2 * lq) * 8 * MiB); S.at = (unsigned)(256 * 2048 * 2); S.bt = (unsigned)(256 * 2048 * 2);
            pg8::EpiBf16 E; E.O = (bf16*)(ws + WS_P); E.ldc = D;
            pg8::gemm_phase<pg8::EpiBf16, pg8::SchedPlain, true, true>(Cq.lds, Cq.tid, (const char*)ws, 2048, 2048, 2048, S, E);
            SEAM(pb + 6);
        }
        REP(9) if (EN(9) && IN(pb + 7)) { PH_BEGIN; const float* nr = args.in[lq ? L2_NORMS : L0_NORMS];
            ph_ln(Cq, ws + WS_P, 0, nr, nr + D, nullptr, ws + WS_X8, nullptr, false); SEAM(pb + 7); }
        REP(10) if (EN(10) && IN(pb + 8)) {
            PH_BEGIN;
            pg8::SchedPlain S; S.init(M / 256, 44, Cq.G, Cq.bid); S.A0 = (unsigned)(WS_X8); S.B0 = (unsigned)(WS_WFGU + (size_t)lq * 44 * MiB); S.at = (unsigned)(256 * 2048); S.bt = (unsigned)(256 * 2048);
            pg8::EpiSwiglu8 E; E.O = ws + WS_HID; E.ldc = DFF; E.inv = 1.0f / 16384.0f; E.so = 32.0f;
            pg8::gemm_phase<pg8::EpiSwiglu8, pg8::SchedPlain, true, true, true>(Cq.lds, Cq.tid, (const char*)ws, 1024, 1024, 1024, S, E);
            SEAM(pb + 8);
        }
        REP(11) if (EN(11) && IN(pb + 9)) {
            PH_BEGIN;
            pg8::SchedPlain S; S.init(M / 256, 8, Cq.G, Cq.bid); S.A0 = (unsigned)(WS_HID); S.B0 = (unsigned)(WS_WFD + (size_t)lq * 22 * MiB); S.at = (unsigned)(256 * DFF); S.bt = (unsigned)(256 * DFF);
            pg8::EpiFp8S E; E.O = ws + WS_P; E.ldc = D; E.sc = 1.0f / 256.0f;
            pg8::gemm_phase<pg8::EpiFp8S, pg8::SchedPlain, true, true, true>(Cq.lds, Cq.tid, (const char*)ws, DFF / 2, DFF / 2, DFF / 2, S, E);
            SEAM(pb + 9);
        }
        REP(12) if (EN(12) && IN(pb + 10)) { PH_BEGIN; const float* nr = args.in[lq ? L2_NORMS : L0_NORMS];
            ph_ln(Cq, ws + WS_P, 1, nr + 2 * D, nr + 3 * D, nullptr, nullptr, nullptr, false); SEAM(pb + 10); }
        REP(13) if (EN(13) && IN(pb + 11)) {
            PH_BEGIN;
            pg8::SchedPlain S; S.init(M / 256, 20, Cq.G, Cq.bid); S.A0 = (unsigned)(WS_XB); S.B0 = (unsigned)(WS_WIN + (size_t)(2 * lq + 1) * 22 * MiB); S.at = (unsigned)(256 * 2048 * 2); S.bt = (unsigned)(256 * 2048 * 2);
            pg8::EpiBf16 E; E.O = (bf16*)(ws + WS_P); E.ldc = LDP_RET;
            pg8::gemm_phase<pg8::EpiBf16, pg8::SchedPlain, true, true>(Cq.lds, Cq.tid, (const char*)ws, 2048, 2048, 2048, S, E);
            SEAM(pb + 11);
        }
        REP(14) if (EN(14) && IN(pb + 12)) { PH_BEGIN; ph_ret_prep(Cq); ph_memattn(Cq, (const bf16*)(ws + WS_P), LDP_RET, 4608); SEAM(pb + 12); }
        REP(16) if (EN(16) && IN(pb + 14)) { PH_BEGIN; ph_ret_prefix(Cq); SEAM(pb + 14); }
        REP(17) if (EN(17) && IN(pb + 15)) { PH_BEGIN; ph_ret_out(Cq, args.in[lq ? L3_GN : L1_GN]); SEAM(pb + 15); }
        REP(18) if (EN(18) && IN(pb + 16)) {
            PH_BEGIN;
            pg8::SchedPlain S; S.init(M / 256, 8, Cq.G, Cq.bid); S.A0 = (unsigned)(WS_MIX); S.B0 = (unsigned)(WS_WOUT + (size_t)(2 * lq + 1) * 8 * MiB); S.at = (unsigned)(256 * 2048 * 2); S.bt = (unsigned)(256 * 2048 * 2);
            pg8::EpiBf16 E; E.O = (bf16*)(ws + WS_P); E.ldc = D;
            pg8::gemm_phase<pg8::EpiBf16, pg8::SchedPlain, true, true>(Cq.lds, Cq.tid, (const char*)ws, 2048, 2048, 2048, S, E);
            SEAM(pb + 16);
        }
        REP(19) if (EN(19) && IN(pb + 17)) {
            PH_BEGIN; const float* nr = args.in[lq ? L3_NORMS : L1_NORMS];
            REP(25) { ph_ln(Cq, ws + WS_P, 0, nr, nr + D, nullptr, ws + WS_X8, args.in[lq ? L3_ROUTER : L1_ROUTER], true);
            __syncthreads(); }
            SEAM(pb + 17);
        }
        REP(20) if (EN(20) && IN(pb + 18)) { PH_BEGIN; ph_slots(Cq); SEAM(pb + 18); }
        REP(22) if (EN(22) && IN(pb + 20)) {
            PH_BEGIN;
            const int nT = __builtin_amdgcn_readfirstlane(((const int*)(ws + WS_CTL))[CW_NT]);
            pg8::SchedMoEg S; S.init(nT, 44, Cq.G, Cq.bid); S.B0 = (unsigned)(WS_MWGU); S.bt = (unsigned)(256 * 2048); S.be = (unsigned)(22 * MiB);
            S.xoff = (unsigned)WS_X8; S.zoff = (unsigned)(WS_CTL + 512 * 1024); S.texp = (const int*)(ws + WS_CTL) + CW_TEXP; S.slot_tok = (const int*)(ws + WS_SLOTTOK);
            pg8::EpiSwiglu8 E; E.O = ws + WS_HIDM; E.ldc = DFF; E.inv = 1.0f / 16384.0f; E.so = 32.0f;
            pg8::gemm_phase<pg8::EpiSwiglu8, pg8::SchedMoEg, true, true, true>(Cq.lds, Cq.tid, (const char*)ws, 1024, 1024, 1024, S, E);
            SEAM(pb + 20);
        }
        REP(23) if (EN(23) && IN(pb + 21)) {
            PH_BEGIN;
            const int nT = __builtin_amdgcn_readfirstlane(((const int*)(ws + WS_CTL))[CW_NT]);
            pg8::SchedMoE S; S.init(nT, 8, Cq.G, Cq.bid); S.A0 = (unsigned)(WS_HIDM); S.B0 = (unsigned)(WS_MWD); S.at = (unsigned)(256 * DFF); S.bt = (unsigned)(256 * DFF); S.be = (unsigned)(11 * MiB);
            S.texp = (const int*)(ws + WS_CTL) + CW_TEXP;
            pg8::EpiFp8S E; E.O = ws + WS_XPERM; E.ldc = D; E.sc = 1.0f / 256.0f;
            pg8::gemm_phase<pg8::EpiFp8S, pg8::SchedMoE, true, true, true>(Cq.lds, Cq.tid, (const char*)ws, DFF / 2, DFF / 2, DFF / 2, S, E);
            SEAM(pb + 21);
        }
        REP(24) if (EN(24) && IN(pb + 22)) {
            PH_BEGIN; const float* nr = args.in[lq ? L3_NORMS : L1_NORMS];
            ph_ln(Cq, ws + WS_XPERM, 2, nr + 2 * D, nr + 3 * D, lq == 1 ? args.out : nullptr, nullptr, nullptr, false);
            SEAM(pb + 22);
        }
    }
#undef IN
#undef SEAM
}

#ifndef MK_PER_PHASE
#define MK_PER_PHASE 0
#endif
extern "C" void kernel_launch(void* const* d_in, const int* in_sizes, int n_in, void* d_out, int out_size, void* d_ws, size_t ws_size, hipStream_t stream) {
    static int ready = 0;
    if (ready == 0) {
        ready = 1;
        if (n_in != 43 || out_size != M * D || ws_size < WS_END) { fprintf(stderr, "kernel_launch: unexpected problem (n_in %d out %d ws %zu need %zu)\n", n_in, out_size, ws_size, (size_t)WS_END); ready = -1; }
        else if (hipFuncSetAttribute((const void*)fwd_kernel, hipFuncAttributeMaxDynamicSharedMemorySize, LDS_BYTES) != hipSuccess) { fprintf(stderr, "kernel_launch: hipFuncSetAttribute failed\n"); ready = -1; }
        (void)hipGetLastError();
    }
    if (ready < 0) return;
    (void)hipMemsetAsync((char*)d_ws + WS_CTL, 0, CTL_BYTES, stream);
    Args a{};
    for (int i = 0; i < 43; ++i) a.in[i] = (const float*)d_in[i];
    a.out = (float*)d_out; a.ws = (unsigned char*)d_ws;
#if MK_PER_PHASE
    for (int p = 0; p < NPH; ++p) { a.ph_lo = p; a.ph_hi = p + 1; hipLaunchKernelGGL(fwd_kernel, dim3(GRID), dim3(NTHR), LDS_BYTES, stream, a); }
#else
    a.ph_lo = 0; a.ph_hi = NPH;
    hipLaunchKernelGGL(fwd_kernel, dim3(GRID), dim3(NTHR), LDS_BYTES, stream, a);
#endif
}
```

```cpp
#include <hip/hip_runtime.h>
#include <cstdio>
#include <cstdint>

#define LAS __attribute__((address_space(3)))
#define GAS __attribute__((address_space(1)))
typedef unsigned short bf16;
typedef short bf16x8 __attribute__((ext_vector_type(8)));
typedef float f32x4 __attribute__((ext_vector_type(4)));
typedef float f32x2 __attribute__((ext_vector_type(2)));
typedef unsigned u32x4 __attribute__((ext_vector_type(4)));
typedef unsigned u32x2 __attribute__((ext_vector_type(2)));

constexpr int M = 32768, D = 2048, SEQ = 2048, NB = 16;
constexpr int SW = 1536;
constexpr int LDP_RW = 5632, LDP_RET = 5120;
constexpr int DFF = 5632;
constexpr int NSLOT = 67584;
constexpr float ALPHA = 1.6817928305074290f;
constexpr float LN_EPS = 1e-5f;
constexpr int NWAVES = 8, NTHR = 512, GRID = 256;

constexpr size_t MiB = 1u << 20;
constexpr size_t WS_CTL = 0, CTL_BYTES = 1 * MiB;
constexpr size_t WS_WKV = 1 * MiB;
constexpr size_t WS_WIN = WS_WKV + 4 * MiB;
constexpr size_t WS_WOUT = WS_WIN + 88 * MiB;
constexpr size_t WS_WLORA = WS_WOUT + 32 * MiB;
constexpr size_t WS_WFGU = WS_WLORA + 6 * MiB;
constexpr size_t WS_WFD = WS_WFGU + 88 * MiB;
constexpr size_t WS_MEMB = WS_WFD + 44 * MiB;
constexpr size_t WS_MEMK = WS_MEMB + 16 * MiB;
constexpr size_t WS_MEMVT = WS_MEMK + 4 * MiB;
constexpr size_t WS_CS = WS_MEMVT + 4 * MiB;
constexpr size_t WS_XB = WS_CS + 16 * MiB;
constexpr size_t WS_MIX = WS_XB + 128 * MiB;
constexpr size_t WS_VFIRST = WS_MIX + 128 * MiB;
constexpr size_t WS_P = WS_VFIRST + 96 * MiB;
constexpr size_t WS_MISC = WS_P + 352 * MiB;
constexpr size_t WS_ROUTE = WS_MISC, WS_SLOT1 = WS_MISC + 512 * 1024, WS_SLOT2 = WS_SLOT1 + 128 * 1024, WS_SLOTTOK = WS_SLOT2 + 128 * 1024;
constexpr size_t WS_BONUS = WS_MISC + 2 * MiB;
constexpr size_t WS_SB = WS_BONUS + 3 * MiB;
constexpr size_t WS_ALORA = WS_SB, WS_LORAOUT = WS_SB + 32 * MiB, WS_SCANIN = WS_SB + 416 * MiB;
constexpr size_t WS_QR = WS_SB, WS_KR = WS_SB + 48 * MiB, WS_KDT = WS_SB + 96 * MiB, WS_VT = WS_SB + 144 * MiB, WS_KVT = WS_SB + 240 * MiB, WS_RTB = WS_SB + 432 * MiB;
constexpr size_t WS_HID = WS_SB;
constexpr size_t WS_XPERM = WS_SB, WS_HIDM = WS_SB + 264 * MiB, WS_MWGU = WS_SB + 1184 * MiB, WS_MWD = WS_SB + 1360 * MiB;
constexpr size_t WS_XLO = WS_SB + 1518 * MiB;
constexpr size_t WS_X8 = WS_XLO + 64 * MiB;
constexpr size_t WS_END = WS_X8 + 64 * MiB;
constexpr int CW_BAR = 4096;
constexpr int CW_CNT = 16384;
constexpr int CW_NT = 20480;
constexpr int CW_TEXP = 20544;

constexpr int RING_BYTES = 131072;
constexpr int LDS_MISC = RING_BYTES;
constexpr int LDS_BYTES = RING_BYTES + 8192;

#define LDS_WAIT() asm volatile("s_waitcnt lgkmcnt(0)" ::: "memory")
#define VM_WAIT() asm volatile("s_waitcnt vmcnt(0)" ::: "memory")
__device__ __forceinline__ unsigned cvt_pk_bf16(float lo, float hi) { unsigned r; asm volatile("v_cvt_pk_bf16_f32 %0, %1, %2" : "=v"(r) : "v"(lo), "v"(hi)); return r; }
__device__ __forceinline__ bf16 f2bf(float f) { return (bf16)(cvt_pk_bf16(f, 0.f) & 0xffffu); }
__device__ __forceinline__ float bf2f(bf16 b) { return __uint_as_float(((unsigned)b) << 16); }
__device__ __forceinline__ float bflo(unsigned w) { return __uint_as_float(w << 16); }
__device__ __forceinline__ float bfhi(unsigned w) { return __uint_as_float(w & 0xffff0000u); }
template <int CTRL> __device__ __forceinline__ float dpp_add(float x) {
    int y = __builtin_amdgcn_update_dpp(0, __float_as_int(x), CTRL, 0xf, 0xf, true);
    return x + __int_as_float(y);
}
__device__ __forceinline__ float row16_sum(float x) { x = dpp_add<0xB1>(x); x = dpp_add<0x4E>(x); x = dpp_add<0x141>(x); x = dpp_add<0x140>(x); return x; }
__device__ __forceinline__ float wave_sum(float v) {
    v = row16_sum(v);
    const float a = __int_as_float(__builtin_amdgcn_readlane(__float_as_int(v), 0)), b = __int_as_float(__builtin_amdgcn_readlane(__float_as_int(v), 16));
    const float c = __int_as_float(__builtin_amdgcn_readlane(__float_as_int(v), 32)), d = __int_as_float(__builtin_amdgcn_readlane(__float_as_int(v), 48));
    return (a + b) + (c + d);
}
__device__ __forceinline__ unsigned pk4_fp8(float a, float b, float c, float d) {
    a = __builtin_amdgcn_fmed3f(a, -448.f, 448.f); b = __builtin_amdgcn_fmed3f(b, -448.f, 448.f); c = __builtin_amdgcn_fmed3f(c, -448.f, 448.f); d = __builtin_amdgcn_fmed3f(d, -448.f, 448.f);
    unsigned w = 0; w = __builtin_amdgcn_cvt_pk_fp8_f32(a, b, w, false); w = __builtin_amdgcn_cvt_pk_fp8_f32(c, d, w, true); return w; }
__device__ __forceinline__ float sigmoidf_(float z) { return __builtin_amdgcn_rcpf(1.0f + __expf(-z)); }

__device__ __forceinline__ unsigned char* opq(unsigned char* p) { asm volatile("" : "+s"(p)); return p; }
__device__ __forceinline__ int opq_i(int v) { asm volatile("" : "+s"(v)); return v; }
__device__ __forceinline__ int opq_v(int v) { asm volatile("" : "+v"(v)); return v; }
__device__ __forceinline__ int lane_id_asm() { int l; asm volatile("v_mbcnt_lo_u32_b32 %0, -1, 0\n\tv_mbcnt_hi_u32_b32 %0, -1, %0" : "=v"(l)); return l; }
typedef _Float16 h16x2 __attribute__((ext_vector_type(2)));
__device__ __forceinline__ float shx(float v, int lane, int m) { return __builtin_bit_cast(float, __builtin_amdgcn_ds_bpermute((lane ^ m) << 2, __builtin_bit_cast(int, v))); }
__device__ __forceinline__ float shl(float v, int src) { return __builtin_bit_cast(float, __builtin_amdgcn_ds_bpermute(src << 2, __builtin_bit_cast(int, v))); }
#define XB_TMO      128
#define XB_XCNT(j)  (256  + 64 * (j))
#define XB_XSUB(j)  (1280 + 64 * (j))
#define XB_XGEN(j)  (2304 + 64 * (j))
#define XB_TOP      3328
#define XB_TOPGEN   3392
#define XCD_BAR_WORDS 3456
#define XB_SPIN_CAP (1u << 18)
__device__ __forceinline__ unsigned xb_ld(unsigned* p)              { return __hip_atomic_load(p, __ATOMIC_RELAXED, __HIP_MEMORY_SCOPE_AGENT); }
__device__ __forceinline__ unsigned xb_add(unsigned* p, unsigned v) { return __hip_atomic_fetch_add(p, v, __ATOMIC_RELAXED, __HIP_MEMORY_SCOPE_AGENT); }
__device__ __forceinline__ unsigned xb_xcc_id() { return (unsigned)__builtin_amdgcn_s_getreg((3 << 11) | 20) & 0xFu; }
#define XB_SPIN(cond, bar) do { unsigned _sp = 0; while (cond) { __builtin_amdgcn_s_sleep(1); \
    if ((++_sp & 255u) == 0u) { if (xb_ld(&(bar)[XB_TMO])) break; if (_sp > XB_SPIN_CAP) { atomicAdd(&(bar)[XB_TMO], 1u); break; } } } } while (0)
struct XcdBarrier { unsigned* bar; unsigned x; volatile LAS unsigned* st; };
__device__ __forceinline__ XcdBarrier xcd_barrier_post(unsigned* bar, volatile LAS unsigned* st) {
    XcdBarrier b; b.bar = bar; b.x = xb_xcc_id(); b.st = st;
    if (threadIdx.x == 0) (void)xb_add(&bar[XB_XCNT(b.x)], 1u);
    return b;
}
__device__ __forceinline__ void xcd_barrier_complete(unsigned* bar, unsigned x, unsigned& nloc, unsigned& nx) {
    const unsigned G = gridDim.x * gridDim.y * gridDim.z;
    unsigned sum, cnt, mine, sp = 0u;
    for (;;) {
        sum = 0u; cnt = 0u; mine = 0u;
#pragma unroll
        for (unsigned j = 0; j < 16; ++j) { const unsigned c = xb_ld(&bar[XB_XCNT(j)]); sum += c; cnt += (c > 0u) ? 1u : 0u; mine = (j == x) ? c : mine; }
        if (sum == G) break;
        __builtin_amdgcn_s_sleep(1);
        if ((++sp & 255u) == 0u) { if (xb_ld(&bar[XB_TMO])) break; if (sp > XB_SPIN_CAP) { atomicAdd(&bar[XB_TMO], 1u); break; } }
    }
    nloc = mine > 0u ? mine : 1u; nx = cnt > 0u ? cnt : 1u;
}
__device__ __forceinline__ void xcd_barrier(const XcdBarrier& b, const bool leader  ) {
    asm volatile("s_waitcnt vmcnt(0)" ::: "memory");
    __syncthreads();
    if (leader) {
        unsigned* bar = b.bar;
        __builtin_amdgcn_s_waitcnt(0);
        unsigned nloc = b.st[0], nx = b.st[1];
        if (nloc == 0u) { xcd_barrier_complete(bar, b.x, nloc, nx); b.st[0] = nloc; b.st[1] = nx; }
        const unsigned old = xb_add(&bar[XB_XSUB(b.x)], 1u);
        const unsigned gen = old / nloc;
        if (old + 1u == (gen + 1u) * nloc) {
            __builtin_amdgcn_fence(__ATOMIC_RELEASE, "agent");
            asm volatile("s_waitcnt vmcnt(0)" ::: "memory");
            const unsigned og = xb_add(&bar[XB_TOP], 1u);
            const unsigned tg = og / nx;
            if (og + 1u == (tg + 1u) * nx) xb_add(&bar[XB_TOPGEN], 1u);
            else XB_SPIN(xb_ld(&bar[XB_TOPGEN]) == tg, bar);
            __builtin_amdgcn_fence(__ATOMIC_ACQUIRE, "agent");
            xb_add(&bar[XB_XGEN(b.x)], 1u);
            asm volatile("s_waitcnt vmcnt(0)" ::: "memory");
        } else {
            XB_SPIN(xb_ld(&bar[XB_XGEN(b.x)]) == gen, bar);
            __builtin_amdgcn_fence(__ATOMIC_ACQUIRE, "agent");
            asm volatile("s_waitcnt vmcnt(0)" ::: "memory");
        }
    }
    __syncthreads();
}

namespace pg8 {
constexpr int BM = 256, BK = 64, HALF = 128, HTB = HALF * BK * 2, STAGE_BYTES = 8 * HTB, NXCD = 8, WGM = 8;
__host__ __device__ __forceinline__ int lds_byte(int r, int c) { const int st = (r >> 4) * 2 + (c >> 5), rr = r & 15, cc = c & 31, ob = rr * 64 + cc * 2; return st * 1024 + (ob ^ (((ob >> 9) & 1) << 5)); }
__host__ __device__ __forceinline__ void stage_rc(int b, int& R, int& C) { const int st = b / 1024, sb = b % 1024, swz = sb ^ (((sb >> 9) & 1) << 5); R = (st >> 1) * 16 + swz / 64; C = (st & 1) * 32 + (swz % 64) / 2; }
__host__ __device__ __forceinline__ int perm32(int rho) { const int n = rho >> 4, i = rho & 15; return 8 * (i >> 2) + 4 * n + (i & 3); }
typedef int i32x8 __attribute__((ext_vector_type(8)));
typedef int i32x4_ __attribute__((ext_vector_type(4)));
__device__ __forceinline__ i32x8 cat8(bf16x8 a, bf16x8 b) { const i32x4_ x = __builtin_bit_cast(i32x4_, a), y = __builtin_bit_cast(i32x4_, b); return __builtin_shufflevector(x, y, 0, 1, 2, 3, 4, 5, 6, 7); }
__device__ __forceinline__ void mfma8(f32x4& acc, const i32x8 a, const i32x8 b) {
    asm volatile("v_mfma_scale_f32_16x16x128_f8f6f4 %0, %1, %2, %0, %3, %3 op_sel_hi:[0,0,0]" : "+v"(acc) : "v"(a), "v"(b), "v"(127)); }
struct Unit { int pm, pn, z; };
struct Order {
    int nM, nN, nwg, G, c;
    __device__ __forceinline__ void init(int nM_, int nN_, int G_, int c_) { nM = nM_; nN = nN_; nwg = nM * nN; G = G_; c = c_; }
    __device__ __forceinline__ bool next_mn(int i, Unit& u) const {
        const long L = (long)i * G + c; if (L >= nwg) return false;
        int wgid = (int)L; { const int q = nwg / NXCD, r = nwg % NXCD, xcd = wgid % NXCD, off = wgid / NXCD; wgid = (xcd < r ? xcd * (q + 1) : r * (q + 1) + (xcd - r) * q) + off; }
        const int nig = WGM * nN, gid = wgid / nig, fm = gid * WGM, gsz = (nM - fm) < WGM ? (nM - fm) : WGM;
        u.pm = fm + ((wgid % nig) % gsz); u.pn = (wgid % nig) / gsz; u.z = 0; return true;
    }
};

template <class Epi, class Sched, bool ALIGN_EPI, bool SP2, bool FP8 = false>
__device__ __forceinline__ void gemm_phase(LAS unsigned char* lds, const int tid_in, const char* base  , const int lda, const int ldb, const int K, const Sched& S, const Epi& E) {
    const int tid = tid_in, wid = __builtin_amdgcn_readfirstlane(tid >> 6), lane = tid & 63, wr = wid >> 2, wc = wid & 3, fr = lane & 15, fq = lane >> 4;
    const int nt = K / BK;
    unsigned voffA[2], voffB[2];
#pragma unroll
    for (int i = 0; i < 2; ++i) { int R, C; stage_rc(tid * 16 + i * 8192, R, C); const int Rb = Epi::PERM ? ((R & ~31) + perm32(R & 31)) : R;
        voffA[i] = (unsigned)(R * lda + C) * 2u; voffB[i] = (unsigned)(Rb * ldb + C) * 2u; }
    constexpr bool GATHER = Sched::GATHER;
    unsigned gvC[2][2], gvN[2][2];
#define PG8_GV(dst, unit) do { _Pragma("unroll") for (int hh_ = 0; hh_ < 2; ++hh_) _Pragma("unroll") for (int i_ = 0; i_ < 2; ++i_) { int R_, C_; stage_rc(tid * 16 + i_ * 8192, R_, C_); \
        dst[hh_][i_] = S.arow(unit, hh_ * HALF + R_) + (unsigned)C_ * 2u; } } while (0)
    const unsigned kstep = (unsigned)(BK * 2);
    const unsigned hstepA = (unsigned)(HALF * lda * 2), hstepB = (unsigned)(HALF * ldb * 2);
    const __amdgpu_buffer_rsrc_t rsrc = __builtin_amdgcn_make_buffer_rsrc((void*)base, 0, 0xffffffffu, 0x00020000);
    const unsigned ldsw = (unsigned)wid * 1024u;
    const int aoff = lds_byte(wr * 64 + fr, fq * 8), boff = lds_byte(wc * 32 + fr, fq * 8);
#define PG8_SA(b, h) (((b) * 2 + (h)) * HTB)
#define PG8_SB(b, h) ((4 + (b) * 2 + (h)) * HTB)
#define PG8_STAGE(bufoff, goff, voff) do { _Pragma("unroll") for (int _i = 0; _i < 2; ++_i) \
        __builtin_amdgcn_raw_ptr_buffer_load_lds(rsrc, (LAS unsigned*)(lds + (bufoff) + ldsw + _i * 8192), 16, (voff)[_i], (goff), 0, 0); } while (0)
#define PG8_STAGE_A(bufoff, aoff, hh, nx) do { if constexpr (GATHER) { unsigned gv_[2]; gv_[0] = (nx) ? gvN[hh][0] : gvC[hh][0]; gv_[1] = (nx) ? gvN[hh][1] : gvC[hh][1]; PG8_STAGE(bufoff, aoff, gv_); } \
        else { PG8_STAGE(bufoff, (aoff) + (hh) * hstepA, voffA); } } while (0)
#define PG8_LDA(dst, b, h) do { _Pragma("unroll") for (int m = 0; m < 4; ++m) _Pragma("unroll") for (int k = 0; k < 2; ++k) dst[m][k] = *(const LAS bf16x8*)(lds + PG8_SA(b, h) + aoff + m * 2048 + k * 1024); } while (0)
#define PG8_LDB(dst, b, h) do { _Pragma("unroll") for (int n = 0; n < 2; ++n) _Pragma("unroll") for (int k = 0; k < 2; ++k) dst[n][k] = *(const LAS bf16x8*)(lds + PG8_SB(b, h) + boff + n * 2048 + k * 1024); } while (0)
#define PG8_MMA(ai, bj, At, Bt) do { __builtin_amdgcn_s_setprio(1); \
        if constexpr (FP8) { _Pragma("unroll") for (int m = 0; m < 4; ++m) _Pragma("unroll") for (int n = 0; n < 2; ++n) \
            mfma8(acc[ai][bj][m][n], cat8(Bt[n][0], Bt[n][1]), cat8(At[m][0], At[m][1])); } \
        else { _Pragma("unroll") for (int m = 0; m < 4; ++m) _Pragma("unroll") for (int n = 0; n < 2; ++n) _Pragma("unroll") for (int k = 0; k < 2; ++k) \
            acc[ai][bj][m][n] = __builtin_amdgcn_mfma_f32_16x16x32_bf16(Bt[n][k], At[m][k], acc[ai][bj][m][n], 0, 0, 0); } \
        __builtin_amdgcn_s_setprio(0); } while (0)
#define PG8_WAIT_V(n) asm volatile("s_waitcnt vmcnt(" #n ")" ::: "memory")
#define PG8_WAIT_L(n) asm volatile("s_waitcnt lgkmcnt(" #n ")" ::: "memory")
#define PG8_BAR __builtin_amdgcn_s_barrier()
#define PG8_SCHED __builtin_amdgcn_sched_barrier(0)
    Unit cur, nxt; int ui = 0;
    if (!S.next(0, cur)) return;
    f32x4 acc[2][2][4][2];
#pragma unroll
    for (int a = 0; a < 2; ++a)
#pragma unroll
        for (int b = 0; b < 2; ++b)
#pragma unroll
            for (int m = 0; m < 4; ++m)
#pragma unroll
                for (int n = 0; n < 2; ++n) acc[a][b][m][n] = (f32x4){0.f, 0.f, 0.f, 0.f};
    bf16x8 At[4][2], B0[2][2], B1[2][2];
    unsigned cA = S.A(cur), cB = S.B(cur);
    if constexpr (GATHER) { PG8_GV(gvC, cur); _Pragma("unroll") for (int hh_ = 0; hh_ < 2; ++hh_) _Pragma("unroll") for (int i_ = 0; i_ < 2; ++i_) gvN[hh_][i_] = gvC[hh_][i_]; }
    if constexpr (SP2) {
        PG8_STAGE(PG8_SB(0, 0), cB, voffB); PG8_STAGE(PG8_SB(0, 1), cB + hstepB, voffB); PG8_STAGE_A(PG8_SA(0, 0), cA, 0, false); PG8_STAGE_A(PG8_SA(0, 1), cA, 1, false);
        if (wr == 1) PG8_BAR;
        PG8_WAIT_V(2); PG8_BAR;
        PG8_STAGE(PG8_SB(1, 0), cB + kstep, voffB); PG8_STAGE_A(PG8_SA(1, 0), cA + kstep, 0, false); PG8_STAGE(PG8_SB(1, 1), cB + hstepB + kstep, voffB);
        PG8_WAIT_V(6); PG8_BAR;
    } else {
        PG8_STAGE(PG8_SB(0, 0), cB, voffB); PG8_STAGE_A(PG8_SA(0, 0), cA, 0, false); PG8_STAGE(PG8_SB(0, 1), cB + hstepB, voffB); PG8_STAGE_A(PG8_SA(0, 1), cA, 1, false);
        if (wr == 1) PG8_BAR;
        PG8_WAIT_V(4); PG8_BAR;
        PG8_STAGE(PG8_SB(1, 0), cB + kstep, voffB); PG8_STAGE_A(PG8_SA(1, 0), cA + kstep, 0, false); PG8_STAGE(PG8_SB(1, 1), cB + hstepB + kstep, voffB);
        PG8_WAIT_V(6); PG8_BAR;
    }
    for (;;) {
        const bool has_next = S.next(ui + 1, nxt);
        const unsigned nA = has_next ? S.A(nxt) : cA, nB = has_next ? S.B(nxt) : cB;
        if constexpr (GATHER) { if (has_next) PG8_GV(gvN, nxt); }
        for (int t = 0; t < nt; t += 2) {
            const bool last = (t == nt - 2);
            const unsigned a1 = cA + (unsigned)(t + 1) * kstep;
            const unsigned a2 = last ? nA : cA + (unsigned)(t + 2) * kstep, b2 = last ? nB : cB + (unsigned)(t + 2) * kstep;
            const unsigned a3 = a2 + kstep, b3 = b2 + kstep;
            if constexpr (SP2) {
            PG8_LDB(B0, 0, 0); PG8_LDB(B1, 0, 1); PG8_SCHED; PG8_LDA(At, 0, 0); PG8_STAGE_A(PG8_SA(1, 1), a1, 1, false);
            PG8_WAIT_V(8); PG8_WAIT_L(0); PG8_BAR; PG8_MMA(0, 0, At, B0); PG8_MMA(0, 1, At, B1); PG8_BAR; PG8_SCHED;
            PG8_LDA(At, 0, 1); PG8_STAGE(PG8_SB(0, 0), b2, voffB); PG8_STAGE(PG8_SB(0, 1), b2 + hstepB, voffB); PG8_STAGE_A(PG8_SA(0, 0), a2, 0, last);
            PG8_WAIT_V(8); PG8_WAIT_L(0); PG8_BAR; PG8_MMA(1, 0, At, B0); PG8_MMA(1, 1, At, B1); PG8_BAR; PG8_SCHED;
            PG8_LDB(B0, 1, 0); PG8_LDB(B1, 1, 1); PG8_SCHED; PG8_LDA(At, 1, 0); PG8_STAGE_A(PG8_SA(0, 1), a2, 1, last);
            PG8_WAIT_V(8); PG8_WAIT_L(0); PG8_BAR; PG8_MMA(0, 0, At, B0); PG8_MMA(0, 1, At, B1); PG8_BAR; PG8_SCHED;
            PG8_LDA(At, 1, 1); PG8_STAGE(PG8_SB(1, 0), b3, voffB); PG8_STAGE(PG8_SB(1, 1), b3 + hstepB, voffB); PG8_STAGE_A(PG8_SA(1, 0), a3, 0, last);
            PG8_WAIT_V(8); PG8_WAIT_L(0); PG8_BAR; PG8_MMA(1, 0, At, B0); PG8_MMA(1, 1, At, B1); PG8_BAR; PG8_SCHED;
            } else {
            PG8_LDB(B0, 0, 0); PG8_SCHED; PG8_LDA(At, 0, 0); PG8_STAGE_A(PG8_SA(1, 1), a1, 1, false);
            PG8_WAIT_L(8); PG8_BAR; PG8_WAIT_L(0); PG8_MMA(0, 0, At, B0); PG8_BAR; PG8_SCHED;
            PG8_LDB(B1, 0, 1); PG8_STAGE(PG8_SB(0, 0), b2, voffB);
            PG8_BAR; PG8_WAIT_L(0); PG8_MMA(0, 1, At, B1); PG8_BAR;
            PG8_LDA(At, 0, 1); PG8_STAGE_A(PG8_SA(0, 0), a2, 0, last);
            PG8_BAR; PG8_WAIT_L(0); PG8_MMA(1, 0, At, B0); PG8_BAR; PG8_SCHED;
            PG8_STAGE(PG8_SB(0, 1), b2 + hstepB, voffB);
            PG8_WAIT_V(6); PG8_BAR; PG8_MMA(1, 1, At, B1); PG8_BAR;
            PG8_LDB(B0, 1, 0); PG8_SCHED; PG8_LDA(At, 1, 0); PG8_STAGE_A(PG8_SA(0, 1), a2, 1, last);
            PG8_WAIT_L(8); PG8_BAR; PG8_WAIT_L(0); PG8_MMA(0, 0, At, B0); PG8_BAR; PG8_SCHED;
            PG8_LDB(B1, 1, 1); PG8_STAGE(PG8_SB(1, 0), b3, voffB);
            PG8_BAR; PG8_WAIT_L(0); PG8_MMA(0, 1, At, B1); PG8_BAR;
            PG8_LDA(At, 1, 1); PG8_STAGE_A(PG8_SA(1, 0), a3, 0, last);
            PG8_BAR; PG8_WAIT_L(0); PG8_MMA(1, 0, At, B0); PG8_BAR; PG8_SCHED;
            PG8_STAGE(PG8_SB(1, 1), b3 + hstepB, voffB);
            PG8_WAIT_V(6); PG8_BAR; PG8_MMA(1, 1, At, B1); PG8_BAR;
            }
        }
        if constexpr (ALIGN_EPI) { if (wr == 0) PG8_BAR; }
        if constexpr (FP8) asm volatile("s_nop 15\n\ts_nop 15\n\ts_nop 7" ::: "memory");
        E(acc, cur, wr, wc, fr, fq);
        if (!has_next) break;
#pragma unroll
        for (int a = 0; a < 2; ++a)
#pragma unroll
            for (int b = 0; b < 2; ++b)
#pragma unroll
                for (int m = 0; m < 4; ++m)
#pragma unroll
                    for (int n = 0; n < 2; ++n) acc[a][b][m][n] = (f32x4){0.f, 0.f, 0.f, 0.f};
        cur = nxt; cA = nA; cB = nB; ++ui;
        if constexpr (GATHER) { _Pragma("unroll") for (int hh_ = 0; hh_ < 2; ++hh_) _Pragma("unroll") for (int i_ = 0; i_ < 2; ++i_) gvC[hh_][i_] = gvN[hh_][i_]; }
        if constexpr (ALIGN_EPI) { if (wr == 1) PG8_BAR; }
    }
    PG8_WAIT_V(0);
    if constexpr (!ALIGN_EPI) { if (wr == 0) PG8_BAR; }
    PG8_BAR;
#undef PG8_SA
#undef PG8_SB
#undef PG8_STAGE
#undef PG8_STAGE_A
#undef PG8_GV
#undef PG8_LDA
#undef PG8_LDB
#undef PG8_MMA
#undef PG8_WAIT_V
#undef PG8_WAIT_L
#undef PG8_BAR
#undef PG8_SCHED
}

struct SchedPlain : Order {
    static constexpr bool GATHER = false; __device__ __forceinline__ unsigned arow(const Unit&, int) const { return 0u; }
    unsigned A0, B0, at, bt;
    __device__ __forceinline__ bool next(int i, Unit& u) const { return next_mn(i, u); }
    __device__ __forceinline__ unsigned A(const Unit& u) const { return A0 + (unsigned)u.pm * at; }
    __device__ __forceinline__ unsigned B(const Unit& u) const { return B0 + (unsigned)u.pn * bt; }
};
struct SchedLora : Order {
    static constexpr bool GATHER = false; __device__ __forceinline__ unsigned arow(const Unit&, int) const { return 0u; }
    unsigned A0, B0; int skipv;
    __device__ __forceinline__ bool next(int i, Unit& u) const { if (!next_mn(i, u)) return false; if (skipv && u.pn >= 12) u.pn += 6; return true; }
    __device__ __forceinline__ unsigned A(const Unit& u) const { return A0 + (unsigned)u.pm * (256u * 512u * 2u) + (u.pn >= 18 ? 512u : 0u); }
    __device__ __forceinline__ unsigned B(const Unit& u) const { return B0 + (unsigned)u.pn * (256u * 256u * 2u); }
};
struct SchedMem {
    static constexpr bool GATHER = false; __device__ __forceinline__ unsigned arow(const Unit&, int) const { return 0u; }
    int G, c; unsigned memb, wkv;
    __device__ __forceinline__ bool next(int i, Unit& u) const {
        const int L = i * G + c; if (L >= 64) return false;
        if (L < 32) { u.z = 0; u.pm = L >> 1; u.pn = L & 1; } else { const int q = L - 32; u.z = 1; u.pm = q & 1; u.pn = q >> 1; }
        return true;
    }
    __device__ __forceinline__ unsigned A(const Unit& u) const { return u.z == 0 ? memb + (unsigned)u.pm * (256u * 2048u * 2u) : wkv + (unsigned)(2 + u.pm) * (256u * 2048u * 2u); }
    __device__ __forceinline__ unsigned B(const Unit& u) const { return u.z == 0 ? wkv + (unsigned)u.pn * (256u * 2048u * 2u) : memb + (unsigned)u.pn * (256u * 2048u * 2u); }
};
struct SchedMoE : Order {
    static constexpr bool GATHER = false; __device__ __forceinline__ unsigned arow(const Unit&, int) const { return 0u; }
    unsigned A0, B0, at, bt, be; const int* texp;
    __device__ __forceinline__ bool next(int i, Unit& u) const { if (!next_mn(i, u)) return false; u.z = __builtin_amdgcn_readfirstlane(texp[u.pm]); return true; }
    __device__ __forceinline__ unsigned A(const Unit& u) const { return A0 + (unsigned)u.pm * at; }
    __device__ __forceinline__ unsigned B(const Unit& u) const { return B0 + (unsigned)u.z * be + (unsigned)u.pn * bt; }
};

struct SchedMoEg : Order {
    static constexpr bool GATHER = true;
    unsigned B0, bt, be, xoff, zoff; const int* texp; const int* slot_tok;
    __device__ __forceinline__ bool next(int i, Unit& u) const { if (!next_mn(i, u)) return false; u.z = __builtin_amdgcn_readfirstlane(texp[u.pm]); return true; }
    __device__ __forceinline__ unsigned A(const Unit&) const { return 0u; }
    __device__ __forceinline__ unsigned B(const Unit& u) const { return B0 + (unsigned)u.z * be + (unsigned)u.pn * bt; }
    __device__ __forceinline__ unsigned arow(const Unit& u, int r) const { const int tok = slot_tok[u.pm * 256 + r]; return tok < 0 ? zoff : xoff + (unsigned)tok * 2048u; }
};

struct EpiBf16 {
    static constexpr bool PERM = true;
    bf16* O; int ldc;
    __device__ __forceinline__ void operator()(const f32x4 (&acc)[2][2][4][2], const Unit& u, int wr, int wc, int fr, int fq) const {
        const int row0 = u.pm * BM + wr * 64 + fr, col0 = u.pn * BM + wc * 32 + 8 * fq;
#pragma unroll
        for (int ai = 0; ai < 2; ++ai)
#pragma unroll
            for (int m = 0; m < 4; ++m) { bf16* rowp = O + (size_t)(row0 + ai * HALF + m * 16) * ldc + col0;
#pragma unroll
                for (int bj = 0; bj < 2; ++bj) { const f32x4 v0 = acc[ai][bj][m][0], v1 = acc[ai][bj][m][1];
                    u32x4 w; w.x = cvt_pk_bf16(v0[0], v0[1]); w.y = cvt_pk_bf16(v0[2], v0[3]); w.z = cvt_pk_bf16(v1[0], v1[1]); w.w = cvt_pk_bf16(v1[2], v1[3]);
                    *(u32x4*)(rowp + bj * HALF) = w; } }
    }
};
struct EpiMem {
    static constexpr bool PERM = true;
    bf16* O0; bf16* O1;
    __device__ __forceinline__ void operator()(const f32x4 (&acc)[2][2][4][2], const Unit& u, int wr, int wc, int fr, int fq) const {
        EpiBf16 e; e.O = u.z == 0 ? O0 : O1; e.ldc = u.z == 0 ? 512 : 4096; e(acc, u, wr, wc, fr, fq);
    }
};
struct EpiLora {
    static constexpr bool PERM = true;
    bf16* O; const float* vecs;
    __device__ __forceinline__ void operator()(const f32x4 (&acc)[2][2][4][2], const Unit& u, int wr, int wc, int fr, int fq) const {
        const int type = u.pn / 6;
        const int row0 = u.pm * BM + wr * 64 + fr, col0 = u.pn * BM + wc * 32 + 8 * fq, cb0 = (u.pn % 6) * BM + wc * 32 + 8 * fq;
        const float* bp = vecs + (type < 3 ? type : 0) * SW;
        const float sc = type == 0 ? 0.6065306597126334f : 1.0f;
#pragma unroll
        for (int bj = 0; bj < 2; ++bj) {
            f32x4 bv0 = (f32x4){0.f, 0.f, 0.f, 0.f}, bv1 = bv0;
            if (type < 3) { bv0 = *(const f32x4*)(bp + cb0 + bj * HALF); bv1 = *(const f32x4*)(bp + cb0 + bj * HALF + 4); }
#pragma unroll
            for (int ai = 0; ai < 2; ++ai)
#pragma unroll
                for (int m = 0; m < 4; ++m) { bf16* rowp = O + (size_t)(row0 + ai * HALF + m * 16) * 6144 + col0 + bj * HALF;
                    f32x4 v0_ = acc[ai][bj][m][0] + bv0, v1_ = acc[ai][bj][m][1] + bv1;
                    if (type < 3) {
#pragma unroll
                        for (int j = 0; j < 4; ++j) { v0_[j] = sc * sigmoidf_(v0_[j]); v1_[j] = sc * sigmoidf_(v1_[j]); } }
                    u32x4 w; w.x = cvt_pk_bf16(v0_[0], v0_[1]); w.y = cvt_pk_bf16(v0_[2], v0_[3]); w.z = cvt_pk_bf16(v1_[0], v1_[1]); w.w = cvt_pk_bf16(v1_[2], v1_[3]);
                    *(u32x4*)rowp = w; asm volatile("" ::: "memory"); }
        }
    }
};
struct EpiSwiglu {
    static constexpr bool PERM = true;
    bf16* O; int ldc;
    __device__ __forceinline__ void operator()(const f32x4 (&acc)[2][2][4][2], const Unit& u, int wr, int wc, int fr, int fq) const {
        const int row0 = u.pm * BM + wr * 64 + fr, col0 = u.pn * HALF + wc * 32 + 8 * fq;
#pragma unroll
        for (int ai = 0; ai < 2; ++ai)
#pragma unroll
            for (int m = 0; m < 4; ++m) { bf16* rowp = O + (size_t)(row0 + ai * HALF + m * 16) * ldc + col0;
                float h[8];
#pragma unroll
                for (int n = 0; n < 2; ++n)
#pragma unroll
                    for (int j = 0; j < 4; ++j) { const float g = acc[ai][0][m][n][j], up = acc[ai][1][m][n][j]; h[n * 4 + j] = g * sigmoidf_(g) * up; }
                u32x4 w; w.x = cvt_pk_bf16(h[0], h[1]); w.y = cvt_pk_bf16(h[2], h[3]); w.z = cvt_pk_bf16(h[4], h[5]); w.w = cvt_pk_bf16(h[6], h[7]);
                *(u32x4*)rowp = w; asm volatile("" ::: "memory"); }
    }
};
struct EpiSwiglu8 {
    static constexpr bool PERM = true;
    unsigned char* O; int ldc; float inv, so;
    __device__ __forceinline__ void operator()(const f32x4 (&acc)[2][2][4][2], const Unit& u, int wr, int wc, int fr, int fq) const {
        const int row0 = u.pm * BM + wr * 64 + fr, col0 = u.pn * HALF + wc * 32 + 8 * fq;
        const float c1 = -inv * 1.4426950408889634f, c2 = inv * inv * so;
#pragma unroll
        for (int ai = 0; ai < 2; ++ai)
#pragma unroll
            for (int m = 0; m < 4; ++m) { unsigned char* rowp = O + (size_t)(row0 + ai * HALF + m * 16) * ldc + col0;
                float h[8];
#pragma unroll
                for (int n = 0; n < 2; ++n)
#pragma unroll
                    for (int j = 0; j < 4; ++j) { const float ag = acc[ai][0][m][n][j], au = acc[ai][1][m][n][j];
                        h[n * 4 + j] = (ag * au) * __builtin_amdgcn_rcpf(1.0f + __builtin_amdgcn_exp2f(ag * c1)) * c2; }
                u32x2 w; w.x = pk4_fp8(h[0], h[1], h[2], h[3]); w.y = pk4_fp8(h[4], h[5], h[6], h[7]);
                *(u32x2*)rowp = w; asm volatile("" ::: "memory"); }
    }
};
struct EpiBf16S {
    static constexpr bool PERM = true;
    bf16* O; int ldc; float sc;
    __device__ __forceinline__ void operator()(const f32x4 (&acc)[2][2][4][2], const Unit& u, int wr, int wc, int fr, int fq) const {
        const int row0 = u.pm * BM + wr * 64 + fr, col0 = u.pn * BM + wc * 32 + 8 * fq;
#pragma unroll
        for (int ai = 0; ai < 2; ++ai)
#pragma unroll
            for (int m = 0; m < 4; ++m) { bf16* rowp = O + (size_t)(row0 + ai * HALF + m * 16) * ldc + col0;
#pragma unroll
                for (int bj = 0; bj < 2; ++bj) { const f32x4 v0 = acc[ai][bj][m][0] * sc, v1 = acc[ai][bj][m][1] * sc;
                    u32x4 w; w.x = cvt_pk_bf16(v0[0], v0[1]); w.y = cvt_pk_bf16(v0[2], v0[3]); w.z = cvt_pk_bf16(v1[0], v1[1]); w.w = cvt_pk_bf16(v1[2], v1[3]);
                    *(u32x4*)(rowp + bj * HALF) = w; } }
    }
};
struct EpiFp8S {
    static constexpr bool PERM = true;
    unsigned char* O; int ldc; float sc;
    __device__ __forceinline__ void operator()(const f32x4 (&acc)[2][2][4][2], const Unit& u, int wr, int wc, int fr, int fq) const {
        const int row0 = u.pm * BM + wr * 64 + fr, col0 = u.pn * BM + wc * 32 + 8 * fq;
#pragma unroll
        for (int ai = 0; ai < 2; ++ai)
#pragma unroll
            for (int m = 0; m < 4; ++m) { unsigned char* rowp = O + (size_t)(row0 + ai * HALF + m * 16) * ldc + col0;
#pragma unroll
                for (int bj = 0; bj < 2; ++bj) { const f32x4 v0 = acc[ai][bj][m][0] * sc, v1 = acc[ai][bj][m][1] * sc;
                    u32x2 w; w.x = pk4_fp8(v0[0], v0[1], v0[2], v0[3]); w.y = pk4_fp8(v1[0], v1[1], v1[2], v1[3]);
                    *(u32x2*)(rowp + bj * HALF) = w; } }
    }
};
struct EpiRes {
    static constexpr bool PERM = false;
    const float* X; float* T;
    __device__ __forceinline__ void operator()(const f32x4 (&acc)[2][2][4][2], const Unit& u, int wr, int wc, int fr, int fq) const {
        const int row0 = u.pm * BM + wr * 64 + fr, col0 = u.pn * BM + wc * 32 + 4 * fq;
#pragma unroll
        for (int ai = 0; ai < 2; ++ai)
#pragma unroll
            for (int m = 0; m < 4; ++m) { const size_t off = (size_t)(row0 + ai * HALF + m * 16) * D + col0;
#pragma unroll
                for (int bj = 0; bj < 2; ++bj)
#pragma unroll
                    for (int n = 0; n < 2; ++n) { const f32x4 xv = *(const f32x4*)(X + off + bj * HALF + n * 16);
                        *(f32x4*)(T + off + bj * HALF + n * 16) = xv * ALPHA + acc[ai][bj][m][n]; } }
    }
};
}

struct Args {
    const float* in[43];
    float* out; unsigned char* ws;
    int ph_lo, ph_hi;
};
struct Ctx { LAS unsigned char* lds; int tid, lane, wave, bid, G, gw, NGW; unsigned char* ws; };

enum { I_X = 0, I_MEM = 1, I_POS = 2, I_WKV = 3,
       L0_WIN = 4, L0_MU, L0_LW, L0_LA, L0_LG, L0_VECS, L0_WOUT, L0_NORMS, L0_FG, L0_FU, L0_FD,
       L1_WIN = 15, L1_GN, L1_WOUT, L1_NORMS, L1_ROUTER, L1_MG, L1_MU_, L1_MD,
       L2_WIN = 23, L2_MU, L2_LW, L2_LA, L2_LV, L2_LG, L2_VECS, L2_WOUT, L2_NORMS, L2_FG, L2_FU, L2_FD,
       L3_WIN = 35, L3_GN, L3_WOUT, L3_NORMS, L3_ROUTER, L3_MG, L3_MU_, L3_MD };

__device__ __forceinline__ void tr_load(f32x4 (&v)[8], const float* W, int ldw, int k0, int n0, int lane) {
#pragma unroll
    for (int i = 0; i < 8; ++i) v[i] = *(const f32x4*)(W + (size_t)(k0 + 8 * i + (lane >> 3)) * ldw + n0 + 4 * (lane & 7));
}
__device__ __forceinline__ void tr_store(const f32x4 (&v)[8], int k0, bf16* WT, int ldt, int drow0, LAS float* scr, int lane) {
#pragma unroll
    for (int i = 0; i < 8; ++i) { LAS float* d = scr + (8 * i + (lane >> 3)) * 33 + 4 * (lane & 7); d[0] = v[i][0]; d[1] = v[i][1]; d[2] = v[i][2]; d[3] = v[i][3]; }
    LDS_WAIT(); asm volatile("" ::: "memory");
    const int c = lane & 7;
#pragma unroll
    for (int j = 0; j < 4; ++j) { const int n = (lane >> 3) + 8 * j; const LAS float* s = scr + (8 * c) * 33 + n;
        u32x4 o; o.x = cvt_pk_bf16(s[0 * 33], s[1 * 33]); o.y = cvt_pk_bf16(s[2 * 33], s[3 * 33]); o.z = cvt_pk_bf16(s[4 * 33], s[5 * 33]); o.w = cvt_pk_bf16(s[6 * 33], s[7 * 33]);
        *(u32x4*)(WT + (size_t)(drow0 + n) * ldt + k0 + 8 * c) = o; }
    LDS_WAIT(); asm volatile("" ::: "memory");
}
__device__ __forceinline__ void conv_mat(const Ctx& C, const float* W, int K, int N, bf16* WT, int mode, int off, int gw0) {
    LAS float* scr = (LAS float*)(C.lds + C.wave * 16384);
    const int nblk = N / 32, items = (K / 64) * nblk;
    int start = C.gw - gw0; if (start < 0) start += C.NGW;
#define CONV_DROW(n0_) (mode == 0 ? off + (n0_) : ((n0_) / 128) * 256 + off + ((n0_) % 128))
    f32x4 va[8], vb[8];
    int it = start;
    if (it < items) tr_load(va, W, N, 64 * (it / nblk), 32 * (it % nblk), C.lane);
    while (it < items) {
        const int it1 = it + C.NGW;
        if (it1 < items) tr_load(vb, W, N, 64 * (it1 / nblk), 32 * (it1 % nblk), C.lane);
        tr_store(va, 64 * (it / nblk), WT, K, CONV_DROW(32 * (it % nblk)), scr, C.lane);
        if (it1 >= items) break;
        const int it2 = it1 + C.NGW;
        if (it2 < items) tr_load(va, W, N, 64 * (it2 / nblk), 32 * (it2 % nblk), C.lane);
        tr_store(vb, 64 * (it1 / nblk), WT, K, CONV_DROW(32 * (it1 % nblk)), scr, C.lane);
        it = it2;
    }
#undef CONV_DROW
}
__device__ __forceinline__ void conv_lora(const Ctx& C, const float* lw, const float* la, const float* lv, const float* lg, bf16* Bt) {
    for (int idx = C.bid * NTHR + C.tid; idx < 6144 * 256; idx += C.G * NTHR) {
        const int n_ = idx % 1536, rest = idx / 1536, k = rest % 256, blk = rest / 256;
        float v = 0.f;
        if (blk == 0) { if (k < 96) v = lw[k * 1536 + n_]; }
        else if (blk == 1) { if (k >= 96 && k < 192) v = la[(k - 96) * 1536 + n_]; }
        else if (blk == 2) { if (lv && k >= 192) v = lv[(k - 192) * 1536 + n_]; }
        else v = lg[k * 1536 + n_];
        Bt[(size_t)(blk * 1536 + n_) * 256 + k] = f2bf(v);
    }
}
__device__ __forceinline__ void conv_f32_bf16(const Ctx& C, const float* src, bf16* dst, size_t n8) {
    const size_t T = (size_t)C.G * NTHR;
    for (size_t i0 = (size_t)C.bid * NTHR + C.tid; i0 < n8; i0 += 4 * T) { f32x4 av[4], bv[4];
#pragma unroll
        for (int q = 0; q < 4; ++q) { av[q] = ((const f32x4*)src)[2 * (i0 + q * T)]; bv[q] = ((const f32x4*)src)[2 * (i0 + q * T) + 1]; }
#pragma unroll
        for (int q = 0; q < 4; ++q) { const f32x4 a = av[q], b = bv[q];
            u32x4 w; w.x = cvt_pk_bf16(a[0], a[1]); w.y = cvt_pk_bf16(a[2], a[3]); w.z = cvt_pk_bf16(b[0], b[1]); w.w = cvt_pk_bf16(b[2], b[3]);
            ((u32x4*)dst)[i0 + q * T] = w; } }
}

struct CvJob { const float* W; bf16* WT; int N, K, k0, n0, mode, off; float f8s; };
__device__ __forceinline__ void cv_load(f32x4 (&v)[8], const CvJob& J, int wave, int lane) {
    const int n = J.n0 + 4 * lane;
#pragma unroll
    for (int i = 0; i < 8; ++i) { v[i] = (f32x4){0.f, 0.f, 0.f, 0.f}; if (n < J.N) v[i] = *(const f32x4*)(J.W + (size_t)(J.k0 + 8 * wave + i) * J.N + n); }
}
__device__ __forceinline__ void cv_put(const f32x4 (&v)[8], LAS float* T, int wave, int lane) {
#pragma unroll
    for (int i = 0; i < 8; ++i) *(LAS f32x4*)(T + (8 * wave + i) * 256 + 4 * (lane ^ wave)) = v[i];
}
__device__ __forceinline__ void cv_out(const CvJob& J, const LAS float* T, int wave, int lane) {
    const int c = lane & 7;
#pragma unroll
    for (int j = 0; j < 4; ++j) { const int nl = 32 * wave + 8 * j + (lane >> 3), n = J.n0 + nl; const LAS float* s = T + (8 * c) * 256 + (nl ^ (c << 2));
        u32x4 o; o.x = cvt_pk_bf16(s[0 * 256], s[1 * 256]); o.y = cvt_pk_bf16(s[2 * 256], s[3 * 256]); o.z = cvt_pk_bf16(s[4 * 256], s[5 * 256]); o.w = cvt_pk_bf16(s[6 * 256], s[7 * 256]);
        if (n < J.N) { const int drow = J.mode == 0 ? J.off + n : (n / 128) * 256 + J.off + (n % 128);
            *(u32x4*)(J.WT + (size_t)drow * J.K + J.k0 + 8 * c) = o; } }
}
__device__ __forceinline__ void cv_out8(const CvJob& J, const LAS float* T, int wave, int lane) {
    const int c4 = lane & 3; unsigned char* W8 = (unsigned char*)J.WT;
#pragma unroll
    for (int j = 0; j < 2; ++j) { const int nl = 32 * wave + 16 * j + (lane >> 2), n = J.n0 + nl;
        float v[16];
#pragma unroll
        for (int q = 0; q < 16; ++q) { const int k = 16 * c4 + q; v[q] = T[k * 256 + (nl ^ (((k >> 3) & 7) << 2))] * J.f8s; }
        u32x4 o; o.x = pk4_fp8(v[0], v[1], v[2], v[3]); o.y = pk4_fp8(v[4], v[5], v[6], v[7]); o.z = pk4_fp8(v[8], v[9], v[10], v[11]); o.w = pk4_fp8(v[12], v[13], v[14], v[15]);
        if (n < J.N) { const int drow = J.mode == 0 ? J.off + n : (n / 128) * 256 + J.off + (n % 128);
            *(u32x4*)(W8 + (size_t)drow * J.K + J.k0 + 16 * c4) = o; } }
}
template <class Dec>
__device__ __forceinline__ void conv_run(const Ctx& C, int ntiles, const Dec& dec, const int t0 = -1, const int STR = GRID) {
    LAS float* T = (LAS float*)C.lds;
    f32x4 va[8], vb[8]; CvJob ja, jb, jc;
    int t = t0 < 0 ? C.bid : t0;
    if (t < ntiles) { dec(t, ja); cv_load(va, ja, C.wave, C.lane); }
    if (t + STR < ntiles) { dec(t + STR, jb); cv_load(vb, jb, C.wave, C.lane); }
    while (t < ntiles) {
        __syncthreads(); cv_put(va, T, C.wave, C.lane); jc = ja;
        if (t + 2 * STR < ntiles) { dec(t + 2 * STR, ja); cv_load(va, ja, C.wave, C.lane); }
        __syncthreads(); if (jc.f8s > 0.f) cv_out8(jc, T, C.wave, C.lane); else cv_out(jc, T, C.wave, C.lane);
        t += STR; if (t >= ntiles) break;
        __syncthreads(); cv_put(vb, T, C.wave, C.lane); jc = jb;
        if (t + 2 * STR < ntiles) { dec(t + 2 * STR, jb); cv_load(vb, jb, C.wave, C.lane); }
        __syncthreads(); if (jc.f8s > 0.f) cv_out8(jc, T, C.wave, C.lane); else cv_out(jc, T, C.wave, C.lane);
        t += STR;
    }
    __syncthreads();
}
struct MoeDec { const float* mg; const float* mu; const float* md; unsigned char* ws;
    __device__ __forceinline__ void operator()(int t, CvJob& J) const {
        const int j = t / 704, r = t % 704, e = j / 3, kind = j % 3;
        if (kind < 2) { J.W = (kind == 0 ? mg : mu) + (size_t)e * 2048 * 5632; J.WT = (bf16*)(ws + WS_MWGU + (size_t)e * 22 * MiB); J.N = 5632; J.K = 2048; J.mode = 1; J.off = kind * 128; J.f8s = 1024.f; J.k0 = 64 * (r / 22); J.n0 = 256 * (r % 22); }
        else { J.W = md + (size_t)e * 2048 * 5632; J.WT = (bf16*)(ws + WS_MWD + (size_t)e * 11 * MiB); J.N = 2048; J.K = 5632; J.mode = 0; J.off = 0; J.f8s = 2048.f; J.k0 = 64 * (r / 8); J.n0 = 256 * (r % 8); }
    } };
struct StaticDec { const float* const* in; unsigned char* ws;
    __device__ __forceinline__ void set(CvJob& J, const float* W, bf16* WT, int K, int N, int mode, int off, int r, float f8s = 0.f) const {
        const int nn = (N + 255) / 256; J.W = W; J.WT = WT; J.N = N; J.K = K; J.mode = mode; J.off = off; J.f8s = f8s; J.k0 = 64 * (r / nn); J.n0 = 256 * (r % nn); }
    __device__ __forceinline__ void operator()(int t, CvJob& J) const {
        int r = t;
        if (r < 128) { set(J, in[I_WKV], (bf16*)(ws + WS_WKV), 2048, 1024, 0, 0, r); return; } r -= 128;
        set(J, in[L0_WIN], (bf16*)(ws + WS_WIN), 2048, 5568, 0, 0, r);
    } };

struct SlotDec { const float* const* in; unsigned char* ws; int lq; MoeDec moe; StaticDec sd;
    __device__ __forceinline__ void operator()(int t, CvJob& J) const {
        if (t < 16896) { moe(t, J); return; }
        int r = t - 16896; const size_t l = (size_t)lq;
        if (r < 704) { sd.set(J, lq ? in[L2_FG] : in[L0_FG], (bf16*)(ws + WS_WFGU + l * 44 * MiB), 2048, 5632, 1, 0, r, 1024.f); return; } r -= 704;
        if (r < 704) { sd.set(J, lq ? in[L2_FU] : in[L0_FU], (bf16*)(ws + WS_WFGU + l * 44 * MiB), 2048, 5632, 1, 128, r, 1024.f); return; } r -= 704;
        if (r < 704) { sd.set(J, lq ? in[L2_FD] : in[L0_FD], (bf16*)(ws + WS_WFD + l * 22 * MiB), 5632, 2048, 0, 0, r, 2048.f); return; } r -= 704;
        if (r < 256) { sd.set(J, lq ? in[L2_WOUT] : in[L0_WOUT], (bf16*)(ws + WS_WOUT + l * 16 * MiB), 2048, 2048, 0, 0, r); return; } r -= 256;
        if (r < 256) { sd.set(J, lq ? in[L3_WOUT] : in[L1_WOUT], (bf16*)(ws + WS_WOUT + (l * 16 + 8) * MiB), 2048, 2048, 0, 0, r); return; } r -= 256;
        if (r < 640) { sd.set(J, lq ? in[L3_WIN] : in[L1_WIN], (bf16*)(ws + WS_WIN + (l * 44 + 22) * MiB), 2048, 5120, 0, 0, r); return; } r -= 640;
        sd.set(J, in[L2_WIN], (bf16*)(ws + WS_WIN + (size_t)44 * MiB), 2048, 5632, 0, 0, r);
    } };

__device__ __forceinline__ void ph_prologue(const Ctx& C, const Args& A) {
    unsigned char* ws = C.ws;
    { StaticDec dec; dec.in = A.in; dec.ws = ws; conv_run(C, 832, dec); }
    conv_lora(C, A.in[L0_LW], A.in[L0_LA], nullptr, A.in[L0_LG], (bf16*)(ws + WS_WLORA));
    conv_lora(C, A.in[L2_LW], A.in[L2_LA], A.in[L2_LV], A.in[L2_LG], (bf16*)(ws + WS_WLORA + 3 * MiB));
    { u32x4* z = (u32x4*)(ws + WS_WIN + (size_t)5568 * 2048 * 2);
      for (int i = C.bid * NTHR + C.tid; i < 64 * 2048 * 2 / 16; i += C.G * NTHR) z[i] = (u32x4){0u, 0u, 0u, 0u}; }
    { const f32x4* xs = (const f32x4*)A.in[I_X]; u32x2* hi = (u32x2*)(ws + WS_XB); unsigned* lo = (unsigned*)(ws + WS_XLO);
      const size_t T = (size_t)C.G * NTHR;
      for (size_t i0 = (size_t)C.bid * NTHR + C.tid; i0 < (size_t)M * D / 4; i0 += 8 * T) { f32x4 ov[8];
#pragma unroll
          for (int q = 0; q < 8; ++q) ov[q] = xs[i0 + q * T];
#pragma unroll
          for (int q = 0; q < 8; ++q) { const f32x4 o = ov[q]; const size_t i = i0 + q * T;
              u32x2 w; w.x = cvt_pk_bf16(o[0], o[1]); w.y = cvt_pk_bf16(o[2], o[3]); hi[i] = w;
              lo[i] = pk4_fp8((o[0] - bflo(w.x)) * 8192.f, (o[1] - bfhi(w.x)) * 8192.f, (o[2] - bflo(w.y)) * 8192.f, (o[3] - bfhi(w.y)) * 8192.f); } } }
    conv_f32_bf16(C, A.in[I_MEM], (bf16*)(ws + WS_MEMB), (size_t)4096 * 2048 / 8);
    { const int* pos = (const int*)A.in[I_POS]; f32x2* cs = (f32x2*)(ws + WS_CS);
      for (int idx = C.bid * NTHR + C.tid; idx < M * 64; idx += C.G * NTHR) {
          const int m = idx >> 6, i = idx & 63;
          const float pw = (float)exp2(13.287712379549449 * (double)i / 64.0);
          const float inv = 1.0f / pw;
          const float ang = (float)pos[m] * inv;
          const double x = (double)ang;
          const double n = rint(x * 0.15915494309189535);
          const double r = fma(-n, 6.283185307179586, x) - n * 2.4492935982947064e-16;
          const double r2 = r * r;
          double s = -1.0 / 121645100408832000.0;
          s = fma(s, r2, 1.0 / 355687428096000.0);
          s = fma(s, r2, -1.0 / 1307674368000.0);
          s = fma(s, r2, 1.0 / 6227020800.0);
          s = fma(s, r2, -1.0 / 39916800.0);
          s = fma(s, r2, 1.0 / 362880.0);
          s = fma(s, r2, -1.0 / 5040.0);
          s = fma(s, r2, 1.0 / 120.0);
          s = fma(s, r2, -1.0 / 6.0);
          s = fma(s * r2, r, r);
          double c = 1.0 / 2432902008176640000.0;
          c = fma(c, r2, -1.0 / 6402373705728000.0);
          c = fma(c, r2, 1.0 / 20922789888000.0);
          c = fma(c, r2, -1.0 / 87178291200.0);
          c = fma(c, r2, 1.0 / 479001600.0);
          c = fma(c, r2, -1.0 / 3628800.0);
          c = fma(c, r2, 1.0 / 40320.0);
          c = fma(c, r2, -1.0 / 720.0);
          c = fma(c, r2, 1.0 / 24.0);
          c = fma(c, r2, -0.5);
          c = fma(c, r2, 1.0);
          cs[idx] = (f32x2){(float)c, (float)s};
      } }
}

struct LnRow { u32x2 rh[8]; unsigned rl[8]; u32x2 a[8]; float w1, w2; };
__device__ __forceinline__ void ln_load(LnRow& R, const Ctx& C, int m, const void* Hp, int hmode, int s1, int s2, float w1, float w2) {
    const u32x2* hr = (const u32x2*)(C.ws + WS_XB + (size_t)m * D * 2) + C.lane;
    const unsigned* lr = (const unsigned*)(C.ws + (hmode == 0 ? WS_XLO : WS_X8) + (size_t)m * D) + C.lane;
#pragma unroll
    for (int j = 0; j < 8; ++j) { R.rh[j] = hr[64 * j]; R.rl[j] = lr[64 * j]; }
    if (hmode == 0) {
        const u32x2* ar = (const u32x2*)((const bf16*)Hp + (size_t)m * D) + C.lane;
#pragma unroll
        for (int j = 0; j < 8; ++j) R.a[j] = ar[64 * j];
        R.w1 = 1.f; R.w2 = 0.f;
    } else if (hmode == 1) {
        const unsigned* ar = (const unsigned*)((const unsigned char*)Hp + (size_t)m * D) + C.lane;
#pragma unroll
        for (int j = 0; j < 8; ++j) { R.a[j].x = ar[64 * j]; R.a[j].y = 0u; }
        R.w1 = 1.f / 256.f; R.w2 = 0.f;
    } else {
        R.w1 = w1; R.w2 = w2;
        const unsigned* y1 = (const unsigned*)((const unsigned char*)Hp + (size_t)s1 * D) + C.lane;
        const unsigned* y2 = (const unsigned*)((const unsigned char*)Hp + (size_t)s2 * D) + C.lane;
#pragma unroll
        for (int j = 0; j < 8; ++j) { R.a[j].x = y1[64 * j]; R.a[j].y = y2[64 * j]; }
    }
}
__device__ __forceinline__ void ln_row(const LnRow& R, const Ctx& C, int m, const LAS float* gb, int hmode, float* Xf32out, unsigned char* X8out,
                                       LAS float* rw, LAS int* hist, bool do_route) {
    const int l4 = 4 * C.lane;
    f32x4 v[8]; float s = 0.f;
#pragma unroll
    for (int j = 0; j < 8; ++j) { f32x4 f, x;
        const f32x2 l01 = __builtin_amdgcn_cvt_pk_f32_fp8(R.rl[j], false), l23 = __builtin_amdgcn_cvt_pk_f32_fp8(R.rl[j], true);
        const float ls = hmode == 0 ? (1.f / 8192.f) : (1.f / 16.f);
        x[0] = bflo(R.rh[j].x) + l01[0] * ls; x[1] = bfhi(R.rh[j].x) + l01[1] * ls; x[2] = bflo(R.rh[j].y) + l23[0] * ls; x[3] = bfhi(R.rh[j].y) + l23[1] * ls;
        if (hmode == 0) { f[0] = bflo(R.a[j].x); f[1] = bfhi(R.a[j].x); f[2] = bflo(R.a[j].y); f[3] = bfhi(R.a[j].y); }
        else { const f32x2 a01 = __builtin_amdgcn_cvt_pk_f32_fp8(R.a[j].x, false), a23 = __builtin_amdgcn_cvt_pk_f32_fp8(R.a[j].x, true);
            f[0] = R.w1 * a01[0]; f[1] = R.w1 * a01[1]; f[2] = R.w1 * a23[0]; f[3] = R.w1 * a23[1];
            if (hmode == 2) { const f32x2 b01 = __builtin_amdgcn_cvt_pk_f32_fp8(R.a[j].y, false), b23 = __builtin_amdgcn_cvt_pk_f32_fp8(R.a[j].y, true);
                f[0] += R.w2 * b01[0]; f[1] += R.w2 * b01[1]; f[2] += R.w2 * b23[0]; f[3] += R.w2 * b23[1]; } }
        v[j] = x * ALPHA + f; s += (v[j][0] + v[j][1]) + (v[j][2] + v[j][3]); }
    const float mean = wave_sum(s) * (1.f / D); float s2 = 0.f;
#pragma unroll
    for (int j = 0; j < 8; ++j) { v[j] = v[j] - mean; s2 += (v[j][0] * v[j][0] + v[j][1] * v[j][1]) + (v[j][2] * v[j][2] + v[j][3] * v[j][3]); }
    const float rstd = 1.0f / sqrtf(wave_sum(s2) * (1.f / D) + LN_EPS);
    float lg[8];
#pragma unroll
    for (int e = 0; e < 8; ++e) lg[e] = 0.f;
    u32x2* ho = (u32x2*)(C.ws + WS_XB + (size_t)m * D * 2) + C.lane;
    unsigned* lo = (unsigned*)(C.ws + WS_XLO + (size_t)m * D) + C.lane;
#pragma unroll
    for (int j = 0; j < 8; ++j) {
        const f32x4 gv = *((const LAS f32x4*)(gb + 256 * j + l4)), bv = *((const LAS f32x4*)(gb + 2048 + 256 * j + l4));
        const f32x4 o = v[j] * rstd * gv + bv;
        if (Xf32out) ((f32x4*)(Xf32out + (size_t)m * D))[64 * j + C.lane] = o;
        else if (X8out) {
            const unsigned p8 = pk4_fp8(o[0] * 16.f, o[1] * 16.f, o[2] * 16.f, o[3] * 16.f);
            ((unsigned*)(X8out + (size_t)m * D))[64 * j + C.lane] = p8;
            const f32x2 d01 = __builtin_amdgcn_cvt_pk_f32_fp8(p8, false), d23 = __builtin_amdgcn_cvt_pk_f32_fp8(p8, true);
            u32x2 w; w.x = cvt_pk_bf16(o[0] - d01[0] * (1.f / 16.f), o[1] - d01[1] * (1.f / 16.f)); w.y = cvt_pk_bf16(o[2] - d23[0] * (1.f / 16.f), o[3] - d23[1] * (1.f / 16.f)); ho[64 * j] = w; }
        else { u32x2 w; w.x = cvt_pk_bf16(o[0], o[1]); w.y = cvt_pk_bf16(o[2], o[3]); ho[64 * j] = w;
            lo[64 * j] = pk4_fp8((o[0] - bflo(w.x)) * 8192.f, (o[1] - bfhi(w.x)) * 8192.f, (o[2] - bflo(w.y)) * 8192.f, (o[3] - bfhi(w.y)) * 8192.f); }
        if (do_route) {
#pragma unroll
            for (int e = 0; e < 8; ++e) { const f32x4 we = *(const LAS f32x4*)(rw + e * 2048 + 256 * j + l4);
                lg[e] += (o[0] * we[0] + o[1] * we[1]) + (o[2] * we[2] + o[3] * we[3]); }
        }
    }
    if (do_route) {
#pragma unroll
        for (int e = 0; e < 8; ++e) lg[e] = wave_sum(lg[e]);
        int e1 = 0; float v1 = lg[0];
#pragma unroll
        for (int e = 1; e < 8; ++e) if (lg[e] > v1) { v1 = lg[e]; e1 = e; }
        int e2 = -1; float v2 = -3.0e38f;
#pragma unroll
        for (int e = 0; e < 8; ++e) if (e != e1 && lg[e] > v2) { v2 = lg[e]; e2 = e; }
        const float ex = __expf(v2 - v1); const float w1 = 1.0f / (1.0f + ex), w2 = ex / (1.0f + ex);
        if (C.lane == 0) { f32x4 rt; rt[0] = __int_as_float(e1 | (e2 << 8)); rt[1] = w1; rt[2] = w2; rt[3] = 0.f; ((f32x4*)(C.ws + WS_ROUTE))[m] = rt;
            atomicAdd((int*)&hist[e1], 1); atomicAdd((int*)&hist[e2], 1); }
    }
}
__device__ __forceinline__ void ph_ln(const Ctx& C, const void* Hp, int hmode, const float* gain, const float* bias, float* Xf32out, unsigned char* X8out,
                                      const float* router, bool do_route) {
    unsigned char* ws = C.ws;
    LAS float* rw = (LAS float*)C.lds;
    LAS int* hist = (LAS int*)(C.lds + LDS_MISC + 64);
    LAS float* gb = (LAS float*)(C.lds + 65536);
    ((LAS f32x4*)gb)[C.tid] = ((const f32x4*)gain)[C.tid]; ((LAS f32x4*)gb)[512 + C.tid] = ((const f32x4*)bias)[C.tid];
    if (!do_route) __syncthreads();
    if (do_route) {
        for (int col = C.tid; col < 2048; col += NTHR) { const f32x4 a = ((const f32x4*)router)[2 * col], b = ((const f32x4*)router)[2 * col + 1];
            rw[0 * 2048 + col] = a[0]; rw[1 * 2048 + col] = a[1]; rw[2 * 2048 + col] = a[2]; rw[3 * 2048 + col] = a[3]; rw[4 * 2048 + col] = b[0]; rw[5 * 2048 + col] = b[1]; rw[6 * 2048 + col] = b[2]; rw[7 * 2048 + col] = b[3]; }
        if (C.tid < 8) hist[C.tid] = 0;
        int* st = (int*)(ws + WS_SLOTTOK);
        for (int i = C.bid * NTHR + C.tid; i < NSLOT; i += C.G * NTHR) st[i] = -1;
        __syncthreads();
    }
    const int m0 = C.bid * 128 + C.wave * 16;
    LnRow Ra, Rb;
    int s1v = 0, s2v = 0, w1v = 0, w2v = 0;
    if (hmode == 2) { const int mr = m0 + (C.lane & 15); const f32x4 rt = ((const f32x4*)(ws + WS_ROUTE))[mr];
        s1v = ((const int*)(ws + WS_SLOT1))[mr]; s2v = ((const int*)(ws + WS_SLOT2))[mr]; w1v = __float_as_int(rt[1] * (1.f / 256.f)); w2v = __float_as_int(rt[2] * (1.f / 256.f)); }
#define LN_LOAD(R_, r_) ln_load(R_, C, m0 + (r_), Hp, hmode, __builtin_amdgcn_readlane(s1v, (r_)), __builtin_amdgcn_readlane(s2v, (r_)), __int_as_float(__builtin_amdgcn_readlane(w1v, (r_))), __int_as_float(__builtin_amdgcn_readlane(w2v, (r_))))
    LN_LOAD(Ra, 0);
#pragma unroll 1
    for (int r = 0; r < 16; r += 2) {
        LN_LOAD(Rb, r + 1);
        ln_row(Ra, C, m0 + r, gb, hmode, Xf32out, X8out, rw, hist, do_route);
        if (r + 2 < 16) LN_LOAD(Ra, r + 2);
        ln_row(Rb, C, m0 + r + 1, gb, hmode, Xf32out, X8out, rw, hist, do_route);
    }
#undef LN_LOAD
    if (do_route) { __syncthreads(); if (C.tid < 8) ((int*)(ws + WS_CTL))[CW_CNT + C.bid * 8 + C.tid] = hist[C.tid]; }
}

__device__ __forceinline__ void ph_slots(const Ctx& C) {
    unsigned char* ws = C.ws;
    LAS int* sm = (LAS int*)(C.lds + LDS_MISC + 128);
    const int* cnt = (const int*)(ws + WS_CTL) + CW_CNT;
    if (C.tid < 8) { int tot = 0, mine = 0; for (int b = 0; b < C.G; ++b) { const int c = cnt[b * 8 + C.tid]; if (b < C.bid) mine += c; tot += c; } sm[C.tid] = tot; sm[8 + C.tid] = mine; }
    __syncthreads();
    if (C.tid == 0) { int base = 0; for (int e = 0; e < 8; ++e) { sm[16 + e] = base; base += (sm[e] + 255) & ~255; } sm[24] = base >> 8; }
    __syncthreads();
    if (C.wave == 0) {
        int off[8];
#pragma unroll
        for (int e = 0; e < 8; ++e) off[e] = sm[16 + e] + sm[8 + e];
        const unsigned long long lt = (1ull << C.lane) - 1ull;
        for (int it = 0; it < 2; ++it) {
            const int m = C.bid * 128 + it * 64 + C.lane;
            const int ee = __float_as_int(((const f32x4*)(ws + WS_ROUTE))[m][0]); const int e1 = ee & 0xff, e2 = (ee >> 8) & 0xff;
            int s1 = 0, s2 = 0;
#pragma unroll
            for (int e = 0; e < 8; ++e) { const unsigned long long m1 = __ballot(e1 == e), m2 = __ballot(e2 == e);
                const int c1 = __popcll(m1), c2 = __popcll(m2);
                if (e1 == e) s1 = off[e] + __popcll(m1 & lt);
                if (e2 == e) s2 = off[e] + c1 + __popcll(m2 & lt);
                off[e] += c1 + c2; }
            ((int*)(ws + WS_SLOT1))[m] = s1; ((int*)(ws + WS_SLOT2))[m] = s2;
            int* st = (int*)(ws + WS_SLOTTOK); st[s1] = m; st[s2] = m;
        }
    }
    if (C.bid == 0) {
        int* ctl = (int*)(ws + WS_CTL);
        if (C.tid == 0) ctl[CW_NT] = sm[24];
        if (C.tid < 264) { int e = 0;
#pragma unroll
            for (int q = 1; q < 8; ++q) if (C.tid >= (sm[16 + q] >> 8)) e = q;
            ctl[CW_TEXP + C.tid] = e; }
    }
}
__device__ __forceinline__ void ph_gather(const Ctx& C) {
    unsigned char* ws = C.ws;
    const int* st = (const int*)(ws + WS_SLOTTOK); const u32x4* xb = (const u32x4*)(ws + WS_XB); u32x4* xp = (u32x4*)(ws + WS_XPERM);
    for (int s = C.gw; s < NSLOT; s += C.NGW) { const int tok = st[s];
#pragma unroll
        for (int j = 0; j < 2; ++j) { u32x4 v = xb[(size_t)(tok < 0 ? 0 : tok) * 128 + j * 64 + C.lane]; const unsigned k = tok < 0 ? 0u : 0xffffffffu; v.x &= k; v.y &= k; v.z &= k; v.w &= k; xp[(size_t)s * 128 + j * 64 + C.lane] = v; } }
}
__device__ __forceinline__ void ph_moe_wconv(const Ctx& C, const float* mg, const float* mu, const float* md, const float* const* in, int lq) {
    SlotDec dec; dec.in = in; dec.ws = C.ws; dec.lq = lq; dec.moe.mg = mg; dec.moe.mu = mu; dec.moe.md = md; dec.moe.ws = C.ws; dec.sd.in = in; dec.sd.ws = C.ws;
    conv_run(C, lq ? 20160 : 20864, dec, C.bid - 192, 64);
}

__device__ __forceinline__ void ph_memattn(const Ctx& C, const bf16* P, int ldp, int qm0) {
    unsigned char* ws = C.ws;
    const bf16* memK = (const bf16*)(ws + WS_MEMK); const bf16* memVT = (const bf16*)(ws + WS_MEMVT); bf16* mix = (bf16*)(ws + WS_MIX);
    const int g = C.lane >> 4, r16 = C.lane & 15;
    LAS unsigned char* LK = C.lds; LAS unsigned char* LV = C.lds + 65536;
    const int b = C.bid >> 4, hm = (C.bid >> 2) & 3, qb = C.bid & 3;
    __syncthreads();
    {   u32x4 st[16];
#pragma unroll
        for (int i = 0; i < 8; ++i) { const int q = C.tid + 512 * i, row = q >> 4, pc = q & 15;
            st[i] = *(const u32x4*)(memK + (size_t)(b * 256 + row) * 512 + hm * 128 + pc * 8); }
#pragma unroll
        for (int i = 0; i < 8; ++i) { const int q = C.tid + 512 * i, row = q >> 5, pc = q & 31;
            st[8 + i] = *(const u32x4*)(memVT + (size_t)(hm * 128 + row) * 4096 + b * 256 + pc * 8); }
#pragma unroll
        for (int i = 0; i < 8; ++i) { const int q = C.tid + 512 * i, row = q >> 4, pc = q & 15;
            *(LAS u32x4*)(LK + row * 256 + ((pc ^ (row & 15)) * 16)) = st[i]; }
#pragma unroll
        for (int i = 0; i < 8; ++i) { const int q = C.tid + 512 * i, row = q >> 5, pc = q & 31;
            *(LAS u32x4*)(LV + row * 512 + ((pc ^ (row & 15)) * 16)) = st[8 + i]; }
    }
    __syncthreads();
    for (int qt = 0; qt < 4; ++qt) {
        const int m0 = b * SEQ + qb * 512 + C.wave * 64 + qt * 16;
        bf16x8 qf[4];
#pragma unroll
        for (int s = 0; s < 4; ++s) qf[s] = *(const bf16x8*)(P + (size_t)(m0 + r16) * ldp + qm0 + hm * 128 + 32 * s + 8 * g);
        f32x4 sacc[16];
#pragma unroll
        for (int kt = 0; kt < 16; ++kt) { sacc[kt] = (f32x4){0.f, 0.f, 0.f, 0.f};
#pragma unroll
            for (int s = 0; s < 4; ++s) { const bf16x8 kf = *(const LAS bf16x8*)(LK + (16 * kt + r16) * 256 + (((4 * s + g) ^ r16) * 16));
                sacc[kt] = __builtin_amdgcn_mfma_f32_16x16x32_bf16(kf, qf[s], sacc[kt], 0, 0, 0); } }
        float mx = -3.0e38f;
#pragma unroll
        for (int kt = 0; kt < 16; ++kt)
#pragma unroll
            for (int j = 0; j < 4; ++j) mx = fmaxf(mx, sacc[kt][j]);
        mx = fmaxf(mx, shx(mx, C.lane, 16)); mx = fmaxf(mx, shx(mx, C.lane, 32));
        const float sc = 0.08838834764831845f * 1.4426950408889634f;
        float sum = 0.f;
#pragma unroll
        for (int kt = 0; kt < 16; ++kt)
#pragma unroll
            for (int j = 0; j < 4; ++j) { const float pv = exp2f((sacc[kt][j] - mx) * sc); sacc[kt][j] = pv; sum += pv; }
        sum += shx(sum, C.lane, 16); sum += shx(sum, C.lane, 32);
        f32x4 oacc[8];
#pragma unroll
        for (int dt = 0; dt < 8; ++dt) oacc[dt] = (f32x4){0.f, 0.f, 0.f, 0.f};
#pragma unroll
        for (int ks = 0; ks < 8; ++ks) {
            u32x4 pw; pw.x = cvt_pk_bf16(sacc[2 * ks][0], sacc[2 * ks][1]); pw.y = cvt_pk_bf16(sacc[2 * ks][2], sacc[2 * ks][3]);
            pw.z = cvt_pk_bf16(sacc[2 * ks + 1][0], sacc[2 * ks + 1][1]); pw.w = cvt_pk_bf16(sacc[2 * ks + 1][2], sacc[2 * ks + 1][3]);
            const bf16x8 pa = __builtin_bit_cast(bf16x8, pw);
#pragma unroll
            for (int dt = 0; dt < 8; ++dt) { const LAS unsigned char* vr = LV + (16 * dt + r16) * 512;
                const u32x2 lo = *(const LAS u32x2*)(vr + (((8 * ks + g) ^ (2 * r16)) * 8)), hi = *(const LAS u32x2*)(vr + (((8 * ks + 4 + g) ^ (2 * r16)) * 8));
                u32x4 vw; vw.x = lo.x; vw.y = lo.y; vw.z = hi.x; vw.w = hi.y;
                oacc[dt] = __builtin_amdgcn_mfma_f32_16x16x32_bf16(pa, __builtin_bit_cast(bf16x8, vw), oacc[dt], 0, 0, 0); } }
        float inv[4];
#pragma unroll
        for (int j = 0; j < 4; ++j) inv[j] = 1.0f / shl(sum, 4 * g + j);
#pragma unroll
        for (int dt = 0; dt < 8; ++dt)
#pragma unroll
            for (int j = 0; j < 4; ++j) mix[(size_t)(m0 + 4 * g + j) * D + SW + hm * 128 + 16 * dt + r16] = f2bf(oacc[dt][j] * inv[j]);
    }
    __syncthreads();
}

__device__ __forceinline__ void ph_rwkv_prep1(const Ctx& C, const float* mu, bool with_v) {
    unsigned char* ws = C.ws;
    const bf16* P = (const bf16*)(ws + WS_P); bf16* AL = (bf16*)(ws + WS_ALORA);
    const int oc0 = 8 * C.lane;
    const int XW0 = 4608, XA0 = 4704, XV0 = 4800, XG0 = with_v ? 4864 : 4800;
    int src, mode;
    if (oc0 < 96) { src = XW0 + oc0; mode = 0; } else if (oc0 < 192) { src = XA0 + oc0 - 96; mode = 1; }
    else if (oc0 < 256) { src = XV0 + oc0 - 192; mode = with_v ? 1 : 2; } else { src = XG0 + oc0 - 256; mode = 3; }
    f32x4 mu0 = (f32x4){0.f, 0.f, 0.f, 0.f}, mu1 = mu0;
    if (mode != 2) { mu0 = *(const f32x4*)(mu + src); mu1 = *(const f32x4*)(mu + src + 4); }
    for (int mb = C.gw; mb < M; mb += 4 * C.NGW) {
        u32x4 cu4[4], pr4[4];
#pragma unroll
        for (int i = 0; i < 4; ++i) { const int m = mb + i * C.NGW; cu4[i] = (u32x4){0u, 0u, 0u, 0u}; pr4[i] = cu4[i];
            if (mode != 2) { cu4[i] = *(const u32x4*)(P + (size_t)m * LDP_RW + src);
                if ((m & (SEQ - 1)) != 0) pr4[i] = *(const u32x4*)(P + (size_t)(m - 1) * LDP_RW + src); } }
#pragma unroll
        for (int i = 0; i < 4; ++i) { const int m = mb + i * C.NGW; const u32x4 cu = cu4[i], pr = pr4[i];
            u32x4 o = (u32x4){0u, 0u, 0u, 0u};
            if (mode != 2) {
                float v[8];
#pragma unroll
                for (int q = 0; q < 4; ++q) { const float c0 = bflo(cu[q]), c1 = bfhi(cu[q]), p0 = bflo(pr[q]), p1 = bfhi(pr[q]);
                    const float m0 = q < 2 ? mu0[2 * q] : mu1[2 * q - 4], m1 = q < 2 ? mu0[2 * q + 1] : mu1[2 * q - 3];
                    v[2 * q] = c0 + m0 * (p0 - c0); v[2 * q + 1] = c1 + m1 * (p1 - c1); }
#pragma unroll
                for (int q = 0; q < 8; ++q) { if (mode == 0) v[q] = 1.0f - 2.0f * __builtin_amdgcn_rcpf(1.0f + __expf(2.0f * v[q])); else if (mode == 3) v[q] = sigmoidf_(v[q]); }
                o.x = cvt_pk_bf16(v[0], v[1]); o.y = cvt_pk_bf16(v[2], v[3]); o.z = cvt_pk_bf16(v[4], v[5]); o.w = cvt_pk_bf16(v[6], v[7]);
            }
            *(u32x4*)(AL + (size_t)m * 512 + oc0) = o; }
    }
}
__device__ __forceinline__ void ph_rwkv_prep2(const Ctx& C, const float* mu, const float* vecs, bool with_v) {
    unsigned char* ws = C.ws;
    const bf16* P = (const bf16*)(ws + WS_P); const bf16* LO = (const bf16*)(ws + WS_LORAOUT); bf16* VF = (bf16*)(ws + WS_VFIRST);
    unsigned char* SI = ws + WS_SCANIN; float* BON = (float*)(ws + WS_BONUS);
    const float* k_k = vecs + (with_v ? 3 : 2) * SW; const float* k_a = k_k + SW; const float* r_k = k_a + SW;
    const int hq = C.lane >> 4, cl = (C.lane & 15) * 4;
    for (int m = C.gw; m < M; m += C.NGW) {
        const int t = m & (SEQ - 1), b = m >> 11; const bool hp = t != 0;
        const bf16* pc = P + (size_t)m * LDP_RW; const bf16* pp = pc - LDP_RW;
#pragma unroll 2
        for (int it = 0; it < 6; ++it) {
            const int c = it * 256 + 4 * C.lane, head = 4 * it + hq;
            const u32x2 rc = *(const u32x2*)(pc + c), kc = *(const u32x2*)(pc + SW + c), vc = *(const u32x2*)(pc + 2 * SW + c);
            u32x2 rp = (u32x2){0u, 0u}, kp_ = rp, vp = rp;
            if (hp) { rp = *(const u32x2*)(pp + c); kp_ = *(const u32x2*)(pp + SW + c); vp = *(const u32x2*)(pp + 2 * SW + c); }
            const u32x2 Ew = *(const u32x2*)(LO + (size_t)m * 6144 + c), aw = *(const u32x2*)(LO + (size_t)m * 6144 + SW + c);
            u32x2 svw = (u32x2){0u, 0u}, vfw = svw;
            if (with_v) { svw = *(const u32x2*)(LO + (size_t)m * 6144 + 2 * SW + c); vfw = *(const u32x2*)(VF + (size_t)m * SW + c); }
            const f32x4 mr = *(const f32x4*)(mu + c), mk = *(const f32x4*)(mu + SW + c), mv = *(const f32x4*)(mu + 2 * SW + c);
            const f32x4 kk4 = *(const f32x4*)(k_k + c), ka4 = *(const f32x4*)(k_a + c), rk4 = *(const f32x4*)(r_k + c);
            float rm[4], km[4], vm[4], E[4], a[4], sv[4], vf[4];
#define UNPK(dst, w) dst[0] = bflo(w.x); dst[1] = bfhi(w.x); dst[2] = bflo(w.y); dst[3] = bfhi(w.y)
            float t0[4], t1[4];
            UNPK(t0, rc); UNPK(t1, rp);
#pragma unroll
            for (int j = 0; j < 4; ++j) rm[j] = t0[j] + mr[j] * (t1[j] - t0[j]);
            UNPK(t0, kc); UNPK(t1, kp_);
#pragma unroll
            for (int j = 0; j < 4; ++j) km[j] = t0[j] + mk[j] * (t1[j] - t0[j]);
            UNPK(t0, vc); UNPK(t1, vp);
#pragma unroll
            for (int j = 0; j < 4; ++j) vm[j] = t0[j] + mv[j] * (t1[j] - t0[j]);
            UNPK(E, Ew); UNPK(a, aw); UNPK(sv, svw); UNPK(vf, vfw);
#undef UNPK
            float vv[4], kkr[4], kp[4], ss = 0.f, bs = 0.f;
#pragma unroll
            for (int j = 0; j < 4; ++j) {
                vv[j] = with_v ? vm[j] + (vf[j] - vm[j]) * sv[j] : vm[j];
                kkr[j] = km[j] * kk4[j]; ss += kkr[j] * kkr[j];
                kp[j] = km[j] * (1.0f + (a[j] - 1.0f) * ka4[j]);
                bs += rm[j] * kp[j] * rk4[j]; }
            ss = row16_sum(ss); bs = row16_sum(bs);
            const float inv = 1.0f / fmaxf(sqrtf(ss), 1e-12f);
            if (!with_v) { u32x2 w; w.x = cvt_pk_bf16(vm[0], vm[1]); w.y = cvt_pk_bf16(vm[2], vm[3]); *(u32x2*)(VF + (size_t)m * SW + c) = w; }
            unsigned char* rec = SI + ((size_t)(b * 24 + head) * SEQ + t) * 768;
            float uw[4], kk[4];
#pragma unroll
            for (int j = 0; j < 4; ++j) { uw[j] = 1.0f - __expf(-E[j]); kk[j] = kkr[j] * inv; }
            u32x2 o;
            { const h16x2 u01 = __builtin_convertvector((f32x2){uw[0], uw[1]}, h16x2), u23 = __builtin_convertvector((f32x2){uw[2], uw[3]}, h16x2);
              o.x = __builtin_bit_cast(unsigned, u01); o.y = __builtin_bit_cast(unsigned, u23); *(u32x2*)(rec + cl * 2) = o; }
            o.x = cvt_pk_bf16(-kk[0], -kk[1]); o.y = cvt_pk_bf16(-kk[2], -kk[3]); *(u32x2*)(rec + 128 + cl * 2) = o;
            o.x = cvt_pk_bf16(kk[0] * a[0], kk[1] * a[1]); o.y = cvt_pk_bf16(kk[2] * a[2], kk[3] * a[3]); *(u32x2*)(rec + 256 + cl * 2) = o;
            o.x = cvt_pk_bf16(kp[0], kp[1]); o.y = cvt_pk_bf16(kp[2], kp[3]); *(u32x2*)(rec + 384 + cl * 2) = o;
            o.x = cvt_pk_bf16(rm[0], rm[1]); o.y = cvt_pk_bf16(rm[2], rm[3]); *(u32x2*)(rec + 512 + cl * 2) = o;
            o.x = cvt_pk_bf16(vv[0], vv[1]); o.y = cvt_pk_bf16(vv[2], vv[3]); *(u32x2*)(rec + 640 + cl * 2) = o;
            if ((C.lane & 15) == 0) BON[m * 24 + head] = bs;
        }
    }
}
__device__ __forceinline__ float fma_(float a, float b, float c) { float d; asm("v_fma_f32 %0, %1, %2, %3" : "=v"(d) : "v"(a), "v"(b), "v"(c)); return d; }
__device__ __forceinline__ float mul_(float a, float b) { float d; asm("v_mul_f32 %0, %1, %2" : "=v"(d) : "v"(a), "v"(b)); return d; }
__device__ __forceinline__ void ph_rwkv_scan(const Ctx& C, const float* mg, const float* mu, const float* md, const float* vecs, bool with_v, const float* const* in, int lq) {
    if (C.bid >= 192) { ph_moe_wconv(C, mg, mu, md, in, lq); return; }
    unsigned char* ws = C.ws;
    const unsigned char* SI = ws + WS_SCANIN;
    constexpr int TC = 16, NCH = SEQ / TC, REC = 7 * 64;
    LAS float* buf = (LAS float*)C.lds;
    LAS float* ybuf = (LAS float*)(C.lds + 114688);
    const bool scanner = C.wave < 4;
    const int slot = (C.wave >> 1) & 1;
    const int rg = C.lane >> 3, cg = C.lane & 7;
    const int rbase = 32 * (C.wave & 1) + 4 * rg;
    if (!scanner) {
        const int lw = C.wave - 4, qd = C.lane;
        const int q2 = qd - 8, lvec = 1 + (q2 >> 3), lpart = q2 & 7;
        const float* BON = (const float*)(ws + WS_BONUS); bf16* mix = (bf16*)(ws + WS_MIX); const bf16* LO = (const bf16*)(ws + WS_LORAOUT);
        const float* gn_g = vecs + (with_v ? 6 : 5) * SW; const float* gn_b = gn_g + SW;
        const int p0 = C.bid * 2, b0 = p0 / 24, h0 = p0 % 24, b1 = (p0 + 1) / 24, h1 = (p0 + 1) % 24;
        const int pr = C.lane >> 4, pc4 = 4 * (C.lane & 15);
        const f32x4 gg0 = *(const f32x4*)(gn_g + h0 * 64 + pc4), gb0 = *(const f32x4*)(gn_b + h0 * 64 + pc4), gg1 = *(const f32x4*)(gn_g + h1 * 64 + pc4), gb1 = *(const f32x4*)(gn_b + h1 * 64 + pc4);
        u32x4 st[8];
#define SCAN_ISSUE(ch_) do { _Pragma("unroll") for (int i_ = 0; i_ < 8; ++i_) { const int ps = lw + 4 * i_; \
        const int sl_ = ps >> 4, t_ = (ch_) * TC + (ps & 15); \
        st[i_] = qd < 48 ? *(const u32x4*)(SI + ((size_t)(p0 + sl_) * SEQ + t_) * 768 + qd * 16) \
                         : *(const u32x4*)(LO + (size_t)((sl_ ? b1 : b0) * SEQ + t_) * 6144 + 3 * SW + (sl_ ? h1 : h0) * 64 + ((qd - 48) & 7) * 8); } } while (0)
#define SCAN_COMMIT(bsel_) do { _Pragma("unroll") for (int i_ = 0; i_ < 8; ++i_) { const int ps = lw + 4 * i_; \
        LAS float* dst = buf + (((bsel_) * 2 * TC) + ps) * REC; \
        if (qd < 8) { f32x4 a_, b_; const unsigned sx_ = st[i_].x, sy_ = st[i_].y, sz_ = st[i_].z, sw_ = st[i_].w;     \
            { const f32x2 t0_ = __builtin_convertvector(__builtin_bit_cast(h16x2, sx_), f32x2), t1_ = __builtin_convertvector(__builtin_bit_cast(h16x2, sy_), f32x2); \
              a_[0] = 1.0f - t0_[0]; a_[1] = 1.0f - t0_[1]; a_[2] = 1.0f - t1_[0]; a_[3] = 1.0f - t1_[1]; } \
            { const f32x2 t0_ = __builtin_convertvector(__builtin_bit_cast(h16x2, sz_), f32x2), t1_ = __builtin_convertvector(__builtin_bit_cast(h16x2, sw_), f32x2); \
              b_[0] = 1.0f - t0_[0]; b_[1] = 1.0f - t0_[1]; b_[2] = 1.0f - t1_[0]; b_[3] = 1.0f - t1_[1]; } \
            *(LAS f32x4*)(dst + 8 * qd) = a_; *(LAS f32x4*)(dst + 8 * qd + 4) = b_; } \
        else if (qd < 56) { LAS float* d2 = dst + lvec * 64 + lpart * 8; \
            f32x4 a_, b_; a_[0] = bflo(st[i_].x); a_[1] = bfhi(st[i_].x); a_[2] = bflo(st[i_].y); a_[3] = bfhi(st[i_].y); \
            b_[0] = bflo(st[i_].z); b_[1] = bfhi(st[i_].z); b_[2] = bflo(st[i_].w); b_[3] = bfhi(st[i_].w); \
            *(LAS f32x4*)d2 = a_; *(LAS f32x4*)(d2 + 4) = b_; } } } while (0)
#define SCAN_POST(cp_) do { _Pragma("unroll") for (int g_ = 0; g_ < 2; ++g_) { const int ps = lw + 4 * (4 * g_ + pr), sl = ps >> 4, stp = ps & 15; \
        const LAS float* rec = buf + ((((cp_) & 1) * 2 * TC) + ps) * REC; \
        const f32x4 yv = *(const LAS f32x4*)(ybuf + ((((cp_) & 1) * 2 + sl) * TC + stp) * 64 + pc4), vv = *(const LAS f32x4*)(rec + 5 * 64 + pc4), gq = *(const LAS f32x4*)(rec + 6 * 64 + pc4); \
        const int m = (sl ? b1 : b0) * SEQ + (cp_) * TC + stp, hh = sl ? h1 : h0; \
        const float bon = BON[m * 24 + hh]; \
        const float mean = row16_sum((yv[0] + yv[1]) + (yv[2] + yv[3])) * (1.f / 64.f); const f32x4 d = yv - mean; \
        const float var = row16_sum((d[0] * d[0] + d[1] * d[1]) + (d[2] * d[2] + d[3] * d[3])) * (1.f / 64.f); \
        const float rstd = 1.0f / sqrtf(var + 64e-5f); const f32x4 gg = sl ? gg1 : gg0, gb = sl ? gb1 : gb0; \
        const f32x4 o_ = (d * rstd * gg + gb + vv * bon) * gq; \
        u32x2 w_; w_.x = cvt_pk_bf16(o_[0], o_[1]); w_.y = cvt_pk_bf16(o_[2], o_[3]); \
        *(u32x2*)(mix + (size_t)m * D + hh * 64 + pc4) = w_; } } while (0)
        SCAN_ISSUE(0); SCAN_COMMIT(0);
        __syncthreads();
        for (int ch = 0; ch < NCH; ++ch) {
            if (ch + 1 < NCH) SCAN_ISSUE(ch + 1);
            if (ch > 0) SCAN_POST(ch - 1);
            if (ch + 1 < NCH) SCAN_COMMIT((ch & 1) ^ 1);
            __syncthreads();
        }
        SCAN_POST(NCH - 1);
#undef SCAN_ISSUE
#undef SCAN_COMMIT
#undef SCAN_POST
    } else {
        f32x2 S[4][4];
#pragma unroll
        for (int i = 0; i < 4; ++i)
#pragma unroll
            for (int c = 0; c < 4; ++c) S[i][c] = (f32x2){0.f, 0.f};
        __syncthreads();
        for (int ch = 0; ch < NCH; ++ch) {
            const LAS float* base = buf + (((ch & 1) * 2 + slot) * TC) * REC;
            LAS float* yb = ybuf + (((ch & 1) * 2 + slot) * TC) * 64 + rbase;
#pragma unroll 2
            for (int s = 0; s < TC; ++s) {
                const LAS float* rp = base + s * REC + 8 * cg;
                f32x2 wv[4], nv[4], bv[4], kv[4], rv[4];
                { const f32x4 x0 = *(const LAS f32x4*)(rp), x1 = *(const LAS f32x4*)(rp + 4); wv[0] = (f32x2){x0[0], x0[1]}; wv[1] = (f32x2){x0[2], x0[3]}; wv[2] = (f32x2){x1[0], x1[1]}; wv[3] = (f32x2){x1[2], x1[3]}; }
                { const f32x4 x0 = *(const LAS f32x4*)(rp + 64), x1 = *(const LAS f32x4*)(rp + 68); nv[0] = (f32x2){x0[0], x0[1]}; nv[1] = (f32x2){x0[2], x0[3]}; nv[2] = (f32x2){x1[0], x1[1]}; nv[3] = (f32x2){x1[2], x1[3]}; }
                { const f32x4 x0 = *(const LAS f32x4*)(rp + 128), x1 = *(const LAS f32x4*)(rp + 132); bv[0] = (f32x2){x0[0], x0[1]}; bv[1] = (f32x2){x0[2], x0[3]}; bv[2] = (f32x2){x1[0], x1[1]}; bv[3] = (f32x2){x1[2], x1[3]}; }
                { const f32x4 x0 = *(const LAS f32x4*)(rp + 192), x1 = *(const LAS f32x4*)(rp + 196); kv[0] = (f32x2){x0[0], x0[1]}; kv[1] = (f32x2){x0[2], x0[3]}; kv[2] = (f32x2){x1[0], x1[1]}; kv[3] = (f32x2){x1[2], x1[3]}; }
                { const f32x4 x0 = *(const LAS f32x4*)(rp + 256), x1 = *(const LAS f32x4*)(rp + 260); rv[0] = (f32x2){x0[0], x0[1]}; rv[1] = (f32x2){x0[2], x0[3]}; rv[2] = (f32x2){x1[0], x1[1]}; rv[3] = (f32x2){x1[2], x1[3]}; }
                const f32x4 vv = *(const LAS f32x4*)(base + s * REC + 320 + rbase);
                f32x4 yo;
#pragma unroll
                for (int i = 0; i < 4; ++i) {
                    f32x2 a2 = S[i][0] * nv[0];
#pragma unroll
                    for (int c = 1; c < 4; ++c) a2 = S[i][c] * nv[c] + a2;
                    float sa = a2[0] + a2[1];
                    sa = dpp_add<0xB1>(sa); sa = dpp_add<0x4E>(sa); sa = dpp_add<0x141>(sa);
                    const f32x2 sa2 = (f32x2){sa, sa}, v2 = (f32x2){vv[i], vv[i]};
                    f32x2 y2 = (f32x2){0.f, 0.f};
#pragma unroll
                    for (int c = 0; c < 4; ++c) { S[i][c] = S[i][c] * wv[c] + (sa2 * bv[c] + v2 * kv[c]); y2 = S[i][c] * rv[c] + y2; }
                    float y = y2[0] + y2[1];
                    y = dpp_add<0xB1>(y); y = dpp_add<0x4E>(y); y = dpp_add<0x141>(y);
                    yo[i] = y;
                }
                if (cg == 0) *(LAS f32x4*)(yb + s * 64) = yo;
            }
            __syncthreads();
        }
    }
}

__device__ __constant__ float RET_LG2[6] = {-0.04580368961312479f, -0.02272007650008353f, -0.011315313227834146f, -0.005646563141142063f, -0.0028205190623786626f, -0.0014095702546713536f};
__device__ __forceinline__ void ph_ret_prep(const Ctx& C) {
    unsigned char* ws = C.ws;
    const bf16* P = (const bf16*)(ws + WS_P); const f32x2* CS = (const f32x2*)(ws + WS_CS);
    bf16* QR = (bf16*)(ws + WS_QR); bf16* KR = (bf16*)(ws + WS_KR); bf16* VT = (bf16*)(ws + WS_VT); bf16* KVT = (bf16*)(ws + WS_KVT);
    LAS unsigned char* LKt = C.lds; LAS unsigned char* LV = C.lds + 32768;
    const int g = C.lane >> 4, r16 = C.lane & 15, w = C.wave;
    __syncthreads();
    for (int u = C.bid; u < 1536; u += C.G) {
        const int c = u & 15, bh = u >> 4, h = bh % 6, b = bh / 6, m0 = b * SEQ + c * 128;
        const float lg2 = RET_LG2[h];
        __syncthreads();
        for (int task = C.tid; task < 1536; task += NTHR) {
            if (task < 512) {
                const bool isk = task >= 256; const int tk = task & 255, i0 = 4 * (tk & 15), tg = tk >> 4;
                const int colb = (isk ? 768 : 0) + h * 128 + i0; const float scl = isk ? 0.08838834764831845f : 1.0f;
                bf16* N = isk ? KR : QR;
                float o1[4][8], o2[4][8];
#pragma unroll
                for (int j = 0; j < 8; ++j) { const int m = m0 + tg * 8 + j;
                    const u32x2 a = *(const u32x2*)(P + (size_t)m * LDP_RET + colb), b2 = *(const u32x2*)(P + (size_t)m * LDP_RET + colb + 64);
                    const f32x4 cs01 = *(const f32x4*)(CS + (size_t)m * 64 + i0), cs23 = *(const f32x4*)(CS + (size_t)m * 64 + i0 + 2);
                    const float x1[4] = {bflo(a.x), bfhi(a.x), bflo(a.y), bfhi(a.y)}, x2[4] = {bflo(b2.x), bfhi(b2.x), bflo(b2.y), bfhi(b2.y)};
                    const float cc[4] = {cs01[0], cs01[2], cs23[0], cs23[2]}, sn[4] = {cs01[1], cs01[3], cs23[1], cs23[3]};
#pragma unroll
                    for (int q = 0; q < 4; ++q) { o1[q][j] = (x1[q] * cc[q] - x2[q] * sn[q]) * scl; o2[q][j] = (x1[q] * sn[q] + x2[q] * cc[q]) * scl; }
                    u32x2 w1, w2; w1.x = cvt_pk_bf16(o1[0][j], o1[1][j]); w1.y = cvt_pk_bf16(o1[2][j], o1[3][j]); w2.x = cvt_pk_bf16(o2[0][j], o2[1][j]); w2.y = cvt_pk_bf16(o2[2][j], o2[3][j]);
                    *(u32x2*)(N + (size_t)m * 768 + h * 128 + i0) = w1; *(u32x2*)(N + (size_t)m * 768 + h * 128 + i0 + 64) = w2; }
                if (isk) {
                    float kd[8];
#pragma unroll
                    for (int j = 0; j < 8; ++j) kd[j] = exp2f((float)(127 - (tg * 8 + j)) * lg2);
#pragma unroll
                    for (int q = 0; q < 4; ++q) {
                        u32x4 w1, w2;
                        w1.x = cvt_pk_bf16(o1[q][0] * kd[0], o1[q][1] * kd[1]); w1.y = cvt_pk_bf16(o1[q][2] * kd[2], o1[q][3] * kd[3]); w1.z = cvt_pk_bf16(o1[q][4] * kd[4], o1[q][5] * kd[5]); w1.w = cvt_pk_bf16(o1[q][6] * kd[6], o1[q][7] * kd[7]);
                        w2.x = cvt_pk_bf16(o2[q][0] * kd[0], o2[q][1] * kd[1]); w2.y = cvt_pk_bf16(o2[q][2] * kd[2], o2[q][3] * kd[3]); w2.z = cvt_pk_bf16(o2[q][4] * kd[4], o2[q][5] * kd[5]); w2.w = cvt_pk_bf16(o2[q][6] * kd[6], o2[q][7] * kd[7]);
                        *(LAS u32x4*)(LKt + (i0 + q) * 256 + ((tg ^ ((i0 + q) & 15)) * 16)) = w1;
                        *(LAS u32x4*)(LKt + (i0 + q + 64) * 256 + ((tg ^ ((i0 + q + 64) & 15)) * 16)) = w2; }
                }
            } else {
                const int tv = task - 512, e0 = 4 * (tv & 63), tg = tv >> 6;
                u32x2 vin[8];
#pragma unroll
                for (int j = 0; j < 8; ++j) vin[j] = *(const u32x2*)(P + (size_t)(m0 + tg * 8 + j) * LDP_RET + 1536 + h * 256 + e0);
                u32x4 w0, w1, w2, w3;
#define PKLO(a_, b_) (((a_) & 0xffffu) | ((b_) << 16))
#define PKHI(a_, b_) (((a_) >> 16) | ((b_) & 0xffff0000u))
                w0.x = PKLO(vin[0].x, vin[1].x); w0.y = PKLO(vin[2].x, vin[3].x); w0.z = PKLO(vin[4].x, vin[5].x); w0.w = PKLO(vin[6].x, vin[7].x);
                w1.x = PKHI(vin[0].x, vin[1].x); w1.y = PKHI(vin[2].x, vin[3].x); w1.z = PKHI(vin[4].x, vin[5].x); w1.w = PKHI(vin[6].x, vin[7].x);
                w2.x = PKLO(vin[0].y, vin[1].y); w2.y = PKLO(vin[2].y, vin[3].y); w2.z = PKLO(vin[4].y, vin[5].y); w2.w = PKLO(vin[6].y, vin[7].y);
                w3.x = PKHI(vin[0].y, vin[1].y); w3.y = PKHI(vin[2].y, vin[3].y); w3.z = PKHI(vin[4].y, vin[5].y); w3.w = PKHI(vin[6].y, vin[7].y);
#undef PKLO
#undef PKHI
                *(LAS u32x4*)(LV + (e0 + 0) * 256 + ((tg ^ ((e0 + 0) & 15)) * 16)) = w0; *(LAS u32x4*)(LV + (e0 + 1) * 256 + ((tg ^ ((e0 + 1) & 15)) * 16)) = w1;
                *(LAS u32x4*)(LV + (e0 + 2) * 256 + ((tg ^ ((e0 + 2) & 15)) * 16)) = w2; *(LAS u32x4*)(LV + (e0 + 3) * 256 + ((tg ^ ((e0 + 3) & 15)) * 16)) = w3;
            }
        }
        __syncthreads();
        {   f32x4 acc[16];
#pragma unroll
            for (int et = 0; et < 16; ++et) acc[et] = (f32x4){0.f, 0.f, 0.f, 0.f};
#pragma unroll
            for (int ks = 0; ks < 4; ++ks) {
                const bf16x8 af = *(const LAS bf16x8*)(LKt + (16 * w + r16) * 256 + (((4 * ks + g) ^ r16) * 16));
#pragma unroll
                for (int et = 0; et < 16; ++et) { const bf16x8 bf = *(const LAS bf16x8*)(LV + (16 * et + r16) * 256 + (((4 * ks + g) ^ r16) * 16));
                    acc[et] = __builtin_amdgcn_mfma_f32_16x16x32_bf16(af, bf, acc[et], 0, 0, 0); } }
#pragma unroll
            for (int et = 0; et < 16; ++et) { u32x2 wv; wv.x = cvt_pk_bf16(acc[et][0], acc[et][1]); wv.y = cvt_pk_bf16(acc[et][2], acc[et][3]); *(u32x2*)(KVT + ((size_t)u * 256 + 16 * et + r16) * 128 + 16 * w + 4 * g) = wv; }
        }
    }
    __syncthreads();
}
__device__ __forceinline__ void ph_ret_kv(const Ctx& C) {
    unsigned char* ws = C.ws;
    const bf16* KDT = (const bf16*)(ws + WS_KDT); const bf16* VT = (const bf16*)(ws + WS_VT); bf16* KVT = (bf16*)(ws + WS_KVT);
    const int g = C.lane >> 4, r16 = C.lane & 15, w = C.wave;
    LAS unsigned char* LKt = C.lds; LAS unsigned char* LV = C.lds + 32768;
    u32x4 st[12];
#define KV_ISSUE(u_) do { const int c_ = (u_) & 15, bh_ = (u_) >> 4; \
        _Pragma("unroll") for (int i = 0; i < 4; ++i) { const int q = C.tid + 512 * i, row = q >> 4, pc = q & 15; st[i] = *(const u32x4*)(KDT + (size_t)(bh_ * 128 + row) * SEQ + c_ * 128 + pc * 8); } \
        _Pragma("unroll") for (int i = 0; i < 8; ++i) { const int q = C.tid + 512 * i, row = q >> 4, pc = q & 15; st[4 + i] = *(const u32x4*)(VT + (size_t)(bh_ * 256 + row) * SEQ + c_ * 128 + pc * 8); } } while (0)
#define KV_COMMIT() do { \
        _Pragma("unroll") for (int i = 0; i < 4; ++i) { const int q = C.tid + 512 * i, row = q >> 4, pc = q & 15; *(LAS u32x4*)(LKt + row * 256 + ((pc ^ (row & 15)) * 16)) = st[i]; } \
        _Pragma("unroll") for (int i = 0; i < 8; ++i) { const int q = C.tid + 512 * i, row = q >> 4, pc = q & 15; *(LAS u32x4*)(LV + row * 256 + ((pc ^ (row & 15)) * 16)) = st[4 + i]; } } while (0)
    __syncthreads();
    if (C.bid < 1536) KV_ISSUE(C.bid);
    for (int u = C.bid; u < 1536; u += C.G) {
        __syncthreads();
        KV_COMMIT();
        if (u + C.G < 1536) KV_ISSUE(u + C.G);
        __syncthreads();
        f32x4 acc[16];
#pragma unroll
        for (int et = 0; et < 16; ++et) acc[et] = (f32x4){0.f, 0.f, 0.f, 0.f};
#pragma unroll
        for (int ks = 0; ks < 4; ++ks) {
            const bf16x8 af = *(const LAS bf16x8*)(LKt + (16 * w + r16) * 256 + (((4 * ks + g) ^ r16) * 16));
#pragma unroll
            for (int et = 0; et < 16; ++et) { const bf16x8 bf = *(const LAS bf16x8*)(LV + (16 * et + r16) * 256 + (((4 * ks + g) ^ r16) * 16));
                acc[et] = __builtin_amdgcn_mfma_f32_16x16x32_bf16(af, bf, acc[et], 0, 0, 0); } }
#pragma unroll
        for (int et = 0; et < 16; ++et) { u32x2 wv; wv.x = cvt_pk_bf16(acc[et][0], acc[et][1]); wv.y = cvt_pk_bf16(acc[et][2], acc[et][3]); *(u32x2*)(KVT + ((size_t)u * 256 + 16 * et + r16) * 128 + 16 * w + 4 * g) = wv; }
    }
    __syncthreads();
#undef KV_ISSUE
#undef KV_COMMIT
}
__device__ __forceinline__ void ph_ret_prefix(const Ctx& C) {
    unsigned char* ws = C.ws;
    const bf16* KVT = (const bf16*)(ws + WS_KVT); bf16* RTB = (bf16*)(ws + WS_RTB);
    for (int idx = C.bid * NTHR + C.tid; idx < 96 * 8192; idx += C.G * NTHR) {
        const int bh = idx >> 13, rem = idx & 8191; const int h = bh % 6;
        const float cd = exp2f(128.0f * RET_LG2[h]);
        f32x4 r = (f32x4){0.f, 0.f, 0.f, 0.f};
        u32x2 kwv[15];
#pragma unroll
        for (int c = 0; c < 15; ++c) kwv[c] = *(const u32x2*)(KVT + ((size_t)(bh * 16 + c) * 8192 + rem) * 4);
#pragma unroll
        for (int c = 0; c < 16; ++c) { const size_t off = ((size_t)(bh * 16 + c) * 8192 + rem) * 4;
            u32x2 w; w.x = cvt_pk_bf16(r[0], r[1]); w.y = cvt_pk_bf16(r[2], r[3]); *(u32x2*)(RTB + off) = w;
            if (c < 15) { const u32x2 kw = kwv[c]; const f32x4 kv = (f32x4){bflo(kw.x), bfhi(kw.x), bflo(kw.y), bfhi(kw.y)}; r = r * cd + kv; } }
    }
}
#define LDS_BAR() asm volatile("s_waitcnt lgkmcnt(0)\n\ts_barrier" ::: "memory")
__device__ __forceinline__ void ret_v_lds(const u32x2 (&vin)[8], LAS unsigned char* LV, int e0, int tg) {
    u32x4 w0, w1, w2, w3;
#define PKLO(a_, b_) (((a_) & 0xffffu) | ((b_) << 16))
#define PKHI(a_, b_) (((a_) >> 16) | ((b_) & 0xffff0000u))
    w0.x = PKLO(vin[0].x, vin[1].x); w0.y = PKLO(vin[2].x, vin[3].x); w0.z = PKLO(vin[4].x, vin[5].x); w0.w = PKLO(vin[6].x, vin[7].x);
    w1.x = PKHI(vin[0].x, vin[1].x); w1.y = PKHI(vin[2].x, vin[3].x); w1.z = PKHI(vin[4].x, vin[5].x); w1.w = PKHI(vin[6].x, vin[7].x);
    w2.x = PKLO(vin[0].y, vin[1].y); w2.y = PKLO(vin[2].y, vin[3].y); w2.z = PKLO(vin[4].y, vin[5].y); w2.w = PKLO(vin[6].y, vin[7].y);
    w3.x = PKHI(vin[0].y, vin[1].y); w3.y = PKHI(vin[2].y, vin[3].y); w3.z = PKHI(vin[4].y, vin[5].y); w3.w = PKHI(vin[6].y, vin[7].y);
#undef PKLO
#undef PKHI
    *(LAS u32x4*)(LV + (e0 + 0) * 256 + ((tg ^ ((e0 + 0) & 15)) * 16)) = w0; *(LAS u32x4*)(LV + (e0 + 1) * 256 + ((tg ^ ((e0 + 1) & 15)) * 16)) = w1;
    *(LAS u32x4*)(LV + (e0 + 2) * 256 + ((tg ^ ((e0 + 2) & 15)) * 16)) = w2; *(LAS u32x4*)(LV + (e0 + 3) * 256 + ((tg ^ ((e0 + 3) & 15)) * 16)) = w3;
}
__device__ __forceinline__ void ph_ret_out(const Ctx& C, const float* gn) {
    unsigned char* ws = C.ws;
    const bf16* P = (const bf16*)(ws + WS_P); const bf16* QR = (const bf16*)(ws + WS_QR); const bf16* KR = (const bf16*)(ws + WS_KR);
    const bf16* VT = (const bf16*)(ws + WS_VT); const bf16* RTB = (const bf16*)(ws + WS_RTB); bf16* mix = (bf16*)(ws + WS_MIX);
    const int g = C.lane >> 4, r16 = C.lane & 15, w = C.wave;
    LAS unsigned char* LR = C.lds; LAS unsigned char* LV = C.lds + 65536;
    for (int u = C.bid; u < 1536; u += C.G) {
        const int c = u & 15, bh = u >> 4, h = bh % 6, b = bh / 6, m0 = b * SEQ + c * 128;
        const float lg2 = RET_LG2[h];
        LDS_BAR();
        const int nl = 16 * w + r16;
        u32x4 kst[4];
        bf16x8 qf[4];
        u32x2 gwv[16];
        {   u32x4 st[8]; u32x2 vinA[8], vinB[8];
            const int e0v = 4 * (C.tid & 63), tgv = C.tid >> 6;
#pragma unroll
            for (int i = 0; i < 8; ++i) { const int q = C.tid + 512 * i, row = q >> 4, pc = q & 15;
                st[i] = *(const u32x4*)(RTB + ((size_t)u * 256 + row) * 128 + pc * 8); }
#pragma unroll
            for (int j = 0; j < 8; ++j) { vinA[j] = *(const u32x2*)(P + (size_t)(m0 + tgv * 8 + j) * LDP_RET + 1536 + h * 256 + e0v);
                vinB[j] = *(const u32x2*)(P + (size_t)(m0 + tgv * 8 + 64 + j) * LDP_RET + 1536 + h * 256 + e0v); }
#pragma unroll
            for (int s = 0; s < 4; ++s) qf[s] = *(const bf16x8*)(QR + (size_t)(m0 + nl) * 768 + h * 128 + 32 * s + 8 * g);
#pragma unroll
            for (int i = 0; i < 8; ++i) { const int q = C.tid + 512 * i, row = q >> 4, pc = q & 15; const int off = row * 256 + ((pc ^ (row & 15)) * 16);
                *(LAS u32x4*)(LR + off) = st[i]; }
            ret_v_lds(vinA, LV, e0v, tgv); ret_v_lds(vinB, LV, e0v, tgv + 8);
        }
#pragma unroll
        for (int i = 0; i < 4; ++i) { const int q = C.tid + 512 * i, row = q >> 4, pc = q & 15;
            kst[i] = *(const u32x4*)(KR + (size_t)(m0 + row) * 768 + h * 128 + pc * 8); }
        LDS_BAR();
        f32x4 o[16];
        const float qdec = exp2f((float)(nl + 1) * lg2);
#pragma unroll
        for (int et = 0; et < 16; ++et) { f32x4 a = (f32x4){0.f, 0.f, 0.f, 0.f};
#pragma unroll
            for (int s = 0; s < 4; ++s) { const bf16x8 rf = *(const LAS bf16x8*)(LR + (16 * et + r16) * 256 + (((4 * s + g) ^ r16) * 16));
                a = __builtin_amdgcn_mfma_f32_16x16x32_bf16(rf, qf[s], a, 0, 0, 0); }
            o[et] = a * qdec;
            if ((et & 3) == 3) __builtin_amdgcn_sched_barrier(0); }
        LDS_BAR();
#pragma unroll
        for (int i = 0; i < 4; ++i) { const int q = C.tid + 512 * i, row = q >> 4, pc = q & 15; *(LAS u32x4*)(LR + row * 256 + ((pc ^ (row & 15)) * 16)) = kst[i]; }
#pragma unroll
        for (int et = 0; et < 16; ++et) gwv[et] = *(const u32x2*)(P + (size_t)(m0 + nl) * LDP_RET + 3072 + h * 256 + 16 * et + 4 * g);
        LDS_BAR();
        const float fd0 = (float)opq_v(nl - 4 * g);
        u32x2 pb[8];
#pragma unroll
        for (int mt = 0; mt < 8; ++mt) {
            pb[mt] = (u32x2){0u, 0u};
            if (mt <= w) { f32x4 a = (f32x4){0.f, 0.f, 0.f, 0.f};
#pragma unroll
                for (int s = 0; s < 4; ++s) { const bf16x8 kf = *(const LAS bf16x8*)(LR + (16 * mt + r16) * 256 + (((4 * s + g) ^ r16) * 16));
                    a = __builtin_amdgcn_mfma_f32_16x16x32_bf16(kf, qf[s], a, 0, 0, 0); }
#pragma unroll
                for (int j = 0; j < 4; ++j) { const float fd = fd0 - (float)(16 * mt + j); a[j] = fd >= 0.f ? a[j] * exp2f(fd * lg2) : 0.f; }
                pb[mt].x = cvt_pk_bf16(a[0], a[1]); pb[mt].y = cvt_pk_bf16(a[2], a[3]); }
        }
#pragma unroll
        for (int ks = 0; ks < 4; ++ks) {
            if (2 * ks <= w) {
                u32x4 pw; pw.x = pb[2 * ks].x; pw.y = pb[2 * ks].y; pw.z = pb[2 * ks + 1].x; pw.w = pb[2 * ks + 1].y;
                const bf16x8 pf = __builtin_bit_cast(bf16x8, pw);
#pragma unroll
                for (int et = 0; et < 16; ++et) { const LAS unsigned char* vr = LV + (16 * et + r16) * 256;
                    const u32x2 lo = *(const LAS u32x2*)(vr + (((8 * ks + g) ^ (2 * r16)) * 8)), hi = *(const LAS u32x2*)(vr + (((8 * ks + 4 + g) ^ (2 * r16)) * 8));
                    u32x4 vw; vw.x = lo.x; vw.y = lo.y; vw.z = hi.x; vw.w = hi.y;
                    o[et] = __builtin_amdgcn_mfma_f32_16x16x32_bf16(__builtin_bit_cast(bf16x8, vw), pf, o[et], 0, 0, 0); } }
        }
        float s1 = 0.f;
#pragma unroll
        for (int et = 0; et < 16; ++et) s1 += (o[et][0] + o[et][1]) + (o[et][2] + o[et][3]);
        s1 += shx(s1, C.lane, 16); s1 += shx(s1, C.lane, 32);
        const float mean = s1 * (1.f / 256.f); float s2 = 0.f;
#pragma unroll
        for (int et = 0; et < 16; ++et) { o[et] = o[et] - mean; s2 += (o[et][0] * o[et][0] + o[et][1] * o[et][1]) + (o[et][2] * o[et][2] + o[et][3] * o[et][3]); }
        s2 += shx(s2, C.lane, 16); s2 += shx(s2, C.lane, 32);
        const float rstd = 1.0f / sqrtf(s2 * (1.f / 256.f) + 1e-5f);
        const int m = m0 + nl;
#pragma unroll
        for (int et = 0; et < 16; ++et) { const int e = h * 256 + 16 * et + 4 * g;
            const f32x4 gg = *(const f32x4*)(gn + e), gb = *(const f32x4*)(gn + SW + e);
            const u32x2 gw_ = gwv[et];
            float gt[4] = {bflo(gw_.x), bfhi(gw_.x), bflo(gw_.y), bfhi(gw_.y)}; float ov[4];
#pragma unroll
            for (int j = 0; j < 4; ++j) { const float yn = o[et][j] * rstd * gg[j] + gb[j]; ov[j] = yn * gt[j] * sigmoidf_(gt[j]); }
            u32x2 wv; wv.x = cvt_pk_bf16(ov[0], ov[1]); wv.y = cvt_pk_bf16(ov[2], ov[3]);
            *(u32x2*)(mix + (size_t)m * D + e) = wv; }
    }
    __syncthreads();
}

constexpr int PH_PER_PAIR = 23, NPH = 2 + 2 * PH_PER_PAIR;
__global__ void __launch_bounds__(NTHR, 2) fwd_kernel(Args args) {
    extern __shared__ __attribute__((aligned(16))) unsigned char lds_raw[];
    Ctx C;
    C.lds = (LAS unsigned char*)lds_raw;
    C.tid = threadIdx.x; C.lane = C.tid & 63; C.wave = __builtin_amdgcn_readfirstlane(C.tid >> 6);
    C.bid = blockIdx.x; C.G = GRID; C.gw = C.bid * NWAVES + C.wave; C.NGW = C.G * NWAVES; C.ws = args.ws;
    for (int u = C.tid; u < (LDS_BYTES - LDS_MISC) / 4; u += NTHR) ((LAS unsigned*)(C.lds + LDS_MISC))[u] = 0u;
    __syncthreads();
    const int lo = args.ph_lo, hi = args.ph_hi;
    XcdBarrier bar; bar.bar = (unsigned*)(args.ws + WS_CTL) + CW_BAR; bar.x = 0; bar.st = nullptr;
    if (hi - lo > 1) bar = xcd_barrier_post((unsigned*)(args.ws + WS_CTL) + CW_BAR, (volatile LAS unsigned*)(C.lds + LDS_MISC));
#ifndef ENMASK
#define ENMASK 0x1ffffffu
#endif
#define EN(j) ((((unsigned)(ENMASK)) >> (j)) & 1u)
#ifndef DBLMASK
#define DBLMASK 0u
#endif
#define REP(j) for (int rep_ = 0; rep_ < 1 + (int)((((unsigned)(DBLMASK)) >> (j)) & 1u); ++rep_)
#define IN(k) (lo <= (k) && (k) < hi)
#define SEAM(k) do { if (IN((k) + 1)) xcd_barrier(bar, (lane_id_asm() == 0) && (Cq.wave == 0)); } while (0)

#define PH_BEGIN Ctx Cq; Cq.lds = C.lds; Cq.lane = lane_id_asm(); Cq.wave = opq_i(C.wave); Cq.tid = Cq.wave * 64 + Cq.lane; Cq.bid = opq_i((int)blockIdx.x); Cq.G = GRID; \
        Cq.gw = Cq.bid * NWAVES + Cq.wave; Cq.NGW = Cq.G * NWAVES; Cq.ws = opq(args.ws); unsigned char* ws = Cq.ws; const int lq = opq_i(lp); (void)ws; (void)lq
    { const int lp = 0;
    REP(0) if (EN(0) && IN(0)) { PH_BEGIN; ph_prologue(Cq, args); SEAM(0); }
    REP(1) if (EN(1) && IN(1)) { PH_BEGIN;
        pg8::SchedMem S; S.G = Cq.G; S.c = Cq.bid; S.memb = (unsigned)WS_MEMB; S.wkv = (unsigned)WS_WKV;
        pg8::EpiMem E; E.O0 = (bf16*)(ws + WS_MEMK); E.O1 = (bf16*)(ws + WS_MEMVT);
        pg8::gemm_phase<pg8::EpiMem, pg8::SchedMem, true, true>(Cq.lds, Cq.tid, (const char*)ws, 2048, 2048, 2048, S, E);
        SEAM(1);
    } }
#pragma unroll 1
    for (int lp = 0; lp < 2; ++lp) {
        const int pb = 2 + lp * PH_PER_PAIR;
        REP(2) if (EN(2) && IN(pb + 0)) {
            PH_BEGIN;
            pg8::SchedPlain S; S.init(M / 256, 22, Cq.G, Cq.bid); S.A0 = (unsigned)(WS_XB); S.B0 = (unsigned)(WS_WIN + (size_t)(2 * lq) * 22 * MiB); S.at = (unsigned)(256 * 2048 * 2); S.bt = (unsigned)(256 * 2048 * 2);
            pg8::EpiBf16 E; E.O = (bf16*)(ws + WS_P); E.ldc = LDP_RW;
            pg8::gemm_phase<pg8::EpiBf16, pg8::SchedPlain, true, true>(Cq.lds, Cq.tid, (const char*)ws, 2048, 2048, 2048, S, E);
            SEAM(pb + 0);
        }
        REP(3) if (EN(3) && IN(pb + 1)) { PH_BEGIN; const bool with_v = lq == 1; ph_rwkv_prep1(Cq, args.in[lq ? L2_MU : L0_MU], with_v); ph_memattn(Cq, (const bf16*)(ws + WS_P), LDP_RW, with_v ? 5120 : 5056); SEAM(pb + 1); }
        REP(4) if (EN(4) && IN(pb + 2)) {
            PH_BEGIN; const float* vecs = args.in[lq ? L2_VECS : L0_VECS];
            pg8::SchedLora S; S.skipv = lq == 0; S.init(M / 256, lq == 0 ? 18 : 24, Cq.G, Cq.bid); S.A0 = (unsigned)(WS_ALORA); S.B0 = (unsigned)(WS_WLORA + (size_t)lq * 3 * MiB);
            pg8::EpiLora E; E.O = (bf16*)(ws + WS_LORAOUT); E.vecs = vecs;
            pg8::gemm_phase<pg8::EpiLora, pg8::SchedLora, true, true>(Cq.lds, Cq.tid, (const char*)ws, 512, 256, opq_i(256), S, E);
            SEAM(pb + 2);
        }
        REP(5) if (EN(5) && IN(pb + 3)) { PH_BEGIN; ph_rwkv_prep2(Cq, args.in[lq ? L2_MU : L0_MU], args.in[lq ? L2_VECS : L0_VECS], lq == 1); SEAM(pb + 3); }
        REP(6) if (EN(6) && IN(pb + 4)) { PH_BEGIN; ph_rwkv_scan(Cq, args.in[lq ? L3_MG : L1_MG], args.in[lq ? L3_MU_ : L1_MU_], args.in[lq ? L3_MD : L1_MD], args.in[lq ? L2_VECS : L0_VECS], lq == 1, args.in, lq); SEAM(pb + 4); }
        REP(8) if (EN(8) && IN(pb + 6)) {
            PH_BEGIN;
            pg8::SchedPlain S; S.init(M / 256, 8, Cq.G, Cq.bid); S.A0 = (unsigned)(WS_MIX); S.B0 = (unsigned)(WS_WOUT + (size_t)(2 * lq) * 8 * MiB); S.at = (unsigned)(256 * 2048 * 2); S.bt = (unsigned)(256 * 2048 * 2);
            pg8::EpiBf16 E; E.O = (bf16*)(ws + WS_P); E.ldc = D;
            pg8::gemm_phase<pg8::EpiBf16, pg8::SchedPlain, true, true>(Cq.lds, Cq.tid, (const char*)ws, 2048, 2048, 2048, S, E);
            SEAM(pb + 6);
        }
        REP(9) if (EN(9) && IN(pb + 7)) { PH_BEGIN; const float* nr = args.in[lq ? L2_NORMS : L0_NORMS];
            ph_ln(Cq, ws + WS_P, 0, nr, nr + D, nullptr, ws + WS_X8, nullptr, false); SEAM(pb + 7); }
        REP(10) if (EN(10) && IN(pb + 8)) {
            PH_BEGIN;
            pg8::SchedPlain S; S.init(M / 256, 44, Cq.G, Cq.bid); S.A0 = (unsigned)(WS_X8); S.B0 = (unsigned)(WS_WFGU + (size_t)lq * 44 * MiB); S.at = (unsigned)(256 * 2048); S.bt = (unsigned)(256 * 2048);
            pg8::EpiSwiglu8 E; E.O = ws + WS_HID; E.ldc = DFF; E.inv = 1.0f / 16384.0f; E.so = 32.0f;
            pg8::gemm_phase<pg8::EpiSwiglu8, pg8::SchedPlain, true, true, true>(Cq.lds, Cq.tid, (const char*)ws, 1024, 1024, 1024, S, E);
            SEAM(pb + 8);
        }
        REP(11) if (EN(11) && IN(pb + 9)) {
            PH_BEGIN;
            pg8::SchedPlain S; S.init(M / 256, 8, Cq.G, Cq.bid); S.A0 = (unsigned)(WS_HID); S.B0 = (unsigned)(WS_WFD + (size_t)lq * 22 * MiB); S.at = (unsigned)(256 * DFF); S.bt = (unsigned)(256 * DFF);
            pg8::EpiFp8S E; E.O = ws + WS_P; E.ldc = D; E.sc = 1.0f / 256.0f;
            pg8::gemm_phase<pg8::EpiFp8S, pg8::SchedPlain, true, true, true>(Cq.lds, Cq.tid, (const char*)ws, DFF / 2, DFF / 2, DFF / 2, S, E);
            SEAM(pb + 9);
        }
        REP(12) if (EN(12) && IN(pb + 10)) { PH_BEGIN; const float* nr = args.in[lq ? L2_NORMS : L0_NORMS];
            ph_ln(Cq, ws + WS_P, 1, nr + 2 * D, nr + 3 * D, nullptr, nullptr, nullptr, false); SEAM(pb + 10); }
        REP(13) if (EN(13) && IN(pb + 11)) {
            PH_BEGIN;
            pg8::SchedPlain S; S.init(M / 256, 20, Cq.G, Cq.bid); S.A0 = (unsigned)(WS_XB); S.B0 = (unsigned)(WS_WIN + (size_t)(2 * lq + 1) * 22 * MiB); S.at = (unsigned)(256 * 2048 * 2); S.bt = (unsigned)(256 * 2048 * 2);
            pg8::EpiBf16 E; E.O = (bf16*)(ws + WS_P); E.ldc = LDP_RET;
            pg8::gemm_phase<pg8::EpiBf16, pg8::SchedPlain, true, true>(Cq.lds, Cq.tid, (const char*)ws, 2048, 2048, 2048, S, E);
            SEAM(pb + 11);
        }
        REP(14) if (EN(14) && IN(pb + 12)) { PH_BEGIN; ph_ret_prep(Cq); ph_memattn(Cq, (const bf16*)(ws + WS_P), LDP_RET, 4608); SEAM(pb + 12); }
        REP(16) if (EN(16) && IN(pb + 14)) { PH_BEGIN; ph_ret_prefix(Cq); SEAM(pb + 14); }
        REP(17) if (EN(17) && IN(pb + 15)) { PH_BEGIN; ph_ret_out(Cq, args.in[lq ? L3_GN : L1_GN]); SEAM(pb + 15); }
        REP(18) if (EN(18) && IN(pb + 16)) {
            PH_BEGIN;
            pg8::SchedPlain S; S.init(M / 256, 8, Cq.G, Cq.bid); S.A0 = (unsigned)(WS_MIX); S.B0 = (unsigned)(WS_WOUT + (size_t)(2 * lq + 1) * 8 * MiB); S.at = (unsigned)(256 * 2048 * 2); S.bt = (unsigned)(256 * 2048 * 2);
            pg8::EpiBf16 E; E.O = (bf16*)(ws + WS_P); E.ldc = D;
            pg8::gemm_phase<pg8::EpiBf16, pg8::SchedPlain, true, true>(Cq.lds, Cq.tid, (const char*)ws, 2048, 2048, 2048, S, E);
            SEAM(pb + 16);
        }
        REP(19) if (EN(19) && IN(pb + 17)) {
            PH_BEGIN; const float* nr = args.in[lq ? L3_NORMS : L1_NORMS];
            REP(25) { ph_ln(Cq, ws + WS_P, 0, nr, nr + D, nullptr, ws + WS_X8, args.in[lq ? L3_ROUTER : L1_ROUTER], true);
            __syncthreads(); }
            SEAM(pb + 17);
        }
        REP(20) if (EN(20) && IN(pb + 18)) { PH_BEGIN; ph_slots(Cq); SEAM(pb + 18); }
        REP(22) if (EN(22) && IN(pb + 20)) {
            PH_BEGIN;
            const int nT = __builtin_amdgcn_readfirstlane(((const int*)(ws + WS_CTL))[CW_NT]);
            pg8::SchedMoEg S; S.init(nT, 44, Cq.G, Cq.bid); S.B0 = (unsigned)(WS_MWGU); S.bt = (unsigned)(256 * 2048); S.be = (unsigned)(22 * MiB);
            S.xoff = (unsigned)WS_X8; S.zoff = (unsigned)(WS_CTL + 512 * 1024); S.texp = (const int*)(ws + WS_CTL) + CW_TEXP; S.slot_tok = (const int*)(ws + WS_SLOTTOK);
            pg8::EpiSwiglu8 E; E.O = ws + WS_HIDM; E.ldc = DFF; E.inv = 1.0f / 16384.0f; E.so = 32.0f;
            pg8::gemm_phase<pg8::EpiSwiglu8, pg8::SchedMoEg, true, true, true>(Cq.lds, Cq.tid, (const char*)ws, 1024, 1024, 1024, S, E);
            SEAM(pb + 20);
        }
        REP(23) if (EN(23) && IN(pb + 21)) {
            PH_BEGIN;
            const int nT = __builtin_amdgcn_readfirstlane(((const int*)(ws + WS_CTL))[CW_NT]);
            pg8::SchedMoE S; S.init(nT, 8, Cq.G, Cq.bid); S.A0 = (unsigned)(WS_HIDM); S.B0 = (unsigned)(WS_MWD); S.at = (unsigned)(256 * DFF); S.bt = (unsigned)(256 * DFF); S.be = (unsigned)(11 * MiB);
            S.texp = (const int*)(ws + WS_CTL) + CW_TEXP;
            pg8::EpiFp8S E; E.O = ws + WS_XPERM; E.ldc = D; E.sc = 1.0f / 256.0f;
            pg8::gemm_phase<pg8::EpiFp8S, pg8::SchedMoE, true, true, true>(Cq.lds, Cq.tid, (const char*)ws, DFF / 2, DFF / 2, DFF / 2, S, E);
            SEAM(pb + 21);
        }
        REP(24) if (EN(24) && IN(pb + 22)) {
            PH_BEGIN; const float* nr = args.in[lq ? L3_NORMS : L1_NORMS];
            ph_ln(Cq, ws + WS_XPERM, 2, nr + 2 * D, nr + 3 * D, lq == 1 ? args.out : nullptr, nullptr, nullptr, false);
            SEAM(pb + 22);
        }
    }
#undef IN
#undef SEAM
}

#ifndef MK_PER_PHASE
#define MK_PER_PHASE 0
#endif
extern "C" void kernel_launch(void* const* d_in, const int* in_sizes, int n_in, void* d_out, int out_size, void* d_ws, size_t ws_size, hipStream_t stream) {
    static int ready = 0;
    if (ready == 0) {
        ready = 1;
        if (n_in != 43 || out_size != M * D || ws_size < WS_END) { fprintf(stderr, "kernel_launch: unexpected problem (n_in %d out %d ws %zu need %zu)\n", n_in, out_size, ws_size, (size_t)WS_END); ready = -1; }
        else if (hipFuncSetAttribute((const void*)fwd_kernel, hipFuncAttributeMaxDynamicSharedMemorySize, LDS_BYTES) != hipSuccess) { fprintf(stderr, "kernel_launch: hipFuncSetAttribute failed\n"); ready = -1; }
        (void)hipGetLastError();
    }
    if (ready < 0) return;
    (void)hipMemsetAsync((char*)d_ws + WS_CTL, 0, CTL_BYTES, stream);
    Args a{};
    for (int i = 0; i < 43; ++i) a.in[i] = (const float*)d_in[i];
    a.out = (float*)d_out; a.ws = (unsigned char*)d_ws;
#if MK_PER_PHASE
    for (int p = 0; p < NPH; ++p) { a.ph_lo = p; a.ph_hi = p + 1; hipLaunchKernelGGL(fwd_kernel, dim3(GRID), dim3(NTHR), LDS_BYTES, stream, a); }
#else
    a.ph_lo = 0; a.ph_hi = NPH;
    hipLaunchKernelGGL(fwd_kernel, dim3(GRID), dim3(NTHR), LDS_BYTES, stream, a);
#endif
}
```

```cpp
#include <hip/hip_runtime.h>
#include <cstdio>
#include <cstdint>

#define LAS __attribute__((address_space(3)))
#define GAS __attribute__((address_space(1)))
typedef unsigned short bf16;
typedef short bf16x8 __attribute__((ext_vector_type(8)));
typedef float f32x4 __attribute__((ext_vector_type(4)));
typedef float f32x2 __attribute__((ext_vector_type(2)));
typedef unsigned u32x4 __attribute__((ext_vector_type(4)));
typedef unsigned u32x2 __attribute__((ext_vector_type(2)));

constexpr int M = 32768, D = 2048, SEQ = 2048, NB = 16;
constexpr int SW = 1536;
constexpr int LDP_RW = 5632, LDP_RET = 5120;
constexpr int DFF = 5632;
constexpr int NSLOT = 67584;
constexpr float ALPHA = 1.6817928305074290f;
constexpr float LN_EPS = 1e-5f;
constexpr int NWAVES = 8, NTHR = 512, GRID = 256;

constexpr size_t MiB = 1u << 20;
constexpr size_t WS_CTL = 0, CTL_BYTES = 1 * MiB;
constexpr size_t WS_WKV = 1 * MiB;
constexpr size_t WS_WIN = WS_WKV + 4 * MiB;
constexpr size_t WS_WOUT = WS_WIN + 88 * MiB;
constexpr size_t WS_WLORA = WS_WOUT + 32 * MiB;
constexpr size_t WS_WFGU = WS_WLORA + 6 * MiB;
constexpr size_t WS_WFD = WS_WFGU + 88 * MiB;
constexpr size_t WS_MEMB = WS_WFD + 44 * MiB;
constexpr size_t WS_MEMK = WS_MEMB + 16 * MiB;
constexpr size_t WS_MEMVT = WS_MEMK + 4 * MiB;
constexpr size_t WS_CS = WS_MEMVT + 4 * MiB;
constexpr size_t WS_XB = WS_CS + 16 * MiB;
constexpr size_t WS_MIX = WS_XB + 128 * MiB;
constexpr size_t WS_VFIRST = WS_MIX + 128 * MiB;
constexpr size_t WS_P = WS_VFIRST + 96 * MiB;
constexpr size_t WS_MISC = WS_P + 352 * MiB;
constexpr size_t WS_ROUTE = WS_MISC, WS_SLOT1 = WS_MISC + 512 * 1024, WS_SLOT2 = WS_SLOT1 + 128 * 1024, WS_SLOTTOK = WS_SLOT2 + 128 * 1024;
constexpr size_t WS_BONUS = WS_MISC + 2 * MiB;
constexpr size_t WS_SB = WS_BONUS + 3 * MiB;
constexpr size_t WS_ALORA = WS_SB, WS_LORAOUT = WS_SB + 32 * MiB, WS_SCANIN = WS_SB + 416 * MiB;
constexpr size_t WS_QR = WS_SB, WS_KR = WS_SB + 48 * MiB, WS_KDT = WS_SB + 96 * MiB, WS_VT = WS_SB + 144 * MiB, WS_KVT = WS_SB + 240 * MiB, WS_RTB = WS_SB + 432 * MiB;
constexpr size_t WS_HID = WS_SB;
constexpr size_t WS_XPERM = WS_SB, WS_HIDM = WS_SB + 264 * MiB, WS_MWGU = WS_SB + 1184 * MiB, WS_MWD = WS_SB + 1360 * MiB;
constexpr size_t WS_XLO = WS_SB + 1518 * MiB;
constexpr size_t WS_X8 = WS_XLO + 64 * MiB;
constexpr size_t WS_END = WS_X8 + 64 * MiB;
constexpr int CW_BAR = 4096;
constexpr int CW_CNT = 16384;
constexpr int CW_NT = 20480;
constexpr int CW_TEXP = 20544;

constexpr int RING_BYTES = 131072;
constexpr int LDS_MISC = RING_BYTES;
constexpr int LDS_BYTES = RING_BYTES + 8192;

#define LDS_WAIT() asm volatile("s_waitcnt lgkmcnt(0)" ::: "memory")
#define VM_WAIT() asm volatile("s_waitcnt vmcnt(0)" ::: "memory")
__device__ __forceinline__ unsigned cvt_pk_bf16(float lo, float hi) { unsigned r; asm volatile("v_cvt_pk_bf16_f32 %0, %1, %2" : "=v"(r) : "v"(lo), "v"(hi)); return r; }
__device__ __forceinline__ bf16 f2bf(float f) { return (bf16)(cvt_pk_bf16(f, 0.f) & 0xffffu); }
__device__ __forceinline__ float bf2f(bf16 b) { return __uint_as_float(((unsigned)b) << 16); }
__device__ __forceinline__ float bflo(unsigned w) { return __uint_as_float(w << 16); }
__device__ __forceinline__ float bfhi(unsigned w) { return __uint_as_float(w & 0xffff0000u); }
template <int CTRL> __device__ __forceinline__ float dpp_add(float x) {
    int y = __builtin_amdgcn_update_dpp(0, __float_as_int(x), CTRL, 0xf, 0xf, true);
    return x + __int_as_float(y);
}
__device__ __forceinline__ float row16_sum(float x) { x = dpp_add<0xB1>(x); x = dpp_add<0x4E>(x); x = dpp_add<0x141>(x); x = dpp_add<0x140>(x); return x; }
__device__ __forceinline__ float wave_sum(float v) {
    v = row16_sum(v);
    const float a = __int_as_float(__builtin_amdgcn_readlane(__float_as_int(v), 0)), b = __int_as_float(__builtin_amdgcn_readlane(__float_as_int(v), 16));
    const float c = __int_as_float(__builtin_amdgcn_readlane(__float_as_int(v), 32)), d = __int_as_float(__builtin_amdgcn_readlane(__float_as_int(v), 48));
    return (a + b) + (c + d);
}
__device__ __forceinline__ unsigned pk4_fp8(float a, float b, float c, float d) {
    a = __builtin_amdgcn_fmed3f(a, -448.f, 448.f); b = __builtin_amdgcn_fmed3f(b, -448.f, 448.f); c = __builtin_amdgcn_fmed3f(c, -448.f, 448.f); d = __builtin_amdgcn_fmed3f(d, -448.f, 448.f);
    unsigned w = 0; w = __builtin_amdgcn_cvt_pk_fp8_f32(a, b, w, false); w = __builtin_amdgcn_cvt_pk_fp8_f32(c, d, w, true); return w; }
__device__ __forceinline__ float sigmoidf_(float z) { return __builtin_amdgcn_rcpf(1.0f + __expf(-z)); }

__device__ __forceinline__ unsigned char* opq(unsigned char* p) { asm volatile("" : "+s"(p)); return p; }
__device__ __forceinline__ int opq_i(int v) { asm volatile("" : "+s"(v)); return v; }
__device__ __forceinline__ int opq_v(int v) { asm volatile("" : "+v"(v)); return v; }
__device__ __forceinline__ int lane_id_asm() { int l; asm volatile("v_mbcnt_lo_u32_b32 %0, -1, 0\n\tv_mbcnt_hi_u32_b32 %0, -1, %0" : "=v"(l)); return l; }
typedef _Float16 h16x2 __attribute__((ext_vector_type(2)));
__device__ __forceinline__ float shx(float v, int lane, int m) { return __builtin_bit_cast(float, __builtin_amdgcn_ds_bpermute((lane ^ m) << 2, __builtin_bit_cast(int, v))); }
__device__ __forceinline__ float shl(float v, int src) { return __builtin_bit_cast(float, __builtin_amdgcn_ds_bpermute(src << 2, __builtin_bit_cast(int, v))); }
#define XB_TMO      128
#define XB_XCNT(j)  (256  + 64 * (j))
#define XB_XSUB(j)  (1280 + 64 * (j))
#define XB_XGEN(j)  (2304 + 64 * (j))
#define XB_TOP      3328
#define XB_TOPGEN   3392
#define XCD_BAR_WORDS 3456
#define XB_SPIN_CAP (1u << 18)
__device__ __forceinline__ unsigned xb_ld(unsigned* p)              { return __hip_atomic_load(p, __ATOMIC_RELAXED, __HIP_MEMORY_SCOPE_AGENT); }
__device__ __forceinline__ unsigned xb_add(unsigned* p, unsigned v) { return __hip_atomic_fetch_add(p, v, __ATOMIC_RELAXED, __HIP_MEMORY_SCOPE_AGENT); }
__device__ __forceinline__ unsigned xb_xcc_id() { return (unsigned)__builtin_amdgcn_s_getreg((3 << 11) | 20) & 0xFu; }
#define XB_SPIN(cond, bar) do { unsigned _sp = 0; while (cond) { __builtin_amdgcn_s_sleep(1); \
    if ((++_sp & 255u) == 0u) { if (xb_ld(&(bar)[XB_TMO])) break; if (_sp > XB_SPIN_CAP) { atomicAdd(&(bar)[XB_TMO], 1u); break; } } } } while (0)
struct XcdBarrier { unsigned* bar; unsigned x; volatile LAS unsigned* st; };
__device__ __forceinline__ XcdBarrier xcd_barrier_post(unsigned* bar, volatile LAS unsigned* st) {
    XcdBarrier b; b.bar = bar; b.x = xb_xcc_id(); b.st = st;
    if (threadIdx.x == 0) (void)xb_add(&bar[XB_XCNT(b.x)], 1u);
    return b;
}
__device__ __forceinline__ void xcd_barrier_complete(unsigned* bar, unsigned x, unsigned& nloc, unsigned& nx) {
    const unsigned G = gridDim.x * gridDim.y * gridDim.z;
    unsigned sum, cnt, mine, sp = 0u;
    for (;;) {
        sum = 0u; cnt = 0u; mine = 0u;
#pragma unroll
        for (unsigned j = 0; j < 16; ++j) { const unsigned c = xb_ld(&bar[XB_XCNT(j)]); sum += c; cnt += (c > 0u) ? 1u : 0u; mine = (j == x) ? c : mine; }
        if (sum == G) break;
        __builtin_amdgcn_s_sleep(1);
        if ((++sp & 255u) == 0u) { if (xb_ld(&bar[XB_TMO])) break; if (sp > XB_SPIN_CAP) { atomicAdd(&bar[XB_TMO], 1u); break; } }
    }
    nloc = mine > 0u ? mine : 1u; nx = cnt > 0u ? cnt : 1u;
}
__device__ __forceinline__ void xcd_barrier(const XcdBarrier& b, const bool leader  ) {
    asm volatile("s_waitcnt vmcnt(0)" ::: "memory");
    __syncthreads();
    if (leader) {
        unsigned* bar = b.bar;
        __builtin_amdgcn_s_waitcnt(0);
        unsigned nloc = b.st[0], nx = b.st[1];
        if (nloc == 0u) { xcd_barrier_complete(bar, b.x, nloc, nx); b.st[0] = nloc; b.st[1] = nx; }
        const unsigned old = xb_add(&bar[XB_XSUB(b.x)], 1u);
        const unsigned gen = old / nloc;
        if (old + 1u == (gen + 1u) * nloc) {
            __builtin_amdgcn_fence(__ATOMIC_RELEASE, "agent");
            asm volatile("s_waitcnt vmcnt(0)" ::: "memory");
            const unsigned og = xb_add(&bar[XB_TOP], 1u);
            const unsigned tg = og / nx;
            if (og + 1u == (tg + 1u) * nx) xb_add(&bar[XB_TOPGEN], 1u);
            else XB_SPIN(xb_ld(&bar[XB_TOPGEN]) == tg, bar);
            __builtin_amdgcn_fence(__ATOMIC_ACQUIRE, "agent");
            xb_add(&bar[XB_XGEN(b.x)], 1u);
            asm volatile("s_waitcnt vmcnt(0)" ::: "memory");
        } else {
            XB_SPIN(xb_ld(&bar[XB_XGEN(b.x)]) == gen, bar);
            __builtin_amdgcn_fence(__ATOMIC_ACQUIRE, "agent");
            asm volatile("s_waitcnt vmcnt(0)" ::: "memory");
        }
    }
    __syncthreads();
}

namespace pg8 {
constexpr int BM = 256, BK = 64, HALF = 128, HTB = HALF * BK * 2, STAGE_BYTES = 8 * HTB, NXCD = 8, WGM = 8;
__host__ __device__ __forceinline__ int lds_byte(int r, int c) { const int st = (r >> 4) * 2 + (c >> 5), rr = r & 15, cc = c & 31, ob = rr * 64 + cc * 2; return st * 1024 + (ob ^ (((ob >> 9) & 1) << 5)); }
__host__ __device__ __forceinline__ void stage_rc(int b, int& R, int& C) { const int st = b / 1024, sb = b % 1024, swz = sb ^ (((sb >> 9) & 1) << 5); R = (st >> 1) * 16 + swz / 64; C = (st & 1) * 32 + (swz % 64) / 2; }
__host__ __device__ __forceinline__ int perm32(int rho) { const int n = rho >> 4, i = rho & 15; return 8 * (i >> 2) + 4 * n + (i & 3); }
typedef int i32x8 __attribute__((ext_vector_type(8)));
typedef int i32x4_ __attribute__((ext_vector_type(4)));
__device__ __forceinline__ i32x8 cat8(bf16x8 a, bf16x8 b) { const i32x4_ x = __builtin_bit_cast(i32x4_, a), y = __builtin_bit_cast(i32x4_, b); return __builtin_shufflevector(x, y, 0, 1, 2, 3, 4, 5, 6, 7); }
__device__ __forceinline__ void mfma8(f32x4& acc, const i32x8 a, const i32x8 b) {
    asm volatile("v_mfma_scale_f32_16x16x128_f8f6f4 %0, %1, %2, %0, %3, %3 op_sel_hi:[0,0,0]" : "+v"(acc) : "v"(a), "v"(b), "v"(127)); }
struct Unit { int pm, pn, z; };
struct Order {
    int nM, nN, nwg, G, c;
    __device__ __forceinline__ void init(int nM_, int nN_, int G_, int c_) { nM = nM_; nN = nN_; nwg = nM * nN; G = G_; c = c_; }
    __device__ __forceinline__ bool next_mn(int i, Unit& u) const {
        const long L = (long)i * G + c; if (L >= nwg) return false;
        int wgid = (int)L; { const int q = nwg / NXCD, r = nwg % NXCD, xcd = wgid % NXCD, off = wgid / NXCD; wgid = (xcd < r ? xcd * (q + 1) : r * (q + 1) + (xcd - r) * q) + off; }
        const int nig = WGM * nN, gid = wgid / nig, fm = gid * WGM, gsz = (nM - fm) < WGM ? (nM - fm) : WGM;
        u.pm = fm + ((wgid % nig) % gsz); u.pn = (wgid % nig) / gsz; u.z = 0; return true;
    }
};

template <class Epi, class Sched, bool ALIGN_EPI, bool SP2, bool FP8 = false>
__device__ __forceinline__ void gemm_phase(LAS unsigned char* lds, const int tid_in, const char* base  , const int lda, const int ldb, const int K, const Sched& S, const Epi& E) {
    const int tid = tid_in, wid = __builtin_amdgcn_readfirstlane(tid >> 6), lane = tid & 63, wr = wid >> 2, wc = wid & 3, fr = lane & 15, fq = lane >> 4;
    const int nt = K / BK;
    unsigned voffA[2], voffB[2];
#pragma unroll
    for (int i = 0; i < 2; ++i) { int R, C; stage_rc(tid * 16 + i * 8192, R, C); const int Rb = Epi::PERM ? ((R & ~31) + perm32(R & 31)) : R;
        voffA[i] = (unsigned)(R * lda + C) * 2u; voffB[i] = (unsigned)(Rb * ldb + C) * 2u; }
    constexpr bool GATHER = Sched::GATHER;
    unsigned gvC[2][2], gvN[2][2];
#define PG8_GV(dst, unit) do { _Pragma("unroll") for (int hh_ = 0; hh_ < 2; ++hh_) _Pragma("unroll") for (int i_ = 0; i_ < 2; ++i_) { int R_, C_; stage_rc(tid * 16 + i_ * 8192, R_, C_); \
        dst[hh_][i_] = S.arow(unit, hh_ * HALF + R_) + (unsigned)C_ * 2u; } } while (0)
    const unsigned kstep = (unsigned)(BK * 2);
    const unsigned hstepA = (unsigned)(HALF * lda * 2), hstepB = (unsigned)(HALF * ldb * 2);
    const __amdgpu_buffer_rsrc_t rsrc = __builtin_amdgcn_make_buffer_rsrc((void*)base, 0, 0xffffffffu, 0x00020000);
    const unsigned ldsw = (unsigned)wid * 1024u;
    const int aoff = lds_byte(wr * 64 + fr, fq * 8), boff = lds_byte(wc * 32 + fr, fq * 8);
#define PG8_SA(b, h) (((b) * 2 + (h)) * HTB)
#define PG8_SB(b, h) ((4 + (b) * 2 + (h)) * HTB)
#define PG8_STAGE(bufoff, goff, voff) do { _Pragma("unroll") for (int _i = 0; _i < 2; ++_i) \
        __builtin_amdgcn_raw_ptr_buffer_load_lds(rsrc, (LAS unsigned*)(lds + (bufoff) + ldsw + _i * 8192), 16, (voff)[_i], (goff), 0, 0); } while (0)
#define PG8_STAGE_A(bufoff, aoff, hh, nx) do { if constexpr (GATHER) { unsigned gv_[2]; gv_[0] = (nx) ? gvN[hh][0] : gvC[hh][0]; gv_[1] = (nx) ? gvN[hh][1] : gvC[hh][1]; PG8_STAGE(bufoff, aoff, gv_); } \
        else { PG8_STAGE(bufoff, (aoff) + (hh) * hstepA, voffA); } } while (0)
#define PG8_LDA(dst, b, h) do { _Pragma("unroll") for (int m = 0; m < 4; ++m) _Pragma("unroll") for (int k = 0; k < 2; ++k) dst[m][k] = *(const LAS bf16x8*)(lds + PG8_SA(b, h) + aoff + m * 2048 + k * 1024); } while (0)
#define PG8_LDB(dst, b, h) do { _Pragma("unroll") for (int n = 0; n < 2; ++n) _Pragma("unroll") for (int k = 0; k < 2; ++k) dst[n][k] = *(const LAS bf16x8*)(lds + PG8_SB(b, h) + boff + n * 2048 + k * 1024); } while (0)
#define PG8_MMA(ai, bj, At, Bt) do { __builtin_amdgcn_s_setprio(1); \
        if constexpr (FP8) { _Pragma("unroll") for (int m = 0; m < 4; ++m) _Pragma("unroll") for (int n = 0; n < 2; ++n) \
            mfma8(acc[ai][bj][m][n], cat8(Bt[n][0], Bt[n][1]), cat8(At[m][0], At[m][1])); } \
        else { _Pragma("unroll") for (int m = 0; m < 4; ++m) _Pragma("unroll") for (int n = 0; n < 2; ++n) _Pragma("unroll") for (int k = 0; k < 2; ++k) \
            acc[ai][bj][m][n] = __builtin_amdgcn_mfma_f32_16x16x32_bf16(Bt[n][k], At[m][k], acc[ai][bj][m][n], 0, 0, 0); } \
        __builtin_amdgcn_s_setprio(0); } while (0)
#define PG8_WAIT_V(n) asm volatile("s_waitcnt vmcnt(" #n ")" ::: "memory")
#define PG8_WAIT_L(n) asm volatile("s_waitcnt lgkmcnt(" #n ")" ::: "memory")
#define PG8_BAR __builtin_amdgcn_s_barrier()
#define PG8_SCHED __builtin_amdgcn_sched_barrier(0)
    Unit cur, nxt; int ui = 0;
    if (!S.next(0, cur)) return;
    f32x4 acc[2][2][4][2];
#pragma unroll
    for (int a = 0; a < 2; ++a)
#pragma unroll
        for (int b = 0; b < 2; ++b)
#pragma unroll
            for (int m = 0; m < 4; ++m)
#pragma unroll
                for (int n = 0; n < 2; ++n) acc[a][b][m][n] = (f32x4){0.f, 0.f, 0.f, 0.f};
    bf16x8 At[4][2], B0[2][2], B1[2][2];
    unsigned cA = S.A(cur), cB = S.B(cur);
    if constexpr (GATHER) { PG8_GV(gvC, cur); _Pragma("unroll") for (int hh_ = 0; hh_ < 2; ++hh_) _Pragma("unroll") for (int i_ = 0; i_ < 2; ++i_) gvN[hh_][i_] = gvC[hh_][i_]; }
    if constexpr (SP2) {
        PG8_STAGE(PG8_SB(0, 0), cB, voffB); PG8_STAGE(PG8_SB(0, 1), cB + hstepB, voffB); PG8_STAGE_A(PG8_SA(0, 0), cA, 0, false); PG8_STAGE_A(PG8_SA(0, 1), cA, 1, false);
        if (wr == 1) PG8_BAR;
        PG8_WAIT_V(2); PG8_BAR;
        PG8_STAGE(PG8_SB(1, 0), cB + kstep, voffB); PG8_STAGE_A(PG8_SA(1, 0), cA + kstep, 0, false); PG8_STAGE(PG8_SB(1, 1), cB + hstepB + kstep, voffB);
        PG8_WAIT_V(6); PG8_BAR;
    } else {
        PG8_STAGE(PG8_SB(0, 0), cB, voffB); PG8_STAGE_A(PG8_SA(0, 0), cA, 0, false); PG8_STAGE(PG8_SB(0, 1), cB + hstepB, voffB); PG8_STAGE_A(PG8_SA(0, 1), cA, 1, false);
        if (wr == 1) PG8_BAR;
        PG8_WAIT_V(4); PG8_BAR;
        PG8_STAGE(PG8_SB(1, 0), cB + kstep, voffB); PG8_STAGE_A(PG8_SA(1, 0), cA + kstep, 0, false); PG8_STAGE(PG8_SB(1, 1), cB + hstepB + kstep, voffB);
        PG8_WAIT_V(6); PG8_BAR;
    }
    for (;;) {
        const bool has_next = S.next(ui + 1, nxt);
        const unsigned nA = has_next ? S.A(nxt) : cA, nB = has_next ? S.B(nxt) : cB;
        if constexpr (GATHER) { if (has_next) PG8_GV(gvN, nxt); }
        for (int t = 0; t < nt; t += 2) {
            const bool last = (t == nt - 2);
            const unsigned a1 = cA + (unsigned)(t + 1) * kstep;
            const unsigned a2 = last ? nA : cA + (unsigned)(t + 2) * kstep, b2 = last ? nB : cB + (unsigned)(t + 2) * kstep;
            const unsigned a3 = a2 + kstep, b3 = b2 + kstep;
            if constexpr (SP2) {
            PG8_LDB(B0, 0, 0); PG8_LDB(B1, 0, 1); PG8_SCHED; PG8_LDA(At, 0, 0); PG8_STAGE_A(PG8_SA(1, 1), a1, 1, false);
            PG8_WAIT_V(8); PG8_WAIT_L(0); PG8_BAR; PG8_MMA(0, 0, At, B0); PG8_MMA(0, 1, At, B1); PG8_BAR; PG8_SCHED;
            PG8_LDA(At, 0, 1); PG8_STAGE(PG8_SB(0, 0), b2, voffB); PG8_STAGE(PG8_SB(0, 1), b2 + hstepB, voffB); PG8_STAGE_A(PG8_SA(0, 0), a2, 0, last);
            PG8_WAIT_V(8); PG8_WAIT_L(0); PG8_BAR; PG8_MMA(1, 0, At, B0); PG8_MMA(1, 1, At, B1); PG8_BAR; PG8_SCHED;
            PG8_LDB(B0, 1, 0); PG8_LDB(B1, 1, 1); PG8_SCHED; PG8_LDA(At, 1, 0); PG8_STAGE_A(PG8_SA(0, 1), a2, 1, last);
            PG8_WAIT_V(8); PG8_WAIT_L(0); PG8_BAR; PG8_MMA(0, 0, At, B0); PG8_MMA(0, 1, At, B1); PG8_BAR; PG8_SCHED;
            PG8_LDA(At, 1, 1); PG8_STAGE(PG8_SB(1, 0), b3, voffB); PG8_STAGE(PG8_SB(1, 1), b3 + hstepB, voffB); PG8_STAGE_A(PG8_SA(1, 0), a3, 0, last);
            PG8_WAIT_V(8); PG8_WAIT_L(0); PG8_BAR; PG8_MMA(1, 0, At, B0); PG8_MMA(1, 1, At, B1); PG8_BAR; PG8_SCHED;
            } else {
            PG8_LDB(B0, 0, 0); PG8_SCHED; PG8_LDA(At, 0, 0); PG8_STAGE_A(PG8_SA(1, 1), a1, 1, false);
            PG8_WAIT_L(8); PG8_BAR; PG8_WAIT_L(0); PG8_MMA(0, 0, At, B0); PG8_BAR; PG8_SCHED;
            PG8_LDB(B1, 0, 1); PG8_STAGE(PG8_SB(0, 0), b2, voffB);
            PG8_BAR; PG8_WAIT_L(0); PG8_MMA(0, 1, At, B1); PG8_BAR;
            PG8_LDA(At, 0, 1); PG8_STAGE_A(PG8_SA(0, 0), a2, 0, last);
            PG8_BAR; PG8_WAIT_L(0); PG8_MMA(1, 0, At, B0); PG8_BAR; PG8_SCHED;
            PG8_STAGE(PG8_SB(0, 1), b2 + hstepB, voffB);
            PG8_WAIT_V(6); PG8_BAR; PG8_MMA(1, 1, At, B1); PG8_BAR;
            PG8_LDB(B0, 1, 0); PG8_SCHED; PG8_LDA(At, 1, 0); PG8_STAGE_A(PG8_SA(0, 1), a2, 1, last);
            PG8_WAIT_L(8); PG8_BAR; PG8_WAIT_L(0); PG8_MMA(0, 0, At, B0); PG8_BAR; PG8_SCHED;
            PG8_LDB(B1, 1, 1); PG8_STAGE(PG8_SB(1, 0), b3, voffB);
            PG8_BAR; PG8_WAIT_L(0); PG8_MMA(0, 1, At, B1); PG8_BAR;
            PG8_LDA(At, 1, 1); PG8_STAGE_A(PG8_SA(1, 0), a3, 0, last);
            PG8_BAR; PG8_WAIT_L(0); PG8_MMA(1, 0, At, B0); PG8_BAR; PG8_SCHED;
            PG8_STAGE(PG8_SB(1, 1), b3 + hstepB, voffB);
            PG8_WAIT_V(6); PG8_BAR; PG8_MMA(1, 1, At, B1); PG8_BAR;
            }
        }
        if constexpr (ALIGN_EPI) { if (wr == 0) PG8_BAR; }
        if constexpr (FP8) asm volatile("s_nop 15\n\ts_nop 15\n\ts_nop 7" ::: "memory");
        E(acc, cur, wr, wc, fr, fq);
        if (!has_next) break;
#pragma unroll
        for (int a = 0; a < 2; ++a)
#pragma unroll
            for (int b = 0; b < 2; ++b)
#pragma unroll
                for (int m = 0; m < 4; ++m)
#pragma unroll
                    for (int n = 0; n < 2; ++n) acc[a][b][m][n] = (f32x4){0.f, 0.f, 0.f, 0.f};
        cur = nxt; cA = nA; cB = nB; ++ui;
        if constexpr (GATHER) { _Pragma("unroll") for (int hh_ = 0; hh_ < 2; ++hh_) _Pragma("unroll") for (int i_ = 0; i_ < 2; ++i_) gvC[hh_][i_] = gvN[hh_][i_]; }
        if constexpr (ALIGN_EPI) { if (wr == 1) PG8_BAR; }
    }
    PG8_WAIT_V(0);
    if constexpr (!ALIGN_EPI) { if (wr == 0) PG8_BAR; }
    PG8_BAR;
#undef PG8_SA
#undef PG8_SB
#undef PG8_STAGE
#undef PG8_STAGE_A
#undef PG8_GV
#undef PG8_LDA
#undef PG8_LDB
#undef PG8_MMA
#undef PG8_WAIT_V
#undef PG8_WAIT_L
#undef PG8_BAR
#undef PG8_SCHED
}

struct SchedPlain : Order {
    static constexpr bool GATHER = false; __device__ __forceinline__ unsigned arow(const Unit&, int) const { return 0u; }
    unsigned A0, B0, at, bt;
    __device__ __forceinline__ bool next(int i, Unit& u) const { return next_mn(i, u); }
    __device__ __forceinline__ unsigned A(const Unit& u) const { return A0 + (unsigned)u.pm * at; }
    __device__ __forceinline__ unsigned B(const Unit& u) const { return B0 + (unsigned)u.pn * bt; }
};
struct SchedLora : Order {
    static constexpr bool GATHER = false; __device__ __forceinline__ unsigned arow(const Unit&, int) const { return 0u; }
    unsigned A0, B0; int skipv;
    __device__ __forceinline__ bool next(int i, Unit& u) const { if (!next_mn(i, u)) return false; if (skipv && u.pn >= 12) u.pn += 6; return true; }
    __device__ __forceinline__ unsigned A(const Unit& u) const { return A0 + (unsigned)u.pm * (256u * 512u * 2u) + (u.pn >= 18 ? 512u : 0u); }
    __device__ __forceinline__ unsigned B(const Unit& u) const { return B0 + (unsigned)u.pn * (256u * 256u * 2u); }
};
struct SchedMem {
    static constexpr bool GATHER = false; __device__ __forceinline__ unsigned arow(const Unit&, int) const { return 0u; }
    int G, c; unsigned memb, wkv;
    __device__ __forceinline__ bool next(int i, Unit& u) const {
        const int L = i * G + c; if (L >= 64) return false;
        if (L < 32) { u.z = 0; u.pm = L >> 1; u.pn = L & 1; } else { const int q = L - 32; u.z = 1; u.pm = q & 1; u.pn = q >> 1; }
        return true;
    }
    __device__ __forceinline__ unsigned A(const Unit& u) const { return u.z == 0 ? memb + (unsigned)u.pm * (256u * 2048u * 2u) : wkv + (unsigned)(2 + u.pm) * (256u * 2048u * 2u); }
    __device__ __forceinline__ unsigned B(const Unit& u) const { return u.z == 0 ? wkv + (unsigned)u.pn * (256u * 2048u * 2u) : memb + (unsigned)u.pn * (256u * 2048u * 2u); }
};
struct SchedMoE : Order {
    static constexpr bool GATHER = false; __device__ __forceinline__ unsigned arow(const Unit&, int) const { return 0u; }
    unsigned A0, B0, at, bt, be; const int* texp;
    __device__ __forceinline__ bool next(int i, Unit& u) const { if (!next_mn(i, u)) return false; u.z = __builtin_amdgcn_readfirstlane(texp[u.pm]); return true; }
    __device__ __forceinline__ unsigned A(const Unit& u) const { return A0 + (unsigned)u.pm * at; }
    __device__ __forceinline__ unsigned B(const Unit& u) const { return B0 + (unsigned)u.z * be + (unsigned)u.pn * bt; }
};

struct SchedMoEg : Order {
    static constexpr bool GATHER = true;
    unsigned B0, bt, be, xoff, zoff; const int* texp; const int* slot_tok;
    __device__ __forceinline__ bool next(int i, Unit& u) const { if (!next_mn(i, u)) return false; u.z = __builtin_amdgcn_readfirstlane(texp[u.pm]); return true; }
    __device__ __forceinline__ unsigned A(const Unit&) const { return 0u; }
    __device__ __forceinline__ unsigned B(const Unit& u) const { return B0 + (unsigned)u.z * be + (unsigned)u.pn * bt; }
    __device__ __forceinline__ unsigned arow(const Unit& u, int r) const { const int tok = slot_tok[u.pm * 256 + r]; return tok < 0 ? zoff : xoff + (unsigned)tok * 2048u; }
};

struct EpiBf16 {
    static constexpr bool PERM = true;
    bf16* O; int ldc;
    __device__ __forceinline__ void operator()(const f32x4 (&acc)[2][2][4][2], const Unit& u, int wr, int wc, int fr, int fq) const {
        const int row0 = u.pm * BM + wr * 64 + fr, col0 = u.pn * BM + wc * 32 + 8 * fq;
#pragma unroll
        for (int ai = 0; ai < 2; ++ai)
#pragma unroll
            for (int m = 0; m < 4; ++m) { bf16* rowp = O + (size_t)(row0 + ai * HALF + m * 16) * ldc + col0;
#pragma unroll
                for (int bj = 0; bj < 2; ++bj) { const f32x4 v0 = acc[ai][bj][m][0], v1 = acc[ai][bj][m][1];
                    u32x4 w; w.x = cvt_pk_bf16(v0[0], v0[1]); w.y = cvt_pk_bf16(v0[2], v0[3]); w.z = cvt_pk_bf16(v1[0], v1[1]); w.w = cvt_pk_bf16(v1[2], v1[3]);
                    *(u32x4*)(rowp + bj * HALF) = w; } }
    }
};
struct EpiMem {
    static constexpr bool PERM = true;
    bf16* O0; bf16* O1;
    __device__ __forceinline__ void operator()(const f32x4 (&acc)[2][2][4][2], const Unit& u, int wr, int wc, int fr, int fq) const {
        EpiBf16 e; e.O = u.z == 0 ? O0 : O1; e.ldc = u.z == 0 ? 512 : 4096; e(acc, u, wr, wc, fr, fq);
    }
};
struct EpiLora {
    static constexpr bool PERM = true;
    bf16* O; const float* vecs;
    __device__ __forceinline__ void operator()(const f32x4 (&acc)[2][2][4][2], const Unit& u, int wr, int wc, int fr, int fq) const {
        const int type = u.pn / 6;
        const int row0 = u.pm * BM + wr * 64 + fr, col0 = u.pn * BM + wc * 32 + 8 * fq, cb0 = (u.pn % 6) * BM + wc * 32 + 8 * fq;
        const float* bp = vecs + (type < 3 ? type : 0) * SW;
        const float sc = type == 0 ? 0.6065306597126334f : 1.0f;
#pragma unroll
        for (int bj = 0; bj < 2; ++bj) {
            f32x4 bv0 = (f32x4){0.f, 0.f, 0.f, 0.f}, bv1 = bv0;
            if (type < 3) { bv0 = *(const f32x4*)(bp + cb0 + bj * HALF); bv1 = *(const f32x4*)(bp + cb0 + bj * HALF + 4); }
#pragma unroll
            for (int ai = 0; ai < 2; ++ai)
#pragma unroll
                for (int m = 0; m < 4; ++m) { bf16* rowp = O + (size_t)(row0 + ai * HALF + m * 16) * 6144 + col0 + bj * HALF;
                    f32x4 v0_ = acc[ai][bj][m][0] + bv0, v1_ = acc[ai][bj][m][1] + bv1;
                    if (type < 3) {
#pragma unroll
                        for (int j = 0; j < 4; ++j) { v0_[j] = sc * sigmoidf_(v0_[j]); v1_[j] = sc * sigmoidf_(v1_[j]); } }
                    u32x4 w; w.x = cvt_pk_bf16(v0_[0], v0_[1]); w.y = cvt_pk_bf16(v0_[2], v0_[3]); w.z = cvt_pk_bf16(v1_[0], v1_[1]); w.w = cvt_pk_bf16(v1_[2], v1_[3]);
                    *(u32x4*)rowp = w; asm volatile("" ::: "memory"); }
        }
    }
};
struct EpiSwiglu {
    static constexpr bool PERM = true;
    bf16* O; int ldc;
    __device__ __forceinline__ void operator()(const f32x4 (&acc)[2][2][4][2], const Unit& u, int wr, int wc, int fr, int fq) const {
        const int row0 = u.pm * BM + wr * 64 + fr, col0 = u.pn * HALF + wc * 32 + 8 * fq;
#pragma unroll
        for (int ai = 0; ai < 2; ++ai)
#pragma unroll
            for (int m = 0; m < 4; ++m) { bf16* rowp = O + (size_t)(row0 + ai * HALF + m * 16) * ldc + col0;
                float h[8];
#pragma unroll
                for (int n = 0; n < 2; ++n)
#pragma unroll
                    for (int j = 0; j < 4; ++j) { const float g = acc[ai][0][m][n][j], up = acc[ai][1][m][n][j]; h[n * 4 + j] = g * sigmoidf_(g) * up; }
                u32x4 w; w.x = cvt_pk_bf16(h[0], h[1]); w.y = cvt_pk_bf16(h[2], h[3]); w.z = cvt_pk_bf16(h[4], h[5]); w.w = cvt_pk_bf16(h[6], h[7]);
                *(u32x4*)rowp = w; asm volatile("" ::: "memory"); }
    }
};
struct EpiSwiglu8 {
    static constexpr bool PERM = true;
    unsigned char* O; int ldc; float inv, so;
    __device__ __forceinline__ void operator()(const f32x4 (&acc)[2][2][4][2], const Unit& u, int wr, int wc, int fr, int fq) const {
        const int row0 = u.pm * BM + wr * 64 + fr, col0 = u.pn * HALF + wc * 32 + 8 * fq;
        const float c1 = -inv * 1.4426950408889634f, c2 = inv * inv * so;
#pragma unroll
        for (int ai = 0; ai < 2; ++ai)
#pragma unroll
            for (int m = 0; m < 4; ++m) { unsigned char* rowp = O + (size_t)(row0 + ai * HALF + m * 16) * ldc + col0;
                float h[8];
#pragma unroll
                for (int n = 0; n < 2; ++n)
#pragma unroll
                    for (int j = 0; j < 4; ++j) { const float ag = acc[ai][0][m][n][j], au = acc[ai][1][m][n][j];
                        h[n * 4 + j] = (ag * au) * __builtin_amdgcn_rcpf(1.0f + __builtin_amdgcn_exp2f(ag * c1)) * c2; }
                u32x2 w; w.x = pk4_fp8(h[0], h[1], h[2], h[3]); w.y = pk4_fp8(h[4], h[5], h[6], h[7]);
                *(u32x2*)rowp = w; asm volatile("" ::: "memory"); }
    }
};
struct EpiBf16S {
    static constexpr bool PERM = true;
    bf16* O; int ldc; float sc;
    __device__ __forceinline__ void operator()(const f32x4 (&acc)[2][2][4][2], const Unit& u, int wr, int wc, int fr, int fq) const {
        const int row0 = u.pm * BM + wr * 64 + fr, col0 = u.pn * BM + wc * 32 + 8 * fq;
#pragma unroll
        for (int ai = 0; ai < 2; ++ai)
#pragma unroll
            for (int m = 0; m < 4; ++m) { bf16* rowp = O + (size_t)(row0 + ai * HALF + m * 16) * ldc + col0;
#pragma unroll
                for (int bj = 0; bj < 2; ++bj) { const f32x4 v0 = acc[ai][bj][m][0] * sc, v1 = acc[ai][bj][m][1] * sc;
                    u32x4 w; w.x = cvt_pk_bf16(v0[0], v0[1]); w.y = cvt_pk_bf16(v0[2], v0[3]); w.z = cvt_pk_bf16(v1[0], v1[1]); w.w = cvt_pk_bf16(v1[2], v1[3]);
                    *(u32x4*)(rowp + bj * HALF) = w; } }
    }
};
struct EpiFp8S {
    static constexpr bool PERM = true;
    unsigned char* O; int ldc; float sc;
    __device__ __forceinline__ void operator()(const f32x4 (&acc)[2][2][4][2], const Unit& u, int wr, int wc, int fr, int fq) const {
        const int row0 = u.pm * BM + wr * 64 + fr, col0 = u.pn * BM + wc * 32 + 8 * fq;
#pragma unroll
        for (int ai = 0; ai < 2; ++ai)
#pragma unroll
            for (int m = 0; m < 4; ++m) { unsigned char* rowp = O + (size_t)(row0 + ai * HALF + m * 16) * ldc + col0;
#pragma unroll
                for (int bj = 0; bj < 2; ++bj) { const f32x4 v0 = acc[ai][bj][m][0] * sc, v1 = acc[ai][bj][m][1] * sc;
                    u32x2 w; w.x = pk4_fp8(v0[0], v0[1], v0[2], v0[3]); w.y = pk4_fp8(v1[0], v1[1], v1[2], v1[3]);
                    *(u32x2*)(rowp + bj * HALF) = w; } }
    }
};
struct EpiRes {
    static constexpr bool PERM = false;
    const float* X; float* T;
    __device__ __forceinline__ void operator()(const f32x4 (&acc)[2][2][4][2], const Unit& u, int wr, int wc, int fr, int fq) const {
        const int row0 = u.pm * BM + wr * 64 + fr, col0 = u.pn * BM + wc * 32 + 4 * fq;
#pragma unroll
        for (int ai = 0; ai < 2; ++ai)
#pragma unroll
            for (int m = 0; m < 4; ++m) { const size_t off = (size_t)(row0 + ai * HALF + m * 16) * D + col0;
#pragma unroll
                for (int bj = 0; bj < 2; ++bj)
#pragma unroll
                    for (int n = 0; n < 2; ++n) { const f32x4 xv = *(const f32x4*)(X + off + bj * HALF + n * 16);
                        *(f32x4*)(T + off + bj * HALF + n * 16) = xv * ALPHA + acc[ai][bj][m][n]; } }
    }
};
}

struct Args {
    const float* in[43];
    float* out; unsigned char* ws;
    int ph_lo, ph_hi;
};
struct Ctx { LAS unsigned char* lds; int tid, lane, wave, bid, G, gw, NGW; unsigned char* ws; };

enum { I_X = 0, I_MEM = 1, I_POS = 2, I_WKV = 3,
       L0_WIN = 4, L0_MU, L0_LW, L0_LA, L0_LG, L0_VECS, L0_WOUT, L0_NORMS, L0_FG, L0_FU, L0_FD,
       L1_WIN = 15, L1_GN, L1_WOUT, L1_NORMS, L1_ROUTER, L1_MG, L1_MU_, L1_MD,
       L2_WIN = 23, L2_MU, L2_LW, L2_LA, L2_LV, L2_LG, L2_VECS, L2_WOUT, L2_NORMS, L2_FG, L2_FU, L2_FD,
       L3_WIN = 35, L3_GN, L3_WOUT, L3_NORMS, L3_ROUTER, L3_MG, L3_MU_, L3_MD };

__device__ __forceinline__ void tr_load(f32x4 (&v)[8], const float* W, int ldw, int k0, int n0, int lane) {
#pragma unroll
    for (int i = 0; i < 8; ++i) v[i] = *(const f32x4*)(W + (size_t)(k0 + 8 * i + (lane >> 3)) * ldw + n0 + 4 * (lane & 7));
}
__device__ __forceinline__ void tr_store(const f32x4 (&v)[8], int k0, bf16* WT, int ldt, int drow0, LAS float* scr, int lane) {
#pragma unroll
    for (int i = 0; i < 8; ++i) { LAS float* d = scr + (8 * i + (lane >> 3)) * 33 + 4 * (lane & 7); d[0] = v[i][0]; d[1] = v[i][1]; d[2] = v[i][2]; d[3] = v[i][3]; }
    LDS_WAIT(); asm volatile("" ::: "memory");
    const int c = lane & 7;
#pragma unroll
    for (int j = 0; j < 4; ++j) { const int n = (lane >> 3) + 8 * j; const LAS float* s = scr + (8 * c) * 33 + n;
        u32x4 o; o.x = cvt_pk_bf16(s[0 * 33], s[1 * 33]); o.y = cvt_pk_bf16(s[2 * 33], s[3 * 33]); o.z = cvt_pk_bf16(s[4 * 33], s[5 * 33]); o.w = cvt_pk_bf16(s[6 * 33], s[7 * 33]);
        *(u32x4*)(WT + (size_t)(drow0 + n) * ldt + k0 + 8 * c) = o; }
    LDS_WAIT(); asm volatile("" ::: "memory");
}
__device__ __forceinline__ void conv_mat(const Ctx& C, const float* W, int K, int N, bf16* WT, int mode, int off, int gw0) {
    LAS float* scr = (LAS float*)(C.lds + C.wave * 16384);
    const int nblk = N / 32, items = (K / 64) * nblk;
    int start = C.gw - gw0; if (start < 0) start += C.NGW;
#define CONV_DROW(n0_) (mode == 0 ? off + (n0_) : ((n0_) / 128) * 256 + off + ((n0_) % 128))
    f32x4 va[8], vb[8];
    int it = start;
    if (it < items) tr_load(va, W, N, 64 * (it / nblk), 32 * (it % nblk), C.lane);
    while (it < items) {
        const int it1 = it + C.NGW;
        if (it1 < items) tr_load(vb, W, N, 64 * (it1 / nblk), 32 * (it1 % nblk), C.lane);
        tr_store(va, 64 * (it / nblk), WT, K, CONV_DROW(32 * (it % nblk)), scr, C.lane);
        if (it1 >= items) break;
        const int it2 = it1 + C.NGW;
        if (it2 < items) tr_load(va, W, N, 64 * (it2 / nblk), 32 * (it2 % nblk), C.lane);
        tr_store(vb, 64 * (it1 / nblk), WT, K, CONV_DROW(32 * (it1 % nblk)), scr, C.lane);
        it = it2;
    }
#undef CONV_DROW
}
__device__ __forceinline__ void conv_lora(const Ctx& C, const float* lw, const float* la, const float* lv, const float* lg, bf16* Bt) {
    for (int idx = C.bid * NTHR + C.tid; idx < 6144 * 256; idx += C.G * NTHR) {
        const int n_ = idx % 1536, rest = idx / 1536, k = rest % 256, blk = rest / 256;
        float v = 0.f;
        if (blk == 0) { if (k < 96) v = lw[k * 1536 + n_]; }
        else if (blk == 1) { if (k >= 96 && k < 192) v = la[(k - 96) * 1536 + n_]; }
        else if (blk == 2) { if (lv && k >= 192) v = lv[(k - 192) * 1536 + n_]; }
        else v = lg[k * 1536 + n_];
        Bt[(size_t)(blk * 1536 + n_) * 256 + k] = f2bf(v);
    }
}
__device__ __forceinline__ void conv_f32_bf16(const Ctx& C, const float* src, bf16* dst, size_t n8) {
    const size_t T = (size_t)C.G * NTHR;
    for (size_t i0 = (size_t)C.bid * NTHR + C.tid; i0 < n8; i0 += 4 * T) { f32x4 av[4], bv[4];
#pragma unroll
        for (int q = 0; q < 4; ++q) { av[q] = ((const f32x4*)src)[2 * (i0 + q * T)]; bv[q] = ((const f32x4*)src)[2 * (i0 + q * T) + 1]; }
#pragma unroll
        for (int q = 0; q < 4; ++q) { const f32x4 a = av[q], b = bv[q];
            u32x4 w; w.x = cvt_pk_bf16(a[0], a[1]); w.y = cvt_pk_bf16(a[2], a[3]); w.z = cvt_pk_bf16(b[0], b[1]); w.w = cvt_pk_bf16(b[2], b[3]);
            ((u32x4*)dst)[i0 + q * T] = w; } }
}

struct CvJob { const float* W; bf16* WT; int N, K, k0, n0, mode, off; float f8s; };
__device__ __forceinline__ void cv_load(f32x4 (&v)[8], const CvJob& J, int wave, int lane) {
    const int n = J.n0 + 4 * lane;
#pragma unroll
    for (int i = 0; i < 8; ++i) { v[i] = (f32x4){0.f, 0.f, 0.f, 0.f}; if (n < J.N) v[i] = *(const f32x4*)(J.W + (size_t)(J.k0 + 8 * wave + i) * J.N + n); }
}
__device__ __forceinline__ void cv_put(const f32x4 (&v)[8], LAS float* T, int wave, int lane) {
#pragma unroll
    for (int i = 0; i < 8; ++i) *(LAS f32x4*)(T + (8 * wave + i) * 256 + 4 * (lane ^ wave)) = v[i];
}
__device__ __forceinline__ void cv_out(const CvJob& J, const LAS float* T, int wave, int lane) {
    const int c = lane & 7;
#pragma unroll
    for (int j = 0; j < 4; ++j) { const int nl = 32 * wave + 8 * j + (lane >> 3), n = J.n0 + nl; const LAS float* s = T + (8 * c) * 256 + (nl ^ (c << 2));
        u32x4 o; o.x = cvt_pk_bf16(s[0 * 256], s[1 * 256]); o.y = cvt_pk_bf16(s[2 * 256], s[3 * 256]); o.z = cvt_pk_bf16(s[4 * 256], s[5 * 256]); o.w = cvt_pk_bf16(s[6 * 256], s[7 * 256]);
        if (n < J.N) { const int drow = J.mode == 0 ? J.off + n : (n / 128) * 256 + J.off + (n % 128);
            *(u32x4*)(J.WT + (size_t)drow * J.K + J.k0 + 8 * c) = o; } }
}
__device__ __forceinline__ void cv_out8(const CvJob& J, const LAS float* T, int wave, int lane) {
    const int c4 = lane & 3; unsigned char* W8 = (unsigned char*)J.WT;
#pragma unroll
    for (int j = 0; j < 2; ++j) { const int nl = 32 * wave + 16 * j + (lane >> 2), n = J.n0 + nl;
        float v[16];
#pragma unroll
        for (int q = 0; q < 16; ++q) { const int k = 16 * c4 + q; v[q] = T[k * 256 + (nl ^ (((k >> 3) & 7) << 2))] * J.f8s; }
        u32x4 o; o.x = pk4_fp8(v[0], v[1], v[2], v[3]); o.y = pk4_fp8(v[4], v[5], v[6], v[7]); o.z = pk4_fp8(v[8], v[9], v[10], v[11]); o.w = pk4_fp8(v[12], v[13], v[14], v[15]);
        if (n < J.N) { const int drow = J.mode == 0 ? J.off + n : (n / 128) * 256 + J.off + (n % 128);
            *(u32x4*)(W8 + (size_t)drow * J.K + J.k0 + 16 * c4) = o; } }
}
template <class Dec>
__device__ __forceinline__ void conv_run(const Ctx& C, int ntiles, const Dec& dec, const int t0 = -1, const int STR = GRID) {
    LAS float* T = (LAS float*)C.lds;
    f32x4 va[8], vb[8]; CvJob ja, jb, jc;
    int t = t0 < 0 ? C.bid : t0;
    if (t < ntiles) { dec(t, ja); cv_load(va, ja, C.wave, C.lane); }
    if (t + STR < ntiles) { dec(t + STR, jb); cv_load(vb, jb, C.wave, C.lane); }
    while (t < ntiles) {
        __syncthreads(); cv_put(va, T, C.wave, C.lane); jc = ja;
        if (t + 2 * STR < ntiles) { dec(t + 2 * STR, ja); cv_load(va, ja, C.wave, C.lane); }
        __syncthreads(); if (jc.f8s > 0.f) cv_out8(jc, T, C.wave, C.lane); else cv_out(jc, T, C.wave, C.lane);
        t += STR; if (t >= ntiles) break;
        __syncthreads(); cv_put(vb, T, C.wave, C.lane); jc = jb;
        if (t + 2 * STR < ntiles) { dec(t + 2 * STR, jb); cv_load(vb, jb, C.wave, C.lane); }
        __syncthreads(); if (jc.f8s > 0.f) cv_out8(jc, T, C.wave, C.lane); else cv_out(jc, T, C.wave, C.lane);
        t += STR;
    }
    __syncthreads();
}
struct MoeDec { const float* mg; const float* mu; const float* md; unsigned char* ws;
    __device__ __forceinline__ void operator()(int t, CvJob& J) const {
        const int j = t / 704, r = t % 704, e = j / 3, kind = j % 3;
        if (kind < 2) { J.W = (kind == 0 ? mg : mu) + (size_t)e * 2048 * 5632; J.WT = (bf16*)(ws + WS_MWGU + (size_t)e * 22 * MiB); J.N = 5632; J.K = 2048; J.mode = 1; J.off = kind * 128; J.f8s = 1024.f; J.k0 = 64 * (r / 22); J.n0 = 256 * (r % 22); }
        else { J.W = md + (size_t)e * 2048 * 5632; J.WT = (bf16*)(ws + WS_MWD + (size_t)e * 11 * MiB); J.N = 2048; J.K = 5632; J.mode = 0; J.off = 0; J.f8s = 2048.f; J.k0 = 64 * (r / 8); J.n0 = 256 * (r % 8); }
    } };
struct StaticDec { const float* const* in; unsigned char* ws;
    __device__ __forceinline__ void set(CvJob& J, const float* W, bf16* WT, int K, int N, int mode, int off, int r, float f8s = 0.f) const {
        const int nn = (N + 255) / 256; J.W = W; J.WT = WT; J.N = N; J.K = K; J.mode = mode; J.off = off; J.f8s = f8s; J.k0 = 64 * (r / nn); J.n0 = 256 * (r % nn); }
    __device__ __forceinline__ void operator()(int t, CvJob& J) const {
        int r = t;
        if (r < 128) { set(J, in[I_WKV], (bf16*)(ws + WS_WKV), 2048, 1024, 0, 0, r); return; } r -= 128;
        set(J, in[L0_WIN], (bf16*)(ws + WS_WIN), 2048, 5568, 0, 0, r);
    } };

struct SlotDec { const float* const* in; unsigned char* ws; int lq; MoeDec moe; StaticDec sd;
    __device__ __forceinline__ void operator()(int t, CvJob& J) const {
        if (t < 16896) { moe(t, J); return; }
        int r = t - 16896; const size_t l = (size_t)lq;
        if (r < 704) { sd.set(J, lq ? in[L2_FG] : in[L0_FG], (bf16*)(ws + WS_WFGU + l * 44 * MiB), 2048, 5632, 1, 0, r, 1024.f); return; } r -= 704;
        if (r < 704) { sd.set(J, lq ? in[L2_FU] : in[L0_FU], (bf16*)(ws + WS_WFGU + l * 44 * MiB), 2048, 5632, 1, 128, r, 1024.f); return; } r -= 704;
        if (r < 704) { sd.set(J, lq ? in[L2_FD] : in[L0_FD], (bf16*)(ws + WS_WFD + l * 22 * MiB), 5632, 2048, 0, 0, r, 2048.f); return; } r -= 704;
        if (r < 256) { sd.set(J, lq ? in[L2_WOUT] : in[L0_WOUT], (bf16*)(ws + WS_WOUT + l * 16 * MiB), 2048, 2048, 0, 0, r); return; } r -= 256;
        if (r < 256) { sd.set(J, lq ? in[L3_WOUT] : in[L1_WOUT], (bf16*)(ws + WS_WOUT + (l * 16 + 8) * MiB), 2048, 2048, 0, 0, r); return; } r -= 256;
        if (r < 640) { sd.set(J, lq ? in[L3_WIN] : in[L1_WIN], (bf16*)(ws + WS_WIN + (l * 44 + 22) * MiB), 2048, 5120, 0, 0, r); return; } r -= 640;
        sd.set(J, in[L2_WIN], (bf16*)(ws + WS_WIN + (size_t)44 * MiB), 2048, 5632, 0, 0, r);
    } };

__device__ __forceinline__ void ph_prologue(const Ctx& C, const Args& A) {
    unsigned char* ws = C.ws;
    { StaticDec dec; dec.in = A.in; dec.ws = ws; conv_run(C, 832, dec); }
    conv_lora(C, A.in[L0_LW], A.in[L0_LA], nullptr, A.in[L0_LG], (bf16*)(ws + WS_WLORA));
    conv_lora(C, A.in[L2_LW], A.in[L2_LA], A.in[L2_LV], A.in[L2_LG], (bf16*)(ws + WS_WLORA + 3 * MiB));
    { u32x4* z = (u32x4*)(ws + WS_WIN + (size_t)5568 * 2048 * 2);
      for (int i = C.bid * NTHR + C.tid; i < 64 * 2048 * 2 / 16; i += C.G * NTHR) z[i] = (u32x4){0u, 0u, 0u, 0u}; }
    { const f32x4* xs = (const f32x4*)A.in[I_X]; u32x2* hi = (u32x2*)(ws + WS_XB); unsigned* lo = (unsigned*)(ws + WS_XLO);
      const size_t T = (size_t)C.G * NTHR;
      for (size_t i0 = (size_t)C.bid * NTHR + C.tid; i0 < (size_t)M * D / 4; i0 += 8 * T) { f32x4 ov[8];
#pragma unroll
          for (int q = 0; q < 8; ++q) ov[q] = xs[i0 + q * T];
#pragma unroll
          for (int q = 0; q < 8; ++q) { const f32x4 o = ov[q]; const size_t i = i0 + q * T;
              u32x2 w; w.x = cvt_pk_bf16(o[0], o[1]); w.y = cvt_pk_bf16(o[2], o[3]); hi[i] = w;
              lo[i] = pk4_fp8((o[0] - bflo(w.x)) * 8192.f, (o[1] - bfhi(w.x)) * 8192.f, (o[2] - bflo(w.y)) * 8192.f, (o[3] - bfhi(w.y)) * 8192.f); } } }
    conv_f32_bf16(C, A.in[I_MEM], (bf16*)(ws + WS_MEMB), (size_t)4096 * 2048 / 8);
    { const int* pos = (const int*)A.in[I_POS]; f32x2* cs = (f32x2*)(ws + WS_CS);
      for (int idx = C.bid * NTHR + C.tid; idx < M * 64; idx += C.G * NTHR) {
          const int m = idx >> 6, i = idx & 63;
          const float pw = (float)exp2(13.287712379549449 * (double)i / 64.0);
          const float inv = 1.0f / pw;
          const float ang = (float)pos[m] * inv;
          const double x = (double)ang;
          const double n = rint(x * 0.15915494309189535);
          const double r = fma(-n, 6.283185307179586, x) - n * 2.4492935982947064e-16;
          const double r2 = r * r;
          double s = -1.0 / 121645100408832000.0;
          s = fma(s, r2, 1.0 / 355687428096000.0);
          s = fma(s, r2, -1.0 / 1307674368000.0);
          s = fma(s, r2, 1.0 / 6227020800.0);
          s = fma(s, r2, -1.0 / 39916800.0);
          s = fma(s, r2, 1.0 / 362880.0);
          s = fma(s, r2, -1.0 / 5040.0);
          s = fma(s, r2, 1.0 / 120.0);
          s = fma(s, r2, -1.0 / 6.0);
          s = fma(s * r2, r, r);
          double c = 1.0 / 2432902008176640000.0;
          c = fma(c, r2, -1.0 / 6402373705728000.0);
          c = fma(c, r2, 1.0 / 20922789888000.0);
          c = fma(c, r2, -1.0 / 87178291200.0);
          c = fma(c, r2, 1.0 / 479001600.0);
          c = fma(c, r2, -1.0 / 3628800.0);
          c = fma(c, r2, 1.0 / 40320.0);
          c = fma(c, r2, -1.0 / 720.0);
          c = fma(c, r2, 1.0 / 24.0);
          c = fma(c, r2, -0.5);
          c = fma(c, r2, 1.0);
          cs[idx] = (f32x2){(float)c, (float)s};
      } }
}

struct LnRow { u32x2 rh[8]; unsigned rl[8]; u32x2 a[8]; float w1, w2; };
__device__ __forceinline__ void ln_load(LnRow& R, const Ctx& C, int m, const void* Hp, int hmode, int s1, int s2, float w1, float w2) {
    const u32x2* hr = (const u32x2*)(C.ws + WS_XB + (size_t)m * D * 2) + C.lane;
    const unsigned* lr = (const unsigned*)(C.ws + (hmode == 0 ? WS_XLO : WS_X8) + (size_t)m * D) + C.lane;
#pragma unroll
    for (int j = 0; j < 8; ++j) { R.rh[j] = hr[64 * j]; R.rl[j] = lr[64 * j]; }
    if (hmode == 0) {
        const u32x2* ar = (const u32x2*)((const bf16*)Hp + (size_t)m * D) + C.lane;
#pragma unroll
        for (int j = 0; j < 8; ++j) R.a[j] = ar[64 * j];
        R.w1 = 1.f; R.w2 = 0.f;
    } else if (hmode == 1) {
        const unsigned* ar = (const unsigned*)((const unsigned char*)Hp + (size_t)m * D) + C.lane;
#pragma unroll
        for (int j = 0; j < 8; ++j) { R.a[j].x = ar[64 * j]; R.a[j].y = 0u; }
        R.w1 = 1.f / 256.f; R.w2 = 0.f;
    } else {
        R.w1 = w1; R.w2 = w2;
        const unsigned* y1 = (const unsigned*)((const unsigned char*)Hp + (size_t)s1 * D) + C.lane;
        const unsigned* y2 = (const unsigned*)((const unsigned char*)Hp + (size_t)s2 * D) + C.lane;
#pragma unroll
        for (int j = 0; j < 8; ++j) { R.a[j].x = y1[64 * j]; R.a[j].y = y2[64 * j]; }
    }
}
__device__ __forceinline__ void ln_row(const LnRow& R, const Ctx& C, int m, const LAS float* gb, int hmode, float* Xf32out, unsigned char* X8out,
                                       LAS float* rw, LAS int* hist, bool do_route) {
    const int l4 = 4 * C.lane;
    f32x4 v[8]; float s = 0.f;
#pragma unroll
    for (int j = 0; j < 8; ++j) { f32x4 f, x;
        const f32x2 l01 = __builtin_amdgcn_cvt_pk_f32_fp8(R.rl[j], false), l23 = __builtin_amdgcn_cvt_pk_f32_fp8(R.rl[j], true);
        const float ls = hmode == 0 ? (1.f / 8192.f) : (1.f / 16.f);
        x[0] = bflo(R.rh[j].x) + l01[0] * ls; x[1] = bfhi(R.rh[j].x) + l01[1] * ls; x[2] = bflo(R.rh[j].y) + l23[0] * ls; x[3] = bfhi(R.rh[j].y) + l23[1] * ls;
        if (hmode == 0) { f[0] = bflo(R.a[j].x); f[1] = bfhi(R.a[j].x); f[2] = bflo(R.a[j].y); f[3] = bfhi(R.a[j].y); }
        else { const f32x2 a01 = __builtin_amdgcn_cvt_pk_f32_fp8(R.a[j].x, false), a23 = __builtin_amdgcn_cvt_pk_f32_fp8(R.a[j].x, true);
            f[0] = R.w1 * a01[0]; f[1] = R.w1 * a01[1]; f[2] = R.w1 * a23[0]; f[3] = R.w1 * a23[1];
            if (hmode == 2) { const f32x2 b01 = __builtin_amdgcn_cvt_pk_f32_fp8(R.a[j].y, false), b23 = __builtin_amdgcn_cvt_pk_f32_fp8(R.a[j].y, true);
                f[0] += R.w2 * b01[0]; f[1] += R.w2 * b01[1]; f[2] += R.w2 * b23[0]; f[3] += R.w2 * b23[1]; } }
        v[j] = x * ALPHA + f; s += (v[j][0] + v[j][1]) + (v[j][2] + v[j][3]); }
    const float mean = wave_sum(s) * (1.f / D); float s2 = 0.f;
#pragma unroll
    for (int j = 0; j < 8; ++j) { v[j] = v[j] - mean; s2 += (v[j][0] * v[j][0] + v[j][1] * v[j][1]) + (v[j][2] * v[j][2] + v[j][3] * v[j][3]); }
    const float rstd = 1.0f / sqrtf(wave_sum(s2) * (1.f / D) + LN_EPS);
    float lg[8];
#pragma unroll
    for (int e = 0; e < 8; ++e) lg[e] = 0.f;
    u32x2* ho = (u32x2*)(C.ws + WS_XB + (size_t)m * D * 2) + C.lane;
    unsigned* lo = (unsigned*)(C.ws + WS_XLO + (size_t)m * D) + C.lane;
#pragma unroll
    for (int j = 0; j < 8; ++j) {
        const f32x4 gv = *((const LAS f32x4*)(gb + 256 * j + l4)), bv = *((const LAS f32x4*)(gb + 2048 + 256 * j + l4));
        const f32x4 o = v[j] * rstd * gv + bv;
        if (Xf32out) ((f32x4*)(Xf32out + (size_t)m * D))[64 * j + C.lane] = o;
        else if (X8out) {
            const unsigned p8 = pk4_fp8(o[0] * 16.f, o[1] * 16.f, o[2] * 16.f, o[3] * 16.f);
            ((unsigned*)(X8out + (size_t)m * D))[64 * j + C.lane] = p8;
            const f32x2 d01 = __builtin_amdgcn_cvt_pk_f32_fp8(p8, false), d23 = __builtin_amdgcn_cvt_pk_f32_fp8(p8, true);
            u32x2 w; w.x = cvt_pk_bf16(o[0] - d01[0] * (1.f / 16.f), o[1] - d01[1] * (1.f / 16.f)); w.y = cvt_pk_bf16(o[2] - d23[0] * (1.f / 16.f), o[3] - d23[1] * (1.f / 16.f)); ho[64 * j] = w; }
        else { u32x2 w; w.x = cvt_pk_bf16(o[0], o[1]); w.y = cvt_pk_bf16(o[2], o[3]); ho[64 * j] = w;
            lo[64 * j] = pk4_fp8((o[0] - bflo(w.x)) * 8192.f, (o[1] - bfhi(w.x)) * 8192.f, (o[2] - bflo(w.y)) * 8192.f, (o[3] - bfhi(w.y)) * 8192.f); }
        if (do_route) {
#pragma unroll
            for (int e = 0; e < 8; ++e) { const f32x4 we = *(const LAS f32x4*)(rw + e * 2048 + 256 * j + l4);
                lg[e] += (o[0] * we[0] + o[1] * we[1]) + (o[2] * we[2] + o[3] * we[3]); }
        }
    }
    if (do_route) {
#pragma unroll
        for (int e = 0; e < 8; ++e) lg[e] = wave_sum(lg[e]);
        int e1 = 0; float v1 = lg[0];
#pragma unroll
        for (int e = 1; e < 8; ++e) if (lg[e] > v1) { v1 = lg[e]; e1 = e; }
        int e2 = -1; float v2 = -3.0e38f;
#pragma unroll
        for (int e = 0; e < 8; ++e) if (e != e1 && lg[e] > v2) { v2 = lg[e]; e2 = e; }
        const float ex = __expf(v2 - v1); const float w1 = 1.0f / (1.0f + ex), w2 = ex / (1.0f + ex);
        if (C.lane == 0) { f32x4 rt; rt[0] = __int_as_float(e1 | (e2 << 8)); rt[1] = w1; rt[2] = w2; rt[3] = 0.f; ((f32x4*)(C.ws + WS_ROUTE))[m] = rt;
            atomicAdd((int*)&hist[e1], 1); atomicAdd((int*)&hist[e2], 1); }
    }
}
__device__ __forceinline__ void ph_ln(const Ctx& C, const void* Hp, int hmode, const float* gain, const float* bias, float* Xf32out, unsigned char* X8out,
                                      const float* router, bool do_route) {
    unsigned char* ws = C.ws;
    LAS float* rw = (LAS float*)C.lds;
    LAS int* hist = (LAS int*)(C.lds + LDS_MISC + 64);
    LAS float* gb = (LAS float*)(C.lds + 65536);
    ((LAS f32x4*)gb)[C.tid] = ((const f32x4*)gain)[C.tid]; ((LAS f32x4*)gb)[512 + C.tid] = ((const f32x4*)bias)[C.tid];
    if (!do_route) __syncthreads();
    if (do_route) {
        for (int col = C.tid; col < 2048; col += NTHR) { const f32x4 a = ((const f32x4*)router)[2 * col], b = ((const f32x4*)router)[2 * col + 1];
            rw[0 * 2048 + col] = a[0]; rw[1 * 2048 + col] = a[1]; rw[2 * 2048 + col] = a[2]; rw[3 * 2048 + col] = a[3]; rw[4 * 2048 + col] = b[0]; rw[5 * 2048 + col] = b[1]; rw[6 * 2048 + col] = b[2]; rw[7 * 2048 + col] = b[3]; }
        if (C.tid < 8) hist[C.tid] = 0;
        int* st = (int*)(ws + WS_SLOTTOK);
        for (int i = C.bid * NTHR + C.tid; i < NSLOT; i += C.G * NTHR) st[i] = -1;
        __syncthreads();
    }
    const int m0 = C.bid * 128 + C.wave * 16;
    LnRow Ra, Rb;
    int s1v = 0, s2v = 0, w1v = 0, w2v = 0;
    if (hmode == 2) { const int mr = m0 + (C.lane & 15); const f32x4 rt = ((const f32x4*)(ws + WS_ROUTE))[mr];
        s1v = ((const int*)(ws + WS_SLOT1))[mr]; s2v = ((const int*)(ws + WS_SLOT2))[mr]; w1v = __float_as_int(rt[1] * (1.f / 256.f)); w2v = __float_as_int(rt[2] * (1.f / 256.f)); }
#define LN_LOAD(R_, r_) ln_load(R_, C, m0 + (r_), Hp, hmode, __builtin_amdgcn_readlane(s1v, (r_)), __builtin_amdgcn_readlane(s2v, (r_)), __int_as_float(__builtin_amdgcn_readlane(w1v, (r_))), __int_as_float(__builtin_amdgcn_readlane(w2v, (r_))))
    LN_LOAD(Ra, 0);
#pragma unroll 1
    for (int r = 0; r < 16; r += 2) {
        LN_LOAD(Rb, r + 1);
        ln_row(Ra, C, m0 + r, gb, hmode, Xf32out, X8out, rw, hist, do_route);
        if (r + 2 < 16) LN_LOAD(Ra, r + 2);
        ln_row(Rb, C, m0 + r + 1, gb, hmode, Xf32out, X8out, rw, hist, do_route);
    }
#undef LN_LOAD
    if (do_route) { __syncthreads(); if (C.tid < 8) ((int*)(ws + WS_CTL))[CW_CNT + C.bid * 8 + C.tid] = hist[C.tid]; }
}

__device__ __forceinline__ void ph_slots(const Ctx& C) {
    unsigned char* ws = C.ws;
    LAS int* sm = (LAS int*)(C.lds + LDS_MISC + 128);
    const int* cnt = (const int*)(ws + WS_CTL) + CW_CNT;
    if (C.tid < 8) { int tot = 0, mine = 0; for (int b = 0; b < C.G; ++b) { const int c = cnt[b * 8 + C.tid]; if (b < C.bid) mine += c; tot += c; } sm[C.tid] = tot; sm[8 + C.tid] = mine; }
    __syncthreads();
    if (C.tid == 0) { int base = 0; for (int e = 0; e < 8; ++e) { sm[16 + e] = base; base += (sm[e] + 255) & ~255; } sm[24] = base >> 8; }
    __syncthreads();
    if (C.wave == 0) {
        int off[8];
#pragma unroll
        for (int e = 0; e < 8; ++e) off[e] = sm[16 + e] + sm[8 + e];
        const unsigned long long lt = (1ull << C.lane) - 1ull;
        for (int it = 0; it < 2; ++it) {
            const int m = C.bid * 128 + it * 64 + C.lane;
            const int ee = __float_as_int(((const f32x4*)(ws + WS_ROUTE))[m][0]); const int e1 = ee & 0xff, e2 = (ee >> 8) & 0xff;
            int s1 = 0, s2 = 0;
#pragma unroll
            for (int e = 0; e < 8; ++e) { const unsigned long long m1 = __ballot(e1 == e), m2 = __ballot(e2 == e);
                const int c1 = __popcll(m1), c2 = __popcll(m2);
                if (e1 == e) s1 = off[e] + __popcll(m1 & lt);
                if (e2 == e) s2 = off[e] + c1 + __popcll(m2 & lt);
                off[e] += c1 + c2; }
            ((int*)(ws + WS_SLOT1))[m] = s1; ((int*)(ws + WS_SLOT2))[m] = s2;
            int* st = (int*)(ws + WS_SLOTTOK); st[s1] = m; st[s2] = m;
        }
    }
    if (C.bid == 0) {
        int* ctl = (int*)(ws + WS_CTL);
        if (C.tid == 0) ctl[CW_NT] = sm[24];
        if (C.tid < 264) { int e = 0;
#pragma unroll
            for (int q = 1; q < 8; ++q) if (C.tid >= (sm[16 + q] >> 8)) e = q;
            ctl[CW_TEXP + C.tid] = e; }
    }
}
__device__ __forceinline__ void ph_gather(const Ctx& C) {
    unsigned char* ws = C.ws;
    const int* st = (const int*)(ws + WS_SLOTTOK); const u32x4* xb = (const u32x4*)(ws + WS_XB); u32x4* xp = (u32x4*)(ws + WS_XPERM);
    for (int s = C.gw; s < NSLOT; s += C.NGW) { const int tok = st[s];
#pragma unroll
        for (int j = 0; j < 2; ++j) { u32x4 v = xb[(size_t)(tok < 0 ? 0 : tok) * 128 + j * 64 + C.lane]; const unsigned k = tok < 0 ? 0u : 0xffffffffu; v.x &= k; v.y &= k; v.z &= k; v.w &= k; xp[(size_t)s * 128 + j * 64 + C.lane] = v; } }
}
__device__ __forceinline__ void ph_moe_wconv(const Ctx& C, const float* mg, const float* mu, const float* md, const float* const* in, int lq) {
    SlotDec dec; dec.in = in; dec.ws = C.ws; dec.lq = lq; dec.moe.mg = mg; dec.moe.mu = mu; dec.moe.md = md; dec.moe.ws = C.ws; dec.sd.in = in; dec.sd.ws = C.ws;
    conv_run(C, lq ? 20160 : 20864, dec, C.bid - 192, 64);
}

__device__ __forceinline__ void ph_memattn(const Ctx& C, const bf16* P, int ldp, int qm0) {
    unsigned char* ws = C.ws;
    const bf16* memK = (const bf16*)(ws + WS_MEMK); const bf16* memVT = (const bf16*)(ws + WS_MEMVT); bf16* mix = (bf16*)(ws + WS_MIX);
    const int g = C.lane >> 4, r16 = C.lane & 15;
    LAS unsigned char* LK = C.lds; LAS unsigned char* LV = C.lds + 65536;
    const int b = C.bid >> 4, hm = (C.bid >> 2) & 3, qb = C.bid & 3;
    __syncthreads();
    {   u32x4 st[16];
#pragma unroll
        for (int i = 0; i < 8; ++i) { const int q = C.tid + 512 * i, row = q >> 4, pc = q & 15;
            st[i] = *(const u32x4*)(memK + (size_t)(b * 256 + row) * 512 + hm * 128 + pc * 8); }
#pragma unroll
        for (int i = 0; i < 8; ++i) { const int q = C.tid + 512 * i, row = q >> 5, pc = q & 31;
            st[8 + i] = *(const u32x4*)(memVT + (size_t)(hm * 128 + row) * 4096 + b * 256 + pc * 8); }
#pragma unroll
        for (int i = 0; i < 8; ++i) { const int q = C.tid + 512 * i, row = q >> 4, pc = q & 15;
            *(LAS u32x4*)(LK + row * 256 + ((pc ^ (row & 15)) * 16)) = st[i]; }
#pragma unroll
        for (int i = 0; i < 8; ++i) { const int q = C.tid + 512 * i, row = q >> 5, pc = q & 31;
            *(LAS u32x4*)(LV + row * 512 + ((pc ^ (row & 15)) * 16)) = st[8 + i]; }
    }
    __syncthreads();
    for (int qt = 0; qt < 4; ++qt) {
        const int m0 = b * SEQ + qb * 512 + C.wave * 64 + qt * 16;
        bf16x8 qf[4];
#pragma unroll
        for (int s = 0; s < 4; ++s) qf[s] = *(const bf16x8*)(P + (size_t)(m0 + r16) * ldp + qm0 + hm * 128 + 32 * s + 8 * g);
        f32x4 sacc[16];
#pragma unroll
        for (int kt = 0; kt < 16; ++kt) { sacc[kt] = (f32x4){0.f, 0.f, 0.f, 0.f};
#pragma unroll
            for (int s = 0; s < 4; ++s) { const bf16x8 kf = *(const LAS bf16x8*)(LK + (16 * kt + r16) * 256 + (((4 * s + g) ^ r16) * 16));
                sacc[kt] = __builtin_amdgcn_mfma_f32_16x16x32_bf16(kf, qf[s], sacc[kt], 0, 0, 0); } }
        float mx = -3.0e38f;
#pragma unroll
        for (int kt = 0; kt < 16; ++kt)
#pragma unroll
            for (int j = 0; j < 4; ++j) mx = fmaxf(mx, sacc[kt][j]);
        mx = fmaxf(mx, shx(mx, C.lane, 16)); mx = fmaxf(mx, shx(mx, C.lane, 32));
        const float sc = 0.08838834764831845f * 1.4426950408889634f;
        float sum = 0.f;
#pragma unroll
        for (int kt = 0; kt < 16; ++kt)
#pragma unroll
            for (int j = 0; j < 4; ++j) { const float pv = exp2f((sacc[kt][j] - mx) * sc); sacc[kt][j] = pv; sum += pv; }
        sum += shx(sum, C.lane, 16); sum += shx(sum, C.lane, 32);
        f32x4 oacc[8];
#pragma unroll
        for (int dt = 0; dt < 8; ++dt) oacc[dt] = (f32x4){0.f, 0.f, 0.f, 0.f};
#pragma unroll
        for (int ks = 0; ks < 8; ++ks) {
            u32x4 pw; pw.x = cvt_pk_bf16(sacc[2 * ks][0], sacc[2 * ks][1]); pw.y = cvt_pk_bf16(sacc[2 * ks][2], sacc[2 * ks][3]);
            pw.z = cvt_pk_bf16(sacc[2 * ks + 1][0], sacc[2 * ks + 1][1]); pw.w = cvt_pk_bf16(sacc[2 * ks + 1][2], sacc[2 * ks + 1][3]);
            const bf16x8 pa = __builtin_bit_cast(bf16x8, pw);
#pragma unroll
            for (int dt = 0; dt < 8; ++dt) { const LAS unsigned char* vr = LV + (16 * dt + r16) * 512;
                const u32x2 lo = *(const LAS u32x2*)(vr + (((8 * ks + g) ^ (2 * r16)) * 8)), hi = *(const LAS u32x2*)(vr + (((8 * ks + 4 + g) ^ (2 * r16)) * 8));
                u32x4 vw; vw.x = lo.x; vw.y = lo.y; vw.z = hi.x; vw.w = hi.y;
                oacc[dt] = __builtin_amdgcn_mfma_f32_16x16x32_bf16(pa, __builtin_bit_cast(bf16x8, vw), oacc[dt], 0, 0, 0); } }
        float inv[4];
#pragma unroll
        for (int j = 0; j < 4; ++j) inv[j] = 1.0f / shl(sum, 4 * g + j);
#pragma unroll
        for (int dt = 0; dt < 8; ++dt)
#pragma unroll
            for (int j = 0; j < 4; ++j) mix[(size_t)(m0 + 4 * g + j) * D + SW + hm * 128 + 16 * dt + r16] = f2bf(oacc[dt][j] * inv[j]);
    }
    __syncthreads();
}

__device__ __forceinline__ void ph_rwkv_prep1(const Ctx& C, const float* mu, bool with_v) {
    unsigned char* ws = C.ws;
    const bf16* P = (const bf16*)(ws + WS_P); bf16* AL = (bf16*)(ws + WS_ALORA);
    const int oc0 = 8 * C.lane;
    const int XW0 = 4608, XA0 = 4704, XV0 = 4800, XG0 = with_v ? 4864 : 4800;
    int src, mode;
    if (oc0 < 96) { src = XW0 + oc0; mode = 0; } else if (oc0 < 192) { src = XA0 + oc0 - 96; mode = 1; }
    else if (oc0 < 256) { src = XV0 + oc0 - 192; mode = with_v ? 1 : 2; } else { src = XG0 + oc0 - 256; mode = 3; }
    f32x4 mu0 = (f32x4){0.f, 0.f, 0.f, 0.f}, mu1 = mu0;
    if (mode != 2) { mu0 = *(const f32x4*)(mu + src); mu1 = *(const f32x4*)(mu + src + 4); }
    for (int mb = C.gw; mb < M; mb += 4 * C.NGW) {
        u32x4 cu4[4], pr4[4];
#pragma unroll
        for (int i = 0; i < 4; ++i) { const int m = mb + i * C.NGW; cu4[i] = (u32x4){0u, 0u, 0u, 0u}; pr4[i] = cu4[i];
            if (mode != 2) { cu4[i] = *(const u32x4*)(P + (size_t)m * LDP_RW + src);
                if ((m & (SEQ - 1)) != 0) pr4[i] = *(const u32x4*)(P + (size_t)(m - 1) * LDP_RW + src); } }
#pragma unroll
        for (int i = 0; i < 4; ++i) { const int m = mb + i * C.NGW; const u32x4 cu = cu4[i], pr = pr4[i];
            u32x4 o = (u32x4){0u, 0u, 0u, 0u};
            if (mode != 2) {
                float v[8];
#pragma unroll
                for (int q = 0; q < 4; ++q) { const float c0 = bflo(cu[q]), c1 = bfhi(cu[q]), p0 = bflo(pr[q]), p1 = bfhi(pr[q]);
                    const float m0 = q < 2 ? mu0[2 * q] : mu1[2 * q - 4], m1 = q < 2 ? mu0[2 * q + 1] : mu1[2 * q - 3];
                    v[2 * q] = c0 + m0 * (p0 - c0); v[2 * q + 1] = c1 + m1 * (p1 - c1); }
#pragma unroll
                for (int q = 0; q < 8; ++q) { if (mode == 0) v[q] = 1.0f - 2.0f * __builtin_amdgcn_rcpf(1.0f + __expf(2.0f * v[q])); else if (mode == 3) v[q] = sigmoidf_(v[q]); }
                o.x = cvt_pk_bf16(v[0], v[1]); o.y = cvt_pk_bf16(v[2], v[3]); o.z = cvt_pk_bf16(v[4], v[5]); o.w = cvt_pk_bf16(v[6], v[7]);
            }
            *(u32x4*)(AL + (size_t)m * 512 + oc0) = o; }
    }
}
__device__ __forceinline__ void ph_rwkv_prep2(const Ctx& C, const float* mu, const float* vecs, bool with_v) {
    unsigned char* ws = C.ws;
    const bf16* P = (const bf16*)(ws + WS_P); const bf16* LO = (const bf16*)(ws + WS_LORAOUT); bf16* VF = (bf16*)(ws + WS_VFIRST);
    unsigned char* SI = ws + WS_SCANIN; float* BON = (float*)(ws + WS_BONUS);
    const float* k_k = vecs + (with_v ? 3 : 2) * SW; const float* k_a = k_k + SW; const float* r_k = k_a + SW;
    const int hq = C.lane >> 4, cl = (C.lane & 15) * 4;
    LAS float* LPAR = (LAS float*)C.lds;
    for (int i = C.tid; i < 3 * SW / 4; i += NTHR) { ((LAS f32x4*)LPAR)[i] = ((const f32x4*)mu)[i]; ((LAS f32x4*)LPAR)[3 * SW / 4 + i] = ((const f32x4*)k_k)[i]; }
    __syncthreads();
    for (int m = C.gw; m < M; m += C.NGW) {
        const int t = m & (SEQ - 1), b = m >> 11; const bool hp = t != 0;
        const bf16* pc = P + (size_t)m * LDP_RW; const bf16* pp = pc - LDP_RW;
#pragma unroll 2
        for (int it = 0; it < 6; ++it) {
            const int c = it * 256 + 4 * C.lane, head = 4 * it + hq;
            const u32x2 rc = *(const u32x2*)(pc + c), kc = *(const u32x2*)(pc + SW + c), vc = *(const u32x2*)(pc + 2 * SW + c);
            u32x2 rp = (u32x2){0u, 0u}, kp_ = rp, vp = rp;
            if (hp) { rp = *(const u32x2*)(pp + c); kp_ = *(const u32x2*)(pp + SW + c); vp = *(const u32x2*)(pp + 2 * SW + c); }
            const u32x2 Ew = *(const u32x2*)(LO + (size_t)m * 6144 + c), aw = *(const u32x2*)(LO + (size_t)m * 6144 + SW + c);
            u32x2 svw = (u32x2){0u, 0u}, vfw = svw;
            if (with_v) { svw = *(const u32x2*)(LO + (size_t)m * 6144 + 2 * SW + c); vfw = *(const u32x2*)(VF + (size_t)m * SW + c); }
            const f32x4 mr = *(const LAS f32x4*)(LPAR + c), mk = *(const LAS f32x4*)(LPAR + SW + c), mv = *(const LAS f32x4*)(LPAR + 2 * SW + c);
            const f32x4 kk4 = *(const LAS f32x4*)(LPAR + 3 * SW + c), ka4 = *(const LAS f32x4*)(LPAR + 4 * SW + c), rk4 = *(const LAS f32x4*)(LPAR + 5 * SW + c);
            float rm[4], km[4], vm[4], E[4], a[4], sv[4], vf[4];
#define UNPK(dst, w) dst[0] = bflo(w.x); dst[1] = bfhi(w.x); dst[2] = bflo(w.y); dst[3] = bfhi(w.y)
            float t0[4], t1[4];
            UNPK(t0, rc); UNPK(t1, rp);
#pragma unroll
            for (int j = 0; j < 4; ++j) rm[j] = t0[j] + mr[j] * (t1[j] - t0[j]);
            UNPK(t0, kc); UNPK(t1, kp_);
#pragma unroll
            for (int j = 0; j < 4; ++j) km[j] = t0[j] + mk[j] * (t1[j] - t0[j]);
            UNPK(t0, vc); UNPK(t1, vp);
#pragma unroll
            for (int j = 0; j < 4; ++j) vm[j] = t0[j] + mv[j] * (t1[j] - t0[j]);
            UNPK(E, Ew); UNPK(a, aw); UNPK(sv, svw); UNPK(vf, vfw);
#undef UNPK
            float vv[4], kkr[4], kp[4], ss = 0.f, bs = 0.f;
#pragma unroll
            for (int j = 0; j < 4; ++j) {
                vv[j] = with_v ? vm[j] + (vf[j] - vm[j]) * sv[j] : vm[j];
                kkr[j] = km[j] * kk4[j]; ss += kkr[j] * kkr[j];
                kp[j] = km[j] * (1.0f + (a[j] - 1.0f) * ka4[j]);
                bs += rm[j] * kp[j] * rk4[j]; }
            ss = row16_sum(ss); bs = row16_sum(bs);
            const float inv = 1.0f / fmaxf(sqrtf(ss), 1e-12f);
            if (!with_v) { u32x2 w; w.x = cvt_pk_bf16(vm[0], vm[1]); w.y = cvt_pk_bf16(vm[2], vm[3]); *(u32x2*)(VF + (size_t)m * SW + c) = w; }
            unsigned char* rec = SI + ((size_t)(b * 24 + head) * SEQ + t) * 768;
            float uw[4], kk[4];
#pragma unroll
            for (int j = 0; j < 4; ++j) { uw[j] = 1.0f - __expf(-E[j]); kk[j] = kkr[j] * inv; }
            u32x2 o;
            { const h16x2 u01 = __builtin_convertvector((f32x2){uw[0], uw[1]}, h16x2), u23 = __builtin_convertvector((f32x2){uw[2], uw[3]}, h16x2);
              o.x = __builtin_bit_cast(unsigned, u01); o.y = __builtin_bit_cast(unsigned, u23); *(u32x2*)(rec + cl * 2) = o; }
            o.x = cvt_pk_bf16(-kk[0], -kk[1]); o.y = cvt_pk_bf16(-kk[2], -kk[3]); *(u32x2*)(rec + 128 + cl * 2) = o;
            o.x = cvt_pk_bf16(kk[0] * a[0], kk[1] * a[1]); o.y = cvt_pk_bf16(kk[2] * a[2], kk[3] * a[3]); *(u32x2*)(rec + 256 + cl * 2) = o;
            o.x = cvt_pk_bf16(kp[0], kp[1]); o.y = cvt_pk_bf16(kp[2], kp[3]); *(u32x2*)(rec + 384 + cl * 2) = o;
            o.x = cvt_pk_bf16(rm[0], rm[1]); o.y = cvt_pk_bf16(rm[2], rm[3]); *(u32x2*)(rec + 512 + cl * 2) = o;
            o.x = cvt_pk_bf16(vv[0], vv[1]); o.y = cvt_pk_bf16(vv[2], vv[3]); *(u32x2*)(rec + 640 + cl * 2) = o;
            if ((C.lane & 15) == 0) BON[m * 24 + head] = bs;
        }
    }
}
__device__ __forceinline__ float fma_(float a, float b, float c) { float d; asm("v_fma_f32 %0, %1, %2, %3" : "=v"(d) : "v"(a), "v"(b), "v"(c)); return d; }
__device__ __forceinline__ float mul_(float a, float b) { float d; asm("v_mul_f32 %0, %1, %2" : "=v"(d) : "v"(a), "v"(b)); return d; }
__device__ __forceinline__ void ph_rwkv_scan(const Ctx& C, const float* mg, const float* mu, const float* md, const float* vecs, bool with_v, const float* const* in, int lq) {
    if (C.bid >= 192) { ph_moe_wconv(C, mg, mu, md, in, lq); return; }
    unsigned char* ws = C.ws;
    const unsigned char* SI = ws + WS_SCANIN;
    constexpr int TC = 16, NCH = SEQ / TC, REC = 7 * 64;
    LAS float* buf = (LAS float*)C.lds;
    LAS float* ybuf = (LAS float*)(C.lds + 114688);
    const bool scanner = C.wave < 4;
    const int slot = (C.wave >> 1) & 1;
    const int rg = C.lane >> 3, cg = C.lane & 7;
    const int rbase = 32 * (C.wave & 1) + 4 * rg;
    if (!scanner) {
        const int lw = C.wave - 4, qd = C.lane;
        const int q2 = qd - 8, lvec = 1 + (q2 >> 3), lpart = q2 & 7;
        const float* BON = (const float*)(ws + WS_BONUS); bf16* mix = (bf16*)(ws + WS_MIX); const bf16* LO = (const bf16*)(ws + WS_LORAOUT);
        const float* gn_g = vecs + (with_v ? 6 : 5) * SW; const float* gn_b = gn_g + SW;
        const int p0 = C.bid * 2, b0 = p0 / 24, h0 = p0 % 24, b1 = (p0 + 1) / 24, h1 = (p0 + 1) % 24;
        const int pr = C.lane >> 4, pc4 = 4 * (C.lane & 15);
        const f32x4 gg0 = *(const f32x4*)(gn_g + h0 * 64 + pc4), gb0 = *(const f32x4*)(gn_b + h0 * 64 + pc4), gg1 = *(const f32x4*)(gn_g + h1 * 64 + pc4), gb1 = *(const f32x4*)(gn_b + h1 * 64 + pc4);
        u32x4 st[8];
#define SCAN_ISSUE(ch_) do { _Pragma("unroll") for (int i_ = 0; i_ < 8; ++i_) { const int ps = lw + 4 * i_; \
        const int sl_ = ps >> 4, t_ = (ch_) * TC + (ps & 15); \
        st[i_] = qd < 48 ? *(const u32x4*)(SI + ((size_t)(p0 + sl_) * SEQ + t_) * 768 + qd * 16) \
                         : *(const u32x4*)(LO + (size_t)((sl_ ? b1 : b0) * SEQ + t_) * 6144 + 3 * SW + (sl_ ? h1 : h0) * 64 + ((qd - 48) & 7) * 8); } } while (0)
#define SCAN_COMMIT(bsel_) do { _Pragma("unroll") for (int i_ = 0; i_ < 8; ++i_) { const int ps = lw + 4 * i_; \
        LAS float* dst = buf + (((bsel_) * 2 * TC) + ps) * REC; \
        if (qd < 8) { f32x4 a_, b_; const unsigned sx_ = st[i_].x, sy_ = st[i_].y, sz_ = st[i_].z, sw_ = st[i_].w;     \
            { const f32x2 t0_ = __builtin_convertvector(__builtin_bit_cast(h16x2, sx_), f32x2), t1_ = __builtin_convertvector(__builtin_bit_cast(h16x2, sy_), f32x2); \
              a_[0] = 1.0f - t0_[0]; a_[1] = 1.0f - t0_[1]; a_[2] = 1.0f - t1_[0]; a_[3] = 1.0f - t1_[1]; } \
            { const f32x2 t0_ = __builtin_convertvector(__builtin_bit_cast(h16x2, sz_), f32x2), t1_ = __builtin_convertvector(__builtin_bit_cast(h16x2, sw_), f32x2); \
              b_[0] = 1.0f - t0_[0]; b_[1] = 1.0f - t0_[1]; b_[2] = 1.0f - t1_[0]; b_[3] = 1.0f - t1_[1]; } \
            *(LAS f32x4*)(dst + 8 * qd) = a_; *(LAS f32x4*)(dst + 8 * qd + 4) = b_; } \
        else if (qd < 56) { LAS float* d2 = dst + lvec * 64 + lpart * 8; \
            f32x4 a_, b_; a_[0] = bflo(st[i_].x); a_[1] = bfhi(st[i_].x); a_[2] = bflo(st[i_].y); a_[3] = bfhi(st[i_].y); \
            b_[0] = bflo(st[i_].z); b_[1] = bfhi(st[i_].z); b_[2] = bflo(st[i_].w); b_[3] = bfhi(st[i_].w); \
            *(LAS f32x4*)d2 = a_; *(LAS f32x4*)(d2 + 4) = b_; } } } while (0)
#define SCAN_POST(cp_) do { _Pragma("unroll") for (int g_ = 0; g_ < 2; ++g_) { const int ps = lw + 4 * (4 * g_ + pr), sl = ps >> 4, stp = ps & 15; \
        const LAS float* rec = buf + ((((cp_) & 1) * 2 * TC) + ps) * REC; \
        const f32x4 yv = *(const LAS f32x4*)(ybuf + ((((cp_) & 1) * 2 + sl) * TC + stp) * 64 + pc4), vv = *(const LAS f32x4*)(rec + 5 * 64 + pc4), gq = *(const LAS f32x4*)(rec + 6 * 64 + pc4); \
        const int m = (sl ? b1 : b0) * SEQ + (cp_) * TC + stp, hh = sl ? h1 : h0; \
        const float bon = BON[m * 24 + hh]; \
        const float mean = row16_sum((yv[0] + yv[1]) + (yv[2] + yv[3])) * (1.f / 64.f); const f32x4 d = yv - mean; \
        const float var = row16_sum((d[0] * d[0] + d[1] * d[1]) + (d[2] * d[2] + d[3] * d[3])) * (1.f / 64.f); \
        const float rstd = 1.0f / sqrtf(var + 64e-5f); const f32x4 gg = sl ? gg1 : gg0, gb = sl ? gb1 : gb0; \
        const f32x4 o_ = (d * rstd * gg + gb + vv * bon) * gq; \
        u32x2 w_; w_.x = cvt_pk_bf16(o_[0], o_[1]); w_.y = cvt_pk_bf16(o_[2], o_[3]); \
        *(u32x2*)(mix + (size_t)m * D + hh * 64 + pc4) = w_; } } while (0)
        SCAN_ISSUE(0); SCAN_COMMIT(0);
        __syncthreads();
        for (int ch = 0; ch < NCH; ++ch) {
            if (ch + 1 < NCH) SCAN_ISSUE(ch + 1);
            if (ch > 0) SCAN_POST(ch - 1);
            if (ch + 1 < NCH) SCAN_COMMIT((ch & 1) ^ 1);
            __syncthreads();
        }
        SCAN_POST(NCH - 1);
#undef SCAN_ISSUE
#undef SCAN_COMMIT
#undef SCAN_POST
    } else {
        f32x2 S[4][4];
#pragma unroll
        for (int i = 0; i < 4; ++i)
#pragma unroll
            for (int c = 0; c < 4; ++c) S[i][c] = (f32x2){0.f, 0.f};
        __syncthreads();
        for (int ch = 0; ch < NCH; ++ch) {
            const LAS float* base = buf + (((ch & 1) * 2 + slot) * TC) * REC;
            LAS float* yb = ybuf + (((ch & 1) * 2 + slot) * TC) * 64 + rbase;
#pragma unroll 2
            for (int s = 0; s < TC; ++s) {
                const LAS float* rp = base + s * REC + 8 * cg;
                f32x2 wv[4], nv[4], bv[4], kv[4], rv[4];
                { const f32x4 x0 = *(const LAS f32x4*)(rp), x1 = *(const LAS f32x4*)(rp + 4); wv[0] = (f32x2){x0[0], x0[1]}; wv[1] = (f32x2){x0[2], x0[3]}; wv[2] = (f32x2){x1[0], x1[1]}; wv[3] = (f32x2){x1[2], x1[3]}; }
                { const f32x4 x0 = *(const LAS f32x4*)(rp + 64), x1 = *(const LAS f32x4*)(rp + 68); nv[0] = (f32x2){x0[0], x0[1]}; nv[1] = (f32x2){x0[2], x0[3]}; nv[2] = (f32x2){x1[0], x1[1]}; nv[3] = (f32x2){x1[2], x1[3]}; }
                { const f32x4 x0 = *(const LAS f32x4*)(rp + 128), x1 = *(const LAS f32x4*)(rp + 132); bv[0] = (f32x2){x0[0], x0[1]}; bv[1] = (f32x2){x0[2], x0[3]}; bv[2] = (f32x2){x1[0], x1[1]}; bv[3] = (f32x2){x1[2], x1[3]}; }
                { const f32x4 x0 = *(const LAS f32x4*)(rp + 192), x1 = *(const LAS f32x4*)(rp + 196); kv[0] = (f32x2){x0[0], x0[1]}; kv[1] = (f32x2){x0[2], x0[3]}; kv[2] = (f32x2){x1[0], x1[1]}; kv[3] = (f32x2){x1[2], x1[3]}; }
                { const f32x4 x0 = *(const LAS f32x4*)(rp + 256), x1 = *(const LAS f32x4*)(rp + 260); rv[0] = (f32x2){x0[0], x0[1]}; rv[1] = (f32x2){x0[2], x0[3]}; rv[2] = (f32x2){x1[0], x1[1]}; rv[3] = (f32x2){x1[2], x1[3]}; }
                const f32x4 vv = *(const LAS f32x4*)(base + s * REC + 320 + rbase);
                f32x4 yo;
#pragma unroll
                for (int i = 0; i < 4; ++i) {
                    f32x2 a2 = S[i][0] * nv[0];
#pragma unroll
                    for (int c = 1; c < 4; ++c) a2 = S[i][c] * nv[c] + a2;
                    float sa = a2[0] + a2[1];
                    sa = dpp_add<0xB1>(sa); sa = dpp_add<0x4E>(sa); sa = dpp_add<0x141>(sa);
                    const f32x2 sa2 = (f32x2){sa, sa}, v2 = (f32x2){vv[i], vv[i]};
                    f32x2 y2 = (f32x2){0.f, 0.f};
#pragma unroll
                    for (int c = 0; c < 4; ++c) { S[i][c] = S[i][c] * wv[c] + (sa2 * bv[c] + v2 * kv[c]); y2 = S[i][c] * rv[c] + y2; }
                    float y = y2[0] + y2[1];
                    y = dpp_add<0xB1>(y); y = dpp_add<0x4E>(y); y = dpp_add<0x141>(y);
                    yo[i] = y;
                }
                if (cg == 0) *(LAS f32x4*)(yb + s * 64) = yo;
            }
            __syncthreads();
        }
    }
}

__device__ __constant__ float RET_LG2[6] = {-0.04580368961312479f, -0.02272007650008353f, -0.011315313227834146f, -0.005646563141142063f, -0.0028205190623786626f, -0.0014095702546713536f};
__device__ __forceinline__ void ph_ret_prep(const Ctx& C) {
    unsigned char* ws = C.ws;
    const bf16* P = (const bf16*)(ws + WS_P); const f32x2* CS = (const f32x2*)(ws + WS_CS);
    bf16* QR = (bf16*)(ws + WS_QR); bf16* KR = (bf16*)(ws + WS_KR); bf16* VT = (bf16*)(ws + WS_VT); bf16* KVT = (bf16*)(ws + WS_KVT);
    LAS unsigned char* LKt = C.lds; LAS unsigned char* LV = C.lds + 32768;
    const int g = C.lane >> 4, r16 = C.lane & 15, w = C.wave;
    __syncthreads();
    for (int u = C.bid; u < 1536; u += C.G) {
        const int c = u & 15, bh = u >> 4, h = bh % 6, b = bh / 6, m0 = b * SEQ + c * 128;
        const float lg2 = RET_LG2[h];
        __syncthreads();
        for (int task = C.tid; task < 1536; task += NTHR) {
            if (task < 512) {
                const bool isk = task >= 256; const int tk = task & 255, i0 = 4 * (tk & 15), tg = tk >> 4;
                const int colb = (isk ? 768 : 0) + h * 128 + i0; const float scl = isk ? 0.08838834764831845f : 1.0f;
                bf16* N = isk ? KR : QR;
                float o1[4][8], o2[4][8];
#pragma unroll
                for (int j = 0; j < 8; ++j) { const int m = m0 + tg * 8 + j;
                    const u32x2 a = *(const u32x2*)(P + (size_t)m * LDP_RET + colb), b2 = *(const u32x2*)(P + (size_t)m * LDP_RET + colb + 64);
                    const f32x4 cs01 = *(const f32x4*)(CS + (size_t)m * 64 + i0), cs23 = *(const f32x4*)(CS + (size_t)m * 64 + i0 + 2);
                    const float x1[4] = {bflo(a.x), bfhi(a.x), bflo(a.y), bfhi(a.y)}, x2[4] = {bflo(b2.x), bfhi(b2.x), bflo(b2.y), bfhi(b2.y)};
                    const float cc[4] = {cs01[0], cs01[2], cs23[0], cs23[2]}, sn[4] = {cs01[1], cs01[3], cs23[1], cs23[3]};
#pragma unroll
                    for (int q = 0; q < 4; ++q) { o1[q][j] = (x1[q] * cc[q] - x2[q] * sn[q]) * scl; o2[q][j] = (x1[q] * sn[q] + x2[q] * cc[q]) * scl; }
                    u32x2 w1, w2; w1.x = cvt_pk_bf16(o1[0][j], o1[1][j]); w1.y = cvt_pk_bf16(o1[2][j], o1[3][j]); w2.x = cvt_pk_bf16(o2[0][j], o2[1][j]); w2.y = cvt_pk_bf16(o2[2][j], o2[3][j]);
                    *(u32x2*)(N + (size_t)m * 768 + h * 128 + i0) = w1; *(u32x2*)(N + (size_t)m * 768 + h * 128 + i0 + 64) = w2; }
                if (isk) {
                    float kd[8];
#pragma unroll
                    for (int j = 0; j < 8; ++j) kd[j] = exp2f((float)(127 - (tg * 8 + j)) * lg2);
#pragma unroll
                    for (int q = 0; q < 4; ++q) {
                        u32x4 w1, w2;
                        w1.x = cvt_pk_bf16(o1[q][0] * kd[0], o1[q][1] * kd[1]); w1.y = cvt_pk_bf16(o1[q][2] * kd[2], o1[q][3] * kd[3]); w1.z = cvt_pk_bf16(o1[q][4] * kd[4], o1[q][5] * kd[5]); w1.w = cvt_pk_bf16(o1[q][6] * kd[6], o1[q][7] * kd[7]);
                        w2.x = cvt_pk_bf16(o2[q][0] * kd[0], o2[q][1] * kd[1]); w2.y = cvt_pk_bf16(o2[q][2] * kd[2], o2[q][3] * kd[3]); w2.z = cvt_pk_bf16(o2[q][4] * kd[4], o2[q][5] * kd[5]); w2.w = cvt_pk_bf16(o2[q][6] * kd[6], o2[q][7] * kd[7]);
                        *(LAS u32x4*)(LKt + (i0 + q) * 256 + ((tg ^ ((i0 + q) & 15)) * 16)) = w1;
                        *(LAS u32x4*)(LKt + (i0 + q + 64) * 256 + ((tg ^ ((i0 + q + 64) & 15)) * 16)) = w2; }
                }
            } else {
                const int tv = task - 512, e0 = 4 * (tv & 63), tg = tv >> 6;
                u32x2 vin[8];
#pragma unroll
                for (int j = 0; j < 8; ++j) vin[j] = *(const u32x2*)(P + (size_t)(m0 + tg * 8 + j) * LDP_RET + 1536 + h * 256 + e0);
                u32x4 w0, w1, w2, w3;
#define PKLO(a_, b_) (((a_) & 0xffffu) | ((b_) << 16))
#define PKHI(a_, b_) (((a_) >> 16) | ((b_) & 0xffff0000u))
                w0.x = PKLO(vin[0].x, vin[1].x); w0.y = PKLO(vin[2].x, vin[3].x); w0.z = PKLO(vin[4].x, vin[5].x); w0.w = PKLO(vin[6].x, vin[7].x);
                w1.x = PKHI(vin[0].x, vin[1].x); w1.y = PKHI(vin[2].x, vin[3].x); w1.z = PKHI(vin[4].x, vin[5].x); w1.w = PKHI(vin[6].x, vin[7].x);
                w2.x = PKLO(vin[0].y, vin[1].y); w2.y = PKLO(vin[2].y, vin[3].y); w2.z = PKLO(vin[4].y, vin[5].y); w2.w = PKLO(vin[6].y, vin[7].y);
                w3.x = PKHI(vin[0].y, vin[1].y); w3.y = PKHI(vin[2].y, vin[3].y); w3.z = PKHI(vin[4].y, vin[5].y); w3.w = PKHI(vin[6].y, vin[7].y);
#undef PKLO
#undef PKHI
                *(LAS u32x4*)(LV + (e0 + 0) * 256 + ((tg ^ ((e0 + 0) & 15)) * 16)) = w0; *(LAS u32x4*)(LV + (e0 + 1) * 256 + ((tg ^ ((e0 + 1) & 15)) * 16)) = w1;
                *(LAS u32x4*)(LV + (e0 + 2) * 256 + ((tg ^ ((e0 + 2) & 15)) * 16)) = w2; *(LAS u32x4*)(LV + (e0 + 3) * 256 + ((tg ^ ((e0 + 3) & 15)) * 16)) = w3;
            }
        }
        __syncthreads();
        {   f32x4 acc[16];
#pragma unroll
            for (int et = 0; et < 16; ++et) acc[et] = (f32x4){0.f, 0.f, 0.f, 0.f};
#pragma unroll
            for (int ks = 0; ks < 4; ++ks) {
                const bf16x8 af = *(const LAS bf16x8*)(LKt + (16 * w + r16) * 256 + (((4 * ks + g) ^ r16) * 16));
#pragma unroll
                for (int et = 0; et < 16; ++et) { const bf16x8 bf = *(const LAS bf16x8*)(LV + (16 * et + r16) * 256 + (((4 * ks + g) ^ r16) * 16));
                    acc[et] = __builtin_amdgcn_mfma_f32_16x16x32_bf16(af, bf, acc[et], 0, 0, 0); } }
#pragma unroll
            for (int et = 0; et < 16; ++et) { u32x2 wv; wv.x = cvt_pk_bf16(acc[et][0], acc[et][1]); wv.y = cvt_pk_bf16(acc[et][2], acc[et][3]); *(u32x2*)(KVT + ((size_t)u * 256 + 16 * et + r16) * 128 + 16 * w + 4 * g) = wv; }
        }
    }
    __syncthreads();
}
__device__ __forceinline__ void ph_ret_kv(const Ctx& C) {
    unsigned char* ws = C.ws;
    const bf16* KDT = (const bf16*)(ws + WS_KDT); const bf16* VT = (const bf16*)(ws + WS_VT); bf16* KVT = (bf16*)(ws + WS_KVT);
    const int g = C.lane >> 4, r16 = C.lane & 15, w = C.wave;
    LAS unsigned char* LKt = C.lds; LAS unsigned char* LV = C.lds + 32768;
    u32x4 st[12];
#define KV_ISSUE(u_) do { const int c_ = (u_) & 15, bh_ = (u_) >> 4; \
        _Pragma("unroll") for (int i = 0; i < 4; ++i) { const int q = C.tid + 512 * i, row = q >> 4, pc = q & 15; st[i] = *(const u32x4*)(KDT + (size_t)(bh_ * 128 + row) * SEQ + c_ * 128 + pc * 8); } \
        _Pragma("unroll") for (int i = 0; i < 8; ++i) { const int q = C.tid + 512 * i, row = q >> 4, pc = q & 15; st[4 + i] = *(const u32x4*)(VT + (size_t)(bh_ * 256 + row) * SEQ + c_ * 128 + pc * 8); } } while (0)
#define KV_COMMIT() do { \
        _Pragma("unroll") for (int i = 0; i < 4; ++i) { const int q = C.tid + 512 * i, row = q >> 4, pc = q & 15; *(LAS u32x4*)(LKt + row * 256 + ((pc ^ (row & 15)) * 16)) = st[i]; } \
        _Pragma("unroll") for (int i = 0; i < 8; ++i) { const int q = C.tid + 512 * i, row = q >> 4, pc = q & 15; *(LAS u32x4*)(LV + row * 256 + ((pc ^ (row & 15)) * 16)) = st[4 + i]; } } while (0)
    __syncthreads();
    if (C.bid < 1536) KV_ISSUE(C.bid);
    for (int u = C.bid; u < 1536; u += C.G) {
        __syncthreads();
        KV_COMMIT();
        if (u + C.G < 1536) KV_ISSUE(u + C.G);
        __syncthreads();
        f32x4 acc[16];
#pragma unroll
        for (int et = 0; et < 16; ++et) acc[et] = (f32x4){0.f, 0.f, 0.f, 0.f};
#pragma unroll
        for (int ks = 0; ks < 4; ++ks) {
            const bf16x8 af = *(const LAS bf16x8*)(LKt + (16 * w + r16) * 256 + (((4 * ks + g) ^ r16) * 16));
#pragma unroll
            for (int et = 0; et < 16; ++et) { const bf16x8 bf = *(const LAS bf16x8*)(LV + (16 * et + r16) * 256 + (((4 * ks + g) ^ r16) * 16));
                acc[et] = __builtin_amdgcn_mfma_f32_16x16x32_bf16(af, bf, acc[et], 0, 0, 0); } }
#pragma unroll
        for (int et = 0; et < 16; ++et) { u32x2 wv; wv.x = cvt_pk_bf16(acc[et][0], acc[et][1]); wv.y = cvt_pk_bf16(acc[et][2], acc[et][3]); *(u32x2*)(KVT + ((size_t)u * 256 + 16 * et + r16) * 128 + 16 * w + 4 * g) = wv; }
    }
    __syncthreads();
#undef KV_ISSUE
#undef KV_COMMIT
}
__device__ __forceinline__ void ph_ret_prefix(const Ctx& C) {
    unsigned char* ws = C.ws;
    const bf16* KVT = (const bf16*)(ws + WS_KVT); bf16* RTB = (bf16*)(ws + WS_RTB);
    for (int idx = C.bid * NTHR + C.tid; idx < 96 * 8192; idx += C.G * NTHR) {
        const int bh = idx >> 13, rem = idx & 8191; const int h = bh % 6;
        const float cd = exp2f(128.0f * RET_LG2[h]);
        f32x4 r = (f32x4){0.f, 0.f, 0.f, 0.f};
        u32x2 kwv[15];
#pragma unroll
        for (int c = 0; c < 15; ++c) kwv[c] = *(const u32x2*)(KVT + ((size_t)(bh * 16 + c) * 8192 + rem) * 4);
#pragma unroll
        for (int c = 0; c < 16; ++c) { const size_t off = ((size_t)(bh * 16 + c) * 8192 + rem) * 4;
            u32x2 w; w.x = cvt_pk_bf16(r[0], r[1]); w.y = cvt_pk_bf16(r[2], r[3]); *(u32x2*)(RTB + off) = w;
            if (c < 15) { const u32x2 kw = kwv[c]; const f32x4 kv = (f32x4){bflo(kw.x), bfhi(kw.x), bflo(kw.y), bfhi(kw.y)}; r = r * cd + kv; } }
    }
}
#define LDS_BAR() asm volatile("s_waitcnt lgkmcnt(0)\n\ts_barrier" ::: "memory")
__device__ __forceinline__ void ret_v_lds(const u32x2 (&vin)[8], LAS unsigned char* LV, int e0, int tg) {
    u32x4 w0, w1, w2, w3;
#define PKLO(a_, b_) (((a_) & 0xffffu) | ((b_) << 16))
#define PKHI(a_, b_) (((a_) >> 16) | ((b_) & 0xffff0000u))
    w0.x = PKLO(vin[0].x, vin[1].x); w0.y = PKLO(vin[2].x, vin[3].x); w0.z = PKLO(vin[4].x, vin[5].x); w0.w = PKLO(vin[6].x, vin[7].x);
    w1.x = PKHI(vin[0].x, vin[1].x); w1.y = PKHI(vin[2].x, vin[3].x); w1.z = PKHI(vin[4].x, vin[5].x); w1.w = PKHI(vin[6].x, vin[7].x);
    w2.x = PKLO(vin[0].y, vin[1].y); w2.y = PKLO(vin[2].y, vin[3].y); w2.z = PKLO(vin[4].y, vin[5].y); w2.w = PKLO(vin[6].y, vin[7].y);
    w3.x = PKHI(vin[0].y, vin[1].y); w3.y = PKHI(vin[2].y, vin[3].y); w3.z = PKHI(vin[4].y, vin[5].y); w3.w = PKHI(vin[6].y, vin[7].y);
#undef PKLO
#undef PKHI
    *(LAS u32x4*)(LV + (e0 + 0) * 256 + ((tg ^ ((e0 + 0) & 15)) * 16)) = w0; *(LAS u32x4*)(LV + (e0 + 1) * 256 + ((tg ^ ((e0 + 1) & 15)) * 16)) = w1;
    *(LAS u32x4*)(LV + (e0 + 2) * 256 + ((tg ^ ((e0 + 2) & 15)) * 16)) = w2; *(LAS u32x4*)(LV + (e0 + 3) * 256 + ((tg ^ ((e0 + 3) & 15)) * 16)) = w3;
}
__device__ __forceinline__ void ph_ret_out(const Ctx& C, const float* gn) {
    unsigned char* ws = C.ws;
    const bf16* P = (const bf16*)(ws + WS_P); const bf16* QR = (const bf16*)(ws + WS_QR); const bf16* KR = (const bf16*)(ws + WS_KR);
    const bf16* VT = (const bf16*)(ws + WS_VT); const bf16* RTB = (const bf16*)(ws + WS_RTB); bf16* mix = (bf16*)(ws + WS_MIX);
    const int g = C.lane >> 4, r16 = C.lane & 15, w = C.wave;
    LAS unsigned char* LR = C.lds; LAS unsigned char* LV = C.lds + 65536;
    for (int u = C.bid; u < 1536; u += C.G) {
        const int c = u & 15, bh = u >> 4, h = bh % 6, b = bh / 6, m0 = b * SEQ + c * 128;
        const float lg2 = RET_LG2[h];
        LDS_BAR();
        const int nl = 16 * w + r16;
        u32x4 kst[4];
        bf16x8 qf[4];
        u32x2 gwv[16];
        {   u32x4 st[8]; u32x2 vinA[8], vinB[8];
            const int e0v = 4 * (C.tid & 63), tgv = C.tid >> 6;
#pragma unroll
            for (int i = 0; i < 8; ++i) { const int q = C.tid + 512 * i, row = q >> 4, pc = q & 15;
                st[i] = *(const u32x4*)(RTB + ((size_t)u * 256 + row) * 128 + pc * 8); }
#pragma unroll
            for (int j = 0; j < 8; ++j) { vinA[j] = *(const u32x2*)(P + (size_t)(m0 + tgv * 8 + j) * LDP_RET + 1536 + h * 256 + e0v);
                vinB[j] = *(const u32x2*)(P + (size_t)(m0 + tgv * 8 + 64 + j) * LDP_RET + 1536 + h * 256 + e0v); }
#pragma unroll
            for (int s = 0; s < 4; ++s) qf[s] = *(const bf16x8*)(QR + (size_t)(m0 + nl) * 768 + h * 128 + 32 * s + 8 * g);
#pragma unroll
            for (int i = 0; i < 8; ++i) { const int q = C.tid + 512 * i, row = q >> 4, pc = q & 15; const int off = row * 256 + ((pc ^ (row & 15)) * 16);
                *(LAS u32x4*)(LR + off) = st[i]; }
            ret_v_lds(vinA, LV, e0v, tgv); ret_v_lds(vinB, LV, e0v, tgv + 8);
        }
#pragma unroll
        for (int i = 0; i < 4; ++i) { const int q = C.tid + 512 * i, row = q >> 4, pc = q & 15;
            kst[i] = *(const u32x4*)(KR + (size_t)(m0 + row) * 768 + h * 128 + pc * 8); }
        LDS_BAR();
        f32x4 o[16];
        const float qdec = exp2f((float)(nl + 1) * lg2);
#pragma unroll
        for (int et = 0; et < 16; ++et) { f32x4 a = (f32x4){0.f, 0.f, 0.f, 0.f};
#pragma unroll
            for (int s = 0; s < 4; ++s) { const bf16x8 rf = *(const LAS bf16x8*)(LR + (16 * et + r16) * 256 + (((4 * s + g) ^ r16) * 16));
                a = __builtin_amdgcn_mfma_f32_16x16x32_bf16(rf, qf[s], a, 0, 0, 0); }
            o[et] = a * qdec;
            if ((et & 3) == 3) __builtin_amdgcn_sched_barrier(0); }
        LDS_BAR();
#pragma unroll
        for (int i = 0; i < 4; ++i) { const int q = C.tid + 512 * i, row = q >> 4, pc = q & 15; *(LAS u32x4*)(LR + row * 256 + ((pc ^ (row & 15)) * 16)) = kst[i]; }
#pragma unroll
        for (int et = 0; et < 16; ++et) gwv[et] = *(const u32x2*)(P + (size_t)(m0 + nl) * LDP_RET + 3072 + h * 256 + 16 * et + 4 * g);
        LDS_BAR();
        const float fd0 = (float)opq_v(nl - 4 * g);
        u32x2 pb[8];
#pragma unroll
        for (int mt = 0; mt < 8; ++mt) {
            pb[mt] = (u32x2){0u, 0u};
            if (mt <= w) { f32x4 a = (f32x4){0.f, 0.f, 0.f, 0.f};
#pragma unroll
                for (int s = 0; s < 4; ++s) { const bf16x8 kf = *(const LAS bf16x8*)(LR + (16 * mt + r16) * 256 + (((4 * s + g) ^ r16) * 16));
                    a = __builtin_amdgcn_mfma_f32_16x16x32_bf16(kf, qf[s], a, 0, 0, 0); }
#pragma unroll
                for (int j = 0; j < 4; ++j) { const float fd = fd0 - (float)(16 * mt + j); a[j] = fd >= 0.f ? a[j] * exp2f(fd * lg2) : 0.f; }
                pb[mt].x = cvt_pk_bf16(a[0], a[1]); pb[mt].y = cvt_pk_bf16(a[2], a[3]); }
        }
#pragma unroll
        for (int ks = 0; ks < 4; ++ks) {
            if (2 * ks <= w) {
                u32x4 pw; pw.x = pb[2 * ks].x; pw.y = pb[2 * ks].y; pw.z = pb[2 * ks + 1].x; pw.w = pb[2 * ks + 1].y;
                const bf16x8 pf = __builtin_bit_cast(bf16x8, pw);
#pragma unroll
                for (int et = 0; et < 16; ++et) { const LAS unsigned char* vr = LV + (16 * et + r16) * 256;
                    const u32x2 lo = *(const LAS u32x2*)(vr + (((8 * ks + g) ^ (2 * r16)) * 8)), hi = *(const LAS u32x2*)(vr + (((8 * ks + 4 + g) ^ (2 * r16)) * 8));
                    u32x4 vw; vw.x = lo.x; vw.y = lo.y; vw.z = hi.x; vw.w = hi.y;
                    o[et] = __builtin_amdgcn_mfma_f32_16x16x32_bf16(__builtin_bit_cast(bf16x8, vw), pf, o[et], 0, 0, 0); } }
        }
        float s1 = 0.f;
#pragma unroll
        for (int et = 0; et < 16; ++et) s1 += (o[et][0] + o[et][1]) + (o[et][2] + o[et][3]);
        s1 += shx(s1, C.lane, 16); s1 += shx(s1, C.lane, 32);
        const float mean = s1 * (1.f / 256.f); float s2 = 0.f;
#pragma unroll
        for (int et = 0; et < 16; ++et) { o[et] = o[et] - mean; s2 += (o[et][0] * o[et][0] + o[et][1] * o[et][1]) + (o[et][2] * o[et][2] + o[et][3] * o[et][3]); }
        s2 += shx(s2, C.lane, 16); s2 += shx(s2, C.lane, 32);
        const float rstd = 1.0f / sqrtf(s2 * (1.f / 256.f) + 1e-5f);
        const int m = m0 + nl;
#pragma unroll
        for (int et = 0; et < 16; ++et) { const int e = h * 256 + 16 * et + 4 * g;
            const f32x4 gg = *(const f32x4*)(gn + e), gb = *(const f32x4*)(gn + SW + e);
            const u32x2 gw_ = gwv[et];
            float gt[4] = {bflo(gw_.x), bfhi(gw_.x), bflo(gw_.y), bfhi(gw_.y)}; float ov[4];
#pragma unroll
            for (int j = 0; j < 4; ++j) { const float yn = o[et][j] * rstd * gg[j] + gb[j]; ov[j] = yn * gt[j] * sigmoidf_(gt[j]); }
            u32x2 wv; wv.x = cvt_pk_bf16(ov[0], ov[1]); wv.y = cvt_pk_bf16(ov[2], ov[3]);
            *(u32x2*)(mix + (size_t)m * D + e) = wv; }
    }
    __syncthreads();
}

constexpr int PH_PER_PAIR = 23, NPH = 2 + 2 * PH_PER_PAIR;
__global__ void __launch_bounds__(NTHR, 2) fwd_kernel(Args args) {
    extern __shared__ __attribute__((aligned(16))) unsigned char lds_raw[];
    Ctx C;
    C.lds = (LAS unsigned char*)lds_raw;
    C.tid = threadIdx.x; C.lane = C.tid & 63; C.wave = __builtin_amdgcn_readfirstlane(C.tid >> 6);
    C.bid = blockIdx.x; C.G = GRID; C.gw = C.bid * NWAVES + C.wave; C.NGW = C.G * NWAVES; C.ws = args.ws;
    for (int u = C.tid; u < (LDS_BYTES - LDS_MISC) / 4; u += NTHR) ((LAS unsigned*)(C.lds + LDS_MISC))[u] = 0u;
    __syncthreads();
    const int lo = args.ph_lo, hi = args.ph_hi;
    XcdBarrier bar; bar.bar = (unsigned*)(args.ws + WS_CTL) + CW_BAR; bar.x = 0; bar.st = nullptr;
    if (hi - lo > 1) bar = xcd_barrier_post((unsigned*)(args.ws + WS_CTL) + CW_BAR, (volatile LAS unsigned*)(C.lds + LDS_MISC));
#ifndef ENMASK
#define ENMASK 0x1ffffffu
#endif
#define EN(j) ((((unsigned)(ENMASK)) >> (j)) & 1u)
#ifndef DBLMASK
#define DBLMASK 0u
#endif
#define REP(j) for (int rep_ = 0; rep_ < 1 + (int)((((unsigned)(DBLMASK)) >> (j)) & 1u); ++rep_)
#define IN(k) (lo <= (k) && (k) < hi)
#define SEAM(k) do { if (IN((k) + 1)) xcd_barrier(bar, (lane_id_asm() == 0) && (Cq.wave == 0)); } while (0)

#define PH_BEGIN Ctx Cq; Cq.lds = C.lds; Cq.lane = lane_id_asm(); Cq.wave = opq_i(C.wave); Cq.tid = Cq.wave * 64 + Cq.lane; Cq.bid = opq_i((int)blockIdx.x); Cq.G = GRID; \
        Cq.gw = Cq.bid * NWAVES + Cq.wave; Cq.NGW = Cq.G * NWAVES; Cq.ws = opq(args.ws); unsigned char* ws = Cq.ws; const int lq = opq_i(lp); (void)ws; (void)lq
    { const int lp = 0;
    REP(0) if (EN(0) && IN(0)) { PH_BEGIN; ph_prologue(Cq, args); SEAM(0); }
    REP(1) if (EN(1) && IN(1)) { PH_BEGIN;
        pg8::SchedMem S; S.G = Cq.G; S.c = Cq.bid; S.memb = (unsigned)WS_MEMB; S.wkv = (unsigned)WS_WKV;
        pg8::EpiMem E; E.O0 = (bf16*)(ws + WS_MEMK); E.O1 = (bf16*)(ws + WS_MEMVT);
        pg8::gemm_phase<pg8::EpiMem, pg8::SchedMem, true, true>(Cq.lds, Cq.tid, (const char*)ws, 2048, 2048, 2048, S, E);
        SEAM(1);
    } }
#pragma unroll 1
    for (int lp = 0; lp < 2; ++lp) {
        const int pb = 2 + lp * PH_PER_PAIR;
        REP(2) if (EN(2) && IN(pb + 0)) {
            PH_BEGIN;
            pg8::SchedPlain S; S.init(M / 256, 22, Cq.G, Cq.bid); S.A0 = (unsigned)(WS_XB); S.B0 = (unsigned)(WS_WIN + (size_t)(2 * lq) * 22 * MiB); S.at = (unsigned)(256 * 2048 * 2); S.bt = (unsigned)(256 * 2048 * 2);
            pg8::EpiBf16 E; E.O = (bf16*)(ws + WS_P); E.ldc = LDP_RW;
            pg8::gemm_phase<pg8::EpiBf16, pg8::SchedPlain, true, true>(Cq.lds, Cq.tid, (const char*)ws, 2048, 2048, 2048, S, E);
            SEAM(pb + 0);
        }
        REP(3) if (EN(3) && IN(pb + 1)) { PH_BEGIN; const bool with_v = lq == 1; ph_rwkv_prep1(Cq, args.in[lq ? L2_MU : L0_MU], with_v); ph_memattn(Cq, (const bf16*)(ws + WS_P), LDP_RW, with_v ? 5120 : 5056); SEAM(pb + 1); }
        REP(4) if (EN(4) && IN(pb + 2)) {
            PH_BEGIN; const float* vecs = args.in[lq ? L2_VECS : L0_VECS];
            pg8::SchedLora S; S.skipv = lq == 0; S.init(M / 256, lq == 0 ? 18 : 24, Cq.G, Cq.bid); S.A0 = (unsigned)(WS_ALORA); S.B0 = (unsigned)(WS_WLORA + (size_t)lq * 3 * MiB);
            pg8::EpiLora E; E.O = (bf16*)(ws + WS_LORAOUT); E.vecs = vecs;
            pg8::gemm_phase<pg8::EpiLora, pg8::SchedLora, true, true>(Cq.lds, Cq.tid, (const char*)ws, 512, 256, opq_i(256), S, E);
            SEAM(pb + 2);
        }
        REP(5) if (EN(5) && IN(pb + 3)) { PH_BEGIN; ph_rwkv_prep2(Cq, args.in[lq ? L2_MU : L0_MU], args.in[lq ? L2_VECS : L0_VECS], lq == 1); SEAM(pb + 3); }
        REP(6) if (EN(6) && IN(pb + 4)) { PH_BEGIN; ph_rwkv_scan(Cq, args.in[lq ? L3_MG : L1_MG], args.in[lq ? L3_MU_ : L1_MU_], args.in[lq ? L3_MD : L1_MD], args.in[lq ? L2_VECS : L0_VECS], lq == 1, args.in, lq); SEAM(pb + 4); }
        REP(8) if (EN(8) && IN(pb + 6)) {
            PH_BEGIN;
            pg8::SchedPlain S; S.init(M / 256, 8, Cq.G, Cq.bid); S.A0 = (unsigned)(WS_MIX); S.B0 = (unsigned)(WS_WOUT + (size_t)(2 * lq) * 8 * MiB); S.at = (unsigned)(256 * 2048 * 2); S.bt = (unsigned)(256 * 2048 * 2);
            pg8::EpiBf16 E; E.O = (bf16*)(ws + WS_P); E.ldc = D;
            pg8::gemm_phase<pg8::EpiBf16, pg8::SchedPlain, true, true>(Cq.lds, Cq.tid, (const char*)ws, 2048, 2048, 2048, S, E);
            SEAM(pb + 6);
        }
        REP(9) if (EN(9) && IN(pb + 7)) { PH_BEGIN; const float* nr = args.in[lq ? L2_NORMS : L0_NORMS];
            ph_ln(Cq, ws + WS_P, 0, nr, nr + D, nullptr, ws + WS_X8, nullptr, false); SEAM(pb + 7); }
        REP(10) if (EN(10) && IN(pb + 8)) {
            PH_BEGIN;
            pg8::SchedPlain S; S.init(M / 256, 44, Cq.G, Cq.bid); S.A0 = (unsigned)(WS_X8); S.B0 = (unsigned)(WS_WFGU + (size_t)lq * 44 * MiB); S.at = (unsigned)(256 * 2048); S.bt = (unsigned)(256 * 2048);
            pg8::EpiSwiglu8 E; E.O = ws + WS_HID; E.ldc = DFF; E.inv = 1.0f / 16384.0f; E.so = 32.0f;
            pg8::gemm_phase<pg8::EpiSwiglu8, pg8::SchedPlain, true, true, true>(Cq.lds, Cq.tid, (const char*)ws, 1024, 1024, 1024, S, E);
            SEAM(pb + 8);
        }
        REP(11) if (EN(11) && IN(pb + 9)) {
            PH_BEGIN;
            pg8::SchedPlain S; S.init(M / 256, 8, Cq.G, Cq.bid); S.A0 = (unsigned)(WS_HID); S.B0 = (unsigned)(WS_WFD + (size_t)lq * 22 * MiB); S.at = (unsigned)(256 * DFF); S.bt = (unsigned)(256 * DFF);
            pg8::EpiFp8S E; E.O = ws + WS_P; E.ldc = D; E.sc = 1.0f / 256.0f;
            pg8::gemm_phase<pg8::EpiFp8S, pg8::SchedPlain, true, true, true>(Cq.lds, Cq.tid, (const char*)ws, DFF / 2, DFF / 2, DFF / 2, S, E);
            SEAM(pb + 9);
        }
        REP(12) if (EN(12) && IN(pb + 10)) { PH_BEGIN; const float* nr = args.in[lq ? L2_NORMS : L0_NORMS];
            ph_ln(Cq, ws + WS_P, 1, nr + 2 * D, nr + 3 * D, nullptr, nullptr, nullptr, false); SEAM(pb + 10); }
        REP(13) if (EN(13) && IN(pb + 11)) {
            PH_BEGIN;
            pg8::SchedPlain S; S.init(M / 256, 20, Cq.G, Cq.bid); S.A0 = (unsigned)(WS_XB); S.B0 = (unsigned)(WS_WIN + (size_t)(2 * lq + 1) * 22 * MiB); S.at = (unsigned)(256 * 2048 * 2); S.bt = (unsigned)(256 * 2048 * 2);
            pg8::EpiBf16 E; E.O = (bf16*)(ws + WS_P); E.ldc = LDP_RET;
            pg8::gemm_phase<pg8::EpiBf16, pg8::SchedPlain, true, true>(Cq.lds, Cq.tid, (const char*)ws, 2048, 2048, 2048, S, E);
            SEAM(pb + 11);
        }
        REP(14) if (EN(14) && IN(pb + 12)) { PH_BEGIN; ph_ret_prep(Cq); ph_memattn(Cq, (const bf16*)(ws + WS_P), LDP_RET, 4608); SEAM(pb + 12); }
        REP(16) if (EN(16) && IN(pb + 14)) { PH_BEGIN; ph_ret_prefix(Cq); SEAM(pb + 14); }
        REP(17) if (EN(17) && IN(pb + 15)) { PH_BEGIN; ph_ret_out(Cq, args.in[lq ? L3_GN : L1_GN]); SEAM(pb + 15); }
        REP(18) if (EN(18) && IN(pb + 16)) {
            PH_BEGIN;
            pg8::SchedPlain S; S.init(M / 256, 8, Cq.G, Cq.bid); S.A0 = (unsigned)(WS_MIX); S.B0 = (unsigned)(WS_WOUT + (size_t)(2 * lq + 1) * 8 * MiB); S.at = (unsigned)(256 * 2048 * 2); S.bt = (unsigned)(256 * 2048 * 2);
            pg8::EpiBf16 E; E.O = (bf16*)(ws + WS_P); E.ldc = D;
            pg8::gemm_phase<pg8::EpiBf16, pg8::SchedPlain, true, true>(Cq.lds, Cq.tid, (const char*)ws, 2048, 2048, 2048, S, E);
            SEAM(pb + 16);
        }
        REP(19) if (EN(19) && IN(pb + 17)) {
            PH_BEGIN; const float* nr = args.in[lq ? L3_NORMS : L1_NORMS];
            REP(25) { ph_ln(Cq, ws + WS_P, 0, nr, nr + D, nullptr, ws + WS_X8, args.in[lq ? L3_ROUTER : L1_ROUTER], true);
            __syncthreads(); }
            SEAM(pb + 17);
        }
        REP(20) if (EN(20) && IN(pb + 18)) { PH_BEGIN; ph_slots(Cq); SEAM(pb + 18); }
        REP(22) if (EN(22) && IN(pb + 20)) {
            PH_BEGIN;
            const int nT = __builtin_amdgcn_readfirstlane(((const int*)(ws + WS_CTL))[CW_NT]);
            pg8::SchedMoEg S; S.init(nT, 44, Cq.G, Cq.bid); S.B0 = (unsigned)(WS_MWGU); S.bt = (unsigned)(256 * 2048); S.be = (unsigned)(22 * MiB);
            S.xoff = (unsigned)WS_X8; S.zoff = (unsigned)(WS_CTL + 512 * 1024); S.texp = (const int*)(ws + WS_CTL) + CW_TEXP; S.slot_tok = (const int*)(ws + WS_SLOTTOK);
            pg8::EpiSwiglu8 E; E.O = ws + WS_HIDM; E.ldc = DFF; E.inv = 1.0f / 16384.0f; E.so = 32.0f;
            pg8::gemm_phase<pg8::EpiSwiglu8, pg8::SchedMoEg, true, true, true>(Cq.lds, Cq.tid, (const char*)ws, 1024, 1024, 1024, S, E);
            SEAM(pb + 20);
        }
        REP(23) if (EN(23) && IN(pb + 21)) {
            PH_BEGIN;
            const int nT = __builtin_amdgcn_readfirstlane(((const int*)(ws + WS_CTL))[CW_NT]);
            pg8::SchedMoE S; S.init(nT, 8, Cq.G, Cq.bid); S.A0 = (unsigned)(WS_HIDM); S.B0 = (unsigned)(WS_MWD); S.at = (unsigned)(256 * DFF); S.bt = (unsigned)(256 * DFF); S.be = (unsigned)(11 * MiB);
            S.texp = (const int*)(ws + WS_CTL) + CW_TEXP;
            pg8::EpiFp8S E; E.O = ws + WS_XPERM; E.ldc = D; E.sc = 1.0f / 256.0f;
            pg8::gemm_phase<pg8::EpiFp8S, pg8::SchedMoE, true, true, true>(Cq.lds, Cq.tid, (const char*)ws, DFF / 2, DFF / 2, DFF / 2, S, E);
            SEAM(pb + 21);
        }
        REP(24) if (EN(24) && IN(pb + 22)) {
            PH_BEGIN; const float* nr = args.in[lq ? L3_NORMS : L1_NORMS];
            ph_ln(Cq, ws + WS_XPERM, 2, nr + 2 * D, nr + 3 * D, lq == 1 ? args.out : nullptr, nullptr, nullptr, false);
            SEAM(pb + 22);
        }
    }
#undef IN
#undef SEAM
}

#ifndef MK_PER_PHASE
#define MK_PER_PHASE 0
#endif
extern "C" void kernel_launch(void* const* d_in, const int* in_sizes, int n_in, void* d_out, int out_size, void* d_ws, size_t ws_size, hipStream_t stream) {
    static int ready = 0;
    if (ready == 0) {
        ready = 1;
        if (n_in != 43 || out_size != M * D || ws_size < WS_END) { fprintf(stderr, "kernel_launch: unexpected problem (n_in %d out %d ws %zu need %zu)\n", n_in, out_size, ws_size, (size_t)WS_END); ready = -1; }
        else if (hipFuncSetAttribute((const void*)fwd_kernel, hipFuncAttributeMaxDynamicSharedMemorySize, LDS_BYTES) != hipSuccess) { fprintf(stderr, "kernel_launch: hipFuncSetAttribute failed\n"); ready = -1; }
        (void)hipGetLastError();
    }
    if (ready < 0) return;
    (void)hipMemsetAsync((char*)d_ws + WS_CTL, 0, CTL_BYTES, stream);
    Args a{};
    for (int i = 0; i < 43; ++i) a.in[i] = (const float*)d_in[i];
    a.out = (float*)d_out; a.ws = (unsigned char*)d_ws;
#if MK_PER_PHASE
    for (int p = 0; p < NPH; ++p) { a.ph_lo = p; a.ph_hi = p + 1; hipLaunchKernelGGL(fwd_kernel, dim3(GRID), dim3(NTHR), LDS_BYTES, stream, a); }
#else
    a.ph_lo = 0; a.ph_hi = NPH;
    hipLaunchKernelGGL(fwd_kernel, dim3(GRID), dim3(NTHR), LDS_BYTES, stream, a);
#endif
}
```

```cpp
#include <hip/hip_runtime.h>
#include <cstdio>
#include <cstdint>

#define LAS __attribute__((address_space(3)))
#define GAS __attribute__((address_space(1)))
typedef unsigned short bf16;
typedef short bf16x8 __attribute__((ext_vector_type(8)));
typedef float f32x4 __attribute__((ext_vector_type(4)));
typedef float f32x2 __attribute__((ext_vector_type(2)));
typedef unsigned u32x4 __attribute__((ext_vector_type(4)));
typedef unsigned u32x2 __attribute__((ext_vector_type(2)));

constexpr int M = 32768, D = 2048, SEQ = 2048, NB = 16;
constexpr int SW = 1536;
constexpr int LDP_RW = 5632, LDP_RET = 5120;
constexpr int DFF = 5632;
constexpr int NSLOT = 67584;
constexpr float ALPHA = 1.6817928305074290f;
constexpr float LN_EPS = 1e-5f;
constexpr int NWAVES = 8, NTHR = 512, GRID = 256;

constexpr size_t MiB = 1u << 20;
constexpr size_t WS_CTL = 0, CTL_BYTES = 1 * MiB;
constexpr size_t WS_WKV = 1 * MiB;
constexpr size_t WS_WIN = WS_WKV + 4 * MiB;
constexpr size_t WS_WOUT = WS_WIN + 88 * MiB;
constexpr size_t WS_WLORA = WS_WOUT + 32 * MiB;
constexpr size_t WS_WFGU = WS_WLORA + 6 * MiB;
constexpr size_t WS_WFD = WS_WFGU + 88 * MiB;
constexpr size_t WS_MEMB = WS_WFD + 44 * MiB;
constexpr size_t WS_MEMK = WS_MEMB + 16 * MiB;
constexpr size_t WS_MEMVT = WS_MEMK + 4 * MiB;
constexpr size_t WS_CS = WS_MEMVT + 4 * MiB;
constexpr size_t WS_XB = WS_CS + 16 * MiB;
constexpr size_t WS_MIX = WS_XB + 128 * MiB;
constexpr size_t WS_VFIRST = WS_MIX + 128 * MiB;
constexpr size_t WS_P = WS_VFIRST + 96 * MiB;
constexpr size_t WS_MISC = WS_P + 352 * MiB;
constexpr size_t WS_ROUTE = WS_MISC, WS_SLOT1 = WS_MISC + 512 * 1024, WS_SLOT2 = WS_SLOT1 + 128 * 1024, WS_SLOTTOK = WS_SLOT2 + 128 * 1024;
constexpr size_t WS_BONUS = WS_MISC + 2 * MiB;
constexpr size_t WS_SB = WS_BONUS + 3 * MiB;
constexpr size_t WS_ALORA = WS_SB, WS_LORAOUT = WS_SB + 32 * MiB, WS_SCANIN = WS_SB + 416 * MiB;
constexpr size_t WS_QR = WS_SB, WS_KR = WS_SB + 48 * MiB, WS_KDT = WS_SB + 96 * MiB, WS_VT = WS_SB + 144 * MiB, WS_KVT = WS_SB + 240 * MiB, WS_RTB = WS_SB + 432 * MiB;
constexpr size_t WS_HID = WS_SB;
constexpr size_t WS_XPERM = WS_SB, WS_HIDM = WS_SB + 264 * MiB, WS_MWGU = WS_SB + 1184 * MiB, WS_MWD = WS_SB + 1360 * MiB;
constexpr size_t WS_XLO = WS_SB + 1518 * MiB;
constexpr size_t WS_X8 = WS_XLO + 64 * MiB;
constexpr size_t WS_END = WS_X8 + 64 * MiB;
constexpr int CW_BAR = 4096;
constexpr int CW_CNT = 16384;
constexpr int CW_NT = 20480;
constexpr int CW_TEXP = 20544;

constexpr int RING_BYTES = 131072;
constexpr int LDS_MISC = RING_BYTES;
constexpr int LDS_BYTES = RING_BYTES + 8192;

#define LDS_WAIT() asm volatile("s_waitcnt lgkmcnt(0)" ::: "memory")
#define VM_WAIT() asm volatile("s_waitcnt vmcnt(0)" ::: "memory")
__device__ __forceinline__ unsigned cvt_pk_bf16(float lo, float hi) { unsigned r; asm volatile("v_cvt_pk_bf16_f32 %0, %1, %2" : "=v"(r) : "v"(lo), "v"(hi)); return r; }
__device__ __forceinline__ bf16 f2bf(float f) { return (bf16)(cvt_pk_bf16(f, 0.f) & 0xffffu); }
__device__ __forceinline__ float bf2f(bf16 b) { return __uint_as_float(((unsigned)b) << 16); }
__device__ __forceinline__ float bflo(unsigned w) { return __uint_as_float(w << 16); }
__device__ __forceinline__ float bfhi(unsigned w) { return __uint_as_float(w & 0xffff0000u); }
template <int CTRL> __device__ __forceinline__ float dpp_add(float x) {
    int y = __builtin_amdgcn_update_dpp(0, __float_as_int(x), CTRL, 0xf, 0xf, true);
    return x + __int_as_float(y);
}
__device__ __forceinline__ float row16_sum(float x) { x = dpp_add<0xB1>(x); x = dpp_add<0x4E>(x); x = dpp_add<0x141>(x); x = dpp_add<0x140>(x); return x; }
__device__ __forceinline__ float wave_sum(float v) {
    v = row16_sum(v);
    const float a = __int_as_float(__builtin_amdgcn_readlane(__float_as_int(v), 0)), b = __int_as_float(__builtin_amdgcn_readlane(__float_as_int(v), 16));
    const float c = __int_as_float(__builtin_amdgcn_readlane(__float_as_int(v), 32)), d = __int_as_float(__builtin_amdgcn_readlane(__float_as_int(v), 48));
    return (a + b) + (c + d);
}
__device__ __forceinline__ unsigned pk4_fp8(float a, float b, float c, float d) {
    a = __builtin_amdgcn_fmed3f(a, -448.f, 448.f); b = __builtin_amdgcn_fmed3f(b, -448.f, 448.f); c = __builtin_amdgcn_fmed3f(c, -448.f, 448.f); d = __builtin_amdgcn_fmed3f(d, -448.f, 448.f);
    unsigned w = 0; w = __builtin_amdgcn_cvt_pk_fp8_f32(a, b, w, false); w = __builtin_amdgcn_cvt_pk_fp8_f32(c, d, w, true); return w; }
__device__ __forceinline__ float sigmoidf_(float z) { return __builtin_amdgcn_rcpf(1.0f + __expf(-z)); }

__device__ __forceinline__ unsigned char* opq(unsigned char* p) { asm volatile("" : "+s"(p)); return p; }
__device__ __forceinline__ int opq_i(int v) { asm volatile("" : "+s"(v)); return v; }
__device__ __forceinline__ int opq_v(int v) { asm volatile("" : "+v"(v)); return v; }
__device__ __forceinline__ int lane_id_asm() { int l; asm volatile("v_mbcnt_lo_u32_b32 %0, -1, 0\n\tv_mbcnt_hi_u32_b32 %0, -1, %0" : "=v"(l)); return l; }
typedef _Float16 h16x2 __attribute__((ext_vector_type(2)));
__device__ __forceinline__ float shx(float v, int lane, int m) { return __builtin_bit_cast(float, __builtin_amdgcn_ds_bpermute((lane ^ m) << 2, __builtin_bit_cast(int, v))); }
__device__ __forceinline__ float shl(float v, int src) { return __builtin_bit_cast(float, __builtin_amdgcn_ds_bpermute(src << 2, __builtin_bit_cast(int, v))); }
#define XB_TMO      128
#define XB_XCNT(j)  (256  + 64 * (j))
#define XB_XSUB(j)  (1280 + 64 * (j))
#define XB_XGEN(j)  (2304 + 64 * (j))
#define XB_TOP      3328
#define XB_TOPGEN   3392
#define XCD_BAR_WORDS 3456
#define XB_SPIN_CAP (1u << 18)
__device__ __forceinline__ unsigned xb_ld(unsigned* p)              { return __hip_atomic_load(p, __ATOMIC_RELAXED, __HIP_MEMORY_SCOPE_AGENT); }
__device__ __forceinline__ unsigned xb_add(unsigned* p, unsigned v) { return __hip_atomic_fetch_add(p, v, __ATOMIC_RELAXED, __HIP_MEMORY_SCOPE_AGENT); }
__device__ __forceinline__ unsigned xb_xcc_id() { return (unsigned)__builtin_amdgcn_s_getreg((3 << 11) | 20) & 0xFu; }
#define XB_SPIN(cond, bar) do { unsigned _sp = 0; while (cond) { __builtin_amdgcn_s_sleep(1); \
    if ((++_sp & 255u) == 0u) { if (xb_ld(&(bar)[XB_TMO])) break; if (_sp > XB_SPIN_CAP) { atomicAdd(&(bar)[XB_TMO], 1u); break; } } } } while (0)
struct XcdBarrier { unsigned* bar; unsigned x; volatile LAS unsigned* st; };
__device__ __forceinline__ XcdBarrier xcd_barrier_post(unsigned* bar, volatile LAS unsigned* st) {
    XcdBarrier b; b.bar = bar; b.x = xb_xcc_id(); b.st = st;
    if (threadIdx.x == 0) (void)xb_add(&bar[XB_XCNT(b.x)], 1u);
    return b;
}
__device__ __forceinline__ void xcd_barrier_complete(unsigned* bar, unsigned x, unsigned& nloc, unsigned& nx) {
    const unsigned G = gridDim.x * gridDim.y * gridDim.z;
    unsigned sum, cnt, mine, sp = 0u;
    for (;;) {
        sum = 0u; cnt = 0u; mine = 0u;
#pragma unroll
        for (unsigned j = 0; j < 16; ++j) { const unsigned c = xb_ld(&bar[XB_XCNT(j)]); sum += c; cnt += (c > 0u) ? 1u : 0u; mine = (j == x) ? c : mine; }
        if (sum == G) break;
        __builtin_amdgcn_s_sleep(1);
        if ((++sp & 255u) == 0u) { if (xb_ld(&bar[XB_TMO])) break; if (sp > XB_SPIN_CAP) { atomicAdd(&bar[XB_TMO], 1u); break; } }
    }
    nloc = mine > 0u ? mine : 1u; nx = cnt > 0u ? cnt : 1u;
}
__device__ __forceinline__ void xcd_barrier(const XcdBarrier& b, const bool leader  ) {
    asm volatile("s_waitcnt vmcnt(0)" ::: "memory");
    __syncthreads();
    if (leader) {
        unsigned* bar = b.bar;
        __builtin_amdgcn_s_waitcnt(0);
        unsigned nloc = b.st[0], nx = b.st[1];
        if (nloc == 0u) { xcd_barrier_complete(bar, b.x, nloc, nx); b.st[0] = nloc; b.st[1] = nx; }
        const unsigned old = xb_add(&bar[XB_XSUB(b.x)], 1u);
        const unsigned gen = old / nloc;
        if (old + 1u == (gen + 1u) * nloc) {
            __builtin_amdgcn_fence(__ATOMIC_RELEASE, "agent");
            asm volatile("s_waitcnt vmcnt(0)" ::: "memory");
            const unsigned og = xb_add(&bar[XB_TOP], 1u);
            const unsigned tg = og / nx;
            if (og + 1u == (tg + 1u) * nx) xb_add(&bar[XB_TOPGEN], 1u);
            else XB_SPIN(xb_ld(&bar[XB_TOPGEN]) == tg, bar);
            __builtin_amdgcn_fence(__ATOMIC_ACQUIRE, "agent");
            xb_add(&bar[XB_XGEN(b.x)], 1u);
            asm volatile("s_waitcnt vmcnt(0)" ::: "memory");
        } else {
            XB_SPIN(xb_ld(&bar[XB_XGEN(b.x)]) == gen, bar);
            __builtin_amdgcn_fence(__ATOMIC_ACQUIRE, "agent");
            asm volatile("s_waitcnt vmcnt(0)" ::: "memory");
        }
    }
    __syncthreads();
}

namespace pg8 {
constexpr int BM = 256, BK = 64, HALF = 128, HTB = HALF * BK * 2, STAGE_BYTES = 8 * HTB, NXCD = 8, WGM = 8;
__host__ __device__ __forceinline__ int lds_byte(int r, int c) { const int st = (r >> 4) * 2 + (c >> 5), rr = r & 15, cc = c & 31, ob = rr * 64 + cc * 2; return st * 1024 + (ob ^ (((ob >> 9) & 1) << 5)); }
__host__ __device__ __forceinline__ void stage_rc(int b, int& R, int& C) { const int st = b / 1024, sb = b % 1024, swz = sb ^ (((sb >> 9) & 1) << 5); R = (st >> 1) * 16 + swz / 64; C = (st & 1) * 32 + (swz % 64) / 2; }
__host__ __device__ __forceinline__ int perm32(int rho) { const int n = rho >> 4, i = rho & 15; return 8 * (i >> 2) + 4 * n + (i & 3); }
typedef int i32x8 __attribute__((ext_vector_type(8)));
typedef int i32x4_ __attribute__((ext_vector_type(4)));
__device__ __forceinline__ i32x8 cat8(bf16x8 a, bf16x8 b) { const i32x4_ x = __builtin_bit_cast(i32x4_, a), y = __builtin_bit_cast(i32x4_, b); return __builtin_shufflevector(x, y, 0, 1, 2, 3, 4, 5, 6, 7); }
__device__ __forceinline__ void mfma8(f32x4& acc, const i32x8 a, const i32x8 b) {
    asm volatile("v_mfma_scale_f32_16x16x128_f8f6f4 %0, %1, %2, %0, %3, %3 op_sel_hi:[0,0,0]" : "+v"(acc) : "v"(a), "v"(b), "v"(127)); }
struct Unit { int pm, pn, z; };
struct Order {
    int nM, nN, nwg, G, c;
    __device__ __forceinline__ void init(int nM_, int nN_, int G_, int c_) { nM = nM_; nN = nN_; nwg = nM * nN; G = G_; c = c_; }
    __device__ __forceinline__ bool next_mn(int i, Unit& u) const {
        const long L = (long)i * G + c; if (L >= nwg) return false;
        int wgid = (int)L; { const int q = nwg / NXCD, r = nwg % NXCD, xcd = wgid % NXCD, off = wgid / NXCD; wgid = (xcd < r ? xcd * (q + 1) : r * (q + 1) + (xcd - r) * q) + off; }
        const int nig = WGM * nN, gid = wgid / nig, fm = gid * WGM, gsz = (nM - fm) < WGM ? (nM - fm) : WGM;
        u.pm = fm + ((wgid % nig) % gsz); u.pn = (wgid % nig) / gsz; u.z = 0; return true;
    }
};

template <class Epi, class Sched, bool ALIGN_EPI, bool SP2, bool FP8 = false>
__device__ __forceinline__ void gemm_phase(LAS unsigned char* lds, const int tid_in, const char* base  , const int lda, const int ldb, const int K, const Sched& S, const Epi& E) {
    const int tid = tid_in, wid = __builtin_amdgcn_readfirstlane(tid >> 6), lane = tid & 63, wr = wid >> 2, wc = wid & 3, fr = lane & 15, fq = lane >> 4;
    const int nt = K / BK;
    unsigned voffA[2], voffB[2];
#pragma unroll
    for (int i = 0; i < 2; ++i) { int R, C; stage_rc(tid * 16 + i * 8192, R, C); const int Rb = Epi::PERM ? ((R & ~31) + perm32(R & 31)) : R;
        voffA[i] = (unsigned)(R * lda + C) * 2u; voffB[i] = (unsigned)(Rb * ldb + C) * 2u; }
    constexpr bool GATHER = Sched::GATHER;
    unsigned gvC[2][2], gvN[2][2];
#define PG8_GV(dst, unit) do { _Pragma("unroll") for (int hh_ = 0; hh_ < 2; ++hh_) _Pragma("unroll") for (int i_ = 0; i_ < 2; ++i_) { int R_, C_; stage_rc(tid * 16 + i_ * 8192, R_, C_); \
        dst[hh_][i_] = S.arow(unit, hh_ * HALF + R_) + (unsigned)C_ * 2u; } } while (0)
    const unsigned kstep = (unsigned)(BK * 2);
    const unsigned hstepA = (unsigned)(HALF * lda * 2), hstepB = (unsigned)(HALF * ldb * 2);
    const __amdgpu_buffer_rsrc_t rsrc = __builtin_amdgcn_make_buffer_rsrc((void*)base, 0, 0xffffffffu, 0x00020000);
    const unsigned ldsw = (unsigned)wid * 1024u;
    const int aoff = lds_byte(wr * 64 + fr, fq * 8), boff = lds_byte(wc * 32 + fr, fq * 8);
#define PG8_SA(b, h) (((b) * 2 + (h)) * HTB)
#define PG8_SB(b, h) ((4 + (b) * 2 + (h)) * HTB)
#define PG8_STAGE(bufoff, goff, voff) do { _Pragma("unroll") for (int _i = 0; _i < 2; ++_i) \
        __builtin_amdgcn_raw_ptr_buffer_load_lds(rsrc, (LAS unsigned*)(lds + (bufoff) + ldsw + _i * 8192), 16, (voff)[_i], (goff), 0, 0); } while (0)
#define PG8_STAGE_A(bufoff, aoff, hh, nx) do { if constexpr (GATHER) { unsigned gv_[2]; gv_[0] = (nx) ? gvN[hh][0] : gvC[hh][0]; gv_[1] = (nx) ? gvN[hh][1] : gvC[hh][1]; PG8_STAGE(bufoff, aoff, gv_); } \
        else { PG8_STAGE(bufoff, (aoff) + (hh) * hstepA, voffA); } } while (0)
#define PG8_LDA(dst, b, h) do { _Pragma("unroll") for (int m = 0; m < 4; ++m) _Pragma("unroll") for (int k = 0; k < 2; ++k) dst[m][k] = *(const LAS bf16x8*)(lds + PG8_SA(b, h) + aoff + m * 2048 + k * 1024); } while (0)
#define PG8_LDB(dst, b, h) do { _Pragma("unroll") for (int n = 0; n < 2; ++n) _Pragma("unroll") for (int k = 0; k < 2; ++k) dst[n][k] = *(const LAS bf16x8*)(lds + PG8_SB(b, h) + boff + n * 2048 + k * 1024); } while (0)
#define PG8_MMA(ai, bj, At, Bt) do { __builtin_amdgcn_s_setprio(1); \
        if constexpr (FP8) { _Pragma("unroll") for (int m = 0; m < 4; ++m) _Pragma("unroll") for (int n = 0; n < 2; ++n) \
            mfma8(acc[ai][bj][m][n], cat8(Bt[n][0], Bt[n][1]), cat8(At[m][0], At[m][1])); } \
        else { _Pragma("unroll") for (int m = 0; m < 4; ++m) _Pragma("unroll") for (int n = 0; n < 2; ++n) _Pragma("unroll") for (int k = 0; k < 2; ++k) \
            acc[ai][bj][m][n] = __builtin_amdgcn_mfma_f32_16x16x32_bf16(Bt[n][k], At[m][k], acc[ai][bj][m][n], 0, 0, 0); } \
        __builtin_amdgcn_s_setprio(0); } while (0)
#define PG8_WAIT_V(n) asm volatile("s_waitcnt vmcnt(" #n ")" ::: "memory")
#define PG8_WAIT_L(n) asm volatile("s_waitcnt lgkmcnt(" #n ")" ::: "memory")
#define PG8_BAR __builtin_amdgcn_s_barrier()
#define PG8_SCHED __builtin_amdgcn_sched_barrier(0)
    Unit cur, nxt; int ui = 0;
    if (!S.next(0, cur)) return;
    f32x4 acc[2][2][4][2];
#pragma unroll
    for (int a = 0; a < 2; ++a)
#pragma unroll
        for (int b = 0; b < 2; ++b)
#pragma unroll
            for (int m = 0; m < 4; ++m)
#pragma unroll
                for (int n = 0; n < 2; ++n) acc[a][b][m][n] = (f32x4){0.f, 0.f, 0.f, 0.f};
    bf16x8 At[4][2], B0[2][2], B1[2][2];
    unsigned cA = S.A(cur), cB = S.B(cur);
    if constexpr (GATHER) { PG8_GV(gvC, cur); _Pragma("unroll") for (int hh_ = 0; hh_ < 2; ++hh_) _Pragma("unroll") for (int i_ = 0; i_ < 2; ++i_) gvN[hh_][i_] = gvC[hh_][i_]; }
    if constexpr (SP2) {
        PG8_STAGE(PG8_SB(0, 0), cB, voffB); PG8_STAGE(PG8_SB(0, 1), cB + hstepB, voffB); PG8_STAGE_A(PG8_SA(0, 0), cA, 0, false); PG8_STAGE_A(PG8_SA(0, 1), cA, 1, false);
        if (wr == 1) PG8_BAR;
        PG8_WAIT_V(2); PG8_BAR;
        PG8_STAGE(PG8_SB(1, 0), cB + kstep, voffB); PG8_STAGE_A(PG8_SA(1, 0), cA + kstep, 0, false); PG8_STAGE(PG8_SB(1, 1), cB + hstepB + kstep, voffB);
        PG8_WAIT_V(6); PG8_BAR;
    } else {
        PG8_STAGE(PG8_SB(0, 0), cB, voffB); PG8_STAGE_A(PG8_SA(0, 0), cA, 0, false); PG8_STAGE(PG8_SB(0, 1), cB + hstepB, voffB); PG8_STAGE_A(PG8_SA(0, 1), cA, 1, false);
        if (wr == 1) PG8_BAR;
        PG8_WAIT_V(4); PG8_BAR;
        PG8_STAGE(PG8_SB(1, 0), cB + kstep, voffB); PG8_STAGE_A(PG8_SA(1, 0), cA + kstep, 0, false); PG8_STAGE(PG8_SB(1, 1), cB + hstepB + kstep, voffB);
        PG8_WAIT_V(6); PG8_BAR;
    }
    for (;;) {
        const bool has_next = S.next(ui + 1, nxt);
        const unsigned nA = has_next ? S.A(nxt) : cA, nB = has_next ? S.B(nxt) : cB;
        if constexpr (GATHER) { if (has_next) PG8_GV(gvN, nxt); }
        for (int t = 0; t < nt; t += 2) {
            const bool last = (t == nt - 2);
            const unsigned a1 = cA + (unsigned)(t + 1) * kstep;
            const unsigned a2 = last ? nA : cA + (unsigned)(t + 2) * kstep, b2 = last ? nB : cB + (unsigned)(t + 2) * kstep;
            const unsigned a3 = a2 + kstep, b3 = b2 + kstep;
            if constexpr (SP2) {
            PG8_LDB(B0, 0, 0); PG8_LDB(B1, 0, 1); PG8_SCHED; PG8_LDA(At, 0, 0); PG8_STAGE_A(PG8_SA(1, 1), a1, 1, false);
            PG8_WAIT_V(8); PG8_WAIT_L(0); PG8_BAR; PG8_MMA(0, 0, At, B0); PG8_MMA(0, 1, At, B1); PG8_BAR; PG8_SCHED;
            PG8_LDA(At, 0, 1); PG8_STAGE(PG8_SB(0, 0), b2, voffB); PG8_STAGE(PG8_SB(0, 1), b2 + hstepB, voffB); PG8_STAGE_A(PG8_SA(0, 0), a2, 0, last);
            PG8_WAIT_V(8); PG8_WAIT_L(0); PG8_BAR; PG8_MMA(1, 0, At, B0); PG8_MMA(1, 1, At, B1); PG8_BAR; PG8_SCHED;
            PG8_LDB(B0, 1, 0); PG8_LDB(B1, 1, 1); PG8_SCHED; PG8_LDA(At, 1, 0); PG8_STAGE_A(PG8_SA(0, 1), a2, 1, last);
            PG8_WAIT_V(8); PG8_WAIT_L(0); PG8_BAR; PG8_MMA(0, 0, At, B0); PG8_MMA(0, 1, At, B1); PG8_BAR; PG8_SCHED;
            PG8_LDA(At, 1, 1); PG8_STAGE(PG8_SB(1, 0), b3, voffB); PG8_STAGE(PG8_SB(1, 1), b3 + hstepB, voffB); PG8_STAGE_A(PG8_SA(1, 0), a3, 0, last);
            PG8_WAIT_V(8); PG8_WAIT_L(0); PG8_BAR; PG8_MMA(1, 0, At, B0); PG8_MMA(1, 1, At, B1); PG8_BAR; PG8_SCHED;
            } else {
            PG8_LDB(B0, 0, 0); PG8_SCHED; PG8_LDA(At, 0, 0); PG8_STAGE_A(PG8_SA(1, 1), a1, 1, false);
            PG8_WAIT_L(8); PG8_BAR; PG8_WAIT_L(0); PG8_MMA(0, 0, At, B0); PG8_BAR; PG8_SCHED;
            PG8_LDB(B1, 0, 1); PG8_STAGE(PG8_SB(0, 0), b2, voffB);
            PG8_BAR; PG8_WAIT_L(0); PG8_MMA(0, 1, At, B1); PG8_BAR;
            PG8_LDA(At, 0, 1); PG8_STAGE_A(PG8_SA(0, 0), a2, 0, last);
            PG8_BAR; PG8_WAIT_L(0); PG8_MMA(1, 0, At, B0); PG8_BAR; PG8_SCHED;
            PG8_STAGE(PG8_SB(0, 1), b2 + hstepB, voffB);
            PG8_WAIT_V(6); PG8_BAR; PG8_MMA(1, 1, At, B1); PG8_BAR;
            PG8_LDB(B0, 1, 0); PG8_SCHED; PG8_LDA(At, 1, 0); PG8_STAGE_A(PG8_SA(0, 1), a2, 1, last);
            PG8_WAIT_L(8); PG8_BAR; PG8_WAIT_L(0); PG8_MMA(0, 0, At, B0); PG8_BAR; PG8_SCHED;
            PG8_LDB(B1, 1, 1); PG8_STAGE(PG8_SB(1, 0), b3, voffB);
            PG8_BAR; PG8_WAIT_L(0); PG8_MMA(0, 1, At, B1); PG8_BAR;
            PG8_LDA(At, 1, 1); PG8_STAGE_A(PG8_SA(1, 0), a3, 0, last);
            PG8_BAR; PG8_WAIT_L(0); PG8_MMA(1, 0, At, B0); PG8_BAR; PG8_SCHED;
            PG8_STAGE(PG8_SB(1, 1), b3 + hstepB, voffB);
            PG8_WAIT_V(6); PG8_BAR; PG8_MMA(1, 1, At, B1); PG8_BAR;
            }
        }
        if constexpr (ALIGN_EPI) { if (wr == 0) PG8_BAR; }
        if constexpr (FP8) asm volatile("s_nop 15\n\ts_nop 15\n\ts_nop 7" ::: "memory");
        E(acc, cur, wr, wc, fr, fq);
        if (!has_next) break;
#pragma unroll
        for (int a = 0; a < 2; ++a)
#pragma unroll
            for (int b = 0; b < 2; ++b)
#pragma unroll
                for (int m = 0; m < 4; ++m)
#pragma unroll
                    for (int n = 0; n < 2; ++n) acc[a][b][m][n] = (f32x4){0.f, 0.f, 0.f, 0.f};
        cur = nxt; cA = nA; cB = nB; ++ui;
        if constexpr (GATHER) { _Pragma("unroll") for (int hh_ = 0; hh_ < 2; ++hh_) _Pragma("unroll") for (int i_ = 0; i_ < 2; ++i_) gvC[hh_][i_] = gvN[hh_][i_]; }
        if constexpr (ALIGN_EPI) { if (wr == 1) PG8_BAR; }
    }
    PG8_WAIT_V(0);
    if constexpr (!ALIGN_EPI) { if (wr == 0) PG8_BAR; }
    PG8_BAR;
#undef PG8_SA
#undef PG8_SB
#undef PG8_STAGE
#undef PG8_STAGE_A
#undef PG8_GV
#undef PG8_LDA
#undef PG8_LDB
#undef PG8_MMA
#undef PG8_WAIT_V
#undef PG8_WAIT_L
#undef PG8_BAR
#undef PG8_SCHED
}

struct SchedPlain : Order {
    static constexpr bool GATHER = false; __device__ __forceinline__ unsigned arow(const Unit&, int) const { return 0u; }
    unsigned A0, B0, at, bt;
    __device__ __forceinline__ bool next(int i, Unit& u) const { return next_mn(i, u); }
    __device__ __forceinline__ unsigned A(const Unit& u) const { return A0 + (unsigned)u.pm * at; }
    __device__ __forceinline__ unsigned B(const Unit& u) const { return B0 + (unsigned)u.pn * bt; }
};
struct SchedLora : Order {
    static constexpr bool GATHER = false; __device__ __forceinline__ unsigned arow(const Unit&, int) const { return 0u; }
    unsigned A0, B0; int skipv;
    __device__ __forceinline__ bool next(int i, Unit& u) const { if (!next_mn(i, u)) return false; if (skipv && u.pn >= 12) u.pn += 6; return true; }
    __device__ __forceinline__ unsigned A(const Unit& u) const { return A0 + (unsigned)u.pm * (256u * 512u * 2u) + (u.pn >= 18 ? 512u : 0u); }
    __device__ __forceinline__ unsigned B(const Unit& u) const { return B0 + (unsigned)u.pn * (256u * 256u * 2u); }
};
struct SchedMem {
    static constexpr bool GATHER = false; __device__ __forceinline__ unsigned arow(const Unit&, int) const { return 0u; }
    int G, c; unsigned memb, wkv;
    __device__ __forceinline__ bool next(int i, Unit& u) const {
        const int L = i * G + c; if (L >= 64) return false;
        if (L < 32) { u.z = 0; u.pm = L >> 1; u.pn = L & 1; } else { const int q = L - 32; u.z = 1; u.pm = q & 1; u.pn = q >> 1; }
        return true;
    }
    __device__ __forceinline__ unsigned A(const Unit& u) const { return u.z == 0 ? memb + (unsigned)u.pm * (256u * 2048u * 2u) : wkv + (unsigned)(2 + u.pm) * (256u * 2048u * 2u); }
    __device__ __forceinline__ unsigned B(const Unit& u) const { return u.z == 0 ? wkv + (unsigned)u.pn * (256u * 2048u * 2u) : memb + (unsigned)u.pn * (256u * 2048u * 2u); }
};
struct SchedMoE : Order {
    static constexpr bool GATHER = false; __device__ __forceinline__ unsigned arow(const Unit&, int) const { return 0u; }
    unsigned A0, B0, at, bt, be; const int* texp;
    __device__ __forceinline__ bool next(int i, Unit& u) const { if (!next_mn(i, u)) return false; u.z = __builtin_amdgcn_readfirstlane(texp[u.pm]); return true; }
    __device__ __forceinline__ unsigned A(const Unit& u) const { return A0 + (unsigned)u.pm * at; }
    __device__ __forceinline__ unsigned B(const Unit& u) const { return B0 + (unsigned)u.z * be + (unsigned)u.pn * bt; }
};

struct SchedMoEg : Order {
    static constexpr bool GATHER = true;
    unsigned B0, bt, be, xoff, zoff; const int* texp; const int* slot_tok;
    __device__ __forceinline__ bool next(int i, Unit& u) const { if (!next_mn(i, u)) return false; u.z = __builtin_amdgcn_readfirstlane(texp[u.pm]); return true; }
    __device__ __forceinline__ unsigned A(const Unit&) const { return 0u; }
    __device__ __forceinline__ unsigned B(const Unit& u) const { return B0 + (unsigned)u.z * be + (unsigned)u.pn * bt; }
    __device__ __forceinline__ unsigned arow(const Unit& u, int r) const { const int tok = slot_tok[u.pm * 256 + r]; return tok < 0 ? zoff : xoff + (unsigned)tok * 2048u; }
};

struct EpiBf16 {
    static constexpr bool PERM = true;
    bf16* O; int ldc;
    __device__ __forceinline__ void operator()(const f32x4 (&acc)[2][2][4][2], const Unit& u, int wr, int wc, int fr, int fq) const {
        const int row0 = u.pm * BM + wr * 64 + fr, col0 = u.pn * BM + wc * 32 + 8 * fq;
#pragma unroll
        for (int ai = 0; ai < 2; ++ai)
#pragma unroll
            for (int m = 0; m < 4; ++m) { bf16* rowp = O + (size_t)(row0 + ai * HALF + m * 16) * ldc + col0;
#pragma unroll
                for (int bj = 0; bj < 2; ++bj) { const f32x4 v0 = acc[ai][bj][m][0], v1 = acc[ai][bj][m][1];
                    u32x4 w; w.x = cvt_pk_bf16(v0[0], v0[1]); w.y = cvt_pk_bf16(v0[2], v0[3]); w.z = cvt_pk_bf16(v1[0], v1[1]); w.w = cvt_pk_bf16(v1[2], v1[3]);
                    *(u32x4*)(rowp + bj * HALF) = w; } }
    }
};
struct EpiMem {
    static constexpr bool PERM = true;
    bf16* O0; bf16* O1;
    __device__ __forceinline__ void operator()(const f32x4 (&acc)[2][2][4][2], const Unit& u, int wr, int wc, int fr, int fq) const {
        EpiBf16 e; e.O = u.z == 0 ? O0 : O1; e.ldc = u.z == 0 ? 512 : 4096; e(acc, u, wr, wc, fr, fq);
    }
};
struct EpiLora {
    static constexpr bool PERM = true;
    bf16* O; const float* vecs;
    __device__ __forceinline__ void operator()(const f32x4 (&acc)[2][2][4][2], const Unit& u, int wr, int wc, int fr, int fq) const {
        const int type = u.pn / 6;
        const int row0 = u.pm * BM + wr * 64 + fr, col0 = u.pn * BM + wc * 32 + 8 * fq, cb0 = (u.pn % 6) * BM + wc * 32 + 8 * fq;
        const float* bp = vecs + (type < 3 ? type : 0) * SW;
        const float sc = type == 0 ? 0.6065306597126334f : 1.0f;
#pragma unroll
        for (int bj = 0; bj < 2; ++bj) {
            f32x4 bv0 = (f32x4){0.f, 0.f, 0.f, 0.f}, bv1 = bv0;
            if (type < 3) { bv0 = *(const f32x4*)(bp + cb0 + bj * HALF); bv1 = *(const f32x4*)(bp + cb0 + bj * HALF + 4); }
#pragma unroll
            for (int ai = 0; ai < 2; ++ai)
#pragma unroll
                for (int m = 0; m < 4; ++m) { bf16* rowp = O + (size_t)(row0 + ai * HALF + m * 16) * 6144 + col0 + bj * HALF;
                    f32x4 v0_ = acc[ai][bj][m][0] + bv0, v1_ = acc[ai][bj][m][1] + bv1;
                    if (type < 3) {
#pragma unroll
                        for (int j = 0; j < 4; ++j) { v0_[j] = sc * sigmoidf_(v0_[j]); v1_[j] = sc * sigmoidf_(v1_[j]); } }
                    u32x4 w; w.x = cvt_pk_bf16(v0_[0], v0_[1]); w.y = cvt_pk_bf16(v0_[2], v0_[3]); w.z = cvt_pk_bf16(v1_[0], v1_[1]); w.w = cvt_pk_bf16(v1_[2], v1_[3]);
                    *(u32x4*)rowp = w; asm volatile("" ::: "memory"); }
        }
    }
};
struct EpiSwiglu {
    static constexpr bool PERM = true;
    bf16* O; int ldc;
    __device__ __forceinline__ void operator()(const f32x4 (&acc)[2][2][4][2], const Unit& u, int wr, int wc, int fr, int fq) const {
        const int row0 = u.pm * BM + wr * 64 + fr, col0 = u.pn * HALF + wc * 32 + 8 * fq;
#pragma unroll
        for (int ai = 0; ai < 2; ++ai)
#pragma unroll
            for (int m = 0; m < 4; ++m) { bf16* rowp = O + (size_t)(row0 + ai * HALF + m * 16) * ldc + col0;
                float h[8];
#pragma unroll
                for (int n = 0; n < 2; ++n)
#pragma unroll
                    for (int j = 0; j < 4; ++j) { const float g = acc[ai][0][m][n][j], up = acc[ai][1][m][n][j]; h[n * 4 + j] = g * sigmoidf_(g) * up; }
                u32x4 w; w.x = cvt_pk_bf16(h[0], h[1]); w.y = cvt_pk_bf16(h[2], h[3]); w.z = cvt_pk_bf16(h[4], h[5]); w.w = cvt_pk_bf16(h[6], h[7]);
                *(u32x4*)rowp = w; asm volatile("" ::: "memory"); }
    }
};
struct EpiSwiglu8 {
    static constexpr bool PERM = true;
    unsigned char* O; int ldc; float inv, so;
    __device__ __forceinline__ void operator()(const f32x4 (&acc)[2][2][4][2], const Unit& u, int wr, int wc, int fr, int fq) const {
        const int row0 = u.pm * BM + wr * 64 + fr, col0 = u.pn * HALF + wc * 32 + 8 * fq;
        const float c1 = -inv * 1.4426950408889634f, c2 = inv * inv * so;
#pragma unroll
        for (int ai = 0; ai < 2; ++ai)
#pragma unroll
            for (int m = 0; m < 4; ++m) { unsigned char* rowp = O + (size_t)(row0 + ai * HALF + m * 16) * ldc + col0;
                float h[8];
#pragma unroll
                for (int n = 0; n < 2; ++n)
#pragma unroll
                    for (int j = 0; j < 4; ++j) { const float ag = acc[ai][0][m][n][j], au = acc[ai][1][m][n][j];
                        h[n * 4 + j] = (ag * au) * __builtin_amdgcn_rcpf(1.0f + __builtin_amdgcn_exp2f(ag * c1)) * c2; }
                u32x2 w; w.x = pk4_fp8(h[0], h[1], h[2], h[3]); w.y = pk4_fp8(h[4], h[5], h[6], h[7]);
                *(u32x2*)rowp = w; asm volatile("" ::: "memory"); }
    }
};
struct EpiBf16S {
    static constexpr bool PERM = true;
    bf16* O; int ldc; float sc;
    __device__ __forceinline__ void operator()(const f32x4 (&acc)[2][2][4][2], const Unit& u, int wr, int wc, int fr, int fq) const {
        const int row0 = u.pm * BM + wr * 64 + fr, col0 = u.pn * BM + wc * 32 + 8 * fq;
#pragma unroll
        for (int ai = 0; ai < 2; ++ai)
#pragma unroll
            for (int m = 0; m < 4; ++m) { bf16* rowp = O + (size_t)(row0 + ai * HALF + m * 16) * ldc + col0;
#pragma unroll
                for (int bj = 0; bj < 2; ++bj) { const f32x4 v0 = acc[ai][bj][m][0] * sc, v1 = acc[ai][bj][m][1] * sc;
                    u32x4 w; w.x = cvt_pk_bf16(v0[0], v0[1]); w.y = cvt_pk_bf16(v0[2], v0[3]); w.z = cvt_pk_bf16(v1[0], v1[1]); w.w = cvt_pk_bf16(v1[2], v1[3]);
                    *(u32x4*)(rowp + bj * HALF) = w; } }
    }
};
struct EpiFp8S {
    static constexpr bool PERM = true;
    unsigned char* O; int ldc; float sc;
    __device__ __forceinline__ void operator()(const f32x4 (&acc)[2][2][4][2], const Unit& u, int wr, int wc, int fr, int fq) const {
        const int row0 = u.pm * BM + wr * 64 + fr, col0 = u.pn * BM + wc * 32 + 8 * fq;
#pragma unroll
        for (int ai = 0; ai < 2; ++ai)
#pragma unroll
            for (int m = 0; m < 4; ++m) { unsigned char* rowp = O + (size_t)(row0 + ai * HALF + m * 16) * ldc + col0;
#pragma unroll
                for (int bj = 0; bj < 2; ++bj) { const f32x4 v0 = acc[ai][bj][m][0] * sc, v1 = acc[ai][bj][m][1] * sc;
                    u32x2 w; w.x = pk4_fp8(v0[0], v0[1], v0[2], v0[3]); w.y = pk4_fp8(v1[0], v1[1], v1[2], v1[3]);
                    *(u32x2*)(rowp + bj * HALF) = w; } }
    }
};
struct EpiRes {
    static constexpr bool PERM = false;
    const float* X; float* T;
    __device__ __forceinline__ void operator()(const f32x4 (&acc)[2][2][4][2], const Unit& u, int wr, int wc, int fr, int fq) const {
        const int row0 = u.pm * BM + wr * 64 + fr, col0 = u.pn * BM + wc * 32 + 4 * fq;
#pragma unroll
        for (int ai = 0; ai < 2; ++ai)
#pragma unroll
            for (int m = 0; m < 4; ++m) { const size_t off = (size_t)(row0 + ai * HALF + m * 16) * D + col0;
#pragma unroll
                for (int bj = 0; bj < 2; ++bj)
#pragma unroll
                    for (int n = 0; n < 2; ++n) { const f32x4 xv = *(const f32x4*)(X + off + bj * HALF + n * 16);
                        *(f32x4*)(T + off + bj * HALF + n * 16) = xv * ALPHA + acc[ai][bj][m][n]; } }
    }
};
}

struct Args {
    const float* in[43];
    float* out; unsigned char* ws;
    int ph_lo, ph_hi;
};
struct Ctx { LAS unsigned char* lds; int tid, lane, wave, bid, G, gw, NGW; unsigned char* ws; };

enum { I_X = 0, I_MEM = 1, I_POS = 2, I_WKV = 3,
       L0_WIN = 4, L0_MU, L0_LW, L0_LA, L0_LG, L0_VECS, L0_WOUT, L0_NORMS, L0_FG, L0_FU, L0_FD,
       L1_WIN = 15, L1_GN, L1_WOUT, L1_NORMS, L1_ROUTER, L1_MG, L1_MU_, L1_MD,
       L2_WIN = 23, L2_MU, L2_LW, L2_LA, L2_LV, L2_LG, L2_VECS, L2_WOUT, L2_NORMS, L2_FG, L2_FU, L2_FD,
       L3_WIN = 35, L3_GN, L3_WOUT, L3_NORMS, L3_ROUTER, L3_MG, L3_MU_, L3_MD };

__device__ __forceinline__ void tr_load(f32x4 (&v)[8], const float* W, int ldw, int k0, int n0, int lane) {
#pragma unroll
    for (int i = 0; i < 8; ++i) v[i] = *(const f32x4*)(W + (size_t)(k0 + 8 * i + (lane >> 3)) * ldw + n0 + 4 * (lane & 7));
}
__device__ __forceinline__ void tr_store(const f32x4 (&v)[8], int k0, bf16* WT, int ldt, int drow0, LAS float* scr, int lane) {
#pragma unroll
    for (int i = 0; i < 8; ++i) { LAS float* d = scr + (8 * i + (lane >> 3)) * 33 + 4 * (lane & 7); d[0] = v[i][0]; d[1] = v[i][1]; d[2] = v[i][2]; d[3] = v[i][3]; }
    LDS_WAIT(); asm volatile("" ::: "memory");
    const int c = lane & 7;
#pragma unroll
    for (int j = 0; j < 4; ++j) { const int n = (lane >> 3) + 8 * j; const LAS float* s = scr + (8 * c) * 33 + n;
        u32x4 o; o.x = cvt_pk_bf16(s[0 * 33], s[1 * 33]); o.y = cvt_pk_bf16(s[2 * 33], s[3 * 33]); o.z = cvt_pk_bf16(s[4 * 33], s[5 * 33]); o.w = cvt_pk_bf16(s[6 * 33], s[7 * 33]);
        *(u32x4*)(WT + (size_t)(drow0 + n) * ldt + k0 + 8 * c) = o; }
    LDS_WAIT(); asm volatile("" ::: "memory");
}
__device__ __forceinline__ void conv_mat(const Ctx& C, const float* W, int K, int N, bf16* WT, int mode, int off, int gw0) {
    LAS float* scr = (LAS float*)(C.lds + C.wave * 16384);
    const int nblk = N / 32, items = (K / 64) * nblk;
    int start = C.gw - gw0; if (start < 0) start += C.NGW;
#define CONV_DROW(n0_) (mode == 0 ? off + (n0_) : ((n0_) / 128) * 256 + off + ((n0_) % 128))
    f32x4 va[8], vb[8];
    int it = start;
    if (it < items) tr_load(va, W, N, 64 * (it / nblk), 32 * (it % nblk), C.lane);
    while (it < items) {
        const int it1 = it + C.NGW;
        if (it1 < items) tr_load(vb, W, N, 64 * (it1 / nblk), 32 * (it1 % nblk), C.lane);
        tr_store(va, 64 * (it / nblk), WT, K, CONV_DROW(32 * (it % nblk)), scr, C.lane);
        if (it1 >= items) break;
        const int it2 = it1 + C.NGW;
        if (it2 < items) tr_load(va, W, N, 64 * (it2 / nblk), 32 * (it2 % nblk), C.lane);
        tr_store(vb, 64 * (it1 / nblk), WT, K, CONV_DROW(32 * (it1 % nblk)), scr, C.lane);
        it = it2;
    }
#undef CONV_DROW
}
__device__ __forceinline__ void conv_lora(const Ctx& C, const float* lw, const float* la, const float* lv, const float* lg, bf16* Bt) {
    for (int idx = C.bid * NTHR + C.tid; idx < 6144 * 256; idx += C.G * NTHR) {
        const int n_ = idx % 1536, rest = idx / 1536, k = rest % 256, blk = rest / 256;
        float v = 0.f;
        if (blk == 0) { if (k < 96) v = lw[k * 1536 + n_]; }
        else if (blk == 1) { if (k >= 96 && k < 192) v = la[(k - 96) * 1536 + n_]; }
        else if (blk == 2) { if (lv && k >= 192) v = lv[(k - 192) * 1536 + n_]; }
        else v = lg[k * 1536 + n_];
        Bt[(size_t)(blk * 1536 + n_) * 256 + k] = f2bf(v);
    }
}
__device__ __forceinline__ void conv_f32_bf16(const Ctx& C, const float* src, bf16* dst, size_t n8) {
    const size_t T = (size_t)C.G * NTHR;
    for (size_t i0 = (size_t)C.bid * NTHR + C.tid; i0 < n8; i0 += 4 * T) { f32x4 av[4], bv[4];
#pragma unroll
        for (int q = 0; q < 4; ++q) { av[q] = ((const f32x4*)src)[2 * (i0 + q * T)]; bv[q] = ((const f32x4*)src)[2 * (i0 + q * T) + 1]; }
#pragma unroll
        for (int q = 0; q < 4; ++q) { const f32x4 a = av[q], b = bv[q];
            u32x4 w; w.x = cvt_pk_bf16(a[0], a[1]); w.y = cvt_pk_bf16(a[2], a[3]); w.z = cvt_pk_bf16(b[0], b[1]); w.w = cvt_pk_bf16(b[2], b[3]);
            ((u32x4*)dst)[i0 + q * T] = w; } }
}

struct CvJob { const float* W; bf16* WT; int N, K, k0, n0, mode, off; float f8s; };
__device__ __forceinline__ void cv_load(f32x4 (&v)[8], const CvJob& J, int wave, int lane) {
    const int n = J.n0 + 4 * lane;
#pragma unroll
    for (int i = 0; i < 8; ++i) { v[i] = (f32x4){0.f, 0.f, 0.f, 0.f}; if (n < J.N) v[i] = *(const f32x4*)(J.W + (size_t)(J.k0 + 8 * wave + i) * J.N + n); }
}
__device__ __forceinline__ void cv_put(const f32x4 (&v)[8], LAS float* T, int wave, int lane) {
#pragma unroll
    for (int i = 0; i < 8; ++i) *(LAS f32x4*)(T + (8 * wave + i) * 256 + 4 * (lane ^ wave)) = v[i];
}
__device__ __forceinline__ void cv_out(const CvJob& J, const LAS float* T, int wave, int lane) {
    const int c = lane & 7;
#pragma unroll
    for (int j = 0; j < 4; ++j) { const int nl = 32 * wave + 8 * j + (lane >> 3), n = J.n0 + nl; const LAS float* s = T + (8 * c) * 256 + (nl ^ (c << 2));
        u32x4 o; o.x = cvt_pk_bf16(s[0 * 256], s[1 * 256]); o.y = cvt_pk_bf16(s[2 * 256], s[3 * 256]); o.z = cvt_pk_bf16(s[4 * 256], s[5 * 256]); o.w = cvt_pk_bf16(s[6 * 256], s[7 * 256]);
        if (n < J.N) { const int drow = J.mode == 0 ? J.off + n : (n / 128) * 256 + J.off + (n % 128);
            *(u32x4*)(J.WT + (size_t)drow * J.K + J.k0 + 8 * c) = o; } }
}
__device__ __forceinline__ void cv_out8(const CvJob& J, const LAS float* T, int wave, int lane) {
    const int c4 = lane & 3; unsigned char* W8 = (unsigned char*)J.WT;
#pragma unroll
    for (int j = 0; j < 2; ++j) { const int nl = 32 * wave + 16 * j + (lane >> 2), n = J.n0 + nl;
        float v[16];
#pragma unroll
        for (int q = 0; q < 16; ++q) { const int k = 16 * c4 + q; v[q] = T[k * 256 + (nl ^ (((k >> 3) & 7) << 2))] * J.f8s; }
        u32x4 o; o.x = pk4_fp8(v[0], v[1], v[2], v[3]); o.y = pk4_fp8(v[4], v[5], v[6], v[7]); o.z = pk4_fp8(v[8], v[9], v[10], v[11]); o.w = pk4_fp8(v[12], v[13], v[14], v[15]);
        if (n < J.N) { const int drow = J.mode == 0 ? J.off + n : (n / 128) * 256 + J.off + (n % 128);
            *(u32x4*)(W8 + (size_t)drow * J.K + J.k0 + 16 * c4) = o; } }
}
template <class Dec>
__device__ __forceinline__ void conv_run(const Ctx& C, int ntiles, const Dec& dec, const int t0 = -1, const int STR = GRID) {
    LAS float* T = (LAS float*)C.lds;
    f32x4 va[8], vb[8]; CvJob ja, jb, jc;
    int t = t0 < 0 ? C.bid : t0;
    if (t < ntiles) { dec(t, ja); cv_load(va, ja, C.wave, C.lane); }
    if (t + STR < ntiles) { dec(t + STR, jb); cv_load(vb, jb, C.wave, C.lane); }
    while (t < ntiles) {
        __syncthreads(); cv_put(va, T, C.wave, C.lane); jc = ja;
        if (t + 2 * STR < ntiles) { dec(t + 2 * STR, ja); cv_load(va, ja, C.wave, C.lane); }
        __syncthreads(); if (jc.f8s > 0.f) cv_out8(jc, T, C.wave, C.lane); else cv_out(jc, T, C.wave, C.lane);
        t += STR; if (t >= ntiles) break;
        __syncthreads(); cv_put(vb, T, C.wave, C.lane); jc = jb;
        if (t + 2 * STR < ntiles) { dec(t + 2 * STR, jb); cv_load(vb, jb, C.wave, C.lane); }
        __syncthreads(); if (jc.f8s > 0.f) cv_out8(jc, T, C.wave, C.lane); else cv_out(jc, T, C.wave, C.lane);
        t += STR;
    }
    __syncthreads();
}
struct MoeDec { const float* mg; const float* mu; const float* md; unsigned char* ws;
    __device__ __forceinline__ void operator()(int t, CvJob& J) const {
        const int j = t / 704, r = t % 704, e = j / 3, kind = j % 3;
        if (kind < 2) { J.W = (kind == 0 ? mg : mu) + (size_t)e * 2048 * 5632; J.WT = (bf16*)(ws + WS_MWGU + (size_t)e * 22 * MiB); J.N = 5632; J.K = 2048; J.mode = 1; J.off = kind * 128; J.f8s = 1024.f; J.k0 = 64 * (r / 22); J.n0 = 256 * (r % 22); }
        else { J.W = md + (size_t)e * 2048 * 5632; J.WT = (bf16*)(ws + WS_MWD + (size_t)e * 11 * MiB); J.N = 2048; J.K = 5632; J.mode = 0; J.off = 0; J.f8s = 2048.f; J.k0 = 64 * (r / 8); J.n0 = 256 * (r % 8); }
    } };
struct StaticDec { const float* const* in; unsigned char* ws;
    __device__ __forceinline__ void set(CvJob& J, const float* W, bf16* WT, int K, int N, int mode, int off, int r, float f8s = 0.f) const {
        const int nn = (N + 255) / 256; J.W = W; J.WT = WT; J.N = N; J.K = K; J.mode = mode; J.off = off; J.f8s = f8s; J.k0 = 64 * (r / nn); J.n0 = 256 * (r % nn); }
    __device__ __forceinline__ void operator()(int t, CvJob& J) const {
        int r = t;
        if (r < 128) { set(J, in[I_WKV], (bf16*)(ws + WS_WKV), 2048, 1024, 0, 0, r); return; } r -= 128;
        set(J, in[L0_WIN], (bf16*)(ws + WS_WIN), 2048, 5568, 0, 0, r);
    } };

struct SlotDec { const float* const* in; unsigned char* ws; int lq; MoeDec moe; StaticDec sd;
    __device__ __forceinline__ void operator()(int t, CvJob& J) const {
        if (t < 16896) { moe(t, J); return; }
        int r = t - 16896; const size_t l = (size_t)lq;
        if (r < 704) { sd.set(J, lq ? in[L2_FG] : in[L0_FG], (bf16*)(ws + WS_WFGU + l * 44 * MiB), 2048, 5632, 1, 0, r, 1024.f); return; } r -= 704;
        if (r < 704) { sd.set(J, lq ? in[L2_FU] : in[L0_FU], (bf16*)(ws + WS_WFGU + l * 44 * MiB), 2048, 5632, 1, 128, r, 1024.f); return; } r -= 704;
        if (r < 704) { sd.set(J, lq ? in[L2_FD] : in[L0_FD], (bf16*)(ws + WS_WFD + l * 22 * MiB), 5632, 2048, 0, 0, r, 2048.f); return; } r -= 704;
        if (r < 256) { sd.set(J, lq ? in[L2_WOUT] : in[L0_WOUT], (bf16*)(ws + WS_WOUT + l * 16 * MiB), 2048, 2048, 0, 0, r); return; } r -= 256;
        if (r < 256) { sd.set(J, lq ? in[L3_WOUT] : in[L1_WOUT], (bf16*)(ws + WS_WOUT + (l * 16 + 8) * MiB), 2048, 2048, 0, 0, r); return; } r -= 256;
        if (r < 640) { sd.set(J, lq ? in[L3_WIN] : in[L1_WIN], (bf16*)(ws + WS_WIN + (l * 44 + 22) * MiB), 2048, 5120, 0, 0, r); return; } r -= 640;
        sd.set(J, in[L2_WIN], (bf16*)(ws + WS_WIN + (size_t)44 * MiB), 2048, 5632, 0, 0, r);
    } };

__device__ __forceinline__ void ph_prologue(const Ctx& C, const Args& A) {
    unsigned char* ws = C.ws;
    { StaticDec dec; dec.in = A.in; dec.ws = ws; conv_run(C, 832, dec); }
    conv_lora(C, A.in[L0_LW], A.in[L0_LA], nullptr, A.in[L0_LG], (bf16*)(ws + WS_WLORA));
    conv_lora(C, A.in[L2_LW], A.in[L2_LA], A.in[L2_LV], A.in[L2_LG], (bf16*)(ws + WS_WLORA + 3 * MiB));
    { u32x4* z = (u32x4*)(ws + WS_WIN + (size_t)5568 * 2048 * 2);
      for (int i = C.bid * NTHR + C.tid; i < 64 * 2048 * 2 / 16; i += C.G * NTHR) z[i] = (u32x4){0u, 0u, 0u, 0u}; }
    { const f32x4* xs = (const f32x4*)A.in[I_X]; u32x2* hi = (u32x2*)(ws + WS_XB); unsigned* lo = (unsigned*)(ws + WS_XLO);
      const size_t T = (size_t)C.G * NTHR;
      for (size_t i0 = (size_t)C.bid * NTHR + C.tid; i0 < (size_t)M * D / 4; i0 += 8 * T) { f32x4 ov[8];
#pragma unroll
          for (int q = 0; q < 8; ++q) ov[q] = xs[i0 + q * T];
#pragma unroll
          for (int q = 0; q < 8; ++q) { const f32x4 o = ov[q]; const size_t i = i0 + q * T;
              u32x2 w; w.x = cvt_pk_bf16(o[0], o[1]); w.y = cvt_pk_bf16(o[2], o[3]); hi[i] = w;
              lo[i] = pk4_fp8((o[0] - bflo(w.x)) * 8192.f, (o[1] - bfhi(w.x)) * 8192.f, (o[2] - bflo(w.y)) * 8192.f, (o[3] - bfhi(w.y)) * 8192.f); } } }
    conv_f32_bf16(C, A.in[I_MEM], (bf16*)(ws + WS_MEMB), (size_t)4096 * 2048 / 8);
    { const int* pos = (const int*)A.in[I_POS]; f32x2* cs = (f32x2*)(ws + WS_CS);
      for (int idx = C.bid * NTHR + C.tid; idx < M * 64; idx += C.G * NTHR) {
          const int m = idx >> 6, i = idx & 63;
          const float pw = (float)exp2(13.287712379549449 * (double)i / 64.0);
          const float inv = 1.0f / pw;
          const float ang = (float)pos[m] * inv;
          const double x = (double)ang;
          const double n = rint(x * 0.15915494309189535);
          const double r = fma(-n, 6.283185307179586, x) - n * 2.4492935982947064e-16;
          const double r2 = r * r;
          double s = -1.0 / 121645100408832000.0;
          s = fma(s, r2, 1.0 / 355687428096000.0);
          s = fma(s, r2, -1.0 / 1307674368000.0);
          s = fma(s, r2, 1.0 / 6227020800.0);
          s = fma(s, r2, -1.0 / 39916800.0);
          s = fma(s, r2, 1.0 / 362880.0);
          s = fma(s, r2, -1.0 / 5040.0);
          s = fma(s, r2, 1.0 / 120.0);
          s = fma(s, r2, -1.0 / 6.0);
          s = fma(s * r2, r, r);
          double c = 1.0 / 2432902008176640000.0;
          c = fma(c, r2, -1.0 / 6402373705728000.0);
          c = fma(c, r2, 1.0 / 20922789888000.0);
          c = fma(c, r2, -1.0 / 87178291200.0);
          c = fma(c, r2, 1.0 / 479001600.0);
          c = fma(c, r2, -1.0 / 3628800.0);
          c = fma(c, r2, 1.0 / 40320.0);
          c = fma(c, r2, -1.0 / 720.0);
          c = fma(c, r2, 1.0 / 24.0);
          c = fma(c, r2, -0.5);
          c = fma(c, r2, 1.0);
          cs[idx] = (f32x2){(float)c, (float)s};
      } }
}

struct LnRow { u32x2 rh[8]; unsigned rl[8]; u32x2 a[8]; float w1, w2; };
__device__ __forceinline__ void ln_load(LnRow& R, const Ctx& C, int m, const void* Hp, int hmode, int s1, int s2, float w1, float w2) {
    const u32x2* hr = (const u32x2*)(C.ws + WS_XB + (size_t)m * D * 2) + C.lane;
    const unsigned* lr = (const unsigned*)(C.ws + (hmode == 0 ? WS_XLO : WS_X8) + (size_t)m * D) + C.lane;
#pragma unroll
    for (int j = 0; j < 8; ++j) { R.rh[j] = hr[64 * j]; R.rl[j] = lr[64 * j]; }
    if (hmode == 0) {
        const u32x2* ar = (const u32x2*)((const bf16*)Hp + (size_t)m * D) + C.lane;
#pragma unroll
        for (int j = 0; j < 8; ++j) R.a[j] = ar[64 * j];
        R.w1 = 1.f; R.w2 = 0.f;
    } else if (hmode == 1) {
        const unsigned* ar = (const unsigned*)((const unsigned char*)Hp + (size_t)m * D) + C.lane;
#pragma unroll
        for (int j = 0; j < 8; ++j) { R.a[j].x = ar[64 * j]; R.a[j].y = 0u; }
        R.w1 = 1.f / 256.f; R.w2 = 0.f;
    } else {
        R.w1 = w1; R.w2 = w2;
        const unsigned* y1 = (const unsigned*)((const unsigned char*)Hp + (size_t)s1 * D) + C.lane;
        const unsigned* y2 = (const unsigned*)((const unsigned char*)Hp + (size_t)s2 * D) + C.lane;
#pragma unroll
        for (int j = 0; j < 8; ++j) { R.a[j].x = y1[64 * j]; R.a[j].y = y2[64 * j]; }
    }
}
__device__ __forceinline__ void ln_row(const LnRow& R, const Ctx& C, int m, const LAS float* gb, int hmode, float* Xf32out, unsigned char* X8out,
                                       LAS float* rw, LAS int* hist, bool do_route) {
    const int l4 = 4 * C.lane;
    f32x4 v[8]; float s = 0.f;
#pragma unroll
    for (int j = 0; j < 8; ++j) { f32x4 f, x;
        const f32x2 l01 = __builtin_amdgcn_cvt_pk_f32_fp8(R.rl[j], false), l23 = __builtin_amdgcn_cvt_pk_f32_fp8(R.rl[j], true);
        const float ls = hmode == 0 ? (1.f / 8192.f) : (1.f / 16.f);
        x[0] = bflo(R.rh[j].x) + l01[0] * ls; x[1] = bfhi(R.rh[j].x) + l01[1] * ls; x[2] = bflo(R.rh[j].y) + l23[0] * ls; x[3] = bfhi(R.rh[j].y) + l23[1] * ls;
        if (hmode == 0) { f[0] = bflo(R.a[j].x); f[1] = bfhi(R.a[j].x); f[2] = bflo(R.a[j].y); f[3] = bfhi(R.a[j].y); }
        else { const f32x2 a01 = __builtin_amdgcn_cvt_pk_f32_fp8(R.a[j].x, false), a23 = __builtin_amdgcn_cvt_pk_f32_fp8(R.a[j].x, true);
            f[0] = R.w1 * a01[0]; f[1] = R.w1 * a01[1]; f[2] = R.w1 * a23[0]; f[3] = R.w1 * a23[1];
            if (hmode == 2) { const f32x2 b01 = __builtin_amdgcn_cvt_pk_f32_fp8(R.a[j].y, false), b23 = __builtin_amdgcn_cvt_pk_f32_fp8(R.a[j].y, true);
                f[0] += R.w2 * b01[0]; f[1] += R.w2 * b01[1]; f[2] += R.w2 * b23[0]; f[3] += R.w2 * b23[1]; } }
        v[j] = x * ALPHA + f; s += (v[j][0] + v[j][1]) + (v[j][2] + v[j][3]); }
    const float mean = wave_sum(s) * (1.f / D); float s2 = 0.f;
#pragma unroll
    for (int j = 0; j < 8; ++j) { v[j] = v[j] - mean; s2 += (v[j][0] * v[j][0] + v[j][1] * v[j][1]) + (v[j][2] * v[j][2] + v[j][3] * v[j][3]); }
    const float rstd = 1.0f / sqrtf(wave_sum(s2) * (1.f / D) + LN_EPS);
    float lg[8];
#pragma unroll
    for (int e = 0; e < 8; ++e) lg[e] = 0.f;
    u32x2* ho = (u32x2*)(C.ws + WS_XB + (size_t)m * D * 2) + C.lane;
    unsigned* lo = (unsigned*)(C.ws + WS_XLO + (size_t)m * D) + C.lane;
#pragma unroll
    for (int j = 0; j < 8; ++j) {
        const f32x4 gv = *((const LAS f32x4*)(gb + 256 * j + l4)), bv = *((const LAS f32x4*)(gb + 2048 + 256 * j + l4));
        const f32x4 o = v[j] * rstd * gv + bv;
        if (Xf32out) ((f32x4*)(Xf32out + (size_t)m * D))[64 * j + C.lane] = o;
        else if (X8out) {
            const unsigned p8 = pk4_fp8(o[0] * 16.f, o[1] * 16.f, o[2] * 16.f, o[3] * 16.f);
            ((unsigned*)(X8out + (size_t)m * D))[64 * j + C.lane] = p8;
            const f32x2 d01 = __builtin_amdgcn_cvt_pk_f32_fp8(p8, false), d23 = __builtin_amdgcn_cvt_pk_f32_fp8(p8, true);
            u32x2 w; w.x = cvt_pk_bf16(o[0] - d01[0] * (1.f / 16.f), o[1] - d01[1] * (1.f / 16.f)); w.y = cvt_pk_bf16(o[2] - d23[0] * (1.f / 16.f), o[3] - d23[1] * (1.f / 16.f)); ho[64 * j] = w; }
        else { u32x2 w; w.x = cvt_pk_bf16(o[0], o[1]); w.y = cvt_pk_bf16(o[2], o[3]); ho[64 * j] = w;
            lo[64 * j] = pk4_fp8((o[0] - bflo(w.x)) * 8192.f, (o[1] - bfhi(w.x)) * 8192.f, (o[2] - bflo(w.y)) * 8192.f, (o[3] - bfhi(w.y)) * 8192.f); }
        if (do_route) {
#pragma unroll
            for (int e = 0; e < 8; ++e) { const f32x4 we = *(const LAS f32x4*)(rw + e * 2048 + 256 * j + l4);
                lg[e] += (o[0] * we[0] + o[1] * we[1]) + (o[2] * we[2] + o[3] * we[3]); }
        }
    }
    if (do_route) {
#pragma unroll
        for (int e = 0; e < 8; ++e) lg[e] = wave_sum(lg[e]);
        int e1 = 0; float v1 = lg[0];
#pragma unroll
        for (int e = 1; e < 8; ++e) if (lg[e] > v1) { v1 = lg[e]; e1 = e; }
        int e2 = -1; float v2 = -3.0e38f;
#pragma unroll
        for (int e = 0; e < 8; ++e) if (e != e1 && lg[e] > v2) { v2 = lg[e]; e2 = e; }
        const float ex = __expf(v2 - v1); const float w1 = 1.0f / (1.0f + ex), w2 = ex / (1.0f + ex);
        if (C.lane == 0) { f32x4 rt; rt[0] = __int_as_float(e1 | (e2 << 8)); rt[1] = w1; rt[2] = w2; rt[3] = 0.f; ((f32x4*)(C.ws + WS_ROUTE))[m] = rt;
            atomicAdd((int*)&hist[e1], 1); atomicAdd((int*)&hist[e2], 1); }
    }
}
__device__ __forceinline__ void ph_ln(const Ctx& C, const void* Hp, int hmode, const float* gain, const float* bias, float* Xf32out, unsigned char* X8out,
                                      const float* router, bool do_route) {
    unsigned char* ws = C.ws;
    LAS float* rw = (LAS float*)C.lds;
    LAS int* hist = (LAS int*)(C.lds + LDS_MISC + 64);
    LAS float* gb = (LAS float*)(C.lds + 65536);
    ((LAS f32x4*)gb)[C.tid] = ((const f32x4*)gain)[C.tid]; ((LAS f32x4*)gb)[512 + C.tid] = ((const f32x4*)bias)[C.tid];
    if (!do_route) __syncthreads();
    if (do_route) {
        for (int col = C.tid; col < 2048; col += NTHR) { const f32x4 a = ((const f32x4*)router)[2 * col], b = ((const f32x4*)router)[2 * col + 1];
            rw[0 * 2048 + col] = a[0]; rw[1 * 2048 + col] = a[1]; rw[2 * 2048 + col] = a[2]; rw[3 * 2048 + col] = a[3]; rw[4 * 2048 + col] = b[0]; rw[5 * 2048 + col] = b[1]; rw[6 * 2048 + col] = b[2]; rw[7 * 2048 + col] = b[3]; }
        if (C.tid < 8) hist[C.tid] = 0;
        int* st = (int*)(ws + WS_SLOTTOK);
        for (int i = C.bid * NTHR + C.tid; i < NSLOT; i += C.G * NTHR) st[i] = -1;
        __syncthreads();
    }
    const int m0 = C.bid * 128 + C.wave * 16;
    LnRow Ra, Rb;
    int s1v = 0, s2v = 0, w1v = 0, w2v = 0;
    if (hmode == 2) { const int mr = m0 + (C.lane & 15); const f32x4 rt = ((const f32x4*)(ws + WS_ROUTE))[mr];
        s1v = ((const int*)(ws + WS_SLOT1))[mr]; s2v = ((const int*)(ws + WS_SLOT2))[mr]; w1v = __float_as_int(rt[1] * (1.f / 256.f)); w2v = __float_as_int(rt[2] * (1.f / 256.f)); }
#define LN_LOAD(R_, r_) ln_load(R_, C, m0 + (r_), Hp, hmode, __builtin_amdgcn_readlane(s1v, (r_)), __builtin_amdgcn_readlane(s2v, (r_)), __int_as_float(__builtin_amdgcn_readlane(w1v, (r_))), __int_as_float(__builtin_amdgcn_readlane(w2v, (r_))))
    LN_LOAD(Ra, 0);
#pragma unroll 1
    for (int r = 0; r < 16; r += 2) {
        LN_LOAD(Rb, r + 1);
        ln_row(Ra, C, m0 + r, gb, hmode, Xf32out, X8out, rw, hist, do_route);
        if (r + 2 < 16) LN_LOAD(Ra, r + 2);
        ln_row(Rb, C, m0 + r + 1, gb, hmode, Xf32out, X8out, rw, hist, do_route);
    }
#undef LN_LOAD
    if (do_route) { __syncthreads(); if (C.tid < 8) ((int*)(ws + WS_CTL))[CW_CNT + C.bid * 8 + C.tid] = hist[C.tid]; }
}

__device__ __forceinline__ void ph_slots(const Ctx& C) {
    unsigned char* ws = C.ws;
    LAS int* sm = (LAS int*)(C.lds + LDS_MISC + 128);
    const int* cnt = (const int*)(ws + WS_CTL) + CW_CNT;
    if (C.tid < 8) { int tot = 0, mine = 0; for (int b = 0; b < C.G; ++b) { const int c = cnt[b * 8 + C.tid]; if (b < C.bid) mine += c; tot += c; } sm[C.tid] = tot; sm[8 + C.tid] = mine; }
    __syncthreads();
    if (C.tid == 0) { int base = 0; for (int e = 0; e < 8; ++e) { sm[16 + e] = base; base += (sm[e] + 255) & ~255; } sm[24] = base >> 8; }
    __syncthreads();
    if (C.wave == 0) {
        int off[8];
#pragma unroll
        for (int e = 0; e < 8; ++e) off[e] = sm[16 + e] + sm[8 + e];
        const unsigned long long lt = (1ull << C.lane) - 1ull;
        for (int it = 0; it < 2; ++it) {
            const int m = C.bid * 128 + it * 64 + C.lane;
            const int ee = __float_as_int(((const f32x4*)(ws + WS_ROUTE))[m][0]); const int e1 = ee & 0xff, e2 = (ee >> 8) & 0xff;
            int s1 = 0, s2 = 0;
#pragma unroll
            for (int e = 0; e < 8; ++e) { const unsigned long long m1 = __ballot(e1 == e), m2 = __ballot(e2 == e);
                const int c1 = __popcll(m1), c2 = __popcll(m2);
                if (e1 == e) s1 = off[e] + __popcll(m1 & lt);
                if (e2 == e) s2 = off[e] + c1 + __popcll(m2 & lt);
                off[e] += c1 + c2; }
            ((int*)(ws + WS_SLOT1))[m] = s1; ((int*)(ws + WS_SLOT2))[m] = s2;
            int* st = (int*)(ws + WS_SLOTTOK); st[s1] = m; st[s2] = m;
        }
    }
    if (C.bid == 0) {
        int* ctl = (int*)(ws + WS_CTL);
        if (C.tid == 0) ctl[CW_NT] = sm[24];
        if (C.tid < 264) { int e = 0;
#pragma unroll
            for (int q = 1; q < 8; ++q) if (C.tid >= (sm[16 + q] >> 8)) e = q;
            ctl[CW_TEXP + C.tid] = e; }
    }
}
__device__ __forceinline__ void ph_gather(const Ctx& C) {
    unsigned char* ws = C.ws;
    const int* st = (const int*)(ws + WS_SLOTTOK); const u32x4* xb = (const u32x4*)(ws + WS_XB); u32x4* xp = (u32x4*)(ws + WS_XPERM);
    for (int s = C.gw; s < NSLOT; s += C.NGW) { const int tok = st[s];
#pragma unroll
        for (int j = 0; j < 2; ++j) { u32x4 v = xb[(size_t)(tok < 0 ? 0 : tok) * 128 + j * 64 + C.lane]; const unsigned k = tok < 0 ? 0u : 0xffffffffu; v.x &= k; v.y &= k; v.z &= k; v.w &= k; xp[(size_t)s * 128 + j * 64 + C.lane] = v; } }
}
__device__ __forceinline__ void ph_moe_wconv(const Ctx& C, const float* mg, const float* mu, const float* md, const float* const* in, int lq) {
    SlotDec dec; dec.in = in; dec.ws = C.ws; dec.lq = lq; dec.moe.mg = mg; dec.moe.mu = mu; dec.moe.md = md; dec.moe.ws = C.ws; dec.sd.in = in; dec.sd.ws = C.ws;
    conv_run(C, lq ? 20160 : 20864, dec, C.bid - 192, 64);
}

__device__ __forceinline__ void ph_memattn(const Ctx& C, const bf16* P, int ldp, int qm0) {
    unsigned char* ws = C.ws;
    const bf16* memK = (const bf16*)(ws + WS_MEMK); const bf16* memVT = (const bf16*)(ws + WS_MEMVT); bf16* mix = (bf16*)(ws + WS_MIX);
    const int g = C.lane >> 4, r16 = C.lane & 15;
    LAS unsigned char* LK = C.lds; LAS unsigned char* LV = C.lds + 65536;
    const int b = C.bid >> 4, hm = (C.bid >> 2) & 3, qb = C.bid & 3;
    __syncthreads();
    {   u32x4 st[16];
#pragma unroll
        for (int i = 0; i < 8; ++i) { const int q = C.tid + 512 * i, row = q >> 4, pc = q & 15;
            st[i] = *(const u32x4*)(memK + (size_t)(b * 256 + row) * 512 + hm * 128 + pc * 8); }
#pragma unroll
        for (int i = 0; i < 8; ++i) { const int q = C.tid + 512 * i, row = q >> 5, pc = q & 31;
            st[8 + i] = *(const u32x4*)(memVT + (size_t)(hm * 128 + row) * 4096 + b * 256 + pc * 8); }
#pragma unroll
        for (int i = 0; i < 8; ++i) { const int q = C.tid + 512 * i, row = q >> 4, pc = q & 15;
            *(LAS u32x4*)(LK + row * 256 + ((pc ^ (row & 15)) * 16)) = st[i]; }
#pragma unroll
        for (int i = 0; i < 8; ++i) { const int q = C.tid + 512 * i, row = q >> 5, pc = q & 31;
            *(LAS u32x4*)(LV + row * 512 + ((pc ^ (row & 15)) * 16)) = st[8 + i]; }
    }
    __syncthreads();
    for (int qt = 0; qt < 4; ++qt) {
        const int m0 = b * SEQ + qb * 512 + C.wave * 64 + qt * 16;
        bf16x8 qf[4];
#pragma unroll
        for (int s = 0; s < 4; ++s) qf[s] = *(const bf16x8*)(P + (size_t)(m0 + r16) * ldp + qm0 + hm * 128 + 32 * s + 8 * g);
        f32x4 sacc[16];
#pragma unroll
        for (int kt = 0; kt < 16; ++kt) { sacc[kt] = (f32x4){0.f, 0.f, 0.f, 0.f};
#pragma unroll
            for (int s = 0; s < 4; ++s) { const bf16x8 kf = *(const LAS bf16x8*)(LK + (16 * kt + r16) * 256 + (((4 * s + g) ^ r16) * 16));
                sacc[kt] = __builtin_amdgcn_mfma_f32_16x16x32_bf16(kf, qf[s], sacc[kt], 0, 0, 0); } }
        float mx = -3.0e38f;
#pragma unroll
        for (int kt = 0; kt < 16; ++kt)
#pragma unroll
            for (int j = 0; j < 4; ++j) mx = fmaxf(mx, sacc[kt][j]);
        mx = fmaxf(mx, shx(mx, C.lane, 16)); mx = fmaxf(mx, shx(mx, C.lane, 32));
        const float sc = 0.08838834764831845f * 1.4426950408889634f;
        float sum = 0.f;
#pragma unroll
        for (int kt = 0; kt < 16; ++kt)
#pragma unroll
            for (int j = 0; j < 4; ++j) { const float pv = exp2f((sacc[kt][j] - mx) * sc); sacc[kt][j] = pv; sum += pv; }
        sum += shx(sum, C.lane, 16); sum += shx(sum, C.lane, 32);
        f32x4 oacc[8];
#pragma unroll
        for (int dt = 0; dt < 8; ++dt) oacc[dt] = (f32x4){0.f, 0.f, 0.f, 0.f};
#pragma unroll
        for (int ks = 0; ks < 8; ++ks) {
            u32x4 pw; pw.x = cvt_pk_bf16(sacc[2 * ks][0], sacc[2 * ks][1]); pw.y = cvt_pk_bf16(sacc[2 * ks][2], sacc[2 * ks][3]);
            pw.z = cvt_pk_bf16(sacc[2 * ks + 1][0], sacc[2 * ks + 1][1]); pw.w = cvt_pk_bf16(sacc[2 * ks + 1][2], sacc[2 * ks + 1][3]);
            const bf16x8 pa = __builtin_bit_cast(bf16x8, pw);
#pragma unroll
            for (int dt = 0; dt < 8; ++dt) { const LAS unsigned char* vr = LV + (16 * dt + r16) * 512;
                const u32x2 lo = *(const LAS u32x2*)(vr + (((8 * ks + g) ^ (2 * r16)) * 8)), hi = *(const LAS u32x2*)(vr + (((8 * ks + 4 + g) ^ (2 * r16)) * 8));
                u32x4 vw; vw.x = lo.x; vw.y = lo.y; vw.z = hi.x; vw.w = hi.y;
                oacc[dt] = __builtin_amdgcn_mfma_f32_16x16x32_bf16(pa, __builtin_bit_cast(bf16x8, vw), oacc[dt], 0, 0, 0); } }
        float inv[4];
#pragma unroll
        for (int j = 0; j < 4; ++j) inv[j] = 1.0f / shl(sum, 4 * g + j);
#pragma unroll
        for (int dt = 0; dt < 8; ++dt)
#pragma unroll
            for (int j = 0; j < 4; ++j) mix[(size_t)(m0 + 4 * g + j) * D + SW + hm * 128 + 16 * dt + r16] = f2bf(oacc[dt][j] * inv[j]);
    }
    __syncthreads();
}

__device__ __forceinline__ void ph_rwkv_prep1(const Ctx& C, const float* mu, bool with_v) {
    unsigned char* ws = C.ws;
    const bf16* P = (const bf16*)(ws + WS_P); bf16* AL = (bf16*)(ws + WS_ALORA);
    const int oc0 = 8 * C.lane;
    const int XW0 = 4608, XA0 = 4704, XV0 = 4800, XG0 = with_v ? 4864 : 4800;
    int src, mode;
    if (oc0 < 96) { src = XW0 + oc0; mode = 0; } else if (oc0 < 192) { src = XA0 + oc0 - 96; mode = 1; }
    else if (oc0 < 256) { src = XV0 + oc0 - 192; mode = with_v ? 1 : 2; } else { src = XG0 + oc0 - 256; mode = 3; }
    f32x4 mu0 = (f32x4){0.f, 0.f, 0.f, 0.f}, mu1 = mu0;
    if (mode != 2) { mu0 = *(const f32x4*)(mu + src); mu1 = *(const f32x4*)(mu + src + 4); }
    for (int mb = C.gw; mb < M; mb += 4 * C.NGW) {
        u32x4 cu4[4], pr4[4];
#pragma unroll
        for (int i = 0; i < 4; ++i) { const int m = mb + i * C.NGW; cu4[i] = (u32x4){0u, 0u, 0u, 0u}; pr4[i] = cu4[i];
            if (mode != 2) { cu4[i] = *(const u32x4*)(P + (size_t)m * LDP_RW + src);
                if ((m & (SEQ - 1)) != 0) pr4[i] = *(const u32x4*)(P + (size_t)(m - 1) * LDP_RW + src); } }
#pragma unroll
        for (int i = 0; i < 4; ++i) { const int m = mb + i * C.NGW; const u32x4 cu = cu4[i], pr = pr4[i];
            u32x4 o = (u32x4){0u, 0u, 0u, 0u};
            if (mode != 2) {
                float v[8];
#pragma unroll
                for (int q = 0; q < 4; ++q) { const float c0 = bflo(cu[q]), c1 = bfhi(cu[q]), p0 = bflo(pr[q]), p1 = bfhi(pr[q]);
                    const float m0 = q < 2 ? mu0[2 * q] : mu1[2 * q - 4], m1 = q < 2 ? mu0[2 * q + 1] : mu1[2 * q - 3];
                    v[2 * q] = c0 + m0 * (p0 - c0); v[2 * q + 1] = c1 + m1 * (p1 - c1); }
#pragma unroll
                for (int q = 0; q < 8; ++q) { if (mode == 0) v[q] = 1.0f - 2.0f * __builtin_amdgcn_rcpf(1.0f + __expf(2.0f * v[q])); else if (mode == 3) v[q] = sigmoidf_(v[q]); }
                o.x = cvt_pk_bf16(v[0], v[1]); o.y = cvt_pk_bf16(v[2], v[3]); o.z = cvt_pk_bf16(v[4], v[5]); o.w = cvt_pk_bf16(v[6], v[7]);
            }
            *(u32x4*)(AL + (size_t)m * 512 + oc0) = o; }
    }
}
__device__ __forceinline__ void ph_rwkv_prep2(const Ctx& C, const float* mu, const float* vecs, bool with_v) {
    unsigned char* ws = C.ws;
    const bf16* P = (const bf16*)(ws + WS_P); const bf16* LO = (const bf16*)(ws + WS_LORAOUT); bf16* VF = (bf16*)(ws + WS_VFIRST);
    unsigned char* SI = ws + WS_SCANIN; float* BON = (float*)(ws + WS_BONUS);
    const float* k_k = vecs + (with_v ? 3 : 2) * SW; const float* k_a = k_k + SW; const float* r_k = k_a + SW;
    const int hq = C.lane >> 4, cl = (C.lane & 15) * 4;
    LAS float* LPAR = (LAS float*)C.lds;
    for (int i = C.tid; i < 3 * SW / 4; i += NTHR) { ((LAS f32x4*)LPAR)[i] = ((const f32x4*)mu)[i]; ((LAS f32x4*)LPAR)[3 * SW / 4 + i] = ((const f32x4*)k_k)[i]; }
    __syncthreads();
    for (int m = C.gw; m < M; m += C.NGW) {
        const int t = m & (SEQ - 1), b = m >> 11; const bool hp = t != 0;
        const bf16* pc = P + (size_t)m * LDP_RW; const bf16* pp = pc - LDP_RW;
#pragma unroll 2
        for (int it = 0; it < 6; ++it) {
            const int c = it * 256 + 4 * C.lane, head = 4 * it + hq;
            const u32x2 rc = *(const u32x2*)(pc + c), kc = *(const u32x2*)(pc + SW + c), vc = *(const u32x2*)(pc + 2 * SW + c);
            u32x2 rp = (u32x2){0u, 0u}, kp_ = rp, vp = rp;
            if (hp) { rp = *(const u32x2*)(pp + c); kp_ = *(const u32x2*)(pp + SW + c); vp = *(const u32x2*)(pp + 2 * SW + c); }
            const u32x2 Ew = *(const u32x2*)(LO + (size_t)m * 6144 + c), aw = *(const u32x2*)(LO + (size_t)m * 6144 + SW + c);
            u32x2 svw = (u32x2){0u, 0u}, vfw = svw;
            if (with_v) { svw = *(const u32x2*)(LO + (size_t)m * 6144 + 2 * SW + c); vfw = *(const u32x2*)(VF + (size_t)m * SW + c); }
            const f32x4 mr = *(const LAS f32x4*)(LPAR + c), mk = *(const LAS f32x4*)(LPAR + SW + c), mv = *(const LAS f32x4*)(LPAR + 2 * SW + c);
            const f32x4 kk4 = *(const LAS f32x4*)(LPAR + 3 * SW + c), ka4 = *(const LAS f32x4*)(LPAR + 4 * SW + c), rk4 = *(const LAS f32x4*)(LPAR + 5 * SW + c);
            float rm[4], km[4], vm[4], E[4], a[4], sv[4], vf[4];
#define UNPK(dst, w) dst[0] = bflo(w.x); dst[1] = bfhi(w.x); dst[2] = bflo(w.y); dst[3] = bfhi(w.y)
            float t0[4], t1[4];
            UNPK(t0, rc); UNPK(t1, rp);
#pragma unroll
            for (int j = 0; j < 4; ++j) rm[j] = t0[j] + mr[j] * (t1[j] - t0[j]);
            UNPK(t0, kc); UNPK(t1, kp_);
#pragma unroll
            for (int j = 0; j < 4; ++j) km[j] = t0[j] + mk[j] * (t1[j] - t0[j]);
            UNPK(t0, vc); UNPK(t1, vp);
#pragma unroll
            for (int j = 0; j < 4; ++j) vm[j] = t0[j] + mv[j] * (t1[j] - t0[j]);
            UNPK(E, Ew); UNPK(a, aw); UNPK(sv, svw); UNPK(vf, vfw);
#undef UNPK
            float vv[4], kkr[4], kp[4], ss = 0.f, bs = 0.f;
#pragma unroll
            for (int j = 0; j < 4; ++j) {
                vv[j] = with_v ? vm[j] + (vf[j] - vm[j]) * sv[j] : vm[j];
                kkr[j] = km[j] * kk4[j]; ss += kkr[j] * kkr[j];
                kp[j] = km[j] * (1.0f + (a[j] - 1.0f) * ka4[j]);
                bs += rm[j] * kp[j] * rk4[j]; }
            ss = row16_sum(ss); bs = row16_sum(bs);
            const float inv = 1.0f / fmaxf(sqrtf(ss), 1e-12f);
            if (!with_v) { u32x2 w; w.x = cvt_pk_bf16(vm[0], vm[1]); w.y = cvt_pk_bf16(vm[2], vm[3]); *(u32x2*)(VF + (size_t)m * SW + c) = w; }
            unsigned char* rec = SI + ((size_t)(b * 24 + head) * SEQ + t) * 768;
            float uw[4], kk[4];
#pragma unroll
            for (int j = 0; j < 4; ++j) { uw[j] = 1.0f - __expf(-E[j]); kk[j] = kkr[j] * inv; }
            u32x2 o;
            { const h16x2 u01 = __builtin_convertvector((f32x2){uw[0], uw[1]}, h16x2), u23 = __builtin_convertvector((f32x2){uw[2], uw[3]}, h16x2);
              o.x = __builtin_bit_cast(unsigned, u01); o.y = __builtin_bit_cast(unsigned, u23); *(u32x2*)(rec + cl * 2) = o; }
            o.x = cvt_pk_bf16(-kk[0], -kk[1]); o.y = cvt_pk_bf16(-kk[2], -kk[3]); *(u32x2*)(rec + 128 + cl * 2) = o;
            o.x = cvt_pk_bf16(kk[0] * a[0], kk[1] * a[1]); o.y = cvt_pk_bf16(kk[2] * a[2], kk[3] * a[3]); *(u32x2*)(rec + 256 + cl * 2) = o;
            o.x = cvt_pk_bf16(kp[0], kp[1]); o.y = cvt_pk_bf16(kp[2], kp[3]); *(u32x2*)(rec + 384 + cl * 2) = o;
            o.x = cvt_pk_bf16(rm[0], rm[1]); o.y = cvt_pk_bf16(rm[2], rm[3]); *(u32x2*)(rec + 512 + cl * 2) = o;
            o.x = cvt_pk_bf16(vv[0], vv[1]); o.y = cvt_pk_bf16(vv[2], vv[3]); *(u32x2*)(rec + 640 + cl * 2) = o;
            if ((C.lane & 15) == 0) BON[m * 24 + head] = bs;
        }
    }
}
__device__ __forceinline__ float fma_(float a, float b, float c) { float d; asm("v_fma_f32 %0, %1, %2, %3" : "=v"(d) : "v"(a), "v"(b), "v"(c)); return d; }
__device__ __forceinline__ float mul_(float a, float b) { float d; asm("v_mul_f32 %0, %1, %2" : "=v"(d) : "v"(a), "v"(b)); return d; }
__device__ __forceinline__ void ph_rwkv_scan(const Ctx& C, const float* mg, const float* mu, const float* md, const float* vecs, bool with_v, const float* const* in, int lq) {
    if (C.bid >= 192) { ph_moe_wconv(C, mg, mu, md, in, lq); return; }
    unsigned char* ws = C.ws;
    const unsigned char* SI = ws + WS_SCANIN;
    constexpr int TC = 16, NCH = SEQ / TC, REC = 7 * 64;
    LAS float* buf = (LAS float*)C.lds;
    LAS float* ybuf = (LAS float*)(C.lds + 114688);
    const bool scanner = C.wave < 4;
    const int slot = (C.wave >> 1) & 1;
    const int rg = C.lane >> 3, cg = C.lane & 7;
    const int rbase = 32 * (C.wave & 1) + 4 * rg;
    if (!scanner) {
        const int lw = C.wave - 4, qd = C.lane;
        const int q2 = qd - 8, lvec = 1 + (q2 >> 3), lpart = q2 & 7;
        const float* BON = (const float*)(ws + WS_BONUS); bf16* mix = (bf16*)(ws + WS_MIX); const bf16* LO = (const bf16*)(ws + WS_LORAOUT);
        const float* gn_g = vecs + (with_v ? 6 : 5) * SW; const float* gn_b = gn_g + SW;
        const int p0 = C.bid * 2, b0 = p0 / 24, h0 = p0 % 24, b1 = (p0 + 1) / 24, h1 = (p0 + 1) % 24;
        const int pr = C.lane >> 4, pc4 = 4 * (C.lane & 15);
        const f32x4 gg0 = *(const f32x4*)(gn_g + h0 * 64 + pc4), gb0 = *(const f32x4*)(gn_b + h0 * 64 + pc4), gg1 = *(const f32x4*)(gn_g + h1 * 64 + pc4), gb1 = *(const f32x4*)(gn_b + h1 * 64 + pc4);
        u32x4 st[8];
#define SCAN_ISSUE(ch_) do { _Pragma("unroll") for (int i_ = 0; i_ < 8; ++i_) { const int ps = lw + 4 * i_; \
        const int sl_ = ps >> 4, t_ = (ch_) * TC + (ps & 15); \
        st[i_] = qd < 48 ? *(const u32x4*)(SI + ((size_t)(p0 + sl_) * SEQ + t_) * 768 + qd * 16) \
                         : *(const u32x4*)(LO + (size_t)((sl_ ? b1 : b0) * SEQ + t_) * 6144 + 3 * SW + (sl_ ? h1 : h0) * 64 + ((qd - 48) & 7) * 8); } } while (0)
#define SCAN_COMMIT(bsel_) do { _Pragma("unroll") for (int i_ = 0; i_ < 8; ++i_) { const int ps = lw + 4 * i_; \
        LAS float* dst = buf + (((bsel_) * 2 * TC) + ps) * REC; \
        if (qd < 8) { f32x4 a_, b_; const unsigned sx_ = st[i_].x, sy_ = st[i_].y, sz_ = st[i_].z, sw_ = st[i_].w;     \
            { const f32x2 t0_ = __builtin_convertvector(__builtin_bit_cast(h16x2, sx_), f32x2), t1_ = __builtin_convertvector(__builtin_bit_cast(h16x2, sy_), f32x2); \
              a_[0] = 1.0f - t0_[0]; a_[1] = 1.0f - t0_[1]; a_[2] = 1.0f - t1_[0]; a_[3] = 1.0f - t1_[1]; } \
            { const f32x2 t0_ = __builtin_convertvector(__builtin_bit_cast(h16x2, sz_), f32x2), t1_ = __builtin_convertvector(__builtin_bit_cast(h16x2, sw_), f32x2); \
              b_[0] = 1.0f - t0_[0]; b_[1] = 1.0f - t0_[1]; b_[2] = 1.0f - t1_[0]; b_[3] = 1.0f - t1_[1]; } \
            *(LAS f32x4*)(dst + 8 * qd) = a_; *(LAS f32x4*)(dst + 8 * qd + 4) = b_; } \
        else if (qd < 56) { LAS float* d2 = dst + lvec * 64 + lpart * 8; \
            f32x4 a_, b_; a_[0] = bflo(st[i_].x); a_[1] = bfhi(st[i_].x); a_[2] = bflo(st[i_].y); a_[3] = bfhi(st[i_].y); \
            b_[0] = bflo(st[i_].z); b_[1] = bfhi(st[i_].z); b_[2] = bflo(st[i_].w); b_[3] = bfhi(st[i_].w); \
            *(LAS f32x4*)d2 = a_; *(LAS f32x4*)(d2 + 4) = b_; } } } while (0)
#define SCAN_POST(cp_) do { _Pragma("unroll") for (int g_ = 0; g_ < 2; ++g_) { const int ps = lw + 4 * (4 * g_ + pr), sl = ps >> 4, stp = ps & 15; \
        const LAS float* rec = buf + ((((cp_) & 1) * 2 * TC) + ps) * REC; \
        const f32x4 yv = *(const LAS f32x4*)(ybuf + ((((cp_) & 1) * 2 + sl) * TC + stp) * 64 + pc4), vv = *(const LAS f32x4*)(rec + 5 * 64 + pc4), gq = *(const LAS f32x4*)(rec + 6 * 64 + pc4); \
        const int m = (sl ? b1 : b0) * SEQ + (cp_) * TC + stp, hh = sl ? h1 : h0; \
        const float bon = BON[m * 24 + hh]; \
        const float mean = row16_sum((yv[0] + yv[1]) + (yv[2] + yv[3])) * (1.f / 64.f); const f32x4 d = yv - mean; \
        const float var = row16_sum((d[0] * d[0] + d[1] * d[1]) + (d[2] * d[2] + d[3] * d[3])) * (1.f / 64.f); \
        const float rstd = 1.0f / sqrtf(var + 64e-5f); const f32x4 gg = sl ? gg1 : gg0, gb = sl ? gb1 : gb0; \
        const f32x4 o_ = (d * rstd * gg + gb + vv * bon) * gq; \
        u32x2 w_; w_.x = cvt_pk_bf16(o_[0], o_[1]); w_.y = cvt_pk_bf16(o_[2], o_[3]); \
        *(u32x2*)(mix + (size_t)m * D + hh * 64 + pc4) = w_; } } while (0)
        SCAN_ISSUE(0); SCAN_COMMIT(0);
        __syncthreads();
        for (int ch = 0; ch < NCH; ++ch) {
            if (ch + 1 < NCH) SCAN_ISSUE(ch + 1);
            if (ch > 0) SCAN_POST(ch - 1);
            if (ch + 1 < NCH) SCAN_COMMIT((ch & 1) ^ 1);
            __syncthreads();
        }
        SCAN_POST(NCH - 1);
#undef SCAN_ISSUE
#undef SCAN_COMMIT
#undef SCAN_POST
    } else {
        f32x2 S[4][4];
#pragma unroll
        for (int i = 0; i < 4; ++i)
#pragma unroll
            for (int c = 0; c < 4; ++c) S[i][c] = (f32x2){0.f, 0.f};
        __syncthreads();
        for (int ch = 0; ch < NCH; ++ch) {
            const LAS float* base = buf + (((ch & 1) * 2 + slot) * TC) * REC;
            LAS float* yb = ybuf + (((ch & 1) * 2 + slot) * TC) * 64 + rbase;
#pragma unroll 2
            for (int s = 0; s < TC; ++s) {
                const LAS float* rp = base + s * REC + 8 * cg;
                f32x2 wv[4], nv[4], bv[4], kv[4], rv[4];
                { const f32x4 x0 = *(const LAS f32x4*)(rp), x1 = *(const LAS f32x4*)(rp + 4); wv[0] = (f32x2){x0[0], x0[1]}; wv[1] = (f32x2){x0[2], x0[3]}; wv[2] = (f32x2){x1[0], x1[1]}; wv[3] = (f32x2){x1[2], x1[3]}; }
                { const f32x4 x0 = *(const LAS f32x4*)(rp + 64), x1 = *(const LAS f32x4*)(rp + 68); nv[0] = (f32x2){x0[0], x0[1]}; nv[1] = (f32x2){x0[2], x0[3]}; nv[2] = (f32x2){x1[0], x1[1]}; nv[3] = (f32x2){x1[2], x1[3]}; }
                { const f32x4 x0 = *(const LAS f32x4*)(rp + 128), x1 = *(const LAS f32x4*)(rp + 132); bv[0] = (f32x2){x0[0], x0[1]}; bv[1] = (f32x2){x0[2], x0[3]}; bv[2] = (f32x2){x1[0], x1[1]}; bv[3] = (f32x2){x1[2], x1[3]}; }
                { const f32x4 x0 = *(const LAS f32x4*)(rp + 192), x1 = *(const LAS f32x4*)(rp + 196); kv[0] = (f32x2){x0[0], x0[1]}; kv[1] = (f32x2){x0[2], x0[3]}; kv[2] = (f32x2){x1[0], x1[1]}; kv[3] = (f32x2){x1[2], x1[3]}; }
                { const f32x4 x0 = *(const LAS f32x4*)(rp + 256), x1 = *(const LAS f32x4*)(rp + 260); rv[0] = (f32x2){x0[0], x0[1]}; rv[1] = (f32x2){x0[2], x0[3]}; rv[2] = (f32x2){x1[0], x1[1]}; rv[3] = (f32x2){x1[2], x1[3]}; }
                const f32x4 vv = *(const LAS f32x4*)(base + s * REC + 320 + rbase);
                f32x4 yo;
#pragma unroll
                for (int i = 0; i < 4; ++i) {
                    f32x2 a2 = S[i][0] * nv[0];
#pragma unroll
                    for (int c = 1; c < 4; ++c) a2 = S[i][c] * nv[c] + a2;
                    float sa = a2[0] + a2[1];
                    sa = dpp_add<0xB1>(sa); sa = dpp_add<0x4E>(sa); sa = dpp_add<0x141>(sa);
                    const f32x2 sa2 = (f32x2){sa, sa}, v2 = (f32x2){vv[i], vv[i]};
                    f32x2 y2 = (f32x2){0.f, 0.f};
#pragma unroll
                    for (int c = 0; c < 4; ++c) { S[i][c] = S[i][c] * wv[c] + (sa2 * bv[c] + v2 * kv[c]); y2 = S[i][c] * rv[c] + y2; }
                    float y = y2[0] + y2[1];
                    y = dpp_add<0xB1>(y); y = dpp_add<0x4E>(y); y = dpp_add<0x141>(y);
                    yo[i] = y;
                }
                if (cg == 0) *(LAS f32x4*)(yb + s * 64) = yo;
            }
            __syncthreads();
        }
    }
}

__device__ __constant__ float RET_LG2[6] = {-0.04580368961312479f, -0.02272007650008353f, -0.011315313227834146f, -0.005646563141142063f, -0.0028205190623786626f, -0.0014095702546713536f};
__device__ __forceinline__ void ph_ret_prep(const Ctx& C) {
    unsigned char* ws = C.ws;
    const bf16* P = (const bf16*)(ws + WS_P); const f32x2* CS = (const f32x2*)(ws + WS_CS);
    bf16* QR = (bf16*)(ws + WS_QR); bf16* KR = (bf16*)(ws + WS_KR); bf16* VT = (bf16*)(ws + WS_VT); bf16* KVT = (bf16*)(ws + WS_KVT);
    LAS unsigned char* LKt = C.lds; LAS unsigned char* LV = C.lds + 32768;
    const int g = C.lane >> 4, r16 = C.lane & 15, w = C.wave;
    __syncthreads();
    for (int u = C.bid; u < 1536; u += C.G) {
        const int c = u & 15, bh = u >> 4, h = bh % 6, b = bh / 6, m0 = b * SEQ + c * 128;
        const float lg2 = RET_LG2[h];
        __syncthreads();
        for (int task = C.tid; task < 1536; task += NTHR) {
            if (task < 512) {
                const bool isk = task >= 256; const int tk = task & 255, i0 = 4 * (tk & 15), tg = tk >> 4;
                const int colb = (isk ? 768 : 0) + h * 128 + i0; const float scl = isk ? 0.08838834764831845f : 1.0f;
                bf16* N = isk ? KR : QR;
                float o1[4][8], o2[4][8];
#pragma unroll
                for (int j = 0; j < 8; ++j) { const int m = m0 + tg * 8 + j;
                    const u32x2 a = *(const u32x2*)(P + (size_t)m * LDP_RET + colb), b2 = *(const u32x2*)(P + (size_t)m * LDP_RET + colb + 64);
                    const f32x4 cs01 = *(const f32x4*)(CS + (size_t)m * 64 + i0), cs23 = *(const f32x4*)(CS + (size_t)m * 64 + i0 + 2);
                    const float x1[4] = {bflo(a.x), bfhi(a.x), bflo(a.y), bfhi(a.y)}, x2[4] = {bflo(b2.x), bfhi(b2.x), bflo(b2.y), bfhi(b2.y)};
                    const float cc[4] = {cs01[0], cs01[2], cs23[0], cs23[2]}, sn[4] = {cs01[1], cs01[3], cs23[1], cs23[3]};
#pragma unroll
                    for (int q = 0; q < 4; ++q) { o1[q][j] = (x1[q] * cc[q] - x2[q] * sn[q]) * scl; o2[q][j] = (x1[q] * sn[q] + x2[q] * cc[q]) * scl; }
                    u32x2 w1, w2; w1.x = cvt_pk_bf16(o1[0][j], o1[1][j]); w1.y = cvt_pk_bf16(o1[2][j], o1[3][j]); w2.x = cvt_pk_bf16(o2[0][j], o2[1][j]); w2.y = cvt_pk_bf16(o2[2][j], o2[3][j]);
                    *(u32x2*)(N + (size_t)m * 768 + h * 128 + i0) = w1; *(u32x2*)(N + (size_t)m * 768 + h * 128 + i0 + 64) = w2; }
                if (isk) {
                    float kd[8];
#pragma unroll
                    for (int j = 0; j < 8; ++j) kd[j] = exp2f((float)(127 - (tg * 8 + j)) * lg2);
#pragma unroll
                    for (int q = 0; q < 4; ++q) {
                        u32x4 w1, w2;
                        w1.x = cvt_pk_bf16(o1[q][0] * kd[0], o1[q][1] * kd[1]); w1.y = cvt_pk_bf16(o1[q][2] * kd[2], o1[q][3] * kd[3]); w1.z = cvt_pk_bf16(o1[q][4] * kd[4], o1[q][5] * kd[5]); w1.w = cvt_pk_bf16(o1[q][6] * kd[6], o1[q][7] * kd[7]);
                        w2.x = cvt_pk_bf16(o2[q][0] * kd[0], o2[q][1] * kd[1]); w2.y = cvt_pk_bf16(o2[q][2] * kd[2], o2[q][3] * kd[3]); w2.z = cvt_pk_bf16(o2[q][4] * kd[4], o2[q][5] * kd[5]); w2.w = cvt_pk_bf16(o2[q][6] * kd[6], o2[q][7] * kd[7]);
                        *(LAS u32x4*)(LKt + (i0 + q) * 256 + ((tg ^ ((i0 + q) & 15)) * 16)) = w1;
                        *(LAS u32x4*)(LKt + (i0 + q + 64) * 256 + ((tg ^ ((i0 + q + 64) & 15)) * 16)) = w2; }
                }
            } else {
                const int tv = task - 512, e0 = 4 * (tv & 63), tg = tv >> 6;
                u32x2 vin[8];
#pragma unroll
                for (int j = 0; j < 8; ++j) vin[j] = *(const u32x2*)(P + (size_t)(m0 + tg * 8 + j) * LDP_RET + 1536 + h * 256 + e0);
                u32x4 w0, w1, w2, w3;
#define PKLO(a_, b_) (((a_) & 0xffffu) | ((b_) << 16))
#define PKHI(a_, b_) (((a_) >> 16) | ((b_) & 0xffff0000u))
                w0.x = PKLO(vin[0].x, vin[1].x); w0.y = PKLO(vin[2].x, vin[3].x); w0.z = PKLO(vin[4].x, vin[5].x); w0.w = PKLO(vin[6].x, vin[7].x);
                w1.x = PKHI(vin[0].x, vin[1].x); w1.y = PKHI(vin[2].x, vin[3].x); w1.z = PKHI(vin[4].x, vin[5].x); w1.w = PKHI(vin[6].x, vin[7].x);
                w2.x = PKLO(vin[0].y, vin[1].y); w2.y = PKLO(vin[2].y, vin[3].y); w2.z = PKLO(vin[4].y, vin[5].y); w2.w = PKLO(vin[6].y, vin[7].y);
                w3.x = PKHI(vin[0].y, vin[1].y); w3.y = PKHI(vin[2].y, vin[3].y); w3.z = PKHI(vin[4].y, vin[5].y); w3.w = PKHI(vin[6].y, vin[7].y);
#undef PKLO
#undef PKHI
                *(LAS u32x4*)(LV + (e0 + 0) * 256 + ((tg ^ ((e0 + 0) & 15)) * 16)) = w0; *(LAS u32x4*)(LV + (e0 + 1) * 256 + ((tg ^ ((e0 + 1) & 15)) * 16)) = w1;
                *(LAS u32x4*)(LV + (e0 + 2) * 256 + ((tg ^ ((e0 + 2) & 15)) * 16)) = w2; *(LAS u32x4*)(LV + (e0 + 3) * 256 + ((tg ^ ((e0 + 3) & 15)) * 16)) = w3;
            }
        }
        __syncthreads();
        {   f32x4 acc[16];
#pragma unroll
            for (int et = 0; et < 16; ++et) acc[et] = (f32x4){0.f, 0.f, 0.f, 0.f};
#pragma unroll
            for (int ks = 0; ks < 4; ++ks) {
                const bf16x8 af = *(const LAS bf16x8*)(LKt + (16 * w + r16) * 256 + (((4 * ks + g) ^ r16) * 16));
#pragma unroll
                for (int et = 0; et < 16; ++et) { const bf16x8 bf = *(const LAS bf16x8*)(LV + (16 * et + r16) * 256 + (((4 * ks + g) ^ r16) * 16));
                    acc[et] = __builtin_amdgcn_mfma_f32_16x16x32_bf16(af, bf, acc[et], 0, 0, 0); } }
#pragma unroll
            for (int et = 0; et < 16; ++et) { u32x2 wv; wv.x = cvt_pk_bf16(acc[et][0], acc[et][1]); wv.y = cvt_pk_bf16(acc[et][2], acc[et][3]); *(u32x2*)(KVT + ((size_t)u * 256 + 16 * et + r16) * 128 + 16 * w + 4 * g) = wv; }
        }
    }
    __syncthreads();
}
__device__ __forceinline__ void ph_ret_kv(const Ctx& C) {
    unsigned char* ws = C.ws;
    const bf16* KDT = (const bf16*)(ws + WS_KDT); const bf16* VT = (const bf16*)(ws + WS_VT); bf16* KVT = (bf16*)(ws + WS_KVT);
    const int g = C.lane >> 4, r16 = C.lane & 15, w = C.wave;
    LAS unsigned char* LKt = C.lds; LAS unsigned char* LV = C.lds + 32768;
    u32x4 st[12];
#define KV_ISSUE(u_) do { const int c_ = (u_) & 15, bh_ = (u_) >> 4; \
        _Pragma("unroll") for (int i = 0; i < 4; ++i) { const int q = C.tid + 512 * i, row = q >> 4, pc = q & 15; st[i] = *(const u32x4*)(KDT + (size_t)(bh_ * 128 + row) * SEQ + c_ * 128 + pc * 8); } \
        _Pragma("unroll") for (int i = 0; i < 8; ++i) { const int q = C.tid + 512 * i, row = q >> 4, pc = q & 15; st[4 + i] = *(const u32x4*)(VT + (size_t)(bh_ * 256 + row) * SEQ + c_ * 128 + pc * 8); } } while (0)
#define KV_COMMIT() do { \
        _Pragma("unroll") for (int i = 0; i < 4; ++i) { const int q = C.tid + 512 * i, row = q >> 4, pc = q & 15; *(LAS u32x4*)(LKt + row * 256 + ((pc ^ (row & 15)) * 16)) = st[i]; } \
        _Pragma("unroll") for (int i = 0; i < 8; ++i) { const int q = C.tid + 512 * i, row = q >> 4, pc = q & 15; *(LAS u32x4*)(LV + row * 256 + ((pc ^ (row & 15)) * 16)) = st[4 + i]; } } while (0)
    __syncthreads();
    if (C.bid < 1536) KV_ISSUE(C.bid);
    for (int u = C.bid; u < 1536; u += C.G) {
        __syncthreads();
        KV_COMMIT();
        if (u + C.G < 1536) KV_ISSUE(u + C.G);
        __syncthreads();
        f32x4 acc[16];
#pragma unroll
        for (int et = 0; et < 16; ++et) acc[et] = (f32x4){0.f, 0.f, 0.f, 0.f};
#pragma unroll
        for (int ks = 0; ks < 4; ++ks) {
            const bf16x8 af = *(const LAS bf16x8*)(LKt + (16 * w + r16) * 256 + (((4 * ks + g) ^ r16) * 16));
#pragma unroll
            for (int et = 0; et < 16; ++et) { const bf16x8 bf = *(const LAS bf16x8*)(LV + (16 * et + r16) * 256 + (((4 * ks + g) ^ r16) * 16));
                acc[et] = __builtin_amdgcn_mfma_f32_16x16x32_bf16(af, bf, acc[et], 0, 0, 0); } }
#pragma unroll
        for (int et = 0; et < 16; ++et) { u32x2 wv; wv.x = cvt_pk_bf16(acc[et][0], acc[et][1]); wv.y = cvt_pk_bf16(acc[et][2], acc[et][3]); *(u32x2*)(KVT + ((size_t)u * 256 + 16 * et + r16) * 128 + 16 * w + 4 * g) = wv; }
    }
    __syncthreads();
#undef KV_ISSUE
#undef KV_COMMIT
}
__device__ __forceinline__ void ph_ret_prefix(const Ctx& C) {
    unsigned char* ws = C.ws;
    const bf16* KVT = (const bf16*)(ws + WS_KVT); bf16* RTB = (bf16*)(ws + WS_RTB);
    for (int idx = C.bid * NTHR + C.tid; idx < 96 * 8192; idx += C.G * NTHR) {
        const int bh = idx >> 13, rem = idx & 8191; const int h = bh % 6;
        const float cd = exp2f(128.0f * RET_LG2[h]);
        f32x4 r = (f32x4){0.f, 0.f, 0.f, 0.f};
        u32x2 kwv[15];
#pragma unroll
        for (int c = 0; c < 15; ++c) kwv[c] = *(const u32x2*)(KVT + ((size_t)(bh * 16 + c) * 8192 + rem) * 4);
#pragma unroll
        for (int c = 0; c < 16; ++c) { const size_t off = ((size_t)(bh * 16 + c) * 8192 + rem) * 4;
            u32x2 w; w.x = cvt_pk_bf16(r[0], r[1]); w.y = cvt_pk_bf16(r[2], r[3]); *(u32x2*)(RTB + off) = w;
            if (c < 15) { const u32x2 kw = kwv[c]; const f32x4 kv = (f32x4){bflo(kw.x), bfhi(kw.x), bflo(kw.y), bfhi(kw.y)}; r = r * cd + kv; } }
    }
}
#define LDS_BAR() asm volatile("s_waitcnt lgkmcnt(0)\n\ts_barrier" ::: "memory")
__device__ __forceinline__ void ret_v_lds(const u32x2 (&vin)[8], LAS unsigned char* LV, int e0, int tg) {
    u32x4 w0, w1, w2, w3;
#define PKLO(a_, b_) (((a_) & 0xffffu) | ((b_) << 16))
#define PKHI(a_, b_) (((a_) >> 16) | ((b_) & 0xffff0000u))
    w0.x = PKLO(vin[0].x, vin[1].x); w0.y = PKLO(vin[2].x, vin[3].x); w0.z = PKLO(vin[4].x, vin[5].x); w0.w = PKLO(vin[6].x, vin[7].x);
    w1.x = PKHI(vin[0].x, vin[1].x); w1.y = PKHI(vin[2].x, vin[3].x); w1.z = PKHI(vin[4].x, vin[5].x); w1.w = PKHI(vin[6].x, vin[7].x);
    w2.x = PKLO(vin[0].y, vin[1].y); w2.y = PKLO(vin[2].y, vin[3].y); w2.z = PKLO(vin[4].y, vin[5].y); w2.w = PKLO(vin[6].y, vin[7].y);
    w3.x = PKHI(vin[0].y, vin[1].y); w3.y = PKHI(vin[2].y, vin[3].y); w3.z = PKHI(vin[4].y, vin[5].y); w3.w = PKHI(vin[6].y, vin[7].y);
#undef PKLO
#undef PKHI
    *(LAS u32x4*)(LV + (e0 + 0) * 256 + ((tg ^ ((e0 + 0) & 15)) * 16)) = w0; *(LAS u32x4*)(LV + (e0 + 1) * 256 + ((tg ^ ((e0 + 1) & 15)) * 16)) = w1;
    *(LAS u32x4*)(LV + (e0 + 2) * 256 + ((tg ^ ((e0 + 2) & 15)) * 16)) = w2; *(LAS u32x4*)(LV + (e0 + 3) * 256 + ((tg ^ ((e0 + 3) & 15)) * 16)) = w3;
}
__device__ __forceinline__ void ph_ret_out(const Ctx& C, const float* gn) {
    unsigned char* ws = C.ws;
    const bf16* P = (const bf16*)(ws + WS_P); const bf16* QR = (const bf16*)(ws + WS_QR); const bf16* KR = (const bf16*)(ws + WS_KR);
    const bf16* VT = (const bf16*)(ws + WS_VT); const bf16* RTB = (const bf16*)(ws + WS_RTB); bf16* mix = (bf16*)(ws + WS_MIX);
    const int g = C.lane >> 4, r16 = C.lane & 15, w = C.wave;
    LAS unsigned char* LR = C.lds; LAS unsigned char* LV = C.lds + 65536; LAS float* LG = (LAS float*)(C.lds + LDS_MISC + 2048);
    for (int u = C.bid; u < 1536; u += C.G) {
        const int c = u & 15, bh = u >> 4, h = bh % 6, b = bh / 6, m0 = b * SEQ + c * 128;
        const float lg2 = RET_LG2[h];
        LDS_BAR();
        f32x4 gnst = (f32x4){0.f, 0.f, 0.f, 0.f};
        if (C.tid < 128) gnst = *(const f32x4*)(gn + (C.tid >> 6) * SW + h * 256 + (C.tid & 63) * 4);
        const int nl = 16 * w + r16;
        u32x4 kst[4];
        bf16x8 qf[4];
        u32x2 gwv[16];
        {   u32x4 st[8]; u32x2 vinA[8], vinB[8];
            const int e0v = 4 * (C.tid & 63), tgv = C.tid >> 6;
#pragma unroll
            for (int i = 0; i < 8; ++i) { const int q = C.tid + 512 * i, row = q >> 4, pc = q & 15;
                st[i] = *(const u32x4*)(RTB + ((size_t)u * 256 + row) * 128 + pc * 8); }
#pragma unroll
            for (int j = 0; j < 8; ++j) { vinA[j] = *(const u32x2*)(P + (size_t)(m0 + tgv * 8 + j) * LDP_RET + 1536 + h * 256 + e0v);
                vinB[j] = *(const u32x2*)(P + (size_t)(m0 + tgv * 8 + 64 + j) * LDP_RET + 1536 + h * 256 + e0v); }
#pragma unroll
            for (int s = 0; s < 4; ++s) qf[s] = *(const bf16x8*)(QR + (size_t)(m0 + nl) * 768 + h * 128 + 32 * s + 8 * g);
#pragma unroll
            for (int i = 0; i < 8; ++i) { const int q = C.tid + 512 * i, row = q >> 4, pc = q & 15; const int off = row * 256 + ((pc ^ (row & 15)) * 16);
                *(LAS u32x4*)(LR + off) = st[i]; }
            ret_v_lds(vinA, LV, e0v, tgv); ret_v_lds(vinB, LV, e0v, tgv + 8);
        }
        if (C.tid < 128) *(LAS f32x4*)(LG + (C.tid >> 6) * 256 + (C.tid & 63) * 4) = gnst;
#pragma unroll
        for (int i = 0; i < 4; ++i) { const int q = C.tid + 512 * i, row = q >> 4, pc = q & 15;
            kst[i] = *(const u32x4*)(KR + (size_t)(m0 + row) * 768 + h * 128 + pc * 8); }
        LDS_BAR();
        f32x4 o[16];
        const float qdec = exp2f((float)(nl + 1) * lg2);
#pragma unroll
        for (int et = 0; et < 16; ++et) { f32x4 a = (f32x4){0.f, 0.f, 0.f, 0.f};
#pragma unroll
            for (int s = 0; s < 4; ++s) { const bf16x8 rf = *(const LAS bf16x8*)(LR + (16 * et + r16) * 256 + (((4 * s + g) ^ r16) * 16));
                a = __builtin_amdgcn_mfma_f32_16x16x32_bf16(rf, qf[s], a, 0, 0, 0); }
            o[et] = a * qdec;
            if ((et & 3) == 3) __builtin_amdgcn_sched_barrier(0); }
        LDS_BAR();
#pragma unroll
        for (int i = 0; i < 4; ++i) { const int q = C.tid + 512 * i, row = q >> 4, pc = q & 15; *(LAS u32x4*)(LR + row * 256 + ((pc ^ (row & 15)) * 16)) = kst[i]; }
#pragma unroll
        for (int et = 0; et < 16; ++et) gwv[et] = *(const u32x2*)(P + (size_t)(m0 + nl) * LDP_RET + 3072 + h * 256 + 16 * et + 4 * g);
        LDS_BAR();
        const float fd0 = (float)opq_v(nl - 4 * g);
        u32x2 pb[8];
#pragma unroll
        for (int mt = 0; mt < 8; ++mt) {
            pb[mt] = (u32x2){0u, 0u};
            if (mt <= w) { f32x4 a = (f32x4){0.f, 0.f, 0.f, 0.f};
#pragma unroll
                for (int s = 0; s < 4; ++s) { const bf16x8 kf = *(const LAS bf16x8*)(LR + (16 * mt + r16) * 256 + (((4 * s + g) ^ r16) * 16));
                    a = __builtin_amdgcn_mfma_f32_16x16x32_bf16(kf, qf[s], a, 0, 0, 0); }
#pragma unroll
                for (int j = 0; j < 4; ++j) { const float fd = fd0 - (float)(16 * mt + j); a[j] = fd >= 0.f ? a[j] * exp2f(fd * lg2) : 0.f; }
                pb[mt].x = cvt_pk_bf16(a[0], a[1]); pb[mt].y = cvt_pk_bf16(a[2], a[3]); }
        }
#pragma unroll
        for (int ks = 0; ks < 4; ++ks) {
            if (2 * ks <= w) {
                u32x4 pw; pw.x = pb[2 * ks].x; pw.y = pb[2 * ks].y; pw.z = pb[2 * ks + 1].x; pw.w = pb[2 * ks + 1].y;
                const bf16x8 pf = __builtin_bit_cast(bf16x8, pw);
#pragma unroll
                for (int et = 0; et < 16; ++et) { const LAS unsigned char* vr = LV + (16 * et + r16) * 256;
                    const u32x2 lo = *(const LAS u32x2*)(vr + (((8 * ks + g) ^ (2 * r16)) * 8)), hi = *(const LAS u32x2*)(vr + (((8 * ks + 4 + g) ^ (2 * r16)) * 8));
                    u32x4 vw; vw.x = lo.x; vw.y = lo.y; vw.z = hi.x; vw.w = hi.y;
                    o[et] = __builtin_amdgcn_mfma_f32_16x16x32_bf16(__builtin_bit_cast(bf16x8, vw), pf, o[et], 0, 0, 0); } }
        }
        float s1 = 0.f;
#pragma unroll
        for (int et = 0; et < 16; ++et) s1 += (o[et][0] + o[et][1]) + (o[et][2] + o[et][3]);
        s1 += shx(s1, C.lane, 16); s1 += shx(s1, C.lane, 32);
        const float mean = s1 * (1.f / 256.f); float s2 = 0.f;
#pragma unroll
        for (int et = 0; et < 16; ++et) { o[et] = o[et] - mean; s2 += (o[et][0] * o[et][0] + o[et][1] * o[et][1]) + (o[et][2] * o[et][2] + o[et][3] * o[et][3]); }
        s2 += shx(s2, C.lane, 16); s2 += shx(s2, C.lane, 32);
        const float rstd = 1.0f / sqrtf(s2 * (1.f / 256.f) + 1e-5f);
        const int m = m0 + nl;
#pragma unroll
        for (int et = 0; et < 16; ++et) { const int e = h * 256 + 16 * et + 4 * g;
            const f32x4 gg = *(const LAS f32x4*)(LG + 16 * et + 4 * g), gb = *(const LAS f32x4*)(LG + 256 + 16 * et + 4 * g);
            const u32x2 gw_ = gwv[et];
            float gt[4] = {bflo(gw_.x), bfhi(gw_.x), bflo(gw_.y), bfhi(gw_.y)}; float ov[4];
#pragma unroll
            for (int j = 0; j < 4; ++j) { const float yn = o[et][j] * rstd * gg[j] + gb[j]; ov[j] = yn * gt[j] * sigmoidf_(gt[j]); }
            u32x2 wv; wv.x = cvt_pk_bf16(ov[0], ov[1]); wv.y = cvt_pk_bf16(ov[2], ov[3]);
            *(u32x2*)(mix + (size_t)m * D + e) = wv; }
    }
    __syncthreads();
}

constexpr int PH_PER_PAIR = 23, NPH = 2 + 2 * PH_PER_PAIR;
__global__ void __launch_bounds__(NTHR, 2) fwd_kernel(Args args) {
    extern __shared__ __attribute__((aligned(16))) unsigned char lds_raw[];
    Ctx C;
    C.lds = (LAS unsigned char*)lds_raw;
    C.tid = threadIdx.x; C.lane = C.tid & 63; C.wave = __builtin_amdgcn_readfirstlane(C.tid >> 6);
    C.bid = blockIdx.x; C.G = GRID; C.gw = C.bid * NWAVES + C.wave; C.NGW = C.G * NWAVES; C.ws = args.ws;
    for (int u = C.tid; u < (LDS_BYTES - LDS_MISC) / 4; u += NTHR) ((LAS unsigned*)(C.lds + LDS_MISC))[u] = 0u;
    __syncthreads();
    const int lo = args.ph_lo, hi = args.ph_hi;
    XcdBarrier bar; bar.bar = (unsigned*)(args.ws + WS_CTL) + CW_BAR; bar.x = 0; bar.st = nullptr;
    if (hi - lo > 1) bar = xcd_barrier_post((unsigned*)(args.ws + WS_CTL) + CW_BAR, (volatile LAS unsigned*)(C.lds + LDS_MISC));
#ifndef ENMASK
#define ENMASK 0x1ffffffu
#endif
#define EN(j) ((((unsigned)(ENMASK)) >> (j)) & 1u)
#ifndef DBLMASK
#define DBLMASK 0u
#endif
#define REP(j) for (int rep_ = 0; rep_ < 1 + (int)((((unsigned)(DBLMASK)) >> (j)) & 1u); ++rep_)
#define IN(k) (lo <= (k) && (k) < hi)
#define SEAM(k) do { if (IN((k) + 1)) xcd_barrier(bar, (lane_id_asm() == 0) && (Cq.wave == 0)); } while (0)

#define PH_BEGIN Ctx Cq; Cq.lds = C.lds; Cq.lane = lane_id_asm(); Cq.wave = opq_i(C.wave); Cq.tid = Cq.wave * 64 + Cq.lane; Cq.bid = opq_i((int)blockIdx.x); Cq.G = GRID; \
        Cq.gw = Cq.bid * NWAVES + Cq.wave; Cq.NGW = Cq.G * NWAVES; Cq.ws = opq(args.ws); unsigned char* ws = Cq.ws; const int lq = opq_i(lp); (void)ws; (void)lq
    { const int lp = 0;
    REP(0) if (EN(0) && IN(0)) { PH_BEGIN; ph_prologue(Cq, args); SEAM(0); }
    REP(1) if (EN(1) && IN(1)) { PH_BEGIN;
        pg8::SchedMem S; S.G = Cq.G; S.c = Cq.bid; S.memb = (unsigned)WS_MEMB; S.wkv = (unsigned)WS_WKV;
        pg8::EpiMem E; E.O0 = (bf16*)(ws + WS_MEMK); E.O1 = (bf16*)(ws + WS_MEMVT);
        pg8::gemm_phase<pg8::EpiMem, pg8::SchedMem, true, true>(Cq.lds, Cq.tid, (const char*)ws, 2048, 2048, 2048, S, E);
        SEAM(1);
    } }
#pragma unroll 1
    for (int lp = 0; lp < 2; ++lp) {
        const int pb = 2 + lp * PH_PER_PAIR;
        REP(2) if (EN(2) && IN(pb + 0)) {
            PH_BEGIN;
            pg8::SchedPlain S; S.init(M / 256, 22, Cq.G, Cq.bid); S.A0 = (unsigned)(WS_XB); S.B0 = (unsigned)(WS_WIN + (size_t)(2 * lq) * 22 * MiB); S.at = (unsigned)(256 * 2048 * 2); S.bt = (unsigned)(256 * 2048 * 2);
            pg8::EpiBf16 E; E.O = (bf16*)(ws + WS_P); E.ldc = LDP_RW;
            pg8::gemm_phase<pg8::EpiBf16, pg8::SchedPlain, true, true>(Cq.lds, Cq.tid, (const char*)ws, 2048, 2048, 2048, S, E);
            SEAM(pb + 0);
        }
        REP(3) if (EN(3) && IN(pb + 1)) { PH_BEGIN; const bool with_v = lq == 1; ph_rwkv_prep1(Cq, args.in[lq ? L2_MU : L0_MU], with_v); ph_memattn(Cq, (const bf16*)(ws + WS_P), LDP_RW, with_v ? 5120 : 5056); SEAM(pb + 1); }
        REP(4) if (EN(4) && IN(pb + 2)) {
            PH_BEGIN; const float* vecs = args.in[lq ? L2_VECS : L0_VECS];
            pg8::SchedLora S; S.skipv = lq == 0; S.init(M / 256, lq == 0 ? 18 : 24, Cq.G, Cq.bid); S.A0 = (unsigned)(WS_ALORA); S.B0 = (unsigned)(WS_WLORA + (size_t)lq * 3 * MiB);
            pg8::EpiLora E; E.O = (bf16*)(ws + WS_LORAOUT); E.vecs = vecs;
            pg8::gemm_phase<pg8::EpiLora, pg8::SchedLora, true, true>(Cq.lds, Cq.tid, (const char*)ws, 512, 256, opq_i(256), S, E);
            SEAM(pb + 2);
        }
        REP(5) if (EN(5) && IN(pb + 3)) { PH_BEGIN; ph_rwkv_prep2(Cq, args.in[lq ? L2_MU : L0_MU], args.in[lq ? L2_VECS : L0_VECS], lq == 1); SEAM(pb + 3); }
        REP(6) if (EN(6) && IN(pb + 4)) { PH_BEGIN; ph_rwkv_scan(Cq, args.in[lq ? L3_MG : L1_MG], args.in[lq ? L3_MU_ : L1_MU_], args.in[lq ? L3_MD : L1_MD], args.in[lq ? L2_VECS : L0_VECS], lq == 1, args.in, lq); SEAM(pb + 4); }
        REP(8) if (EN(8) && IN(pb + 6)) {
            PH_BEGIN;
            pg8::SchedPlain S; S.init(M / 256, 8, Cq.G, Cq.bid); S.A0 = (unsigned)(WS_MIX); S.B0 = (unsigned)(WS_WOUT + (size_t)(2 * lq) * 8 * MiB); S.at = (unsigned)(256 * 2048 * 2); S.bt = (unsigned)(256 * 2048 * 2);
            pg8::EpiBf16 E; E.O = (bf16*)(ws + WS_P); E.ldc = D;
            pg8::gemm_phase<pg8::EpiBf16, pg8::SchedPlain, true, true>(Cq.lds, Cq.tid, (const char*)ws, 2048, 2048, 2048, S, E);
            SEAM(pb + 6);
        }
        REP(9) if (EN(9) && IN(pb + 7)) { PH_BEGIN; const float* nr = args.in[lq ? L2_NORMS : L0_NORMS];
            ph_ln(Cq, ws + WS_P, 0, nr, nr + D, nullptr, ws + WS_X8, nullptr, false); SEAM(pb + 7); }
        REP(10) if (EN(10) && IN(pb + 8)) {
            PH_BEGIN;
            pg8::SchedPlain S; S.init(M / 256, 44, Cq.G, Cq.bid); S.A0 = (unsigned)(WS_X8); S.B0 = (unsigned)(WS_WFGU + (size_t)lq * 44 * MiB); S.at = (unsigned)(256 * 2048); S.bt = (unsigned)(256 * 2048);
            pg8::EpiSwiglu8 E; E.O = ws + WS_HID; E.ldc = DFF; E.inv = 1.0f / 16384.0f; E.so = 32.0f;
            pg8::gemm_phase<pg8::EpiSwiglu8, pg8::SchedPlain, true, true, true>(Cq.lds, Cq.tid, (const char*)ws, 1024, 1024, 1024, S, E);
            SEAM(pb + 8);
        }
        REP(11) if (EN(11) && IN(pb + 9)) {
            PH_BEGIN;
            pg8::SchedPlain S; S.init(M / 256, 8, Cq.G, Cq.bid); S.A0 = (unsigned)(WS_HID); S.B0 = (unsigned)(WS_WFD + (size_t)lq * 22 * MiB); S.at = (unsigned)(256 * DFF); S.bt = (unsigned)(256 * DFF);
            pg8::EpiFp8S E; E.O = ws + WS_P; E.ldc = D; E.sc = 1.0f / 256.0f;
            pg8::gemm_phase<pg8::EpiFp8S, pg8::SchedPlain, true, true, true>(Cq.lds, Cq.tid, (const char*)ws, DFF / 2, DFF / 2, DFF / 2, S, E);
            SEAM(pb + 9);
        }
        REP(12) if (EN(12) && IN(pb + 10)) { PH_BEGIN; const float* nr = args.in[lq ? L2_NORMS : L0_NORMS];
            ph_ln(Cq, ws + WS_P, 1, nr + 2 * D, nr + 3 * D, nullptr, nullptr, nullptr, false); SEAM(pb + 10); }
        REP(13) if (EN(13) && IN(pb + 11)) {
            PH_BEGIN;
            pg8::SchedPlain S; S.init(M / 256, 20, Cq.G, Cq.bid); S.A0 = (unsigned)(WS_XB); S.B0 = (unsigned)(WS_WIN + (size_t)(2 * lq + 1) * 22 * MiB); S.at = (unsigned)(256 * 2048 * 2); S.bt = (unsigned)(256 * 2048 * 2);
            pg8::EpiBf16 E; E.O = (bf16*)(ws + WS_P); E.ldc = LDP_RET;
            pg8::gemm_phase<pg8::EpiBf16, pg8::SchedPlain, true, true>(Cq.lds, Cq.tid, (const char*)ws, 2048, 2048, 2048, S, E);
            SEAM(pb + 11);
        }
        REP(14) if (EN(14) && IN(pb + 12)) { PH_BEGIN; ph_ret_prep(Cq); ph_memattn(Cq, (const bf16*)(ws + WS_P), LDP_RET, 4608); SEAM(pb + 12); }
        REP(16) if (EN(16) && IN(pb + 14)) { PH_BEGIN; ph_ret_prefix(Cq); SEAM(pb + 14); }
        REP(17) if (EN(17) && IN(pb + 15)) { PH_BEGIN; ph_ret_out(Cq, args.in[lq ? L3_GN : L1_GN]); SEAM(pb + 15); }
        REP(18) if (EN(18) && IN(pb + 16)) {
            PH_BEGIN;
            pg8::SchedPlain S; S.init(M / 256, 8, Cq.G, Cq.bid); S.A0 = (unsigned)(WS_MIX); S.B0 = (unsigned)(WS_WOUT + (size_t)(2 * lq + 1) * 8 * MiB); S.at = (unsigned)(256 * 2048 * 2); S.bt = (unsigned)(256 * 2048 * 2);
            pg8::EpiBf16 E; E.O = (bf16*)(ws + WS_P); E.ldc = D;
            pg8::gemm_phase<pg8::EpiBf16, pg8::SchedPlain, true, true>(Cq.lds, Cq.tid, (const char*)ws, 2048, 2048, 2048, S, E);
            SEAM(pb + 16);
        }
        REP(19) if (EN(19) && IN(pb + 17)) {
            PH_BEGIN; const float* nr = args.in[lq ? L3_NORMS : L1_NORMS];
            REP(25) { ph_ln(Cq, ws + WS_P, 0, nr, nr + D, nullptr, ws + WS_X8, args.in[lq ? L3_ROUTER : L1_ROUTER], true);
            __syncthreads(); }
            SEAM(pb + 17);
        }
        REP(20) if (EN(20) && IN(pb + 18)) { PH_BEGIN; ph_slots(Cq); SEAM(pb + 18); }
        REP(22) if (EN(22) && IN(pb + 20)) {
            PH_BEGIN;
            const int nT = __builtin_amdgcn_readfirstlane(((const int*)(ws + WS_CTL))[CW_NT]);
            pg8::SchedMoEg S; S.init(nT, 44, Cq.G, Cq.bid); S.B0 = (unsigned)(WS_MWGU); S.bt = (unsigned)(256 * 2048); S.be = (unsigned)(22 * MiB);
            S.xoff = (unsigned)WS_X8; S.zoff = (unsigned)(WS_CTL + 512 * 1024); S.texp = (const int*)(ws + WS_CTL) + CW_TEXP; S.slot_tok = (const int*)(ws + WS_SLOTTOK);
            pg8::EpiSwiglu8 E; E.O = ws + WS_HIDM; E.ldc = DFF; E.inv = 1.0f / 16384.0f; E.so = 32.0f;
            pg8::gemm_phase<pg8::EpiSwiglu8, pg8::SchedMoEg, true, true, true>(Cq.lds, Cq.tid, (const char*)ws, 1024, 1024, 1024, S, E);
            SEAM(pb + 20);
        }
        REP(23) if (EN(23) && IN(pb + 21)) {
            PH_BEGIN;
            const int nT = __builtin_amdgcn_readfirstlane(((const int*)(ws + WS_CTL))[CW_NT]);
            pg8::SchedMoE S; S.init(nT, 8, Cq.G, Cq.bid); S.A0 = (unsigned)(WS_HIDM); S.B0 = (unsigned)(WS_MWD); S.at = (unsigned)(256 * DFF); S.bt = (unsigned)(256 * DFF); S.be = (unsigned)(11 * MiB);
            S.texp = (const int*)(ws + WS_CTL) + CW_TEXP;
            pg8::EpiFp8S E; E.O = ws + WS_XPERM; E.ldc = D; E.sc = 1.0f / 256.0f;
            pg8::gemm_phase<pg8::EpiFp8S, pg8::SchedMoE, true, true, true>(Cq.lds, Cq.tid, (const char*)ws, DFF / 2, DFF / 2, DFF / 2, S, E);
            SEAM(pb + 21);
        }
        REP(24) if (EN(24) && IN(pb + 22)) {
            PH_BEGIN; const float* nr = args.in[lq ? L3_NORMS : L1_NORMS];
            ph_ln(Cq, ws + WS_XPERM, 2, nr + 2 * D, nr + 3 * D, lq == 1 ? args.out : nullptr, nullptr, nullptr, false);
            SEAM(pb + 22);
        }
    }
#undef IN
#undef SEAM
}

#ifndef MK_PER_PHASE
#define MK_PER_PHASE 0
#endif
extern "C" void kernel_launch(void* const* d_in, const int* in_sizes, int n_in, void* d_out, int out_size, void* d_ws, size_t ws_size, hipStream_t stream) {
    static int ready = 0;
    if (ready == 0) {
        ready = 1;
        if (n_in != 43 || out_size != M * D || ws_size < WS_END) { fprintf(stderr, "kernel_launch: unexpected problem (n_in %d out %d ws %zu need %zu)\n", n_in, out_size, ws_size, (size_t)WS_END); ready = -1; }
        else if (hipFuncSetAttribute((const void*)fwd_kernel, hipFuncAttributeMaxDynamicSharedMemorySize, LDS_BYTES) != hipSuccess) { fprintf(stderr, "kernel_launch: hipFuncSetAttribute failed\n"); ready = -1; }
        (void)hipGetLastError();
    }
    if (ready < 0) return;
    (void)hipMemsetAsync((char*)d_ws + WS_CTL, 0, CTL_BYTES, stream);
    Args a{};
    for (int i = 0; i < 43; ++i) a.in[i] = (const float*)d_in[i];
    a.out = (float*)d_out; a.ws = (unsigned char*)d_ws;
#if MK_PER_PHASE
    for (int p = 0; p < NPH; ++p) { a.ph_lo = p; a.ph_hi = p + 1; hipLaunchKernelGGL(fwd_kernel, dim3(GRID), dim3(NTHR), LDS_BYTES, stream, a); }
#else
    a.ph_lo = 0; a.ph_hi = NPH;
    hipLaunchKernelGGL(fwd_kernel, dim3(GRID), dim3(NTHR), LDS_BYTES, stream, a);
#endif
}
```

```cpp
#include <hip/hip_runtime.h>
#include <cstdio>
#include <cstdint>

#define LAS __attribute__((address_space(3)))
#define GAS __attribute__((address_space(1)))
typedef unsigned short bf16;
typedef short bf16x8 __attribute__((ext_vector_type(8)));
typedef float f32x4 __attribute__((ext_vector_type(4)));
typedef float f32x2 __attribute__((ext_vector_type(2)));
typedef unsigned u32x4 __attribute__((ext_vector_type(4)));
typedef unsigned u32x2 __attribute__((ext_vector_type(2)));

constexpr int M = 32768, D = 2048, SEQ = 2048, NB = 16;
constexpr int SW = 1536;
constexpr int LDP_RW = 5632, LDP_RET = 5120;
constexpr int DFF = 5632;
constexpr int NSLOT = 67584;
constexpr float ALPHA = 1.6817928305074290f;
constexpr float LN_EPS = 1e-5f;
constexpr int NWAVES = 8, NTHR = 512, GRID = 256;

constexpr size_t MiB = 1u << 20;
constexpr size_t WS_CTL = 0, CTL_BYTES = 1 * MiB;
constexpr size_t WS_WKV = 1 * MiB;
constexpr size_t WS_WIN = WS_WKV + 4 * MiB;
constexpr size_t WS_WOUT = WS_WIN + 88 * MiB;
constexpr size_t WS_WLORA = WS_WOUT + 32 * MiB;
constexpr size_t WS_WFGU = WS_WLORA + 6 * MiB;
constexpr size_t WS_WFD = WS_WFGU + 88 * MiB;
constexpr size_t WS_MEMB = WS_WFD + 44 * MiB;
constexpr size_t WS_MEMK = WS_MEMB + 16 * MiB;
constexpr size_t WS_MEMVT = WS_MEMK + 4 * MiB;
constexpr size_t WS_CS = WS_MEMVT + 4 * MiB;
constexpr size_t WS_XB = WS_CS + 16 * MiB;
constexpr size_t WS_MIX = WS_XB + 128 * MiB;
constexpr size_t WS_VFIRST = WS_MIX + 128 * MiB;
constexpr size_t WS_P = WS_VFIRST + 96 * MiB;
constexpr size_t WS_MISC = WS_P + 352 * MiB;
constexpr size_t WS_ROUTE = WS_MISC, WS_SLOT1 = WS_MISC + 512 * 1024, WS_SLOT2 = WS_SLOT1 + 128 * 1024, WS_SLOTTOK = WS_SLOT2 + 128 * 1024;
constexpr size_t WS_BONUS = WS_MISC + 2 * MiB;
constexpr size_t WS_SB = WS_BONUS + 3 * MiB;
constexpr size_t WS_ALORA = WS_SB, WS_LORAOUT = WS_SB + 32 * MiB, WS_SCANIN = WS_SB + 416 * MiB;
constexpr size_t WS_QR = WS_SB, WS_KR = WS_SB + 48 * MiB, WS_KDT = WS_SB + 96 * MiB, WS_VT = WS_SB + 144 * MiB, WS_KVT = WS_SB + 240 * MiB, WS_RTB = WS_SB + 432 * MiB;
constexpr size_t WS_HID = WS_SB;
constexpr size_t WS_XPERM = WS_SB, WS_HIDM = WS_SB + 264 * MiB, WS_MWGU = WS_SB + 1184 * MiB, WS_MWD = WS_SB + 1360 * MiB;
constexpr size_t WS_XLO = WS_SB + 1518 * MiB;
constexpr size_t WS_X8 = WS_XLO + 64 * MiB;
constexpr size_t WS_END = WS_X8 + 64 * MiB;
constexpr int CW_BAR = 4096;
constexpr int CW_CNT = 16384;
constexpr int CW_NT = 20480;
constexpr int CW_TEXP = 20544;

constexpr int RING_BYTES = 131072;
constexpr int LDS_MISC = RING_BYTES;
constexpr int LDS_BYTES = RING_BYTES + 8192;

#define LDS_WAIT() asm volatile("s_waitcnt lgkmcnt(0)" ::: "memory")
#define VM_WAIT() asm volatile("s_waitcnt vmcnt(0)" ::: "memory")
__device__ __forceinline__ unsigned cvt_pk_bf16(float lo, float hi) { unsigned r; asm volatile("v_cvt_pk_bf16_f32 %0, %1, %2" : "=v"(r) : "v"(lo), "v"(hi)); return r; }
__device__ __forceinline__ bf16 f2bf(float f) { return (bf16)(cvt_pk_bf16(f, 0.f) & 0xffffu); }
__device__ __forceinline__ float bf2f(bf16 b) { return __uint_as_float(((unsigned)b) << 16); }
__device__ __forceinline__ float bflo(unsigned w) { return __uint_as_float(w << 16); }
__device__ __forceinline__ float bfhi(unsigned w) { return __uint_as_float(w & 0xffff0000u); }
template <int CTRL> __device__ __forceinline__ float dpp_add(float x) {
    int y = __builtin_amdgcn_update_dpp(0, __float_as_int(x), CTRL, 0xf, 0xf, true);
    return x + __int_as_float(y);
}
__device__ __forceinline__ float row16_sum(float x) { x = dpp_add<0xB1>(x); x = dpp_add<0x4E>(x); x = dpp_add<0x141>(x); x = dpp_add<0x140>(x); return x; }
__device__ __forceinline__ float wave_sum(float v) {
    v = row16_sum(v);
    const float a = __int_as_float(__builtin_amdgcn_readlane(__float_as_int(v), 0)), b = __int_as_float(__builtin_amdgcn_readlane(__float_as_int(v), 16));
    const float c = __int_as_float(__builtin_amdgcn_readlane(__float_as_int(v), 32)), d = __int_as_float(__builtin_amdgcn_readlane(__float_as_int(v), 48));
    return (a + b) + (c + d);
}
__device__ __forceinline__ unsigned pk4_fp8(float a, float b, float c, float d) {
    a = __builtin_amdgcn_fmed3f(a, -448.f, 448.f); b = __builtin_amdgcn_fmed3f(b, -448.f, 448.f); c = __builtin_amdgcn_fmed3f(c, -448.f, 448.f); d = __builtin_amdgcn_fmed3f(d, -448.f, 448.f);
    unsigned w = 0; w = __builtin_amdgcn_cvt_pk_fp8_f32(a, b, w, false); w = __builtin_amdgcn_cvt_pk_fp8_f32(c, d, w, true); return w; }
__device__ __forceinline__ float sigmoidf_(float z) { return __builtin_amdgcn_rcpf(1.0f + __expf(-z)); }

__device__ __forceinline__ unsigned char* opq(unsigned char* p) { asm volatile("" : "+s"(p)); return p; }
__device__ __forceinline__ int opq_i(int v) { asm volatile("" : "+s"(v)); return v; }
__device__ __forceinline__ int opq_v(int v) { asm volatile("" : "+v"(v)); return v; }
__device__ __forceinline__ int lane_id_asm() { int l; asm volatile("v_mbcnt_lo_u32_b32 %0, -1, 0\n\tv_mbcnt_hi_u32_b32 %0, -1, %0" : "=v"(l)); return l; }
typedef _Float16 h16x2 __attribute__((ext_vector_type(2)));
__device__ __forceinline__ float shx(float v, int lane, int m) { return __builtin_bit_cast(float, __builtin_amdgcn_ds_bpermute((lane ^ m) << 2, __builtin_bit_cast(int, v))); }
__device__ __forceinline__ float shl(float v, int src) { return __builtin_bit_cast(float, __builtin_amdgcn_ds_bpermute(src << 2, __builtin_bit_cast(int, v))); }
#define XB_TMO      128
#define XB_XCNT(j)  (256  + 64 * (j))
#define XB_XSUB(j)  (1280 + 64 * (j))
#define XB_XGEN(j)  (2304 + 64 * (j))
#define XB_TOP      3328
#define XB_TOPGEN   3392
#define XCD_BAR_WORDS 3456
#define XB_SPIN_CAP (1u << 18)
__device__ __forceinline__ unsigned xb_ld(unsigned* p)              { return __hip_atomic_load(p, __ATOMIC_RELAXED, __HIP_MEMORY_SCOPE_AGENT); }
__device__ __forceinline__ unsigned xb_add(unsigned* p, unsigned v) { return __hip_atomic_fetch_add(p, v, __ATOMIC_RELAXED, __HIP_MEMORY_SCOPE_AGENT); }
__device__ __forceinline__ unsigned xb_xcc_id() { return (unsigned)__builtin_amdgcn_s_getreg((3 << 11) | 20) & 0xFu; }
#define XB_SPIN(cond, bar) do { unsigned _sp = 0; while (cond) { __builtin_amdgcn_s_sleep(1); \
    if ((++_sp & 255u) == 0u) { if (xb_ld(&(bar)[XB_TMO])) break; if (_sp > XB_SPIN_CAP) { atomicAdd(&(bar)[XB_TMO], 1u); break; } } } } while (0)
struct XcdBarrier { unsigned* bar; unsigned x; volatile LAS unsigned* st; };
__device__ __forceinline__ XcdBarrier xcd_barrier_post(unsigned* bar, volatile LAS unsigned* st) {
    XcdBarrier b; b.bar = bar; b.x = xb_xcc_id(); b.st = st;
    if (threadIdx.x == 0) (void)xb_add(&bar[XB_XCNT(b.x)], 1u);
    return b;
}
__device__ __forceinline__ void xcd_barrier_complete(unsigned* bar, unsigned x, unsigned& nloc, unsigned& nx) {
    const unsigned G = gridDim.x * gridDim.y * gridDim.z;
    unsigned sum, cnt, mine, sp = 0u;
    for (;;) {
        sum = 0u; cnt = 0u; mine = 0u;
#pragma unroll
        for (unsigned j = 0; j < 16; ++j) { const unsigned c = xb_ld(&bar[XB_XCNT(j)]); sum += c; cnt += (c > 0u) ? 1u : 0u; mine = (j == x) ? c : mine; }
        if (sum == G) break;
        __builtin_amdgcn_s_sleep(1);
        if ((++sp & 255u) == 0u) { if (xb_ld(&bar[XB_TMO])) break; if (sp > XB_SPIN_CAP) { atomicAdd(&bar[XB_TMO], 1u); break; } }
    }
    nloc = mine > 0u ? mine : 1u; nx = cnt > 0u ? cnt : 1u;
}
__device__ __forceinline__ void xcd_barrier(const XcdBarrier& b, const bool leader  ) {
    asm volatile("s_waitcnt vmcnt(0)" ::: "memory");
    __syncthreads();
    if (leader) {
        unsigned* bar = b.bar;
        __builtin_amdgcn_s_waitcnt(0);
        unsigned nloc = b.st[0], nx = b.st[1];
        if (nloc == 0u) { xcd_barrier_complete(bar, b.x, nloc, nx); b.st[0] = nloc; b.st[1] = nx; }
        const unsigned old = xb_add(&bar[XB_XSUB(b.x)], 1u);
        const unsigned gen = old / nloc;
        if (old + 1u == (gen + 1u) * nloc) {
            __builtin_amdgcn_fence(__ATOMIC_RELEASE, "agent");
            asm volatile("s_waitcnt vmcnt(0)" ::: "memory");
            const unsigned og = xb_add(&bar[XB_TOP], 1u);
            const unsigned tg = og / nx;
            if (og + 1u == (tg + 1u) * nx) xb_add(&bar[XB_TOPGEN], 1u);
            else XB_SPIN(xb_ld(&bar[XB_TOPGEN]) == tg, bar);
            __builtin_amdgcn_fence(__ATOMIC_ACQUIRE, "agent");
            xb_add(&bar[XB_XGEN(b.x)], 1u);
            asm volatile("s_waitcnt vmcnt(0)" ::: "memory");
        } else {
            XB_SPIN(xb_ld(&bar[XB_XGEN(b.x)]) == gen, bar);
            __builtin_amdgcn_fence(__ATOMIC_ACQUIRE, "agent");
            asm volatile("s_waitcnt vmcnt(0)" ::: "memory");
        }
    }
    __syncthreads();
}

namespace pg8 {
constexpr int BM = 256, BK = 64, HALF = 128, HTB = HALF * BK * 2, STAGE_BYTES = 8 * HTB, NXCD = 8, WGM = 8;
__host__ __device__ __forceinline__ int lds_byte(int r, int c) { const int st = (r >> 4) * 2 + (c >> 5), rr = r & 15, cc = c & 31, ob = rr * 64 + cc * 2; return st * 1024 + (ob ^ (((ob >> 9) & 1) << 5)); }
__host__ __device__ __forceinline__ void stage_rc(int b, int& R, int& C) { const int st = b / 1024, sb = b % 1024, swz = sb ^ (((sb >> 9) & 1) << 5); R = (st >> 1) * 16 + swz / 64; C = (st & 1) * 32 + (swz % 64) / 2; }
__host__ __device__ __forceinline__ int perm32(int rho) { const int n = rho >> 4, i = rho & 15; return 8 * (i >> 2) + 4 * n + (i & 3); }
typedef int i32x8 __attribute__((ext_vector_type(8)));
typedef int i32x4_ __attribute__((ext_vector_type(4)));
__device__ __forceinline__ i32x8 cat8(bf16x8 a, bf16x8 b) { const i32x4_ x = __builtin_bit_cast(i32x4_, a), y = __builtin_bit_cast(i32x4_, b); return __builtin_shufflevector(x, y, 0, 1, 2, 3, 4, 5, 6, 7); }
__device__ __forceinline__ void mfma8(f32x4& acc, const i32x8 a, const i32x8 b) {
    asm volatile("v_mfma_scale_f32_16x16x128_f8f6f4 %0, %1, %2, %0, %3, %3 op_sel_hi:[0,0,0]" : "+v"(acc) : "v"(a), "v"(b), "v"(127)); }
struct Unit { int pm, pn, z; };
struct Order {
    int nM, nN, nwg, G, c;
    __device__ __forceinline__ void init(int nM_, int nN_, int G_, int c_) { nM = nM_; nN = nN_; nwg = nM * nN; G = G_; c = c_; }
    __device__ __forceinline__ bool next_mn(int i, Unit& u) const {
        const long L = (long)i * G + c; if (L >= nwg) return false;
        int wgid = (int)L; { const int q = nwg / NXCD, r = nwg % NXCD, xcd = wgid % NXCD, off = wgid / NXCD; wgid = (xcd < r ? xcd * (q + 1) : r * (q + 1) + (xcd - r) * q) + off; }
        const int nig = WGM * nN, gid = wgid / nig, fm = gid * WGM, gsz = (nM - fm) < WGM ? (nM - fm) : WGM;
        u.pm = fm + ((wgid % nig) % gsz); u.pn = (wgid % nig) / gsz; u.z = 0; return true;
    }
};

template <class Epi, class Sched, bool ALIGN_EPI, bool SP2, bool FP8 = false>
__device__ __forceinline__ void gemm_phase(LAS unsigned char* lds, const int tid_in, const char* base  , const int lda, const int ldb, const int K, const Sched& S, const Epi& E) {
    const int tid = tid_in, wid = __builtin_amdgcn_readfirstlane(tid >> 6), lane = tid & 63, wr = wid >> 2, wc = wid & 3, fr = lane & 15, fq = lane >> 4;
    const int nt = K / BK;
    unsigned voffA[2], voffB[2];
#pragma unroll
    for (int i = 0; i < 2; ++i) { int R, C; stage_rc(tid * 16 + i * 8192, R, C); const int Rb = Epi::PERM ? ((R & ~31) + perm32(R & 31)) : R;
        voffA[i] = (unsigned)(R * lda + C) * 2u; voffB[i] = (unsigned)(Rb * ldb + C) * 2u; }
    constexpr bool GATHER = Sched::GATHER;
    unsigned gvC[2][2], gvN[2][2];
#define PG8_GV(dst, unit) do { _Pragma("unroll") for (int hh_ = 0; hh_ < 2; ++hh_) _Pragma("unroll") for (int i_ = 0; i_ < 2; ++i_) { int R_, C_; stage_rc(tid * 16 + i_ * 8192, R_, C_); \
        dst[hh_][i_] = S.arow(unit, hh_ * HALF + R_) + (unsigned)C_ * 2u; } } while (0)
    const unsigned kstep = (unsigned)(BK * 2);
    const unsigned hstepA = (unsigned)(HALF * lda * 2), hstepB = (unsigned)(HALF * ldb * 2);
    const __amdgpu_buffer_rsrc_t rsrc = __builtin_amdgcn_make_buffer_rsrc((void*)base, 0, 0xffffffffu, 0x00020000);
    const unsigned ldsw = (unsigned)wid * 1024u;
    const int aoff = lds_byte(wr * 64 + fr, fq * 8), boff = lds_byte(wc * 32 + fr, fq * 8);
#define PG8_SA(b, h) (((b) * 2 + (h)) * HTB)
#define PG8_SB(b, h) ((4 + (b) * 2 + (h)) * HTB)
#define PG8_STAGE(bufoff, goff, voff) do { _Pragma("unroll") for (int _i = 0; _i < 2; ++_i) \
        __builtin_amdgcn_raw_ptr_buffer_load_lds(rsrc, (LAS unsigned*)(lds + (bufoff) + ldsw + _i * 8192), 16, (voff)[_i], (goff), 0, 0); } while (0)
#define PG8_STAGE_A(bufoff, aoff, hh, nx) do { if constexpr (GATHER) { unsigned gv_[2]; gv_[0] = (nx) ? gvN[hh][0] : gvC[hh][0]; gv_[1] = (nx) ? gvN[hh][1] : gvC[hh][1]; PG8_STAGE(bufoff, aoff, gv_); } \
        else { PG8_STAGE(bufoff, (aoff) + (hh) * hstepA, voffA); } } while (0)
#define PG8_LDA(dst, b, h) do { _Pragma("unroll") for (int m = 0; m < 4; ++m) _Pragma("unroll") for (int k = 0; k < 2; ++k) dst[m][k] = *(const LAS bf16x8*)(lds + PG8_SA(b, h) + aoff + m * 2048 + k * 1024); } while (0)
#define PG8_LDB(dst, b, h) do { _Pragma("unroll") for (int n = 0; n < 2; ++n) _Pragma("unroll") for (int k = 0; k < 2; ++k) dst[n][k] = *(const LAS bf16x8*)(lds + PG8_SB(b, h) + boff + n * 2048 + k * 1024); } while (0)
#define PG8_MMA(ai, bj, At, Bt) do { __builtin_amdgcn_s_setprio(1); \
        if constexpr (FP8) { _Pragma("unroll") for (int m = 0; m < 4; ++m) _Pragma("unroll") for (int n = 0; n < 2; ++n) \
            mfma8(acc[ai][bj][m][n], cat8(Bt[n][0], Bt[n][1]), cat8(At[m][0], At[m][1])); } \
        else { _Pragma("unroll") for (int m = 0; m < 4; ++m) _Pragma("unroll") for (int n = 0; n < 2; ++n) _Pragma("unroll") for (int k = 0; k < 2; ++k) \
            acc[ai][bj][m][n] = __builtin_amdgcn_mfma_f32_16x16x32_bf16(Bt[n][k], At[m][k], acc[ai][bj][m][n], 0, 0, 0); } \
        __builtin_amdgcn_s_setprio(0); } while (0)
#define PG8_WAIT_V(n) asm volatile("s_waitcnt vmcnt(" #n ")" ::: "memory")
#define PG8_WAIT_L(n) asm volatile("s_waitcnt lgkmcnt(" #n ")" ::: "memory")
#define PG8_BAR __builtin_amdgcn_s_barrier()
#define PG8_SCHED __builtin_amdgcn_sched_barrier(0)
    Unit cur, nxt; int ui = 0;
    if (!S.next(0, cur)) return;
    f32x4 acc[2][2][4][2];
#pragma unroll
    for (int a = 0; a < 2; ++a)
#pragma unroll
        for (int b = 0; b < 2; ++b)
#pragma unroll
            for (int m = 0; m < 4; ++m)
#pragma unroll
                for (int n = 0; n < 2; ++n) acc[a][b][m][n] = (f32x4){0.f, 0.f, 0.f, 0.f};
    bf16x8 At[4][2], B0[2][2], B1[2][2];
    unsigned cA = S.A(cur), cB = S.B(cur);
    if constexpr (GATHER) { PG8_GV(gvC, cur); _Pragma("unroll") for (int hh_ = 0; hh_ < 2; ++hh_) _Pragma("unroll") for (int i_ = 0; i_ < 2; ++i_) gvN[hh_][i_] = gvC[hh_][i_]; }
    if constexpr (SP2) {
        PG8_STAGE(PG8_SB(0, 0), cB, voffB); PG8_STAGE(PG8_SB(0, 1), cB + hstepB, voffB); PG8_STAGE_A(PG8_SA(0, 0), cA, 0, false); PG8_STAGE_A(PG8_SA(0, 1), cA, 1, false);
        if (wr == 1) PG8_BAR;
        PG8_WAIT_V(2); PG8_BAR;
        PG8_STAGE(PG8_SB(1, 0), cB + kstep, voffB); PG8_STAGE_A(PG8_SA(1, 0), cA + kstep, 0, false); PG8_STAGE(PG8_SB(1, 1), cB + hstepB + kstep, voffB);
        PG8_WAIT_V(6); PG8_BAR;
    } else {
        PG8_STAGE(PG8_SB(0, 0), cB, voffB); PG8_STAGE_A(PG8_SA(0, 0), cA, 0, false); PG8_STAGE(PG8_SB(0, 1), cB + hstepB, voffB); PG8_STAGE_A(PG8_SA(0, 1), cA, 1, false);
        if (wr == 1) PG8_BAR;
        PG8_WAIT_V(4); PG8_BAR;
        PG8_STAGE(PG8_SB(1, 0), cB + kstep, voffB); PG8_STAGE_A(PG8_SA(1, 0), cA + kstep, 0, false); PG8_STAGE(PG8_SB(1, 1), cB + hstepB + kstep, voffB);
        PG8_WAIT_V(6); PG8_BAR;
    }
    for (;;) {
        const bool has_next = S.next(ui + 1, nxt);
        const unsigned nA = has_next ? S.A(nxt) : cA, nB = has_next ? S.B(nxt) : cB;
        if constexpr (GATHER) { if (has_next) PG8_GV(gvN, nxt); }
        for (int t = 0; t < nt; t += 2) {
            const bool last = (t == nt - 2);
            const unsigned a1 = cA + (unsigned)(t + 1) * kstep;
            const unsigned a2 = last ? nA : cA + (unsigned)(t + 2) * kstep, b2 = last ? nB : cB + (unsigned)(t + 2) * kstep;
            const unsigned a3 = a2 + kstep, b3 = b2 + kstep;
            if constexpr (SP2) {
            PG8_LDB(B0, 0, 0); PG8_LDB(B1, 0, 1); PG8_SCHED; PG8_LDA(At, 0, 0); PG8_STAGE_A(PG8_SA(1, 1), a1, 1, false);
            PG8_WAIT_V(8); PG8_WAIT_L(0); PG8_BAR; PG8_MMA(0, 0, At, B0); PG8_MMA(0, 1, At, B1); PG8_BAR; PG8_SCHED;
            PG8_LDA(At, 0, 1); PG8_STAGE(PG8_SB(0, 0), b2, voffB); PG8_STAGE(PG8_SB(0, 1), b2 + hstepB, voffB); PG8_STAGE_A(PG8_SA(0, 0), a2, 0, last);
            PG8_WAIT_V(8); PG8_WAIT_L(0); PG8_BAR; PG8_MMA(1, 0, At, B0); PG8_MMA(1, 1, At, B1); PG8_BAR; PG8_SCHED;
            PG8_LDB(B0, 1, 0); PG8_LDB(B1, 1, 1); PG8_SCHED; PG8_LDA(At, 1, 0); PG8_STAGE_A(PG8_SA(0, 1), a2, 1, last);
            PG8_WAIT_V(8); PG8_WAIT_L(0); PG8_BAR; PG8_MMA(0, 0, At, B0); PG8_MMA(0, 1, At, B1); PG8_BAR; PG8_SCHED;
            PG8_LDA(At, 1, 1); PG8_STAGE(PG8_SB(1, 0), b3, voffB); PG8_STAGE(PG8_SB(1, 1), b3 + hstepB, voffB); PG8_STAGE_A(PG8_SA(1, 0), a3, 0, last);
            PG8_WAIT_V(8); PG8_WAIT_L(0); PG8_BAR; PG8_MMA(1, 0, At, B0); PG8_MMA(1, 1, At, B1); PG8_BAR; PG8_SCHED;
            } else {
            PG8_LDB(B0, 0, 0); PG8_SCHED; PG8_LDA(At, 0, 0); PG8_STAGE_A(PG8_SA(1, 1), a1, 1, false);
            PG8_WAIT_L(8); PG8_BAR; PG8_WAIT_L(0); PG8_MMA(0, 0, At, B0); PG8_BAR; PG8_SCHED;
            PG8_LDB(B1, 0, 1); PG8_STAGE(PG8_SB(0, 0), b2, voffB);
            PG8_BAR; PG8_WAIT_L(0); PG8_MMA(0, 1, At, B1); PG8_BAR;
            PG8_LDA(At, 0, 1); PG8_STAGE_A(PG8_SA(0, 0), a2, 0, last);
            PG8_BAR; PG8_WAIT_L(0); PG8_MMA(1, 0, At, B0); PG8_BAR; PG8_SCHED;
            PG8_STAGE(PG8_SB(0, 1), b2 + hstepB, voffB);
            PG8_WAIT_V(6); PG8_BAR; PG8_MMA(1, 1, At, B1); PG8_BAR;
            PG8_LDB(B0, 1, 0); PG8_SCHED; PG8_LDA(At, 1, 0); PG8_STAGE_A(PG8_SA(0, 1), a2, 1, last);
            PG8_WAIT_L(8); PG8_BAR; PG8_WAIT_L(0); PG8_MMA(0, 0, At, B0); PG8_BAR; PG8_SCHED;
            PG8_LDB(B1, 1, 1); PG8_STAGE(PG8_SB(1, 0), b3, voffB);
            PG8_BAR; PG8_WAIT_L(0); PG8_MMA(0, 1, At, B1); PG8_BAR;
            PG8_LDA(At, 1, 1); PG8_STAGE_A(PG8_SA(1, 0), a3, 0, last);
            PG8_BAR; PG8_WAIT_L(0); PG8_MMA(1, 0, At, B0); PG8_BAR; PG8_SCHED;
            PG8_STAGE(PG8_SB(1, 1), b3 + hstepB, voffB);
            PG8_WAIT_V(6); PG8_BAR; PG8_MMA(1, 1, At, B1); PG8_BAR;
            }
        }
        if constexpr (ALIGN_EPI) { if (wr == 0) PG8_BAR; }
        if constexpr (FP8) asm volatile("s_nop 15\n\ts_nop 15\n\ts_nop 7" ::: "memory");
        E(acc, cur, wr, wc, fr, fq);
        if (!has_next) break;
#pragma unroll
        for (int a = 0; a < 2; ++a)
#pragma unroll
            for (int b = 0; b < 2; ++b)
#pragma unroll
                for (int m = 0; m < 4; ++m)
#pragma unroll
                    for (int n = 0; n < 2; ++n) acc[a][b][m][n] = (f32x4){0.f, 0.f, 0.f, 0.f};
        cur = nxt; cA = nA; cB = nB; ++ui;
        if constexpr (GATHER) { _Pragma("unroll") for (int hh_ = 0; hh_ < 2; ++hh_) _Pragma("unroll") for (int i_ = 0; i_ < 2; ++i_) gvC[hh_][i_] = gvN[hh_][i_]; }
        if constexpr (ALIGN_EPI) { if (wr == 1) PG8_BAR; }
    }
    PG8_WAIT_V(0);
    if constexpr (!ALIGN_EPI) { if (wr == 0) PG8_BAR; }
    PG8_BAR;
#undef PG8_SA
#undef PG8_SB
#undef PG8_STAGE
#undef PG8_STAGE_A
#undef PG8_GV
#undef PG8_LDA
#undef PG8_LDB
#undef PG8_MMA
#undef PG8_WAIT_V
#undef PG8_WAIT_L
#undef PG8_BAR
#undef PG8_SCHED
}

struct SchedPlain : Order {
    static constexpr bool GATHER = false; __device__ __forceinline__ unsigned arow(const Unit&, int) const { return 0u; }
    unsigned A0, B0, at, bt;
    __device__ __forceinline__ bool next(int i, Unit& u) const { return next_mn(i, u); }
    __device__ __forceinline__ unsigned A(const Unit& u) const { return A0 + (unsigned)u.pm * at; }
    __device__ __forceinline__ unsigned B(const Unit& u) const { return B0 + (unsigned)u.pn * bt; }
};
struct SchedLora : Order {
    static constexpr bool GATHER = false; __device__ __forceinline__ unsigned arow(const Unit&, int) const { return 0u; }
    unsigned A0, B0; int skipv;
    __device__ __forceinline__ bool next(int i, Unit& u) const { if (!next_mn(i, u)) return false; if (skipv && u.pn >= 12) u.pn += 6; return true; }
    __device__ __forceinline__ unsigned A(const Unit& u) const { return A0 + (unsigned)u.pm * (256u * 512u * 2u) + (u.pn >= 18 ? 512u : 0u); }
    __device__ __forceinline__ unsigned B(const Unit& u) const { return B0 + (unsigned)u.pn * (256u * 256u * 2u); }
};
struct SchedMem {
    static constexpr bool GATHER = false; __device__ __forceinline__ unsigned arow(const Unit&, int) const { return 0u; }
    int G, c; unsigned memb, wkv;
    __device__ __forceinline__ bool next(int i, Unit& u) const {
        const int L = i * G + c; if (L >= 64) return false;
        if (L < 32) { u.z = 0; u.pm = L >> 1; u.pn = L & 1; } else { const int q = L - 32; u.z = 1; u.pm = q & 1; u.pn = q >> 1; }
        return true;
    }
    __device__ __forceinline__ unsigned A(const Unit& u) const { return u.z == 0 ? memb + (unsigned)u.pm * (256u * 2048u * 2u) : wkv + (unsigned)(2 + u.pm) * (256u * 2048u * 2u); }
    __device__ __forceinline__ unsigned B(const Unit& u) const { return u.z == 0 ? wkv + (unsigned)u.pn * (256u * 2048u * 2u) : memb + (unsigned)u.pn * (256u * 2048u * 2u); }
};
struct SchedMoE : Order {
    static constexpr bool GATHER = false; __device__ __forceinline__ unsigned arow(const Unit&, int) const { return 0u; }
    unsigned A0, B0, at, bt, be; const int* texp;
    __device__ __forceinline__ bool next(int i, Unit& u) const { if (!next_mn(i, u)) return false; u.z = __builtin_amdgcn_readfirstlane(texp[u.pm]); return true; }
    __device__ __forceinline__ unsigned A(const Unit& u) const { return A0 + (unsigned)u.pm * at; }
    __device__ __forceinline__ unsigned B(const Unit& u) const { return B0 + (unsigned)u.z * be + (unsigned)u.pn * bt; }
};

struct SchedMoEg : Order {
    static constexpr bool GATHER = true;
    unsigned B0, bt, be, xoff, zoff; const int* texp; const int* slot_tok;
    __device__ __forceinline__ bool next(int i, Unit& u) const { if (!next_mn(i, u)) return false; u.z = __builtin_amdgcn_readfirstlane(texp[u.pm]); return true; }
    __device__ __forceinline__ unsigned A(const Unit&) const { return 0u; }
    __device__ __forceinline__ unsigned B(const Unit& u) const { return B0 + (unsigned)u.z * be + (unsigned)u.pn * bt; }
    __device__ __forceinline__ unsigned arow(const Unit& u, int r) const { const int tok = slot_tok[u.pm * 256 + r]; return tok < 0 ? zoff : xoff + (unsigned)tok * 2048u; }
};

struct EpiBf16 {
    static constexpr bool PERM = true;
    bf16* O; int ldc;
    __device__ __forceinline__ void operator()(const f32x4 (&acc)[2][2][4][2], const Unit& u, int wr, int wc, int fr, int fq) const {
        const int row0 = u.pm * BM + wr * 64 + fr, col0 = u.pn * BM + wc * 32 + 8 * fq;
#pragma unroll
        for (int ai = 0; ai < 2; ++ai)
#pragma unroll
            for (int m = 0; m < 4; ++m) { bf16* rowp = O + (size_t)(row0 + ai * HALF + m * 16) * ldc + col0;
#pragma unroll
                for (int bj = 0; bj < 2; ++bj) { const f32x4 v0 = acc[ai][bj][m][0], v1 = acc[ai][bj][m][1];
                    u32x4 w; w.x = cvt_pk_bf16(v0[0], v0[1]); w.y = cvt_pk_bf16(v0[2], v0[3]); w.z = cvt_pk_bf16(v1[0], v1[1]); w.w = cvt_pk_bf16(v1[2], v1[3]);
                    *(u32x4*)(rowp + bj * HALF) = w; } }
    }
};
struct EpiMem {
    static constexpr bool PERM = true;
    bf16* O0; bf16* O1;
    __device__ __forceinline__ void operator()(const f32x4 (&acc)[2][2][4][2], const Unit& u, int wr, int wc, int fr, int fq) const {
        EpiBf16 e; e.O = u.z == 0 ? O0 : O1; e.ldc = u.z == 0 ? 512 : 4096; e(acc, u, wr, wc, fr, fq);
    }
};
struct EpiLora {
    static constexpr bool PERM = true;
    bf16* O; const float* vecs;
    __device__ __forceinline__ void operator()(const f32x4 (&acc)[2][2][4][2], const Unit& u, int wr, int wc, int fr, int fq) const {
        const int type = u.pn / 6;
        const int row0 = u.pm * BM + wr * 64 + fr, col0 = u.pn * BM + wc * 32 + 8 * fq, cb0 = (u.pn % 6) * BM + wc * 32 + 8 * fq;
        const float* bp = vecs + (type < 3 ? type : 0) * SW;
        const float sc = type == 0 ? 0.6065306597126334f : 1.0f;
#pragma unroll
        for (int bj = 0; bj < 2; ++bj) {
            f32x4 bv0 = (f32x4){0.f, 0.f, 0.f, 0.f}, bv1 = bv0;
            if (type < 3) { bv0 = *(const f32x4*)(bp + cb0 + bj * HALF); bv1 = *(const f32x4*)(bp + cb0 + bj * HALF + 4); }
#pragma unroll
            for (int ai = 0; ai < 2; ++ai)
#pragma unroll
                for (int m = 0; m < 4; ++m) { bf16* rowp = O + (size_t)(row0 + ai * HALF + m * 16) * 6144 + col0 + bj * HALF;
                    f32x4 v0_ = acc[ai][bj][m][0] + bv0, v1_ = acc[ai][bj][m][1] + bv1;
                    if (type < 3) {
#pragma unroll
                        for (int j = 0; j < 4; ++j) { v0_[j] = sc * sigmoidf_(v0_[j]); v1_[j] = sc * sigmoidf_(v1_[j]); } }
                    u32x4 w; w.x = cvt_pk_bf16(v0_[0], v0_[1]); w.y = cvt_pk_bf16(v0_[2], v0_[3]); w.z = cvt_pk_bf16(v1_[0], v1_[1]); w.w = cvt_pk_bf16(v1_[2], v1_[3]);
                    *(u32x4*)rowp = w; asm volatile("" ::: "memory"); }
        }
    }
};
struct EpiSwiglu {
    static constexpr bool PERM = true;
    bf16* O; int ldc;
    __device__ __forceinline__ void operator()(const f32x4 (&acc)[2][2][4][2], const Unit& u, int wr, int wc, int fr, int fq) const {
        const int row0 = u.pm * BM + wr * 64 + fr, col0 = u.pn * HALF + wc * 32 + 8 * fq;
#pragma unroll
        for (int ai = 0; ai < 2; ++ai)
#pragma unroll
            for (int m = 0; m < 4; ++m) { bf16* rowp = O + (size_t)(row0 + ai * HALF + m * 16) * ldc + col0;
                float h[8];
#pragma unroll
                for (int n = 0; n < 2; ++n)
#pragma unroll
                    for (int j = 0; j < 4; ++j) { const float g = acc[ai][0][m][n][j], up = acc[ai][1][m][n][j]; h[n * 4 + j] = g * sigmoidf_(g) * up; }
                u32x4 w; w.x = cvt_pk_bf16(h[0], h[1]); w.y = cvt_pk_bf16(h[2], h[3]); w.z = cvt_pk_bf16(h[4], h[5]); w.w = cvt_pk_bf16(h[6], h[7]);
                *(u32x4*)rowp = w; asm volatile("" ::: "memory"); }
    }
};
struct EpiSwiglu8 {
    static constexpr bool PERM = true;
    unsigned char* O; int ldc; float inv, so;
    __device__ __forceinline__ void operator()(const f32x4 (&acc)[2][2][4][2], const Unit& u, int wr, int wc, int fr, int fq) const {
        const int row0 = u.pm * BM + wr * 64 + fr, col0 = u.pn * HALF + wc * 32 + 8 * fq;
        const float c1 = -inv * 1.4426950408889634f, c2 = inv * inv * so;
#pragma unroll
        for (int ai = 0; ai < 2; ++ai)
#pragma unroll
            for (int m = 0; m < 4; ++m) { unsigned char* rowp = O + (size_t)(row0 + ai * HALF + m * 16) * ldc + col0;
                float h[8];
#pragma unroll
                for (int n = 0; n < 2; ++n)
#pragma unroll
                    for (int j = 0; j < 4; ++j) { const float ag = acc[ai][0][m][n][j], au = acc[ai][1][m][n][j];
                        h[n * 4 + j] = (ag * au) * __builtin_amdgcn_rcpf(1.0f + __builtin_amdgcn_exp2f(ag * c1)) * c2; }
                u32x2 w; w.x = pk4_fp8(h[0], h[1], h[2], h[3]); w.y = pk4_fp8(h[4], h[5], h[6], h[7]);
                *(u32x2*)rowp = w; asm volatile("" ::: "memory"); }
    }
};
struct EpiBf16S {
    static constexpr bool PERM = true;
    bf16* O; int ldc; float sc;
    __device__ __forceinline__ void operator()(const f32x4 (&acc)[2][2][4][2], const Unit& u, int wr, int wc, int fr, int fq) const {
        const int row0 = u.pm * BM + wr * 64 + fr, col0 = u.pn * BM + wc * 32 + 8 * fq;
#pragma unroll
        for (int ai = 0; ai < 2; ++ai)
#pragma unroll
            for (int m = 0; m < 4; ++m) { bf16* rowp = O + (size_t)(row0 + ai * HALF + m * 16) * ldc + col0;
#pragma unroll
                for (int bj = 0; bj < 2; ++bj) { const f32x4 v0 = acc[ai][bj][m][0] * sc, v1 = acc[ai][bj][m][1] * sc;
                    u32x4 w; w.x = cvt_pk_bf16(v0[0], v0[1]); w.y = cvt_pk_bf16(v0[2], v0[3]); w.z = cvt_pk_bf16(v1[0], v1[1]); w.w = cvt_pk_bf16(v1[2], v1[3]);
                    *(u32x4*)(rowp + bj * HALF) = w; } }
    }
};
struct EpiFp8S {
    static constexpr bool PERM = true;
    unsigned char* O; int ldc; float sc;
    __device__ __forceinline__ void operator()(const f32x4 (&acc)[2][2][4][2], const Unit& u, int wr, int wc, int fr, int fq) const {
        const int row0 = u.pm * BM + wr * 64 + fr, col0 = u.pn * BM + wc * 32 + 8 * fq;
#pragma unroll
        for (int ai = 0; ai < 2; ++ai)
#pragma unroll
            for (int m = 0; m < 4; ++m) { unsigned char* rowp = O + (size_t)(row0 + ai * HALF + m * 16) * ldc + col0;
#pragma unroll
                for (int bj = 0; bj < 2; ++bj) { const f32x4 v0 = acc[ai][bj][m][0] * sc, v1 = acc[ai][bj][m][1] * sc;
                    u32x2 w; w.x = pk4_fp8(v0[0], v0[1], v0[2], v0[3]); w.y = pk4_fp8(v1[0], v1[1], v1[2], v1[3]);
                    *(u32x2*)(rowp + bj * HALF) = w; } }
    }
};
struct EpiRes {
    static constexpr bool PERM = false;
    const float* X; float* T;
    __device__ __forceinline__ void operator()(const f32x4 (&acc)[2][2][4][2], const Unit& u, int wr, int wc, int fr, int fq) const {
        const int row0 = u.pm * BM + wr * 64 + fr, col0 = u.pn * BM + wc * 32 + 4 * fq;
#pragma unroll
        for (int ai = 0; ai < 2; ++ai)
#pragma unroll
            for (int m = 0; m < 4; ++m) { const size_t off = (size_t)(row0 + ai * HALF + m * 16) * D + col0;
#pragma unroll
                for (int bj = 0; bj < 2; ++bj)
#pragma unroll
                    for (int n = 0; n < 2; ++n) { const f32x4 xv = *(const f32x4*)(X + off + bj * HALF + n * 16);
                        *(f32x4*)(T + off + bj * HALF + n * 16) = xv * ALPHA + acc[ai][bj][m][n]; } }
    }
};
}

struct Args {
    const float* in[43];
    float* out; unsigned char* ws;
    int ph_lo, ph_hi;
};
struct Ctx { LAS unsigned char* lds; int tid, lane, wave, bid, G, gw, NGW; unsigned char* ws; };

enum { I_X = 0, I_MEM = 1, I_POS = 2, I_WKV = 3,
       L0_WIN = 4, L0_MU, L0_LW, L0_LA, L0_LG, L0_VECS, L0_WOUT, L0_NORMS, L0_FG, L0_FU, L0_FD,
       L1_WIN = 15, L1_GN, L1_WOUT, L1_NORMS, L1_ROUTER, L1_MG, L1_MU_, L1_MD,
       L2_WIN = 23, L2_MU, L2_LW, L2_LA, L2_LV, L2_LG, L2_VECS, L2_WOUT, L2_NORMS, L2_FG, L2_FU, L2_FD,
       L3_WIN = 35, L3_GN, L3_WOUT, L3_NORMS, L3_ROUTER, L3_MG, L3_MU_, L3_MD };

__device__ __forceinline__ void tr_load(f32x4 (&v)[8], const float* W, int ldw, int k0, int n0, int lane) {
#pragma unroll
    for (int i = 0; i < 8; ++i) v[i] = *(const f32x4*)(W + (size_t)(k0 + 8 * i + (lane >> 3)) * ldw + n0 + 4 * (lane & 7));
}
__device__ __forceinline__ void tr_store(const f32x4 (&v)[8], int k0, bf16* WT, int ldt, int drow0, LAS float* scr, int lane) {
#pragma unroll
    for (int i = 0; i < 8; ++i) { LAS float* d = scr + (8 * i + (lane >> 3)) * 33 + 4 * (lane & 7); d[0] = v[i][0]; d[1] = v[i][1]; d[2] = v[i][2]; d[3] = v[i][3]; }
    LDS_WAIT(); asm volatile("" ::: "memory");
    const int c = lane & 7;
#pragma unroll
    for (int j = 0; j < 4; ++j) { const int n = (lane >> 3) + 8 * j; const LAS float* s = scr + (8 * c) * 33 + n;
        u32x4 o; o.x = cvt_pk_bf16(s[0 * 33], s[1 * 33]); o.y = cvt_pk_bf16(s[2 * 33], s[3 * 33]); o.z = cvt_pk_bf16(s[4 * 33], s[5 * 33]); o.w = cvt_pk_bf16(s[6 * 33], s[7 * 33]);
        *(u32x4*)(WT + (size_t)(drow0 + n) * ldt + k0 + 8 * c) = o; }
    LDS_WAIT(); asm volatile("" ::: "memory");
}
__device__ __forceinline__ void conv_mat(const Ctx& C, const float* W, int K, int N, bf16* WT, int mode, int off, int gw0) {
    LAS float* scr = (LAS float*)(C.lds + C.wave * 16384);
    const int nblk = N / 32, items = (K / 64) * nblk;
    int start = C.gw - gw0; if (start < 0) start += C.NGW;
#define CONV_DROW(n0_) (mode == 0 ? off + (n0_) : ((n0_) / 128) * 256 + off + ((n0_) % 128))
    f32x4 va[8], vb[8];
    int it = start;
    if (it < items) tr_load(va, W, N, 64 * (it / nblk), 32 * (it % nblk), C.lane);
    while (it < items) {
        const int it1 = it + C.NGW;
        if (it1 < items) tr_load(vb, W, N, 64 * (it1 / nblk), 32 * (it1 % nblk), C.lane);
        tr_store(va, 64 * (it / nblk), WT, K, CONV_DROW(32 * (it % nblk)), scr, C.lane);
        if (it1 >= items) break;
        const int it2 = it1 + C.NGW;
        if (it2 < items) tr_load(va, W, N, 64 * (it2 / nblk), 32 * (it2 % nblk), C.lane);
        tr_store(vb, 64 * (it1 / nblk), WT, K, CONV_DROW(32 * (it1 % nblk)), scr, C.lane);
        it = it2;
    }
#undef CONV_DROW
}
__device__ __forceinline__ void conv_lora(const Ctx& C, const float* lw, const float* la, const float* lv, const float* lg, bf16* Bt) {
    for (int idx = C.bid * NTHR + C.tid; idx < 6144 * 32; idx += C.G * NTHR) {
        const int n_ = idx % 1536, rest = idx / 1536, k0 = (rest % 32) * 8, blk = rest / 32;
        const float* src = nullptr;
        if (blk == 0) { if (k0 < 96) src = lw + (size_t)k0 * 1536; }
        else if (blk == 1) { if (k0 >= 96 && k0 < 192) src = la + (size_t)(k0 - 96) * 1536; }
        else if (blk == 2) { if (lv && k0 >= 192) src = lv + (size_t)(k0 - 192) * 1536; }
        else src = lg + (size_t)k0 * 1536;
        float v[8];
#pragma unroll
        for (int q = 0; q < 8; ++q) v[q] = 0.f;
        if (src) {
#pragma unroll
            for (int q = 0; q < 8; ++q) v[q] = src[q * 1536 + n_]; }
        u32x4 w; w.x = cvt_pk_bf16(v[0], v[1]); w.y = cvt_pk_bf16(v[2], v[3]); w.z = cvt_pk_bf16(v[4], v[5]); w.w = cvt_pk_bf16(v[6], v[7]);
        *(u32x4*)(Bt + (size_t)(blk * 1536 + n_) * 256 + k0) = w;
    }
}
__device__ __forceinline__ void conv_f32_bf16(const Ctx& C, const float* src, bf16* dst, size_t n8) {
    const size_t T = (size_t)C.G * NTHR;
    for (size_t i0 = (size_t)C.bid * NTHR + C.tid; i0 < n8; i0 += 4 * T) { f32x4 av[4], bv[4];
#pragma unroll
        for (int q = 0; q < 4; ++q) { av[q] = ((const f32x4*)src)[2 * (i0 + q * T)]; bv[q] = ((const f32x4*)src)[2 * (i0 + q * T) + 1]; }
#pragma unroll
        for (int q = 0; q < 4; ++q) { const f32x4 a = av[q], b = bv[q];
            u32x4 w; w.x = cvt_pk_bf16(a[0], a[1]); w.y = cvt_pk_bf16(a[2], a[3]); w.z = cvt_pk_bf16(b[0], b[1]); w.w = cvt_pk_bf16(b[2], b[3]);
            ((u32x4*)dst)[i0 + q * T] = w; } }
}

struct CvJob { const float* W; bf16* WT; int N, K, k0, n0, mode, off; float f8s; };
__device__ __forceinline__ void cv_load(f32x4 (&v)[8], const CvJob& J, int wave, int lane) {
    const int n = J.n0 + 4 * lane;
#pragma unroll
    for (int i = 0; i < 8; ++i) { v[i] = (f32x4){0.f, 0.f, 0.f, 0.f}; if (n < J.N) v[i] = *(const f32x4*)(J.W + (size_t)(J.k0 + 8 * wave + i) * J.N + n); }
}
__device__ __forceinline__ void cv_put(const f32x4 (&v)[8], LAS float* T, int wave, int lane) {
#pragma unroll
    for (int i = 0; i < 8; ++i) *(LAS f32x4*)(T + (8 * wave + i) * 256 + 4 * (lane ^ wave)) = v[i];
}
__device__ __forceinline__ void cv_out(const CvJob& J, const LAS float* T, int wave, int lane) {
    const int c = lane & 7;
#pragma unroll
    for (int j = 0; j < 4; ++j) { const int nl = 32 * wave + 8 * j + (lane >> 3), n = J.n0 + nl; const LAS float* s = T + (8 * c) * 256 + (nl ^ (c << 2));
        u32x4 o; o.x = cvt_pk_bf16(s[0 * 256], s[1 * 256]); o.y = cvt_pk_bf16(s[2 * 256], s[3 * 256]); o.z = cvt_pk_bf16(s[4 * 256], s[5 * 256]); o.w = cvt_pk_bf16(s[6 * 256], s[7 * 256]);
        if (n < J.N) { const int drow = J.mode == 0 ? J.off + n : (n / 128) * 256 + J.off + (n % 128);
            *(u32x4*)(J.WT + (size_t)drow * J.K + J.k0 + 8 * c) = o; } }
}
__device__ __forceinline__ void cv_out8(const CvJob& J, const LAS float* T, int wave, int lane) {
    const int c4 = lane & 3; unsigned char* W8 = (unsigned char*)J.WT;
#pragma unroll
    for (int j = 0; j < 2; ++j) { const int nl = 32 * wave + 16 * j + (lane >> 2), n = J.n0 + nl;
        float v[16];
#pragma unroll
        for (int q = 0; q < 16; ++q) { const int k = 16 * c4 + q; v[q] = T[k * 256 + (nl ^ (((k >> 3) & 7) << 2))] * J.f8s; }
        u32x4 o; o.x = pk4_fp8(v[0], v[1], v[2], v[3]); o.y = pk4_fp8(v[4], v[5], v[6], v[7]); o.z = pk4_fp8(v[8], v[9], v[10], v[11]); o.w = pk4_fp8(v[12], v[13], v[14], v[15]);
        if (n < J.N) { const int drow = J.mode == 0 ? J.off + n : (n / 128) * 256 + J.off + (n % 128);
            *(u32x4*)(W8 + (size_t)drow * J.K + J.k0 + 16 * c4) = o; } }
}
template <class Dec>
__device__ __forceinline__ void conv_run(const Ctx& C, int ntiles, const Dec& dec, const int t0 = -1, const int STR = GRID) {
    LAS float* T = (LAS float*)C.lds;
    f32x4 va[8], vb[8]; CvJob ja, jb, jc;
    int t = t0 < 0 ? C.bid : t0;
    if (t < ntiles) { dec(t, ja); cv_load(va, ja, C.wave, C.lane); }
    if (t + STR < ntiles) { dec(t + STR, jb); cv_load(vb, jb, C.wave, C.lane); }
    while (t < ntiles) {
        __syncthreads(); cv_put(va, T, C.wave, C.lane); jc = ja;
        if (t + 2 * STR < ntiles) { dec(t + 2 * STR, ja); cv_load(va, ja, C.wave, C.lane); }
        __syncthreads(); if (jc.f8s > 0.f) cv_out8(jc, T, C.wave, C.lane); else cv_out(jc, T, C.wave, C.lane);
        t += STR; if (t >= ntiles) break;
        __syncthreads(); cv_put(vb, T, C.wave, C.lane); jc = jb;
        if (t + 2 * STR < ntiles) { dec(t + 2 * STR, jb); cv_load(vb, jb, C.wave, C.lane); }
        __syncthreads(); if (jc.f8s > 0.f) cv_out8(jc, T, C.wave, C.lane); else cv_out(jc, T, C.wave, C.lane);
        t += STR;
    }
    __syncthreads();
}
struct MoeDec { const float* mg; const float* mu; const float* md; unsigned char* ws;
    __device__ __forceinline__ void operator()(int t, CvJob& J) const {
        const int j = t / 704, r = t % 704, e = j / 3, kind = j % 3;
        if (kind < 2) { J.W = (kind == 0 ? mg : mu) + (size_t)e * 2048 * 5632; J.WT = (bf16*)(ws + WS_MWGU + (size_t)e * 22 * MiB); J.N = 5632; J.K = 2048; J.mode = 1; J.off = kind * 128; J.f8s = 1024.f; J.k0 = 64 * (r / 22); J.n0 = 256 * (r % 22); }
        else { J.W = md + (size_t)e * 2048 * 5632; J.WT = (bf16*)(ws + WS_MWD + (size_t)e * 11 * MiB); J.N = 2048; J.K = 5632; J.mode = 0; J.off = 0; J.f8s = 2048.f; J.k0 = 64 * (r / 8); J.n0 = 256 * (r % 8); }
    } };
struct StaticDec { const float* const* in; unsigned char* ws;
    __device__ __forceinline__ void set(CvJob& J, const float* W, bf16* WT, int K, int N, int mode, int off, int r, float f8s = 0.f) const {
        const int nn = (N + 255) / 256; J.W = W; J.WT = WT; J.N = N; J.K = K; J.mode = mode; J.off = off; J.f8s = f8s; J.k0 = 64 * (r / nn); J.n0 = 256 * (r % nn); }
    __device__ __forceinline__ void operator()(int t, CvJob& J) const {
        int r = t;
        if (r < 128) { set(J, in[I_WKV], (bf16*)(ws + WS_WKV), 2048, 1024, 0, 0, r); return; } r -= 128;
        set(J, in[L0_WIN], (bf16*)(ws + WS_WIN), 2048, 5568, 0, 0, r);
    } };

struct SlotDec { const float* const* in; unsigned char* ws; int lq; MoeDec moe; StaticDec sd;
    __device__ __forceinline__ void operator()(int t, CvJob& J) const {
        if (t < 16896) { moe(t, J); return; }
        int r = t - 16896; const size_t l = (size_t)lq;
        if (r < 704) { sd.set(J, lq ? in[L2_FG] : in[L0_FG], (bf16*)(ws + WS_WFGU + l * 44 * MiB), 2048, 5632, 1, 0, r, 1024.f); return; } r -= 704;
        if (r < 704) { sd.set(J, lq ? in[L2_FU] : in[L0_FU], (bf16*)(ws + WS_WFGU + l * 44 * MiB), 2048, 5632, 1, 128, r, 1024.f); return; } r -= 704;
        if (r < 704) { sd.set(J, lq ? in[L2_FD] : in[L0_FD], (bf16*)(ws + WS_WFD + l * 22 * MiB), 5632, 2048, 0, 0, r, 2048.f); return; } r -= 704;
        if (r < 256) { sd.set(J, lq ? in[L2_WOUT] : in[L0_WOUT], (bf16*)(ws + WS_WOUT + l * 16 * MiB), 2048, 2048, 0, 0, r); return; } r -= 256;
        if (r < 256) { sd.set(J, lq ? in[L3_WOUT] : in[L1_WOUT], (bf16*)(ws + WS_WOUT + (l * 16 + 8) * MiB), 2048, 2048, 0, 0, r); return; } r -= 256;
        if (r < 640) { sd.set(J, lq ? in[L3_WIN] : in[L1_WIN], (bf16*)(ws + WS_WIN + (l * 44 + 22) * MiB), 2048, 5120, 0, 0, r); return; } r -= 640;
        sd.set(J, in[L2_WIN], (bf16*)(ws + WS_WIN + (size_t)44 * MiB), 2048, 5632, 0, 0, r);
    } };

__device__ __forceinline__ void ph_prologue(const Ctx& C, const Args& A) {
    unsigned char* ws = C.ws;
    { StaticDec dec; dec.in = A.in; dec.ws = ws; conv_run(C, 832, dec); }
    conv_lora(C, A.in[L0_LW], A.in[L0_LA], nullptr, A.in[L0_LG], (bf16*)(ws + WS_WLORA));
    conv_lora(C, A.in[L2_LW], A.in[L2_LA], A.in[L2_LV], A.in[L2_LG], (bf16*)(ws + WS_WLORA + 3 * MiB));
    { u32x4* z = (u32x4*)(ws + WS_WIN + (size_t)5568 * 2048 * 2);
      for (int i = C.bid * NTHR + C.tid; i < 64 * 2048 * 2 / 16; i += C.G * NTHR) z[i] = (u32x4){0u, 0u, 0u, 0u}; }
    { const f32x4* xs = (const f32x4*)A.in[I_X]; u32x2* hi = (u32x2*)(ws + WS_XB); unsigned* lo = (unsigned*)(ws + WS_XLO);
      const size_t T = (size_t)C.G * NTHR;
      for (size_t i0 = (size_t)C.bid * NTHR + C.tid; i0 < (size_t)M * D / 4; i0 += 8 * T) { f32x4 ov[8];
#pragma unroll
          for (int q = 0; q < 8; ++q) ov[q] = xs[i0 + q * T];
#pragma unroll
          for (int q = 0; q < 8; ++q) { const f32x4 o = ov[q]; const size_t i = i0 + q * T;
              u32x2 w; w.x = cvt_pk_bf16(o[0], o[1]); w.y = cvt_pk_bf16(o[2], o[3]); hi[i] = w;
              lo[i] = pk4_fp8((o[0] - bflo(w.x)) * 8192.f, (o[1] - bfhi(w.x)) * 8192.f, (o[2] - bflo(w.y)) * 8192.f, (o[3] - bfhi(w.y)) * 8192.f); } } }
    conv_f32_bf16(C, A.in[I_MEM], (bf16*)(ws + WS_MEMB), (size_t)4096 * 2048 / 8);
    { const int* pos = (const int*)A.in[I_POS]; f32x2* cs = (f32x2*)(ws + WS_CS);
      for (int idx = C.bid * NTHR + C.tid; idx < M * 64; idx += C.G * NTHR) {
          const int m = idx >> 6, i = idx & 63;
          const float pw = (float)exp2(13.287712379549449 * (double)i / 64.0);
          const float inv = 1.0f / pw;
          const float ang = (float)pos[m] * inv;
          const double x = (double)ang;
          const double n = rint(x * 0.15915494309189535);
          const double r = fma(-n, 6.283185307179586, x) - n * 2.4492935982947064e-16;
          const double r2 = r * r;
          double s = -1.0 / 121645100408832000.0;
          s = fma(s, r2, 1.0 / 355687428096000.0);
          s = fma(s, r2, -1.0 / 1307674368000.0);
          s = fma(s, r2, 1.0 / 6227020800.0);
          s = fma(s, r2, -1.0 / 39916800.0);
          s = fma(s, r2, 1.0 / 362880.0);
          s = fma(s, r2, -1.0 / 5040.0);
          s = fma(s, r2, 1.0 / 120.0);
          s = fma(s, r2, -1.0 / 6.0);
          s = fma(s * r2, r, r);
          double c = 1.0 / 2432902008176640000.0;
          c = fma(c, r2, -1.0 / 6402373705728000.0);
          c = fma(c, r2, 1.0 / 20922789888000.0);
          c = fma(c, r2, -1.0 / 87178291200.0);
          c = fma(c, r2, 1.0 / 479001600.0);
          c = fma(c, r2, -1.0 / 3628800.0);
          c = fma(c, r2, 1.0 / 40320.0);
          c = fma(c, r2, -1.0 / 720.0);
          c = fma(c, r2, 1.0 / 24.0);
          c = fma(c, r2, -0.5);
          c = fma(c, r2, 1.0);
          cs[idx] = (f32x2){(float)c, (float)s};
      } }
}

struct LnRow { u32x2 rh[8]; unsigned rl[8]; u32x2 a[8]; float w1, w2; };
__device__ __forceinline__ void ln_load(LnRow& R, const Ctx& C, int m, const void* Hp, int hmode, int s1, int s2, float w1, float w2) {
    const u32x2* hr = (const u32x2*)(C.ws + WS_XB + (size_t)m * D * 2) + C.lane;
    const unsigned* lr = (const unsigned*)(C.ws + (hmode == 0 ? WS_XLO : WS_X8) + (size_t)m * D) + C.lane;
#pragma unroll
    for (int j = 0; j < 8; ++j) { R.rh[j] = hr[64 * j]; R.rl[j] = lr[64 * j]; }
    if (hmode == 0) {
        const u32x2* ar = (const u32x2*)((const bf16*)Hp + (size_t)m * D) + C.lane;
#pragma unroll
        for (int j = 0; j < 8; ++j) R.a[j] = ar[64 * j];
        R.w1 = 1.f; R.w2 = 0.f;
    } else if (hmode == 1) {
        const unsigned* ar = (const unsigned*)((const unsigned char*)Hp + (size_t)m * D) + C.lane;
#pragma unroll
        for (int j = 0; j < 8; ++j) { R.a[j].x = ar[64 * j]; R.a[j].y = 0u; }
        R.w1 = 1.f / 256.f; R.w2 = 0.f;
    } else {
        R.w1 = w1; R.w2 = w2;
        const unsigned* y1 = (const unsigned*)((const unsigned char*)Hp + (size_t)s1 * D) + C.lane;
        const unsigned* y2 = (const unsigned*)((const unsigned char*)Hp + (size_t)s2 * D) + C.lane;
#pragma unroll
        for (int j = 0; j < 8; ++j) { R.a[j].x = y1[64 * j]; R.a[j].y = y2[64 * j]; }
    }
}
__device__ __forceinline__ void ln_row(const LnRow& R, const Ctx& C, int m, const LAS float* gb, int hmode, float* Xf32out, unsigned char* X8out,
                                       LAS float* rw, LAS int* hist, bool do_route) {
    const int l4 = 4 * C.lane;
    f32x4 v[8]; float s = 0.f;
#pragma unroll
    for (int j = 0; j < 8; ++j) { f32x4 f, x;
        const f32x2 l01 = __builtin_amdgcn_cvt_pk_f32_fp8(R.rl[j], false), l23 = __builtin_amdgcn_cvt_pk_f32_fp8(R.rl[j], true);
        const float ls = hmode == 0 ? (1.f / 8192.f) : (1.f / 16.f);
        x[0] = bflo(R.rh[j].x) + l01[0] * ls; x[1] = bfhi(R.rh[j].x) + l01[1] * ls; x[2] = bflo(R.rh[j].y) + l23[0] * ls; x[3] = bfhi(R.rh[j].y) + l23[1] * ls;
        if (hmode == 0) { f[0] = bflo(R.a[j].x); f[1] = bfhi(R.a[j].x); f[2] = bflo(R.a[j].y); f[3] = bfhi(R.a[j].y); }
        else { const f32x2 a01 = __builtin_amdgcn_cvt_pk_f32_fp8(R.a[j].x, false), a23 = __builtin_amdgcn_cvt_pk_f32_fp8(R.a[j].x, true);
            f[0] = R.w1 * a01[0]; f[1] = R.w1 * a01[1]; f[2] = R.w1 * a23[0]; f[3] = R.w1 * a23[1];
            if (hmode == 2) { const f32x2 b01 = __builtin_amdgcn_cvt_pk_f32_fp8(R.a[j].y, false), b23 = __builtin_amdgcn_cvt_pk_f32_fp8(R.a[j].y, true);
                f[0] += R.w2 * b01[0]; f[1] += R.w2 * b01[1]; f[2] += R.w2 * b23[0]; f[3] += R.w2 * b23[1]; } }
        v[j] = x * ALPHA + f; s += (v[j][0] + v[j][1]) + (v[j][2] + v[j][3]); }
    const float mean = wave_sum(s) * (1.f / D); float s2 = 0.f;
#pragma unroll
    for (int j = 0; j < 8; ++j) { v[j] = v[j] - mean; s2 += (v[j][0] * v[j][0] + v[j][1] * v[j][1]) + (v[j][2] * v[j][2] + v[j][3] * v[j][3]); }
    const float rstd = 1.0f / sqrtf(wave_sum(s2) * (1.f / D) + LN_EPS);
    float lg[8];
#pragma unroll
    for (int e = 0; e < 8; ++e) lg[e] = 0.f;
    u32x2* ho = (u32x2*)(C.ws + WS_XB + (size_t)m * D * 2) + C.lane;
    unsigned* lo = (unsigned*)(C.ws + WS_XLO + (size_t)m * D) + C.lane;
#pragma unroll
    for (int j = 0; j < 8; ++j) {
        const f32x4 gv = *((const LAS f32x4*)(gb + 256 * j + l4)), bv = *((const LAS f32x4*)(gb + 2048 + 256 * j + l4));
        const f32x4 o = v[j] * rstd * gv + bv;
        if (Xf32out) ((f32x4*)(Xf32out + (size_t)m * D))[64 * j + C.lane] = o;
        else if (X8out) {
            const unsigned p8 = pk4_fp8(o[0] * 16.f, o[1] * 16.f, o[2] * 16.f, o[3] * 16.f);
            ((unsigned*)(X8out + (size_t)m * D))[64 * j + C.lane] = p8;
            const f32x2 d01 = __builtin_amdgcn_cvt_pk_f32_fp8(p8, false), d23 = __builtin_amdgcn_cvt_pk_f32_fp8(p8, true);
            u32x2 w; w.x = cvt_pk_bf16(o[0] - d01[0] * (1.f / 16.f), o[1] - d01[1] * (1.f / 16.f)); w.y = cvt_pk_bf16(o[2] - d23[0] * (1.f / 16.f), o[3] - d23[1] * (1.f / 16.f)); ho[64 * j] = w; }
        else { u32x2 w; w.x = cvt_pk_bf16(o[0], o[1]); w.y = cvt_pk_bf16(o[2], o[3]); ho[64 * j] = w;
            lo[64 * j] = pk4_fp8((o[0] - bflo(w.x)) * 8192.f, (o[1] - bfhi(w.x)) * 8192.f, (o[2] - bflo(w.y)) * 8192.f, (o[3] - bfhi(w.y)) * 8192.f); }
        if (do_route) {
#pragma unroll
            for (int e = 0; e < 8; ++e) { const f32x4 we = *(const LAS f32x4*)(rw + e * 2048 + 256 * j + l4);
                lg[e] += (o[0] * we[0] + o[1] * we[1]) + (o[2] * we[2] + o[3] * we[3]); }
        }
    }
    if (do_route) {
#pragma unroll
        for (int e = 0; e < 8; ++e) lg[e] = wave_sum(lg[e]);
        int e1 = 0; float v1 = lg[0];
#pragma unroll
        for (int e = 1; e < 8; ++e) if (lg[e] > v1) { v1 = lg[e]; e1 = e; }
        int e2 = -1; float v2 = -3.0e38f;
#pragma unroll
        for (int e = 0; e < 8; ++e) if (e != e1 && lg[e] > v2) { v2 = lg[e]; e2 = e; }
        const float ex = __expf(v2 - v1); const float w1 = 1.0f / (1.0f + ex), w2 = ex / (1.0f + ex);
        if (C.lane == 0) { f32x4 rt; rt[0] = __int_as_float(e1 | (e2 << 8)); rt[1] = w1; rt[2] = w2; rt[3] = 0.f; ((f32x4*)(C.ws + WS_ROUTE))[m] = rt;
            atomicAdd((int*)&hist[e1], 1); atomicAdd((int*)&hist[e2], 1); }
    }
}
__device__ __forceinline__ void ph_ln(const Ctx& C, const void* Hp, int hmode, const float* gain, const float* bias, float* Xf32out, unsigned char* X8out,
                                      const float* router, bool do_route) {
    unsigned char* ws = C.ws;
    LAS float* rw = (LAS float*)C.lds;
    LAS int* hist = (LAS int*)(C.lds + LDS_MISC + 64);
    LAS float* gb = (LAS float*)(C.lds + 65536);
    ((LAS f32x4*)gb)[C.tid] = ((const f32x4*)gain)[C.tid]; ((LAS f32x4*)gb)[512 + C.tid] = ((const f32x4*)bias)[C.tid];
    if (!do_route) __syncthreads();
    if (do_route) {
        for (int col = C.tid; col < 2048; col += NTHR) { const f32x4 a = ((const f32x4*)router)[2 * col], b = ((const f32x4*)router)[2 * col + 1];
            rw[0 * 2048 + col] = a[0]; rw[1 * 2048 + col] = a[1]; rw[2 * 2048 + col] = a[2]; rw[3 * 2048 + col] = a[3]; rw[4 * 2048 + col] = b[0]; rw[5 * 2048 + col] = b[1]; rw[6 * 2048 + col] = b[2]; rw[7 * 2048 + col] = b[3]; }
        if (C.tid < 8) hist[C.tid] = 0;
        int* st = (int*)(ws + WS_SLOTTOK);
        for (int i = C.bid * NTHR + C.tid; i < NSLOT; i += C.G * NTHR) st[i] = -1;
        __syncthreads();
    }
    const int m0 = C.bid * 128 + C.wave * 16;
    LnRow Ra, Rb;
    int s1v = 0, s2v = 0, w1v = 0, w2v = 0;
    if (hmode == 2) { const int mr = m0 + (C.lane & 15); const f32x4 rt = ((const f32x4*)(ws + WS_ROUTE))[mr];
        s1v = ((const int*)(ws + WS_SLOT1))[mr]; s2v = ((const int*)(ws + WS_SLOT2))[mr]; w1v = __float_as_int(rt[1] * (1.f / 256.f)); w2v = __float_as_int(rt[2] * (1.f / 256.f)); }
#define LN_LOAD(R_, r_) ln_load(R_, C, m0 + (r_), Hp, hmode, __builtin_amdgcn_readlane(s1v, (r_)), __builtin_amdgcn_readlane(s2v, (r_)), __int_as_float(__builtin_amdgcn_readlane(w1v, (r_))), __int_as_float(__builtin_amdgcn_readlane(w2v, (r_))))
    LN_LOAD(Ra, 0);
#pragma unroll 1
    for (int r = 0; r < 16; r += 2) {
        LN_LOAD(Rb, r + 1);
        ln_row(Ra, C, m0 + r, gb, hmode, Xf32out, X8out, rw, hist, do_route);
        if (r + 2 < 16) LN_LOAD(Ra, r + 2);
        ln_row(Rb, C, m0 + r + 1, gb, hmode, Xf32out, X8out, rw, hist, do_route);
    }
#undef LN_LOAD
    if (do_route) { __syncthreads(); if (C.tid < 8) ((int*)(ws + WS_CTL))[CW_CNT + C.bid * 8 + C.tid] = hist[C.tid]; }
}

__device__ __forceinline__ void ph_slots(const Ctx& C) {
    unsigned char* ws = C.ws;
    LAS int* sm = (LAS int*)(C.lds + LDS_MISC + 128);
    const int* cnt = (const int*)(ws + WS_CTL) + CW_CNT;
    if (C.tid < 8) { int tot = 0, mine = 0; for (int b = 0; b < C.G; ++b) { const int c = cnt[b * 8 + C.tid]; if (b < C.bid) mine += c; tot += c; } sm[C.tid] = tot; sm[8 + C.tid] = mine; }
    __syncthreads();
    if (C.tid == 0) { int base = 0; for (int e = 0; e < 8; ++e) { sm[16 + e] = base; base += (sm[e] + 255) & ~255; } sm[24] = base >> 8; }
    __syncthreads();
    if (C.wave == 0) {
        int off[8];
#pragma unroll
        for (int e = 0; e < 8; ++e) off[e] = sm[16 + e] + sm[8 + e];
        const unsigned long long lt = (1ull << C.lane) - 1ull;
        for (int it = 0; it < 2; ++it) {
            const int m = C.bid * 128 + it * 64 + C.lane;
            const int ee = __float_as_int(((const f32x4*)(ws + WS_ROUTE))[m][0]); const int e1 = ee & 0xff, e2 = (ee >> 8) & 0xff;
            int s1 = 0, s2 = 0;
#pragma unroll
            for (int e = 0; e < 8; ++e) { const unsigned long long m1 = __ballot(e1 == e), m2 = __ballot(e2 == e);
                const int c1 = __popcll(m1), c2 = __popcll(m2);
                if (e1 == e) s1 = off[e] + __popcll(m1 & lt);
                if (e2 == e) s2 = off[e] + c1 + __popcll(m2 & lt);
                off[e] += c1 + c2; }
            ((int*)(ws + WS_SLOT1))[m] = s1; ((int*)(ws + WS_SLOT2))[m] = s2;
            int* st = (int*)(ws + WS_SLOTTOK); st[s1] = m; st[s2] = m;
        }
    }
    if (C.bid == 0) {
        int* ctl = (int*)(ws + WS_CTL);
        if (C.tid == 0) ctl[CW_NT] = sm[24];
        if (C.tid < 264) { int e = 0;
#pragma unroll
            for (int q = 1; q < 8; ++q) if (C.tid >= (sm[16 + q] >> 8)) e = q;
            ctl[CW_TEXP + C.tid] = e; }
    }
}
__device__ __forceinline__ void ph_gather(const Ctx& C) {
    unsigned char* ws = C.ws;
    const int* st = (const int*)(ws + WS_SLOTTOK); const u32x4* xb = (const u32x4*)(ws + WS_XB); u32x4* xp = (u32x4*)(ws + WS_XPERM);
    for (int s = C.gw; s < NSLOT; s += C.NGW) { const int tok = st[s];
#pragma unroll
        for (int j = 0; j < 2; ++j) { u32x4 v = xb[(size_t)(tok < 0 ? 0 : tok) * 128 + j * 64 + C.lane]; const unsigned k = tok < 0 ? 0u : 0xffffffffu; v.x &= k; v.y &= k; v.z &= k; v.w &= k; xp[(size_t)s * 128 + j * 64 + C.lane] = v; } }
}
__device__ __forceinline__ void ph_moe_wconv(const Ctx& C, const float* mg, const float* mu, const float* md, const float* const* in, int lq) {
    SlotDec dec; dec.in = in; dec.ws = C.ws; dec.lq = lq; dec.moe.mg = mg; dec.moe.mu = mu; dec.moe.md = md; dec.moe.ws = C.ws; dec.sd.in = in; dec.sd.ws = C.ws;
    conv_run(C, lq ? 20160 : 20864, dec, C.bid - 192, 64);
}

__device__ __forceinline__ void ph_memattn(const Ctx& C, const bf16* P, int ldp, int qm0) {
    unsigned char* ws = C.ws;
    const bf16* memK = (const bf16*)(ws + WS_MEMK); const bf16* memVT = (const bf16*)(ws + WS_MEMVT); bf16* mix = (bf16*)(ws + WS_MIX);
    const int g = C.lane >> 4, r16 = C.lane & 15;
    LAS unsigned char* LK = C.lds; LAS unsigned char* LV = C.lds + 65536;
    const int b = C.bid >> 4, hm = (C.bid >> 2) & 3, qb = C.bid & 3;
    __syncthreads();
    {   u32x4 st[16];
#pragma unroll
        for (int i = 0; i < 8; ++i) { const int q = C.tid + 512 * i, row = q >> 4, pc = q & 15;
            st[i] = *(const u32x4*)(memK + (size_t)(b * 256 + row) * 512 + hm * 128 + pc * 8); }
#pragma unroll
        for (int i = 0; i < 8; ++i) { const int q = C.tid + 512 * i, row = q >> 5, pc = q & 31;
            st[8 + i] = *(const u32x4*)(memVT + (size_t)(hm * 128 + row) * 4096 + b * 256 + pc * 8); }
#pragma unroll
        for (int i = 0; i < 8; ++i) { const int q = C.tid + 512 * i, row = q >> 4, pc = q & 15;
            *(LAS u32x4*)(LK + row * 256 + ((pc ^ (row & 15)) * 16)) = st[i]; }
#pragma unroll
        for (int i = 0; i < 8; ++i) { const int q = C.tid + 512 * i, row = q >> 5, pc = q & 31;
            *(LAS u32x4*)(LV + row * 512 + ((pc ^ (row & 15)) * 16)) = st[8 + i]; }
    }
    __syncthreads();
    for (int qt = 0; qt < 4; ++qt) {
        const int m0 = b * SEQ + qb * 512 + C.wave * 64 + qt * 16;
        bf16x8 qf[4];
#pragma unroll
        for (int s = 0; s < 4; ++s) qf[s] = *(const bf16x8*)(P + (size_t)(m0 + r16) * ldp + qm0 + hm * 128 + 32 * s + 8 * g);
        f32x4 sacc[16];
#pragma unroll
        for (int kt = 0; kt < 16; ++kt) { sacc[kt] = (f32x4){0.f, 0.f, 0.f, 0.f};
#pragma unroll
            for (int s = 0; s < 4; ++s) { const bf16x8 kf = *(const LAS bf16x8*)(LK + (16 * kt + r16) * 256 + (((4 * s + g) ^ r16) * 16));
                sacc[kt] = __builtin_amdgcn_mfma_f32_16x16x32_bf16(kf, qf[s], sacc[kt], 0, 0, 0); } }
        float mx = -3.0e38f;
#pragma unroll
        for (int kt = 0; kt < 16; ++kt)
#pragma unroll
            for (int j = 0; j < 4; ++j) mx = fmaxf(mx, sacc[kt][j]);
        mx = fmaxf(mx, shx(mx, C.lane, 16)); mx = fmaxf(mx, shx(mx, C.lane, 32));
        const float sc = 0.08838834764831845f * 1.4426950408889634f;
        float sum = 0.f;
#pragma unroll
        for (int kt = 0; kt < 16; ++kt)
#pragma unroll
            for (int j = 0; j < 4; ++j) { const float pv = exp2f((sacc[kt][j] - mx) * sc); sacc[kt][j] = pv; sum += pv; }
        sum += shx(sum, C.lane, 16); sum += shx(sum, C.lane, 32);
        f32x4 oacc[8];
#pragma unroll
        for (int dt = 0; dt < 8; ++dt) oacc[dt] = (f32x4){0.f, 0.f, 0.f, 0.f};
#pragma unroll
        for (int ks = 0; ks < 8; ++ks) {
            u32x4 pw; pw.x = cvt_pk_bf16(sacc[2 * ks][0], sacc[2 * ks][1]); pw.y = cvt_pk_bf16(sacc[2 * ks][2], sacc[2 * ks][3]);
            pw.z = cvt_pk_bf16(sacc[2 * ks + 1][0], sacc[2 * ks + 1][1]); pw.w = cvt_pk_bf16(sacc[2 * ks + 1][2], sacc[2 * ks + 1][3]);
            const bf16x8 pa = __builtin_bit_cast(bf16x8, pw);
#pragma unroll
            for (int dt = 0; dt < 8; ++dt) { const LAS unsigned char* vr = LV + (16 * dt + r16) * 512;
                const u32x2 lo = *(const LAS u32x2*)(vr + (((8 * ks + g) ^ (2 * r16)) * 8)), hi = *(const LAS u32x2*)(vr + (((8 * ks + 4 + g) ^ (2 * r16)) * 8));
                u32x4 vw; vw.x = lo.x; vw.y = lo.y; vw.z = hi.x; vw.w = hi.y;
                oacc[dt] = __builtin_amdgcn_mfma_f32_16x16x32_bf16(pa, __builtin_bit_cast(bf16x8, vw), oacc[dt], 0, 0, 0); } }
        float inv[4];
#pragma unroll
        for (int j = 0; j < 4; ++j) inv[j] = 1.0f / shl(sum, 4 * g + j);
#pragma unroll
        for (int dt = 0; dt < 8; ++dt)
#pragma unroll
            for (int j = 0; j < 4; ++j) mix[(size_t)(m0 + 4 * g + j) * D + SW + hm * 128 + 16 * dt + r16] = f2bf(oacc[dt][j] * inv[j]);
    }
    __syncthreads();
}

__device__ __forceinline__ void ph_rwkv_prep1(const Ctx& C, const float* mu, bool with_v) {
    unsigned char* ws = C.ws;
    const bf16* P = (const bf16*)(ws + WS_P); bf16* AL = (bf16*)(ws + WS_ALORA);
    const int oc0 = 8 * C.lane;
    const int XW0 = 4608, XA0 = 4704, XV0 = 4800, XG0 = with_v ? 4864 : 4800;
    int src, mode;
    if (oc0 < 96) { src = XW0 + oc0; mode = 0; } else if (oc0 < 192) { src = XA0 + oc0 - 96; mode = 1; }
    else if (oc0 < 256) { src = XV0 + oc0 - 192; mode = with_v ? 1 : 2; } else { src = XG0 + oc0 - 256; mode = 3; }
    f32x4 mu0 = (f32x4){0.f, 0.f, 0.f, 0.f}, mu1 = mu0;
    if (mode != 2) { mu0 = *(const f32x4*)(mu + src); mu1 = *(const f32x4*)(mu + src + 4); }
    for (int mb = C.gw; mb < M; mb += 4 * C.NGW) {
        u32x4 cu4[4], pr4[4];
#pragma unroll
        for (int i = 0; i < 4; ++i) { const int m = mb + i * C.NGW; cu4[i] = (u32x4){0u, 0u, 0u, 0u}; pr4[i] = cu4[i];
            if (mode != 2) { cu4[i] = *(const u32x4*)(P + (size_t)m * LDP_RW + src);
                if ((m & (SEQ - 1)) != 0) pr4[i] = *(const u32x4*)(P + (size_t)(m - 1) * LDP_RW + src); } }
#pragma unroll
        for (int i = 0; i < 4; ++i) { const int m = mb + i * C.NGW; const u32x4 cu = cu4[i], pr = pr4[i];
            u32x4 o = (u32x4){0u, 0u, 0u, 0u};
            if (mode != 2) {
                float v[8];
#pragma unroll
                for (int q = 0; q < 4; ++q) { const float c0 = bflo(cu[q]), c1 = bfhi(cu[q]), p0 = bflo(pr[q]), p1 = bfhi(pr[q]);
                    const float m0 = q < 2 ? mu0[2 * q] : mu1[2 * q - 4], m1 = q < 2 ? mu0[2 * q + 1] : mu1[2 * q - 3];
                    v[2 * q] = c0 + m0 * (p0 - c0); v[2 * q + 1] = c1 + m1 * (p1 - c1); }
#pragma unroll
                for (int q = 0; q < 8; ++q) { if (mode == 0) v[q] = 1.0f - 2.0f * __builtin_amdgcn_rcpf(1.0f + __expf(2.0f * v[q])); else if (mode == 3) v[q] = sigmoidf_(v[q]); }
                o.x = cvt_pk_bf16(v[0], v[1]); o.y = cvt_pk_bf16(v[2], v[3]); o.z = cvt_pk_bf16(v[4], v[5]); o.w = cvt_pk_bf16(v[6], v[7]);
            }
            *(u32x4*)(AL + (size_t)m * 512 + oc0) = o; }
    }
}
__device__ __forceinline__ void ph_rwkv_prep2(const Ctx& C, const float* mu, const float* vecs, bool with_v) {
    unsigned char* ws = C.ws;
    const bf16* P = (const bf16*)(ws + WS_P); const bf16* LO = (const bf16*)(ws + WS_LORAOUT); bf16* VF = (bf16*)(ws + WS_VFIRST);
    unsigned char* SI = ws + WS_SCANIN; float* BON = (float*)(ws + WS_BONUS);
    const float* k_k = vecs + (with_v ? 3 : 2) * SW; const float* k_a = k_k + SW; const float* r_k = k_a + SW;
    const int hq = C.lane >> 4, cl = (C.lane & 15) * 4;
    LAS float* LPAR = (LAS float*)C.lds;
    for (int i = C.tid; i < 3 * SW / 4; i += NTHR) { ((LAS f32x4*)LPAR)[i] = ((const f32x4*)mu)[i]; ((LAS f32x4*)LPAR)[3 * SW / 4 + i] = ((const f32x4*)k_k)[i]; }
    __syncthreads();
    for (int m = C.gw; m < M; m += C.NGW) {
        const int t = m & (SEQ - 1), b = m >> 11; const bool hp = t != 0;
        const bf16* pc = P + (size_t)m * LDP_RW; const bf16* pp = pc - LDP_RW;
#pragma unroll 2
        for (int it = 0; it < 6; ++it) {
            const int c = it * 256 + 4 * C.lane, head = 4 * it + hq;
            const u32x2 rc = *(const u32x2*)(pc + c), kc = *(const u32x2*)(pc + SW + c), vc = *(const u32x2*)(pc + 2 * SW + c);
            u32x2 rp = (u32x2){0u, 0u}, kp_ = rp, vp = rp;
            if (hp) { rp = *(const u32x2*)(pp + c); kp_ = *(const u32x2*)(pp + SW + c); vp = *(const u32x2*)(pp + 2 * SW + c); }
            const u32x2 Ew = *(const u32x2*)(LO + (size_t)m * 6144 + c), aw = *(const u32x2*)(LO + (size_t)m * 6144 + SW + c);
            u32x2 svw = (u32x2){0u, 0u}, vfw = svw;
            if (with_v) { svw = *(const u32x2*)(LO + (size_t)m * 6144 + 2 * SW + c); vfw = *(const u32x2*)(VF + (size_t)m * SW + c); }
            const f32x4 mr = *(const LAS f32x4*)(LPAR + c), mk = *(const LAS f32x4*)(LPAR + SW + c), mv = *(const LAS f32x4*)(LPAR + 2 * SW + c);
            const f32x4 kk4 = *(const LAS f32x4*)(LPAR + 3 * SW + c), ka4 = *(const LAS f32x4*)(LPAR + 4 * SW + c), rk4 = *(const LAS f32x4*)(LPAR + 5 * SW + c);
            float rm[4], km[4], vm[4], E[4], a[4], sv[4], vf[4];
#define UNPK(dst, w) dst[0] = bflo(w.x); dst[1] = bfhi(w.x); dst[2] = bflo(w.y); dst[3] = bfhi(w.y)
            float t0[4], t1[4];
            UNPK(t0, rc); UNPK(t1, rp);
#pragma unroll
            for (int j = 0; j < 4; ++j) rm[j] = t0[j] + mr[j] * (t1[j] - t0[j]);
            UNPK(t0, kc); UNPK(t1, kp_);
#pragma unroll
            for (int j = 0; j < 4; ++j) km[j] = t0[j] + mk[j] * (t1[j] - t0[j]);
            UNPK(t0, vc); UNPK(t1, vp);
#pragma unroll
            for (int j = 0; j < 4; ++j) vm[j] = t0[j] + mv[j] * (t1[j] - t0[j]);
            UNPK(E, Ew); UNPK(a, aw); UNPK(sv, svw); UNPK(vf, vfw);
#undef UNPK
            float vv[4], kkr[4], kp[4], ss = 0.f, bs = 0.f;
#pragma unroll
            for (int j = 0; j < 4; ++j) {
                vv[j] = with_v ? vm[j] + (vf[j] - vm[j]) * sv[j] : vm[j];
                kkr[j] = km[j] * kk4[j]; ss += kkr[j] * kkr[j];
                kp[j] = km[j] * (1.0f + (a[j] - 1.0f) * ka4[j]);
                bs += rm[j] * kp[j] * rk4[j]; }
            ss = row16_sum(ss); bs = row16_sum(bs);
            const float inv = 1.0f / fmaxf(sqrtf(ss), 1e-12f);
            if (!with_v) { u32x2 w; w.x = cvt_pk_bf16(vm[0], vm[1]); w.y = cvt_pk_bf16(vm[2], vm[3]); *(u32x2*)(VF + (size_t)m * SW + c) = w; }
            unsigned char* rec = SI + ((size_t)(b * 24 + head) * SEQ + t) * 768;
            float uw[4], kk[4];
#pragma unroll
            for (int j = 0; j < 4; ++j) { uw[j] = 1.0f - __expf(-E[j]); kk[j] = kkr[j] * inv; }
            u32x2 o;
            { const h16x2 u01 = __builtin_convertvector((f32x2){uw[0], uw[1]}, h16x2), u23 = __builtin_convertvector((f32x2){uw[2], uw[3]}, h16x2);
              o.x = __builtin_bit_cast(unsigned, u01); o.y = __builtin_bit_cast(unsigned, u23); *(u32x2*)(rec + cl * 2) = o; }
            o.x = cvt_pk_bf16(-kk[0], -kk[1]); o.y = cvt_pk_bf16(-kk[2], -kk[3]); *(u32x2*)(rec + 128 + cl * 2) = o;
            o.x = cvt_pk_bf16(kk[0] * a[0], kk[1] * a[1]); o.y = cvt_pk_bf16(kk[2] * a[2], kk[3] * a[3]); *(u32x2*)(rec + 256 + cl * 2) = o;
            o.x = cvt_pk_bf16(kp[0], kp[1]); o.y = cvt_pk_bf16(kp[2], kp[3]); *(u32x2*)(rec + 384 + cl * 2) = o;
            o.x = cvt_pk_bf16(rm[0], rm[1]); o.y = cvt_pk_bf16(rm[2], rm[3]); *(u32x2*)(rec + 512 + cl * 2) = o;
            o.x = cvt_pk_bf16(vv[0], vv[1]); o.y = cvt_pk_bf16(vv[2], vv[3]); *(u32x2*)(rec + 640 + cl * 2) = o;
            if ((C.lane & 15) == 0) BON[m * 24 + head] = bs;
        }
    }
}
__device__ __forceinline__ float fma_(float a, float b, float c) { float d; asm("v_fma_f32 %0, %1, %2, %3" : "=v"(d) : "v"(a), "v"(b), "v"(c)); return d; }
__device__ __forceinline__ float mul_(float a, float b) { float d; asm("v_mul_f32 %0, %1, %2" : "=v"(d) : "v"(a), "v"(b)); return d; }
__device__ __forceinline__ void ph_rwkv_scan(const Ctx& C, const float* mg, const float* mu, const float* md, const float* vecs, bool with_v, const float* const* in, int lq) {
    if (C.bid >= 192) { ph_moe_wconv(C, mg, mu, md, in, lq); return; }
    unsigned char* ws = C.ws;
    const unsigned char* SI = ws + WS_SCANIN;
    constexpr int TC = 16, NCH = SEQ / TC, REC = 7 * 64;
    LAS float* buf = (LAS float*)C.lds;
    LAS float* ybuf = (LAS float*)(C.lds + 114688);
    const bool scanner = C.wave < 4;
    const int slot = (C.wave >> 1) & 1;
    const int rg = C.lane >> 3, cg = C.lane & 7;
    const int rbase = 32 * (C.wave & 1) + 4 * rg;
    if (!scanner) {
        const int lw = C.wave - 4, qd = C.lane;
        const int q2 = qd - 8, lvec = 1 + (q2 >> 3), lpart = q2 & 7;
        const float* BON = (const float*)(ws + WS_BONUS); bf16* mix = (bf16*)(ws + WS_MIX); const bf16* LO = (const bf16*)(ws + WS_LORAOUT);
        const float* gn_g = vecs + (with_v ? 6 : 5) * SW; const float* gn_b = gn_g + SW;
        const int p0 = C.bid * 2, b0 = p0 / 24, h0 = p0 % 24, b1 = (p0 + 1) / 24, h1 = (p0 + 1) % 24;
        const int pr = C.lane >> 4, pc4 = 4 * (C.lane & 15);
        const f32x4 gg0 = *(const f32x4*)(gn_g + h0 * 64 + pc4), gb0 = *(const f32x4*)(gn_b + h0 * 64 + pc4), gg1 = *(const f32x4*)(gn_g + h1 * 64 + pc4), gb1 = *(const f32x4*)(gn_b + h1 * 64 + pc4);
        u32x4 st[8];
#define SCAN_ISSUE(ch_) do { _Pragma("unroll") for (int i_ = 0; i_ < 8; ++i_) { const int ps = lw + 4 * i_; \
        const int sl_ = ps >> 4, t_ = (ch_) * TC + (ps & 15); \
        st[i_] = qd < 48 ? *(const u32x4*)(SI + ((size_t)(p0 + sl_) * SEQ + t_) * 768 + qd * 16) \
                         : *(const u32x4*)(LO + (size_t)((sl_ ? b1 : b0) * SEQ + t_) * 6144 + 3 * SW + (sl_ ? h1 : h0) * 64 + ((qd - 48) & 7) * 8); } } while (0)
#define SCAN_COMMIT(bsel_) do { _Pragma("unroll") for (int i_ = 0; i_ < 8; ++i_) { const int ps = lw + 4 * i_; \
        LAS float* dst = buf + (((bsel_) * 2 * TC) + ps) * REC; \
        if (qd < 8) { f32x4 a_, b_; const unsigned sx_ = st[i_].x, sy_ = st[i_].y, sz_ = st[i_].z, sw_ = st[i_].w;     \
            { const f32x2 t0_ = __builtin_convertvector(__builtin_bit_cast(h16x2, sx_), f32x2), t1_ = __builtin_convertvector(__builtin_bit_cast(h16x2, sy_), f32x2); \
              a_[0] = 1.0f - t0_[0]; a_[1] = 1.0f - t0_[1]; a_[2] = 1.0f - t1_[0]; a_[3] = 1.0f - t1_[1]; } \
            { const f32x2 t0_ = __builtin_convertvector(__builtin_bit_cast(h16x2, sz_), f32x2), t1_ = __builtin_convertvector(__builtin_bit_cast(h16x2, sw_), f32x2); \
              b_[0] = 1.0f - t0_[0]; b_[1] = 1.0f - t0_[1]; b_[2] = 1.0f - t1_[0]; b_[3] = 1.0f - t1_[1]; } \
            *(LAS f32x4*)(dst + 8 * qd) = a_; *(LAS f32x4*)(dst + 8 * qd + 4) = b_; } \
        else if (qd < 56) { LAS float* d2 = dst + lvec * 64 + lpart * 8; \
            f32x4 a_, b_; a_[0] = bflo(st[i_].x); a_[1] = bfhi(st[i_].x); a_[2] = bflo(st[i_].y); a_[3] = bfhi(st[i_].y); \
            b_[0] = bflo(st[i_].z); b_[1] = bfhi(st[i_].z); b_[2] = bflo(st[i_].w); b_[3] = bfhi(st[i_].w); \
            *(LAS f32x4*)d2 = a_; *(LAS f32x4*)(d2 + 4) = b_; } } } while (0)
#define SCAN_POST(cp_) do { _Pragma("unroll") for (int g_ = 0; g_ < 2; ++g_) { const int ps = lw + 4 * (4 * g_ + pr), sl = ps >> 4, stp = ps & 15; \
        const LAS float* rec = buf + ((((cp_) & 1) * 2 * TC) + ps) * REC; \
        const f32x4 yv = *(const LAS f32x4*)(ybuf + ((((cp_) & 1) * 2 + sl) * TC + stp) * 64 + pc4), vv = *(const LAS f32x4*)(rec + 5 * 64 + pc4), gq = *(const LAS f32x4*)(rec + 6 * 64 + pc4); \
        const int m = (sl ? b1 : b0) * SEQ + (cp_) * TC + stp, hh = sl ? h1 : h0; \
        const float bon = BON[m * 24 + hh]; \
        const float mean = row16_sum((yv[0] + yv[1]) + (yv[2] + yv[3])) * (1.f / 64.f); const f32x4 d = yv - mean; \
        const float var = row16_sum((d[0] * d[0] + d[1] * d[1]) + (d[2] * d[2] + d[3] * d[3])) * (1.f / 64.f); \
        const float rstd = 1.0f / sqrtf(var + 64e-5f); const f32x4 gg = sl ? gg1 : gg0, gb = sl ? gb1 : gb0; \
        const f32x4 o_ = (d * rstd * gg + gb + vv * bon) * gq; \
        u32x2 w_; w_.x = cvt_pk_bf16(o_[0], o_[1]); w_.y = cvt_pk_bf16(o_[2], o_[3]); \
        *(u32x2*)(mix + (size_t)m * D + hh * 64 + pc4) = w_; } } while (0)
        SCAN_ISSUE(0); SCAN_COMMIT(0);
        __syncthreads();
        for (int ch = 0; ch < NCH; ++ch) {
            if (ch + 1 < NCH) SCAN_ISSUE(ch + 1);
            if (ch > 0) SCAN_POST(ch - 1);
            if (ch + 1 < NCH) SCAN_COMMIT((ch & 1) ^ 1);
            __syncthreads();
        }
        SCAN_POST(NCH - 1);
#undef SCAN_ISSUE
#undef SCAN_COMMIT
#undef SCAN_POST
    } else {
        f32x2 S[4][4];
#pragma unroll
        for (int i = 0; i < 4; ++i)
#pragma unroll
            for (int c = 0; c < 4; ++c) S[i][c] = (f32x2){0.f, 0.f};
        __syncthreads();
        for (int ch = 0; ch < NCH; ++ch) {
            const LAS float* base = buf + (((ch & 1) * 2 + slot) * TC) * REC;
            LAS float* yb = ybuf + (((ch & 1) * 2 + slot) * TC) * 64 + rbase;
#pragma unroll 2
            for (int s = 0; s < TC; ++s) {
                const LAS float* rp = base + s * REC + 8 * cg;
                f32x2 wv[4], nv[4], bv[4], kv[4], rv[4];
                { const f32x4 x0 = *(const LAS f32x4*)(rp), x1 = *(const LAS f32x4*)(rp + 4); wv[0] = (f32x2){x0[0], x0[1]}; wv[1] = (f32x2){x0[2], x0[3]}; wv[2] = (f32x2){x1[0], x1[1]}; wv[3] = (f32x2){x1[2], x1[3]}; }
                { const f32x4 x0 = *(const LAS f32x4*)(rp + 64), x1 = *(const LAS f32x4*)(rp + 68); nv[0] = (f32x2){x0[0], x0[1]}; nv[1] = (f32x2){x0[2], x0[3]}; nv[2] = (f32x2){x1[0], x1[1]}; nv[3] = (f32x2){x1[2], x1[3]}; }
                { const f32x4 x0 = *(const LAS f32x4*)(rp + 128), x1 = *(const LAS f32x4*)(rp + 132); bv[0] = (f32x2){x0[0], x0[1]}; bv[1] = (f32x2){x0[2], x0[3]}; bv[2] = (f32x2){x1[0], x1[1]}; bv[3] = (f32x2){x1[2], x1[3]}; }
                { const f32x4 x0 = *(const LAS f32x4*)(rp + 192), x1 = *(const LAS f32x4*)(rp + 196); kv[0] = (f32x2){x0[0], x0[1]}; kv[1] = (f32x2){x0[2], x0[3]}; kv[2] = (f32x2){x1[0], x1[1]}; kv[3] = (f32x2){x1[2], x1[3]}; }
                { const f32x4 x0 = *(const LAS f32x4*)(rp + 256), x1 = *(const LAS f32x4*)(rp + 260); rv[0] = (f32x2){x0[0], x0[1]}; rv[1] = (f32x2){x0[2], x0[3]}; rv[2] = (f32x2){x1[0], x1[1]}; rv[3] = (f32x2){x1[2], x1[3]}; }
                const f32x4 vv = *(const LAS f32x4*)(base + s * REC + 320 + rbase);
                f32x4 yo;
#pragma unroll
                for (int i = 0; i < 4; ++i) {
                    f32x2 a2 = S[i][0] * nv[0];
#pragma unroll
                    for (int c = 1; c < 4; ++c) a2 = S[i][c] * nv[c] + a2;
                    float sa = a2[0] + a2[1];
                    sa = dpp_add<0xB1>(sa); sa = dpp_add<0x4E>(sa); sa = dpp_add<0x141>(sa);
                    const f32x2 sa2 = (f32x2){sa, sa}, v2 = (f32x2){vv[i], vv[i]};
                    f32x2 y2 = (f32x2){0.f, 0.f};
#pragma unroll
                    for (int c = 0; c < 4; ++c) { S[i][c] = S[i][c] * wv[c] + (sa2 * bv[c] + v2 * kv[c]); y2 = S[i][c] * rv[c] + y2; }
                    float y = y2[0] + y2[1];
                    y = dpp_add<0xB1>(y); y = dpp_add<0x4E>(y); y = dpp_add<0x141>(y);
                    yo[i] = y;
                }
                if (cg == 0) *(LAS f32x4*)(yb + s * 64) = yo;
            }
            __syncthreads();
        }
    }
}

__device__ __constant__ float RET_LG2[6] = {-0.04580368961312479f, -0.02272007650008353f, -0.011315313227834146f, -0.005646563141142063f, -0.0028205190623786626f, -0.0014095702546713536f};
__device__ __forceinline__ void ph_ret_prep(const Ctx& C) {
    unsigned char* ws = C.ws;
    const bf16* P = (const bf16*)(ws + WS_P); const f32x2* CS = (const f32x2*)(ws + WS_CS);
    bf16* QR = (bf16*)(ws + WS_QR); bf16* KR = (bf16*)(ws + WS_KR); bf16* VT = (bf16*)(ws + WS_VT); bf16* KVT = (bf16*)(ws + WS_KVT);
    LAS unsigned char* LKt = C.lds; LAS unsigned char* LV = C.lds + 32768;
    const int g = C.lane >> 4, r16 = C.lane & 15, w = C.wave;
    __syncthreads();
    for (int u = C.bid; u < 1536; u += C.G) {
        const int c = u & 15, bh = u >> 4, h = bh % 6, b = bh / 6, m0 = b * SEQ + c * 128;
        const float lg2 = RET_LG2[h];
        __syncthreads();
        for (int task = C.tid; task < 1536; task += NTHR) {
            if (task < 512) {
                const bool isk = task >= 256; const int tk = task & 255, i0 = 4 * (tk & 15), tg = tk >> 4;
                const int colb = (isk ? 768 : 0) + h * 128 + i0; const float scl = isk ? 0.08838834764831845f : 1.0f;
                bf16* N = isk ? KR : QR;
                float o1[4][8], o2[4][8];
#pragma unroll
                for (int j = 0; j < 8; ++j) { const int m = m0 + tg * 8 + j;
                    const u32x2 a = *(const u32x2*)(P + (size_t)m * LDP_RET + colb), b2 = *(const u32x2*)(P + (size_t)m * LDP_RET + colb + 64);
                    const f32x4 cs01 = *(const f32x4*)(CS + (size_t)m * 64 + i0), cs23 = *(const f32x4*)(CS + (size_t)m * 64 + i0 + 2);
                    const float x1[4] = {bflo(a.x), bfhi(a.x), bflo(a.y), bfhi(a.y)}, x2[4] = {bflo(b2.x), bfhi(b2.x), bflo(b2.y), bfhi(b2.y)};
                    const float cc[4] = {cs01[0], cs01[2], cs23[0], cs23[2]}, sn[4] = {cs01[1], cs01[3], cs23[1], cs23[3]};
#pragma unroll
                    for (int q = 0; q < 4; ++q) { o1[q][j] = (x1[q] * cc[q] - x2[q] * sn[q]) * scl; o2[q][j] = (x1[q] * sn[q] + x2[q] * cc[q]) * scl; }
                    u32x2 w1, w2; w1.x = cvt_pk_bf16(o1[0][j], o1[1][j]); w1.y = cvt_pk_bf16(o1[2][j], o1[3][j]); w2.x = cvt_pk_bf16(o2[0][j], o2[1][j]); w2.y = cvt_pk_bf16(o2[2][j], o2[3][j]);
                    *(u32x2*)(N + (size_t)m * 768 + h * 128 + i0) = w1; *(u32x2*)(N + (size_t)m * 768 + h * 128 + i0 + 64) = w2; }
                if (isk) {
                    float kd[8];
#pragma unroll
                    for (int j = 0; j < 8; ++j) kd[j] = exp2f((float)(127 - (tg * 8 + j)) * lg2);
#pragma unroll
                    for (int q = 0; q < 4; ++q) {
                        u32x4 w1, w2;
                        w1.x = cvt_pk_bf16(o1[q][0] * kd[0], o1[q][1] * kd[1]); w1.y = cvt_pk_bf16(o1[q][2] * kd[2], o1[q][3] * kd[3]); w1.z = cvt_pk_bf16(o1[q][4] * kd[4], o1[q][5] * kd[5]); w1.w = cvt_pk_bf16(o1[q][6] * kd[6], o1[q][7] * kd[7]);
                        w2.x = cvt_pk_bf16(o2[q][0] * kd[0], o2[q][1] * kd[1]); w2.y = cvt_pk_bf16(o2[q][2] * kd[2], o2[q][3] * kd[3]); w2.z = cvt_pk_bf16(o2[q][4] * kd[4], o2[q][5] * kd[5]); w2.w = cvt_pk_bf16(o2[q][6] * kd[6], o2[q][7] * kd[7]);
                        *(LAS u32x4*)(LKt + (i0 + q) * 256 + ((tg ^ ((i0 + q) & 15)) * 16)) = w1;
                        *(LAS u32x4*)(LKt + (i0 + q + 64) * 256 + ((tg ^ ((i0 + q + 64) & 15)) * 16)) = w2; }
                }
            } else {
                const int tv = task - 512, e0 = 4 * (tv & 63), tg = tv >> 6;
                u32x2 vin[8];
#pragma unroll
                for (int j = 0; j < 8; ++j) vin[j] = *(const u32x2*)(P + (size_t)(m0 + tg * 8 + j) * LDP_RET + 1536 + h * 256 + e0);
                u32x4 w0, w1, w2, w3;
#define PKLO(a_, b_) (((a_) & 0xffffu) | ((b_) << 16))
#define PKHI(a_, b_) (((a_) >> 16) | ((b_) & 0xffff0000u))
                w0.x = PKLO(vin[0].x, vin[1].x); w0.y = PKLO(vin[2].x, vin[3].x); w0.z = PKLO(vin[4].x, vin[5].x); w0.w = PKLO(vin[6].x, vin[7].x);
                w1.x = PKHI(vin[0].x, vin[1].x); w1.y = PKHI(vin[2].x, vin[3].x); w1.z = PKHI(vin[4].x, vin[5].x); w1.w = PKHI(vin[6].x, vin[7].x);
                w2.x = PKLO(vin[0].y, vin[1].y); w2.y = PKLO(vin[2].y, vin[3].y); w2.z = PKLO(vin[4].y, vin[5].y); w2.w = PKLO(vin[6].y, vin[7].y);
                w3.x = PKHI(vin[0].y, vin[1].y); w3.y = PKHI(vin[2].y, vin[3].y); w3.z = PKHI(vin[4].y, vin[5].y); w3.w = PKHI(vin[6].y, vin[7].y);
#undef PKLO
#undef PKHI
                *(LAS u32x4*)(LV + (e0 + 0) * 256 + ((tg ^ ((e0 + 0) & 15)) * 16)) = w0; *(LAS u32x4*)(LV + (e0 + 1) * 256 + ((tg ^ ((e0 + 1) & 15)) * 16)) = w1;
                *(LAS u32x4*)(LV + (e0 + 2) * 256 + ((tg ^ ((e0 + 2) & 15)) * 16)) = w2; *(LAS u32x4*)(LV + (e0 + 3) * 256 + ((tg ^ ((e0 + 3) & 15)) * 16)) = w3;
            }
        }
        __syncthreads();
        {   f32x4 acc[16];
#pragma unroll
            for (int et = 0; et < 16; ++et) acc[et] = (f32x4){0.f, 0.f, 0.f, 0.f};
#pragma unroll
            for (int ks = 0; ks < 4; ++ks) {
                const bf16x8 af = *(const LAS bf16x8*)(LKt + (16 * w + r16) * 256 + (((4 * ks + g) ^ r16) * 16));
#pragma unroll
                for (int et = 0; et < 16; ++et) { const bf16x8 bf = *(const LAS bf16x8*)(LV + (16 * et + r16) * 256 + (((4 * ks + g) ^ r16) * 16));
                    acc[et] = __builtin_amdgcn_mfma_f32_16x16x32_bf16(af, bf, acc[et], 0, 0, 0); } }
#pragma unroll
            for (int et = 0; et < 16; ++et) { u32x2 wv; wv.x = cvt_pk_bf16(acc[et][0], acc[et][1]); wv.y = cvt_pk_bf16(acc[et][2], acc[et][3]); *(u32x2*)(KVT + ((size_t)u * 256 + 16 * et + r16) * 128 + 16 * w + 4 * g) = wv; }
        }
    }
    __syncthreads();
}
__device__ __forceinline__ void ph_ret_kv(const Ctx& C) {
    unsigned char* ws = C.ws;
    const bf16* KDT = (const bf16*)(ws + WS_KDT); const bf16* VT = (const bf16*)(ws + WS_VT); bf16* KVT = (bf16*)(ws + WS_KVT);
    const int g = C.lane >> 4, r16 = C.lane & 15, w = C.wave;
    LAS unsigned char* LKt = C.lds; LAS unsigned char* LV = C.lds + 32768;
    u32x4 st[12];
#define KV_ISSUE(u_) do { const int c_ = (u_) & 15, bh_ = (u_) >> 4; \
        _Pragma("unroll") for (int i = 0; i < 4; ++i) { const int q = C.tid + 512 * i, row = q >> 4, pc = q & 15; st[i] = *(const u32x4*)(KDT + (size_t)(bh_ * 128 + row) * SEQ + c_ * 128 + pc * 8); } \
        _Pragma("unroll") for (int i = 0; i < 8; ++i) { const int q = C.tid + 512 * i, row = q >> 4, pc = q & 15; st[4 + i] = *(const u32x4*)(VT + (size_t)(bh_ * 256 + row) * SEQ + c_ * 128 + pc * 8); } } while (0)
#define KV_COMMIT() do { \
        _Pragma("unroll") for (int i = 0; i < 4; ++i) { const int q = C.tid + 512 * i, row = q >> 4, pc = q & 15; *(LAS u32x4*)(LKt + row * 256 + ((pc ^ (row & 15)) * 16)) = st[i]; } \
        _Pragma("unroll") for (int i = 0; i < 8; ++i) { const int q = C.tid + 512 * i, row = q >> 4, pc = q & 15; *(LAS u32x4*)(LV + row * 256 + ((pc ^ (row & 15)) * 16)) = st[4 + i]; } } while (0)
    __syncthreads();
    if (C.bid < 1536) KV_ISSUE(C.bid);
    for (int u = C.bid; u < 1536; u += C.G) {
        __syncthreads();
        KV_COMMIT();
        if (u + C.G < 1536) KV_ISSUE(u + C.G);
        __syncthreads();
        f32x4 acc[16];
#pragma unroll
        for (int et = 0; et < 16; ++et) acc[et] = (f32x4){0.f, 0.f, 0.f, 0.f};
#pragma unroll
        for (int ks = 0; ks < 4; ++ks) {
            const bf16x8 af = *(const LAS bf16x8*)(LKt + (16 * w + r16) * 256 + (((4 * ks + g) ^ r16) * 16));
#pragma unroll
            for (int et = 0; et < 16; ++et) { const bf16x8 bf = *(const LAS bf16x8*)(LV + (16 * et + r16) * 256 + (((4 * ks + g) ^ r16) * 16));
                acc[et] = __builtin_amdgcn_mfma_f32_16x16x32_bf16(af, bf, acc[et], 0, 0, 0); } }
#pragma unroll
        for (int et = 0; et < 16; ++et) { u32x2 wv; wv.x = cvt_pk_bf16(acc[et][0], acc[et][1]); wv.y = cvt_pk_bf16(acc[et][2], acc[et][3]); *(u32x2*)(KVT + ((size_t)u * 256 + 16 * et + r16) * 128 + 16 * w + 4 * g) = wv; }
    }
    __syncthreads();
#undef KV_ISSUE
#undef KV_COMMIT
}
__device__ __forceinline__ void ph_ret_prefix(const Ctx& C) {
    unsigned char* ws = C.ws;
    const bf16* KVT = (const bf16*)(ws + WS_KVT); bf16* RTB = (bf16*)(ws + WS_RTB);
    for (int idx = C.bid * NTHR + C.tid; idx < 96 * 8192; idx += C.G * NTHR) {
        const int bh = idx >> 13, rem = idx & 8191; const int h = bh % 6;
        const float cd = exp2f(128.0f * RET_LG2[h]);
        f32x4 r = (f32x4){0.f, 0.f, 0.f, 0.f};
        u32x2 kwv[15];
#pragma unroll
        for (int c = 0; c < 15; ++c) kwv[c] = *(const u32x2*)(KVT + ((size_t)(bh * 16 + c) * 8192 + rem) * 4);
#pragma unroll
        for (int c = 0; c < 16; ++c) { const size_t off = ((size_t)(bh * 16 + c) * 8192 + rem) * 4;
            u32x2 w; w.x = cvt_pk_bf16(r[0], r[1]); w.y = cvt_pk_bf16(r[2], r[3]); *(u32x2*)(RTB + off) = w;
            if (c < 15) { const u32x2 kw = kwv[c]; const f32x4 kv = (f32x4){bflo(kw.x), bfhi(kw.x), bflo(kw.y), bfhi(kw.y)}; r = r * cd + kv; } }
    }
}
#define LDS_BAR() asm volatile("s_waitcnt lgkmcnt(0)\n\ts_barrier" ::: "memory")
__device__ __forceinline__ void ret_v_lds(const u32x2 (&vin)[8], LAS unsigned char* LV, int e0, int tg) {
    u32x4 w0, w1, w2, w3;
#define PKLO(a_, b_) (((a_) & 0xffffu) | ((b_) << 16))
#define PKHI(a_, b_) (((a_) >> 16) | ((b_) & 0xffff0000u))
    w0.x = PKLO(vin[0].x, vin[1].x); w0.y = PKLO(vin[2].x, vin[3].x); w0.z = PKLO(vin[4].x, vin[5].x); w0.w = PKLO(vin[6].x, vin[7].x);
    w1.x = PKHI(vin[0].x, vin[1].x); w1.y = PKHI(vin[2].x, vin[3].x); w1.z = PKHI(vin[4].x, vin[5].x); w1.w = PKHI(vin[6].x, vin[7].x);
    w2.x = PKLO(vin[0].y, vin[1].y); w2.y = PKLO(vin[2].y, vin[3].y); w2.z = PKLO(vin[4].y, vin[5].y); w2.w = PKLO(vin[6].y, vin[7].y);
    w3.x = PKHI(vin[0].y, vin[1].y); w3.y = PKHI(vin[2].y, vin[3].y); w3.z = PKHI(vin[4].y, vin[5].y); w3.w = PKHI(vin[6].y, vin[7].y);
#undef PKLO
#undef PKHI
    *(LAS u32x4*)(LV + (e0 + 0) * 256 + ((tg ^ ((e0 + 0) & 15)) * 16)) = w0; *(LAS u32x4*)(LV + (e0 + 1) * 256 + ((tg ^ ((e0 + 1) & 15)) * 16)) = w1;
    *(LAS u32x4*)(LV + (e0 + 2) * 256 + ((tg ^ ((e0 + 2) & 15)) * 16)) = w2; *(LAS u32x4*)(LV + (e0 + 3) * 256 + ((tg ^ ((e0 + 3) & 15)) * 16)) = w3;
}
__device__ __forceinline__ void ph_ret_out(const Ctx& C, const float* gn) {
    unsigned char* ws = C.ws;
    const bf16* P = (const bf16*)(ws + WS_P); const bf16* QR = (const bf16*)(ws + WS_QR); const bf16* KR = (const bf16*)(ws + WS_KR);
    const bf16* VT = (const bf16*)(ws + WS_VT); const bf16* RTB = (const bf16*)(ws + WS_RTB); bf16* mix = (bf16*)(ws + WS_MIX);
    const int g = C.lane >> 4, r16 = C.lane & 15, w = C.wave;
    LAS unsigned char* LR = C.lds; LAS unsigned char* LV = C.lds + 65536; LAS float* LG = (LAS float*)(C.lds + LDS_MISC + 2048);
    for (int u = C.bid; u < 1536; u += C.G) {
        const int c = u & 15, bh = u >> 4, h = bh % 6, b = bh / 6, m0 = b * SEQ + c * 128;
        const float lg2 = RET_LG2[h];
        LDS_BAR();
        f32x4 gnst = (f32x4){0.f, 0.f, 0.f, 0.f};
        if (C.tid < 128) gnst = *(const f32x4*)(gn + (C.tid >> 6) * SW + h * 256 + (C.tid & 63) * 4);
        const int nl = 16 * w + r16;
        u32x4 kst[4];
        bf16x8 qf[4];
        u32x2 gwv[16];
        {   u32x4 st[8]; u32x2 vinA[8], vinB[8];
            const int e0v = 4 * (C.tid & 63), tgv = C.tid >> 6;
#pragma unroll
            for (int i = 0; i < 8; ++i) { const int q = C.tid + 512 * i, row = q >> 4, pc = q & 15;
                st[i] = *(const u32x4*)(RTB + ((size_t)u * 256 + row) * 128 + pc * 8); }
#pragma unroll
            for (int j = 0; j < 8; ++j) { vinA[j] = *(const u32x2*)(P + (size_t)(m0 + tgv * 8 + j) * LDP_RET + 1536 + h * 256 + e0v);
                vinB[j] = *(const u32x2*)(P + (size_t)(m0 + tgv * 8 + 64 + j) * LDP_RET + 1536 + h * 256 + e0v); }
#pragma unroll
            for (int s = 0; s < 4; ++s) qf[s] = *(const bf16x8*)(QR + (size_t)(m0 + nl) * 768 + h * 128 + 32 * s + 8 * g);
#pragma unroll
            for (int i = 0; i < 8; ++i) { const int q = C.tid + 512 * i, row = q >> 4, pc = q & 15; const int off = row * 256 + ((pc ^ (row & 15)) * 16);
                *(LAS u32x4*)(LR + off) = st[i]; }
            ret_v_lds(vinA, LV, e0v, tgv); ret_v_lds(vinB, LV, e0v, tgv + 8);
        }
        if (C.tid < 128) *(LAS f32x4*)(LG + (C.tid >> 6) * 256 + (C.tid & 63) * 4) = gnst;
#pragma unroll
        for (int i = 0; i < 4; ++i) { const int q = C.tid + 512 * i, row = q >> 4, pc = q & 15;
            kst[i] = *(const u32x4*)(KR + (size_t)(m0 + row) * 768 + h * 128 + pc * 8); }
        LDS_BAR();
        f32x4 o[16];
        const float qdec = exp2f((float)(nl + 1) * lg2);
#pragma unroll
        for (int et = 0; et < 16; ++et) { f32x4 a = (f32x4){0.f, 0.f, 0.f, 0.f};
#pragma unroll
            for (int s = 0; s < 4; ++s) { const bf16x8 rf = *(const LAS bf16x8*)(LR + (16 * et + r16) * 256 + (((4 * s + g) ^ r16) * 16));
                a = __builtin_amdgcn_mfma_f32_16x16x32_bf16(rf, qf[s], a, 0, 0, 0); }
            o[et] = a * qdec;
            if ((et & 3) == 3) __builtin_amdgcn_sched_barrier(0); }
        LDS_BAR();
#pragma unroll
        for (int i = 0; i < 4; ++i) { const int q = C.tid + 512 * i, row = q >> 4, pc = q & 15; *(LAS u32x4*)(LR + row * 256 + ((pc ^ (row & 15)) * 16)) = kst[i]; }
#pragma unroll
        for (int et = 0; et < 16; ++et) gwv[et] = *(const u32x2*)(P + (size_t)(m0 + nl) * LDP_RET + 3072 + h * 256 + 16 * et + 4 * g);
        LDS_BAR();
        const float fd0 = (float)opq_v(nl - 4 * g);
        u32x2 pb[8];
#pragma unroll
        for (int mt = 0; mt < 8; ++mt) {
            pb[mt] = (u32x2){0u, 0u};
            if (mt <= w) { f32x4 a = (f32x4){0.f, 0.f, 0.f, 0.f};
#pragma unroll
                for (int s = 0; s < 4; ++s) { const bf16x8 kf = *(const LAS bf16x8*)(LR + (16 * mt + r16) * 256 + (((4 * s + g) ^ r16) * 16));
                    a = __builtin_amdgcn_mfma_f32_16x16x32_bf16(kf, qf[s], a, 0, 0, 0); }
#pragma unroll
                for (int j = 0; j < 4; ++j) { const float fd = fd0 - (float)(16 * mt + j); a[j] = fd >= 0.f ? a[j] * exp2f(fd * lg2) : 0.f; }
                pb[mt].x = cvt_pk_bf16(a[0], a[1]); pb[mt].y = cvt_pk_bf16(a[2], a[3]); }
        }
#pragma unroll
        for (int ks = 0; ks < 4; ++ks) {
            if (2 * ks <= w) {
                u32x4 pw; pw.x = pb[2 * ks].x; pw.y = pb[2 * ks].y; pw.z = pb[2 * ks + 1].x; pw.w = pb[2 * ks + 1].y;
                const bf16x8 pf = __builtin_bit_cast(bf16x8, pw);
#pragma unroll
                for (int et = 0; et < 16; ++et) { const LAS unsigned char* vr = LV + (16 * et + r16) * 256;
                    const u32x2 lo = *(const LAS u32x2*)(vr + (((8 * ks + g) ^ (2 * r16)) * 8)), hi = *(const LAS u32x2*)(vr + (((8 * ks + 4 + g) ^ (2 * r16)) * 8));
                    u32x4 vw; vw.x = lo.x; vw.y = lo.y; vw.z = hi.x; vw.w = hi.y;
                    o[et] = __builtin_amdgcn_mfma_f32_16x16x32_bf16(__builtin_bit_cast(bf16x8, vw), pf, o[et], 0, 0, 0); } }
        }
        float s1 = 0.f;
#pragma unroll
        for (int et = 0; et < 16; ++et) s1 += (o[et][0] + o[et][1]) + (o[et][2] + o[et][3]);
        s1 += shx(s1, C.lane, 16); s1 += shx(s1, C.lane, 32);
        const float mean = s1 * (1.f / 256.f); float s2 = 0.f;
#pragma unroll
        for (int et = 0; et < 16; ++et) { o[et] = o[et] - mean; s2 += (o[et][0] * o[et][0] + o[et][1] * o[et][1]) + (o[et][2] * o[et][2] + o[et][3] * o[et][3]); }
        s2 += shx(s2, C.lane, 16); s2 += shx(s2, C.lane, 32);
        const float rstd = 1.0f / sqrtf(s2 * (1.f / 256.f) + 1e-5f);
        const int m = m0 + nl;
#pragma unroll
        for (int et = 0; et < 16; ++et) { const int e = h * 256 + 16 * et + 4 * g;
            const f32x4 gg = *(const LAS f32x4*)(LG + 16 * et + 4 * g), gb = *(const LAS f32x4*)(LG + 256 + 16 * et + 4 * g);
            const u32x2 gw_ = gwv[et];
            float gt[4] = {bflo(gw_.x), bfhi(gw_.x), bflo(gw_.y), bfhi(gw_.y)}; float ov[4];
#pragma unroll
            for (int j = 0; j < 4; ++j) { const float yn = o[et][j] * rstd * gg[j] + gb[j]; ov[j] = yn * gt[j] * sigmoidf_(gt[j]); }
            u32x2 wv; wv.x = cvt_pk_bf16(ov[0], ov[1]); wv.y = cvt_pk_bf16(ov[2], ov[3]);
            *(u32x2*)(mix + (size_t)m * D + e) = wv; }
    }
    __syncthreads();
}

constexpr int PH_PER_PAIR = 23, NPH = 2 + 2 * PH_PER_PAIR;
__global__ void __launch_bounds__(NTHR, 2) fwd_kernel(Args args) {
    extern __shared__ __attribute__((aligned(16))) unsigned char lds_raw[];
    Ctx C;
    C.lds = (LAS unsigned char*)lds_raw;
    C.tid = threadIdx.x; C.lane = C.tid & 63; C.wave = __builtin_amdgcn_readfirstlane(C.tid >> 6);
    C.bid = blockIdx.x; C.G = GRID; C.gw = C.bid * NWAVES + C.wave; C.NGW = C.G * NWAVES; C.ws = args.ws;
    for (int u = C.tid; u < (LDS_BYTES - LDS_MISC) / 4; u += NTHR) ((LAS unsigned*)(C.lds + LDS_MISC))[u] = 0u;
    __syncthreads();
    const int lo = args.ph_lo, hi = args.ph_hi;
    XcdBarrier bar; bar.bar = (unsigned*)(args.ws + WS_CTL) + CW_BAR; bar.x = 0; bar.st = nullptr;
    if (hi - lo > 1) bar = xcd_barrier_post((unsigned*)(args.ws + WS_CTL) + CW_BAR, (volatile LAS unsigned*)(C.lds + LDS_MISC));
#ifndef ENMASK
#define ENMASK 0x1ffffffu
#endif
#define EN(j) ((((unsigned)(ENMASK)) >> (j)) & 1u)
#ifndef DBLMASK
#define DBLMASK 0u
#endif
#define REP(j) for (int rep_ = 0; rep_ < 1 + (int)((((unsigned)(DBLMASK)) >> (j)) & 1u); ++rep_)
#define IN(k) (lo <= (k) && (k) < hi)
#define SEAM(k) do { if (IN((k) + 1)) xcd_barrier(bar, (lane_id_asm() == 0) && (Cq.wave == 0)); } while (0)

#define PH_BEGIN Ctx Cq; Cq.lds = C.lds; Cq.lane = lane_id_asm(); Cq.wave = opq_i(C.wave); Cq.tid = Cq.wave * 64 + Cq.lane; Cq.bid = opq_i((int)blockIdx.x); Cq.G = GRID; \
        Cq.gw = Cq.bid * NWAVES + Cq.wave; Cq.NGW = Cq.G * NWAVES; Cq.ws = opq(args.ws); unsigned char* ws = Cq.ws; const int lq = opq_i(lp); (void)ws; (void)lq
    { const int lp = 0;
    REP(0) if (EN(0) && IN(0)) { PH_BEGIN; ph_prologue(Cq, args); SEAM(0); }
    REP(1) if (EN(1) && IN(1)) { PH_BEGIN;
        pg8::SchedMem S; S.G = Cq.G; S.c = Cq.bid; S.memb = (unsigned)WS_MEMB; S.wkv = (unsigned)WS_WKV;
        pg8::EpiMem E; E.O0 = (bf16*)(ws + WS_MEMK); E.O1 = (bf16*)(ws + WS_MEMVT);
        pg8::gemm_phase<pg8::EpiMem, pg8::SchedMem, true, true>(Cq.lds, Cq.tid, (const char*)ws, 2048, 2048, 2048, S, E);
        SEAM(1);
    } }
#pragma unroll 1
    for (int lp = 0; lp < 2; ++lp) {
        const int pb = 2 + lp * PH_PER_PAIR;
        REP(2) if (EN(2) && IN(pb + 0)) {
            PH_BEGIN;
            pg8::SchedPlain S; S.init(M / 256, 22, Cq.G, Cq.bid); S.A0 = (unsigned)(WS_XB); S.B0 = (unsigned)(WS_WIN + (size_t)(2 * lq) * 22 * MiB); S.at = (unsigned)(256 * 2048 * 2); S.bt = (unsigned)(256 * 2048 * 2);
            pg8::EpiBf16 E; E.O = (bf16*)(ws + WS_P); E.ldc = LDP_RW;
            pg8::gemm_phase<pg8::EpiBf16, pg8::SchedPlain, true, true>(Cq.lds, Cq.tid, (const char*)ws, 2048, 2048, 2048, S, E);
            SEAM(pb + 0);
        }
        REP(3) if (EN(3) && IN(pb + 1)) { PH_BEGIN; const bool with_v = lq == 1; ph_rwkv_prep1(Cq, args.in[lq ? L2_MU : L0_MU], with_v); ph_memattn(Cq, (const bf16*)(ws + WS_P), LDP_RW, with_v ? 5120 : 5056); SEAM(pb + 1); }
        REP(4) if (EN(4) && IN(pb + 2)) {
            PH_BEGIN; const float* vecs = args.in[lq ? L2_VECS : L0_VECS];
            pg8::SchedLora S; S.skipv = lq == 0; S.init(M / 256, lq == 0 ? 18 : 24, Cq.G, Cq.bid); S.A0 = (unsigned)(WS_ALORA); S.B0 = (unsigned)(WS_WLORA + (size_t)lq * 3 * MiB);
            pg8::EpiLora E; E.O = (bf16*)(ws + WS_LORAOUT); E.vecs = vecs;
            pg8::gemm_phase<pg8::EpiLora, pg8::SchedLora, true, true>(Cq.lds, Cq.tid, (const char*)ws, 512, 256, opq_i(256), S, E);
            SEAM(pb + 2);
        }
        REP(5) if (EN(5) && IN(pb + 3)) { PH_BEGIN; ph_rwkv_prep2(Cq, args.in[lq ? L2_MU : L0_MU], args.in[lq ? L2_VECS : L0_VECS], lq == 1); SEAM(pb + 3); }
        REP(6) if (EN(6) && IN(pb + 4)) { PH_BEGIN; ph_rwkv_scan(Cq, args.in[lq ? L3_MG : L1_MG], args.in[lq ? L3_MU_ : L1_MU_], args.in[lq ? L3_MD : L1_MD], args.in[lq ? L2_VECS : L0_VECS], lq == 1, args.in, lq); SEAM(pb + 4); }
        REP(8) if (EN(8) && IN(pb + 6)) {
            PH_BEGIN;
            pg8::SchedPlain S; S.init(M / 256, 8, Cq.G, Cq.bid); S.A0 = (unsigned)(WS_MIX); S.B0 = (unsigned)(WS_WOUT + (size_t)(2 * lq) * 8 * MiB); S.at = (unsigned)(256 * 2048 * 2); S.bt = (unsigned)(256 * 2048 * 2);
            pg8::EpiBf16 E; E.O = (bf16*)(ws + WS_P); E.ldc = D;
            pg8::gemm_phase<pg8::EpiBf16, pg8::SchedPlain, true, true>(Cq.lds, Cq.tid, (const char*)ws, 2048, 2048, 2048, S, E);
            SEAM(pb + 6);
        }
        REP(9) if (EN(9) && IN(pb + 7)) { PH_BEGIN; const float* nr = args.in[lq ? L2_NORMS : L0_NORMS];
            ph_ln(Cq, ws + WS_P, 0, nr, nr + D, nullptr, ws + WS_X8, nullptr, false); SEAM(pb + 7); }
        REP(10) if (EN(10) && IN(pb + 8)) {
            PH_BEGIN;
            pg8::SchedPlain S; S.init(M / 256, 44, Cq.G, Cq.bid); S.A0 = (unsigned)(WS_X8); S.B0 = (unsigned)(WS_WFGU + (size_t)lq * 44 * MiB); S.at = (unsigned)(256 * 2048); S.bt = (unsigned)(256 * 2048);
            pg8::EpiSwiglu8 E; E.O = ws + WS_HID; E.ldc = DFF; E.inv = 1.0f / 16384.0f; E.so = 32.0f;
            pg8::gemm_phase<pg8::EpiSwiglu8, pg8::SchedPlain, true, true, true>(Cq.lds, Cq.tid, (const char*)ws, 1024, 1024, 1024, S, E);
            SEAM(pb + 8);
        }
        REP(11) if (EN(11) && IN(pb + 9)) {
            PH_BEGIN;
            pg8::SchedPlain S; S.init(M / 256, 8, Cq.G, Cq.bid); S.A0 = (unsigned)(WS_HID); S.B0 = (unsigned)(WS_WFD + (size_t)lq * 22 * MiB); S.at = (unsigned)(256 * DFF); S.bt = (unsigned)(256 * DFF);
            pg8::EpiFp8S E; E.O = ws + WS_P; E.ldc = D; E.sc = 1.0f / 256.0f;
            pg8::gemm_phase<pg8::EpiFp8S, pg8::SchedPlain, true, true, true>(Cq.lds, Cq.tid, (const char*)ws, DFF / 2, DFF / 2, DFF / 2, S, E);
            SEAM(pb + 9);
        }
        REP(12) if (EN(12) && IN(pb + 10)) { PH_BEGIN; const float* nr = args.in[lq ? L2_NORMS : L0_NORMS];
            ph_ln(Cq, ws + WS_P, 1, nr + 2 * D, nr + 3 * D, nullptr, nullptr, nullptr, false); SEAM(pb + 10); }
        REP(13) if (EN(13) && IN(pb + 11)) {
            PH_BEGIN;
            pg8::SchedPlain S; S.init(M / 256, 20, Cq.G, Cq.bid); S.A0 = (unsigned)(WS_XB); S.B0 = (unsigned)(WS_WIN + (size_t)(2 * lq + 1) * 22 * MiB); S.at = (unsigned)(256 * 2048 * 2); S.bt = (unsigned)(256 * 2048 * 2);
            pg8::EpiBf16 E; E.O = (bf16*)(ws + WS_P); E.ldc = LDP_RET;
            pg8::gemm_phase<pg8::EpiBf16, pg8::SchedPlain, true, true>(Cq.lds, Cq.tid, (const char*)ws, 2048, 2048, 2048, S, E);
            SEAM(pb + 11);
        }
        REP(14) if (EN(14) && IN(pb + 12)) { PH_BEGIN; ph_ret_prep(Cq); ph_memattn(Cq, (const bf16*)(ws + WS_P), LDP_RET, 4608); SEAM(pb + 12); }
        REP(16) if (EN(16) && IN(pb + 14)) { PH_BEGIN; ph_ret_prefix(Cq); SEAM(pb + 14); }
        REP(17) if (EN(17) && IN(pb + 15)) { PH_BEGIN; ph_ret_out(Cq, args.in[lq ? L3_GN : L1_GN]); SEAM(pb + 15); }
        REP(18) if (EN(18) && IN(pb + 16)) {
            PH_BEGIN;
            pg8::SchedPlain S; S.init(M / 256, 8, Cq.G, Cq.bid); S.A0 = (unsigned)(WS_MIX); S.B0 = (unsigned)(WS_WOUT + (size_t)(2 * lq + 1) * 8 * MiB); S.at = (unsigned)(256 * 2048 * 2); S.bt = (unsigned)(256 * 2048 * 2);
            pg8::EpiBf16 E; E.O = (bf16*)(ws + WS_P); E.ldc = D;
            pg8::gemm_phase<pg8::EpiBf16, pg8::SchedPlain, true, true>(Cq.lds, Cq.tid, (const char*)ws, 2048, 2048, 2048, S, E);
            SEAM(pb + 16);
        }
        REP(19) if (EN(19) && IN(pb + 17)) {
            PH_BEGIN; const float* nr = args.in[lq ? L3_NORMS : L1_NORMS];
            REP(25) { ph_ln(Cq, ws + WS_P, 0, nr, nr + D, nullptr, ws + WS_X8, args.in[lq ? L3_ROUTER : L1_ROUTER], true);
            __syncthreads(); }
            SEAM(pb + 17);
        }
        REP(20) if (EN(20) && IN(pb + 18)) { PH_BEGIN; ph_slots(Cq); SEAM(pb + 18); }
        REP(22) if (EN(22) && IN(pb + 20)) {
            PH_BEGIN;
            const int nT = __builtin_amdgcn_readfirstlane(((const int*)(ws + WS_CTL))[CW_NT]);
            pg8::SchedMoEg S; S.init(nT, 44, Cq.G, Cq.bid); S.B0 = (unsigned)(WS_MWGU); S.bt = (unsigned)(256 * 2048); S.be = (unsigned)(22 * MiB);
            S.xoff = (unsigned)WS_X8; S.zoff = (unsigned)(WS_CTL + 512 * 1024); S.texp = (const int*)(ws + WS_CTL) + CW_TEXP; S.slot_tok = (const int*)(ws + WS_SLOTTOK);
            pg8::EpiSwiglu8 E; E.O = ws + WS_HIDM; E.ldc = DFF; E.inv = 1.0f / 16384.0f; E.so = 32.0f;
            pg8::gemm_phase<pg8::EpiSwiglu8, pg8::SchedMoEg, true, true, true>(Cq.lds, Cq.tid, (const char*)ws, 1024, 1024, 1024, S, E);
            SEAM(pb + 20);
        }
        REP(23) if (EN(23) && IN(pb + 21)) {
            PH_BEGIN;
            const int nT = __builtin_amdgcn_readfirstlane(((const int*)(ws + WS_CTL))[CW_NT]);
            pg8::SchedMoE S; S.init(nT, 8, Cq.G, Cq.bid); S.A0 = (unsigned)(WS_HIDM); S.B0 = (unsigned)(WS_MWD); S.at = (unsigned)(256 * DFF); S.bt = (unsigned)(256 * DFF); S.be = (unsigned)(11 * MiB);
            S.texp = (const int*)(ws + WS_CTL) + CW_TEXP;
            pg8::EpiFp8S E; E.O = ws + WS_XPERM; E.ldc = D; E.sc = 1.0f / 256.0f;
            pg8::gemm_phase<pg8::EpiFp8S, pg8::SchedMoE, true, true, true>(Cq.lds, Cq.tid, (const char*)ws, DFF / 2, DFF / 2, DFF / 2, S, E);
            SEAM(pb + 21);
        }
        REP(24) if (EN(24) && IN(pb + 22)) {
            PH_BEGIN; const float* nr = args.in[lq ? L3_NORMS : L1_NORMS];
            ph_ln(Cq, ws + WS_XPERM, 2, nr + 2 * D, nr + 3 * D, lq == 1 ? args.out : nullptr, nullptr, nullptr, false);
            SEAM(pb + 22);
        }
    }
#undef IN
#undef SEAM
}

#ifndef MK_PER_PHASE
#define MK_PER_PHASE 0
#endif
extern "C" void kernel_launch(void* const* d_in, const int* in_sizes, int n_in, void* d_out, int out_size, void* d_ws, size_t ws_size, hipStream_t stream) {
    static int ready = 0;
    if (ready == 0) {
        ready = 1;
        if (n_in != 43 || out_size != M * D || ws_size < WS_END) { fprintf(stderr, "kernel_launch: unexpected problem (n_in %d out %d ws %zu need %zu)\n", n_in, out_size, ws_size, (size_t)WS_END); ready = -1; }
        else if (hipFuncSetAttribute((const void*)fwd_kernel, hipFuncAttributeMaxDynamicSharedMemorySize, LDS_BYTES) != hipSuccess) { fprintf(stderr, "kernel_launch: hipFuncSetAttribute failed\n"); ready = -1; }
        (void)hipGetLastError();
    }
    if (ready < 0) return;
    (void)hipMemsetAsync((char*)d_ws + WS_CTL, 0, CTL_BYTES, stream);
    Args a{};
    for (int i = 0; i < 43; ++i) a.in[i] = (const float*)d_in[i];
    a.out = (float*)d_out; a.ws = (unsigned char*)d_ws;
#if MK_PER_PHASE
    for (int p = 0; p < NPH; ++p) { a.ph_lo = p; a.ph_hi = p + 1; hipLaunchKernelGGL(fwd_kernel, dim3(GRID), dim3(NTHR), LDS_BYTES, stream, a); }
#else
    a.ph_lo = 0; a.ph_hi = NPH;
    hipLaunchKernelGGL(fwd_kernel, dim3(GRID), dim3(NTHR), LDS_BYTES, stream, a);
#endif
}
```
